# Optimizing an MI355X kernel written in HIP

```python
import jax
import jax.numpy as jnp
from jax import lax
import numpy as np

D_MODEL = 1024
BATCH = 16
SEQ = 4096
DEPTH = 4

CTX_LEN = 256
GRID_W = 64
HEAD_DIM = 64
BRANCH_W = D_MODEL // 2
N_BRANCH = 4
NA_HEADS = BRANCH_W // HEAD_DIM
NA_WIN_H = 8
NA_WIN_W = 16
ROPE_THETA = 10000.0
ROPE_AXIS_DIM = HEAD_DIM // 2
ROPE_FREQS = ROPE_AXIS_DIM // 2
FNET_GROUPS = 4
FNET_GROUP_W = BRANCH_W // FNET_GROUPS
GMLP_CHUNK = 128
GMLP_GROUPS = 8
GMLP_GROUP_W = BRANCH_W // GMLP_GROUPS
HGRN_HEADS = 8
HGRN_DK = BRANCH_W // HGRN_HEADS
HGRN_DV = BRANCH_W // HGRN_HEADS
HGRN_CHUNK = 64
EPS = 1e-6
F_FLOOR = 1e-30
NEG_INF = -1e30
F32 = jnp.float32

IN_NAMES = ('a_q', 'a_k', 'a_v', 'a_g', 'b_x', 'b_g', 'c_u', 'c_v', 'c_g',
            'd_q', 'd_f_fwd', 'd_f_bwd', 'd_i', 'd_g', 'gate_0', 'gate_1', 'gate_2', 'gate_3')
IN_SIZES = (BRANCH_W,) * 14 + (D_MODEL,) * N_BRANCH
IN_W = 14 * BRANCH_W + N_BRANCH * D_MODEL

kernel_name = 'hybrid_gated_branch_flow_block'


def in_proj(h, w_in_l, name):
    idx = IN_NAMES.index(name)
    start = sum(IN_SIZES[:idx])
    return h @ w_in_l[:, start:start + IN_SIZES[idx]]


def rmsnorm(x, g):
    xf = x.astype(F32)
    y = xf * lax.rsqrt(jnp.mean(xf * xf, axis=-1, keepdims=True) + EPS)
    return (y * g.astype(F32)).astype(x.dtype)


def heads(t, h):
    return t.reshape(t.shape[0], t.shape[1], h, t.shape[2] // h)


def axial_rope(n_tok):
    t = jnp.arange(n_tok, dtype=jnp.int32)
    pos = jnp.stack([t // GRID_W, t % GRID_W], axis=-1).astype(F32)
    inv = ROPE_THETA ** (-jnp.arange(ROPE_FREQS, dtype=F32) * 2.0 / ROPE_AXIS_DIM)
    ang = pos[:, :, None] * inv
    return jnp.cos(ang), jnp.sin(ang)


def rope2d(x, cos, sin):
    b, n, h, dh = x.shape
    xr = x.reshape(b, n, h, 2, 2, ROPE_FREQS).astype(F32)
    x1, x2 = xr[..., 0, :], xr[..., 1, :]
    c_, s_ = cos[:, None], sin[:, None]
    out = jnp.stack([x1 * c_ - x2 * s_, x2 * c_ + x1 * s_], axis=-2)
    return out.reshape(b, n, h, dh).astype(x.dtype)


def dense_attention(q, k, v):
    s = jnp.einsum('bhqd,bhkd->bhqk', q, k).astype(F32) * (q.shape[-1] ** -0.5)
    p = jax.nn.softmax(s, axis=-1).astype(v.dtype)
    return jnp.einsum('bhqk,bhkd->bhqd', p, v)


def neighbourhood_attention(q_rot, q_plain, k_rot, v, k_ctx, v_ctx, rpb, rows):
    b, n, h, dh = q_rot.shape
    kh = min(NA_WIN_H, rows)
    kw = NA_WIN_W
    scale = dh ** -0.5

    def to_grid(t):
        return t.reshape(b, rows, GRID_W, h, dh).transpose(0, 3, 1, 2, 4)

    qg_r, qg_p, kg, vg = to_grid(q_rot), to_grid(q_plain), to_grid(k_rot), to_grid(v)
    col = jnp.arange(GRID_W)
    col_start = jnp.clip(col - kw // 2, 0, GRID_W - kw)
    col_valid = (col[None, :] >= col_start[:, None]) & (col[None, :] < col_start[:, None] + kw)
    col_idx = jnp.clip(col[None, :] - col[:, None] + NA_WIN_W - 1, 0, 2 * NA_WIN_W - 2)
    rpb_f = rpb.astype(F32)
    band = kh * GRID_W

    def row_block(r):
        rs = jnp.clip(r - kh // 2, 0, rows - kh)
        q_r = lax.dynamic_index_in_dim(qg_r, r, axis=2, keepdims=False)
        q_p = lax.dynamic_index_in_dim(qg_p, r, axis=2, keepdims=False)
        k_band = lax.dynamic_slice_in_dim(kg, rs, kh, axis=2)
        v_band = lax.dynamic_slice_in_dim(vg, rs, kh, axis=2)
        row_idx = rs + jnp.arange(kh) - r + NA_WIN_H - 1
        bias = rpb_f[:, row_idx[None, :, None], col_idx[:, None, :]]
        bias = jnp.where(col_valid[:, None, :], bias, NEG_INF)
        s_band = jnp.einsum('bhqd,bhikd->bhqik', q_r, k_band).astype(F32) * scale + bias
        s_ctx = jnp.einsum('bhqd,bhld->bhql', q_p, k_ctx).astype(F32) * scale
        s = jnp.concatenate([s_band.reshape(b, h, GRID_W, band), s_ctx], axis=-1)
        p = jax.nn.softmax(s, axis=-1).astype(v.dtype)
        o = jnp.einsum('bhqik,bhikd->bhqd', p[..., :band].reshape(b, h, GRID_W, kh, GRID_W), v_band)
        return o + jnp.einsum('bhql,bhld->bhqd', p[..., band:], v_ctx)

    out = lax.map(row_block, jnp.arange(rows))
    return out.transpose(1, 0, 3, 2, 4).reshape(b, n, h * dh)


def na_branch(hx, hc, w, rpb, cos, sin, rows, with_ctx):
    q = heads(in_proj(hx, w, 'a_q'), NA_HEADS)
    k = heads(in_proj(hx, w, 'a_k'), NA_HEADS)
    v = heads(in_proj(hx, w, 'a_v'), NA_HEADS)
    kc = heads(in_proj(hc, w, 'a_k'), NA_HEADS).transpose(0, 2, 1, 3)
    vc = heads(in_proj(hc, w, 'a_v'), NA_HEADS).transpose(0, 2, 1, 3)
    o = neighbourhood_attention(rope2d(q, cos, sin), q, rope2d(k, cos, sin), v, kc, vc, rpb, rows)
    y_lat = o * jax.nn.silu(in_proj(hx, w, 'a_g'))
    if not with_ctx:
        return y_lat, None
    qc = heads(in_proj(hc, w, 'a_q'), NA_HEADS).transpose(0, 2, 1, 3)
    oc = dense_attention(qc, kc, vc).transpose(0, 2, 1, 3).reshape(hc.shape[0], hc.shape[1], BRANCH_W)
    return y_lat, oc * jax.nn.silu(in_proj(hc, w, 'a_g'))


def fourier_branch(h, w, w_f):
    b, n, _ = h.shape
    xb = in_proj(h, w, 'b_x')
    z = xb.reshape(b, n, FNET_GROUPS, FNET_GROUP_W).astype(F32)
    spec = jnp.fft.fft2(z, axes=(1, 3), norm='ortho').real
    y = jnp.einsum('bngc,gcd->bngd', spec, w_f.astype(F32)).reshape(b, n, BRANCH_W).astype(h.dtype)
    return y * jax.nn.silu(in_proj(h, w, 'b_g'))


def gmlp_branch(h, w, g_norm, w_s, b_s):
    b, n, _ = h.shape
    u = in_proj(h, w, 'c_u')
    vn = rmsnorm(in_proj(h, w, 'c_v'), g_norm)
    vn = vn.reshape(b, n // GMLP_CHUNK, GMLP_CHUNK, GMLP_GROUPS, GMLP_GROUP_W)
    mixed = jnp.einsum('gts,bksgc->bktgc', w_s, vn) + b_s.T[None, None, :, :, None]
    return u * mixed.reshape(b, n, BRANCH_W) * jax.nn.silu(in_proj(h, w, 'c_g'))


def forget_gate(z, lb):
    zf = z.astype(F32)
    f = lb + (1.0 - lb) * jax.nn.sigmoid(zf)
    logf = jnp.log(jnp.maximum(f, F_FLOOR))
    k = (1.0 - lb) * jax.nn.sigmoid(-zf)
    return heads(logf, HGRN_HEADS), heads(k, HGRN_HEADS)


def hgrn2_scan(k, logf, i, s0, q=None):
    b, n, h, _ = k.shape
    nc = n // HGRN_CHUNK

    def chunks(t):
        return t.reshape(b, nc, HGRN_CHUNK, h, t.shape[-1]).transpose(1, 0, 3, 2, 4)

    seen = jnp.tril(jnp.ones((HGRN_CHUNK, HGRN_CHUNK), dtype=bool))[:, :, None]

    def step(state, xs):
        kc, gc, ic = xs[0], xs[1], xs[2]
        a = jnp.cumsum(gc, axis=2)
        a_last = a[:, :, -1:, :]
        new_state = jnp.exp(a_last[:, :, 0, :])[..., None] * state + jnp.einsum(
            'bhsk,bhsv->bhkv', kc * jnp.exp(a_last - a), ic)
        if q is None:
            return new_state, None
        qc = xs[3]
        diff = jnp.where(seen, a[:, :, :, None, :] - a[:, :, None, :, :], 0.0)
        decay = jnp.where(seen, jnp.exp(diff), 0.0)
        scores = jnp.einsum('bhtk,bhsk,bhtsk->bhts', qc, kc, decay)
        o = jnp.einsum('bhts,bhsv->bhtv', scores, ic) + jnp.einsum('bhtk,bhkv->bhtv', qc * jnp.exp(a), state)
        return new_state, o

    if q is None:
        final, _ = lax.scan(step, s0, (chunks(k), chunks(logf), chunks(i)))
        return None, final
    final, o = lax.scan(step, s0, (chunks(k), chunks(logf), chunks(i), chunks(q)))
    return o.transpose(1, 0, 3, 2, 4).reshape(b, n, h, o.shape[-1]), final


def hgrn2_readout(o, gate, g_norm):
    b, n = o.shape[0], o.shape[1]
    on = o * lax.rsqrt(jnp.mean(o * o, axis=-1, keepdims=True) + EPS)
    y = (on.reshape(b, n, BRANCH_W) * g_norm.astype(F32)).astype(gate.dtype)
    return y * jax.nn.silu(gate)


def hgrn2_branch(hx, hc, w, lb, g_norm, with_ctx):
    def prep(h, with_q):
        q = heads(in_proj(h, w, 'd_q'), HGRN_HEADS).astype(F32) if with_q else None
        i = heads(in_proj(h, w, 'd_i'), HGRN_HEADS).astype(F32)
        lf_f, k_f = forget_gate(in_proj(h, w, 'd_f_fwd'), lb[0])
        lf_b, k_b = forget_gate(in_proj(h, w, 'd_f_bwd'), lb[1])
        return q, i, lf_f, k_f, lf_b, k_b

    def flip(t):
        return None if t is None else jnp.flip(t, axis=1)

    q, i, lf_f, k_f, lf_b, k_b = prep(hx, True)
    qc, ic, lfc_f, kc_f, lfc_b, kc_b = prep(hc, with_ctx)
    s0 = jnp.zeros((hx.shape[0], HGRN_HEADS, HGRN_DK, HGRN_DV), F32)
    oc_f, sc_f = hgrn2_scan(kc_f, lfc_f, ic, s0, qc)
    oc_b, sc_b = hgrn2_scan(flip(kc_b), flip(lfc_b), flip(ic), s0, flip(qc))
    o_f, _ = hgrn2_scan(k_f, lf_f, i, sc_f, q)
    o_b, _ = hgrn2_scan(flip(k_b), flip(lf_b), flip(i), sc_b, flip(q))
    y_lat = hgrn2_readout(o_f + flip(o_b), in_proj(hx, w, 'd_g'), g_norm)
    if not with_ctx:
        return y_lat, None
    return y_lat, hgrn2_readout(oc_f + flip(oc_b), in_proj(hc, w, 'd_g'), g_norm)


def merge_branches(ys, h, w, w_branch_l, w_out_l):
    merged = None
    for r in range(N_BRANCH):
        term = jax.nn.sigmoid(in_proj(h, w, 'gate_%d' % r)) * (ys[r] @ w_branch_l[r])
        merged = term if merged is None else merged + term
    return merged @ w_out_l


def setup_inputs(seed: int = 0) -> dict:
    key = jax.random.key(seed)
    ks = jax.random.split(key, 18)

    def nrm(k, shape, scale):
        return jax.random.normal(k, shape, F32) * scale

    return {
        'x': nrm(ks[0], (BATCH, SEQ, D_MODEL), 1.0),
        'c': nrm(ks[1], (BATCH, D_MODEL), 1.0),
        'ctx': nrm(ks[2], (BATCH, CTX_LEN, D_MODEL), 1.0),
        'c_ctx': nrm(ks[3], (D_MODEL,), 1.0),
        'w_ada': nrm(ks[4], (DEPTH, D_MODEL, 3 * D_MODEL), D_MODEL ** -0.5),
        'b_ada': nrm(ks[5], (DEPTH, 3 * D_MODEL), 0.02),
        'g_pre': 1.0 + nrm(ks[6], (DEPTH, D_MODEL), 0.02),
        'g_post': 1.0 + nrm(ks[7], (DEPTH, D_MODEL), 0.02),
        'w_in': nrm(ks[8], (DEPTH, D_MODEL, IN_W), D_MODEL ** -0.5),
        'na_rpb': nrm(ks[9], (DEPTH, NA_HEADS, 2 * NA_WIN_H - 1, 2 * NA_WIN_W - 1), 0.5),
        'fnet_w': nrm(ks[10], (DEPTH, FNET_GROUPS, FNET_GROUP_W, FNET_GROUP_W), FNET_GROUP_W ** -0.5),
        'gmlp_norm_g': 1.0 + nrm(ks[11], (DEPTH, BRANCH_W), 0.02),
        'gmlp_ws': nrm(ks[12], (DEPTH, GMLP_GROUPS, GMLP_CHUNK, GMLP_CHUNK), GMLP_CHUNK ** -0.5),
        'gmlp_bs': 1.0 + nrm(ks[13], (DEPTH, GMLP_GROUPS, GMLP_CHUNK), 0.02),
        'hgrn_lb_logits': nrm(ks[14], (DEPTH, 2, BRANCH_W), 0.5),
        'hgrn_norm_g': 1.0 + nrm(ks[15], (DEPTH, BRANCH_W), 0.02),
        'w_branch': nrm(ks[16], (DEPTH, N_BRANCH, BRANCH_W, D_MODEL), BRANCH_W ** -0.5),
        'w_out': nrm(ks[17], (DEPTH, D_MODEL, D_MODEL), D_MODEL ** -0.5),
    }


def reference(x, c, ctx, c_ctx, w_ada, b_ada, g_pre, g_post, w_in, na_rpb, fnet_w,
              gmlp_norm_g, gmlp_ws, gmlp_bs, hgrn_lb_logits, hgrn_norm_g, w_branch, w_out):
    n_tok = x.shape[1]
    rows = n_tok // GRID_W
    cos, sin = axial_rope(n_tok)
    lb_sm = jax.nn.softmax(hgrn_lb_logits.astype(F32), axis=0)
    lower_bounds = jnp.maximum(jnp.cumsum(lb_sm, axis=0) - lb_sm[0:1], 0.0)
    silu_c = jax.nn.silu(c)
    silu_cc = jax.nn.silu(c_ctx)
    for l in range(DEPTH):
        with_ctx = l < DEPTH - 1
        sh_x, sc_x, gt_x = jnp.split(silu_c @ w_ada[l] + b_ada[l], 3, axis=-1)
        sh_c, sc_c, gt_c = jnp.split(silu_cc @ w_ada[l] + b_ada[l], 3, axis=-1)
        hx = rmsnorm(x, g_pre[l]) * (1.0 + sc_x[:, None]) + sh_x[:, None]
        hc = rmsnorm(ctx, g_pre[l]) * (1.0 + sc_c) + sh_c
        w = w_in[l]
        ya, ya_c = na_branch(hx, hc, w, na_rpb[l], cos, sin, rows, with_ctx)
        yb = fourier_branch(hx, w, fnet_w[l])
        yc = gmlp_branch(hx, w, gmlp_norm_g[l], gmlp_ws[l], gmlp_bs[l])
        yd, yd_c = hgrn2_branch(hx, hc, w, lower_bounds[l], hgrn_norm_g[l], with_ctx)
        out_x = merge_branches((ya, yb, yc, yd), hx, w, w_branch[l], w_out[l])
        if with_ctx:
            yb_c = fourier_branch(hc, w, fnet_w[l])
            yc_c = gmlp_branch(hc, w, gmlp_norm_g[l], gmlp_ws[l], gmlp_bs[l])
            out_c = merge_branches((ya_c, yb_c, yc_c, yd_c), hc, w, w_branch[l], w_out[l])
            ctx = ctx + gt_c * rmsnorm(out_c, g_post[l])
        x = x + gt_x[:, None] * rmsnorm(out_x, g_post[l])
    return x
```

```cpp
#include <hip/hip_runtime.h>
#include <hip/hip_cooperative_groups.h>
#include <cstdio>
namespace cg = cooperative_groups;
__device__ __forceinline__ int tidx() { int t = threadIdx.x; asm volatile("" : "+v"(t)); return t; }
template <class T> __device__ __forceinline__ T* opaque(T* p) {
    unsigned long long v = (unsigned long long)p; const unsigned lo = __builtin_amdgcn_readfirstlane((unsigned)v), hi = __builtin_amdgcn_readfirstlane((unsigned)(v >> 32));
    v = ((unsigned long long)hi << 32) | lo; asm volatile("" : "+s"(v)); return (T*)v; }
__device__ __forceinline__ float shx(float v, int m) { const int lane = tidx() & 63; return __int_as_float(__builtin_amdgcn_ds_bpermute((lane ^ m) << 2, __float_as_int(v))); }
namespace pg8 {
#define PG8_LAS __attribute__((address_space(3)))
typedef unsigned short bf16_t;
typedef short bf16x8 __attribute__((ext_vector_type(8)));
typedef float f32x4 __attribute__((ext_vector_type(4)));
typedef unsigned u32x4 __attribute__((ext_vector_type(4)));
constexpr int BM = 256, BK = 64, HALF = 128, HTB = HALF * BK * 2  , STAGE_BYTES = 8 * HTB, NXCD = 8, WGM = 8;

__host__ __device__ __forceinline__ int lds_byte(int r, int c) { const int st = (r >> 4) * 2 + (c >> 5), rr = r & 15, cc = c & 31, ob = rr * 64 + cc * 2; return st * 1024 + (ob ^ (((ob >> 9) & 1) << 5)); }
__host__ __device__ __forceinline__ void stage_rc(int b, int& R, int& C) { const int st = b / 1024, sb = b % 1024, swz = sb ^ (((sb >> 9) & 1) << 5); R = (st >> 1) * 16 + swz / 64; C = (st & 1) * 32 + (swz % 64) / 2; }
__host__ __device__ __forceinline__ int perm32(int rho) { const int n = rho >> 4, i = rho & 15; return 8 * (i >> 2) + 4 * n + (i & 3); }

struct Unit { int pm, pn; };
struct Gemm { const bf16_t* A; const bf16_t* Bt; int M, N, K; };

struct StaticOrder {
    int nM, nN, nwg, G, c;
    __host__ __device__ void init(int M, int N, int G_, int c_) { nM = M / BM; nN = N / BM; nwg = nM * nN; G = G_; c = c_; }
    __host__ __device__ bool next(int i, Unit& u) const {
        const long L = (long)i * G + c; if (L >= nwg) return false;
        int wgid = (int)L; { const int q = nwg / NXCD, r = nwg % NXCD, xcd = wgid % NXCD, off = wgid / NXCD; wgid = (xcd < r ? xcd * (q + 1) : r * (q + 1) + (xcd - r) * q) + off; }
        const int nig = WGM * nN, gid = wgid / nig, fm = gid * WGM, gsz = (nM - fm) < WGM ? (nM - fm) : WGM;
        u.pm = fm + ((wgid % nig) % gsz); u.pn = (wgid % nig) / gsz; return true;
    }
    __device__ __forceinline__ void a_ready(const Unit&) const {}
    __device__ __forceinline__ void done(const Unit&) const {}
};
__device__ __forceinline__ unsigned cvt_pk_bf16(float lo, float hi) { unsigned r; asm volatile("v_cvt_pk_bf16_f32 %0, %1, %2" : "=v"(r) : "v"(lo), "v"(hi)); return r; }

template <class Epi, class Sched, bool STAMP = false>
__device__ __forceinline__ void gemm_phase(PG8_LAS unsigned char* lds, const Gemm g, const Sched& S, const Epi& E, unsigned long long* stamps) {
    const int tid = tidx(), wid = __builtin_amdgcn_readfirstlane(tid >> 6), lane = tid & 63, wr = wid >> 2, wc = wid & 3, fr = lane & 15, fq = lane >> 4;
    const int K = g.K, nt = K / BK;
    int ts_lo = 0, ts_hi = 0, nts = 0; const unsigned long long rt_entry = STAMP ? (unsigned long long)wall_clock64() : 0ull;
#define PG8_STAMP() do { if (STAMP && wid == 0 && nts < 64) { const unsigned long long _c = (unsigned long long)clock64(); \
        ts_lo = (lane == nts) ? (int)(unsigned)_c : ts_lo; ts_hi = (lane == nts) ? (int)(unsigned)(_c >> 32) : ts_hi; ++nts; } } while (0)
    PG8_STAMP();
    unsigned voffA[2], voffB[2];
#pragma unroll
    for (int i = 0; i < 2; ++i) { int R, C; stage_rc(tid * 16 + i * 8192, R, C); const int Rb = Epi::PERM ? ((R & ~31) + perm32(R & 31)) : R;
        voffA[i] = (unsigned)(R * K + C) * 2u; voffB[i] = (unsigned)(Rb * K + C) * 2u; }
    const size_t kstep = (size_t)(BK * 2);
    const size_t hstep = (size_t)HALF * K * 2;
    const size_t tstep = 2 * hstep;
    const unsigned ldsw = (unsigned)wid * 1024u;
    const int aoff = lds_byte(wr * 64 + fr, fq * 8), boff = lds_byte(wc * 32 + fr, fq * 8);
#define PG8_SA(b, h) (((b) * 2 + (h)) * HTB)
#define PG8_SB(b, h) ((4 + (b) * 2 + (h)) * HTB)
#define PG8_STAGE(bufoff, gbase, voff) do { _Pragma("unroll") for (int _i = 0; _i < 2; ++_i) \
        __builtin_amdgcn_global_load_lds((const unsigned*)((const char*)(gbase) + (voff)[_i]), (PG8_LAS unsigned*)(lds + (bufoff) + ldsw + _i * 8192), 16, 0, 0); } while (0)
#define PG8_LDA(dst, b, h) do { _Pragma("unroll") for (int m = 0; m < 4; ++m) _Pragma("unroll") for (int k = 0; k < 2; ++k) dst[m][k] = *(const PG8_LAS bf16x8*)(lds + PG8_SA(b, h) + aoff + m * 2048 + k * 1024); } while (0)
#define PG8_LDB(dst, b, h) do { _Pragma("unroll") for (int n = 0; n < 2; ++n) _Pragma("unroll") for (int k = 0; k < 2; ++k) dst[n][k] = *(const PG8_LAS bf16x8*)(lds + PG8_SB(b, h) + boff + n * 2048 + k * 1024); } while (0)
#define PG8_MMA(ai, bj, At, Bt) do { __builtin_amdgcn_s_setprio(1); _Pragma("unroll") for (int m = 0; m < 4; ++m) _Pragma("unroll") for (int n = 0; n < 2; ++n) _Pragma("unroll") for (int k = 0; k < 2; ++k) \
        acc[ai][bj][m][n] = __builtin_amdgcn_mfma_f32_16x16x32_bf16(Bt[n][k], At[m][k], acc[ai][bj][m][n], 0, 0, 0); __builtin_amdgcn_s_setprio(0); } while (0)
#define PG8_WAIT_V(n) asm volatile("s_waitcnt vmcnt(" #n ")" ::: "memory")
#define PG8_WAIT_L(n) asm volatile("s_waitcnt lgkmcnt(" #n ")" ::: "memory")
#define PG8_BAR __builtin_amdgcn_s_barrier()
#define PG8_SCHED __builtin_amdgcn_sched_barrier(0)
    Unit cur, nxt; int ui = 0;
    if (!S.next(0, cur)) return;
    f32x4 acc[2][2][4][2];
#pragma unroll
    for (int a = 0; a < 2; ++a)
#pragma unroll
        for (int b = 0; b < 2; ++b)
#pragma unroll
            for (int m = 0; m < 4; ++m)
#pragma unroll
                for (int n = 0; n < 2; ++n) acc[a][b][m][n] = (f32x4){0.f, 0.f, 0.f, 0.f};
    bf16x8 At[4][2], B0[2][2], B1[2][2];
    const char* cA = (const char*)g.A + (size_t)cur.pm * tstep; const char* cB = (const char*)g.Bt + (size_t)cur.pn * tstep;
    S.a_ready(cur);
    PG8_STAGE(PG8_SB(0, 0), cB, voffB); PG8_STAGE(PG8_SA(0, 0), cA, voffA); PG8_STAGE(PG8_SB(0, 1), cB + hstep, voffB); PG8_STAGE(PG8_SA(0, 1), cA + hstep, voffA);
    if (wr == 1) PG8_BAR;
    PG8_WAIT_V(4); PG8_BAR;
    PG8_STAGE(PG8_SB(1, 0), cB + kstep, voffB); PG8_STAGE(PG8_SA(1, 0), cA + kstep, voffA); PG8_STAGE(PG8_SB(1, 1), cB + hstep + kstep, voffB);
    PG8_WAIT_V(6); PG8_BAR;
    PG8_STAMP();
    for (;;) {
        const bool has_next = S.next(ui + 1, nxt);
        const char* nA = has_next ? (const char*)g.A + (size_t)nxt.pm * tstep : cA; const char* nB = has_next ? (const char*)g.Bt + (size_t)nxt.pn * tstep : cB;
        for (int t = 0; t < nt; t += 2) {
            const bool last = (t == nt - 2);
            const char* a1 = cA + (size_t)(t + 1) * kstep;
            const char* a2 = last ? nA : cA + (size_t)(t + 2) * kstep; const char* b2 = last ? nB : cB + (size_t)(t + 2) * kstep;
            const char* a3 = a2 + kstep; const char* b3 = b2 + kstep;
            if (last && has_next) S.a_ready(nxt);
            PG8_LDB(B0, 0, 0); PG8_SCHED; PG8_LDA(At, 0, 0); PG8_STAGE(PG8_SA(1, 1), a1 + hstep, voffA);
            PG8_WAIT_L(8); PG8_BAR; PG8_WAIT_L(0); PG8_MMA(0, 0, At, B0); PG8_BAR; PG8_SCHED;
            PG8_LDB(B1, 0, 1); PG8_STAGE(PG8_SB(0, 0), b2, voffB);
            PG8_BAR; PG8_WAIT_L(0); PG8_MMA(0, 1, At, B1); PG8_BAR;
            PG8_LDA(At, 0, 1); PG8_STAGE(PG8_SA(0, 0), a2, voffA);
            PG8_BAR; PG8_WAIT_L(0); PG8_MMA(1, 0, At, B0); PG8_BAR; PG8_SCHED;
            PG8_STAGE(PG8_SB(0, 1), b2 + hstep, voffB);
            PG8_WAIT_V(6); PG8_BAR; PG8_MMA(1, 1, At, B1); PG8_BAR;
            PG8_LDB(B0, 1, 0); PG8_SCHED; PG8_LDA(At, 1, 0); PG8_STAGE(PG8_SA(0, 1), a2 + hstep, voffA);
            PG8_WAIT_L(8); PG8_BAR; PG8_WAIT_L(0); PG8_MMA(0, 0, At, B0); PG8_BAR; PG8_SCHED;
            PG8_LDB(B1, 1, 1); PG8_STAGE(PG8_SB(1, 0), b3, voffB);
            PG8_BAR; PG8_WAIT_L(0); PG8_MMA(0, 1, At, B1); PG8_BAR;
            PG8_LDA(At, 1, 1); PG8_STAGE(PG8_SA(1, 0), a3, voffA);
            PG8_BAR; PG8_WAIT_L(0); PG8_MMA(1, 0, At, B0); PG8_BAR; PG8_SCHED;
            PG8_STAGE(PG8_SB(1, 1), b3 + hstep, voffB);
            PG8_WAIT_V(6); PG8_BAR; PG8_MMA(1, 1, At, B1); PG8_BAR;
        }
        PG8_STAMP();
        if constexpr (!Epi::AFTER_DRAIN) { E(acc, cur, wr, wc, fr, fq); S.done(cur); }
        PG8_STAMP();
        if (!has_next) break;
#pragma unroll
        for (int a = 0; a < 2; ++a)
#pragma unroll
            for (int b = 0; b < 2; ++b)
#pragma unroll
                for (int m = 0; m < 4; ++m)
#pragma unroll
                    for (int n = 0; n < 2; ++n) acc[a][b][m][n] = (f32x4){0.f, 0.f, 0.f, 0.f};
        cur = nxt; cA = nA; cB = nB; ++ui;
    }
    PG8_WAIT_V(0);
    if (wr == 0) PG8_BAR;
    PG8_BAR;
    if constexpr (Epi::AFTER_DRAIN) { E.fused(acc, cur, wr, wc, fr, fq, lds, wid, lane); S.done(cur); }
    PG8_STAMP();
    if (STAMP && wid == 0) { stamps[lane] = lane < nts ? (((unsigned long long)(unsigned)ts_hi << 32) | (unsigned)ts_lo) : 0ull;
        if (lane == 62) stamps[62] = rt_entry; if (lane == 63) stamps[63] = (unsigned long long)wall_clock64(); }
#undef PG8_STAMP
#undef PG8_SA
#undef PG8_SB
#undef PG8_STAGE
#undef PG8_LDA
#undef PG8_LDB
#undef PG8_MMA
#undef PG8_WAIT_V
#undef PG8_WAIT_L
#undef PG8_BAR
#undef PG8_SCHED
}
}

typedef unsigned short u16;
typedef short s16x4 __attribute__((ext_vector_type(4)));
using pg8::bf16x8; using pg8::f32x4; using pg8::Unit;
#define LAS __attribute__((address_space(3)))
#define MFMA16(a, b, c) __builtin_amdgcn_mfma_f32_16x16x32_bf16(a, b, c, 0, 0, 0)

constexpr int DM = 1024, NBATCH = 16, SEQ = 4096, DEPTH = 4, CTXL = 256, NPROJ = 11776, NIN = 11264;
constexpr int GB = 4, MLAT = GB * SEQ, MCTX = NBATCH * CTXL;
constexpr int LDS_BYTES = 152 * 1024;
constexpr float LOG2E = 1.4426950408889634f;
constexpr float EPSN = 1e-6f;

constexpr size_t al256(size_t x) { return (x + 255) & ~(size_t)255; }
constexpr size_t OFF_WTIN = 0;
constexpr size_t OFF_WTBR = OFF_WTIN + (size_t)DEPTH * NPROJ * DM * 2;
constexpr size_t OFF_WTOUT = OFF_WTBR + (size_t)DEPTH * 4 * 1024 * 512 * 2;
constexpr size_t OFF_WS16 = OFF_WTOUT + (size_t)DEPTH * 1024 * 1024 * 2;
constexpr size_t OFF_MOD = OFF_WS16 + (size_t)DEPTH * 8 * 128 * 128 * 2;
constexpr size_t OFF_LB = OFF_MOD + al256((size_t)DEPTH * 17 * 3072 * 4);
constexpr size_t OFF_ROPE = OFF_LB + (size_t)DEPTH * 2 * 512 * 4;
constexpr size_t OFF_TW = OFF_ROPE + 2 * 64 * 16 * 4;
constexpr size_t OFF_M1 = OFF_TW + 4096 * 8;
constexpr size_t OFF_M2 = OFF_M1 + 128 * 128 * 2;
constexpr size_t OFF_M3 = OFF_M2 + 64 * 128 * 2;
constexpr size_t OFF_CSW = OFF_M3 + 256 * 512 * 2;
constexpr size_t OFF_CTXW = OFF_CSW + (size_t)DEPTH * 4 * 2 * 128 * 128 * 4;
constexpr size_t OFF_CTXKV = OFF_CTXW + (size_t)NBATCH * CTXL * DM * 4;
constexpr size_t OFF_CTXST = OFF_CTXKV + (size_t)DEPTH * MCTX * 1024 * 2;
constexpr size_t OFF_H = OFF_CTXST + (size_t)DEPTH * 256 * 4096 * 4;
constexpr size_t OFF_PROJ = OFF_H + (size_t)MLAT * DM * 2;
constexpr size_t OFF_QROT = OFF_PROJ + (size_t)MLAT * NPROJ * 2;
constexpr size_t OFF_LOGF = OFF_QROT + (size_t)MLAT * 512 * 2;
constexpr size_t OFF_Y = OFF_LOGF + (size_t)MLAT * 1024 * 4;
constexpr size_t OFF_FY = OFF_Y + (size_t)4 * MLAT * 512 * 2;
constexpr size_t OFF_HL = OFF_FY + (size_t)GB * 4096 * 1024 * 2;
constexpr size_t OFF_HD = OFF_HL + (size_t)4096 * 4096 * 4;
constexpr size_t OFF_HS = OFF_HD + (size_t)4096 * 64 * 4;
constexpr size_t OFF_MB = OFF_HS + (size_t)4096 * 4096 * 4;
constexpr size_t WS_END = OFF_MB + (size_t)MLAT * DM * 2;
constexpr size_t OFF_MERGED = OFF_LOGF;
constexpr size_t OFF_OUT = OFF_PROJ;

struct Params {
    const float *x, *c, *ctx, *c_ctx, *w_ada, *b_ada, *g_pre, *g_post, *w_in, *rpb, *fnet_w, *gmlp_g, *gmlp_ws, *gmlp_bs, *lb_logits, *hgrn_g, *w_branch, *w_out;
    float* out; unsigned char* ws;
};
struct PassInfo { int is_ctx, nb, T, M, b0; };

__device__ __forceinline__ u16 f2bf(float f) { unsigned u = __float_as_uint(f); u += 0x7FFFu + ((u >> 16) & 1u); return (u16)(u >> 16); }
__device__ __forceinline__ float bf2f(u16 b) { return __uint_as_float(((unsigned)b) << 16); }
__device__ __forceinline__ unsigned pack2(float a, float b) { return (unsigned)f2bf(a) | ((unsigned)f2bf(b) << 16); }
__device__ __forceinline__ float bflo(unsigned w) { return __uint_as_float(w << 16); }
__device__ __forceinline__ float bfhi(unsigned w) { return __uint_as_float(w & 0xFFFF0000u); }
__device__ __forceinline__ float sigmoidf_(float v) { return 1.f / (1.f + __expf(-v)); }
__device__ __forceinline__ void unpack8(uint4 w, float* f) { f[0] = bflo(w.x); f[1] = bfhi(w.x); f[2] = bflo(w.y); f[3] = bfhi(w.y); f[4] = bflo(w.z); f[5] = bfhi(w.z); f[6] = bflo(w.w); f[7] = bfhi(w.w); }
__device__ __forceinline__ bf16x8 tr_read2(const u16* p0, const u16* p1) {
    s16x4 a = __builtin_amdgcn_ds_read_tr16_b64_v4i16((LAS s16x4*)p0);
    s16x4 b = __builtin_amdgcn_ds_read_tr16_b64_v4i16((LAS s16x4*)p1);
    return (bf16x8){a[0], a[1], a[2], a[3], b[0], b[1], b[2], b[3]};
}
__device__ __forceinline__ bf16x8 ld_frag_g(const u16* p) { return *(const bf16x8*)p; }

struct EpiProj {
    static constexpr bool PERM = true, AFTER_DRAIN = false;
    u16* proj; u16* qrot; float* logf; u16* ctxkv; const float* rope; const float* lb; int is_ctx;
    __device__ __forceinline__ void operator()(const f32x4 (&acc)[2][2][4][2], const Unit& u, int wr, int wc, int fr, int fq) const {
        const int blk = u.pn >> 1;
        const int row0 = u.pm * 256 + wr * 64 + fr, col0 = u.pn * 256 + wc * 32 + 8 * fq;
        int type = 0;
        if (blk == 3 || blk == 6 || blk == 9 || blk == 14) type = 1;
        else if (blk >= 15) type = 2;
        else if ((blk == 0 || blk == 1) && !is_ctx) type = 3;
        else if (blk == 11 || blk == 12) type = 5;
#pragma unroll
        for (int ai = 0; ai < 2; ++ai)
#pragma unroll
            for (int m = 0; m < 4; ++m) {
                const int row = row0 + ai * 128 + m * 16;
#pragma unroll
                for (int bj = 0; bj < 2; ++bj) {
                    const int col = col0 + bj * 128;
                    f32x4 v0 = acc[ai][bj][m][0], v1 = acc[ai][bj][m][1];
                    float o[8] = {v0[0], v0[1], v0[2], v0[3], v1[0], v1[1], v1[2], v1[3]};
                    if (type == 1) {
#pragma unroll
                        for (int e = 0; e < 8; ++e) o[e] = o[e] * sigmoidf_(o[e]);
                    } else if (type == 2) {
#pragma unroll
                        for (int e = 0; e < 8; ++e) o[e] = sigmoidf_(o[e]);
                    } else if (type == 3) {
                        const int t = row & 4095, pos = (wc & 1) ? (t & 63) : (t >> 6), f0 = 8 * (fq & 1);
                        const float4 c0 = *(const float4*)(rope + pos * 16 + f0), c1 = *(const float4*)(rope + pos * 16 + f0 + 4);
                        const float4 s0 = *(const float4*)(rope + 1024 + pos * 16 + f0), s1 = *(const float4*)(rope + 1024 + pos * 16 + f0 + 4);
                        const float cs[8] = {c0.x, c0.y, c0.z, c0.w, c1.x, c1.y, c1.z, c1.w}, sn[8] = {s0.x, s0.y, s0.z, s0.w, s1.x, s1.y, s1.z, s1.w};
                        const float sgn = (fq >> 1) ? 1.f : -1.f;
                        float r[8];
#pragma unroll
                        for (int e = 0; e < 8; ++e) { const float pr = shx(o[e], 32); r[e] = o[e] * cs[e] + sgn * pr * sn[e]; }
                        if (blk == 0) {
                            uint4 w; w.x = pack2(r[0], r[1]); w.y = pack2(r[2], r[3]); w.z = pack2(r[4], r[5]); w.w = pack2(r[6], r[7]);
                            *(uint4*)(qrot + (size_t)row * 512 + col) = w;
                        } else {
#pragma unroll
                            for (int e = 0; e < 8; ++e) o[e] = r[e];
                        }
                    } else if (type == 5) {
                        const int dir = blk - 11, cc = col - blk * 512;
                        const float4 l0 = *(const float4*)(lb + dir * 512 + cc), l1 = *(const float4*)(lb + dir * 512 + cc + 4);
                        const float lbv[8] = {l0.x, l0.y, l0.z, l0.w, l1.x, l1.y, l1.z, l1.w};
                        float lf[8];
#pragma unroll
                        for (int e = 0; e < 8; ++e) {
                            const float z = o[e], sg = 1.f / (1.f + __expf(-z)), sgn_ = 1.f / (1.f + __expf(z));
                            const float f = lbv[e] + (1.f - lbv[e]) * sg;
                            lf[e] = __logf(fmaxf(f, 1e-30f));
                            o[e] = (1.f - lbv[e]) * sgn_;
                        }
                        float* lp = logf + (size_t)row * 1024 + dir * 512 + cc;
                        *(float4*)lp = make_float4(lf[0], lf[1], lf[2], lf[3]); *(float4*)(lp + 4) = make_float4(lf[4], lf[5], lf[6], lf[7]);
                    }
                    uint4 w; w.x = pack2(o[0], o[1]); w.y = pack2(o[2], o[3]); w.z = pack2(o[4], o[5]); w.w = pack2(o[6], o[7]);
                    *(uint4*)(proj + (size_t)row * NPROJ + col) = w;
                    if (is_ctx && (blk == 1 || blk == 2)) *(uint4*)(ctxkv + (size_t)row * 1024 + (col - 512)) = w;
                }
            }
    }
};
template <int R> struct EpiMerge {
    static constexpr bool PERM = false, AFTER_DRAIN = false;
    const u16* proj; float* merged; u16* mb;
    __device__ __forceinline__ void operator()(const f32x4 (&acc)[2][2][4][2], const Unit& u, int wr, int wc, int fr, int fq) const {
        const int row0 = u.pm * 256 + wr * 64 + fr, col0 = u.pn * 256 + wc * 32 + 4 * fq;
#pragma unroll
        for (int ai = 0; ai < 2; ++ai)
#pragma unroll
            for (int m = 0; m < 4; ++m) {
                const int row = row0 + ai * 128 + m * 16;
#pragma unroll
                for (int bj = 0; bj < 2; ++bj)
#pragma unroll
                    for (int n = 0; n < 2; ++n) {
                        const int col = col0 + bj * 128 + n * 16;
                        const uint2 g = *(const uint2*)(proj + (size_t)row * NPROJ + 7680 + R * 1024 + col);
                        f32x4 v = acc[ai][bj][m][n];
                        v[0] *= bflo(g.x); v[1] *= bfhi(g.x); v[2] *= bflo(g.y); v[3] *= bfhi(g.y);
                        float* mp = merged + (size_t)row * 1024 + col;
                        if (R > 0) { const f32x4 old = *(const f32x4*)mp; v += old; }
                        if (R < 3) *(f32x4*)mp = v;
                        else { uint2 w; w.x = pack2(v[0], v[1]); w.y = pack2(v[2], v[3]); *(uint2*)(mb + (size_t)row * 1024 + col) = w; }
                    }
            }
    }
};
struct EpiOut {
    static constexpr bool PERM = false, AFTER_DRAIN = false;
    float* C;
    __device__ __forceinline__ void operator()(const f32x4 (&acc)[2][2][4][2], const Unit& u, int wr, int wc, int fr, int fq) const {
        const int row0 = u.pm * 256 + wr * 64 + fr, col0 = u.pn * 256 + wc * 32 + 4 * fq;
#pragma unroll
        for (int ai = 0; ai < 2; ++ai)
#pragma unroll
            for (int m = 0; m < 4; ++m) { float* rowp = C + (size_t)(row0 + ai * 128 + m * 16) * 1024 + col0;
#pragma unroll
                for (int bj = 0; bj < 2; ++bj)
#pragma unroll
                    for (int n = 0; n < 2; ++n) *(f32x4*)(rowp + bj * 128 + n * 16) = acc[ai][bj][m][n]; }
    }
};

__device__ void transpose_tile(const float* src, int lds_, u16* dst, int ldd, int k0, int n0s, int n0d, u16* t) {
    const int tid = tidx();
#pragma unroll
    for (int it = 0; it < 2; ++it) {
        const int kk = (tid >> 4) + it * 32, nn = (tid & 15) * 4;
        const float4 v = *(const float4*)(src + (size_t)(k0 + kk) * lds_ + n0s + nn);
        t[(nn + 0) * 72 + kk] = f2bf(v.x); t[(nn + 1) * 72 + kk] = f2bf(v.y); t[(nn + 2) * 72 + kk] = f2bf(v.z); t[(nn + 3) * 72 + kk] = f2bf(v.w);
    }
    __syncthreads();
    { const int n = tid >> 3, k8 = (tid & 7) * 8;
      const uint4 v = *(const uint4*)(t + n * 72 + k8);
      *(uint4*)(dst + (size_t)(n0d + n) * ldd + k0 + k8) = v; }
    __syncthreads();
}

__device__ void prep1(const Params& p, unsigned char* lds) {
    unsigned char* ws = opaque(p.ws);
    const int tid = tidx();
    const size_t gt = (size_t)blockIdx.x * 512 + tid, gn = (size_t)gridDim.x * 512;
    { u16* ws16 = (u16*)(ws + OFF_WS16);
      for (size_t i = gt; i < (size_t)DEPTH * 8 * 128 * 128; i += gn) ws16[i] = f2bf(p.gmlp_ws[i]);
      float* lbp = (float*)(ws + OFF_LB);
      for (size_t i = gt; i < 1024; i += gn) {
          float e[DEPTH], mx = -1e30f, sum = 0.f;
#pragma unroll
          for (int l = 0; l < DEPTH; ++l) { e[l] = p.lb_logits[l * 1024 + i]; mx = fmaxf(mx, e[l]); }
#pragma unroll
          for (int l = 0; l < DEPTH; ++l) { e[l] = expf(e[l] - mx); sum += e[l]; }
          float run = 0.f;
#pragma unroll
          for (int l = 0; l < DEPTH; ++l) { if (l > 0) run += e[l] / sum; lbp[l * 1024 + i] = fmaxf(run, 0.f); }
      }
      float* rope = (float*)(ws + OFF_ROPE);
      for (size_t i = gt; i < 1024; i += gn) { const int pos = (int)(i >> 4), f = (int)(i & 15);
          const float inv = powf(10000.f, -(float)f * 2.0f / 32.0f), ang = (float)pos * inv;
          rope[i] = cosf(ang); rope[1024 + i] = sinf(ang); }
      float* tw = (float*)(ws + OFF_TW);
      for (size_t i = gt; i < 4096; i += gn) { float s, c; sincospif((float)i * (2.0f / 4096.0f), &s, &c); tw[2 * i] = c; tw[2 * i + 1] = s; }
      u16* m1 = (u16*)(ws + OFF_M1);
      for (size_t i = gt; i < 128 * 128; i += gn) { const int ii = (int)(i >> 7), kk = (int)(i & 127), k1 = ii >> 1, po = ii & 1, n1 = kk >> 1, pi = kk & 1;
          float s, c; sincospif((float)((k1 * n1) & 63) * (2.0f / 64.0f), &s, &c);
          const float v = (po == 0) ? (pi == 0 ? c : -s) : (pi == 0 ? -s : -c);
          m1[i] = f2bf(v); }
      u16* m2 = (u16*)(ws + OFF_M2);
      for (size_t i = gt; i < 64 * 128; i += gn) { const int k2 = (int)(i >> 7), kk = (int)(i & 127), n2 = kk >> 1, pi = kk & 1;
          float s, c; sincospif((float)((k2 * n2) & 63) * (2.0f / 64.0f), &s, &c);
          m2[i] = f2bf(pi == 0 ? c : s); }
      u16* m3 = (u16*)(ws + OFF_M3);
      for (size_t i = gt; i < 256 * 512; i += gn) { const int k = (int)(i >> 9), kk = (int)(i & 511), n = kk >> 1, pi = kk & 1;
          float s, c; sincospif((float)((k * n) & 255) * (2.0f / 256.0f), &s, &c);
          m3[i] = f2bf(pi == 0 ? c : -s); }
    }
    constexpr int N_WIN = DEPTH * 176 * 16, N_WBR = 16 * 16 * 8, N_WOUT = DEPTH * 16 * 16, N_MOD = DEPTH * 48, N_CSW = DEPTH * 4 * 2 * 2;
    constexpr int TOT = N_WIN + N_WBR + N_WOUT + N_MOD + N_CSW;
    for (int it = blockIdx.x; it < TOT; it += gridDim.x) {
        int idx = it;
        if (idx < N_WIN) {
            const int l = idx / 2816, rem = idx % 2816, cb = rem >> 4, kb = rem & 15, n0 = cb * 64;
            if (n0 >= 2048 && n0 < 2560) continue;
            const int n0d = n0 < 2048 ? n0 : n0 + 512;
            transpose_tile(p.w_in + (size_t)l * DM * NIN, NIN, (u16*)(ws + OFF_WTIN) + (size_t)l * NPROJ * DM, DM, kb * 64, n0, n0d, (u16*)lds);
            continue;
        }
        idx -= N_WIN;
        if (idx < N_WBR) {
            const int mat = idx >> 7, rem = idx & 127, cb = rem >> 3, kb = rem & 7;
            transpose_tile(p.w_branch + (size_t)mat * 512 * 1024, 1024, (u16*)(ws + OFF_WTBR) + (size_t)mat * 1024 * 512, 512, kb * 64, cb * 64, cb * 64, (u16*)lds);
            continue;
        }
        idx -= N_WBR;
        if (idx < N_WOUT) {
            const int l = idx >> 8, rem = idx & 255, cb = rem >> 4, kb = rem & 15;
            transpose_tile(p.w_out + (size_t)l * 1024 * 1024, 1024, (u16*)(ws + OFF_WTOUT) + (size_t)l * 1024 * 1024, 1024, kb * 64, cb * 64, cb * 64, (u16*)lds);
            continue;
        }
        idx -= N_WOUT;
        if (idx < N_MOD) {
            const int l = idx / 48, cb = idx % 48;
            float* s = (float*)lds; float* red = s + 17 * 1024;
            for (int i = tid; i < 17 * 1024; i += 512) { const int j = i >> 10, k = i & 1023; const float v = j < 16 ? p.c[j * 1024 + k] : p.c_ctx[k]; s[i] = v / (1.f + expf(-v)); }
            __syncthreads();
            const int col = tid & 63, ks = tid >> 6;
            float acc[17];
#pragma unroll
            for (int j = 0; j < 17; ++j) acc[j] = 0.f;
            for (int k = ks * 128; k < ks * 128 + 128; ++k) {
                const float w = p.w_ada[((size_t)l * 1024 + k) * 3072 + cb * 64 + col];
#pragma unroll
                for (int j = 0; j < 17; ++j) acc[j] += s[j * 1024 + k] * w;
            }
#pragma unroll
            for (int j = 0; j < 17; ++j) red[(ks * 17 + j) * 64 + col] = acc[j];
            __syncthreads();
            for (int o = tid; o < 17 * 64; o += 512) { const int j = o >> 6, cc = o & 63; float sum = 0.f;
                for (int q = 0; q < 8; ++q) sum += red[(q * 17 + j) * 64 + cc];
                ((float*)(ws + OFF_MOD))[((size_t)l * 17 + j) * 3072 + cb * 64 + cc] = sum + p.b_ada[l * 3072 + cb * 64 + cc]; }
            __syncthreads();
            continue;
        }
        idx -= N_MOD;
        {
            const int cblk = idx & 1, part = (idx >> 1) & 1, g = (idx >> 2) & 3, l = idx >> 4;
            float* tb = (float*)lds;
            if (tid < 128) { float s, c; sincospif((float)tid * (2.0f / 128.0f), &s, &c); tb[tid] = part ? s : c; }
            __syncthreads();
            const int d = tid & 127, cq = tid >> 7;
            float acc[16];
#pragma unroll
            for (int i = 0; i < 16; ++i) acc[i] = 0.f;
            const float* wf = p.fnet_w + ((size_t)(l * 4 + g) * 128) * 128;
            for (int c2 = 0; c2 < 128; ++c2) {
                const float w = wf[c2 * 128 + d];
#pragma unroll
                for (int i = 0; i < 16; ++i) { const int c = cblk * 64 + cq * 16 + i; acc[i] += tb[(c * c2) & 127] * w; }
            }
            float* dst = (float*)(ws + OFF_CSW) + ((size_t)((l * 4 + g) * 2 + part) * 128) * 128;
#pragma unroll
            for (int i = 0; i < 16; ++i) dst[(cblk * 64 + cq * 16 + i) * 128 + d] = acc[i];
            __syncthreads();
        }
    }
}

__device__ void prep2(const Params& p, unsigned char* lds) {
    unsigned char* ws = opaque(p.ws);
    const int tid = tidx();
    float* wb = (float*)lds;
    float* cw = wb + 64 * 129;
    for (int it = blockIdx.x; it < DEPTH * 4 * 2 * 16; it += gridDim.x) {
        const int kb = it & 15, part = (it >> 4) & 1, g = (it >> 5) & 3, l = it >> 7;
        for (int i = tid; i < 64 * 128; i += 512) { const int kk = i >> 7, c = i & 127; wb[kk * 129 + c] = p.w_in[((size_t)l * 1024 + kb * 64 + kk) * NIN + 2048 + g * 128 + c]; }
        const float* src = (const float*)(ws + OFF_CSW) + ((size_t)((l * 4 + g) * 2 + part) * 128) * 128;
        for (int i = tid; i < 128 * 128; i += 512) cw[i] = src[i];
        __syncthreads();
        const int d = tid & 127, kq = tid >> 7;
        float acc[16];
#pragma unroll
        for (int i = 0; i < 16; ++i) acc[i] = 0.f;
        for (int c = 0; c < 128; ++c) {
            const float w = cw[c * 128 + d];
#pragma unroll
            for (int i = 0; i < 16; ++i) acc[i] += wb[(kq * 16 + i) * 129 + c] * w;
        }
        u16* dst = (u16*)(ws + OFF_WTIN) + ((size_t)l * NPROJ + (4 + part) * 512 + g * 128 + d) * DM + kb * 64 + kq * 16;
        uint4 w0, w1;
        w0.x = pack2(acc[0], acc[1]); w0.y = pack2(acc[2], acc[3]); w0.z = pack2(acc[4], acc[5]); w0.w = pack2(acc[6], acc[7]);
        w1.x = pack2(acc[8], acc[9]); w1.y = pack2(acc[10], acc[11]); w1.z = pack2(acc[12], acc[13]); w1.w = pack2(acc[14], acc[15]);
        *(uint4*)dst = w0; *(uint4*)(dst + 8) = w1;
        __syncthreads();
    }
}

__device__ void phase_norm(const Params& p, const PassInfo ps, int l) {
    unsigned char* ws = opaque(p.ws);
    const int wave = tidx() >> 6, lane = tidx() & 63;
    const float* mod = (const float*)(ws + OFF_MOD);
    const float* OUT = (const float*)(ws + OFF_OUT);
    u16* H = (u16*)(ws + OFF_H);
    for (int rr = blockIdx.x * 8 + wave; rr < ps.M; rr += gridDim.x * 8) {
        const int b = ps.b0 + rr / ps.T, t = rr % ps.T, mrow = ps.is_ctx ? 16 : b;
        const size_t xoff = ((size_t)b * ps.T + t) * 1024;
        const float* xin = (l <= 1) ? ((ps.is_ctx ? p.ctx : p.x) + xoff) : ((ps.is_ctx ? (const float*)(ws + OFF_CTXW) : (const float*)p.out) + xoff);
        float* xout = (ps.is_ctx ? (float*)(ws + OFF_CTXW) : p.out) + xoff;
        float xv[16];
#pragma unroll
        for (int hlf = 0; hlf < 2; ++hlf) {
            const int c0 = hlf * 512 + lane * 8;
            const float4 a = *(const float4*)(xin + c0), bq = *(const float4*)(xin + c0 + 4);
            xv[hlf * 8 + 0] = a.x; xv[hlf * 8 + 1] = a.y; xv[hlf * 8 + 2] = a.z; xv[hlf * 8 + 3] = a.w;
            xv[hlf * 8 + 4] = bq.x; xv[hlf * 8 + 5] = bq.y; xv[hlf * 8 + 6] = bq.z; xv[hlf * 8 + 7] = bq.w;
        }
        if (l > 0) {
            float ov[16]; float ss = 0.f;
#pragma unroll
            for (int hlf = 0; hlf < 2; ++hlf) {
                const int c0 = hlf * 512 + lane * 8;
                const float4 a = *(const float4*)(OUT + (size_t)rr * 1024 + c0), bq = *(const float4*)(OUT + (size_t)rr * 1024 + c0 + 4);
                ov[hlf * 8 + 0] = a.x; ov[hlf * 8 + 1] = a.y; ov[hlf * 8 + 2] = a.z; ov[hlf * 8 + 3] = a.w;
                ov[hlf * 8 + 4] = bq.x; ov[hlf * 8 + 5] = bq.y; ov[hlf * 8 + 6] = bq.z; ov[hlf * 8 + 7] = bq.w;
            }
#pragma unroll
            for (int e = 0; e < 16; ++e) ss += ov[e] * ov[e];
#pragma unroll
            for (int o = 32; o > 0; o >>= 1) ss += shx(ss, o);
            const float rstd = rsqrtf(ss * (1.f / 1024.f) + EPSN);
            const float* gt = mod + ((size_t)(l - 1) * 17 + mrow) * 3072 + 2048;
            const float* gp = p.g_post + (l - 1) * 1024;
#pragma unroll
            for (int hlf = 0; hlf < 2; ++hlf) {
                const int c0 = hlf * 512 + lane * 8;
#pragma unroll
                for (int e = 0; e < 8; ++e) xv[hlf * 8 + e] += gt[c0 + e] * (ov[hlf * 8 + e] * rstd * gp[c0 + e]);
                *(float4*)(xout + c0) = make_float4(xv[hlf * 8 + 0], xv[hlf * 8 + 1], xv[hlf * 8 + 2], xv[hlf * 8 + 3]);
                *(float4*)(xout + c0 + 4) = make_float4(xv[hlf * 8 + 4], xv[hlf * 8 + 5], xv[hlf * 8 + 6], xv[hlf * 8 + 7]);
            }
        }
        if (l < DEPTH) {
            float ss = 0.f;
#pragma unroll
            for (int e = 0; e < 16; ++e) ss += xv[e] * xv[e];
#pragma unroll
            for (int o = 32; o > 0; o >>= 1) ss += shx(ss, o);
            const float rstd = rsqrtf(ss * (1.f / 1024.f) + EPSN);
            const float* sh = mod + ((size_t)l * 17 + mrow) * 3072; const float* sc = sh + 1024;
            const float* gp = p.g_pre + l * 1024;
#pragma unroll
            for (int hlf = 0; hlf < 2; ++hlf) {
                const int c0 = hlf * 512 + lane * 8;
                float hv[8];
#pragma unroll
                for (int e = 0; e < 8; ++e) hv[e] = xv[hlf * 8 + e] * rstd * gp[c0 + e] * (1.f + sc[c0 + e]) + sh[c0 + e];
                uint4 w; w.x = pack2(hv[0], hv[1]); w.y = pack2(hv[2], hv[3]); w.z = pack2(hv[4], hv[5]); w.w = pack2(hv[6], hv[7]);
                *(uint4*)(H + (size_t)rr * 1024 + c0) = w;
            }
        }
    }
}

constexpr int KVS = 72;
constexpr int TS = 528;
constexpr int T3S = 136;
constexpr int HS_ = 68;
constexpr float NORM_LAT = 0.0013810679320049757f;
constexpr float NORM_CTX = 0.005524271728019903f;

__device__ void attn_item(const Params& p, const PassInfo ps, int l, int item, unsigned char* lds) {
    unsigned char* ws = opaque(p.ws);
    const u16* PROJ = (const u16*)(ws + OFF_PROJ); const u16* QROT = (const u16*)(ws + OFF_QROT);
    const u16* CKV = (const u16*)(ws + OFF_CTXKV) + (size_t)l * MCTX * 1024;
    u16* Y0 = (u16*)(ws + OFF_Y);
    const int tid = tidx(), w = tid >> 6, lane = tid & 63, qtr = w & 3, kh = w >> 2, li = lane & 15, quad = lane >> 4;
    u16* Kl = (u16*)lds; u16* Vl = Kl + 512 * KVS; float* rp = (float*)(Vl + 512 * KVS);
    int bl, h, r = 0, qrow0, bglob;
    if (!ps.is_ctx) { r = item & 63; h = (item >> 6) & 7; bl = item >> 9; qrow0 = bl * 4096 + r * 64; bglob = ps.b0 + bl; }
    else { const int qb = item & 3; h = (item >> 2) & 7; bl = item >> 5; qrow0 = bl * 256 + qb * 64; bglob = bl; }
    const int qrow = qrow0 + qtr * 16 + li;
    float m_run = -1e30f, l_run = 0.f;
    f32x4 O[4];
#pragma unroll
    for (int d = 0; d < 4; ++d) O[d] = (f32x4){0.f, 0.f, 0.f, 0.f};
    if (!ps.is_ctx) {
        const int rs = min(max(r - 4, 0), 56);
        const size_t krow0 = (size_t)bl * 4096 + rs * 64;
#pragma unroll
        for (int i = 0; i < 8; ++i) { const int idx = tid + 512 * i, key = idx >> 3, ch = idx & 7;
            const uint4 kv = *(const uint4*)(PROJ + (krow0 + key) * NPROJ + 512 + h * 64 + ch * 8);
            const uint4 vv = *(const uint4*)(PROJ + (krow0 + key) * NPROJ + 1024 + h * 64 + ch * 8);
            *(uint4*)(Kl + key * KVS + ch * 8) = kv; *(uint4*)(Vl + key * KVS + ch * 8) = vv; }
        for (int i = tid; i < 465; i += 512) rp[i] = p.rpb[((size_t)l * 8 + h) * 465 + i];
        __syncthreads();
        const int cbase = (qtr == 0) ? 0 : (qtr == 1 ? 8 : (qtr == 2 ? 24 : 32));
        const bf16x8 q0 = ld_frag_g(QROT + (size_t)qrow * 512 + h * 64 + quad * 8), q1 = ld_frag_g(QROT + (size_t)qrow * 512 + h * 64 + 32 + quad * 8);
        const int qc = qtr * 16 + li, cst = min(max(qc - 8, 0), 48);
        float s[8][4];
        float mx = -1e30f;
#pragma unroll
        for (int sb = 0; sb < 8; ++sb) {
            const int i = kh * 4 + (sb >> 1), cs = sb & 1;
            const u16* kp = Kl + (i * 64 + cbase + cs * 16 + li) * KVS + quad * 8;
            f32x4 a = (f32x4){0.f, 0.f, 0.f, 0.f};
            a = MFMA16(*(const bf16x8*)kp, q0, a); a = MFMA16(*(const bf16x8*)(kp + 32), q1, a);
            const int ridx = rs + i - r + 7;
#pragma unroll
            for (int j = 0; j < 4; ++j) { const int kc = cbase + cs * 16 + quad * 4 + j;
                const bool valid = (kc >= cst) && (kc < cst + 16);
                const int cidx = min(max(kc - qc + 15, 0), 30);
                const float v = valid ? (a[j] * 0.125f + rp[ridx * 31 + cidx]) : -1e30f;
                s[sb][j] = v; mx = fmaxf(mx, v); }
        }
        mx = fmaxf(mx, shx(mx, 16)); mx = fmaxf(mx, shx(mx, 32));
        m_run = mx;
        float ls = 0.f;
#pragma unroll
        for (int sb = 0; sb < 8; ++sb)
#pragma unroll
            for (int j = 0; j < 4; ++j) { const float e = __expf(s[sb][j] - mx); s[sb][j] = e; ls += e; }
        ls += shx(ls, 16); ls += shx(ls, 32);
        l_run = ls;
#pragma unroll
        for (int kp2 = 0; kp2 < 4; ++kp2) {
            bf16x8 pf; { const unsigned a0 = pack2(s[2 * kp2][0], s[2 * kp2][1]), a1 = pack2(s[2 * kp2][2], s[2 * kp2][3]), b0 = pack2(s[2 * kp2 + 1][0], s[2 * kp2 + 1][1]), b1 = pack2(s[2 * kp2 + 1][2], s[2 * kp2 + 1][3]);
                pf = (bf16x8){(short)(a0 & 0xffff), (short)(a0 >> 16), (short)(a1 & 0xffff), (short)(a1 >> 16), (short)(b0 & 0xffff), (short)(b0 >> 16), (short)(b1 & 0xffff), (short)(b1 >> 16)}; }
            const int vrow0 = (kh * 4 + kp2) * 64 + cbase + quad * 4 + (li >> 2);
#pragma unroll
            for (int d = 0; d < 4; ++d) {
                const u16* vp = Vl + vrow0 * KVS + d * 16 + 4 * (li & 3);
                const bf16x8 vf = tr_read2(vp, vp + 16 * KVS);
                O[d] = MFMA16(vf, pf, O[d]);
            }
        }
        __syncthreads();
    }
    {
        const size_t crow0 = (size_t)bglob * 256;
#pragma unroll
        for (int i = 0; i < 4; ++i) { const int idx = tid + 512 * i, key = idx >> 3, ch = idx & 7;
            const uint4 kv = *(const uint4*)(CKV + (crow0 + key) * 1024 + h * 64 + ch * 8);
            const uint4 vv = *(const uint4*)(CKV + (crow0 + key) * 1024 + 512 + h * 64 + ch * 8);
            *(uint4*)(Kl + key * KVS + ch * 8) = kv; *(uint4*)(Vl + key * KVS + ch * 8) = vv; }
        __syncthreads();
        const bf16x8 q0 = ld_frag_g(PROJ + (size_t)qrow * NPROJ + h * 64 + quad * 8), q1 = ld_frag_g(PROJ + (size_t)qrow * NPROJ + h * 64 + 32 + quad * 8);
        float s[8][4];
        float mx = -1e30f;
#pragma unroll
        for (int sb = 0; sb < 8; ++sb) {
            const u16* kp = Kl + (kh * 128 + sb * 16 + li) * KVS + quad * 8;
            f32x4 a = (f32x4){0.f, 0.f, 0.f, 0.f};
            a = MFMA16(*(const bf16x8*)kp, q0, a); a = MFMA16(*(const bf16x8*)(kp + 32), q1, a);
#pragma unroll
            for (int j = 0; j < 4; ++j) { const float v = a[j] * 0.125f; s[sb][j] = v; mx = fmaxf(mx, v); }
        }
        mx = fmaxf(mx, shx(mx, 16)); mx = fmaxf(mx, shx(mx, 32));
        const float m_new = fmaxf(m_run, mx), resc = __expf(m_run - m_new);
        float ls = 0.f;
#pragma unroll
        for (int sb = 0; sb < 8; ++sb)
#pragma unroll
            for (int j = 0; j < 4; ++j) { const float e = __expf(s[sb][j] - m_new); s[sb][j] = e; ls += e; }
        ls += shx(ls, 16); ls += shx(ls, 32);
        l_run = l_run * resc + ls; m_run = m_new;
#pragma unroll
        for (int d = 0; d < 4; ++d) O[d] *= resc;
#pragma unroll
        for (int kp2 = 0; kp2 < 4; ++kp2) {
            bf16x8 pf; { const unsigned a0 = pack2(s[2 * kp2][0], s[2 * kp2][1]), a1 = pack2(s[2 * kp2][2], s[2 * kp2][3]), b0 = pack2(s[2 * kp2 + 1][0], s[2 * kp2 + 1][1]), b1 = pack2(s[2 * kp2 + 1][2], s[2 * kp2 + 1][3]);
                pf = (bf16x8){(short)(a0 & 0xffff), (short)(a0 >> 16), (short)(a1 & 0xffff), (short)(a1 >> 16), (short)(b0 & 0xffff), (short)(b0 >> 16), (short)(b1 & 0xffff), (short)(b1 >> 16)}; }
            const int vrow0 = kh * 128 + kp2 * 32 + quad * 4 + (li >> 2);
#pragma unroll
            for (int d = 0; d < 4; ++d) {
                const u16* vp = Vl + vrow0 * KVS + d * 16 + 4 * (li & 3);
                const bf16x8 vf = tr_read2(vp, vp + 16 * KVS);
                O[d] = MFMA16(vf, pf, O[d]);
            }
        }
        __syncthreads();
    }
    float* cb = (float*)lds;
    if (kh == 1) {
#pragma unroll
        for (int d = 0; d < 4; ++d)
#pragma unroll
            for (int j = 0; j < 4; ++j) cb[(qtr * 18 + d * 4 + j) * 64 + lane] = O[d][j];
        cb[(qtr * 18 + 16) * 64 + lane] = m_run; cb[(qtr * 18 + 17) * 64 + lane] = l_run;
    }
    __syncthreads();
    if (kh == 0) {
        const float m2 = cb[(qtr * 18 + 16) * 64 + lane], l2 = cb[(qtr * 18 + 17) * 64 + lane];
        const float mm = fmaxf(m_run, m2), e1 = __expf(m_run - mm), e2 = __expf(m2 - mm);
        const float inv = 1.f / (l_run * e1 + l2 * e2);
#pragma unroll
        for (int d = 0; d < 4; ++d) {
            const int col = h * 64 + d * 16 + quad * 4;
            const uint2 g = *(const uint2*)(PROJ + (size_t)qrow * NPROJ + 3 * 512 + col);
            float o[4];
#pragma unroll
            for (int j = 0; j < 4; ++j) o[j] = (O[d][j] * e1 + cb[(qtr * 18 + d * 4 + j) * 64 + lane] * e2) * inv;
            uint2 wv; wv.x = pack2(o[0] * bflo(g.x), o[1] * bfhi(g.x)); wv.y = pack2(o[2] * bflo(g.y), o[3] * bfhi(g.y));
            *(uint2*)(Y0 + (size_t)qrow * 512 + col) = wv;
        }
    }
    __syncthreads();
}

__device__ __forceinline__ void load_tile(u16* dstl, int lstride, const u16* src, size_t sstride, int rows, int chunks_per_row) {
    const int total = rows * chunks_per_row;
    for (int i = tidx(); i < total; i += 512) { const int r = i / chunks_per_row, ch = i - r * chunks_per_row;
        *(uint4*)(dstl + r * lstride + ch * 8) = *(const uint4*)(src + (size_t)r * sstride + ch * 8); }
}

__device__ void four1_item(const Params& p, int item, unsigned char* lds) {
    unsigned char* ws = opaque(p.ws);
    const u16* PROJ = (const u16*)(ws + OFF_PROJ); const u16* M1 = (const u16*)(ws + OFF_M1); const float* TW = (const float*)(ws + OFF_TW);
    u16* FY = (u16*)(ws + OFF_FY);
    const int tid = tidx(), w = tid >> 6, lane = tid & 63, li = lane & 15, quad = lane >> 4;
    const int n2 = item & 63, bl = item >> 6;
    u16* T = (u16*)lds;
    for (int i = tid; i < 128 * 64; i += 512) { const int kk = i >> 6, ch = i & 63, n1 = kk >> 1, part = kk & 1;
        *(uint4*)(T + kk * TS + ch * 8) = *(const uint4*)(PROJ + ((size_t)bl * 4096 + n1 * 64 + n2) * NPROJ + (4 + part) * 512 + ch * 8); }
    __syncthreads();
    for (int isub = 0; isub < 8; ++isub) {
        bf16x8 xf[4];
#pragma unroll
        for (int ks = 0; ks < 4; ++ks) xf[ks] = ld_frag_g(M1 + (isub * 16 + li) * 128 + ks * 32 + quad * 8);
#pragma unroll
        for (int cs = 0; cs < 4; ++cs) {
            const int c0 = w * 64 + cs * 16;
            f32x4 a = (f32x4){0.f, 0.f, 0.f, 0.f};
#pragma unroll
            for (int ks = 0; ks < 4; ++ks) {
                const u16* tp = T + (ks * 32 + quad * 8 + (li >> 2)) * TS + c0 + 4 * (li & 3);
                a = MFMA16(xf[ks], tr_read2(tp, tp + 4 * TS), a);
            }
            const int ch = c0 + li;
#pragma unroll
            for (int hh = 0; hh < 2; ++hh) {
                const int k1 = isub * 8 + quad * 2 + hh;
                const float yr = a[2 * hh], yi = a[2 * hh + 1];
                const float tc = TW[2 * (n2 * k1)], tsn = TW[2 * (n2 * k1) + 1];
                const float orr = yr * tc + yi * tsn, oi = yi * tc - yr * tsn;
                u16* dst = FY + (((size_t)bl * 64 + k1) * 64 + n2) * 1024 + ch;
                dst[0] = f2bf(orr); dst[512] = f2bf(oi);
            }
        }
    }
    __syncthreads();
}

__device__ void four2_item(const Params& p, int item, unsigned char* lds) {
    unsigned char* ws = opaque(p.ws);
    const u16* PROJ = (const u16*)(ws + OFF_PROJ); const u16* M2 = (const u16*)(ws + OFF_M2); const u16* FY = (const u16*)(ws + OFF_FY);
    u16* Y1 = (u16*)(ws + OFF_Y) + (size_t)1 * MLAT * 512;
    const int tid = tidx(), w = tid >> 6, lane = tid & 63, li = lane & 15, quad = lane >> 4;
    const int k1 = item & 63, bl = item >> 6;
    u16* T = (u16*)lds;
    load_tile(T, TS, FY + ((size_t)bl * 64 + k1) * 64 * 1024, 512, 128, 64);
    __syncthreads();
    bf16x8 xf[4][4];
#pragma unroll
    for (int cs = 0; cs < 4; ++cs)
#pragma unroll
        for (int ks = 0; ks < 4; ++ks) { const u16* tp = T + (ks * 32 + quad * 8 + (li >> 2)) * TS + w * 64 + cs * 16 + 4 * (li & 3); xf[cs][ks] = tr_read2(tp, tp + 4 * TS); }
    for (int k2s = 0; k2s < 4; ++k2s) {
        bf16x8 yf[4];
#pragma unroll
        for (int ks = 0; ks < 4; ++ks) yf[ks] = ld_frag_g(M2 + (k2s * 16 + li) * 128 + ks * 32 + quad * 8);
        const int k2 = k2s * 16 + li;
        const size_t row = (size_t)bl * 4096 + k1 + 64 * k2;
#pragma unroll
        for (int cs = 0; cs < 4; ++cs) {
            f32x4 a = (f32x4){0.f, 0.f, 0.f, 0.f};
#pragma unroll
            for (int ks = 0; ks < 4; ++ks) a = MFMA16(xf[cs][ks], yf[ks], a);
            const int ch = w * 64 + cs * 16 + quad * 4;
            const uint2 g = *(const uint2*)(PROJ + row * NPROJ + 6 * 512 + ch);
            uint2 wv; wv.x = pack2(a[0] * NORM_LAT * bflo(g.x), a[1] * NORM_LAT * bfhi(g.x)); wv.y = pack2(a[2] * NORM_LAT * bflo(g.y), a[3] * NORM_LAT * bfhi(g.y));
            *(uint2*)(Y1 + row * 512 + ch) = wv;
        }
    }
    __syncthreads();
}

__device__ void fourc_item(const Params& p, int item, unsigned char* lds) {
    unsigned char* ws = opaque(p.ws);
    const u16* PROJ = (const u16*)(ws + OFF_PROJ); const u16* M3 = (const u16*)(ws + OFF_M3);
    u16* Y1 = (u16*)(ws + OFF_Y) + (size_t)1 * MLAT * 512;
    const int tid = tidx(), w = tid >> 6, lane = tid & 63, li = lane & 15, quad = lane >> 4;
    const int chb = item & 3, b = item >> 2;
    u16* T = (u16*)lds;
    for (int i = tid; i < 512 * 16; i += 512) { const int kk = i >> 4, ch = i & 15, n = kk >> 1, part = kk & 1;
        *(uint4*)(T + kk * T3S + ch * 8) = *(const uint4*)(PROJ + ((size_t)b * 256 + n) * NPROJ + (4 + part) * 512 + chb * 128 + ch * 8); }
    __syncthreads();
    for (int kq = 0; kq < 2; ++kq) {
        const int ksub = w * 2 + kq;
        f32x4 a[8];
#pragma unroll
        for (int cs = 0; cs < 8; ++cs) a[cs] = (f32x4){0.f, 0.f, 0.f, 0.f};
        for (int ks = 0; ks < 16; ++ks) {
            const bf16x8 yf = ld_frag_g(M3 + (ksub * 16 + li) * 512 + ks * 32 + quad * 8);
#pragma unroll
            for (int cs = 0; cs < 8; ++cs) { const u16* tp = T + (ks * 32 + quad * 8 + (li >> 2)) * T3S + cs * 16 + 4 * (li & 3);
                a[cs] = MFMA16(tr_read2(tp, tp + 4 * T3S), yf, a[cs]); }
        }
        const size_t row = (size_t)b * 256 + ksub * 16 + li;
#pragma unroll
        for (int cs = 0; cs < 8; ++cs) {
            const int ch = chb * 128 + cs * 16 + quad * 4;
            const uint2 g = *(const uint2*)(PROJ + row * NPROJ + 6 * 512 + ch);
            uint2 wv; wv.x = pack2(a[cs][0] * NORM_CTX * bflo(g.x), a[cs][1] * NORM_CTX * bfhi(g.x)); wv.y = pack2(a[cs][2] * NORM_CTX * bflo(g.y), a[cs][3] * NORM_CTX * bfhi(g.y));
            *(uint2*)(Y1 + row * 512 + ch) = wv;
        }
    }
    __syncthreads();
}

__device__ void gmlp_item(const Params& p, int l, int item, unsigned char* lds) {
    unsigned char* ws = opaque(p.ws);
    const u16* PROJ = (const u16*)(ws + OFF_PROJ); const u16* WS16 = (const u16*)(ws + OFF_WS16) + (size_t)l * 8 * 128 * 128;
    u16* Y2 = (u16*)(ws + OFF_Y) + (size_t)2 * MLAT * 512;
    const int tid = tidx(), w = tid >> 6, lane = tid & 63, li = lane & 15, quad = lane >> 4;
    const size_t r0 = (size_t)item * 128;
    u16* VN = (u16*)lds;
    {
        const int row = tid >> 2, qd = tid & 3;
        const u16* src = PROJ + (r0 + row) * NPROJ + 8 * 512;
        uint4 raw[16]; float ss = 0.f;
#pragma unroll
        for (int i = 0; i < 16; ++i) { raw[i] = *(const uint4*)(src + (qd + 4 * i) * 8); float f[8]; unpack8(raw[i], f);
#pragma unroll
            for (int e = 0; e < 8; ++e) ss += f[e] * f[e]; }
        ss += shx(ss, 1); ss += shx(ss, 2);
        const float rstd = rsqrtf(ss * (1.f / 512.f) + EPSN);
        const float* gn = p.gmlp_g + l * 512;
#pragma unroll
        for (int i = 0; i < 16; ++i) { float f[8]; unpack8(raw[i], f); const int c0 = (qd + 4 * i) * 8;
            const float4 g0 = *(const float4*)(gn + c0), g1 = *(const float4*)(gn + c0 + 4);
            uint4 o; o.x = pack2(f[0] * rstd * g0.x, f[1] * rstd * g0.y); o.y = pack2(f[2] * rstd * g0.z, f[3] * rstd * g0.w);
            o.z = pack2(f[4] * rstd * g1.x, f[5] * rstd * g1.y); o.w = pack2(f[6] * rstd * g1.z, f[7] * rstd * g1.w);
            *(uint4*)(VN + row * TS + c0) = o; }
    }
    __syncthreads();
    const int g = w;
    bf16x8 xf[4][4];
#pragma unroll
    for (int cs = 0; cs < 4; ++cs)
#pragma unroll
        for (int ks = 0; ks < 4; ++ks) { const u16* tp = VN + (ks * 32 + quad * 8 + (li >> 2)) * TS + g * 64 + cs * 16 + 4 * (li & 3); xf[cs][ks] = tr_read2(tp, tp + 4 * TS); }
    for (int ts = 0; ts < 8; ++ts) {
        bf16x8 yf[4];
#pragma unroll
        for (int ks = 0; ks < 4; ++ks) yf[ks] = ld_frag_g(WS16 + ((size_t)g * 128 + ts * 16 + li) * 128 + ks * 32 + quad * 8);
        const int t = ts * 16 + li;
        const float bs = p.gmlp_bs[((size_t)l * 8 + g) * 128 + t];
        const size_t row = r0 + t;
#pragma unroll
        for (int cs = 0; cs < 4; ++cs) {
            f32x4 a = (f32x4){0.f, 0.f, 0.f, 0.f};
#pragma unroll
            for (int ks = 0; ks < 4; ++ks) a = MFMA16(xf[cs][ks], yf[ks], a);
            const int c = g * 64 + cs * 16 + quad * 4;
            const uint2 uu = *(const uint2*)(PROJ + row * NPROJ + 7 * 512 + c), gg = *(const uint2*)(PROJ + row * NPROJ + 9 * 512 + c);
            uint2 wv; wv.x = pack2(bflo(uu.x) * (a[0] + bs) * bflo(gg.x), bfhi(uu.x) * (a[1] + bs) * bfhi(gg.x));
            wv.y = pack2(bflo(uu.y) * (a[2] + bs) * bflo(gg.y), bfhi(uu.y) * (a[3] + bs) * bfhi(gg.y));
            *(uint2*)(Y2 + row * 512 + c) = wv;
        }
    }
    __syncthreads();
}

__device__ __forceinline__ void chunk_cumsum(float* A, float* tmp, int dir) {
    const int k = tidx() & 63, seg = tidx() >> 6;
    float v[8]; float run = 0.f;
    if (dir == 0) {
#pragma unroll
        for (int e = 0; e < 8; ++e) { run += A[(seg * 8 + e) * HS_ + k]; v[e] = run; }
    } else {
#pragma unroll
        for (int e = 7; e >= 0; --e) { run += A[(seg * 8 + e) * HS_ + k]; v[e] = run; }
    }
    tmp[seg * 64 + k] = run;
    __syncthreads();
    float off = 0.f;
#pragma unroll
    for (int s2 = 0; s2 < 8; ++s2) { const float tv = tmp[s2 * 64 + k]; if (dir == 0 ? (s2 < seg) : (s2 > seg)) off += tv; }
#pragma unroll
    for (int e = 0; e < 8; ++e) A[(seg * 8 + e) * HS_ + k] = (v[e] + off) * LOG2E;
    __syncthreads();
}
__device__ __forceinline__ void load_bf_tile64(float* dst, const u16* src  , size_t sstride) {
    const int t = tidx() >> 3, k8 = (tidx() & 7) * 8;
    float f[8]; unpack8(*(const uint4*)(src + (size_t)t * sstride + k8), f);
    *(float4*)(dst + t * HS_ + k8) = make_float4(f[0], f[1], f[2], f[3]); *(float4*)(dst + t * HS_ + k8 + 4) = make_float4(f[4], f[5], f[6], f[7]);
}
__device__ __forceinline__ void load_f32_tile64(float* dst, const float* src, size_t sstride) {
    const int t = tidx() >> 3, k8 = (tidx() & 7) * 8;
    *(float4*)(dst + t * HS_ + k8) = *(const float4*)(src + (size_t)t * sstride + k8); *(float4*)(dst + t * HS_ + k8 + 4) = *(const float4*)(src + (size_t)t * sstride + k8 + 4);
}

__device__ void hgrn1_item(const Params& p, const PassInfo ps, int item, unsigned char* lds) {
    unsigned char* ws = opaque(p.ws);
    const u16* PROJ = (const u16*)(ws + OFF_PROJ); const float* LOGF = (const float*)(ws + OFF_LOGF);
    float* HL = (float*)(ws + OFF_HL); float* HD = (float*)(ws + OFF_HD);
    const int NC = ps.T >> 6, c = item % NC, ci = item / NC, dir = ci & 1, h = (ci >> 1) & 7, bl = ci >> 4;
    const size_t r0 = (size_t)bl * ps.T + c * 64;
    float* A = (float*)lds; float* KK = A + 64 * HS_; float* I = KK + 64 * HS_; float* tmp = I + 64 * HS_;
    const int tid = tidx();
    load_f32_tile64(A, LOGF + r0 * 1024 + dir * 512 + h * 64, 1024);
    load_bf_tile64(KK, PROJ + r0 * NPROJ + (11 + dir) * 512 + h * 64, NPROJ);
    load_bf_tile64(I, PROJ + r0 * NPROJ + 13 * 512 + h * 64, NPROJ);
    __syncthreads();
    chunk_cumsum(A, tmp, dir);
    const int lastt = dir == 0 ? 63 : 0;
    { const int t = tid >> 3, k8 = (tid & 7) * 8;
#pragma unroll
      for (int e = 0; e < 8; ++e) KK[t * HS_ + k8 + e] *= __builtin_amdgcn_exp2f(A[lastt * HS_ + k8 + e] - A[t * HS_ + k8 + e]);
      if (tid < 64) HD[(size_t)item * 64 + tid] = __builtin_amdgcn_exp2f(A[lastt * HS_ + tid]); }
    __syncthreads();
    { const int k = tid >> 3, v8 = (tid & 7) * 8;
      float acc[8];
#pragma unroll
      for (int e = 0; e < 8; ++e) acc[e] = 0.f;
      for (int t = 0; t < 64; ++t) { const float wv = KK[t * HS_ + k]; const float4 i0 = *(const float4*)(I + t * HS_ + v8), i1 = *(const float4*)(I + t * HS_ + v8 + 4);
          acc[0] += wv * i0.x; acc[1] += wv * i0.y; acc[2] += wv * i0.z; acc[3] += wv * i0.w; acc[4] += wv * i1.x; acc[5] += wv * i1.y; acc[6] += wv * i1.z; acc[7] += wv * i1.w; }
      float* dst = HL + ((size_t)item * 64 + k) * 64 + v8;
      *(float4*)dst = make_float4(acc[0], acc[1], acc[2], acc[3]); *(float4*)(dst + 4) = make_float4(acc[4], acc[5], acc[6], acc[7]); }
    __syncthreads();
}

__device__ void hgrn2_all(const Params& p, const PassInfo ps, int l) {
    unsigned char* ws = opaque(p.ws);
    const float* HL = (const float*)(ws + OFF_HL); const float* HD = (const float*)(ws + OFF_HD); float* HS = (float*)(ws + OFF_HS);
    float* CST = (float*)(ws + OFF_CTXST) + (size_t)l * 256 * 4096;
    const int NC = ps.T >> 6, chains = ps.nb * 16;
    const size_t total = (size_t)chains * 4096;
    for (size_t e = (size_t)blockIdx.x * 512 + tidx(); e < total; e += (size_t)gridDim.x * 512) {
        const int ci = (int)(e >> 12), kv = (int)(e & 4095), k = kv >> 6, dir = ci & 1;
        float s = ps.is_ctx ? 0.f : CST[((size_t)ps.b0 * 16 + ci) * 4096 + kv];
        for (int cc = 0; cc < NC; ++cc) { const int c = dir ? NC - 1 - cc : cc; const size_t idx = (size_t)ci * NC + c;
            HS[idx * 4096 + kv] = s; s = HD[idx * 64 + k] * s + HL[idx * 4096 + kv]; }
        if (ps.is_ctx) CST[(size_t)ci * 4096 + kv] = s;
    }
}

__device__ void hgrn3_item(const Params& p, const PassInfo ps, int l, int item, unsigned char* lds) {
    unsigned char* ws = opaque(p.ws);
    const u16* PROJ = (const u16*)(ws + OFF_PROJ); const float* LOGF = (const float*)(ws + OFF_LOGF); const float* HSt = (const float*)(ws + OFF_HS);
    u16* Y3 = (u16*)(ws + OFF_Y) + (size_t)3 * MLAT * 512;
    const int NC = ps.T >> 6, c = item % NC, bh = item / NC, h = bh & 7, bl = bh >> 3;
    const size_t r0 = (size_t)bl * ps.T + c * 64;
    const size_t idxf = (size_t)(bh * 2 + 0) * NC + c, idxb = (size_t)(bh * 2 + 1) * NC + c;
    float* Q = (float*)lds; float* I = Q + 64 * HS_; float* KKf = I + 64 * HS_; float* KKb = KKf + 64 * HS_; float* Af = KKb + 64 * HS_; float* Ab = Af + 64 * HS_; float* SC = Ab + 64 * HS_; float* tmp = SC + 64 * HS_;
    const int tid = tidx();
    load_bf_tile64(Q, PROJ + r0 * NPROJ + 10 * 512 + h * 64, NPROJ);
    load_bf_tile64(I, PROJ + r0 * NPROJ + 13 * 512 + h * 64, NPROJ);
    load_bf_tile64(KKf, PROJ + r0 * NPROJ + 11 * 512 + h * 64, NPROJ);
    load_bf_tile64(KKb, PROJ + r0 * NPROJ + 12 * 512 + h * 64, NPROJ);
    load_f32_tile64(Af, LOGF + r0 * 1024 + h * 64, 1024);
    load_f32_tile64(Ab, LOGF + r0 * 1024 + 512 + h * 64, 1024);
    __syncthreads();
    chunk_cumsum(Af, tmp, 0);
    chunk_cumsum(Ab, tmp, 1);
    {
        const int tp = tid >> 4, sq = tid & 15;
#pragma unroll
        for (int tt = 0; tt < 2; ++tt)
#pragma unroll
            for (int ss = 0; ss < 4; ++ss) {
                const int t = tp + 32 * tt, s = sq + 16 * ss;
                const bool fwd = s <= t;
                const float* KKp = fwd ? KKf : KKb; const float* Ap = fwd ? Af : Ab;
                float acc = 0.f;
#pragma unroll 4
                for (int k4 = 0; k4 < 16; ++k4) {
                    const float4 q4 = *(const float4*)(Q + t * HS_ + 4 * k4), kk4 = *(const float4*)(KKp + s * HS_ + 4 * k4);
                    const float4 at = *(const float4*)(Ap + t * HS_ + 4 * k4), as = *(const float4*)(Ap + s * HS_ + 4 * k4);
                    acc += q4.x * kk4.x * __builtin_amdgcn_exp2f(at.x - as.x); acc += q4.y * kk4.y * __builtin_amdgcn_exp2f(at.y - as.y);
                    acc += q4.z * kk4.z * __builtin_amdgcn_exp2f(at.z - as.z); acc += q4.w * kk4.w * __builtin_amdgcn_exp2f(at.w - as.w);
                }
                if (s == t) {
#pragma unroll 4
                    for (int k4 = 0; k4 < 16; ++k4) { const float4 q4 = *(const float4*)(Q + t * HS_ + 4 * k4), kk4 = *(const float4*)(KKb + t * HS_ + 4 * k4);
                        acc += q4.x * kk4.x + q4.y * kk4.y + q4.z * kk4.z + q4.w * kk4.w; }
                }
                SC[t * HS_ + s] = acc;
            }
    }
    __syncthreads();
    {
        const int t = tid >> 3, k8 = (tid & 7) * 8;
#pragma unroll
        for (int e = 0; e < 8; ++e) { const float q = Q[t * HS_ + k8 + e];
            KKf[t * HS_ + k8 + e] = q * __builtin_amdgcn_exp2f(Af[t * HS_ + k8 + e]); KKb[t * HS_ + k8 + e] = q * __builtin_amdgcn_exp2f(Ab[t * HS_ + k8 + e]); }
    }
    __syncthreads();
    load_f32_tile64(Af, HSt + idxf * 4096, 64);
    load_f32_tile64(Ab, HSt + idxb * 4096, 64);
    __syncthreads();
    {
        const int t = tid >> 3, v8 = (tid & 7) * 8;
        float acc[8];
#pragma unroll
        for (int e = 0; e < 8; ++e) acc[e] = 0.f;
#define HG_FMA(wv, ptr) do { const float4 i0 = *(const float4*)(ptr), i1 = *(const float4*)((ptr) + 4); \
        acc[0] += wv * i0.x; acc[1] += wv * i0.y; acc[2] += wv * i0.z; acc[3] += wv * i0.w; acc[4] += wv * i1.x; acc[5] += wv * i1.y; acc[6] += wv * i1.z; acc[7] += wv * i1.w; } while (0)
        for (int s = 0; s < 64; ++s) {
            const float sc = SC[t * HS_ + s]; HG_FMA(sc, I + s * HS_ + v8);
            const float qf = KKf[t * HS_ + s]; HG_FMA(qf, Af + s * HS_ + v8);
            const float qb = KKb[t * HS_ + s]; HG_FMA(qb, Ab + s * HS_ + v8);
        }
#undef HG_FMA
        float ss = 0.f;
#pragma unroll
        for (int e = 0; e < 8; ++e) ss += acc[e] * acc[e];
        ss += shx(ss, 1); ss += shx(ss, 2); ss += shx(ss, 4);
        const float rstd = rsqrtf(ss * (1.f / 64.f) + EPSN);
        const float* gn = p.hgrn_g + l * 512 + h * 64 + v8;
        float gate[8]; unpack8(*(const uint4*)(PROJ + (r0 + t) * NPROJ + 14 * 512 + h * 64 + v8), gate);
        float o[8];
#pragma unroll
        for (int e = 0; e < 8; ++e) o[e] = acc[e] * rstd * gn[e] * gate[e];
        uint4 wv; wv.x = pack2(o[0], o[1]); wv.y = pack2(o[2], o[3]); wv.z = pack2(o[4], o[5]); wv.w = pack2(o[6], o[7]);
        *(uint4*)(Y3 + (r0 + t) * 512 + h * 64 + v8) = wv;
    }
    __syncthreads();
}

template <class Epi> __device__ __forceinline__ void run_gemm(LAS unsigned char* lds, const u16* A, const u16* Bt, int M, int N, int K, const Epi& E) {
    pg8::Gemm g; g.A = A; g.Bt = Bt; g.M = M; g.N = N; g.K = K;
    pg8::StaticOrder S; S.init(M, N, (int)gridDim.x, (int)blockIdx.x);
    pg8::gemm_phase<Epi, pg8::StaticOrder, false>(lds, g, S, E, nullptr);
}


__device__ __forceinline__ Params KP() {
    auto q0 = __builtin_amdgcn_kernarg_segment_ptr();
    asm volatile("" : "+s"(q0));
    const __attribute__((address_space(4))) Params* q = (const __attribute__((address_space(4))) Params*)q0;
    Params r;
    r.x = q->x; r.c = q->c; r.ctx = q->ctx; r.c_ctx = q->c_ctx; r.w_ada = q->w_ada; r.b_ada = q->b_ada; r.g_pre = q->g_pre; r.g_post = q->g_post; r.w_in = q->w_in; r.rpb = q->rpb;
    r.fnet_w = q->fnet_w; r.gmlp_g = q->gmlp_g; r.gmlp_ws = q->gmlp_ws; r.gmlp_bs = q->gmlp_bs; r.lb_logits = q->lb_logits; r.hgrn_g = q->hgrn_g; r.w_branch = q->w_branch; r.w_out = q->w_out;
    r.out = q->out; r.ws = q->ws; return r;
}
__device__ __forceinline__ void gsync() { cg::this_grid().sync(); }
__global__ void __launch_bounds__(512, 2) mega_fwd(Params p_unused) {
    extern __shared__ __attribute__((aligned(16))) unsigned char shm[];
    LAS unsigned char* lds3 = (LAS unsigned char*)shm;
    prep1(KP(), shm);
    gsync();
    prep2(KP(), shm);
    gsync();
#pragma nounroll
    for (int pass = 0; pass < 1 + NBATCH / GB; ++pass) {
        PassInfo ps;
        if (pass == 0) { ps.is_ctx = 1; ps.nb = NBATCH; ps.T = CTXL; ps.M = MCTX; ps.b0 = 0; }
        else { ps.is_ctx = 0; ps.nb = GB; ps.T = SEQ; ps.M = MLAT; ps.b0 = (pass - 1) * GB; }
        const int NC = ps.T >> 6;
#pragma nounroll
        for (int l = 0; l < DEPTH; ++l) {
            phase_norm(KP(), ps, l);
            gsync();
            {
                unsigned char* ws = opaque(KP().ws);
                EpiProj E; E.proj = (u16*)(ws + OFF_PROJ); E.qrot = (u16*)(ws + OFF_QROT); E.logf = (float*)(ws + OFF_LOGF);
                E.ctxkv = (u16*)(ws + OFF_CTXKV) + (size_t)l * MCTX * 1024; E.rope = (const float*)(ws + OFF_ROPE); E.lb = (const float*)(ws + OFF_LB) + l * 1024; E.is_ctx = ps.is_ctx;
                run_gemm(lds3, (const u16*)(ws + OFF_H), (const u16*)(ws + OFF_WTIN) + (size_t)l * NPROJ * DM, ps.M, NPROJ, DM, E);
            }
            gsync();
            const bool full = !(ps.is_ctx && l == DEPTH - 1);
            {
                const int n_h1 = ps.nb * 16 * NC, n_at = full ? ps.nb * 8 * (ps.T >> 6) : 0, n_f1 = ps.is_ctx ? 0 : ps.nb * 64;
                for (int it = blockIdx.x; it < n_h1 + n_at + n_f1; it += gridDim.x) {
                    if (it < n_h1) hgrn1_item(KP(), ps, it, shm);
                    else if (it < n_h1 + n_at) attn_item(KP(), ps, l, it - n_h1, shm);
                    else four1_item(KP(), it - n_h1 - n_at, shm);
                }
            }
            gsync();
            {
                hgrn2_all(KP(), ps, l);
                if (full) {
                    const int n_f2 = ps.is_ctx ? ps.nb * 4 : ps.nb * 64, n_g = ps.M >> 7;
                    for (int it = blockIdx.x; it < n_f2 + n_g; it += gridDim.x) {
                        if (it < n_f2) { if (ps.is_ctx) fourc_item(KP(), it, shm); else four2_item(KP(), it, shm); }
                        else gmlp_item(KP(), l, it - n_f2, shm);
                    }
                }
            }
            gsync();
            if (!full) continue;
            {
                const int n_h3 = ps.nb * 8 * NC;
                for (int it = blockIdx.x; it < n_h3; it += gridDim.x) hgrn3_item(KP(), ps, l, it, shm);
            }
            gsync();
            {
                unsigned char* ws = opaque(KP().ws);
                const u16* Y = (const u16*)(ws + OFF_Y); const u16* WB = (const u16*)(ws + OFF_WTBR) + (size_t)l * 4 * 1024 * 512;
                { EpiMerge<0> E; E.proj = (const u16*)(ws + OFF_PROJ); E.merged = (float*)(ws + OFF_MERGED); E.mb = (u16*)(ws + OFF_MB); run_gemm(lds3, Y + (size_t)0 * MLAT * 512, WB + (size_t)0 * 1024 * 512, ps.M, 1024, 512, E); }
                { EpiMerge<1> E; E.proj = (const u16*)(ws + OFF_PROJ); E.merged = (float*)(ws + OFF_MERGED); E.mb = (u16*)(ws + OFF_MB); run_gemm(lds3, Y + (size_t)1 * MLAT * 512, WB + (size_t)1 * 1024 * 512, ps.M, 1024, 512, E); }
                { EpiMerge<2> E; E.proj = (const u16*)(ws + OFF_PROJ); E.merged = (float*)(ws + OFF_MERGED); E.mb = (u16*)(ws + OFF_MB); run_gemm(lds3, Y + (size_t)2 * MLAT * 512, WB + (size_t)2 * 1024 * 512, ps.M, 1024, 512, E); }
                { EpiMerge<3> E; E.proj = (const u16*)(ws + OFF_PROJ); E.merged = (float*)(ws + OFF_MERGED); E.mb = (u16*)(ws + OFF_MB); run_gemm(lds3, Y + (size_t)3 * MLAT * 512, WB + (size_t)3 * 1024 * 512, ps.M, 1024, 512, E); }
            }
            gsync();
            {
                unsigned char* ws = opaque(KP().ws);
                EpiOut E; E.C = (float*)(ws + OFF_OUT);
                run_gemm(lds3, (const u16*)(ws + OFF_MB), (const u16*)(ws + OFF_WTOUT) + (size_t)l * 1024 * 1024, ps.M, 1024, 1024, E);
            }
            gsync();
        }
        if (!ps.is_ctx) phase_norm(KP(), ps, DEPTH);
    }
}

static_assert(WS_END <= (size_t)1073741824, "workspace map exceeds 1 GiB");

extern "C" void kernel_launch(void* const* d_in, const int* in_sizes, int n_in, void* d_out, int out_size, void* d_ws, size_t ws_size, hipStream_t stream) {
    static int grid_blocks = 0;
    if (grid_blocks == 0) {
        if (n_in != 18 || ws_size < WS_END) { fprintf(stderr, "kernel_launch: unexpected n_in %d or ws_size %zu (need %zu)\n", n_in, ws_size, (size_t)WS_END); grid_blocks = -1; return; }
        int dev = 0, cus = 0, per_cu = 0;
        hipGetDevice(&dev);
        hipDeviceGetAttribute(&cus, hipDeviceAttributeMultiprocessorCount, dev);
        if (hipFuncSetAttribute((const void*)mega_fwd, hipFuncAttributeMaxDynamicSharedMemorySize, LDS_BYTES) != hipSuccess) { fprintf(stderr, "kernel_launch: hipFuncSetAttribute failed\n"); grid_blocks = -1; return; }
        hipOccupancyMaxActiveBlocksPerMultiprocessor(&per_cu, (const void*)mega_fwd, 512, LDS_BYTES);
        if (per_cu < 1) { fprintf(stderr, "kernel_launch: occupancy query gave %d\n", per_cu); per_cu = 1; }
        (void)hipGetLastError();
        grid_blocks = cus * per_cu;
    }
    if (grid_blocks < 0) return;
    Params p{};
    const float** pp = (const float**)&p;
    for (int i = 0; i < 18; ++i) pp[i] = (const float*)d_in[i];
    p.out = (float*)d_out; p.ws = (unsigned char*)d_ws;
    void* args[] = {&p};
    hipError_t e = hipLaunchCooperativeKernel((const void*)mega_fwd, dim3(grid_blocks), dim3(512), args, LDS_BYTES, stream);
    if (e != hipSuccess) fprintf(stderr, "cooperative launch failed: %s (grid %d)\n", hipGetErrorString(e), grid_blocks);
}
```

```cpp
#include <hip/hip_runtime.h>
#include <hip/hip_cooperative_groups.h>
#include <cstdio>
namespace cg = cooperative_groups;
__device__ __forceinline__ int tidx() { int t = threadIdx.x; asm volatile("" : "+v"(t)); return t; }
template <class T> __device__ __forceinline__ T* opaque(T* p) {
    unsigned long long v = (unsigned long long)p; const unsigned lo = __builtin_amdgcn_readfirstlane((unsigned)v), hi = __builtin_amdgcn_readfirstlane((unsigned)(v >> 32));
    v = ((unsigned long long)hi << 32) | lo; asm volatile("" : "+s"(v)); return (T*)v; }
__device__ __forceinline__ float shx(float v, int m) { const int lane = tidx() & 63; return __int_as_float(__builtin_amdgcn_ds_bpermute((lane ^ m) << 2, __float_as_int(v))); }
namespace pg8 {
#define PG8_LAS __attribute__((address_space(3)))
typedef unsigned short bf16_t;
typedef short bf16x8 __attribute__((ext_vector_type(8)));
typedef float f32x4 __attribute__((ext_vector_type(4)));
typedef unsigned u32x4 __attribute__((ext_vector_type(4)));
constexpr int BM = 256, BK = 64, HALF = 128, HTB = HALF * BK * 2  , STAGE_BYTES = 8 * HTB, NXCD = 8, WGM = 8;

__host__ __device__ __forceinline__ int lds_byte(int r, int c) { const int st = (r >> 4) * 2 + (c >> 5), rr = r & 15, cc = c & 31, ob = rr * 64 + cc * 2; return st * 1024 + (ob ^ (((ob >> 9) & 1) << 5)); }
__host__ __device__ __forceinline__ void stage_rc(int b, int& R, int& C) { const int st = b / 1024, sb = b % 1024, swz = sb ^ (((sb >> 9) & 1) << 5); R = (st >> 1) * 16 + swz / 64; C = (st & 1) * 32 + (swz % 64) / 2; }
__host__ __device__ __forceinline__ int perm32(int rho) { const int n = rho >> 4, i = rho & 15; return 8 * (i >> 2) + 4 * n + (i & 3); }

struct Unit { int pm, pn; };
struct Gemm { const bf16_t* A; const bf16_t* Bt; int M, N, K; };

struct StaticOrder {
    int nM, nN, nwg, G, c;
    __host__ __device__ void init(int M, int N, int G_, int c_) { nM = M / BM; nN = N / BM; nwg = nM * nN; G = G_; c = c_; }
    __host__ __device__ bool next(int i, Unit& u) const {
        const long L = (long)i * G + c; if (L >= nwg) return false;
        int wgid = (int)L; { const int q = nwg / NXCD, r = nwg % NXCD, xcd = wgid % NXCD, off = wgid / NXCD; wgid = (xcd < r ? xcd * (q + 1) : r * (q + 1) + (xcd - r) * q) + off; }
        const int nig = WGM * nN, gid = wgid / nig, fm = gid * WGM, gsz = (nM - fm) < WGM ? (nM - fm) : WGM;
        u.pm = fm + ((wgid % nig) % gsz); u.pn = (wgid % nig) / gsz; return true;
    }
    __device__ __forceinline__ void a_ready(const Unit&) const {}
    __device__ __forceinline__ void done(const Unit&) const {}
};
__device__ __forceinline__ unsigned cvt_pk_bf16(float lo, float hi) { unsigned r; asm volatile("v_cvt_pk_bf16_f32 %0, %1, %2" : "=v"(r) : "v"(lo), "v"(hi)); return r; }

template <class Epi, class Sched, bool STAMP = false>
__device__ __forceinline__ void gemm_phase(PG8_LAS unsigned char* lds, const Gemm g, const Sched& S, const Epi& E, unsigned long long* stamps) {
    const int tid = tidx(), wid = __builtin_amdgcn_readfirstlane(tid >> 6), lane = tid & 63, wr = wid >> 2, wc = wid & 3, fr = lane & 15, fq = lane >> 4;
    const int K = g.K, nt = K / BK;
    int ts_lo = 0, ts_hi = 0, nts = 0; const unsigned long long rt_entry = STAMP ? (unsigned long long)wall_clock64() : 0ull;
#define PG8_STAMP() do { if (STAMP && wid == 0 && nts < 64) { const unsigned long long _c = (unsigned long long)clock64(); \
        ts_lo = (lane == nts) ? (int)(unsigned)_c : ts_lo; ts_hi = (lane == nts) ? (int)(unsigned)(_c >> 32) : ts_hi; ++nts; } } while (0)
    PG8_STAMP();
    unsigned voffA[2], voffB[2];
#pragma unroll
    for (int i = 0; i < 2; ++i) { int R, C; stage_rc(tid * 16 + i * 8192, R, C); const int Rb = Epi::PERM ? ((R & ~31) + perm32(R & 31)) : R;
        voffA[i] = (unsigned)(R * K + C) * 2u; voffB[i] = (unsigned)(Rb * K + C) * 2u; }
    const size_t kstep = (size_t)(BK * 2);
    const size_t hstep = (size_t)HALF * K * 2;
    const size_t tstep = 2 * hstep;
    const unsigned ldsw = (unsigned)wid * 1024u;
    const int aoff = lds_byte(wr * 64 + fr, fq * 8), boff = lds_byte(wc * 32 + fr, fq * 8);
#define PG8_SA(b, h) (((b) * 2 + (h)) * HTB)
#define PG8_SB(b, h) ((4 + (b) * 2 + (h)) * HTB)
#define PG8_STAGE(bufoff, gbase, voff) do { _Pragma("unroll") for (int _i = 0; _i < 2; ++_i) \
        __builtin_amdgcn_global_load_lds((const unsigned*)((const char*)(gbase) + (voff)[_i]), (PG8_LAS unsigned*)(lds + (bufoff) + ldsw + _i * 8192), 16, 0, 0); } while (0)
#define PG8_LDA(dst, b, h) do { _Pragma("unroll") for (int m = 0; m < 4; ++m) _Pragma("unroll") for (int k = 0; k < 2; ++k) dst[m][k] = *(const PG8_LAS bf16x8*)(lds + PG8_SA(b, h) + aoff + m * 2048 + k * 1024); } while (0)
#define PG8_LDB(dst, b, h) do { _Pragma("unroll") for (int n = 0; n < 2; ++n) _Pragma("unroll") for (int k = 0; k < 2; ++k) dst[n][k] = *(const PG8_LAS bf16x8*)(lds + PG8_SB(b, h) + boff + n * 2048 + k * 1024); } while (0)
#define PG8_MMA(ai, bj, At, Bt) do { __builtin_amdgcn_s_setprio(1); _Pragma("unroll") for (int m = 0; m < 4; ++m) _Pragma("unroll") for (int n = 0; n < 2; ++n) _Pragma("unroll") for (int k = 0; k < 2; ++k) \
        acc[ai][bj][m][n] = __builtin_amdgcn_mfma_f32_16x16x32_bf16(Bt[n][k], At[m][k], acc[ai][bj][m][n], 0, 0, 0); __builtin_amdgcn_s_setprio(0); } while (0)
#define PG8_WAIT_V(n) asm volatile("s_waitcnt vmcnt(" #n ")" ::: "memory")
#define PG8_WAIT_L(n) asm volatile("s_waitcnt lgkmcnt(" #n ")" ::: "memory")
#define PG8_BAR __builtin_amdgcn_s_barrier()
#define PG8_SCHED __builtin_amdgcn_sched_barrier(0)
    Unit cur, nxt; int ui = 0;
    if (!S.next(0, cur)) return;
    f32x4 acc[2][2][4][2];
#pragma unroll
    for (int a = 0; a < 2; ++a)
#pragma unroll
        for (int b = 0; b < 2; ++b)
#pragma unroll
            for (int m = 0; m < 4; ++m)
#pragma unroll
                for (int n = 0; n < 2; ++n) acc[a][b][m][n] = (f32x4){0.f, 0.f, 0.f, 0.f};
    bf16x8 At[4][2], B0[2][2], B1[2][2];
    const char* cA = (const char*)g.A + (size_t)cur.pm * tstep; const char* cB = (const char*)g.Bt + (size_t)cur.pn * tstep;
    S.a_ready(cur);
    PG8_STAGE(PG8_SB(0, 0), cB, voffB); PG8_STAGE(PG8_SA(0, 0), cA, voffA); PG8_STAGE(PG8_SB(0, 1), cB + hstep, voffB); PG8_STAGE(PG8_SA(0, 1), cA + hstep, voffA);
    if (wr == 1) PG8_BAR;
    PG8_WAIT_V(4); PG8_BAR;
    PG8_STAGE(PG8_SB(1, 0), cB + kstep, voffB); PG8_STAGE(PG8_SA(1, 0), cA + kstep, voffA); PG8_STAGE(PG8_SB(1, 1), cB + hstep + kstep, voffB);
    PG8_WAIT_V(6); PG8_BAR;
    PG8_STAMP();
    for (;;) {
        const bool has_next = S.next(ui + 1, nxt);
        const char* nA = has_next ? (const char*)g.A + (size_t)nxt.pm * tstep : cA; const char* nB = has_next ? (const char*)g.Bt + (size_t)nxt.pn * tstep : cB;
        for (int t = 0; t < nt; t += 2) {
            const bool last = (t == nt - 2);
            const char* a1 = cA + (size_t)(t + 1) * kstep;
            const char* a2 = last ? nA : cA + (size_t)(t + 2) * kstep; const char* b2 = last ? nB : cB + (size_t)(t + 2) * kstep;
            const char* a3 = a2 + kstep; const char* b3 = b2 + kstep;
            if (last && has_next) S.a_ready(nxt);
            PG8_LDB(B0, 0, 0); PG8_SCHED; PG8_LDA(At, 0, 0); PG8_STAGE(PG8_SA(1, 1), a1 + hstep, voffA);
            PG8_WAIT_L(8); PG8_BAR; PG8_WAIT_L(0); PG8_MMA(0, 0, At, B0); PG8_BAR; PG8_SCHED;
            PG8_LDB(B1, 0, 1); PG8_STAGE(PG8_SB(0, 0), b2, voffB);
            PG8_BAR; PG8_WAIT_L(0); PG8_MMA(0, 1, At, B1); PG8_BAR;
            PG8_LDA(At, 0, 1); PG8_STAGE(PG8_SA(0, 0), a2, voffA);
            PG8_BAR; PG8_WAIT_L(0); PG8_MMA(1, 0, At, B0); PG8_BAR; PG8_SCHED;
            PG8_STAGE(PG8_SB(0, 1), b2 + hstep, voffB);
            PG8_WAIT_V(6); PG8_BAR; PG8_MMA(1, 1, At, B1); PG8_BAR;
            PG8_LDB(B0, 1, 0); PG8_SCHED; PG8_LDA(At, 1, 0); PG8_STAGE(PG8_SA(0, 1), a2 + hstep, voffA);
            PG8_WAIT_L(8); PG8_BAR; PG8_WAIT_L(0); PG8_MMA(0, 0, At, B0); PG8_BAR; PG8_SCHED;
            PG8_LDB(B1, 1, 1); PG8_STAGE(PG8_SB(1, 0), b3, voffB);
            PG8_BAR; PG8_WAIT_L(0); PG8_MMA(0, 1, At, B1); PG8_BAR;
            PG8_LDA(At, 1, 1); PG8_STAGE(PG8_SA(1, 0), a3, voffA);
            PG8_BAR; PG8_WAIT_L(0); PG8_MMA(1, 0, At, B0); PG8_BAR; PG8_SCHED;
            PG8_STAGE(PG8_SB(1, 1), b3 + hstep, voffB);
            PG8_WAIT_V(6); PG8_BAR; PG8_MMA(1, 1, At, B1); PG8_BAR;
        }
        PG8_STAMP();
        if constexpr (!Epi::AFTER_DRAIN) { E(acc, cur, wr, wc, fr, fq); S.done(cur); }
        PG8_STAMP();
        if (!has_next) break;
#pragma unroll
        for (int a = 0; a < 2; ++a)
#pragma unroll
            for (int b = 0; b < 2; ++b)
#pragma unroll
                for (int m = 0; m < 4; ++m)
#pragma unroll
                    for (int n = 0; n < 2; ++n) acc[a][b][m][n] = (f32x4){0.f, 0.f, 0.f, 0.f};
        cur = nxt; cA = nA; cB = nB; ++ui;
    }
    PG8_WAIT_V(0);
    if (wr == 0) PG8_BAR;
    PG8_BAR;
    if constexpr (Epi::AFTER_DRAIN) { E.fused(acc, cur, wr, wc, fr, fq, lds, wid, lane); S.done(cur); }
    PG8_STAMP();
    if (STAMP && wid == 0) { stamps[lane] = lane < nts ? (((unsigned long long)(unsigned)ts_hi << 32) | (unsigned)ts_lo) : 0ull;
        if (lane == 62) stamps[62] = rt_entry; if (lane == 63) stamps[63] = (unsigned long long)wall_clock64(); }
#undef PG8_STAMP
#undef PG8_SA
#undef PG8_SB
#undef PG8_STAGE
#undef PG8_LDA
#undef PG8_LDB
#undef PG8_MMA
#undef PG8_WAIT_V
#undef PG8_WAIT_L
#undef PG8_BAR
#undef PG8_SCHED
}
}

typedef unsigned short u16;
typedef short s16x4 __attribute__((ext_vector_type(4)));
using pg8::bf16x8; using pg8::f32x4; using pg8::Unit;
#define LAS __attribute__((address_space(3)))
#define MFMA16(a, b, c) __builtin_amdgcn_mfma_f32_16x16x32_bf16(a, b, c, 0, 0, 0)

constexpr int DM = 1024, NBATCH = 16, SEQ = 4096, DEPTH = 4, CTXL = 256, NPROJ = 11776, NIN = 11264;
constexpr int GB = 4, MLAT = GB * SEQ, MCTX = NBATCH * CTXL;
constexpr int LDS_BYTES = 152 * 1024;
constexpr float LOG2E = 1.4426950408889634f;
constexpr float EPSN = 1e-6f;

constexpr size_t al256(size_t x) { return (x + 255) & ~(size_t)255; }
constexpr size_t OFF_WTIN = 0;
constexpr size_t OFF_WTBR = OFF_WTIN + (size_t)DEPTH * NPROJ * DM * 2;
constexpr size_t OFF_WTOUT = OFF_WTBR + (size_t)DEPTH * 4 * 1024 * 512 * 2;
constexpr size_t OFF_WS16 = OFF_WTOUT + (size_t)DEPTH * 1024 * 1024 * 2;
constexpr size_t OFF_MOD = OFF_WS16 + (size_t)DEPTH * 8 * 128 * 128 * 2;
constexpr size_t OFF_LB = OFF_MOD + al256((size_t)DEPTH * 17 * 3072 * 4);
constexpr size_t OFF_ROPE = OFF_LB + (size_t)DEPTH * 2 * 512 * 4;
constexpr size_t OFF_TW = OFF_ROPE + 2 * 64 * 16 * 4;
constexpr size_t OFF_M1 = OFF_TW + 4096 * 8;
constexpr size_t OFF_M2 = OFF_M1 + 128 * 128 * 2;
constexpr size_t OFF_M3 = OFF_M2 + 64 * 128 * 2;
constexpr size_t OFF_CSW = OFF_M3 + 256 * 512 * 2;
constexpr size_t OFF_CTXW = OFF_CSW + (size_t)DEPTH * 4 * 2 * 128 * 128 * 4;
constexpr size_t OFF_CTXKV = OFF_CTXW + (size_t)NBATCH * CTXL * DM * 4;
constexpr size_t OFF_CTXST = OFF_CTXKV + (size_t)DEPTH * MCTX * 1024 * 2;
constexpr size_t OFF_H = OFF_CTXST + (size_t)DEPTH * 256 * 4096 * 4;
constexpr size_t OFF_PROJ = OFF_H + (size_t)MLAT * DM * 2;
constexpr size_t OFF_QROT = OFF_PROJ + (size_t)MLAT * NPROJ * 2;
constexpr size_t OFF_LOGF = OFF_QROT + (size_t)MLAT * 512 * 2;
constexpr size_t OFF_Y = OFF_LOGF + (size_t)MLAT * 1024 * 4;
constexpr size_t OFF_FY = OFF_Y + (size_t)4 * MLAT * 512 * 2;
constexpr size_t OFF_HL = OFF_FY + (size_t)GB * 4096 * 1024 * 2;
constexpr size_t OFF_HD = OFF_HL + (size_t)4096 * 4096 * 4;
constexpr size_t OFF_HS = OFF_HD + (size_t)4096 * 64 * 4;
constexpr size_t OFF_MB = OFF_HS + (size_t)4096 * 4096 * 4;
constexpr size_t WS_END = OFF_MB + (size_t)MLAT * DM * 2;
constexpr size_t OFF_MERGED = OFF_LOGF;
constexpr size_t OFF_OUT = OFF_PROJ;

struct Params {
    const float *x, *c, *ctx, *c_ctx, *w_ada, *b_ada, *g_pre, *g_post, *w_in, *rpb, *fnet_w, *gmlp_g, *gmlp_ws, *gmlp_bs, *lb_logits, *hgrn_g, *w_branch, *w_out;
    float* out; unsigned char* ws;
};
struct PassInfo { int is_ctx, nb, T, M, b0; };

__device__ __forceinline__ u16 f2bf(float f) { unsigned u = __float_as_uint(f); u += 0x7FFFu + ((u >> 16) & 1u); return (u16)(u >> 16); }
__device__ __forceinline__ float bf2f(u16 b) { return __uint_as_float(((unsigned)b) << 16); }
__device__ __forceinline__ unsigned pack2(float a, float b) { return (unsigned)f2bf(a) | ((unsigned)f2bf(b) << 16); }
__device__ __forceinline__ float bflo(unsigned w) { return __uint_as_float(w << 16); }
__device__ __forceinline__ float bfhi(unsigned w) { return __uint_as_float(w & 0xFFFF0000u); }
__device__ __forceinline__ float sigmoidf_(float v) { return 1.f / (1.f + __expf(-v)); }
__device__ __forceinline__ void unpack8(uint4 w, float* f) { f[0] = bflo(w.x); f[1] = bfhi(w.x); f[2] = bflo(w.y); f[3] = bfhi(w.y); f[4] = bflo(w.z); f[5] = bfhi(w.z); f[6] = bflo(w.w); f[7] = bfhi(w.w); }
__device__ __forceinline__ bf16x8 tr_read2(const u16* p0, const u16* p1) {
    s16x4 a = __builtin_amdgcn_ds_read_tr16_b64_v4i16((LAS s16x4*)p0);
    s16x4 b = __builtin_amdgcn_ds_read_tr16_b64_v4i16((LAS s16x4*)p1);
    return (bf16x8){a[0], a[1], a[2], a[3], b[0], b[1], b[2], b[3]};
}
__device__ __forceinline__ bf16x8 ld_frag_g(const u16* p) { return *(const bf16x8*)p; }

struct EpiProj {
    static constexpr bool PERM = true, AFTER_DRAIN = false;
    unsigned char* ws; int l; int is_ctx;
    __device__ __forceinline__ void operator()(const f32x4 (&acc)[2][2][4][2], const Unit& u, int wr, int wc, int fr, int fq) const {
        u16* proj = (u16*)(ws + OFF_PROJ); u16* qrot = (u16*)(ws + OFF_QROT); float* logf = (float*)(ws + OFF_LOGF); u16* ctxkv = (u16*)(ws + OFF_CTXKV) + (size_t)l * MCTX * 1024;
        const float* rope = (const float*)(ws + OFF_ROPE); const float* lb = (const float*)(ws + OFF_LB) + l * 1024;
        const int blk = u.pn >> 1;
        const int row0 = u.pm * 256 + wr * 64 + fr, col0 = u.pn * 256 + wc * 32 + 8 * fq;
        int type = 0;
        if (blk == 3 || blk == 6 || blk == 9 || blk == 14) type = 1;
        else if (blk >= 15) type = 2;
        else if ((blk == 0 || blk == 1) && !is_ctx) type = 3;
        else if (blk == 11 || blk == 12) type = 5;
#pragma unroll
        for (int ai = 0; ai < 2; ++ai)
#pragma unroll
            for (int m = 0; m < 4; ++m) {
                const int row = row0 + ai * 128 + m * 16;
#pragma unroll
                for (int bj = 0; bj < 2; ++bj) {
                    const int col = col0 + bj * 128;
                    f32x4 v0 = acc[ai][bj][m][0], v1 = acc[ai][bj][m][1];
                    float o[8] = {v0[0], v0[1], v0[2], v0[3], v1[0], v1[1], v1[2], v1[3]};
                    if (type == 1) {
#pragma unroll
                        for (int e = 0; e < 8; ++e) o[e] = o[e] * sigmoidf_(o[e]);
                    } else if (type == 2) {
#pragma unroll
                        for (int e = 0; e < 8; ++e) o[e] = sigmoidf_(o[e]);
                    } else if (type == 3) {
                        const int t = row & 4095, pos = (wc & 1) ? (t & 63) : (t >> 6), f0 = 8 * (fq & 1);
                        const float4 c0 = *(const float4*)(rope + pos * 16 + f0), c1 = *(const float4*)(rope + pos * 16 + f0 + 4);
                        const float4 s0 = *(const float4*)(rope + 1024 + pos * 16 + f0), s1 = *(const float4*)(rope + 1024 + pos * 16 + f0 + 4);
                        const float cs[8] = {c0.x, c0.y, c0.z, c0.w, c1.x, c1.y, c1.z, c1.w}, sn[8] = {s0.x, s0.y, s0.z, s0.w, s1.x, s1.y, s1.z, s1.w};
                        const float sgn = (fq >> 1) ? 1.f : -1.f;
                        float r[8];
#pragma unroll
                        for (int e = 0; e < 8; ++e) { const float pr = shx(o[e], 32); r[e] = o[e] * cs[e] + sgn * pr * sn[e]; }
                        if (blk == 0) {
                            uint4 w; w.x = pack2(r[0], r[1]); w.y = pack2(r[2], r[3]); w.z = pack2(r[4], r[5]); w.w = pack2(r[6], r[7]);
                            *(uint4*)(qrot + (size_t)row * 512 + col) = w;
                        } else {
#pragma unroll
                            for (int e = 0; e < 8; ++e) o[e] = r[e];
                        }
                    } else if (type == 5) {
                        const int dir = blk - 11, cc = col - blk * 512;
                        const float4 l0 = *(const float4*)(lb + dir * 512 + cc), l1 = *(const float4*)(lb + dir * 512 + cc + 4);
                        const float lbv[8] = {l0.x, l0.y, l0.z, l0.w, l1.x, l1.y, l1.z, l1.w};
                        float lf[8];
#pragma unroll
                        for (int e = 0; e < 8; ++e) {
                            const float z = o[e], sg = 1.f / (1.f + __expf(-z)), sgn_ = 1.f / (1.f + __expf(z));
                            const float f = lbv[e] + (1.f - lbv[e]) * sg;
                            lf[e] = __logf(fmaxf(f, 1e-30f));
                            o[e] = (1.f - lbv[e]) * sgn_;
                        }
                        float* lp = logf + (size_t)row * 1024 + dir * 512 + cc;
                        *(float4*)lp = make_float4(lf[0], lf[1], lf[2], lf[3]); *(float4*)(lp + 4) = make_float4(lf[4], lf[5], lf[6], lf[7]);
                    }
                    uint4 w; w.x = pack2(o[0], o[1]); w.y = pack2(o[2], o[3]); w.z = pack2(o[4], o[5]); w.w = pack2(o[6], o[7]);
                    *(uint4*)(proj + (size_t)row * NPROJ + col) = w;
                    if (is_ctx && (blk == 1 || blk == 2)) *(uint4*)(ctxkv + (size_t)row * 1024 + (col - 512)) = w;
                }
            }
    }
};
template <int R> struct EpiMerge {
    static constexpr bool PERM = false, AFTER_DRAIN = false;
    unsigned char* ws;
    __device__ __forceinline__ void operator()(const f32x4 (&acc)[2][2][4][2], const Unit& u, int wr, int wc, int fr, int fq) const {
        const u16* proj = (const u16*)(ws + OFF_PROJ); float* merged = (float*)(ws + OFF_MERGED); u16* mb = (u16*)(ws + OFF_MB);
        const int row0 = u.pm * 256 + wr * 64 + fr, col0 = u.pn * 256 + wc * 32 + 4 * fq;
#pragma unroll
        for (int ai = 0; ai < 2; ++ai)
#pragma unroll
            for (int m = 0; m < 4; ++m) {
                const int row = row0 + ai * 128 + m * 16;
#pragma unroll
                for (int bj = 0; bj < 2; ++bj)
#pragma unroll
                    for (int n = 0; n < 2; ++n) {
                        const int col = col0 + bj * 128 + n * 16;
                        const uint2 g = *(const uint2*)(proj + (size_t)row * NPROJ + 7680 + R * 1024 + col);
                        f32x4 v = acc[ai][bj][m][n];
                        v[0] *= bflo(g.x); v[1] *= bfhi(g.x); v[2] *= bflo(g.y); v[3] *= bfhi(g.y);
                        float* mp = merged + (size_t)row * 1024 + col;
                        if (R > 0) { const f32x4 old = *(const f32x4*)mp; v += old; }
                        if (R < 3) *(f32x4*)mp = v;
                        else { uint2 w; w.x = pack2(v[0], v[1]); w.y = pack2(v[2], v[3]); *(uint2*)(mb + (size_t)row * 1024 + col) = w; }
                    }
            }
    }
};
struct EpiOut {
    static constexpr bool PERM = false, AFTER_DRAIN = false;
    float* C;
    __device__ __forceinline__ void operator()(const f32x4 (&acc)[2][2][4][2], const Unit& u, int wr, int wc, int fr, int fq) const {
        const int row0 = u.pm * 256 + wr * 64 + fr, col0 = u.pn * 256 + wc * 32 + 4 * fq;
#pragma unroll
        for (int ai = 0; ai < 2; ++ai)
#pragma unroll
            for (int m = 0; m < 4; ++m) { float* rowp = C + (size_t)(row0 + ai * 128 + m * 16) * 1024 + col0;
#pragma unroll
                for (int bj = 0; bj < 2; ++bj)
#pragma unroll
                    for (int n = 0; n < 2; ++n) *(f32x4*)(rowp + bj * 128 + n * 16) = acc[ai][bj][m][n]; }
    }
};

__device__ void transpose_tile(const float* src, int lds_, u16* dst, int ldd, int k0, int n0s, int n0d, u16* t) {
    const int tid = tidx();
#pragma unroll
    for (int it = 0; it < 2; ++it) {
        const int kk = (tid >> 4) + it * 32, nn = (tid & 15) * 4;
        const float4 v = *(const float4*)(src + (size_t)(k0 + kk) * lds_ + n0s + nn);
        t[(nn + 0) * 72 + kk] = f2bf(v.x); t[(nn + 1) * 72 + kk] = f2bf(v.y); t[(nn + 2) * 72 + kk] = f2bf(v.z); t[(nn + 3) * 72 + kk] = f2bf(v.w);
    }
    __syncthreads();
    { const int n = tid >> 3, k8 = (tid & 7) * 8;
      const uint4 v = *(const uint4*)(t + n * 72 + k8);
      *(uint4*)(dst + (size_t)(n0d + n) * ldd + k0 + k8) = v; }
    __syncthreads();
}

__device__ void prep1(const Params& p, unsigned char* lds) {
    unsigned char* ws = opaque(p.ws);
    const int tid = tidx();
    const size_t gt = (size_t)blockIdx.x * 512 + tid, gn = (size_t)gridDim.x * 512;
    { u16* ws16 = (u16*)(ws + OFF_WS16);
      for (size_t i = gt; i < (size_t)DEPTH * 8 * 128 * 128; i += gn) ws16[i] = f2bf(p.gmlp_ws[i]);
      float* lbp = (float*)(ws + OFF_LB);
      for (size_t i = gt; i < 1024; i += gn) {
          float e[DEPTH], mx = -1e30f, sum = 0.f;
#pragma unroll
          for (int l = 0; l < DEPTH; ++l) { e[l] = p.lb_logits[l * 1024 + i]; mx = fmaxf(mx, e[l]); }
#pragma unroll
          for (int l = 0; l < DEPTH; ++l) { e[l] = expf(e[l] - mx); sum += e[l]; }
          float run = 0.f;
#pragma unroll
          for (int l = 0; l < DEPTH; ++l) { if (l > 0) run += e[l] / sum; lbp[l * 1024 + i] = fmaxf(run, 0.f); }
      }
      float* rope = (float*)(ws + OFF_ROPE);
      for (size_t i = gt; i < 1024; i += gn) { const int pos = (int)(i >> 4), f = (int)(i & 15);
          const float inv = powf(10000.f, -(float)f * 2.0f / 32.0f), ang = (float)pos * inv;
          rope[i] = cosf(ang); rope[1024 + i] = sinf(ang); }
      float* tw = (float*)(ws + OFF_TW);
      for (size_t i = gt; i < 4096; i += gn) { float s, c; sincospif((float)i * (2.0f / 4096.0f), &s, &c); tw[2 * i] = c; tw[2 * i + 1] = s; }
      u16* m1 = (u16*)(ws + OFF_M1);
      for (size_t i = gt; i < 128 * 128; i += gn) { const int ii = (int)(i >> 7), kk = (int)(i & 127), k1 = ii >> 1, po = ii & 1, n1 = kk >> 1, pi = kk & 1;
          float s, c; sincospif((float)((k1 * n1) & 63) * (2.0f / 64.0f), &s, &c);
          const float v = (po == 0) ? (pi == 0 ? c : -s) : (pi == 0 ? -s : -c);
          m1[i] = f2bf(v); }
      u16* m2 = (u16*)(ws + OFF_M2);
      for (size_t i = gt; i < 64 * 128; i += gn) { const int k2 = (int)(i >> 7), kk = (int)(i & 127), n2 = kk >> 1, pi = kk & 1;
          float s, c; sincospif((float)((k2 * n2) & 63) * (2.0f / 64.0f), &s, &c);
          m2[i] = f2bf(pi == 0 ? c : s); }
      u16* m3 = (u16*)(ws + OFF_M3);
      for (size_t i = gt; i < 256 * 512; i += gn) { const int k = (int)(i >> 9), kk = (int)(i & 511), n = kk >> 1, pi = kk & 1;
          float s, c; sincospif((float)((k * n) & 255) * (2.0f / 256.0f), &s, &c);
          m3[i] = f2bf(pi == 0 ? c : -s); }
    }
    constexpr int N_WIN = DEPTH * 176 * 16, N_WBR = 16 * 16 * 8, N_WOUT = DEPTH * 16 * 16, N_MOD = DEPTH * 48, N_CSW = DEPTH * 4 * 2 * 2;
    constexpr int TOT = N_WIN + N_WBR + N_WOUT + N_MOD + N_CSW;
    for (int it = blockIdx.x; it < TOT; it += gridDim.x) {
        int idx = it;
        if (idx < N_WIN) {
            const int l = idx / 2816, rem = idx % 2816, cb = rem >> 4, kb = rem & 15, n0 = cb * 64;
            if (n0 >= 2048 && n0 < 2560) continue;
            const int n0d = n0 < 2048 ? n0 : n0 + 512;
            transpose_tile(p.w_in + (size_t)l * DM * NIN, NIN, (u16*)(ws + OFF_WTIN) + (size_t)l * NPROJ * DM, DM, kb * 64, n0, n0d, (u16*)lds);
            continue;
        }
        idx -= N_WIN;
        if (idx < N_WBR) {
            const int mat = idx >> 7, rem = idx & 127, cb = rem >> 3, kb = rem & 7;
            transpose_tile(p.w_branch + (size_t)mat * 512 * 1024, 1024, (u16*)(ws + OFF_WTBR) + (size_t)mat * 1024 * 512, 512, kb * 64, cb * 64, cb * 64, (u16*)lds);
            continue;
        }
        idx -= N_WBR;
        if (idx < N_WOUT) {
            const int l = idx >> 8, rem = idx & 255, cb = rem >> 4, kb = rem & 15;
            transpose_tile(p.w_out + (size_t)l * 1024 * 1024, 1024, (u16*)(ws + OFF_WTOUT) + (size_t)l * 1024 * 1024, 1024, kb * 64, cb * 64, cb * 64, (u16*)lds);
            continue;
        }
        idx -= N_WOUT;
        if (idx < N_MOD) {
            const int l = idx / 48, cb = idx % 48;
            float* s = (float*)lds; float* red = s + 17 * 1024;
            for (int i = tid; i < 17 * 1024; i += 512) { const int j = i >> 10, k = i & 1023; const float v = j < 16 ? p.c[j * 1024 + k] : p.c_ctx[k]; s[i] = v / (1.f + expf(-v)); }
            __syncthreads();
            const int col = tid & 63, ks = tid >> 6;
            float acc[17];
#pragma unroll
            for (int j = 0; j < 17; ++j) acc[j] = 0.f;
            for (int k = ks * 128; k < ks * 128 + 128; ++k) {
                const float w = p.w_ada[((size_t)l * 1024 + k) * 3072 + cb * 64 + col];
#pragma unroll
                for (int j = 0; j < 17; ++j) acc[j] += s[j * 1024 + k] * w;
            }
#pragma unroll
            for (int j = 0; j < 17; ++j) red[(ks * 17 + j) * 64 + col] = acc[j];
            __syncthreads();
            for (int o = tid; o < 17 * 64; o += 512) { const int j = o >> 6, cc = o & 63; float sum = 0.f;
                for (int q = 0; q < 8; ++q) sum += red[(q * 17 + j) * 64 + cc];
                ((float*)(ws + OFF_MOD))[((size_t)l * 17 + j) * 3072 + cb * 64 + cc] = sum + p.b_ada[l * 3072 + cb * 64 + cc]; }
            __syncthreads();
            continue;
        }
        idx -= N_MOD;
        {
            const int cblk = idx & 1, part = (idx >> 1) & 1, g = (idx >> 2) & 3, l = idx >> 4;
            float* tb = (float*)lds;
            if (tid < 128) { float s, c; sincospif((float)tid * (2.0f / 128.0f), &s, &c); tb[tid] = part ? s : c; }
            __syncthreads();
            const int d = tid & 127, cq = tid >> 7;
            float acc[16];
#pragma unroll
            for (int i = 0; i < 16; ++i) acc[i] = 0.f;
            const float* wf = p.fnet_w + ((size_t)(l * 4 + g) * 128) * 128;
            for (int c2 = 0; c2 < 128; ++c2) {
                const float w = wf[c2 * 128 + d];
#pragma unroll
                for (int i = 0; i < 16; ++i) { const int c = cblk * 64 + cq * 16 + i; acc[i] += tb[(c * c2) & 127] * w; }
            }
            float* dst = (float*)(ws + OFF_CSW) + ((size_t)((l * 4 + g) * 2 + part) * 128) * 128;
#pragma unroll
            for (int i = 0; i < 16; ++i) dst[(cblk * 64 + cq * 16 + i) * 128 + d] = acc[i];
            __syncthreads();
        }
    }
}

__device__ void prep2(const Params& p, unsigned char* lds) {
    unsigned char* ws = opaque(p.ws);
    const int tid = tidx();
    float* wb = (float*)lds;
    float* cw = wb + 64 * 129;
    for (int it = blockIdx.x; it < DEPTH * 4 * 2 * 16; it += gridDim.x) {
        const int kb = it & 15, part = (it >> 4) & 1, g = (it >> 5) & 3, l = it >> 7;
        for (int i = tid; i < 64 * 128; i += 512) { const int kk = i >> 7, c = i & 127; wb[kk * 129 + c] = p.w_in[((size_t)l * 1024 + kb * 64 + kk) * NIN + 2048 + g * 128 + c]; }
        const float* src = (const float*)(ws + OFF_CSW) + ((size_t)((l * 4 + g) * 2 + part) * 128) * 128;
        for (int i = tid; i < 128 * 128; i += 512) cw[i] = src[i];
        __syncthreads();
        const int d = tid & 127, kq = tid >> 7;
        float acc[16];
#pragma unroll
        for (int i = 0; i < 16; ++i) acc[i] = 0.f;
        for (int c = 0; c < 128; ++c) {
            const float w = cw[c * 128 + d];
#pragma unroll
            for (int i = 0; i < 16; ++i) acc[i] += wb[(kq * 16 + i) * 129 + c] * w;
        }
        u16* dst = (u16*)(ws + OFF_WTIN) + ((size_t)l * NPROJ + (4 + part) * 512 + g * 128 + d) * DM + kb * 64 + kq * 16;
        uint4 w0, w1;
        w0.x = pack2(acc[0], acc[1]); w0.y = pack2(acc[2], acc[3]); w0.z = pack2(acc[4], acc[5]); w0.w = pack2(acc[6], acc[7]);
        w1.x = pack2(acc[8], acc[9]); w1.y = pack2(acc[10], acc[11]); w1.z = pack2(acc[12], acc[13]); w1.w = pack2(acc[14], acc[15]);
        *(uint4*)dst = w0; *(uint4*)(dst + 8) = w1;
        __syncthreads();
    }
}

__device__ void phase_norm(const Params& p, const PassInfo ps, int l) {
    unsigned char* ws = opaque(p.ws);
    const int wave = tidx() >> 6, lane = tidx() & 63;
    const float* mod = (const float*)(ws + OFF_MOD);
    const float* OUT = (const float*)(ws + OFF_OUT);
    u16* H = (u16*)(ws + OFF_H);
    for (int rr = blockIdx.x * 8 + wave; rr < ps.M; rr += gridDim.x * 8) {
        const int tsh = ps.is_ctx ? 8 : 12; const int b = ps.b0 + (rr >> tsh), t = rr & (ps.T - 1), mrow = ps.is_ctx ? 16 : b;
        const size_t xoff = ((size_t)b * ps.T + t) * 1024;
        const float* xin = (l <= 1) ? ((ps.is_ctx ? p.ctx : p.x) + xoff) : ((ps.is_ctx ? (const float*)(ws + OFF_CTXW) : (const float*)p.out) + xoff);
        float* xout = (ps.is_ctx ? (float*)(ws + OFF_CTXW) : p.out) + xoff;
        float xv[16];
#pragma unroll
        for (int hlf = 0; hlf < 2; ++hlf) {
            const int c0 = hlf * 512 + lane * 8;
            const float4 a = *(const float4*)(xin + c0), bq = *(const float4*)(xin + c0 + 4);
            xv[hlf * 8 + 0] = a.x; xv[hlf * 8 + 1] = a.y; xv[hlf * 8 + 2] = a.z; xv[hlf * 8 + 3] = a.w;
            xv[hlf * 8 + 4] = bq.x; xv[hlf * 8 + 5] = bq.y; xv[hlf * 8 + 6] = bq.z; xv[hlf * 8 + 7] = bq.w;
        }
        if (l > 0) {
            float ov[16]; float ss = 0.f;
#pragma unroll
            for (int hlf = 0; hlf < 2; ++hlf) {
                const int c0 = hlf * 512 + lane * 8;
                const float4 a = *(const float4*)(OUT + (size_t)rr * 1024 + c0), bq = *(const float4*)(OUT + (size_t)rr * 1024 + c0 + 4);
                ov[hlf * 8 + 0] = a.x; ov[hlf * 8 + 1] = a.y; ov[hlf * 8 + 2] = a.z; ov[hlf * 8 + 3] = a.w;
                ov[hlf * 8 + 4] = bq.x; ov[hlf * 8 + 5] = bq.y; ov[hlf * 8 + 6] = bq.z; ov[hlf * 8 + 7] = bq.w;
            }
#pragma unroll
            for (int e = 0; e < 16; ++e) ss += ov[e] * ov[e];
#pragma unroll
            for (int o = 32; o > 0; o >>= 1) ss += shx(ss, o);
            const float rstd = rsqrtf(ss * (1.f / 1024.f) + EPSN);
            const float* gt = mod + ((size_t)(l - 1) * 17 + mrow) * 3072 + 2048;
            const float* gp = p.g_post + (l - 1) * 1024;
#pragma unroll
            for (int hlf = 0; hlf < 2; ++hlf) {
                const int c0 = hlf * 512 + lane * 8;
#pragma unroll
                for (int e = 0; e < 8; ++e) xv[hlf * 8 + e] += gt[c0 + e] * (ov[hlf * 8 + e] * rstd * gp[c0 + e]);
                *(float4*)(xout + c0) = make_float4(xv[hlf * 8 + 0], xv[hlf * 8 + 1], xv[hlf * 8 + 2], xv[hlf * 8 + 3]);
                *(float4*)(xout + c0 + 4) = make_float4(xv[hlf * 8 + 4], xv[hlf * 8 + 5], xv[hlf * 8 + 6], xv[hlf * 8 + 7]);
            }
        }
        if (l < DEPTH) {
            float ss = 0.f;
#pragma unroll
            for (int e = 0; e < 16; ++e) ss += xv[e] * xv[e];
#pragma unroll
            for (int o = 32; o > 0; o >>= 1) ss += shx(ss, o);
            const float rstd = rsqrtf(ss * (1.f / 1024.f) + EPSN);
            const float* sh = mod + ((size_t)l * 17 + mrow) * 3072; const float* sc = sh + 1024;
            const float* gp = p.g_pre + l * 1024;
#pragma unroll
            for (int hlf = 0; hlf < 2; ++hlf) {
                const int c0 = hlf * 512 + lane * 8;
                float hv[8];
#pragma unroll
                for (int e = 0; e < 8; ++e) hv[e] = xv[hlf * 8 + e] * rstd * gp[c0 + e] * (1.f + sc[c0 + e]) + sh[c0 + e];
                uint4 w; w.x = pack2(hv[0], hv[1]); w.y = pack2(hv[2], hv[3]); w.z = pack2(hv[4], hv[5]); w.w = pack2(hv[6], hv[7]);
                *(uint4*)(H + (size_t)rr * 1024 + c0) = w;
            }
        }
    }
}

constexpr int KVS = 72;
constexpr int TS = 528;
constexpr int T3S = 136;
constexpr int HS_ = 68;
constexpr float NORM_LAT = 0.0013810679320049757f;
constexpr float NORM_CTX = 0.005524271728019903f;

__device__ void attn_item(const Params& p, const PassInfo ps, int l, int item, unsigned char* lds) {
    unsigned char* ws = opaque(p.ws);
    const u16* PROJ = (const u16*)(ws + OFF_PROJ); const u16* QROT = (const u16*)(ws + OFF_QROT);
    const u16* CKV = (const u16*)(ws + OFF_CTXKV) + (size_t)l * MCTX * 1024;
    u16* Y0 = (u16*)(ws + OFF_Y);
    const int tid = tidx(), w = tid >> 6, lane = tid & 63, qtr = w & 3, kh = w >> 2, li = lane & 15, quad = lane >> 4;
    u16* Kl = (u16*)lds; u16* Vl = Kl + 512 * KVS; float* rp = (float*)(Vl + 512 * KVS);
    int bl, h, r = 0, qrow0, bglob;
    if (!ps.is_ctx) { r = item & 63; h = (item >> 6) & 7; bl = item >> 9; qrow0 = bl * 4096 + r * 64; bglob = ps.b0 + bl; }
    else { const int qb = item & 3; h = (item >> 2) & 7; bl = item >> 5; qrow0 = bl * 256 + qb * 64; bglob = bl; }
    const int qrow = qrow0 + qtr * 16 + li;
    float m_run = -1e30f, l_run = 0.f;
    f32x4 O[4];
#pragma unroll
    for (int d = 0; d < 4; ++d) O[d] = (f32x4){0.f, 0.f, 0.f, 0.f};
    if (!ps.is_ctx) {
        const int rs = min(max(r - 4, 0), 56);
        const size_t krow0 = (size_t)bl * 4096 + rs * 64;
#pragma unroll
        for (int i = 0; i < 8; ++i) { const int idx = tid + 512 * i, key = idx >> 3, ch = idx & 7;
            const uint4 kv = *(const uint4*)(PROJ + (krow0 + key) * NPROJ + 512 + h * 64 + ch * 8);
            const uint4 vv = *(const uint4*)(PROJ + (krow0 + key) * NPROJ + 1024 + h * 64 + ch * 8);
            *(uint4*)(Kl + key * KVS + ch * 8) = kv; *(uint4*)(Vl + key * KVS + ch * 8) = vv; }
        for (int i = tid; i < 465; i += 512) rp[i] = p.rpb[((size_t)l * 8 + h) * 465 + i];
        __syncthreads();
        const int cbase = (qtr == 0) ? 0 : (qtr == 1 ? 8 : (qtr == 2 ? 24 : 32));
        const bf16x8 q0 = ld_frag_g(QROT + (size_t)qrow * 512 + h * 64 + quad * 8), q1 = ld_frag_g(QROT + (size_t)qrow * 512 + h * 64 + 32 + quad * 8);
        const int qc = qtr * 16 + li, cst = min(max(qc - 8, 0), 48);
        float s[8][4];
        float mx = -1e30f;
#pragma unroll
        for (int sb = 0; sb < 8; ++sb) {
            const int i = kh * 4 + (sb >> 1), cs = sb & 1;
            const u16* kp = Kl + (i * 64 + cbase + cs * 16 + li) * KVS + quad * 8;
            f32x4 a = (f32x4){0.f, 0.f, 0.f, 0.f};
            a = MFMA16(*(const bf16x8*)kp, q0, a); a = MFMA16(*(const bf16x8*)(kp + 32), q1, a);
            const int ridx = rs + i - r + 7;
#pragma unroll
            for (int j = 0; j < 4; ++j) { const int kc = cbase + cs * 16 + quad * 4 + j;
                const bool valid = (kc >= cst) && (kc < cst + 16);
                const int cidx = min(max(kc - qc + 15, 0), 30);
                const float v = valid ? (a[j] * 0.125f + rp[ridx * 31 + cidx]) : -1e30f;
                s[sb][j] = v; mx = fmaxf(mx, v); }
        }
        mx = fmaxf(mx, shx(mx, 16)); mx = fmaxf(mx, shx(mx, 32));
        m_run = mx;
        float ls = 0.f;
#pragma unroll
        for (int sb = 0; sb < 8; ++sb)
#pragma unroll
            for (int j = 0; j < 4; ++j) { const float e = __expf(s[sb][j] - mx); s[sb][j] = e; ls += e; }
        ls += shx(ls, 16); ls += shx(ls, 32);
        l_run = ls;
#pragma unroll
        for (int kp2 = 0; kp2 < 4; ++kp2) {
            bf16x8 pf; { const unsigned a0 = pack2(s[2 * kp2][0], s[2 * kp2][1]), a1 = pack2(s[2 * kp2][2], s[2 * kp2][3]), b0 = pack2(s[2 * kp2 + 1][0], s[2 * kp2 + 1][1]), b1 = pack2(s[2 * kp2 + 1][2], s[2 * kp2 + 1][3]);
                pf = (bf16x8){(short)(a0 & 0xffff), (short)(a0 >> 16), (short)(a1 & 0xffff), (short)(a1 >> 16), (short)(b0 & 0xffff), (short)(b0 >> 16), (short)(b1 & 0xffff), (short)(b1 >> 16)}; }
            const int vrow0 = (kh * 4 + kp2) * 64 + cbase + quad * 4 + (li >> 2);
#pragma unroll
            for (int d = 0; d < 4; ++d) {
                const u16* vp = Vl + vrow0 * KVS + d * 16 + 4 * (li & 3);
                const bf16x8 vf = tr_read2(vp, vp + 16 * KVS);
                O[d] = MFMA16(vf, pf, O[d]);
            }
        }
        __syncthreads();
    }
    {
        const size_t crow0 = (size_t)bglob * 256;
#pragma unroll
        for (int i = 0; i < 4; ++i) { const int idx = tid + 512 * i, key = idx >> 3, ch = idx & 7;
            const uint4 kv = *(const uint4*)(CKV + (crow0 + key) * 1024 + h * 64 + ch * 8);
            const uint4 vv = *(const uint4*)(CKV + (crow0 + key) * 1024 + 512 + h * 64 + ch * 8);
            *(uint4*)(Kl + key * KVS + ch * 8) = kv; *(uint4*)(Vl + key * KVS + ch * 8) = vv; }
        __syncthreads();
        const bf16x8 q0 = ld_frag_g(PROJ + (size_t)qrow * NPROJ + h * 64 + quad * 8), q1 = ld_frag_g(PROJ + (size_t)qrow * NPROJ + h * 64 + 32 + quad * 8);
        float s[8][4];
        float mx = -1e30f;
#pragma unroll
        for (int sb = 0; sb < 8; ++sb) {
            const u16* kp = Kl + (kh * 128 + sb * 16 + li) * KVS + quad * 8;
            f32x4 a = (f32x4){0.f, 0.f, 0.f, 0.f};
            a = MFMA16(*(const bf16x8*)kp, q0, a); a = MFMA16(*(const bf16x8*)(kp + 32), q1, a);
#pragma unroll
            for (int j = 0; j < 4; ++j) { const float v = a[j] * 0.125f; s[sb][j] = v; mx = fmaxf(mx, v); }
        }
        mx = fmaxf(mx, shx(mx, 16)); mx = fmaxf(mx, shx(mx, 32));
        const float m_new = fmaxf(m_run, mx), resc = __expf(m_run - m_new);
        float ls = 0.f;
#pragma unroll
        for (int sb = 0; sb < 8; ++sb)
#pragma unroll
            for (int j = 0; j < 4; ++j) { const float e = __expf(s[sb][j] - m_new); s[sb][j] = e; ls += e; }
        ls += shx(ls, 16); ls += shx(ls, 32);
        l_run = l_run * resc + ls; m_run = m_new;
#pragma unroll
        for (int d = 0; d < 4; ++d) O[d] *= resc;
#pragma unroll
        for (int kp2 = 0; kp2 < 4; ++kp2) {
            bf16x8 pf; { const unsigned a0 = pack2(s[2 * kp2][0], s[2 * kp2][1]), a1 = pack2(s[2 * kp2][2], s[2 * kp2][3]), b0 = pack2(s[2 * kp2 + 1][0], s[2 * kp2 + 1][1]), b1 = pack2(s[2 * kp2 + 1][2], s[2 * kp2 + 1][3]);
                pf = (bf16x8){(short)(a0 & 0xffff), (short)(a0 >> 16), (short)(a1 & 0xffff), (short)(a1 >> 16), (short)(b0 & 0xffff), (short)(b0 >> 16), (short)(b1 & 0xffff), (short)(b1 >> 16)}; }
            const int vrow0 = kh * 128 + kp2 * 32 + quad * 4 + (li >> 2);
#pragma unroll
            for (int d = 0; d < 4; ++d) {
                const u16* vp = Vl + vrow0 * KVS + d * 16 + 4 * (li & 3);
                const bf16x8 vf = tr_read2(vp, vp + 16 * KVS);
                O[d] = MFMA16(vf, pf, O[d]);
            }
        }
        __syncthreads();
    }
    float* cb = (float*)lds;
    if (kh == 1) {
#pragma unroll
        for (int d = 0; d < 4; ++d)
#pragma unroll
            for (int j = 0; j < 4; ++j) cb[(qtr * 18 + d * 4 + j) * 64 + lane] = O[d][j];
        cb[(qtr * 18 + 16) * 64 + lane] = m_run; cb[(qtr * 18 + 17) * 64 + lane] = l_run;
    }
    __syncthreads();
    if (kh == 0) {
        const float m2 = cb[(qtr * 18 + 16) * 64 + lane], l2 = cb[(qtr * 18 + 17) * 64 + lane];
        const float mm = fmaxf(m_run, m2), e1 = __expf(m_run - mm), e2 = __expf(m2 - mm);
        const float inv = 1.f / (l_run * e1 + l2 * e2);
#pragma unroll
        for (int d = 0; d < 4; ++d) {
            const int col = h * 64 + d * 16 + quad * 4;
            const uint2 g = *(const uint2*)(PROJ + (size_t)qrow * NPROJ + 3 * 512 + col);
            float o[4];
#pragma unroll
            for (int j = 0; j < 4; ++j) o[j] = (O[d][j] * e1 + cb[(qtr * 18 + d * 4 + j) * 64 + lane] * e2) * inv;
            uint2 wv; wv.x = pack2(o[0] * bflo(g.x), o[1] * bfhi(g.x)); wv.y = pack2(o[2] * bflo(g.y), o[3] * bfhi(g.y));
            *(uint2*)(Y0 + (size_t)qrow * 512 + col) = wv;
        }
    }
    __syncthreads();
}

__device__ __forceinline__ void load_tile(u16* dstl, int lstride, const u16* src, size_t sstride, int rows, int chunks_per_row) {
    const int total = rows * chunks_per_row;
    for (int i = tidx(); i < total; i += 512) { const int r = i / chunks_per_row, ch = i - r * chunks_per_row;
        *(uint4*)(dstl + r * lstride + ch * 8) = *(const uint4*)(src + (size_t)r * sstride + ch * 8); }
}

__device__ void four1_item(const Params& p, int item, unsigned char* lds) {
    unsigned char* ws = opaque(p.ws);
    const u16* PROJ = (const u16*)(ws + OFF_PROJ); const u16* M1 = (const u16*)(ws + OFF_M1); const float* TW = (const float*)(ws + OFF_TW);
    u16* FY = (u16*)(ws + OFF_FY);
    const int tid = tidx(), w = tid >> 6, lane = tid & 63, li = lane & 15, quad = lane >> 4;
    const int n2 = item & 63, bl = item >> 6;
    u16* T = (u16*)lds;
    for (int i = tid; i < 128 * 64; i += 512) { const int kk = i >> 6, ch = i & 63, n1 = kk >> 1, part = kk & 1;
        *(uint4*)(T + kk * TS + ch * 8) = *(const uint4*)(PROJ + ((size_t)bl * 4096 + n1 * 64 + n2) * NPROJ + (4 + part) * 512 + ch * 8); }
    __syncthreads();
    for (int isub = 0; isub < 8; ++isub) {
        bf16x8 xf[4];
#pragma unroll
        for (int ks = 0; ks < 4; ++ks) xf[ks] = ld_frag_g(M1 + (isub * 16 + li) * 128 + ks * 32 + quad * 8);
#pragma unroll
        for (int cs = 0; cs < 4; ++cs) {
            const int c0 = w * 64 + cs * 16;
            f32x4 a = (f32x4){0.f, 0.f, 0.f, 0.f};
#pragma unroll
            for (int ks = 0; ks < 4; ++ks) {
                const u16* tp = T + (ks * 32 + quad * 8 + (li >> 2)) * TS + c0 + 4 * (li & 3);
                a = MFMA16(xf[ks], tr_read2(tp, tp + 4 * TS), a);
            }
            const int ch = c0 + li;
#pragma unroll
            for (int hh = 0; hh < 2; ++hh) {
                const int k1 = isub * 8 + quad * 2 + hh;
                const float yr = a[2 * hh], yi = a[2 * hh + 1];
                const float tc = TW[2 * (n2 * k1)], tsn = TW[2 * (n2 * k1) + 1];
                const float orr = yr * tc + yi * tsn, oi = yi * tc - yr * tsn;
                u16* dst = FY + (((size_t)bl * 64 + k1) * 64 + n2) * 1024 + ch;
                dst[0] = f2bf(orr); dst[512] = f2bf(oi);
            }
        }
    }
    __syncthreads();
}

__device__ void four2_item(const Params& p, int item, unsigned char* lds) {
    unsigned char* ws = opaque(p.ws);
    const u16* PROJ = (const u16*)(ws + OFF_PROJ); const u16* M2 = (const u16*)(ws + OFF_M2); const u16* FY = (const u16*)(ws + OFF_FY);
    u16* Y1 = (u16*)(ws + OFF_Y) + (size_t)1 * MLAT * 512;
    const int tid = tidx(), w = tid >> 6, lane = tid & 63, li = lane & 15, quad = lane >> 4;
    const int k1 = item & 63, bl = item >> 6;
    u16* T = (u16*)lds;
    load_tile(T, TS, FY + ((size_t)bl * 64 + k1) * 64 * 1024, 512, 128, 64);
    __syncthreads();
    bf16x8 xf[4][4];
#pragma unroll
    for (int cs = 0; cs < 4; ++cs)
#pragma unroll
        for (int ks = 0; ks < 4; ++ks) { const u16* tp = T + (ks * 32 + quad * 8 + (li >> 2)) * TS + w * 64 + cs * 16 + 4 * (li & 3); xf[cs][ks] = tr_read2(tp, tp + 4 * TS); }
    for (int k2s = 0; k2s < 4; ++k2s) {
        bf16x8 yf[4];
#pragma unroll
        for (int ks = 0; ks < 4; ++ks) yf[ks] = ld_frag_g(M2 + (k2s * 16 + li) * 128 + ks * 32 + quad * 8);
        const int k2 = k2s * 16 + li;
        const size_t row = (size_t)bl * 4096 + k1 + 64 * k2;
#pragma unroll
        for (int cs = 0; cs < 4; ++cs) {
            f32x4 a = (f32x4){0.f, 0.f, 0.f, 0.f};
#pragma unroll
            for (int ks = 0; ks < 4; ++ks) a = MFMA16(xf[cs][ks], yf[ks], a);
            const int ch = w * 64 + cs * 16 + quad * 4;
            const uint2 g = *(const uint2*)(PROJ + row * NPROJ + 6 * 512 + ch);
            uint2 wv; wv.x = pack2(a[0] * NORM_LAT * bflo(g.x), a[1] * NORM_LAT * bfhi(g.x)); wv.y = pack2(a[2] * NORM_LAT * bflo(g.y), a[3] * NORM_LAT * bfhi(g.y));
            *(uint2*)(Y1 + row * 512 + ch) = wv;
        }
    }
    __syncthreads();
}

__device__ void fourc_item(const Params& p, int item, unsigned char* lds) {
    unsigned char* ws = opaque(p.ws);
    const u16* PROJ = (const u16*)(ws + OFF_PROJ); const u16* M3 = (const u16*)(ws + OFF_M3);
    u16* Y1 = (u16*)(ws + OFF_Y) + (size_t)1 * MLAT * 512;
    const int tid = tidx(), w = tid >> 6, lane = tid & 63, li = lane & 15, quad = lane >> 4;
    const int chb = item & 3, b = item >> 2;
    u16* T = (u16*)lds;
    for (int i = tid; i < 512 * 16; i += 512) { const int kk = i >> 4, ch = i & 15, n = kk >> 1, part = kk & 1;
        *(uint4*)(T + kk * T3S + ch * 8) = *(const uint4*)(PROJ + ((size_t)b * 256 + n) * NPROJ + (4 + part) * 512 + chb * 128 + ch * 8); }
    __syncthreads();
    for (int kq = 0; kq < 2; ++kq) {
        const int ksub = w * 2 + kq;
        f32x4 a[8];
#pragma unroll
        for (int cs = 0; cs < 8; ++cs) a[cs] = (f32x4){0.f, 0.f, 0.f, 0.f};
        for (int ks = 0; ks < 16; ++ks) {
            const bf16x8 yf = ld_frag_g(M3 + (ksub * 16 + li) * 512 + ks * 32 + quad * 8);
#pragma unroll
            for (int cs = 0; cs < 8; ++cs) { const u16* tp = T + (ks * 32 + quad * 8 + (li >> 2)) * T3S + cs * 16 + 4 * (li & 3);
                a[cs] = MFMA16(tr_read2(tp, tp + 4 * T3S), yf, a[cs]); }
        }
        const size_t row = (size_t)b * 256 + ksub * 16 + li;
#pragma unroll
        for (int cs = 0; cs < 8; ++cs) {
            const int ch = chb * 128 + cs * 16 + quad * 4;
            const uint2 g = *(const uint2*)(PROJ + row * NPROJ + 6 * 512 + ch);
            uint2 wv; wv.x = pack2(a[cs][0] * NORM_CTX * bflo(g.x), a[cs][1] * NORM_CTX * bfhi(g.x)); wv.y = pack2(a[cs][2] * NORM_CTX * bflo(g.y), a[cs][3] * NORM_CTX * bfhi(g.y));
            *(uint2*)(Y1 + row * 512 + ch) = wv;
        }
    }
    __syncthreads();
}

__device__ void gmlp_item(const Params& p, int l, int item, unsigned char* lds) {
    unsigned char* ws = opaque(p.ws);
    const u16* PROJ = (const u16*)(ws + OFF_PROJ); const u16* WS16 = (const u16*)(ws + OFF_WS16) + (size_t)l * 8 * 128 * 128;
    u16* Y2 = (u16*)(ws + OFF_Y) + (size_t)2 * MLAT * 512;
    const int tid = tidx(), w = tid >> 6, lane = tid & 63, li = lane & 15, quad = lane >> 4;
    const size_t r0 = (size_t)item * 128;
    u16* VN = (u16*)lds;
    {
        const int row = tid >> 2, qd = tid & 3;
        const u16* src = PROJ + (r0 + row) * NPROJ + 8 * 512;
        uint4 raw[16]; float ss = 0.f;
#pragma unroll
        for (int i = 0; i < 16; ++i) { raw[i] = *(const uint4*)(src + (qd + 4 * i) * 8); float f[8]; unpack8(raw[i], f);
#pragma unroll
            for (int e = 0; e < 8; ++e) ss += f[e] * f[e]; }
        ss += shx(ss, 1); ss += shx(ss, 2);
        const float rstd = rsqrtf(ss * (1.f / 512.f) + EPSN);
        const float* gn = p.gmlp_g + l * 512;
#pragma unroll
        for (int i = 0; i < 16; ++i) { float f[8]; unpack8(raw[i], f); const int c0 = (qd + 4 * i) * 8;
            const float4 g0 = *(const float4*)(gn + c0), g1 = *(const float4*)(gn + c0 + 4);
            uint4 o; o.x = pack2(f[0] * rstd * g0.x, f[1] * rstd * g0.y); o.y = pack2(f[2] * rstd * g0.z, f[3] * rstd * g0.w);
            o.z = pack2(f[4] * rstd * g1.x, f[5] * rstd * g1.y); o.w = pack2(f[6] * rstd * g1.z, f[7] * rstd * g1.w);
            *(uint4*)(VN + row * TS + c0) = o; }
    }
    __syncthreads();
    const int g = w;
    bf16x8 xf[4][4];
#pragma unroll
    for (int cs = 0; cs < 4; ++cs)
#pragma unroll
        for (int ks = 0; ks < 4; ++ks) { const u16* tp = VN + (ks * 32 + quad * 8 + (li >> 2)) * TS + g * 64 + cs * 16 + 4 * (li & 3); xf[cs][ks] = tr_read2(tp, tp + 4 * TS); }
    for (int ts = 0; ts < 8; ++ts) {
        bf16x8 yf[4];
#pragma unroll
        for (int ks = 0; ks < 4; ++ks) yf[ks] = ld_frag_g(WS16 + ((size_t)g * 128 + ts * 16 + li) * 128 + ks * 32 + quad * 8);
        const int t = ts * 16 + li;
        const float bs = p.gmlp_bs[((size_t)l * 8 + g) * 128 + t];
        const size_t row = r0 + t;
#pragma unroll
        for (int cs = 0; cs < 4; ++cs) {
            f32x4 a = (f32x4){0.f, 0.f, 0.f, 0.f};
#pragma unroll
            for (int ks = 0; ks < 4; ++ks) a = MFMA16(xf[cs][ks], yf[ks], a);
            const int c = g * 64 + cs * 16 + quad * 4;
            const uint2 uu = *(const uint2*)(PROJ + row * NPROJ + 7 * 512 + c), gg = *(const uint2*)(PROJ + row * NPROJ + 9 * 512 + c);
            uint2 wv; wv.x = pack2(bflo(uu.x) * (a[0] + bs) * bflo(gg.x), bfhi(uu.x) * (a[1] + bs) * bfhi(gg.x));
            wv.y = pack2(bflo(uu.y) * (a[2] + bs) * bflo(gg.y), bfhi(uu.y) * (a[3] + bs) * bfhi(gg.y));
            *(uint2*)(Y2 + row * 512 + c) = wv;
        }
    }
    __syncthreads();
}

__device__ __forceinline__ void chunk_cumsum(float* A, float* tmp, int dir) {
    const int k = tidx() & 63, seg = tidx() >> 6;
    float v[8]; float run = 0.f;
    if (dir == 0) {
#pragma unroll
        for (int e = 0; e < 8; ++e) { run += A[(seg * 8 + e) * HS_ + k]; v[e] = run; }
    } else {
#pragma unroll
        for (int e = 7; e >= 0; --e) { run += A[(seg * 8 + e) * HS_ + k]; v[e] = run; }
    }
    tmp[seg * 64 + k] = run;
    __syncthreads();
    float off = 0.f;
#pragma unroll
    for (int s2 = 0; s2 < 8; ++s2) { const float tv = tmp[s2 * 64 + k]; if (dir == 0 ? (s2 < seg) : (s2 > seg)) off += tv; }
#pragma unroll
    for (int e = 0; e < 8; ++e) A[(seg * 8 + e) * HS_ + k] = (v[e] + off) * LOG2E;
    __syncthreads();
}
__device__ __forceinline__ void load_bf_tile64(float* dst, const u16* src  , size_t sstride) {
    const int t = tidx() >> 3, k8 = (tidx() & 7) * 8;
    float f[8]; unpack8(*(const uint4*)(src + (size_t)t * sstride + k8), f);
    *(float4*)(dst + t * HS_ + k8) = make_float4(f[0], f[1], f[2], f[3]); *(float4*)(dst + t * HS_ + k8 + 4) = make_float4(f[4], f[5], f[6], f[7]);
}
__device__ __forceinline__ void load_f32_tile64(float* dst, const float* src, size_t sstride) {
    const int t = tidx() >> 3, k8 = (tidx() & 7) * 8;
    *(float4*)(dst + t * HS_ + k8) = *(const float4*)(src + (size_t)t * sstride + k8); *(float4*)(dst + t * HS_ + k8 + 4) = *(const float4*)(src + (size_t)t * sstride + k8 + 4);
}

__device__ void hgrn1_item(const Params& p, const PassInfo ps, int item, unsigned char* lds) {
    unsigned char* ws = opaque(p.ws);
    const u16* PROJ = (const u16*)(ws + OFF_PROJ); const float* LOGF = (const float*)(ws + OFF_LOGF);
    float* HL = (float*)(ws + OFF_HL); float* HD = (float*)(ws + OFF_HD);
    const int NC = ps.T >> 6, ncsh = ps.is_ctx ? 2 : 6, c = item & (NC - 1), ci = item >> ncsh, dir = ci & 1, h = (ci >> 1) & 7, bl = ci >> 4;
    const size_t r0 = (size_t)bl * ps.T + c * 64;
    float* A = (float*)lds; float* KK = A + 64 * HS_; float* I = KK + 64 * HS_; float* tmp = I + 64 * HS_;
    const int tid = tidx();
    load_f32_tile64(A, LOGF + r0 * 1024 + dir * 512 + h * 64, 1024);
    load_bf_tile64(KK, PROJ + r0 * NPROJ + (11 + dir) * 512 + h * 64, NPROJ);
    load_bf_tile64(I, PROJ + r0 * NPROJ + 13 * 512 + h * 64, NPROJ);
    __syncthreads();
    chunk_cumsum(A, tmp, dir);
    const int lastt = dir == 0 ? 63 : 0;
    { const int t = tid >> 3, k8 = (tid & 7) * 8;
#pragma unroll
      for (int e = 0; e < 8; ++e) KK[t * HS_ + k8 + e] *= __builtin_amdgcn_exp2f(A[lastt * HS_ + k8 + e] - A[t * HS_ + k8 + e]);
      if (tid < 64) HD[(size_t)item * 64 + tid] = __builtin_amdgcn_exp2f(A[lastt * HS_ + tid]); }
    __syncthreads();
    { const int k = tid >> 3, v8 = (tid & 7) * 8;
      float acc[8];
#pragma unroll
      for (int e = 0; e < 8; ++e) acc[e] = 0.f;
      for (int t = 0; t < 64; ++t) { const float wv = KK[t * HS_ + k]; const float4 i0 = *(const float4*)(I + t * HS_ + v8), i1 = *(const float4*)(I + t * HS_ + v8 + 4);
          acc[0] += wv * i0.x; acc[1] += wv * i0.y; acc[2] += wv * i0.z; acc[3] += wv * i0.w; acc[4] += wv * i1.x; acc[5] += wv * i1.y; acc[6] += wv * i1.z; acc[7] += wv * i1.w; }
      float* dst = HL + ((size_t)item * 64 + k) * 64 + v8;
      *(float4*)dst = make_float4(acc[0], acc[1], acc[2], acc[3]); *(float4*)(dst + 4) = make_float4(acc[4], acc[5], acc[6], acc[7]); }
    __syncthreads();
}

__device__ void hgrn2_all(const Params& p, const PassInfo ps, int l) {
    unsigned char* ws = opaque(p.ws);
    const float* HL = (const float*)(ws + OFF_HL); const float* HD = (const float*)(ws + OFF_HD); float* HS = (float*)(ws + OFF_HS);
    float* CST = (float*)(ws + OFF_CTXST) + (size_t)l * 256 * 4096;
    const int NC = ps.T >> 6, chains = ps.nb * 16;
    const size_t total = (size_t)chains * 4096;
    for (size_t e = (size_t)blockIdx.x * 512 + tidx(); e < total; e += (size_t)gridDim.x * 512) {
        const int ci = (int)(e >> 12), kv = (int)(e & 4095), k = kv >> 6, dir = ci & 1;
        float s = ps.is_ctx ? 0.f : CST[((size_t)ps.b0 * 16 + ci) * 4096 + kv];
        for (int cc = 0; cc < NC; ++cc) { const int c = dir ? NC - 1 - cc : cc; const size_t idx = (size_t)ci * NC + c;
            HS[idx * 4096 + kv] = s; s = HD[idx * 64 + k] * s + HL[idx * 4096 + kv]; }
        if (ps.is_ctx) CST[(size_t)ci * 4096 + kv] = s;
    }
}

__device__ void hgrn3_item(const Params& p, const PassInfo ps, int l, int item, unsigned char* lds) {
    unsigned char* ws = opaque(p.ws);
    const u16* PROJ = (const u16*)(ws + OFF_PROJ); const float* LOGF = (const float*)(ws + OFF_LOGF); const float* HSt = (const float*)(ws + OFF_HS);
    u16* Y3 = (u16*)(ws + OFF_Y) + (size_t)3 * MLAT * 512;
    const int NC = ps.T >> 6, ncsh = ps.is_ctx ? 2 : 6, c = item & (NC - 1), bh = item >> ncsh, h = bh & 7, bl = bh >> 3;
    const size_t r0 = (size_t)bl * ps.T + c * 64;
    const size_t idxf = (size_t)(bh * 2 + 0) * NC + c, idxb = (size_t)(bh * 2 + 1) * NC + c;
    float* Q = (float*)lds; float* KKf = Q + 64 * HS_; float* KKb = KKf + 64 * HS_; float* Af = KKb + 64 * HS_; float* Ab = Af + 64 * HS_; float* tmp = Ab + 64 * HS_;
    u16* Ib = (u16*)(tmp + 512); u16* Sfb = Ib + 64 * KVS; u16* Sbb = Sfb + 64 * KVS; float* comb = (float*)(Sbb + 64 * KVS);
    const int tid = tidx(), w = tid >> 6, lane = tid & 63, li = lane & 15, quad = lane >> 4;
    load_bf_tile64(Q, PROJ + r0 * NPROJ + 10 * 512 + h * 64, NPROJ);
    load_bf_tile64(KKf, PROJ + r0 * NPROJ + 11 * 512 + h * 64, NPROJ);
    load_bf_tile64(KKb, PROJ + r0 * NPROJ + 12 * 512 + h * 64, NPROJ);
    load_f32_tile64(Af, LOGF + r0 * 1024 + h * 64, 1024);
    load_f32_tile64(Ab, LOGF + r0 * 1024 + 512 + h * 64, 1024);
    { const int t = tid >> 3, k8 = (tid & 7) * 8;
      *(uint4*)(Ib + t * KVS + k8) = *(const uint4*)(PROJ + (r0 + t) * NPROJ + 13 * 512 + h * 64 + k8);
      const float* sf = HSt + idxf * 4096 + t * 64 + k8; const float* sb = HSt + idxb * 4096 + t * 64 + k8;
      const float4 a0 = *(const float4*)sf, a1 = *(const float4*)(sf + 4), b0 = *(const float4*)sb, b1 = *(const float4*)(sb + 4);
      uint4 wa, wb; wa.x = pack2(a0.x, a0.y); wa.y = pack2(a0.z, a0.w); wa.z = pack2(a1.x, a1.y); wa.w = pack2(a1.z, a1.w);
      wb.x = pack2(b0.x, b0.y); wb.y = pack2(b0.z, b0.w); wb.z = pack2(b1.x, b1.y); wb.w = pack2(b1.z, b1.w);
      *(uint4*)(Sfb + t * KVS + k8) = wa; *(uint4*)(Sbb + t * KVS + k8) = wb; }
    __syncthreads();
    chunk_cumsum(Af, tmp, 0);
    chunk_cumsum(Ab, tmp, 1);
    const int dir = w >> 2, T = w & 3;
    const float* A = dir ? Ab : Af; const float* KK = dir ? KKb : KKf; const u16* Sb16 = dir ? Sbb : Sfb;
    const int t = 16 * T + li;
    const int rrow = dir ? 16 * T + 16 : 16 * T - 1; const bool rzero = dir ? (T == 3) : (T == 0);
    bf16x8 qt[2], qh[2];
    float Rv[2][8];
#pragma unroll
    for (int ks = 0; ks < 2; ++ks) {
        const int k0 = ks * 32 + quad * 8;
        float qv[8], av[8];
        { const float4 x0 = *(const float4*)(Q + t * HS_ + k0), x1 = *(const float4*)(Q + t * HS_ + k0 + 4); qv[0] = x0.x; qv[1] = x0.y; qv[2] = x0.z; qv[3] = x0.w; qv[4] = x1.x; qv[5] = x1.y; qv[6] = x1.z; qv[7] = x1.w; }
        { const float4 x0 = *(const float4*)(A + t * HS_ + k0), x1 = *(const float4*)(A + t * HS_ + k0 + 4); av[0] = x0.x; av[1] = x0.y; av[2] = x0.z; av[3] = x0.w; av[4] = x1.x; av[5] = x1.y; av[6] = x1.z; av[7] = x1.w; }
        if (rzero) {
#pragma unroll
            for (int e = 0; e < 8; ++e) Rv[ks][e] = 0.f;
        } else { const float4 x0 = *(const float4*)(A + rrow * HS_ + k0), x1 = *(const float4*)(A + rrow * HS_ + k0 + 4); Rv[ks][0] = x0.x; Rv[ks][1] = x0.y; Rv[ks][2] = x0.z; Rv[ks][3] = x0.w; Rv[ks][4] = x1.x; Rv[ks][5] = x1.y; Rv[ks][6] = x1.z; Rv[ks][7] = x1.w; }
        float a_[8], b_[8];
#pragma unroll
        for (int e = 0; e < 8; ++e) { a_[e] = qv[e] * __builtin_amdgcn_exp2f(av[e] - Rv[ks][e]); b_[e] = qv[e] * __builtin_amdgcn_exp2f(av[e]); }
        const unsigned a0 = pack2(a_[0], a_[1]), a1 = pack2(a_[2], a_[3]), a2 = pack2(a_[4], a_[5]), a3 = pack2(a_[6], a_[7]);
        const unsigned b0 = pack2(b_[0], b_[1]), b1 = pack2(b_[2], b_[3]), b2 = pack2(b_[4], b_[5]), b3 = pack2(b_[6], b_[7]);
        qt[ks] = (bf16x8){(short)(a0 & 0xffff), (short)(a0 >> 16), (short)(a1 & 0xffff), (short)(a1 >> 16), (short)(a2 & 0xffff), (short)(a2 >> 16), (short)(a3 & 0xffff), (short)(a3 >> 16)};
        qh[ks] = (bf16x8){(short)(b0 & 0xffff), (short)(b0 >> 16), (short)(b1 & 0xffff), (short)(b1 >> 16), (short)(b2 & 0xffff), (short)(b2 >> 16), (short)(b3 & 0xffff), (short)(b3 >> 16)};
    }
    const int nS = dir ? 4 - T : T + 1;
    float sc[4][4];
#pragma unroll
    for (int i = 0; i < 4; ++i) {
        if (i < nS) {
            const int S = dir ? T + i : i, srow = 16 * S + li;
            f32x4 a = (f32x4){0.f, 0.f, 0.f, 0.f};
#pragma unroll
            for (int ks = 0; ks < 2; ++ks) {
                const int k0 = ks * 32 + quad * 8;
                const float4 x0 = *(const float4*)(KK + srow * HS_ + k0), x1 = *(const float4*)(KK + srow * HS_ + k0 + 4);
                const float4 y0 = *(const float4*)(A + srow * HS_ + k0), y1 = *(const float4*)(A + srow * HS_ + k0 + 4);
                const float kv[8] = {x0.x, x0.y, x0.z, x0.w, x1.x, x1.y, x1.z, x1.w}, as[8] = {y0.x, y0.y, y0.z, y0.w, y1.x, y1.y, y1.z, y1.w};
                float c_[8];
#pragma unroll
                for (int e = 0; e < 8; ++e) c_[e] = kv[e] * __builtin_amdgcn_exp2f(Rv[ks][e] - as[e]);
                const unsigned c0 = pack2(c_[0], c_[1]), c1 = pack2(c_[2], c_[3]), c2 = pack2(c_[4], c_[5]), c3 = pack2(c_[6], c_[7]);
                const bf16x8 kf = (bf16x8){(short)(c0 & 0xffff), (short)(c0 >> 16), (short)(c1 & 0xffff), (short)(c1 >> 16), (short)(c2 & 0xffff), (short)(c2 >> 16), (short)(c3 & 0xffff), (short)(c3 >> 16)};
                a = MFMA16(kf, qt[ks], a);
            }
            const bool diag = (S == T);
#pragma unroll
            for (int j = 0; j < 4; ++j) { const int sl = quad * 4 + j; const bool keep = !diag || (dir ? (sl >= li) : (sl <= li)); sc[i][j] = keep ? a[j] : 0.f; }
        } else {
#pragma unroll
            for (int j = 0; j < 4; ++j) sc[i][j] = 0.f;
        }
    }
    f32x4 O[4];
#pragma unroll
    for (int v = 0; v < 4; ++v) O[v] = (f32x4){0.f, 0.f, 0.f, 0.f};
#pragma unroll
    for (int pr = 0; pr < 2; ++pr) {
        if (2 * pr < nS) {
            const unsigned a0 = pack2(sc[2 * pr][0], sc[2 * pr][1]), a1 = pack2(sc[2 * pr][2], sc[2 * pr][3]), b0 = pack2(sc[2 * pr + 1][0], sc[2 * pr + 1][1]), b1 = pack2(sc[2 * pr + 1][2], sc[2 * pr + 1][3]);
            const bf16x8 pf = (bf16x8){(short)(a0 & 0xffff), (short)(a0 >> 16), (short)(a1 & 0xffff), (short)(a1 >> 16), (short)(b0 & 0xffff), (short)(b0 >> 16), (short)(b1 & 0xffff), (short)(b1 >> 16)};
            const int S0 = dir ? T + 2 * pr : 2 * pr; int S1 = S0 + 1; if (S1 > 3) S1 = 3;
            const u16* p0 = Ib + (16 * S0 + quad * 4 + (li >> 2)) * KVS + 4 * (li & 3);
            const u16* p1 = Ib + (16 * S1 + quad * 4 + (li >> 2)) * KVS + 4 * (li & 3);
#pragma unroll
            for (int v = 0; v < 4; ++v) O[v] = MFMA16(tr_read2(p0 + v * 16, p1 + v * 16), pf, O[v]);
        }
    }
#pragma unroll
    for (int ks = 0; ks < 2; ++ks) {
        const u16* p0 = Sb16 + (ks * 32 + quad * 8 + (li >> 2)) * KVS + 4 * (li & 3);
#pragma unroll
        for (int v = 0; v < 4; ++v) O[v] = MFMA16(tr_read2(p0 + v * 16, p0 + 4 * KVS + v * 16), qh[ks], O[v]);
    }
    if (dir == 1) {
#pragma unroll
        for (int v = 0; v < 4; ++v)
#pragma unroll
            for (int j = 0; j < 4; ++j) comb[(T * 16 + v * 4 + j) * 64 + lane] = O[v][j];
    }
    __syncthreads();
    if (dir == 0) {
        float ss = 0.f;
#pragma unroll
        for (int v = 0; v < 4; ++v)
#pragma unroll
            for (int j = 0; j < 4; ++j) { O[v][j] += comb[(T * 16 + v * 4 + j) * 64 + lane]; ss += O[v][j] * O[v][j]; }
        ss += shx(ss, 16); ss += shx(ss, 32);
        const float rstd = rsqrtf(ss * (1.f / 64.f) + EPSN);
        const size_t row = r0 + t;
#pragma unroll
        for (int v = 0; v < 4; ++v) {
            const int col = h * 64 + v * 16 + quad * 4;
            const float4 gn = *(const float4*)(p.hgrn_g + l * 512 + col);
            const uint2 g = *(const uint2*)(PROJ + row * NPROJ + 14 * 512 + col);
            uint2 wv; wv.x = pack2(O[v][0] * rstd * gn.x * bflo(g.x), O[v][1] * rstd * gn.y * bfhi(g.x)); wv.y = pack2(O[v][2] * rstd * gn.z * bflo(g.y), O[v][3] * rstd * gn.w * bfhi(g.y));
            *(uint2*)(Y3 + row * 512 + col) = wv;
        }
    }
    __syncthreads();
}

#ifndef REP_B
#define REP_B 1
#endif
#ifndef REP_C1
#define REP_C1 1
#endif
#ifndef REP_C2
#define REP_C2 1
#endif
#ifndef REP_C3
#define REP_C3 1
#endif
#ifndef REP_DE
#define REP_DE 1
#endif
template <class Epi> __device__ __forceinline__ void run_gemm(LAS unsigned char* lds, const u16* A, const u16* Bt, int M, int N, int K, const Epi& E) {
    pg8::Gemm g; g.A = A; g.Bt = Bt; g.M = M; g.N = N; g.K = K;
    pg8::StaticOrder S; S.init(M, N, (int)gridDim.x, (int)blockIdx.x);
    pg8::gemm_phase<Epi, pg8::StaticOrder, false>(lds, g, S, E, nullptr);
}


__device__ __forceinline__ Params KP() {
    auto q0 = __builtin_amdgcn_kernarg_segment_ptr();
    asm volatile("" : "+s"(q0));
    const __attribute__((address_space(4))) Params* q = (const __attribute__((address_space(4))) Params*)q0;
    Params r;
    r.x = q->x; r.c = q->c; r.ctx = q->ctx; r.c_ctx = q->c_ctx; r.w_ada = q->w_ada; r.b_ada = q->b_ada; r.g_pre = q->g_pre; r.g_post = q->g_post; r.w_in = q->w_in; r.rpb = q->rpb;
    r.fnet_w = q->fnet_w; r.gmlp_g = q->gmlp_g; r.gmlp_ws = q->gmlp_ws; r.gmlp_bs = q->gmlp_bs; r.lb_logits = q->lb_logits; r.hgrn_g = q->hgrn_g; r.w_branch = q->w_branch; r.w_out = q->w_out;
    r.out = q->out; r.ws = q->ws; return r;
}
__device__ __forceinline__ void gsync() { cg::this_grid().sync(); }
__global__ void __launch_bounds__(512, 2) mega_fwd(Params p_unused) {
    extern __shared__ __attribute__((aligned(16))) unsigned char shm[];
    LAS unsigned char* lds3 = (LAS unsigned char*)shm;
    prep1(KP(), shm);
    gsync();
    prep2(KP(), shm);
    gsync();
#pragma nounroll
    for (int pass = 0; pass < 1 + NBATCH / GB; ++pass) {
        PassInfo ps;
        if (pass == 0) { ps.is_ctx = 1; ps.nb = NBATCH; ps.T = CTXL; ps.M = MCTX; ps.b0 = 0; }
        else { ps.is_ctx = 0; ps.nb = GB; ps.T = SEQ; ps.M = MLAT; ps.b0 = (pass - 1) * GB; }
        const int NC = ps.T >> 6;
#pragma nounroll
        for (int l = 0; l < DEPTH; ++l) {
            phase_norm(KP(), ps, l);
            gsync();
            _Pragma("nounroll") for (int rep = 0; rep < REP_B; ++rep) {
                unsigned char* ws = opaque(KP().ws);
                EpiProj E; E.ws = ws; E.l = l; E.is_ctx = ps.is_ctx;
                run_gemm(lds3, (const u16*)(ws + OFF_H), (const u16*)(ws + OFF_WTIN) + (size_t)l * NPROJ * DM, ps.M, NPROJ, DM, E);
                gsync();
            }
            const bool full = !(ps.is_ctx && l == DEPTH - 1);
            _Pragma("nounroll") for (int rep = 0; rep < REP_C1; ++rep) {
                const int n_h1 = ps.nb * 16 * NC, n_at = full ? ps.nb * 8 * (ps.T >> 6) : 0, n_f1 = ps.is_ctx ? 0 : ps.nb * 64;
                for (int it = blockIdx.x; it < n_h1 + n_at + n_f1; it += gridDim.x) {
                    if (it < n_h1) hgrn1_item(KP(), ps, it, shm);
                    else if (it < n_h1 + n_at) attn_item(KP(), ps, l, it - n_h1, shm);
                    else four1_item(KP(), it - n_h1 - n_at, shm);
                }
                gsync();
            }
            _Pragma("nounroll") for (int rep = 0; rep < REP_C2; ++rep) {
                hgrn2_all(KP(), ps, l);
                if (full) {
                    const int n_f2 = ps.is_ctx ? ps.nb * 4 : ps.nb * 64, n_g = ps.M >> 7;
                    for (int it = blockIdx.x; it < n_f2 + n_g; it += gridDim.x) {
                        if (it < n_f2) { if (ps.is_ctx) fourc_item(KP(), it, shm); else four2_item(KP(), it, shm); }
                        else gmlp_item(KP(), l, it - n_f2, shm);
                    }
                }
                gsync();
            }
            if (!full) continue;
            _Pragma("nounroll") for (int rep = 0; rep < REP_C3; ++rep) {
                const int n_h3 = ps.nb * 8 * NC;
                for (int it = blockIdx.x; it < n_h3; it += gridDim.x) hgrn3_item(KP(), ps, l, it, shm);
                gsync();
            }
            _Pragma("nounroll") for (int rep = 0; rep < REP_DE; ++rep) {
            {
                unsigned char* ws = opaque(KP().ws);
                const u16* Y = (const u16*)(ws + OFF_Y); const u16* WB = (const u16*)(ws + OFF_WTBR) + (size_t)l * 4 * 1024 * 512;
                { EpiMerge<0> E; E.ws = ws; run_gemm(lds3, Y + (size_t)0 * MLAT * 512, WB + (size_t)0 * 1024 * 512, ps.M, 1024, 512, E); }
                { EpiMerge<1> E; E.ws = ws; run_gemm(lds3, Y + (size_t)1 * MLAT * 512, WB + (size_t)1 * 1024 * 512, ps.M, 1024, 512, E); }
                { EpiMerge<2> E; E.ws = ws; run_gemm(lds3, Y + (size_t)2 * MLAT * 512, WB + (size_t)2 * 1024 * 512, ps.M, 1024, 512, E); }
                { EpiMerge<3> E; E.ws = ws; run_gemm(lds3, Y + (size_t)3 * MLAT * 512, WB + (size_t)3 * 1024 * 512, ps.M, 1024, 512, E); }
            }
            gsync();
            if (REP_DE > 1 && rep + 1 < REP_DE) continue;
            {
                unsigned char* ws = opaque(KP().ws);
                EpiOut E; E.C = (float*)(ws + OFF_OUT);
                run_gemm(lds3, (const u16*)(ws + OFF_MB), (const u16*)(ws + OFF_WTOUT) + (size_t)l * 1024 * 1024, ps.M, 1024, 1024, E);
            }
            gsync();
            }
        }
        if (!ps.is_ctx) phase_norm(KP(), ps, DEPTH);
    }
}

static_assert(WS_END <= (size_t)1073741824, "workspace map exceeds 1 GiB");

extern "C" void kernel_launch(void* const* d_in, const int* in_sizes, int n_in, void* d_out, int out_size, void* d_ws, size_t ws_size, hipStream_t stream) {
    static int grid_blocks = 0;
    if (grid_blocks == 0) {
        if (n_in != 18 || ws_size < WS_END) { fprintf(stderr, "kernel_launch: unexpected n_in %d or ws_size %zu (need %zu)\n", n_in, ws_size, (size_t)WS_END); grid_blocks = -1; return; }
        int dev = 0, cus = 0, per_cu = 0;
        hipGetDevice(&dev);
        hipDeviceGetAttribute(&cus, hipDeviceAttributeMultiprocessorCount, dev);
        if (hipFuncSetAttribute((const void*)mega_fwd, hipFuncAttributeMaxDynamicSharedMemorySize, LDS_BYTES) != hipSuccess) { fprintf(stderr, "kernel_launch: hipFuncSetAttribute failed\n"); grid_blocks = -1; return; }
        hipOccupancyMaxActiveBlocksPerMultiprocessor(&per_cu, (const void*)mega_fwd, 512, LDS_BYTES);
        if (per_cu < 1) { fprintf(stderr, "kernel_launch: occupancy query gave %d\n", per_cu); per_cu = 1; }
        (void)hipGetLastError();
        grid_blocks = cus * per_cu;
    }
    if (grid_blocks < 0) return;
    Params p{};
    const float** pp = (const float**)&p;
    for (int i = 0; i < 18; ++i) pp[i] = (const float*)d_in[i];
    p.out = (float*)d_out; p.ws = (unsigned char*)d_ws;
    void* args[] = {&p};
    hipError_t e = hipLaunchCooperativeKernel((const void*)mega_fwd, dim3(grid_blocks), dim3(512), args, LDS_BYTES, stream);
    if (e != hipSuccess) fprintf(stderr, "cooperative launch failed: %s (grid %d)\n", hipGetErrorString(e), grid_blocks);
}
```

```cpp
#include <hip/hip_runtime.h>
#include <hip/hip_cooperative_groups.h>
#include <cstdio>
namespace cg = cooperative_groups;
__device__ __forceinline__ int tidx() { int t = threadIdx.x; asm volatile("" : "+v"(t)); return t; }
template <class T> __device__ __forceinline__ T* opaque(T* p) {
    unsigned long long v = (unsigned long long)p; const unsigned lo = __builtin_amdgcn_readfirstlane((unsigned)v), hi = __builtin_amdgcn_readfirstlane((unsigned)(v >> 32));
    v = ((unsigned long long)hi << 32) | lo; asm volatile("" : "+s"(v)); return (T*)((__attribute__((address_space(1))) T*)v); }
__device__ __forceinline__ float shx(float v, int m) { const int lane = tidx() & 63; return __int_as_float(__builtin_amdgcn_ds_bpermute((lane ^ m) << 2, __float_as_int(v))); }
namespace pg8 {
#define PG8_LAS __attribute__((address_space(3)))
typedef unsigned short bf16_t;
typedef short bf16x8 __attribute__((ext_vector_type(8)));
typedef float f32x4 __attribute__((ext_vector_type(4)));
typedef unsigned u32x4 __attribute__((ext_vector_type(4)));
constexpr int BM = 256, BK = 64, HALF = 128, HTB = HALF * BK * 2  , STAGE_BYTES = 8 * HTB, NXCD = 8, WGM = 8;

__host__ __device__ __forceinline__ int lds_byte(int r, int c) { const int st = (r >> 4) * 2 + (c >> 5), rr = r & 15, cc = c & 31, ob = rr * 64 + cc * 2; return st * 1024 + (ob ^ (((ob >> 9) & 1) << 5)); }
__host__ __device__ __forceinline__ void stage_rc(int b, int& R, int& C) { const int st = b / 1024, sb = b % 1024, swz = sb ^ (((sb >> 9) & 1) << 5); R = (st >> 1) * 16 + swz / 64; C = (st & 1) * 32 + (swz % 64) / 2; }
__host__ __device__ __forceinline__ int perm32(int rho) { const int n = rho >> 4, i = rho & 15; return 8 * (i >> 2) + 4 * n + (i & 3); }

struct Unit { int pm, pn, r; };
struct Gemm { const bf16_t* A; const bf16_t* Bt; int M, N, K; size_t rsA, rsB; };

struct StaticOrder {
    int nM, nN, nwg, G, c;
    __host__ __device__ void init(int M, int N, int G_, int c_) { nM = M / BM; nN = N / BM; nwg = nM * nN; G = G_; c = c_; }
    __host__ __device__ bool next(int i, Unit& u) const {
        const long L = (long)i * G + c; if (L >= nwg) return false;
        int wgid = (int)L; { const int q = nwg / NXCD, r = nwg % NXCD, xcd = wgid % NXCD, off = wgid / NXCD; wgid = (xcd < r ? xcd * (q + 1) : r * (q + 1) + (xcd - r) * q) + off; }
        const int nig = WGM * nN, gid = wgid / nig, fm = gid * WGM, gsz = (nM - fm) < WGM ? (nM - fm) : WGM;
        u.pm = fm + ((wgid % nig) % gsz); u.pn = (wgid % nig) / gsz; u.r = 0; return true;
    }
    __device__ __forceinline__ void a_ready(const Unit&) const {}
    __device__ __forceinline__ void done(const Unit&) const {}
};
__device__ __forceinline__ unsigned cvt_pk_bf16(float lo, float hi) { unsigned r; asm volatile("v_cvt_pk_bf16_f32 %0, %1, %2" : "=v"(r) : "v"(lo), "v"(hi)); return r; }

template <class Epi, class Sched, bool STAMP = false>
__device__ __forceinline__ void gemm_phase(PG8_LAS unsigned char* lds, const Gemm g, const Sched& S, const Epi& E, unsigned long long* stamps) {
    const int tid = tidx(), wid = __builtin_amdgcn_readfirstlane(tid >> 6), lane = tid & 63, wr = wid >> 2, wc = wid & 3, fr = lane & 15, fq = lane >> 4;
    const int K = g.K, nt = K / BK;
    int ts_lo = 0, ts_hi = 0, nts = 0; const unsigned long long rt_entry = STAMP ? (unsigned long long)wall_clock64() : 0ull;
#define PG8_STAMP() do { if (STAMP && wid == 0 && nts < 64) { const unsigned long long _c = (unsigned long long)clock64(); \
        ts_lo = (lane == nts) ? (int)(unsigned)_c : ts_lo; ts_hi = (lane == nts) ? (int)(unsigned)(_c >> 32) : ts_hi; ++nts; } } while (0)
    PG8_STAMP();
    unsigned voffA[2], voffB[2];
#pragma unroll
    for (int i = 0; i < 2; ++i) { int R, C; stage_rc(tid * 16 + i * 8192, R, C); const int Rb = Epi::PERM ? ((R & ~31) + perm32(R & 31)) : R;
        voffA[i] = (unsigned)(R * K + C) * 2u; voffB[i] = (unsigned)(Rb * K + C) * 2u; }
    const size_t kstep = (size_t)(BK * 2);
    const size_t hstep = (size_t)HALF * K * 2;
    const size_t tstep = 2 * hstep;
    const unsigned ldsw = (unsigned)wid * 1024u;
    const int aoff = lds_byte(wr * 64 + fr, fq * 8), boff = lds_byte(wc * 32 + fr, fq * 8);
#define PG8_SA(b, h) (((b) * 2 + (h)) * HTB)
#define PG8_SB(b, h) ((4 + (b) * 2 + (h)) * HTB)
#define PG8_STAGE(bufoff, gbase, voff) do { _Pragma("unroll") for (int _i = 0; _i < 2; ++_i) \
        __builtin_amdgcn_global_load_lds((const unsigned*)((const char*)(gbase) + (voff)[_i]), (PG8_LAS unsigned*)(lds + (bufoff) + ldsw + _i * 8192), 16, 0, 0); } while (0)
#define PG8_LDA(dst, b, h) do { _Pragma("unroll") for (int m = 0; m < 4; ++m) _Pragma("unroll") for (int k = 0; k < 2; ++k) dst[m][k] = *(const PG8_LAS bf16x8*)(lds + PG8_SA(b, h) + aoff + m * 2048 + k * 1024); } while (0)
#define PG8_LDB(dst, b, h) do { _Pragma("unroll") for (int n = 0; n < 2; ++n) _Pragma("unroll") for (int k = 0; k < 2; ++k) dst[n][k] = *(const PG8_LAS bf16x8*)(lds + PG8_SB(b, h) + boff + n * 2048 + k * 1024); } while (0)
#define PG8_MMA(ai, bj, At, Bt) do { __builtin_amdgcn_s_setprio(1); _Pragma("unroll") for (int m = 0; m < 4; ++m) _Pragma("unroll") for (int n = 0; n < 2; ++n) _Pragma("unroll") for (int k = 0; k < 2; ++k) \
        acc[ai][bj][m][n] = __builtin_amdgcn_mfma_f32_16x16x32_bf16(Bt[n][k], At[m][k], acc[ai][bj][m][n], 0, 0, 0); __builtin_amdgcn_s_setprio(0); } while (0)
#define PG8_WAIT_V(n) asm volatile("s_waitcnt vmcnt(" #n ")" ::: "memory")
#define PG8_WAIT_L(n) asm volatile("s_waitcnt lgkmcnt(" #n ")" ::: "memory")
#define PG8_BAR __builtin_amdgcn_s_barrier()
#define PG8_SCHED __builtin_amdgcn_sched_barrier(0)
    Unit cur, nxt; int ui = 0;
    if (!S.next(0, cur)) return;
    f32x4 acc[2][2][4][2];
#pragma unroll
    for (int a = 0; a < 2; ++a)
#pragma unroll
        for (int b = 0; b < 2; ++b)
#pragma unroll
            for (int m = 0; m < 4; ++m)
#pragma unroll
                for (int n = 0; n < 2; ++n) acc[a][b][m][n] = (f32x4){0.f, 0.f, 0.f, 0.f};
    bf16x8 At[4][2], B0[2][2], B1[2][2];
    const char* cA = (const char*)g.A + (size_t)cur.pm * tstep + (size_t)cur.r * g.rsA; const char* cB = (const char*)g.Bt + (size_t)cur.pn * tstep + (size_t)cur.r * g.rsB;
    S.a_ready(cur);
    PG8_STAGE(PG8_SB(0, 0), cB, voffB); PG8_STAGE(PG8_SA(0, 0), cA, voffA); PG8_STAGE(PG8_SB(0, 1), cB + hstep, voffB); PG8_STAGE(PG8_SA(0, 1), cA + hstep, voffA);
    if (wr == 1) PG8_BAR;
    PG8_WAIT_V(4); PG8_BAR;
    PG8_STAGE(PG8_SB(1, 0), cB + kstep, voffB); PG8_STAGE(PG8_SA(1, 0), cA + kstep, voffA); PG8_STAGE(PG8_SB(1, 1), cB + hstep + kstep, voffB);
    PG8_WAIT_V(6); PG8_BAR;
    PG8_STAMP();
    for (;;) {
        const bool has_next = S.next(ui + 1, nxt);
        const char* nA = has_next ? (const char*)g.A + (size_t)nxt.pm * tstep + (size_t)nxt.r * g.rsA : cA; const char* nB = has_next ? (const char*)g.Bt + (size_t)nxt.pn * tstep + (size_t)nxt.r * g.rsB : cB;
        for (int t = 0; t < nt; t += 2) {
            const bool last = (t == nt - 2);
            const char* a1 = cA + (size_t)(t + 1) * kstep;
            const char* a2 = last ? nA : cA + (size_t)(t + 2) * kstep; const char* b2 = last ? nB : cB + (size_t)(t + 2) * kstep;
            const char* a3 = a2 + kstep; const char* b3 = b2 + kstep;
            if (last && has_next) S.a_ready(nxt);
            PG8_LDB(B0, 0, 0); PG8_SCHED; PG8_LDA(At, 0, 0); PG8_STAGE(PG8_SA(1, 1), a1 + hstep, voffA);
            PG8_WAIT_L(8); PG8_BAR; PG8_WAIT_L(0); PG8_MMA(0, 0, At, B0); PG8_BAR; PG8_SCHED;
            PG8_LDB(B1, 0, 1); PG8_STAGE(PG8_SB(0, 0), b2, voffB);
            PG8_BAR; PG8_WAIT_L(0); PG8_MMA(0, 1, At, B1); PG8_BAR;
            PG8_LDA(At, 0, 1); PG8_STAGE(PG8_SA(0, 0), a2, voffA);
            PG8_BAR; PG8_WAIT_L(0); PG8_MMA(1, 0, At, B0); PG8_BAR; PG8_SCHED;
            PG8_STAGE(PG8_SB(0, 1), b2 + hstep, voffB);
            PG8_WAIT_V(6); PG8_BAR; PG8_MMA(1, 1, At, B1); PG8_BAR;
            PG8_LDB(B0, 1, 0); PG8_SCHED; PG8_LDA(At, 1, 0); PG8_STAGE(PG8_SA(0, 1), a2 + hstep, voffA);
            PG8_WAIT_L(8); PG8_BAR; PG8_WAIT_L(0); PG8_MMA(0, 0, At, B0); PG8_BAR; PG8_SCHED;
            PG8_LDB(B1, 1, 1); PG8_STAGE(PG8_SB(1, 0), b3, voffB);
            PG8_BAR; PG8_WAIT_L(0); PG8_MMA(0, 1, At, B1); PG8_BAR;
            PG8_LDA(At, 1, 1); PG8_STAGE(PG8_SA(1, 0), a3, voffA);
            PG8_BAR; PG8_WAIT_L(0); PG8_MMA(1, 0, At, B0); PG8_BAR; PG8_SCHED;
            PG8_STAGE(PG8_SB(1, 1), b3 + hstep, voffB);
            PG8_WAIT_V(6); PG8_BAR; PG8_MMA(1, 1, At, B1); PG8_BAR;
        }
        PG8_STAMP();
        if constexpr (!Epi::AFTER_DRAIN) { E(acc, cur, wr, wc, fr, fq); S.done(cur); }
        PG8_STAMP();
        if (!has_next) break;
#pragma unroll
        for (int a = 0; a < 2; ++a)
#pragma unroll
            for (int b = 0; b < 2; ++b)
#pragma unroll
                for (int m = 0; m < 4; ++m)
#pragma unroll
                    for (int n = 0; n < 2; ++n) acc[a][b][m][n] = (f32x4){0.f, 0.f, 0.f, 0.f};
        cur = nxt; cA = nA; cB = nB; ++ui;
    }
    PG8_WAIT_V(0);
    if (wr == 0) PG8_BAR;
    PG8_BAR;
    if constexpr (Epi::AFTER_DRAIN) { E.fused(acc, cur, wr, wc, fr, fq, lds, wid, lane); S.done(cur); }
    PG8_STAMP();
    if (STAMP && wid == 0) { stamps[lane] = lane < nts ? (((unsigned long long)(unsigned)ts_hi << 32) | (unsigned)ts_lo) : 0ull;
        if (lane == 62) stamps[62] = rt_entry; if (lane == 63) stamps[63] = (unsigned long long)wall_clock64(); }
#undef PG8_STAMP
#undef PG8_SA
#undef PG8_SB
#undef PG8_STAGE
#undef PG8_LDA
#undef PG8_LDB
#undef PG8_MMA
#undef PG8_WAIT_V
#undef PG8_WAIT_L
#undef PG8_BAR
#undef PG8_SCHED
}
}

typedef unsigned short u16;
typedef short s16x4 __attribute__((ext_vector_type(4)));
using pg8::bf16x8; using pg8::f32x4; using pg8::Unit;
#define LAS __attribute__((address_space(3)))
#define MFMA16(a, b, c) __builtin_amdgcn_mfma_f32_16x16x32_bf16(a, b, c, 0, 0, 0)

constexpr int DM = 1024, NBATCH = 16, SEQ = 4096, DEPTH = 4, CTXL = 256, NPROJ = 11776, NIN = 11264;
constexpr int GB = 4, MLAT = GB * SEQ, MCTX = NBATCH * CTXL;
constexpr int LDS_BYTES = 152 * 1024;
constexpr float LOG2E = 1.4426950408889634f;
constexpr float EPSN = 1e-6f;

constexpr size_t al256(size_t x) { return (x + 255) & ~(size_t)255; }
constexpr size_t OFF_WTIN = 0;
constexpr size_t OFF_WTBR = OFF_WTIN + (size_t)DEPTH * NPROJ * DM * 2;
constexpr size_t OFF_WTOUT = OFF_WTBR + (size_t)DEPTH * 4 * 1024 * 512 * 2;
constexpr size_t OFF_WS16 = OFF_WTOUT + (size_t)DEPTH * 1024 * 1024 * 2;
constexpr size_t OFF_MOD = OFF_WS16 + (size_t)DEPTH * 8 * 128 * 128 * 2;
constexpr size_t OFF_LB = OFF_MOD + al256((size_t)DEPTH * 17 * 3072 * 4);
constexpr size_t OFF_ROPE = OFF_LB + (size_t)DEPTH * 2 * 512 * 4;
constexpr size_t OFF_TW = OFF_ROPE + 2 * 64 * 16 * 4;
constexpr size_t OFF_M1 = OFF_TW + 4096 * 8;
constexpr size_t OFF_M2 = OFF_M1 + 128 * 128 * 2;
constexpr size_t OFF_M3 = OFF_M2 + 64 * 128 * 2;
constexpr size_t OFF_CSW = OFF_M3 + 256 * 512 * 2;
constexpr size_t OFF_CTXW = OFF_CSW + (size_t)DEPTH * 4 * 2 * 128 * 128 * 4;
constexpr size_t OFF_CTXKV = OFF_CTXW + (size_t)NBATCH * CTXL * DM * 4;
constexpr size_t OFF_CTXST = OFF_CTXKV + (size_t)DEPTH * MCTX * 1024 * 2;
constexpr size_t OFF_H = OFF_CTXST + (size_t)DEPTH * 256 * 4096 * 4;
constexpr size_t OFF_PROJ = OFF_H + (size_t)MLAT * DM * 2;
constexpr size_t OFF_QROT = OFF_PROJ + (size_t)MLAT * NPROJ * 2;
constexpr size_t OFF_LOGF = OFF_QROT + (size_t)MLAT * 512 * 2;
constexpr size_t OFF_Y = OFF_LOGF + (size_t)MLAT * 1024 * 4;
constexpr size_t OFF_FY = OFF_Y + (size_t)4 * MLAT * 512 * 2;
constexpr size_t OFF_HL = OFF_FY + (size_t)GB * 4096 * 1024 * 2;
constexpr size_t OFF_HD = OFF_HL + (size_t)4096 * 4096 * 4;
constexpr size_t OFF_HS = OFF_HD + (size_t)4096 * 64 * 4;
constexpr size_t OFF_MB = OFF_HS + (size_t)4096 * 4096 * 4;
constexpr size_t WS_END = OFF_MB + (size_t)MLAT * DM * 2;
constexpr size_t OFF_MERGED = OFF_LOGF;
constexpr size_t OFF_OUT = OFF_PROJ;

struct Params {
    const float *x, *c, *ctx, *c_ctx, *w_ada, *b_ada, *g_pre, *g_post, *w_in, *rpb, *fnet_w, *gmlp_g, *gmlp_ws, *gmlp_bs, *lb_logits, *hgrn_g, *w_branch, *w_out;
    float* out; unsigned char* ws;
};
struct PassInfo { int is_ctx, nb, T, M, b0; };

__device__ __forceinline__ u16 f2bf(float f) { unsigned u = __float_as_uint(f); u += 0x7FFFu + ((u >> 16) & 1u); return (u16)(u >> 16); }
__device__ __forceinline__ float bf2f(u16 b) { return __uint_as_float(((unsigned)b) << 16); }
typedef __bf16 bf16x2_t_ __attribute__((ext_vector_type(2)));
typedef float f32x2_t_ __attribute__((ext_vector_type(2)));
__device__ __forceinline__ unsigned pack2(float a, float b) { f32x2_t_ v = {a, b}; bf16x2_t_ r = __builtin_convertvector(v, bf16x2_t_); return __builtin_bit_cast(unsigned, r); }
__device__ __forceinline__ float bflo(unsigned w) { return __uint_as_float(w << 16); }
__device__ __forceinline__ float bfhi(unsigned w) { return __uint_as_float(w & 0xFFFF0000u); }
__device__ __forceinline__ float sigmoidf_(float v) { return 1.f / (1.f + __expf(-v)); }
__device__ __forceinline__ float siluf_(float v) { return v / (1.f + __expf(-v)); }
__device__ __forceinline__ void unpack8(uint4 w, float* f) { f[0] = bflo(w.x); f[1] = bfhi(w.x); f[2] = bflo(w.y); f[3] = bfhi(w.y); f[4] = bflo(w.z); f[5] = bfhi(w.z); f[6] = bflo(w.w); f[7] = bfhi(w.w); }
__device__ __forceinline__ bf16x8 tr_read2(const u16* p0, const u16* p1) {
    s16x4 a = __builtin_amdgcn_ds_read_tr16_b64_v4i16((LAS s16x4*)p0);
    s16x4 b = __builtin_amdgcn_ds_read_tr16_b64_v4i16((LAS s16x4*)p1);
    return (bf16x8){a[0], a[1], a[2], a[3], b[0], b[1], b[2], b[3]};
}
__device__ __forceinline__ bf16x8 ld_frag_g(const u16* p) { return *(const bf16x8*)p; }

typedef unsigned u32x4_ __attribute__((ext_vector_type(4)));
__device__ __forceinline__ void nt_store16(uint4 w, void* p) { __builtin_nontemporal_store((u32x4_){w.x, w.y, w.z, w.w}, (u32x4_*)p); }
struct EpiProj {
    static constexpr bool PERM = true, AFTER_DRAIN = false;
    unsigned char* ws; int l; int is_ctx;
    __device__ __forceinline__ void operator()(const f32x4 (&acc)[2][2][4][2], const Unit& u, int wr, int wc, int fr, int fq) const {
        u16* proj = (u16*)(ws + OFF_PROJ);
        const int blk = u.pn >> 1;
        const int row0 = u.pm * 256 + wr * 64 + fr, col0 = u.pn * 256 + wc * 32 + 8 * fq;
        u16* pbase = proj + ((size_t)blk * MLAT + row0) * 512 + (col0 & 511);
        if ((blk == 0 || blk == 1) && !is_ctx) {
            u16* qrot = (u16*)(ws + OFF_QROT); const float* rope = (const float*)(ws + OFF_ROPE);
            const int f0 = 8 * (fq & 1); const float sgn = (fq >> 1) ? 1.f : -1.f;
#pragma unroll
            for (int ai = 0; ai < 2; ++ai)
#pragma unroll
                for (int m = 0; m < 4; ++m) {
                    const int row = row0 + ai * 128 + m * 16;
                    const int t = row & 4095, pos = (wc & 1) ? (t & 63) : (t >> 6);
                    const float4 c0 = *(const float4*)(rope + pos * 16 + f0), c1 = *(const float4*)(rope + pos * 16 + f0 + 4);
                    const float4 s0 = *(const float4*)(rope + 1024 + pos * 16 + f0), s1 = *(const float4*)(rope + 1024 + pos * 16 + f0 + 4);
                    const float cs[8] = {c0.x, c0.y, c0.z, c0.w, c1.x, c1.y, c1.z, c1.w}, sn[8] = {s0.x, s0.y, s0.z, s0.w, s1.x, s1.y, s1.z, s1.w};
#pragma unroll
                    for (int bj = 0; bj < 2; ++bj) {
                        const f32x4 v0 = acc[ai][bj][m][0], v1 = acc[ai][bj][m][1];
                        const float o[8] = {v0[0], v0[1], v0[2], v0[3], v1[0], v1[1], v1[2], v1[3]};
                        float r[8];
#pragma unroll
                        for (int e = 0; e < 8; ++e) { const float pr = shx(o[e], 32); r[e] = o[e] * cs[e] + sgn * pr * sn[e]; }
                        uint4 wr_; wr_.x = pack2(r[0], r[1]); wr_.y = pack2(r[2], r[3]); wr_.z = pack2(r[4], r[5]); wr_.w = pack2(r[6], r[7]);
                        u16* dst = pbase + (size_t)(ai * 128 + m * 16) * 512 + bj * 128;
                        if (blk == 0) {
                            uint4 wp; wp.x = pack2(o[0], o[1]); wp.y = pack2(o[2], o[3]); wp.z = pack2(o[4], o[5]); wp.w = pack2(o[6], o[7]);
                            nt_store16(wp, dst);
                            nt_store16(wr_, qrot + (size_t)row * 512 + (col0 & 511) + bj * 128);
                        } else nt_store16(wr_, dst);
                    }
                }
        } else if (blk == 11 || blk == 12) {
            float* logf = (float*)(ws + OFF_LOGF); const float* lb = (const float*)(ws + OFF_LB) + l * 1024;
            const int dir = blk - 11;
#pragma unroll
            for (int bj = 0; bj < 2; ++bj) {
                const int cc = (col0 & 511) + bj * 128;
                const float4 l0 = *(const float4*)(lb + dir * 512 + cc), l1 = *(const float4*)(lb + dir * 512 + cc + 4);
                const float lbv[8] = {l0.x, l0.y, l0.z, l0.w, l1.x, l1.y, l1.z, l1.w};
#pragma unroll
                for (int ai = 0; ai < 2; ++ai)
#pragma unroll
                    for (int m = 0; m < 4; ++m) {
                        const int row = row0 + ai * 128 + m * 16;
                        const f32x4 v0 = acc[ai][bj][m][0], v1 = acc[ai][bj][m][1];
                        const float z[8] = {v0[0], v0[1], v0[2], v0[3], v1[0], v1[1], v1[2], v1[3]};
                        float lf[8], o[8];
#pragma unroll
                        for (int e = 0; e < 8; ++e) {
                            const float ez = __expf(-z[e]);
                            const float inv = 1.f / (1.f + ez);
                            const float sg = inv, sgn_ = (ez > 1e30f) ? 1.f : ez * inv;
                            const float f = lbv[e] + (1.f - lbv[e]) * sg;
                            lf[e] = __logf(fmaxf(f, 1e-30f));
                            o[e] = (1.f - lbv[e]) * sgn_;
                        }
                        float* lp = logf + (size_t)row * 1024 + dir * 512 + cc;
                        __builtin_nontemporal_store((f32x4){lf[0], lf[1], lf[2], lf[3]}, (f32x4*)lp); __builtin_nontemporal_store((f32x4){lf[4], lf[5], lf[6], lf[7]}, (f32x4*)(lp + 4));
                        uint4 w; w.x = pack2(o[0], o[1]); w.y = pack2(o[2], o[3]); w.z = pack2(o[4], o[5]); w.w = pack2(o[6], o[7]);
                        nt_store16(w, pbase + (size_t)(ai * 128 + m * 16) * 512 + bj * 128);
                    }
            }
        } else {
            const bool copy = is_ctx && (blk == 1 || blk == 2);
            u16* cbase = (u16*)(ws + OFF_CTXKV) + (size_t)l * MCTX * 1024 + (size_t)row0 * 1024 + (blk - 1) * 512 + (col0 & 511);
            if (!copy) {
#pragma unroll
                for (int ai = 0; ai < 2; ++ai)
#pragma unroll
                    for (int m = 0; m < 4; ++m)
#pragma unroll
                        for (int bj = 0; bj < 2; ++bj) {
                            const f32x4 v0 = acc[ai][bj][m][0], v1 = acc[ai][bj][m][1];
                            uint4 w; w.x = pack2(v0[0], v0[1]); w.y = pack2(v0[2], v0[3]); w.z = pack2(v1[0], v1[1]); w.w = pack2(v1[2], v1[3]);
                            nt_store16(w, pbase + (size_t)(ai * 128 + m * 16) * 512 + bj * 128);
                        }
            } else {
#pragma unroll
                for (int ai = 0; ai < 2; ++ai)
#pragma unroll
                    for (int m = 0; m < 4; ++m)
#pragma unroll
                        for (int bj = 0; bj < 2; ++bj) {
                            const f32x4 v0 = acc[ai][bj][m][0], v1 = acc[ai][bj][m][1];
                            uint4 w; w.x = pack2(v0[0], v0[1]); w.y = pack2(v0[2], v0[3]); w.z = pack2(v1[0], v1[1]); w.w = pack2(v1[2], v1[3]);
                            nt_store16(w, pbase + (size_t)(ai * 128 + m * 16) * 512 + bj * 128);
                            *(uint4*)(cbase + (size_t)(ai * 128 + m * 16) * 1024 + bj * 128) = w;
                        }
            }
        }
    }
};
struct EpiMerge {
    static constexpr bool PERM = false, AFTER_DRAIN = false;
    unsigned char* ws;
    template <int MODE> __device__ __forceinline__ void run(const f32x4 (&acc)[2][2][4][2], const Unit& u, int wr, int wc, int fr, int fq) const {
        const u16* proj = (const u16*)(ws + OFF_PROJ); u16* mb = (u16*)(ws + OFF_MB);
        const int row0 = u.pm * 256 + wr * 64 + fr, col0 = u.pn * 256 + wc * 32 + 4 * fq, R = u.r;
        const int gcol0 = 7680 + R * 1024 + col0;
        const u16* gbase = proj + ((size_t)(gcol0 >> 9) * MLAT + row0) * 512 + (gcol0 & 511);
        u16* obase = mb + (size_t)row0 * 1024 + col0;
        uint2 g[2][8], old[2][8];
#define MG_LOAD(c, buf) do { _Pragma("unroll") for (int q = 0; q < 8; ++q) { const size_t ro_ = (size_t)((c) * 128 + (q >> 2) * 32 + ((c) * 0) + ((q >> 2) & 0)); (void)ro_; } } while (0)
#undef MG_LOAD
#define MG_LOAD(st, buf) do { _Pragma("unroll") for (int q = 0; q < 8; ++q) { const int ai_ = (st) >> 1, m_ = ((st) & 1) * 2 + (q >> 2), co_ = ((q >> 1) & 1) * 128 + (q & 1) * 16; const size_t ro_ = (size_t)(ai_ * 128 + m_ * 16); \
            g[buf][q] = *(const uint2*)(gbase + ro_ * 512 + co_); if (MODE > 0) old[buf][q] = *(const uint2*)(obase + ro_ * 1024 + co_); } } while (0)
        MG_LOAD(0, 0);
#pragma unroll
        for (int st = 0; st < 4; ++st) {
            const int buf = st & 1;
            if (st + 1 < 4) MG_LOAD(st + 1, buf ^ 1);
            __builtin_amdgcn_sched_barrier(0);
#pragma unroll
            for (int q = 0; q < 8; ++q) { const int ai = st >> 1, m = (st & 1) * 2 + (q >> 2), bj = (q >> 1) & 1, n = q & 1, co = bj * 128 + n * 16; const size_t ro = (size_t)(ai * 128 + m * 16);
                f32x4 v = acc[ai][bj][m][n];
                v[0] *= sigmoidf_(bflo(g[buf][q].x)); v[1] *= sigmoidf_(bfhi(g[buf][q].x)); v[2] *= sigmoidf_(bflo(g[buf][q].y)); v[3] *= sigmoidf_(bfhi(g[buf][q].y));
                if (MODE > 0) { v[0] += bflo(old[buf][q].x); v[1] += bfhi(old[buf][q].x); v[2] += bflo(old[buf][q].y); v[3] += bfhi(old[buf][q].y); }
                uint2 w; w.x = pack2(v[0], v[1]); w.y = pack2(v[2], v[3]); *(uint2*)(obase + ro * 1024 + co) = w; }
        }
#undef MG_LOAD
    }
    __device__ __forceinline__ void operator()(const f32x4 (&acc)[2][2][4][2], const Unit& u, int wr, int wc, int fr, int fq) const {
        if (u.r == 0) run<0>(acc, u, wr, wc, fr, fq);
        else run<1>(acc, u, wr, wc, fr, fq);
    }
};
struct EpiOut {
    static constexpr bool PERM = false, AFTER_DRAIN = false;
    float* C;
    __device__ __forceinline__ void operator()(const f32x4 (&acc)[2][2][4][2], const Unit& u, int wr, int wc, int fr, int fq) const {
        const int row0 = u.pm * 256 + wr * 64 + fr, col0 = u.pn * 256 + wc * 32 + 4 * fq;
#pragma unroll
        for (int ai = 0; ai < 2; ++ai)
#pragma unroll
            for (int m = 0; m < 4; ++m) { float* rowp = C + (size_t)(row0 + ai * 128 + m * 16) * 1024 + col0;
#pragma unroll
                for (int bj = 0; bj < 2; ++bj)
#pragma unroll
                    for (int n = 0; n < 2; ++n) *(f32x4*)(rowp + bj * 128 + n * 16) = acc[ai][bj][m][n]; }
    }
};

__device__ void transpose_tile(const float* src, int lds_, u16* dst, int ldd, int k0, int n0s, int n0d, u16* t) {
    const int tid = tidx();
#pragma unroll
    for (int it = 0; it < 2; ++it) {
        const int kk = (tid >> 4) + it * 32, nn = (tid & 15) * 4;
        const float4 v = *(const float4*)(src + (size_t)(k0 + kk) * lds_ + n0s + nn);
        t[(nn + 0) * 72 + kk] = f2bf(v.x); t[(nn + 1) * 72 + kk] = f2bf(v.y); t[(nn + 2) * 72 + kk] = f2bf(v.z); t[(nn + 3) * 72 + kk] = f2bf(v.w);
    }
    __syncthreads();
    { const int n = tid >> 3, k8 = (tid & 7) * 8;
      const uint4 v = *(const uint4*)(t + n * 72 + k8);
      *(uint4*)(dst + (size_t)(n0d + n) * ldd + k0 + k8) = v; }
    __syncthreads();
}

__device__ void prep1(const Params& p, unsigned char* lds) {
    unsigned char* ws = opaque(p.ws);
    const int tid = tidx();
    const size_t gt = (size_t)blockIdx.x * 512 + tid, gn = (size_t)gridDim.x * 512;
    { u16* ws16 = (u16*)(ws + OFF_WS16);
      for (size_t i = gt; i < (size_t)DEPTH * 8 * 128 * 128; i += gn) ws16[i] = f2bf(p.gmlp_ws[i]);
      float* lbp = (float*)(ws + OFF_LB);
      for (size_t i = gt; i < 1024; i += gn) {
          float e[DEPTH], mx = -1e30f, sum = 0.f;
#pragma unroll
          for (int l = 0; l < DEPTH; ++l) { e[l] = p.lb_logits[l * 1024 + i]; mx = fmaxf(mx, e[l]); }
#pragma unroll
          for (int l = 0; l < DEPTH; ++l) { e[l] = expf(e[l] - mx); sum += e[l]; }
          float run = 0.f;
#pragma unroll
          for (int l = 0; l < DEPTH; ++l) { if (l > 0) run += e[l] / sum; lbp[l * 1024 + i] = fmaxf(run, 0.f); }
      }
      float* rope = (float*)(ws + OFF_ROPE);
      for (size_t i = gt; i < 1024; i += gn) { const int pos = (int)(i >> 4), f = (int)(i & 15);
          const float inv = powf(10000.f, -(float)f * 2.0f / 32.0f), ang = (float)pos * inv;
          rope[i] = cosf(ang); rope[1024 + i] = sinf(ang); }
      float* tw = (float*)(ws + OFF_TW);
      for (size_t i = gt; i < 4096; i += gn) { float s, c; sincospif((float)i * (2.0f / 4096.0f), &s, &c); tw[2 * i] = c; tw[2 * i + 1] = s; }
      u16* m1 = (u16*)(ws + OFF_M1);
      for (size_t i = gt; i < 128 * 128; i += gn) { const int ii = (int)(i >> 7), kk = (int)(i & 127), k1 = ii >> 1, po = ii & 1, n1 = kk >> 1, pi = kk & 1;
          float s, c; sincospif((float)((k1 * n1) & 63) * (2.0f / 64.0f), &s, &c);
          const float v = (po == 0) ? (pi == 0 ? c : -s) : (pi == 0 ? -s : -c);
          m1[i] = f2bf(v); }
      u16* m2 = (u16*)(ws + OFF_M2);
      for (size_t i = gt; i < 64 * 128; i += gn) { const int k2 = (int)(i >> 7), kk = (int)(i & 127), n2 = kk >> 1, pi = kk & 1;
          float s, c; sincospif((float)((k2 * n2) & 63) * (2.0f / 64.0f), &s, &c);
          m2[i] = f2bf(pi == 0 ? c : s); }
      u16* m3 = (u16*)(ws + OFF_M3);
      for (size_t i = gt; i < 256 * 512; i += gn) { const int k = (int)(i >> 9), kk = (int)(i & 511), n = kk >> 1, pi = kk & 1;
          float s, c; sincospif((float)((k * n) & 255) * (2.0f / 256.0f), &s, &c);
          m3[i] = f2bf(pi == 0 ? c : -s); }
    }
    constexpr int N_WIN = DEPTH * 176 * 16, N_WBR = 16 * 16 * 8, N_WOUT = DEPTH * 16 * 16, N_MOD = DEPTH * 48, N_CSW = DEPTH * 4 * 2 * 2;
    constexpr int TOT = N_WIN + N_WBR + N_WOUT + N_MOD + N_CSW;
    for (int it = blockIdx.x; it < TOT; it += gridDim.x) {
        int idx = it;
        if (idx < N_WIN) {
            const int l = idx / 2816, rem = idx % 2816, cb = rem >> 4, kb = rem & 15, n0 = cb * 64;
            if (n0 >= 2048 && n0 < 2560) continue;
            const int n0d = n0 < 2048 ? n0 : n0 + 512;
            transpose_tile(p.w_in + (size_t)l * DM * NIN, NIN, (u16*)(ws + OFF_WTIN) + (size_t)l * NPROJ * DM, DM, kb * 64, n0, n0d, (u16*)lds);
            continue;
        }
        idx -= N_WIN;
        if (idx < N_WBR) {
            const int mat = idx >> 7, rem = idx & 127, cb = rem >> 3, kb = rem & 7;
            transpose_tile(p.w_branch + (size_t)mat * 512 * 1024, 1024, (u16*)(ws + OFF_WTBR) + (size_t)mat * 1024 * 512, 512, kb * 64, cb * 64, cb * 64, (u16*)lds);
            continue;
        }
        idx -= N_WBR;
        if (idx < N_WOUT) {
            const int l = idx >> 8, rem = idx & 255, cb = rem >> 4, kb = rem & 15;
            transpose_tile(p.w_out + (size_t)l * 1024 * 1024, 1024, (u16*)(ws + OFF_WTOUT) + (size_t)l * 1024 * 1024, 1024, kb * 64, cb * 64, cb * 64, (u16*)lds);
            continue;
        }
        idx -= N_WOUT;
        if (idx < N_MOD) {
            const int l = idx / 48, cb = idx % 48;
            float* s = (float*)lds; float* red = s + 17 * 1024;
            for (int i = tid; i < 17 * 1024; i += 512) { const int j = i >> 10, k = i & 1023; const float v = j < 16 ? p.c[j * 1024 + k] : p.c_ctx[k]; s[i] = v / (1.f + expf(-v)); }
            __syncthreads();
            const int col = tid & 63, ks = tid >> 6;
            float acc[17];
#pragma unroll
            for (int j = 0; j < 17; ++j) acc[j] = 0.f;
            for (int k = ks * 128; k < ks * 128 + 128; ++k) {
                const float w = p.w_ada[((size_t)l * 1024 + k) * 3072 + cb * 64 + col];
#pragma unroll
                for (int j = 0; j < 17; ++j) acc[j] += s[j * 1024 + k] * w;
            }
#pragma unroll
            for (int j = 0; j < 17; ++j) red[(ks * 17 + j) * 64 + col] = acc[j];
            __syncthreads();
            for (int o = tid; o < 17 * 64; o += 512) { const int j = o >> 6, cc = o & 63; float sum = 0.f;
                for (int q = 0; q < 8; ++q) sum += red[(q * 17 + j) * 64 + cc];
                ((float*)(ws + OFF_MOD))[((size_t)l * 17 + j) * 3072 + cb * 64 + cc] = sum + p.b_ada[l * 3072 + cb * 64 + cc]; }
            __syncthreads();
            continue;
        }
        idx -= N_MOD;
        {
            const int cblk = idx & 1, part = (idx >> 1) & 1, g = (idx >> 2) & 3, l = idx >> 4;
            float* tb = (float*)lds;
            if (tid < 128) { float s, c; sincospif((float)tid * (2.0f / 128.0f), &s, &c); tb[tid] = part ? s : c; }
            __syncthreads();
            const int d = tid & 127, cq = tid >> 7;
            float acc[16];
#pragma unroll
            for (int i = 0; i < 16; ++i) acc[i] = 0.f;
            const float* wf = p.fnet_w + ((size_t)(l * 4 + g) * 128) * 128;
            for (int c2 = 0; c2 < 128; ++c2) {
                const float w = wf[c2 * 128 + d];
#pragma unroll
                for (int i = 0; i < 16; ++i) { const int c = cblk * 64 + cq * 16 + i; acc[i] += tb[(c * c2) & 127] * w; }
            }
            float* dst = (float*)(ws + OFF_CSW) + ((size_t)((l * 4 + g) * 2 + part) * 128) * 128;
#pragma unroll
            for (int i = 0; i < 16; ++i) dst[(cblk * 64 + cq * 16 + i) * 128 + d] = acc[i];
            __syncthreads();
        }
    }
}

__device__ void prep2(const Params& p, unsigned char* lds) {
    unsigned char* ws = opaque(p.ws);
    const int tid = tidx();
    float* wb = (float*)lds;
    float* cw = wb + 64 * 129;
    for (int it = blockIdx.x; it < DEPTH * 4 * 2 * 16; it += gridDim.x) {
        const int kb = it & 15, part = (it >> 4) & 1, g = (it >> 5) & 3, l = it >> 7;
        for (int i = tid; i < 64 * 128; i += 512) { const int kk = i >> 7, c = i & 127; wb[kk * 129 + c] = p.w_in[((size_t)l * 1024 + kb * 64 + kk) * NIN + 2048 + g * 128 + c]; }
        const float* src = (const float*)(ws + OFF_CSW) + ((size_t)((l * 4 + g) * 2 + part) * 128) * 128;
        for (int i = tid; i < 128 * 128; i += 512) cw[i] = src[i];
        __syncthreads();
        const int d = tid & 127, kq = tid >> 7;
        float acc[16];
#pragma unroll
        for (int i = 0; i < 16; ++i) acc[i] = 0.f;
        for (int c = 0; c < 128; ++c) {
            const float w = cw[c * 128 + d];
#pragma unroll
            for (int i = 0; i < 16; ++i) acc[i] += wb[(kq * 16 + i) * 129 + c] * w;
        }
        u16* dst = (u16*)(ws + OFF_WTIN) + ((size_t)l * NPROJ + (4 + part) * 512 + g * 128 + d) * DM + kb * 64 + kq * 16;
        uint4 w0, w1;
        w0.x = pack2(acc[0], acc[1]); w0.y = pack2(acc[2], acc[3]); w0.z = pack2(acc[4], acc[5]); w0.w = pack2(acc[6], acc[7]);
        w1.x = pack2(acc[8], acc[9]); w1.y = pack2(acc[10], acc[11]); w1.z = pack2(acc[12], acc[13]); w1.w = pack2(acc[14], acc[15]);
        *(uint4*)dst = w0; *(uint4*)(dst + 8) = w1;
        __syncthreads();
    }
}

__device__ void phase_norm(const Params& p, const PassInfo ps, int l) {
    unsigned char* ws = opaque(p.ws);
    const int wave = tidx() >> 6, lane = tidx() & 63;
    const float* mod = (const float*)(ws + OFF_MOD);
    const float* OUT = (const float*)(ws + OFF_OUT);
    u16* H = (u16*)(ws + OFF_H);
    for (int rr = blockIdx.x * 8 + wave; rr < ps.M; rr += gridDim.x * 8) {
        const int tsh = ps.is_ctx ? 8 : 12; const int b = ps.b0 + (rr >> tsh), t = rr & (ps.T - 1), mrow = ps.is_ctx ? 16 : b;
        const size_t xoff = ((size_t)b * ps.T + t) * 1024;
        const float* xin = (l <= 1) ? ((ps.is_ctx ? p.ctx : p.x) + xoff) : ((ps.is_ctx ? (const float*)(ws + OFF_CTXW) : (const float*)p.out) + xoff);
        float* xout = (ps.is_ctx ? (float*)(ws + OFF_CTXW) : p.out) + xoff;
        float xv[16];
#pragma unroll
        for (int hlf = 0; hlf < 2; ++hlf) {
            const int c0 = hlf * 512 + lane * 8;
            const float4 a = *(const float4*)(xin + c0), bq = *(const float4*)(xin + c0 + 4);
            xv[hlf * 8 + 0] = a.x; xv[hlf * 8 + 1] = a.y; xv[hlf * 8 + 2] = a.z; xv[hlf * 8 + 3] = a.w;
            xv[hlf * 8 + 4] = bq.x; xv[hlf * 8 + 5] = bq.y; xv[hlf * 8 + 6] = bq.z; xv[hlf * 8 + 7] = bq.w;
        }
        if (l > 0) {
            float ov[16]; float ss = 0.f;
#pragma unroll
            for (int hlf = 0; hlf < 2; ++hlf) {
                const int c0 = hlf * 512 + lane * 8;
                const float4 a = *(const float4*)(OUT + (size_t)rr * 1024 + c0), bq = *(const float4*)(OUT + (size_t)rr * 1024 + c0 + 4);
                ov[hlf * 8 + 0] = a.x; ov[hlf * 8 + 1] = a.y; ov[hlf * 8 + 2] = a.z; ov[hlf * 8 + 3] = a.w;
                ov[hlf * 8 + 4] = bq.x; ov[hlf * 8 + 5] = bq.y; ov[hlf * 8 + 6] = bq.z; ov[hlf * 8 + 7] = bq.w;
            }
#pragma unroll
            for (int e = 0; e < 16; ++e) ss += ov[e] * ov[e];
#pragma unroll
            for (int o = 32; o > 0; o >>= 1) ss += shx(ss, o);
            const float rstd = rsqrtf(ss * (1.f / 1024.f) + EPSN);
            const float* gt = mod + ((size_t)(l - 1) * 17 + mrow) * 3072 + 2048;
            const float* gp = p.g_post + (l - 1) * 1024;
#pragma unroll
            for (int hlf = 0; hlf < 2; ++hlf) {
                const int c0 = hlf * 512 + lane * 8;
#pragma unroll
                for (int e = 0; e < 8; ++e) xv[hlf * 8 + e] += gt[c0 + e] * (ov[hlf * 8 + e] * rstd * gp[c0 + e]);
                *(float4*)(xout + c0) = make_float4(xv[hlf * 8 + 0], xv[hlf * 8 + 1], xv[hlf * 8 + 2], xv[hlf * 8 + 3]);
                *(float4*)(xout + c0 + 4) = make_float4(xv[hlf * 8 + 4], xv[hlf * 8 + 5], xv[hlf * 8 + 6], xv[hlf * 8 + 7]);
            }
        }
        if (l < DEPTH) {
            float ss = 0.f;
#pragma unroll
            for (int e = 0; e < 16; ++e) ss += xv[e] * xv[e];
#pragma unroll
            for (int o = 32; o > 0; o >>= 1) ss += shx(ss, o);
            const float rstd = rsqrtf(ss * (1.f / 1024.f) + EPSN);
            const float* sh = mod + ((size_t)l * 17 + mrow) * 3072; const float* sc = sh + 1024;
            const float* gp = p.g_pre + l * 1024;
#pragma unroll
            for (int hlf = 0; hlf < 2; ++hlf) {
                const int c0 = hlf * 512 + lane * 8;
                float hv[8];
#pragma unroll
                for (int e = 0; e < 8; ++e) hv[e] = xv[hlf * 8 + e] * rstd * gp[c0 + e] * (1.f + sc[c0 + e]) + sh[c0 + e];
                uint4 w; w.x = pack2(hv[0], hv[1]); w.y = pack2(hv[2], hv[3]); w.z = pack2(hv[4], hv[5]); w.w = pack2(hv[6], hv[7]);
                *(uint4*)(H + (size_t)rr * 1024 + c0) = w;
            }
        }
    }
}

#define PJ(row, blk, c) (PROJ + ((size_t)(blk) * MLAT + (row)) * 512 + (c))
typedef unsigned u32x32_ __attribute__((ext_vector_type(32)));
struct Reg8 {
    u32x32_ v;
    __device__ __forceinline__ void ld(int i, const void* p) { const u32x4_ a = *(const u32x4_*)p; v[4 * i] = a[0]; v[4 * i + 1] = a[1]; v[4 * i + 2] = a[2]; v[4 * i + 3] = a[3]; }
    __device__ __forceinline__ u32x4_ get(int i) const { return (u32x4_){v[4 * i], v[4 * i + 1], v[4 * i + 2], v[4 * i + 3]}; }
    __device__ __forceinline__ uint4 getu(int i) const { uint4 r; r.x = v[4 * i]; r.y = v[4 * i + 1]; r.z = v[4 * i + 2]; r.w = v[4 * i + 3]; return r; }
};
#define MEMBAR() asm volatile("" ::: "memory")
constexpr int KVS = 72;
constexpr int TS = 528;
constexpr int T3S = 136;
constexpr int HS_ = 68;
constexpr float NORM_LAT = 0.0013810679320049757f;
constexpr float NORM_CTX = 0.005524271728019903f;

__device__ void attn_item(const Params& p, const PassInfo ps, int l, int item, unsigned char* lds) {
    unsigned char* ws = opaque(p.ws);
    const u16* PROJ = (const u16*)(ws + OFF_PROJ); const u16* QROT = (const u16*)(ws + OFF_QROT);
    const u16* CKV = (const u16*)(ws + OFF_CTXKV) + (size_t)l * MCTX * 1024;
    u16* Y0 = (u16*)(ws + OFF_Y);
    const int tid = tidx(), w = tid >> 6, lane = tid & 63, qtr = w & 3, kh = w >> 2, li = lane & 15, quad = lane >> 4;
    u16* Kl = (u16*)lds; u16* Vl = Kl + 512 * KVS; float* rp = (float*)(Vl + 512 * KVS);
    int bl, h, r = 0, qrow0, bglob;
    if (!ps.is_ctx) { r = item & 63; h = (item >> 6) & 7; bl = item >> 9; qrow0 = bl * 4096 + r * 64; bglob = ps.b0 + bl; }
    else { const int qb = item & 3; h = (item >> 2) & 7; bl = item >> 5; qrow0 = bl * 256 + qb * 64; bglob = bl; }
    const int qrow = qrow0 + qtr * 16 + li;
    float m_run = -1e30f, l_run = 0.f;
    f32x4 O[4];
#pragma unroll
    for (int d = 0; d < 4; ++d) O[d] = (f32x4){0.f, 0.f, 0.f, 0.f};
    if (!ps.is_ctx) {
        const int rs = min(max(r - 4, 0), 56);
        const size_t krow0 = (size_t)bl * 4096 + rs * 64;
        { u32x32_ kr, vr;
#pragma unroll
          for (int i = 0; i < 8; ++i) { const int idx = tid + 512 * i, key = idx >> 3, ch = idx & 7;
              const u32x4_ a = *(const u32x4_*)(PJ(krow0 + key, 1, h * 64 + ch * 8)), b = *(const u32x4_*)(PJ(krow0 + key, 2, h * 64 + ch * 8));
              kr[4 * i] = a[0]; kr[4 * i + 1] = a[1]; kr[4 * i + 2] = a[2]; kr[4 * i + 3] = a[3]; vr[4 * i] = b[0]; vr[4 * i + 1] = b[1]; vr[4 * i + 2] = b[2]; vr[4 * i + 3] = b[3]; }
          asm volatile("" ::: "memory");
#pragma unroll
          for (int i = 0; i < 8; ++i) { const int idx = tid + 512 * i, key = idx >> 3, ch = idx & 7;
              *(u32x4_*)(Kl + key * KVS + ch * 8) = (u32x4_){kr[4 * i], kr[4 * i + 1], kr[4 * i + 2], kr[4 * i + 3]}; *(u32x4_*)(Vl + key * KVS + ch * 8) = (u32x4_){vr[4 * i], vr[4 * i + 1], vr[4 * i + 2], vr[4 * i + 3]}; } }
        for (int i = tid; i < 465; i += 512) rp[i] = p.rpb[((size_t)l * 8 + h) * 465 + i];
        __syncthreads();
        const int cbase = (qtr == 0) ? 0 : (qtr == 1 ? 8 : (qtr == 2 ? 24 : 32));
        const bf16x8 q0 = ld_frag_g(QROT + (size_t)qrow * 512 + h * 64 + quad * 8), q1 = ld_frag_g(QROT + (size_t)qrow * 512 + h * 64 + 32 + quad * 8);
        const int qc = qtr * 16 + li, cst = min(max(qc - 8, 0), 48);
        float s[8][4];
        float mx = -1e30f;
#pragma unroll
        for (int sb = 0; sb < 8; ++sb) {
            const int i = kh * 4 + (sb >> 1), cs = sb & 1;
            const u16* kp = Kl + (i * 64 + cbase + cs * 16 + li) * KVS + quad * 8;
            f32x4 a = (f32x4){0.f, 0.f, 0.f, 0.f};
            a = MFMA16(*(const bf16x8*)kp, q0, a); a = MFMA16(*(const bf16x8*)(kp + 32), q1, a);
            const int ridx = rs + i - r + 7;
#pragma unroll
            for (int j = 0; j < 4; ++j) { const int kc = cbase + cs * 16 + quad * 4 + j;
                const bool valid = (kc >= cst) && (kc < cst + 16);
                const int cidx = min(max(kc - qc + 15, 0), 30);
                const float v = valid ? (a[j] * 0.125f + rp[ridx * 31 + cidx]) : -1e30f;
                s[sb][j] = v; mx = fmaxf(mx, v); }
        }
        mx = fmaxf(mx, shx(mx, 16)); mx = fmaxf(mx, shx(mx, 32));
        m_run = mx;
        float ls = 0.f;
#pragma unroll
        for (int sb = 0; sb < 8; ++sb)
#pragma unroll
            for (int j = 0; j < 4; ++j) { const float e = __expf(s[sb][j] - mx); s[sb][j] = e; ls += e; }
        ls += shx(ls, 16); ls += shx(ls, 32);
        l_run = ls;
#pragma unroll
        for (int kp2 = 0; kp2 < 4; ++kp2) {
            bf16x8 pf; { const unsigned a0 = pack2(s[2 * kp2][0], s[2 * kp2][1]), a1 = pack2(s[2 * kp2][2], s[2 * kp2][3]), b0 = pack2(s[2 * kp2 + 1][0], s[2 * kp2 + 1][1]), b1 = pack2(s[2 * kp2 + 1][2], s[2 * kp2 + 1][3]);
                pf = (bf16x8){(short)(a0 & 0xffff), (short)(a0 >> 16), (short)(a1 & 0xffff), (short)(a1 >> 16), (short)(b0 & 0xffff), (short)(b0 >> 16), (short)(b1 & 0xffff), (short)(b1 >> 16)}; }
            const int vrow0 = (kh * 4 + kp2) * 64 + cbase + quad * 4 + (li >> 2);
#pragma unroll
            for (int d = 0; d < 4; ++d) {
                const u16* vp = Vl + vrow0 * KVS + d * 16 + 4 * (li & 3);
                const bf16x8 vf = tr_read2(vp, vp + 16 * KVS);
                O[d] = MFMA16(vf, pf, O[d]);
            }
        }
        __syncthreads();
    }
    {
        const size_t crow0 = (size_t)bglob * 256;
        { Reg8 rg;
#pragma unroll
          for (int i = 0; i < 4; ++i) { const int idx = tid + 512 * i, key = idx >> 3, ch = idx & 7;
              rg.ld(2 * i, CKV + (crow0 + key) * 1024 + h * 64 + ch * 8); rg.ld(2 * i + 1, CKV + (crow0 + key) * 1024 + 512 + h * 64 + ch * 8); }
          MEMBAR();
#pragma unroll
          for (int i = 0; i < 4; ++i) { const int idx = tid + 512 * i, key = idx >> 3, ch = idx & 7;
              *(u32x4_*)(Kl + key * KVS + ch * 8) = rg.get(2 * i); *(u32x4_*)(Vl + key * KVS + ch * 8) = rg.get(2 * i + 1); } }
        __syncthreads();
        const bf16x8 q0 = ld_frag_g(PJ(qrow, 0, h * 64 + quad * 8)), q1 = ld_frag_g(PJ(qrow, 0, h * 64 + 32 + quad * 8));
        float s[8][4];
        float mx = -1e30f;
#pragma unroll
        for (int sb = 0; sb < 8; ++sb) {
            const u16* kp = Kl + (kh * 128 + sb * 16 + li) * KVS + quad * 8;
            f32x4 a = (f32x4){0.f, 0.f, 0.f, 0.f};
            a = MFMA16(*(const bf16x8*)kp, q0, a); a = MFMA16(*(const bf16x8*)(kp + 32), q1, a);
#pragma unroll
            for (int j = 0; j < 4; ++j) { const float v = a[j] * 0.125f; s[sb][j] = v; mx = fmaxf(mx, v); }
        }
        mx = fmaxf(mx, shx(mx, 16)); mx = fmaxf(mx, shx(mx, 32));
        const float m_new = fmaxf(m_run, mx), resc = __expf(m_run - m_new);
        float ls = 0.f;
#pragma unroll
        for (int sb = 0; sb < 8; ++sb)
#pragma unroll
            for (int j = 0; j < 4; ++j) { const float e = __expf(s[sb][j] - m_new); s[sb][j] = e; ls += e; }
        ls += shx(ls, 16); ls += shx(ls, 32);
        l_run = l_run * resc + ls; m_run = m_new;
#pragma unroll
        for (int d = 0; d < 4; ++d) O[d] *= resc;
#pragma unroll
        for (int kp2 = 0; kp2 < 4; ++kp2) {
            bf16x8 pf; { const unsigned a0 = pack2(s[2 * kp2][0], s[2 * kp2][1]), a1 = pack2(s[2 * kp2][2], s[2 * kp2][3]), b0 = pack2(s[2 * kp2 + 1][0], s[2 * kp2 + 1][1]), b1 = pack2(s[2 * kp2 + 1][2], s[2 * kp2 + 1][3]);
                pf = (bf16x8){(short)(a0 & 0xffff), (short)(a0 >> 16), (short)(a1 & 0xffff), (short)(a1 >> 16), (short)(b0 & 0xffff), (short)(b0 >> 16), (short)(b1 & 0xffff), (short)(b1 >> 16)}; }
            const int vrow0 = kh * 128 + kp2 * 32 + quad * 4 + (li >> 2);
#pragma unroll
            for (int d = 0; d < 4; ++d) {
                const u16* vp = Vl + vrow0 * KVS + d * 16 + 4 * (li & 3);
                const bf16x8 vf = tr_read2(vp, vp + 16 * KVS);
                O[d] = MFMA16(vf, pf, O[d]);
            }
        }
        __syncthreads();
    }
    float* cb = (float*)lds;
    if (kh == 1) {
#pragma unroll
        for (int d = 0; d < 4; ++d)
#pragma unroll
            for (int j = 0; j < 4; ++j) cb[(qtr * 18 + d * 4 + j) * 64 + lane] = O[d][j];
        cb[(qtr * 18 + 16) * 64 + lane] = m_run; cb[(qtr * 18 + 17) * 64 + lane] = l_run;
    }
    __syncthreads();
    if (kh == 0) {
        const float m2 = cb[(qtr * 18 + 16) * 64 + lane], l2 = cb[(qtr * 18 + 17) * 64 + lane];
        const float mm = fmaxf(m_run, m2), e1 = __expf(m_run - mm), e2 = __expf(m2 - mm);
        const float inv = 1.f / (l_run * e1 + l2 * e2);
#pragma unroll
        for (int d = 0; d < 4; ++d) {
            const int col = h * 64 + d * 16 + quad * 4;
            const uint2 g = *(const uint2*)(PJ(qrow, 3, col));
            float o[4];
#pragma unroll
            for (int j = 0; j < 4; ++j) o[j] = (O[d][j] * e1 + cb[(qtr * 18 + d * 4 + j) * 64 + lane] * e2) * inv;
            uint2 wv; wv.x = pack2(o[0] * siluf_(bflo(g.x)), o[1] * siluf_(bfhi(g.x))); wv.y = pack2(o[2] * siluf_(bflo(g.y)), o[3] * siluf_(bfhi(g.y)));
            *(uint2*)(Y0 + (size_t)qrow * 512 + col) = wv;
        }
    }
    __syncthreads();
}

template <int ROWS, int CPR> __device__ __forceinline__ void load_tile(u16* dstl, int lstride, const u16* src, size_t sstride) {
    constexpr int PER = ROWS * CPR / 512;
    static_assert(PER % 8 == 0, "tile size");
    const int tid_ = tidx();
#pragma unroll
    for (int b8 = 0; b8 < PER / 8; ++b8) { Reg8 rg;
#pragma unroll
        for (int j = 0; j < 8; ++j) { const int i = tid_ + 512 * (b8 * 8 + j), r = i / CPR, ch = i % CPR; rg.ld(j, src + (size_t)r * sstride + ch * 8); }
        MEMBAR();
#pragma unroll
        for (int j = 0; j < 8; ++j) { const int i = tid_ + 512 * (b8 * 8 + j), r = i / CPR, ch = i % CPR; *(u32x4_*)(dstl + r * lstride + ch * 8) = rg.get(j); }
        MEMBAR(); }
}

__device__ void four1_item(const Params& p, int item, unsigned char* lds) {
    unsigned char* ws = opaque(p.ws);
    const u16* PROJ = (const u16*)(ws + OFF_PROJ); const u16* M1 = (const u16*)(ws + OFF_M1); const float* TW = (const float*)(ws + OFF_TW);
    u16* FY = (u16*)(ws + OFF_FY);
    const int tid = tidx(), w = tid >> 6, lane = tid & 63, li = lane & 15, quad = lane >> 4;
    const int n2 = item & 63, bl = item >> 6;
    u16* T = (u16*)lds;
#pragma unroll
    for (int b8 = 0; b8 < 2; ++b8) { Reg8 rg;
#pragma unroll
        for (int j = 0; j < 8; ++j) { const int i = tid + 512 * (b8 * 8 + j), kk = i >> 6, ch = i & 63, n1 = kk >> 1, part = kk & 1;
            rg.ld(j, PJ((size_t)bl * 4096 + n1 * 64 + n2, 4 + part, ch * 8)); }
        MEMBAR();
#pragma unroll
        for (int j = 0; j < 8; ++j) { const int i = tid + 512 * (b8 * 8 + j), kk = i >> 6, ch = i & 63;
            *(u32x4_*)(T + kk * TS + ch * 8) = rg.get(j); }
        MEMBAR(); }
    __syncthreads();
    for (int isub = 0; isub < 8; ++isub) {
        bf16x8 xf[4];
#pragma unroll
        for (int ks = 0; ks < 4; ++ks) xf[ks] = ld_frag_g(M1 + (isub * 16 + li) * 128 + ks * 32 + quad * 8);
#pragma unroll
        for (int cs = 0; cs < 4; ++cs) {
            const int c0 = w * 64 + cs * 16;
            f32x4 a = (f32x4){0.f, 0.f, 0.f, 0.f};
#pragma unroll
            for (int ks = 0; ks < 4; ++ks) {
                const u16* tp = T + (ks * 32 + quad * 8 + (li >> 2)) * TS + c0 + 4 * (li & 3);
                a = MFMA16(xf[ks], tr_read2(tp, tp + 4 * TS), a);
            }
            const int ch = c0 + li;
#pragma unroll
            for (int hh = 0; hh < 2; ++hh) {
                const int k1 = isub * 8 + quad * 2 + hh;
                const float yr = a[2 * hh], yi = a[2 * hh + 1];
                const float tc = TW[2 * (n2 * k1)], tsn = TW[2 * (n2 * k1) + 1];
                const float orr = yr * tc + yi * tsn, oi = yi * tc - yr * tsn;
                u16* dst = FY + (((size_t)bl * 64 + k1) * 64 + n2) * 1024 + ch;
                dst[0] = f2bf(orr); dst[512] = f2bf(oi);
            }
        }
    }
    __syncthreads();
}

__device__ void four2_item(const Params& p, int item, unsigned char* lds) {
    unsigned char* ws = opaque(p.ws);
    const u16* PROJ = (const u16*)(ws + OFF_PROJ); const u16* M2 = (const u16*)(ws + OFF_M2); const u16* FY = (const u16*)(ws + OFF_FY);
    u16* Y1 = (u16*)(ws + OFF_Y) + (size_t)1 * MLAT * 512;
    const int tid = tidx(), w = tid >> 6, lane = tid & 63, li = lane & 15, quad = lane >> 4;
    const int k1 = item & 63, bl = item >> 6;
    u16* T = (u16*)lds;
    load_tile<128, 64>(T, TS, FY + ((size_t)bl * 64 + k1) * 64 * 1024, 512);
    __syncthreads();
    bf16x8 xf[4][4];
#pragma unroll
    for (int cs = 0; cs < 4; ++cs)
#pragma unroll
        for (int ks = 0; ks < 4; ++ks) { const u16* tp = T + (ks * 32 + quad * 8 + (li >> 2)) * TS + w * 64 + cs * 16 + 4 * (li & 3); xf[cs][ks] = tr_read2(tp, tp + 4 * TS); }
    for (int k2s = 0; k2s < 4; ++k2s) {
        bf16x8 yf[4];
#pragma unroll
        for (int ks = 0; ks < 4; ++ks) yf[ks] = ld_frag_g(M2 + (k2s * 16 + li) * 128 + ks * 32 + quad * 8);
        const int k2 = k2s * 16 + li;
        const size_t row = (size_t)bl * 4096 + k1 + 64 * k2;
#pragma unroll
        for (int cs = 0; cs < 4; ++cs) {
            f32x4 a = (f32x4){0.f, 0.f, 0.f, 0.f};
#pragma unroll
            for (int ks = 0; ks < 4; ++ks) a = MFMA16(xf[cs][ks], yf[ks], a);
            const int ch = w * 64 + cs * 16 + quad * 4;
            const uint2 g = *(const uint2*)(PJ(row, 6, ch));
            uint2 wv; wv.x = pack2(a[0] * NORM_LAT * siluf_(bflo(g.x)), a[1] * NORM_LAT * siluf_(bfhi(g.x))); wv.y = pack2(a[2] * NORM_LAT * siluf_(bflo(g.y)), a[3] * NORM_LAT * siluf_(bfhi(g.y)));
            *(uint2*)(Y1 + row * 512 + ch) = wv;
        }
    }
    __syncthreads();
}

__device__ void fourc_item(const Params& p, int item, unsigned char* lds) {
    unsigned char* ws = opaque(p.ws);
    const u16* PROJ = (const u16*)(ws + OFF_PROJ); const u16* M3 = (const u16*)(ws + OFF_M3);
    u16* Y1 = (u16*)(ws + OFF_Y) + (size_t)1 * MLAT * 512;
    const int tid = tidx(), w = tid >> 6, lane = tid & 63, li = lane & 15, quad = lane >> 4;
    const int chb = item & 3, b = item >> 2;
    u16* T = (u16*)lds;
#pragma unroll
    for (int b8 = 0; b8 < 2; ++b8) { Reg8 rg;
#pragma unroll
        for (int j = 0; j < 8; ++j) { const int i = tid + 512 * (b8 * 8 + j), kk = i >> 4, ch = i & 15, n = kk >> 1, part = kk & 1;
            rg.ld(j, PJ((size_t)b * 256 + n, 4 + part, chb * 128 + ch * 8)); }
        MEMBAR();
#pragma unroll
        for (int j = 0; j < 8; ++j) { const int i = tid + 512 * (b8 * 8 + j), kk = i >> 4, ch = i & 15;
            *(u32x4_*)(T + kk * T3S + ch * 8) = rg.get(j); }
        MEMBAR(); }
    __syncthreads();
    for (int kq = 0; kq < 2; ++kq) {
        const int ksub = w * 2 + kq;
        f32x4 a[8];
#pragma unroll
        for (int cs = 0; cs < 8; ++cs) a[cs] = (f32x4){0.f, 0.f, 0.f, 0.f};
        for (int ks = 0; ks < 16; ++ks) {
            const bf16x8 yf = ld_frag_g(M3 + (ksub * 16 + li) * 512 + ks * 32 + quad * 8);
#pragma unroll
            for (int cs = 0; cs < 8; ++cs) { const u16* tp = T + (ks * 32 + quad * 8 + (li >> 2)) * T3S + cs * 16 + 4 * (li & 3);
                a[cs] = MFMA16(tr_read2(tp, tp + 4 * T3S), yf, a[cs]); }
        }
        const size_t row = (size_t)b * 256 + ksub * 16 + li;
#pragma unroll
        for (int cs = 0; cs < 8; ++cs) {
            const int ch = chb * 128 + cs * 16 + quad * 4;
            const uint2 g = *(const uint2*)(PJ(row, 6, ch));
            uint2 wv; wv.x = pack2(a[cs][0] * NORM_CTX * siluf_(bflo(g.x)), a[cs][1] * NORM_CTX * siluf_(bfhi(g.x))); wv.y = pack2(a[cs][2] * NORM_CTX * siluf_(bflo(g.y)), a[cs][3] * NORM_CTX * siluf_(bfhi(g.y)));
            *(uint2*)(Y1 + row * 512 + ch) = wv;
        }
    }
    __syncthreads();
}

__device__ void gmlp_item(const Params& p, int l, int item, unsigned char* lds) {
    unsigned char* ws = opaque(p.ws);
    const u16* PROJ = (const u16*)(ws + OFF_PROJ); const u16* WS16 = (const u16*)(ws + OFF_WS16) + (size_t)l * 8 * 128 * 128;
    u16* Y2 = (u16*)(ws + OFF_Y) + (size_t)2 * MLAT * 512;
    const int tid = tidx(), w = tid >> 6, lane = tid & 63, li = lane & 15, quad = lane >> 4;
    const size_t r0 = (size_t)item * 128;
    u16* VN = (u16*)lds;
    {
        const int row = tid >> 2, qd = tid & 3;
        const u16* src = PJ(r0 + row, 8, 0);
        uint4 raw[16]; float ss = 0.f;
#pragma unroll
        for (int i = 0; i < 16; ++i) { raw[i] = *(const uint4*)(src + (qd + 4 * i) * 8); float f[8]; unpack8(raw[i], f);
#pragma unroll
            for (int e = 0; e < 8; ++e) ss += f[e] * f[e]; }
        ss += shx(ss, 1); ss += shx(ss, 2);
        const float rstd = rsqrtf(ss * (1.f / 512.f) + EPSN);
        const float* gn = p.gmlp_g + l * 512;
#pragma unroll
        for (int i = 0; i < 16; ++i) { float f[8]; unpack8(raw[i], f); const int c0 = (qd + 4 * i) * 8;
            const float4 g0 = *(const float4*)(gn + c0), g1 = *(const float4*)(gn + c0 + 4);
            uint4 o; o.x = pack2(f[0] * rstd * g0.x, f[1] * rstd * g0.y); o.y = pack2(f[2] * rstd * g0.z, f[3] * rstd * g0.w);
            o.z = pack2(f[4] * rstd * g1.x, f[5] * rstd * g1.y); o.w = pack2(f[6] * rstd * g1.z, f[7] * rstd * g1.w);
            *(uint4*)(VN + row * TS + c0) = o; }
    }
    __syncthreads();
    const int g = w;
    bf16x8 xf[4][4];
#pragma unroll
    for (int cs = 0; cs < 4; ++cs)
#pragma unroll
        for (int ks = 0; ks < 4; ++ks) { const u16* tp = VN + (ks * 32 + quad * 8 + (li >> 2)) * TS + g * 64 + cs * 16 + 4 * (li & 3); xf[cs][ks] = tr_read2(tp, tp + 4 * TS); }
    for (int ts = 0; ts < 8; ++ts) {
        bf16x8 yf[4];
#pragma unroll
        for (int ks = 0; ks < 4; ++ks) yf[ks] = ld_frag_g(WS16 + ((size_t)g * 128 + ts * 16 + li) * 128 + ks * 32 + quad * 8);
        const int t = ts * 16 + li;
        const float bs = p.gmlp_bs[((size_t)l * 8 + g) * 128 + t];
        const size_t row = r0 + t;
#pragma unroll
        for (int cs = 0; cs < 4; ++cs) {
            f32x4 a = (f32x4){0.f, 0.f, 0.f, 0.f};
#pragma unroll
            for (int ks = 0; ks < 4; ++ks) a = MFMA16(xf[cs][ks], yf[ks], a);
            const int c = g * 64 + cs * 16 + quad * 4;
            const uint2 uu = *(const uint2*)(PJ(row, 7, c)), gg = *(const uint2*)(PJ(row, 9, c));
            uint2 wv; wv.x = pack2(bflo(uu.x) * (a[0] + bs) * siluf_(bflo(gg.x)), bfhi(uu.x) * (a[1] + bs) * siluf_(bfhi(gg.x)));
            wv.y = pack2(bflo(uu.y) * (a[2] + bs) * siluf_(bflo(gg.y)), bfhi(uu.y) * (a[3] + bs) * siluf_(bfhi(gg.y)));
            *(uint2*)(Y2 + row * 512 + c) = wv;
        }
    }
    __syncthreads();
}

__device__ __forceinline__ void chunk_cumsum(float* A, float* tmp, int dir) {
    const int k = tidx() & 63, seg = tidx() >> 6;
    float v[8]; float run = 0.f;
    if (dir == 0) {
#pragma unroll
        for (int e = 0; e < 8; ++e) { run += A[(seg * 8 + e) * HS_ + k]; v[e] = run; }
    } else {
#pragma unroll
        for (int e = 7; e >= 0; --e) { run += A[(seg * 8 + e) * HS_ + k]; v[e] = run; }
    }
    tmp[seg * 64 + k] = run;
    __syncthreads();
    float off = 0.f;
#pragma unroll
    for (int s2 = 0; s2 < 8; ++s2) { const float tv = tmp[s2 * 64 + k]; if (dir == 0 ? (s2 < seg) : (s2 > seg)) off += tv; }
#pragma unroll
    for (int e = 0; e < 8; ++e) A[(seg * 8 + e) * HS_ + k] = (v[e] + off) * LOG2E;
    __syncthreads();
}
__device__ __forceinline__ void load_bf_tile64(float* dst, const u16* src  , size_t sstride) {
    const int t = tidx() >> 3, k8 = (tidx() & 7) * 8;
    float f[8]; unpack8(*(const uint4*)(src + (size_t)t * sstride + k8), f);
    *(float4*)(dst + t * HS_ + k8) = make_float4(f[0], f[1], f[2], f[3]); *(float4*)(dst + t * HS_ + k8 + 4) = make_float4(f[4], f[5], f[6], f[7]);
}
__device__ __forceinline__ void load_f32_tile64(float* dst, const float* src, size_t sstride) {
    const int t = tidx() >> 3, k8 = (tidx() & 7) * 8;
    *(float4*)(dst + t * HS_ + k8) = *(const float4*)(src + (size_t)t * sstride + k8); *(float4*)(dst + t * HS_ + k8 + 4) = *(const float4*)(src + (size_t)t * sstride + k8 + 4);
}

__device__ void hgrn1_item(const Params& p, const PassInfo ps, int item, unsigned char* lds) {
    unsigned char* ws = opaque(p.ws);
    const u16* PROJ = (const u16*)(ws + OFF_PROJ); const float* LOGF = (const float*)(ws + OFF_LOGF);
    float* HL = (float*)(ws + OFF_HL); float* HD = (float*)(ws + OFF_HD);
    const int NC = ps.T >> 6, ncsh = ps.is_ctx ? 2 : 6, c = item & (NC - 1), ci = item >> ncsh, dir = ci & 1, h = (ci >> 1) & 7, bl = ci >> 4;
    const size_t r0 = (size_t)bl * ps.T + c * 64;
    float* A = (float*)lds; float* KK = A + 64 * HS_; float* I = KK + 64 * HS_; float* tmp = I + 64 * HS_;
    const int tid = tidx();
    { const int t = tid >> 3, k8 = (tid & 7) * 8;
      Reg8 rg;
      const float* ap = LOGF + (r0 + t) * 1024 + dir * 512 + h * 64 + k8;
      rg.ld(0, ap); rg.ld(1, ap + 4); rg.ld(2, PJ(r0 + t, 11 + dir, h * 64 + k8)); rg.ld(3, PJ(r0 + t, 13, h * 64 + k8));
      MEMBAR();
      float kf[8], if_[8]; unpack8(rg.getu(2), kf); unpack8(rg.getu(3), if_);
      *(u32x4_*)(A + t * HS_ + k8) = rg.get(0); *(u32x4_*)(A + t * HS_ + k8 + 4) = rg.get(1);
      *(float4*)(KK + t * HS_ + k8) = make_float4(kf[0], kf[1], kf[2], kf[3]); *(float4*)(KK + t * HS_ + k8 + 4) = make_float4(kf[4], kf[5], kf[6], kf[7]);
      *(float4*)(I + t * HS_ + k8) = make_float4(if_[0], if_[1], if_[2], if_[3]); *(float4*)(I + t * HS_ + k8 + 4) = make_float4(if_[4], if_[5], if_[6], if_[7]); }
    __syncthreads();
    chunk_cumsum(A, tmp, dir);
    const int lastt = dir == 0 ? 63 : 0;
    { const int t = tid >> 3, k8 = (tid & 7) * 8;
#pragma unroll
      for (int e = 0; e < 8; ++e) KK[t * HS_ + k8 + e] *= __builtin_amdgcn_exp2f(A[lastt * HS_ + k8 + e] - A[t * HS_ + k8 + e]);
      if (tid < 64) HD[(size_t)item * 64 + tid] = __builtin_amdgcn_exp2f(A[lastt * HS_ + tid]); }
    __syncthreads();
    { const int k = tid >> 3, v8 = (tid & 7) * 8;
      float acc[8];
#pragma unroll
      for (int e = 0; e < 8; ++e) acc[e] = 0.f;
      for (int t = 0; t < 64; ++t) { const float wv = KK[t * HS_ + k]; const float4 i0 = *(const float4*)(I + t * HS_ + v8), i1 = *(const float4*)(I + t * HS_ + v8 + 4);
          acc[0] += wv * i0.x; acc[1] += wv * i0.y; acc[2] += wv * i0.z; acc[3] += wv * i0.w; acc[4] += wv * i1.x; acc[5] += wv * i1.y; acc[6] += wv * i1.z; acc[7] += wv * i1.w; }
      float* dst = HL + ((size_t)item * 64 + k) * 64 + v8;
      *(float4*)dst = make_float4(acc[0], acc[1], acc[2], acc[3]); *(float4*)(dst + 4) = make_float4(acc[4], acc[5], acc[6], acc[7]); }
    __syncthreads();
}

__device__ void hgrn2_all(const Params& p, const PassInfo ps, int l) {
    unsigned char* ws = opaque(p.ws);
    const float* HL = (const float*)(ws + OFF_HL); const float* HD = (const float*)(ws + OFF_HD); float* HS = (float*)(ws + OFF_HS);
    float* CST = (float*)(ws + OFF_CTXST) + (size_t)l * 256 * 4096;
    const int NC = ps.T >> 6, chains = ps.nb * 16;
    const size_t total = (size_t)chains * 4096;
    for (size_t e = (size_t)blockIdx.x * 512 + tidx(); e < total; e += (size_t)gridDim.x * 512) {
        const int ci = (int)(e >> 12), kv = (int)(e & 4095), k = kv >> 6, dir = ci & 1;
        float s = ps.is_ctx ? 0.f : CST[((size_t)ps.b0 * 16 + ci) * 4096 + kv];
        for (int cc = 0; cc < NC; ++cc) { const int c = dir ? NC - 1 - cc : cc; const size_t idx = (size_t)ci * NC + c;
            HS[idx * 4096 + kv] = s; s = HD[idx * 64 + k] * s + HL[idx * 4096 + kv]; }
        if (ps.is_ctx) CST[(size_t)ci * 4096 + kv] = s;
    }
}

__device__ void hgrn3_item(const Params& p, const PassInfo ps, int l, int item, unsigned char* lds) {
    unsigned char* ws = opaque(p.ws);
    const u16* PROJ = (const u16*)(ws + OFF_PROJ); const float* LOGF = (const float*)(ws + OFF_LOGF); const float* HSt = (const float*)(ws + OFF_HS);
    u16* Y3 = (u16*)(ws + OFF_Y) + (size_t)3 * MLAT * 512;
    const int NC = ps.T >> 6, ncsh = ps.is_ctx ? 2 : 6, c = item & (NC - 1), bh = item >> ncsh, h = bh & 7, bl = bh >> 3;
    const size_t r0 = (size_t)bl * ps.T + c * 64;
    const size_t idxf = (size_t)(bh * 2 + 0) * NC + c, idxb = (size_t)(bh * 2 + 1) * NC + c;
    float* Q = (float*)lds; float* KKf = Q + 64 * HS_; float* KKb = KKf + 64 * HS_; float* Af = KKb + 64 * HS_; float* Ab = Af + 64 * HS_; float* tmp = Ab + 64 * HS_;
    u16* Ib = (u16*)(tmp + 512); u16* Sfb = Ib + 64 * KVS; u16* Sbb = Sfb + 64 * KVS; float* comb = (float*)(Sbb + 64 * KVS);
    const int tid = tidx(), w = tid >> 6, lane = tid & 63, li = lane & 15, quad = lane >> 4;
    { const int t = tid >> 3, k8 = (tid & 7) * 8;
      Reg8 ra, rb;
      const float* ap = LOGF + (r0 + t) * 1024 + h * 64 + k8;
      const float* sf = HSt + idxf * 4096 + t * 64 + k8; const float* sb = HSt + idxb * 4096 + t * 64 + k8;
      ra.ld(0, PJ(r0 + t, 10, h * 64 + k8)); ra.ld(1, PJ(r0 + t, 11, h * 64 + k8)); ra.ld(2, PJ(r0 + t, 12, h * 64 + k8)); ra.ld(3, PJ(r0 + t, 13, h * 64 + k8));
      ra.ld(4, ap); ra.ld(5, ap + 4); ra.ld(6, ap + 512); ra.ld(7, ap + 516);
      rb.ld(0, sf); rb.ld(1, sf + 4); rb.ld(2, sb); rb.ld(3, sb + 4);
      MEMBAR();
      float x[8];
      unpack8(ra.getu(0), x); *(float4*)(Q + t * HS_ + k8) = make_float4(x[0], x[1], x[2], x[3]); *(float4*)(Q + t * HS_ + k8 + 4) = make_float4(x[4], x[5], x[6], x[7]);
      unpack8(ra.getu(1), x); *(float4*)(KKf + t * HS_ + k8) = make_float4(x[0], x[1], x[2], x[3]); *(float4*)(KKf + t * HS_ + k8 + 4) = make_float4(x[4], x[5], x[6], x[7]);
      unpack8(ra.getu(2), x); *(float4*)(KKb + t * HS_ + k8) = make_float4(x[0], x[1], x[2], x[3]); *(float4*)(KKb + t * HS_ + k8 + 4) = make_float4(x[4], x[5], x[6], x[7]);
      *(u32x4_*)(Ib + t * KVS + k8) = ra.get(3);
      *(u32x4_*)(Af + t * HS_ + k8) = ra.get(4); *(u32x4_*)(Af + t * HS_ + k8 + 4) = ra.get(5); *(u32x4_*)(Ab + t * HS_ + k8) = ra.get(6); *(u32x4_*)(Ab + t * HS_ + k8 + 4) = ra.get(7);
      const u32x4_ a0 = rb.get(0), a1 = rb.get(1), b0 = rb.get(2), b1 = rb.get(3);
#define F_(u) __uint_as_float(u)
      uint4 wa, wb; wa.x = pack2(F_(a0[0]), F_(a0[1])); wa.y = pack2(F_(a0[2]), F_(a0[3])); wa.z = pack2(F_(a1[0]), F_(a1[1])); wa.w = pack2(F_(a1[2]), F_(a1[3]));
      wb.x = pack2(F_(b0[0]), F_(b0[1])); wb.y = pack2(F_(b0[2]), F_(b0[3])); wb.z = pack2(F_(b1[0]), F_(b1[1])); wb.w = pack2(F_(b1[2]), F_(b1[3]));
#undef F_
      *(uint4*)(Sfb + t * KVS + k8) = wa; *(uint4*)(Sbb + t * KVS + k8) = wb; }
    __syncthreads();
    chunk_cumsum(Af, tmp, 0);
    chunk_cumsum(Ab, tmp, 1);
    const int dir = w >> 2, T = w & 3;
    const float* A = dir ? Ab : Af; const float* KK = dir ? KKb : KKf; const u16* Sb16 = dir ? Sbb : Sfb;
    const int t = 16 * T + li;
    const int rrow = dir ? 16 * T + 16 : 16 * T - 1; const bool rzero = dir ? (T == 3) : (T == 0);
    bf16x8 qt[2], qh[2];
    float Rv[2][8];
#pragma unroll
    for (int ks = 0; ks < 2; ++ks) {
        const int k0 = ks * 32 + quad * 8;
        float qv[8], av[8];
        { const float4 x0 = *(const float4*)(Q + t * HS_ + k0), x1 = *(const float4*)(Q + t * HS_ + k0 + 4); qv[0] = x0.x; qv[1] = x0.y; qv[2] = x0.z; qv[3] = x0.w; qv[4] = x1.x; qv[5] = x1.y; qv[6] = x1.z; qv[7] = x1.w; }
        { const float4 x0 = *(const float4*)(A + t * HS_ + k0), x1 = *(const float4*)(A + t * HS_ + k0 + 4); av[0] = x0.x; av[1] = x0.y; av[2] = x0.z; av[3] = x0.w; av[4] = x1.x; av[5] = x1.y; av[6] = x1.z; av[7] = x1.w; }
        if (rzero) {
#pragma unroll
            for (int e = 0; e < 8; ++e) Rv[ks][e] = 0.f;
        } else { const float4 x0 = *(const float4*)(A + rrow * HS_ + k0), x1 = *(const float4*)(A + rrow * HS_ + k0 + 4); Rv[ks][0] = x0.x; Rv[ks][1] = x0.y; Rv[ks][2] = x0.z; Rv[ks][3] = x0.w; Rv[ks][4] = x1.x; Rv[ks][5] = x1.y; Rv[ks][6] = x1.z; Rv[ks][7] = x1.w; }
        float a_[8], b_[8];
#pragma unroll
        for (int e = 0; e < 8; ++e) { a_[e] = qv[e] * __builtin_amdgcn_exp2f(av[e] - Rv[ks][e]); b_[e] = qv[e] * __builtin_amdgcn_exp2f(av[e]); }
        const unsigned a0 = pack2(a_[0], a_[1]), a1 = pack2(a_[2], a_[3]), a2 = pack2(a_[4], a_[5]), a3 = pack2(a_[6], a_[7]);
        const unsigned b0 = pack2(b_[0], b_[1]), b1 = pack2(b_[2], b_[3]), b2 = pack2(b_[4], b_[5]), b3 = pack2(b_[6], b_[7]);
        qt[ks] = (bf16x8){(short)(a0 & 0xffff), (short)(a0 >> 16), (short)(a1 & 0xffff), (short)(a1 >> 16), (short)(a2 & 0xffff), (short)(a2 >> 16), (short)(a3 & 0xffff), (short)(a3 >> 16)};
        qh[ks] = (bf16x8){(short)(b0 & 0xffff), (short)(b0 >> 16), (short)(b1 & 0xffff), (short)(b1 >> 16), (short)(b2 & 0xffff), (short)(b2 >> 16), (short)(b3 & 0xffff), (short)(b3 >> 16)};
    }
    const int nS = dir ? 4 - T : T + 1;
    float sc[4][4];
#pragma unroll
    for (int i = 0; i < 4; ++i) {
        if (i < nS) {
            const int S = dir ? T + i : i, srow = 16 * S + li;
            f32x4 a = (f32x4){0.f, 0.f, 0.f, 0.f};
#pragma unroll
            for (int ks = 0; ks < 2; ++ks) {
                const int k0 = ks * 32 + quad * 8;
                const float4 x0 = *(const float4*)(KK + srow * HS_ + k0), x1 = *(const float4*)(KK + srow * HS_ + k0 + 4);
                const float4 y0 = *(const float4*)(A + srow * HS_ + k0), y1 = *(const float4*)(A + srow * HS_ + k0 + 4);
                const float kv[8] = {x0.x, x0.y, x0.z, x0.w, x1.x, x1.y, x1.z, x1.w}, as[8] = {y0.x, y0.y, y0.z, y0.w, y1.x, y1.y, y1.z, y1.w};
                float c_[8];
#pragma unroll
                for (int e = 0; e < 8; ++e) c_[e] = kv[e] * __builtin_amdgcn_exp2f(Rv[ks][e] - as[e]);
                const unsigned c0 = pack2(c_[0], c_[1]), c1 = pack2(c_[2], c_[3]), c2 = pack2(c_[4], c_[5]), c3 = pack2(c_[6], c_[7]);
                const bf16x8 kf = (bf16x8){(short)(c0 & 0xffff), (short)(c0 >> 16), (short)(c1 & 0xffff), (short)(c1 >> 16), (short)(c2 & 0xffff), (short)(c2 >> 16), (short)(c3 & 0xffff), (short)(c3 >> 16)};
                a = MFMA16(kf, qt[ks], a);
            }
            const bool diag = (S == T);
#pragma unroll
            for (int j = 0; j < 4; ++j) { const int sl = quad * 4 + j; const bool keep = !diag || (dir ? (sl >= li) : (sl <= li)); sc[i][j] = keep ? a[j] : 0.f; }
        } else {
#pragma unroll
            for (int j = 0; j < 4; ++j) sc[i][j] = 0.f;
        }
    }
    f32x4 O[4];
#pragma unroll
    for (int v = 0; v < 4; ++v) O[v] = (f32x4){0.f, 0.f, 0.f, 0.f};
#pragma unroll
    for (int pr = 0; pr < 2; ++pr) {
        if (2 * pr < nS) {
            const unsigned a0 = pack2(sc[2 * pr][0], sc[2 * pr][1]), a1 = pack2(sc[2 * pr][2], sc[2 * pr][3]), b0 = pack2(sc[2 * pr + 1][0], sc[2 * pr + 1][1]), b1 = pack2(sc[2 * pr + 1][2], sc[2 * pr + 1][3]);
            const bf16x8 pf = (bf16x8){(short)(a0 & 0xffff), (short)(a0 >> 16), (short)(a1 & 0xffff), (short)(a1 >> 16), (short)(b0 & 0xffff), (short)(b0 >> 16), (short)(b1 & 0xffff), (short)(b1 >> 16)};
            const int S0 = dir ? T + 2 * pr : 2 * pr; int S1 = S0 + 1; if (S1 > 3) S1 = 3;
            const u16* p0 = Ib + (16 * S0 + quad * 4 + (li >> 2)) * KVS + 4 * (li & 3);
            const u16* p1 = Ib + (16 * S1 + quad * 4 + (li >> 2)) * KVS + 4 * (li & 3);
#pragma unroll
            for (int v = 0; v < 4; ++v) O[v] = MFMA16(tr_read2(p0 + v * 16, p1 + v * 16), pf, O[v]);
        }
    }
#pragma unroll
    for (int ks = 0; ks < 2; ++ks) {
        const u16* p0 = Sb16 + (ks * 32 + quad * 8 + (li >> 2)) * KVS + 4 * (li & 3);
#pragma unroll
        for (int v = 0; v < 4; ++v) O[v] = MFMA16(tr_read2(p0 + v * 16, p0 + 4 * KVS + v * 16), qh[ks], O[v]);
    }
    if (dir == 1) {
#pragma unroll
        for (int v = 0; v < 4; ++v)
#pragma unroll
            for (int j = 0; j < 4; ++j) comb[(T * 16 + v * 4 + j) * 64 + lane] = O[v][j];
    }
    __syncthreads();
    if (dir == 0) {
        float ss = 0.f;
#pragma unroll
        for (int v = 0; v < 4; ++v)
#pragma unroll
            for (int j = 0; j < 4; ++j) { O[v][j] += comb[(T * 16 + v * 4 + j) * 64 + lane]; ss += O[v][j] * O[v][j]; }
        ss += shx(ss, 16); ss += shx(ss, 32);
        const float rstd = rsqrtf(ss * (1.f / 64.f) + EPSN);
        const size_t row = r0 + t;
#pragma unroll
        for (int v = 0; v < 4; ++v) {
            const int col = h * 64 + v * 16 + quad * 4;
            const float4 gn = *(const float4*)(p.hgrn_g + l * 512 + col);
            const uint2 g = *(const uint2*)(PJ(row, 14, col));
            uint2 wv; wv.x = pack2(O[v][0] * rstd * gn.x * siluf_(bflo(g.x)), O[v][1] * rstd * gn.y * siluf_(bfhi(g.x))); wv.y = pack2(O[v][2] * rstd * gn.z * siluf_(bflo(g.y)), O[v][3] * rstd * gn.w * siluf_(bfhi(g.y)));
            *(uint2*)(Y3 + row * 512 + col) = wv;
        }
    }
    __syncthreads();
}
#define XB_TMO      128
#define XB_XCNT(j)  (256  + 64 * (j))
#define XB_XSUB(j)  (1280 + 64 * (j))
#define XB_XGEN(j)  (2304 + 64 * (j))
#define XB_TOP      3328
#define XB_TOPGEN   3392
#define XCD_BAR_WORDS 3456
#define XB_SPIN_CAP (1u << 18)

__device__ __forceinline__ unsigned xb_ld(unsigned* p)              { return __hip_atomic_load(p, __ATOMIC_RELAXED, __HIP_MEMORY_SCOPE_AGENT); }
__device__ __forceinline__ unsigned xb_add(unsigned* p, unsigned v) { return __hip_atomic_fetch_add(p, v, __ATOMIC_RELAXED, __HIP_MEMORY_SCOPE_AGENT); }
__device__ __forceinline__ unsigned xb_xcc_id() { return (unsigned)__builtin_amdgcn_s_getreg((3 << 11) | 20) & 0xFu; }
#define XB_SPIN(cond, bar) do { unsigned _sp = 0; while (cond) { __builtin_amdgcn_s_sleep(1); \
    if ((++_sp & 255u) == 0u) { if (xb_ld(&(bar)[XB_TMO])) break; if (_sp > XB_SPIN_CAP) { atomicAdd(&(bar)[XB_TMO], 1u); break; } } } } while (0)

struct XcdBarrier {
    unsigned* bar; unsigned x;
    volatile LAS unsigned* st;
};

__device__ __forceinline__ XcdBarrier xcd_barrier_post(unsigned* bar, volatile LAS unsigned* st) {
    XcdBarrier b; b.bar = bar; b.x = xb_xcc_id(); b.st = st;
    if (tidx() == 0) (void)xb_add(&bar[XB_XCNT(b.x)], 1u);
    return b;
}
__device__ __forceinline__ void xcd_barrier_complete(unsigned* bar, unsigned x, unsigned& nloc, unsigned& nx) {
    const unsigned G = gridDim.x * gridDim.y * gridDim.z;
    unsigned sum, cnt, mine, sp = 0u;
    for (;;) {
        sum = 0u; cnt = 0u; mine = 0u;
#pragma unroll
        for (unsigned j = 0; j < 16; ++j) { const unsigned c = xb_ld(&bar[XB_XCNT(j)]); sum += c; cnt += (c > 0u) ? 1u : 0u; mine = (j == x) ? c : mine; }
        if (sum == G) break;
        __builtin_amdgcn_s_sleep(1);
        if ((++sp & 255u) == 0u) { if (xb_ld(&bar[XB_TMO])) break; if (sp > XB_SPIN_CAP) { atomicAdd(&bar[XB_TMO], 1u); break; } }
    }
    nloc = mine > 0u ? mine : 1u; nx = cnt > 0u ? cnt : 1u;
}

__device__ __forceinline__ void xcd_barrier(const XcdBarrier& b) {
    asm volatile("s_waitcnt vmcnt(0)" ::: "memory");
    __syncthreads();
    if (tidx() == 0) {
        unsigned* bar = b.bar;
        __builtin_amdgcn_s_waitcnt(0);
        unsigned nloc = b.st[0], nx = b.st[1];
        if (nloc == 0u) { xcd_barrier_complete(bar, b.x, nloc, nx); b.st[0] = nloc; b.st[1] = nx; }
        const unsigned old = xb_add(&bar[XB_XSUB(b.x)], 1u);
        const unsigned gen = old / nloc;
        if (old + 1u == (gen + 1u) * nloc) {
            __builtin_amdgcn_fence(__ATOMIC_RELEASE, "agent");
            asm volatile("s_waitcnt vmcnt(0)" ::: "memory");
            const unsigned og = xb_add(&bar[XB_TOP], 1u);
            const unsigned tg = og / nx;
            if (og + 1u == (tg + 1u) * nx) xb_add(&bar[XB_TOPGEN], 1u);
            else XB_SPIN(xb_ld(&bar[XB_TOPGEN]) == tg, bar);
            __builtin_amdgcn_fence(__ATOMIC_ACQUIRE, "agent");
            xb_add(&bar[XB_XGEN(b.x)], 1u);
            asm volatile("s_waitcnt vmcnt(0)" ::: "memory");
        } else {
            XB_SPIN(xb_ld(&bar[XB_XGEN(b.x)]) == gen, bar);
            __builtin_amdgcn_fence(__ATOMIC_ACQUIRE, "agent");
            asm volatile("s_waitcnt vmcnt(0)" ::: "memory");
        }
    }
    __syncthreads();
}

#ifndef STAG_B
#define STAG_B 240
#endif
#ifndef STAG_D
#define STAG_D 300
#endif
#ifndef REP_B
#define REP_B 1
#endif
#ifndef REP_C1
#define REP_C1 1
#endif
#ifndef REP_C2
#define REP_C2 1
#endif
#ifndef REP_C3
#define REP_C3 1
#endif
#ifndef REP_DE
#define REP_DE 1
#endif
__device__ __forceinline__ void stagger(int ticks_per_slot) {
    const int slot = ((int)blockIdx.x >> 3) & 7;
    if (slot) { const unsigned long long t0 = __builtin_amdgcn_s_memrealtime(), dt = (unsigned long long)(slot * ticks_per_slot);
        while (__builtin_amdgcn_s_memrealtime() - t0 < dt) __builtin_amdgcn_s_sleep(4); }
}
template <class Epi> __device__ __forceinline__ void run_gemm(LAS unsigned char* lds, const u16* A, const u16* Bt, int M, int N, int K, const Epi& E) {
    pg8::Gemm g; g.A = A; g.Bt = Bt; g.M = M; g.N = N; g.K = K; g.rsA = 0; g.rsB = 0;
    pg8::StaticOrder S; S.init(M, N, (int)gridDim.x, (int)blockIdx.x);
    pg8::gemm_phase<Epi, pg8::StaticOrder, false>(lds, g, S, E, nullptr);
}


struct EpiNull {
    static constexpr bool PERM = true, AFTER_DRAIN = false;
    unsigned char* ws;
    __device__ __forceinline__ void operator()(const f32x4 (&acc)[2][2][4][2], const Unit& u, int wr, int wc, int fr, int fq) const {
        if (ws == nullptr) {
#pragma unroll
            for (int ai = 0; ai < 2; ++ai)
#pragma unroll
                for (int bj = 0; bj < 2; ++bj)
#pragma unroll
                    for (int m = 0; m < 4; ++m)
#pragma unroll
                        for (int n = 0; n < 2; ++n) *(f32x4*)(ws + (size_t)(((ai * 2 + bj) * 4 + m) * 2 + n) * 16 + fr * 1024 + fq * 65536 + wr * 4096 + wc * 16384 + u.pm) = acc[ai][bj][m][n];
        }
    }
};
struct MergeOrder : pg8::StaticOrder {
    __device__ bool next(int i, Unit& u) const { if (!pg8::StaticOrder::next(i >> 2, u)) return false; u.r = i & 3; return true; }
};
__device__ __forceinline__ Params KP() {
    auto q0 = __builtin_amdgcn_kernarg_segment_ptr();
    asm volatile("" : "+s"(q0));
    const __attribute__((address_space(4))) Params* q = (const __attribute__((address_space(4))) Params*)q0;
    Params r;
    r.x = q->x; r.c = q->c; r.ctx = q->ctx; r.c_ctx = q->c_ctx; r.w_ada = q->w_ada; r.b_ada = q->b_ada; r.g_pre = q->g_pre; r.g_post = q->g_post; r.w_in = q->w_in; r.rpb = q->rpb;
    r.fnet_w = q->fnet_w; r.gmlp_g = q->gmlp_g; r.gmlp_ws = q->gmlp_ws; r.gmlp_bs = q->gmlp_bs; r.lb_logits = q->lb_logits; r.hgrn_g = q->hgrn_g; r.w_branch = q->w_branch; r.w_out = q->w_out;
    r.out = q->out; r.ws = q->ws; return r;
}
constexpr size_t OFF_BAR = WS_END;
constexpr size_t WS_END2 = WS_END + (size_t)XCD_BAR_WORDS * 4;
__device__ __forceinline__ void gsync(LAS unsigned char* lds3) {
    XcdBarrier b; b.bar = (unsigned*)(opaque(KP().ws) + OFF_BAR); b.x = xb_xcc_id(); b.st = (volatile LAS unsigned*)(lds3 + LDS_BYTES);
    xcd_barrier(b);
}
__global__ void __launch_bounds__(512, 2) mega_fwd(Params p_unused) {
    extern __shared__ __attribute__((aligned(16))) unsigned char shm[];
    LAS unsigned char* lds3 = (LAS unsigned char*)shm;
    {
        if (tidx() < 4) ((volatile LAS unsigned*)(lds3 + LDS_BYTES))[tidx()] = 0u;
        if (blockIdx.x == 0) { unsigned* bar = (unsigned*)(opaque(KP().ws) + OFF_BAR); for (int i = tidx(); i < XCD_BAR_WORDS; i += 512) bar[i] = 0u; }
        __syncthreads();
    }
    prep1(KP(), shm);
    cg::this_grid().sync();
    { XcdBarrier b0 = xcd_barrier_post((unsigned*)(opaque(KP().ws) + OFF_BAR), (volatile LAS unsigned*)(lds3 + LDS_BYTES)); (void)b0; }
    prep2(KP(), shm);
    gsync(lds3);
#pragma nounroll
    for (int pass = 0; pass < 1 + NBATCH / GB; ++pass) {
        PassInfo ps;
        if (pass == 0) { ps.is_ctx = 1; ps.nb = NBATCH; ps.T = CTXL; ps.M = MCTX; ps.b0 = 0; }
        else { ps.is_ctx = 0; ps.nb = GB; ps.T = SEQ; ps.M = MLAT; ps.b0 = (pass - 1) * GB; }
        const int NC = ps.T >> 6;
#pragma nounroll
        for (int l = 0; l < DEPTH; ++l) {
            phase_norm(KP(), ps, l);
            gsync(lds3);
            _Pragma("nounroll") for (int rep = 0; rep < REP_B; ++rep) {
                unsigned char* ws = opaque(KP().ws);
                EpiProj E; E.ws = ws; E.l = l; E.is_ctx = ps.is_ctx;

                run_gemm(lds3, (const u16*)(ws + OFF_H), (const u16*)(ws + OFF_WTIN) + (size_t)l * NPROJ * DM, ps.M, NPROJ, DM, E);
                gsync(lds3);
#ifdef PROBE_NULL_B
                { EpiNull EN; EN.ws = ws; run_gemm(lds3, (const u16*)(ws + OFF_H), (const u16*)(ws + OFF_WTIN) + (size_t)l * NPROJ * DM, ps.M, NPROJ, DM, EN); gsync(lds3); }
#endif
            }
            const bool full = !(ps.is_ctx && l == DEPTH - 1);
            _Pragma("nounroll") for (int rep = 0; rep < REP_C1; ++rep) {
                const int n_h1 = ps.nb * 16 * NC, n_at = full ? ps.nb * 8 * (ps.T >> 6) : 0, n_f1 = ps.is_ctx ? 0 : ps.nb * 64;
                for (int it = blockIdx.x; it < n_h1 + n_at + n_f1; it += gridDim.x) {
                    if (it < n_h1) hgrn1_item(KP(), ps, it, shm);
                    else if (it < n_h1 + n_at) attn_item(KP(), ps, l, it - n_h1, shm);
                    else four1_item(KP(), it - n_h1 - n_at, shm);
                }
                gsync(lds3);
            }
            _Pragma("nounroll") for (int rep = 0; rep < REP_C2; ++rep) {
                hgrn2_all(KP(), ps, l);
                if (full) {
                    const int n_f2 = ps.is_ctx ? ps.nb * 4 : ps.nb * 64, n_g = ps.M >> 7;
                    for (int it = blockIdx.x; it < n_f2 + n_g; it += gridDim.x) {
                        if (it < n_f2) { if (ps.is_ctx) fourc_item(KP(), it, shm); else four2_item(KP(), it, shm); }
                        else gmlp_item(KP(), l, it - n_f2, shm);
                    }
                }
                gsync(lds3);
            }
            if (!full) continue;
            _Pragma("nounroll") for (int rep = 0; rep < REP_C3; ++rep) {
                const int n_h3 = ps.nb * 8 * NC;
                for (int it = blockIdx.x; it < n_h3; it += gridDim.x) hgrn3_item(KP(), ps, l, it, shm);
                gsync(lds3);
            }
            _Pragma("nounroll") for (int rep = 0; rep < REP_DE; ++rep) {
            {
                unsigned char* ws = opaque(KP().ws);
                pg8::Gemm g; g.A = (const u16*)(ws + OFF_Y); g.Bt = (const u16*)(ws + OFF_WTBR) + (size_t)l * 4 * 1024 * 512; g.M = ps.M; g.N = 1024; g.K = 512;
                g.rsA = (size_t)MLAT * 512 * 2; g.rsB = (size_t)1024 * 512 * 2;
                MergeOrder S; S.init(ps.M, 1024, (int)gridDim.x, (int)blockIdx.x);
                EpiMerge E; E.ws = ws;

                pg8::gemm_phase<EpiMerge, MergeOrder, false>(lds3, g, S, E, nullptr);
            }
            gsync(lds3);
            if (REP_DE > 1 && rep + 1 < REP_DE) continue;
            {
                unsigned char* ws = opaque(KP().ws);
                EpiOut E; E.C = (float*)(ws + OFF_OUT);
                run_gemm(lds3, (const u16*)(ws + OFF_MB), (const u16*)(ws + OFF_WTOUT) + (size_t)l * 1024 * 1024, ps.M, 1024, 1024, E);
            }
            gsync(lds3);
            }
        }
        if (!ps.is_ctx) phase_norm(KP(), ps, DEPTH);
    }
}

static_assert(WS_END2 <= (size_t)1073741824, "workspace map exceeds 1 GiB");

extern "C" void kernel_launch(void* const* d_in, const int* in_sizes, int n_in, void* d_out, int out_size, void* d_ws, size_t ws_size, hipStream_t stream) {
    static int grid_blocks = 0;
    if (grid_blocks == 0) {
        if (n_in != 18 || ws_size < WS_END2) { fprintf(stderr, "kernel_launch: unexpected n_in %d or ws_size %zu (need %zu)\n", n_in, ws_size, (size_t)WS_END2); grid_blocks = -1; return; }
        int dev = 0, cus = 0, per_cu = 0;
        hipGetDevice(&dev);
        hipDeviceGetAttribute(&cus, hipDeviceAttributeMultiprocessorCount, dev);
        if (hipFuncSetAttribute((const void*)mega_fwd, hipFuncAttributeMaxDynamicSharedMemorySize, LDS_BYTES + 16) != hipSuccess) { fprintf(stderr, "kernel_launch: hipFuncSetAttribute failed\n"); grid_blocks = -1; return; }
        hipOccupancyMaxActiveBlocksPerMultiprocessor(&per_cu, (const void*)mega_fwd, 512, LDS_BYTES + 16);
        if (per_cu < 1) { fprintf(stderr, "kernel_launch: occupancy query gave %d\n", per_cu); per_cu = 1; }
        (void)hipGetLastError();
        grid_blocks = cus * per_cu;
    }
    if (grid_blocks < 0) return;
    Params p{};
    const float** pp = (const float**)&p;
    for (int i = 0; i < 18; ++i) pp[i] = (const float*)d_in[i];
    p.out = (float*)d_out; p.ws = (unsigned char*)d_ws;
    void* args[] = {&p};
    hipError_t e = hipLaunchCooperativeKernel((const void*)mega_fwd, dim3(grid_blocks), dim3(512), args, LDS_BYTES + 16, stream);
    if (e != hipSuccess) fprintf(stderr, "cooperative launch failed: %s (grid %d)\n", hipGetErrorString(e), grid_blocks);
}
```

```cpp
#include <hip/hip_runtime.h>
#include <hip/hip_cooperative_groups.h>
#include <cstdio>
namespace cg = cooperative_groups;
__device__ __forceinline__ int tidx() { int t = threadIdx.x; asm volatile("" : "+v"(t)); return t; }
template <class T> __device__ __forceinline__ T* opaque(T* p) {
    unsigned long long v = (unsigned long long)p; const unsigned lo = __builtin_amdgcn_readfirstlane((unsigned)v), hi = __builtin_amdgcn_readfirstlane((unsigned)(v >> 32));
    v = ((unsigned long long)hi << 32) | lo; asm volatile("" : "+s"(v)); return (T*)((__attribute__((address_space(1))) T*)v); }
__device__ __forceinline__ float shx(float v, int m) { const int lane = tidx() & 63; return __int_as_float(__builtin_amdgcn_ds_bpermute((lane ^ m) << 2, __float_as_int(v))); }
namespace pg8 {
#define PG8_LAS __attribute__((address_space(3)))
typedef unsigned short bf16_t;
typedef short bf16x8 __attribute__((ext_vector_type(8)));
typedef float f32x4 __attribute__((ext_vector_type(4)));
typedef unsigned u32x4 __attribute__((ext_vector_type(4)));
constexpr int BM = 256, BK = 64, HALF = 128, HTB = HALF * BK * 2  , STAGE_BYTES = 8 * HTB, NXCD = 8, WGM = 8;

__host__ __device__ __forceinline__ int lds_byte(int r, int c) { const int st = (r >> 4) * 2 + (c >> 5), rr = r & 15, cc = c & 31, ob = rr * 64 + cc * 2; return st * 1024 + (ob ^ (((ob >> 9) & 1) << 5)); }
__host__ __device__ __forceinline__ void stage_rc(int b, int& R, int& C) { const int st = b / 1024, sb = b % 1024, swz = sb ^ (((sb >> 9) & 1) << 5); R = (st >> 1) * 16 + swz / 64; C = (st & 1) * 32 + (swz % 64) / 2; }
__host__ __device__ __forceinline__ int perm32(int rho) { const int n = rho >> 4, i = rho & 15; return 8 * (i >> 2) + 4 * n + (i & 3); }

struct Unit { int pm, pn, r; };
struct Gemm { const bf16_t* A; const bf16_t* Bt; int M, N, K; size_t rsA, rsB; };

struct StaticOrder {
    int nM, nN, nwg, G, c;
    __host__ __device__ void init(int M, int N, int G_, int c_) { nM = M / BM; nN = N / BM; nwg = nM * nN; G = G_; c = c_; }
    __host__ __device__ bool next(int i, Unit& u) const {
        const long L = (long)i * G + c; if (L >= nwg) return false;
        int wgid = (int)L; { const int q = nwg / NXCD, r = nwg % NXCD, xcd = wgid % NXCD, off = wgid / NXCD; wgid = (xcd < r ? xcd * (q + 1) : r * (q + 1) + (xcd - r) * q) + off; }
        const int nig = WGM * nN, gid = wgid / nig, fm = gid * WGM, gsz = (nM - fm) < WGM ? (nM - fm) : WGM;
        u.pm = fm + ((wgid % nig) % gsz); u.pn = (wgid % nig) / gsz; u.r = 0; return true;
    }
    __device__ __forceinline__ void a_ready(const Unit&) const {}
    __device__ __forceinline__ void done(const Unit&) const {}
};
__device__ __forceinline__ unsigned cvt_pk_bf16(float lo, float hi) { unsigned r; asm volatile("v_cvt_pk_bf16_f32 %0, %1, %2" : "=v"(r) : "v"(lo), "v"(hi)); return r; }

template <class Epi, class Sched, bool STAMP = false>
__device__ __forceinline__ void gemm_phase(PG8_LAS unsigned char* lds, const Gemm g, const Sched& S, const Epi& E, unsigned long long* stamps) {
    const int tid = tidx(), wid = __builtin_amdgcn_readfirstlane(tid >> 6), lane = tid & 63, wr = wid >> 2, wc = wid & 3, fr = lane & 15, fq = lane >> 4;
    const int K = g.K, nt = K / BK;
    int ts_lo = 0, ts_hi = 0, nts = 0; const unsigned long long rt_entry = STAMP ? (unsigned long long)wall_clock64() : 0ull;
#define PG8_STAMP() do { if (STAMP && wid == 0 && nts < 64) { const unsigned long long _c = (unsigned long long)clock64(); \
        ts_lo = (lane == nts) ? (int)(unsigned)_c : ts_lo; ts_hi = (lane == nts) ? (int)(unsigned)(_c >> 32) : ts_hi; ++nts; } } while (0)
    PG8_STAMP();
    unsigned voffA[2], voffB[2];
#pragma unroll
    for (int i = 0; i < 2; ++i) { int R, C; stage_rc(tid * 16 + i * 8192, R, C); const int Rb = Epi::PERM ? ((R & ~31) + perm32(R & 31)) : R;
        voffA[i] = (unsigned)(R * K + C) * 2u; voffB[i] = (unsigned)(Rb * K + C) * 2u; }
    const size_t kstep = (size_t)(BK * 2);
    const size_t hstep = (size_t)HALF * K * 2;
    const size_t tstep = 2 * hstep;
    const unsigned ldsw = (unsigned)wid * 1024u;
    const int aoff = lds_byte(wr * 64 + fr, fq * 8), boff = lds_byte(wc * 32 + fr, fq * 8);
#define PG8_SA(b, h) (((b) * 2 + (h)) * HTB)
#define PG8_SB(b, h) ((4 + (b) * 2 + (h)) * HTB)
#define PG8_STAGE(bufoff, gbase, voff) do { _Pragma("unroll") for (int _i = 0; _i < 2; ++_i) \
        __builtin_amdgcn_global_load_lds((const unsigned*)((const char*)(gbase) + (voff)[_i]), (PG8_LAS unsigned*)(lds + (bufoff) + ldsw + _i * 8192), 16, 0, 0); } while (0)
#define PG8_LDA(dst, b, h) do { _Pragma("unroll") for (int m = 0; m < 4; ++m) _Pragma("unroll") for (int k = 0; k < 2; ++k) dst[m][k] = *(const PG8_LAS bf16x8*)(lds + PG8_SA(b, h) + aoff + m * 2048 + k * 1024); } while (0)
#define PG8_LDB(dst, b, h) do { _Pragma("unroll") for (int n = 0; n < 2; ++n) _Pragma("unroll") for (int k = 0; k < 2; ++k) dst[n][k] = *(const PG8_LAS bf16x8*)(lds + PG8_SB(b, h) + boff + n * 2048 + k * 1024); } while (0)
#define PG8_MMA(ai, bj, At, Bt) do { __builtin_amdgcn_s_setprio(1); _Pragma("unroll") for (int m = 0; m < 4; ++m) _Pragma("unroll") for (int n = 0; n < 2; ++n) _Pragma("unroll") for (int k = 0; k < 2; ++k) \
        acc[ai][bj][m][n] = __builtin_amdgcn_mfma_f32_16x16x32_bf16(Bt[n][k], At[m][k], acc[ai][bj][m][n], 0, 0, 0); __builtin_amdgcn_s_setprio(0); } while (0)
#define PG8_WAIT_V(n) asm volatile("s_waitcnt vmcnt(" #n ")" ::: "memory")
#define PG8_WAIT_L(n) asm volatile("s_waitcnt lgkmcnt(" #n ")" ::: "memory")
#define PG8_BAR __builtin_amdgcn_s_barrier()
#define PG8_SCHED __builtin_amdgcn_sched_barrier(0)
    Unit cur, nxt; int ui = 0;
    if (!S.next(0, cur)) return;
    f32x4 acc[2][2][4][2];
#pragma unroll
    for (int a = 0; a < 2; ++a)
#pragma unroll
        for (int b = 0; b < 2; ++b)
#pragma unroll
            for (int m = 0; m < 4; ++m)
#pragma unroll
                for (int n = 0; n < 2; ++n) acc[a][b][m][n] = (f32x4){0.f, 0.f, 0.f, 0.f};
    bf16x8 At[4][2], B0[2][2], B1[2][2];
    const char* cA = (const char*)g.A + (size_t)cur.pm * tstep + (size_t)cur.r * g.rsA; const char* cB = (const char*)g.Bt + (size_t)cur.pn * tstep + (size_t)cur.r * g.rsB;
    S.a_ready(cur);
    PG8_STAGE(PG8_SB(0, 0), cB, voffB); PG8_STAGE(PG8_SA(0, 0), cA, voffA); PG8_STAGE(PG8_SB(0, 1), cB + hstep, voffB); PG8_STAGE(PG8_SA(0, 1), cA + hstep, voffA);
    if (wr == 1) PG8_BAR;
    PG8_WAIT_V(4); PG8_BAR;
    PG8_STAGE(PG8_SB(1, 0), cB + kstep, voffB); PG8_STAGE(PG8_SA(1, 0), cA + kstep, voffA); PG8_STAGE(PG8_SB(1, 1), cB + hstep + kstep, voffB);
    PG8_WAIT_V(6); PG8_BAR;
    PG8_STAMP();
    for (;;) {
        const bool has_next = S.next(ui + 1, nxt);
        const char* nA = has_next ? (const char*)g.A + (size_t)nxt.pm * tstep + (size_t)nxt.r * g.rsA : cA; const char* nB = has_next ? (const char*)g.Bt + (size_t)nxt.pn * tstep + (size_t)nxt.r * g.rsB : cB;
        for (int t = 0; t < nt; t += 2) {
            const bool last = (t == nt - 2);
            const char* a1 = cA + (size_t)(t + 1) * kstep;
            const char* a2 = last ? nA : cA + (size_t)(t + 2) * kstep; const char* b2 = last ? nB : cB + (size_t)(t + 2) * kstep;
            const char* a3 = a2 + kstep; const char* b3 = b2 + kstep;
            if (last && has_next) S.a_ready(nxt);
            PG8_LDB(B0, 0, 0); PG8_SCHED; PG8_LDA(At, 0, 0); PG8_STAGE(PG8_SA(1, 1), a1 + hstep, voffA);
            PG8_WAIT_L(8); PG8_BAR; PG8_WAIT_L(0); PG8_MMA(0, 0, At, B0); PG8_BAR; PG8_SCHED;
            PG8_LDB(B1, 0, 1); PG8_STAGE(PG8_SB(0, 0), b2, voffB);
            PG8_BAR; PG8_WAIT_L(0); PG8_MMA(0, 1, At, B1); PG8_BAR;
            PG8_LDA(At, 0, 1); PG8_STAGE(PG8_SA(0, 0), a2, voffA);
            PG8_BAR; PG8_WAIT_L(0); PG8_MMA(1, 0, At, B0); PG8_BAR; PG8_SCHED;
            PG8_STAGE(PG8_SB(0, 1), b2 + hstep, voffB);
            PG8_WAIT_V(6); PG8_BAR; PG8_MMA(1, 1, At, B1); PG8_BAR;
            PG8_LDB(B0, 1, 0); PG8_SCHED; PG8_LDA(At, 1, 0); PG8_STAGE(PG8_SA(0, 1), a2 + hstep, voffA);
            PG8_WAIT_L(8); PG8_BAR; PG8_WAIT_L(0); PG8_MMA(0, 0, At, B0); PG8_BAR; PG8_SCHED;
            PG8_LDB(B1, 1, 1); PG8_STAGE(PG8_SB(1, 0), b3, voffB);
            PG8_BAR; PG8_WAIT_L(0); PG8_MMA(0, 1, At, B1); PG8_BAR;
            PG8_LDA(At, 1, 1); PG8_STAGE(PG8_SA(1, 0), a3, voffA);
            PG8_BAR; PG8_WAIT_L(0); PG8_MMA(1, 0, At, B0); PG8_BAR; PG8_SCHED;
            PG8_STAGE(PG8_SB(1, 1), b3 + hstep, voffB);
            PG8_WAIT_V(6); PG8_BAR; PG8_MMA(1, 1, At, B1); PG8_BAR;
        }
        PG8_STAMP();
        if constexpr (!Epi::AFTER_DRAIN) { E(acc, cur, wr, wc, fr, fq); S.done(cur); }
        PG8_STAMP();
        if (!has_next) break;
#pragma unroll
        for (int a = 0; a < 2; ++a)
#pragma unroll
            for (int b = 0; b < 2; ++b)
#pragma unroll
                for (int m = 0; m < 4; ++m)
#pragma unroll
                    for (int n = 0; n < 2; ++n) acc[a][b][m][n] = (f32x4){0.f, 0.f, 0.f, 0.f};
        cur = nxt; cA = nA; cB = nB; ++ui;
    }
    PG8_WAIT_V(0);
    if (wr == 0) PG8_BAR;
    PG8_BAR;
    if constexpr (Epi::AFTER_DRAIN) { E.fused(acc, cur, wr, wc, fr, fq, lds, wid, lane); S.done(cur); }
    PG8_STAMP();
    if (STAMP && wid == 0) { stamps[lane] = lane < nts ? (((unsigned long long)(unsigned)ts_hi << 32) | (unsigned)ts_lo) : 0ull;
        if (lane == 62) stamps[62] = rt_entry; if (lane == 63) stamps[63] = (unsigned long long)wall_clock64(); }
#undef PG8_STAMP
#undef PG8_SA
#undef PG8_SB
#undef PG8_STAGE
#undef PG8_LDA
#undef PG8_LDB
#undef PG8_MMA
#undef PG8_WAIT_V
#undef PG8_WAIT_L
#undef PG8_BAR
#undef PG8_SCHED
}
}

typedef unsigned short u16;
typedef short s16x4 __attribute__((ext_vector_type(4)));
using pg8::bf16x8; using pg8::f32x4; using pg8::Unit;
#define LAS __attribute__((address_space(3)))
#define MFMA16(a, b, c) __builtin_amdgcn_mfma_f32_16x16x32_bf16(a, b, c, 0, 0, 0)

constexpr int DM = 1024, NBATCH = 16, SEQ = 4096, DEPTH = 4, CTXL = 256, NPROJ = 11776, NIN = 11264;
constexpr int GB = 4, MLAT = GB * SEQ, MCTX = NBATCH * CTXL;
constexpr int LDS_BYTES = 152 * 1024;
constexpr float LOG2E = 1.4426950408889634f;
constexpr float EPSN = 1e-6f;

constexpr size_t al256(size_t x) { return (x + 255) & ~(size_t)255; }
constexpr size_t OFF_WTIN = 0;
constexpr size_t OFF_WTBR = OFF_WTIN + (size_t)DEPTH * NPROJ * DM * 2;
constexpr size_t OFF_WTOUT = OFF_WTBR + (size_t)DEPTH * 4 * 1024 * 512 * 2;
constexpr size_t OFF_WS16 = OFF_WTOUT + (size_t)DEPTH * 1024 * 1024 * 2;
constexpr size_t OFF_MOD = OFF_WS16 + (size_t)DEPTH * 8 * 128 * 128 * 2;
constexpr size_t OFF_LB = OFF_MOD + al256((size_t)DEPTH * 17 * 3072 * 4);
constexpr size_t OFF_ROPE = OFF_LB + (size_t)DEPTH * 2 * 512 * 4;
constexpr size_t OFF_TW = OFF_ROPE + 2 * 64 * 16 * 4;
constexpr size_t OFF_M1 = OFF_TW + 4096 * 8;
constexpr size_t OFF_M2 = OFF_M1 + 128 * 128 * 2;
constexpr size_t OFF_M3 = OFF_M2 + 64 * 128 * 2;
constexpr size_t OFF_CSW = OFF_M3 + 256 * 512 * 2;
constexpr size_t OFF_CTXW = OFF_CSW + (size_t)DEPTH * 4 * 2 * 128 * 128 * 4;
constexpr size_t OFF_CTXKV = OFF_CTXW + (size_t)NBATCH * CTXL * DM * 4;
constexpr size_t OFF_CTXST = OFF_CTXKV + (size_t)DEPTH * MCTX * 1024 * 2;
constexpr size_t OFF_H = OFF_CTXST + (size_t)DEPTH * 256 * 4096 * 4;
constexpr size_t OFF_PROJ = OFF_H + (size_t)MLAT * DM * 2;
constexpr size_t OFF_QROT = OFF_PROJ + (size_t)MLAT * NPROJ * 2;
constexpr size_t OFF_LOGF = OFF_QROT + (size_t)MLAT * 512 * 2;
constexpr size_t OFF_Y = OFF_LOGF + (size_t)MLAT * 1024 * 4;
constexpr size_t OFF_FY = OFF_Y + (size_t)4 * MLAT * 512 * 2;
constexpr size_t OFF_HL = OFF_FY + (size_t)GB * 4096 * 1024 * 2;
constexpr size_t OFF_HD = OFF_HL + (size_t)4096 * 4096 * 4;
constexpr size_t OFF_HS = OFF_HD + (size_t)4096 * 64 * 4;
constexpr size_t OFF_MB = OFF_HS + (size_t)4096 * 4096 * 4;
constexpr size_t WS_END = OFF_MB + (size_t)MLAT * DM * 2;
constexpr size_t OFF_MERGED = OFF_LOGF;
constexpr size_t OFF_OUT = OFF_PROJ;

struct Params {
    const float *x, *c, *ctx, *c_ctx, *w_ada, *b_ada, *g_pre, *g_post, *w_in, *rpb, *fnet_w, *gmlp_g, *gmlp_ws, *gmlp_bs, *lb_logits, *hgrn_g, *w_branch, *w_out;
    float* out; unsigned char* ws;
};
struct PassInfo { int is_ctx, nb, T, M, b0; };

__device__ __forceinline__ u16 f2bf(float f) { unsigned u = __float_as_uint(f); u += 0x7FFFu + ((u >> 16) & 1u); return (u16)(u >> 16); }
__device__ __forceinline__ float bf2f(u16 b) { return __uint_as_float(((unsigned)b) << 16); }
typedef __bf16 bf16x2_t_ __attribute__((ext_vector_type(2)));
typedef float f32x2_t_ __attribute__((ext_vector_type(2)));
__device__ __forceinline__ unsigned pack2(float a, float b) { f32x2_t_ v = {a, b}; bf16x2_t_ r = __builtin_convertvector(v, bf16x2_t_); return __builtin_bit_cast(unsigned, r); }
__device__ __forceinline__ float bflo(unsigned w) { return __uint_as_float(w << 16); }
__device__ __forceinline__ float bfhi(unsigned w) { return __uint_as_float(w & 0xFFFF0000u); }
__device__ __forceinline__ float sigmoidf_(float v) { return 1.f / (1.f + __expf(-v)); }
__device__ __forceinline__ float siluf_(float v) { return v / (1.f + __expf(-v)); }
__device__ __forceinline__ void unpack8(uint4 w, float* f) { f[0] = bflo(w.x); f[1] = bfhi(w.x); f[2] = bflo(w.y); f[3] = bfhi(w.y); f[4] = bflo(w.z); f[5] = bfhi(w.z); f[6] = bflo(w.w); f[7] = bfhi(w.w); }
__device__ __forceinline__ bf16x8 tr_read2(const u16* p0, const u16* p1) {
    s16x4 a = __builtin_amdgcn_ds_read_tr16_b64_v4i16((LAS s16x4*)p0);
    s16x4 b = __builtin_amdgcn_ds_read_tr16_b64_v4i16((LAS s16x4*)p1);
    return (bf16x8){a[0], a[1], a[2], a[3], b[0], b[1], b[2], b[3]};
}
__device__ __forceinline__ bf16x8 ld_frag_g(const u16* p) { return *(const bf16x8*)p; }

typedef unsigned u32x4_ __attribute__((ext_vector_type(4)));
__device__ __forceinline__ void nt_store16(uint4 w, void* p) { __builtin_nontemporal_store((u32x4_){w.x, w.y, w.z, w.w}, (u32x4_*)p); }
struct EpiProj {
    static constexpr bool PERM = true, AFTER_DRAIN = false;
    unsigned char* ws; int l; int is_ctx;
    __device__ __forceinline__ void operator()(const f32x4 (&acc)[2][2][4][2], const Unit& u, int wr, int wc, int fr, int fq) const {
        u16* proj = (u16*)(ws + OFF_PROJ);
        const int blk = u.pn >> 1;
        const int row0 = u.pm * 256 + wr * 64 + fr, col0 = u.pn * 256 + wc * 32 + 8 * fq;
        u16* pbase = proj + ((size_t)blk * MLAT + row0) * 512 + (col0 & 511);
        if ((blk == 0 || blk == 1) && !is_ctx) {
            u16* qrot = (u16*)(ws + OFF_QROT); const float* rope = (const float*)(ws + OFF_ROPE);
            const int f0 = 8 * (fq & 1); const float sgn = (fq >> 1) ? 1.f : -1.f;
#pragma unroll
            for (int ai = 0; ai < 2; ++ai)
#pragma unroll
                for (int m = 0; m < 4; ++m) {
                    const int row = row0 + ai * 128 + m * 16;
                    const int t = row & 4095, pos = (wc & 1) ? (t & 63) : (t >> 6);
                    const float4 c0 = *(const float4*)(rope + pos * 16 + f0), c1 = *(const float4*)(rope + pos * 16 + f0 + 4);
                    const float4 s0 = *(const float4*)(rope + 1024 + pos * 16 + f0), s1 = *(const float4*)(rope + 1024 + pos * 16 + f0 + 4);
                    const float cs[8] = {c0.x, c0.y, c0.z, c0.w, c1.x, c1.y, c1.z, c1.w}, sn[8] = {s0.x, s0.y, s0.z, s0.w, s1.x, s1.y, s1.z, s1.w};
#pragma unroll
                    for (int bj = 0; bj < 2; ++bj) {
                        const f32x4 v0 = acc[ai][bj][m][0], v1 = acc[ai][bj][m][1];
                        const float o[8] = {v0[0], v0[1], v0[2], v0[3], v1[0], v1[1], v1[2], v1[3]};
                        float r[8];
#pragma unroll
                        for (int e = 0; e < 8; ++e) { const float pr = shx(o[e], 32); r[e] = o[e] * cs[e] + sgn * pr * sn[e]; }
                        uint4 wr_; wr_.x = pack2(r[0], r[1]); wr_.y = pack2(r[2], r[3]); wr_.z = pack2(r[4], r[5]); wr_.w = pack2(r[6], r[7]);
                        u16* dst = pbase + (size_t)(ai * 128 + m * 16) * 512 + bj * 128;
                        if (blk == 0) {
                            uint4 wp; wp.x = pack2(o[0], o[1]); wp.y = pack2(o[2], o[3]); wp.z = pack2(o[4], o[5]); wp.w = pack2(o[6], o[7]);
                            nt_store16(wp, dst);
                            nt_store16(wr_, qrot + (size_t)row * 512 + (col0 & 511) + bj * 128);
                        } else nt_store16(wr_, dst);
                    }
                }
        } else if (blk == 11 || blk == 12) {
            float* logf = (float*)(ws + OFF_LOGF); const float* lb = (const float*)(ws + OFF_LB) + l * 1024;
            const int dir = blk - 11;
#pragma unroll
            for (int bj = 0; bj < 2; ++bj) {
                const int cc = (col0 & 511) + bj * 128;
                const float4 l0 = *(const float4*)(lb + dir * 512 + cc), l1 = *(const float4*)(lb + dir * 512 + cc + 4);
                const float lbv[8] = {l0.x, l0.y, l0.z, l0.w, l1.x, l1.y, l1.z, l1.w};
#pragma unroll
                for (int ai = 0; ai < 2; ++ai)
#pragma unroll
                    for (int m = 0; m < 4; ++m) {
                        const int row = row0 + ai * 128 + m * 16;
                        const f32x4 v0 = acc[ai][bj][m][0], v1 = acc[ai][bj][m][1];
                        const float z[8] = {v0[0], v0[1], v0[2], v0[3], v1[0], v1[1], v1[2], v1[3]};
                        float lf[8], o[8];
#pragma unroll
                        for (int e = 0; e < 8; ++e) {
                            const float ez = __expf(-z[e]);
                            const float inv = 1.f / (1.f + ez);
                            const float sg = inv, sgn_ = (ez > 1e30f) ? 1.f : ez * inv;
                            const float f = lbv[e] + (1.f - lbv[e]) * sg;
                            lf[e] = __logf(fmaxf(f, 1e-30f));
                            o[e] = (1.f - lbv[e]) * sgn_;
                        }
                        float* lp = logf + (size_t)row * 1024 + dir * 512 + cc;
                        __builtin_nontemporal_store((f32x4){lf[0], lf[1], lf[2], lf[3]}, (f32x4*)lp); __builtin_nontemporal_store((f32x4){lf[4], lf[5], lf[6], lf[7]}, (f32x4*)(lp + 4));
                        uint4 w; w.x = pack2(o[0], o[1]); w.y = pack2(o[2], o[3]); w.z = pack2(o[4], o[5]); w.w = pack2(o[6], o[7]);
                        nt_store16(w, pbase + (size_t)(ai * 128 + m * 16) * 512 + bj * 128);
                    }
            }
        } else {
            const bool copy = is_ctx && (blk == 1 || blk == 2);
            u16* cbase = (u16*)(ws + OFF_CTXKV) + (size_t)l * MCTX * 1024 + (size_t)row0 * 1024 + (blk - 1) * 512 + (col0 & 511);
            if (!copy) {
#pragma unroll
                for (int ai = 0; ai < 2; ++ai)
#pragma unroll
                    for (int m = 0; m < 4; ++m)
#pragma unroll
                        for (int bj = 0; bj < 2; ++bj) {
                            const f32x4 v0 = acc[ai][bj][m][0], v1 = acc[ai][bj][m][1];
                            uint4 w; w.x = pack2(v0[0], v0[1]); w.y = pack2(v0[2], v0[3]); w.z = pack2(v1[0], v1[1]); w.w = pack2(v1[2], v1[3]);
                            nt_store16(w, pbase + (size_t)(ai * 128 + m * 16) * 512 + bj * 128);
                        }
            } else {
#pragma unroll
                for (int ai = 0; ai < 2; ++ai)
#pragma unroll
                    for (int m = 0; m < 4; ++m)
#pragma unroll
                        for (int bj = 0; bj < 2; ++bj) {
                            const f32x4 v0 = acc[ai][bj][m][0], v1 = acc[ai][bj][m][1];
                            uint4 w; w.x = pack2(v0[0], v0[1]); w.y = pack2(v0[2], v0[3]); w.z = pack2(v1[0], v1[1]); w.w = pack2(v1[2], v1[3]);
                            nt_store16(w, pbase + (size_t)(ai * 128 + m * 16) * 512 + bj * 128);
                            *(uint4*)(cbase + (size_t)(ai * 128 + m * 16) * 1024 + bj * 128) = w;
                        }
            }
        }
    }
};
struct EpiMerge {
    static constexpr bool PERM = false, AFTER_DRAIN = false;
    unsigned char* ws;
    template <int MODE> __device__ __forceinline__ void run(const f32x4 (&acc)[2][2][4][2], const Unit& u, int wr, int wc, int fr, int fq) const {
        const u16* proj = (const u16*)(ws + OFF_PROJ); u16* mb = (u16*)(ws + OFF_MB);
        const int row0 = u.pm * 256 + wr * 64 + fr, col0 = u.pn * 256 + wc * 32 + 4 * fq, R = u.r;
        const int gcol0 = 7680 + R * 1024 + col0;
        const u16* gbase = proj + ((size_t)(gcol0 >> 9) * MLAT + row0) * 512 + (gcol0 & 511);
        u16* obase = mb + (size_t)row0 * 1024 + col0;
        uint2 g[2][8], old[2][8];
#define MG_LOAD(c, buf) do { _Pragma("unroll") for (int q = 0; q < 8; ++q) { const size_t ro_ = (size_t)((c) * 128 + (q >> 2) * 32 + ((c) * 0) + ((q >> 2) & 0)); (void)ro_; } } while (0)
#undef MG_LOAD
#define MG_LOAD(st, buf) do { _Pragma("unroll") for (int q = 0; q < 8; ++q) { const int ai_ = (st) >> 1, m_ = ((st) & 1) * 2 + (q >> 2), co_ = ((q >> 1) & 1) * 128 + (q & 1) * 16; const size_t ro_ = (size_t)(ai_ * 128 + m_ * 16); \
            g[buf][q] = *(const uint2*)(gbase + ro_ * 512 + co_); if (MODE > 0) old[buf][q] = *(const uint2*)(obase + ro_ * 1024 + co_); } } while (0)
        MG_LOAD(0, 0);
#pragma unroll
        for (int st = 0; st < 4; ++st) {
            const int buf = st & 1;
            if (st + 1 < 4) MG_LOAD(st + 1, buf ^ 1);
            __builtin_amdgcn_sched_barrier(0);
#pragma unroll
            for (int q = 0; q < 8; ++q) { const int ai = st >> 1, m = (st & 1) * 2 + (q >> 2), bj = (q >> 1) & 1, n = q & 1, co = bj * 128 + n * 16; const size_t ro = (size_t)(ai * 128 + m * 16);
                f32x4 v = acc[ai][bj][m][n];
                v[0] *= sigmoidf_(bflo(g[buf][q].x)); v[1] *= sigmoidf_(bfhi(g[buf][q].x)); v[2] *= sigmoidf_(bflo(g[buf][q].y)); v[3] *= sigmoidf_(bfhi(g[buf][q].y));
                if (MODE > 0) { v[0] += bflo(old[buf][q].x); v[1] += bfhi(old[buf][q].x); v[2] += bflo(old[buf][q].y); v[3] += bfhi(old[buf][q].y); }
                uint2 w; w.x = pack2(v[0], v[1]); w.y = pack2(v[2], v[3]); *(uint2*)(obase + ro * 1024 + co) = w; }
        }
#undef MG_LOAD
    }
    __device__ __forceinline__ void operator()(const f32x4 (&acc)[2][2][4][2], const Unit& u, int wr, int wc, int fr, int fq) const {
        if (u.r == 0) run<0>(acc, u, wr, wc, fr, fq);
        else run<1>(acc, u, wr, wc, fr, fq);
    }
};
struct EpiOut {
    static constexpr bool PERM = false, AFTER_DRAIN = false;
    float* C;
    __device__ __forceinline__ void operator()(const f32x4 (&acc)[2][2][4][2], const Unit& u, int wr, int wc, int fr, int fq) const {
        const int row0 = u.pm * 256 + wr * 64 + fr, col0 = u.pn * 256 + wc * 32 + 4 * fq;
#pragma unroll
        for (int ai = 0; ai < 2; ++ai)
#pragma unroll
            for (int m = 0; m < 4; ++m) { float* rowp = C + (size_t)(row0 + ai * 128 + m * 16) * 1024 + col0;
#pragma unroll
                for (int bj = 0; bj < 2; ++bj)
#pragma unroll
                    for (int n = 0; n < 2; ++n) *(f32x4*)(rowp + bj * 128 + n * 16) = acc[ai][bj][m][n]; }
    }
};

__device__ void transpose_tile(const float* src, int lds_, u16* dst, int ldd, int k0, int n0s, int n0d, u16* t) {
    const int tid = tidx();
#pragma unroll
    for (int it = 0; it < 2; ++it) {
        const int kk = (tid >> 4) + it * 32, nn = (tid & 15) * 4;
        const float4 v = *(const float4*)(src + (size_t)(k0 + kk) * lds_ + n0s + nn);
        t[(nn + 0) * 72 + kk] = f2bf(v.x); t[(nn + 1) * 72 + kk] = f2bf(v.y); t[(nn + 2) * 72 + kk] = f2bf(v.z); t[(nn + 3) * 72 + kk] = f2bf(v.w);
    }
    __syncthreads();
    { const int n = tid >> 3, k8 = (tid & 7) * 8;
      const uint4 v = *(const uint4*)(t + n * 72 + k8);
      *(uint4*)(dst + (size_t)(n0d + n) * ldd + k0 + k8) = v; }
    __syncthreads();
}

__device__ void prep1(const Params& p, unsigned char* lds) {
    unsigned char* ws = opaque(p.ws);
    const int tid = tidx();
    const size_t gt = (size_t)blockIdx.x * 512 + tid, gn = (size_t)gridDim.x * 512;
    { u16* ws16 = (u16*)(ws + OFF_WS16);
      for (size_t i = gt; i < (size_t)DEPTH * 8 * 128 * 128; i += gn) ws16[i] = f2bf(p.gmlp_ws[i]);
      float* lbp = (float*)(ws + OFF_LB);
      for (size_t i = gt; i < 1024; i += gn) {
          float e[DEPTH], mx = -1e30f, sum = 0.f;
#pragma unroll
          for (int l = 0; l < DEPTH; ++l) { e[l] = p.lb_logits[l * 1024 + i]; mx = fmaxf(mx, e[l]); }
#pragma unroll
          for (int l = 0; l < DEPTH; ++l) { e[l] = expf(e[l] - mx); sum += e[l]; }
          float run = 0.f;
#pragma unroll
          for (int l = 0; l < DEPTH; ++l) { if (l > 0) run += e[l] / sum; lbp[l * 1024 + i] = fmaxf(run, 0.f); }
      }
      float* rope = (float*)(ws + OFF_ROPE);
      for (size_t i = gt; i < 1024; i += gn) { const int pos = (int)(i >> 4), f = (int)(i & 15);
          const float inv = powf(10000.f, -(float)f * 2.0f / 32.0f), ang = (float)pos * inv;
          rope[i] = cosf(ang); rope[1024 + i] = sinf(ang); }
      float* tw = (float*)(ws + OFF_TW);
      for (size_t i = gt; i < 4096; i += gn) { float s, c; sincospif((float)i * (2.0f / 4096.0f), &s, &c); tw[2 * i] = c; tw[2 * i + 1] = s; }
      u16* m1 = (u16*)(ws + OFF_M1);
      for (size_t i = gt; i < 128 * 128; i += gn) { const int ii = (int)(i >> 7), kk = (int)(i & 127), k1 = ii >> 1, po = ii & 1, n1 = kk >> 1, pi = kk & 1;
          float s, c; sincospif((float)((k1 * n1) & 63) * (2.0f / 64.0f), &s, &c);
          const float v = (po == 0) ? (pi == 0 ? c : -s) : (pi == 0 ? -s : -c);
          m1[i] = f2bf(v); }
      u16* m2 = (u16*)(ws + OFF_M2);
      for (size_t i = gt; i < 64 * 128; i += gn) { const int k2 = (int)(i >> 7), kk = (int)(i & 127), n2 = kk >> 1, pi = kk & 1;
          float s, c; sincospif((float)((k2 * n2) & 63) * (2.0f / 64.0f), &s, &c);
          m2[i] = f2bf(pi == 0 ? c : s); }
      u16* m3 = (u16*)(ws + OFF_M3);
      for (size_t i = gt; i < 256 * 512; i += gn) { const int k = (int)(i >> 9), kk = (int)(i & 511), n = kk >> 1, pi = kk & 1;
          float s, c; sincospif((float)((k * n) & 255) * (2.0f / 256.0f), &s, &c);
          m3[i] = f2bf(pi == 0 ? c : -s); }
    }
    constexpr int N_WIN = DEPTH * 176 * 16, N_WBR = 16 * 16 * 8, N_WOUT = DEPTH * 16 * 16, N_MOD = DEPTH * 48, N_CSW = DEPTH * 4 * 2 * 2;
    constexpr int TOT = N_WIN + N_WBR + N_WOUT + N_MOD + N_CSW;
    for (int it = blockIdx.x; it < TOT; it += gridDim.x) {
        int idx = it;
        if (idx < N_WIN) {
            const int l = idx / 2816, rem = idx % 2816, cb = rem >> 4, kb = rem & 15, n0 = cb * 64;
            if (n0 >= 2048 && n0 < 2560) continue;
            const int n0d = n0 < 2048 ? n0 : n0 + 512;
            transpose_tile(p.w_in + (size_t)l * DM * NIN, NIN, (u16*)(ws + OFF_WTIN) + (size_t)l * NPROJ * DM, DM, kb * 64, n0, n0d, (u16*)lds);
            continue;
        }
        idx -= N_WIN;
        if (idx < N_WBR) {
            const int mat = idx >> 7, rem = idx & 127, cb = rem >> 3, kb = rem & 7;
            transpose_tile(p.w_branch + (size_t)mat * 512 * 1024, 1024, (u16*)(ws + OFF_WTBR) + (size_t)mat * 1024 * 512, 512, kb * 64, cb * 64, cb * 64, (u16*)lds);
            continue;
        }
        idx -= N_WBR;
        if (idx < N_WOUT) {
            const int l = idx >> 8, rem = idx & 255, cb = rem >> 4, kb = rem & 15;
            transpose_tile(p.w_out + (size_t)l * 1024 * 1024, 1024, (u16*)(ws + OFF_WTOUT) + (size_t)l * 1024 * 1024, 1024, kb * 64, cb * 64, cb * 64, (u16*)lds);
            continue;
        }
        idx -= N_WOUT;
        if (idx < N_MOD) {
            const int l = idx / 48, cb = idx % 48;
            float* s = (float*)lds; float* red = s + 17 * 1024;
            for (int i = tid; i < 17 * 1024; i += 512) { const int j = i >> 10, k = i & 1023; const float v = j < 16 ? p.c[j * 1024 + k] : p.c_ctx[k]; s[i] = v / (1.f + expf(-v)); }
            __syncthreads();
            const int col = tid & 63, ks = tid >> 6;
            float acc[17];
#pragma unroll
            for (int j = 0; j < 17; ++j) acc[j] = 0.f;
            for (int k = ks * 128; k < ks * 128 + 128; ++k) {
                const float w = p.w_ada[((size_t)l * 1024 + k) * 3072 + cb * 64 + col];
#pragma unroll
                for (int j = 0; j < 17; ++j) acc[j] += s[j * 1024 + k] * w;
            }
#pragma unroll
            for (int j = 0; j < 17; ++j) red[(ks * 17 + j) * 64 + col] = acc[j];
            __syncthreads();
            for (int o = tid; o < 17 * 64; o += 512) { const int j = o >> 6, cc = o & 63; float sum = 0.f;
                for (int q = 0; q < 8; ++q) sum += red[(q * 17 + j) * 64 + cc];
                ((float*)(ws + OFF_MOD))[((size_t)l * 17 + j) * 3072 + cb * 64 + cc] = sum + p.b_ada[l * 3072 + cb * 64 + cc]; }
            __syncthreads();
            continue;
        }
        idx -= N_MOD;
        {
            const int cblk = idx & 1, part = (idx >> 1) & 1, g = (idx >> 2) & 3, l = idx >> 4;
            float* tb = (float*)lds;
            if (tid < 128) { float s, c; sincospif((float)tid * (2.0f / 128.0f), &s, &c); tb[tid] = part ? s : c; }
            __syncthreads();
            const int d = tid & 127, cq = tid >> 7;
            float acc[16];
#pragma unroll
            for (int i = 0; i < 16; ++i) acc[i] = 0.f;
            const float* wf = p.fnet_w + ((size_t)(l * 4 + g) * 128) * 128;
            for (int c2 = 0; c2 < 128; ++c2) {
                const float w = wf[c2 * 128 + d];
#pragma unroll
                for (int i = 0; i < 16; ++i) { const int c = cblk * 64 + cq * 16 + i; acc[i] += tb[(c * c2) & 127] * w; }
            }
            float* dst = (float*)(ws + OFF_CSW) + ((size_t)((l * 4 + g) * 2 + part) * 128) * 128;
#pragma unroll
            for (int i = 0; i < 16; ++i) dst[(cblk * 64 + cq * 16 + i) * 128 + d] = acc[i];
            __syncthreads();
        }
    }
}

__device__ void prep2(const Params& p, unsigned char* lds) {
    unsigned char* ws = opaque(p.ws);
    const int tid = tidx();
    float* wb = (float*)lds;
    float* cw = wb + 64 * 129;
    for (int it = blockIdx.x; it < DEPTH * 4 * 2 * 16; it += gridDim.x) {
        const int kb = it & 15, part = (it >> 4) & 1, g = (it >> 5) & 3, l = it >> 7;
        for (int i = tid; i < 64 * 128; i += 512) { const int kk = i >> 7, c = i & 127; wb[kk * 129 + c] = p.w_in[((size_t)l * 1024 + kb * 64 + kk) * NIN + 2048 + g * 128 + c]; }
        const float* src = (const float*)(ws + OFF_CSW) + ((size_t)((l * 4 + g) * 2 + part) * 128) * 128;
        for (int i = tid; i < 128 * 128; i += 512) cw[i] = src[i];
        __syncthreads();
        const int d = tid & 127, kq = tid >> 7;
        float acc[16];
#pragma unroll
        for (int i = 0; i < 16; ++i) acc[i] = 0.f;
        for (int c = 0; c < 128; ++c) {
            const float w = cw[c * 128 + d];
#pragma unroll
            for (int i = 0; i < 16; ++i) acc[i] += wb[(kq * 16 + i) * 129 + c] * w;
        }
        u16* dst = (u16*)(ws + OFF_WTIN) + ((size_t)l * NPROJ + (4 + part) * 512 + g * 128 + d) * DM + kb * 64 + kq * 16;
        uint4 w0, w1;
        w0.x = pack2(acc[0], acc[1]); w0.y = pack2(acc[2], acc[3]); w0.z = pack2(acc[4], acc[5]); w0.w = pack2(acc[6], acc[7]);
        w1.x = pack2(acc[8], acc[9]); w1.y = pack2(acc[10], acc[11]); w1.z = pack2(acc[12], acc[13]); w1.w = pack2(acc[14], acc[15]);
        *(uint4*)dst = w0; *(uint4*)(dst + 8) = w1;
        __syncthreads();
    }
}

__device__ void phase_norm(const Params& p, const PassInfo ps, int l) {
    unsigned char* ws = opaque(p.ws);
    const int wave = tidx() >> 6, lane = tidx() & 63;
    const float* mod = (const float*)(ws + OFF_MOD);
    const float* OUT = (const float*)(ws + OFF_OUT);
    u16* H = (u16*)(ws + OFF_H);
    for (int rr = blockIdx.x * 8 + wave; rr < ps.M; rr += gridDim.x * 8) {
        const int tsh = ps.is_ctx ? 8 : 12; const int b = ps.b0 + (rr >> tsh), t = rr & (ps.T - 1), mrow = ps.is_ctx ? 16 : b;
        const size_t xoff = ((size_t)b * ps.T + t) * 1024;
        const float* xin = (l <= 1) ? ((ps.is_ctx ? p.ctx : p.x) + xoff) : ((ps.is_ctx ? (const float*)(ws + OFF_CTXW) : (const float*)p.out) + xoff);
        float* xout = (ps.is_ctx ? (float*)(ws + OFF_CTXW) : p.out) + xoff;
        float xv[16];
#pragma unroll
        for (int hlf = 0; hlf < 2; ++hlf) {
            const int c0 = hlf * 512 + lane * 8;
            const float4 a = *(const float4*)(xin + c0), bq = *(const float4*)(xin + c0 + 4);
            xv[hlf * 8 + 0] = a.x; xv[hlf * 8 + 1] = a.y; xv[hlf * 8 + 2] = a.z; xv[hlf * 8 + 3] = a.w;
            xv[hlf * 8 + 4] = bq.x; xv[hlf * 8 + 5] = bq.y; xv[hlf * 8 + 6] = bq.z; xv[hlf * 8 + 7] = bq.w;
        }
        if (l > 0) {
            float ov[16]; float ss = 0.f;
#pragma unroll
            for (int hlf = 0; hlf < 2; ++hlf) {
                const int c0 = hlf * 512 + lane * 8;
                const float4 a = *(const float4*)(OUT + (size_t)rr * 1024 + c0), bq = *(const float4*)(OUT + (size_t)rr * 1024 + c0 + 4);
                ov[hlf * 8 + 0] = a.x; ov[hlf * 8 + 1] = a.y; ov[hlf * 8 + 2] = a.z; ov[hlf * 8 + 3] = a.w;
                ov[hlf * 8 + 4] = bq.x; ov[hlf * 8 + 5] = bq.y; ov[hlf * 8 + 6] = bq.z; ov[hlf * 8 + 7] = bq.w;
            }
#pragma unroll
            for (int e = 0; e < 16; ++e) ss += ov[e] * ov[e];
#pragma unroll
            for (int o = 32; o > 0; o >>= 1) ss += shx(ss, o);
            const float rstd = rsqrtf(ss * (1.f / 1024.f) + EPSN);
            const float* gt = mod + ((size_t)(l - 1) * 17 + mrow) * 3072 + 2048;
            const float* gp = p.g_post + (l - 1) * 1024;
#pragma unroll
            for (int hlf = 0; hlf < 2; ++hlf) {
                const int c0 = hlf * 512 + lane * 8;
#pragma unroll
                for (int e = 0; e < 8; ++e) xv[hlf * 8 + e] += gt[c0 + e] * (ov[hlf * 8 + e] * rstd * gp[c0 + e]);
                *(float4*)(xout + c0) = make_float4(xv[hlf * 8 + 0], xv[hlf * 8 + 1], xv[hlf * 8 + 2], xv[hlf * 8 + 3]);
                *(float4*)(xout + c0 + 4) = make_float4(xv[hlf * 8 + 4], xv[hlf * 8 + 5], xv[hlf * 8 + 6], xv[hlf * 8 + 7]);
            }
        }
        if (l < DEPTH) {
            float ss = 0.f;
#pragma unroll
            for (int e = 0; e < 16; ++e) ss += xv[e] * xv[e];
#pragma unroll
            for (int o = 32; o > 0; o >>= 1) ss += shx(ss, o);
            const float rstd = rsqrtf(ss * (1.f / 1024.f) + EPSN);
            const float* sh = mod + ((size_t)l * 17 + mrow) * 3072; const float* sc = sh + 1024;
            const float* gp = p.g_pre + l * 1024;
#pragma unroll
            for (int hlf = 0; hlf < 2; ++hlf) {
                const int c0 = hlf * 512 + lane * 8;
                float hv[8];
#pragma unroll
                for (int e = 0; e < 8; ++e) hv[e] = xv[hlf * 8 + e] * rstd * gp[c0 + e] * (1.f + sc[c0 + e]) + sh[c0 + e];
                uint4 w; w.x = pack2(hv[0], hv[1]); w.y = pack2(hv[2], hv[3]); w.z = pack2(hv[4], hv[5]); w.w = pack2(hv[6], hv[7]);
                *(uint4*)(H + (size_t)rr * 1024 + c0) = w;
            }
        }
    }
}

#define PJ(row, blk, c) (PROJ + ((size_t)(blk) * MLAT + (row)) * 512 + (c))
typedef unsigned u32x32_ __attribute__((ext_vector_type(32)));
struct Reg8 {
    u32x32_ v;
    __device__ __forceinline__ void ld(int i, const void* p) { const u32x4_ a = *(const u32x4_*)p; v[4 * i] = a[0]; v[4 * i + 1] = a[1]; v[4 * i + 2] = a[2]; v[4 * i + 3] = a[3]; }
    __device__ __forceinline__ u32x4_ get(int i) const { return (u32x4_){v[4 * i], v[4 * i + 1], v[4 * i + 2], v[4 * i + 3]}; }
    __device__ __forceinline__ uint4 getu(int i) const { uint4 r; r.x = v[4 * i]; r.y = v[4 * i + 1]; r.z = v[4 * i + 2]; r.w = v[4 * i + 3]; return r; }
};
#define MEMBAR() asm volatile("" ::: "memory")
constexpr int KVS = 72;
constexpr int TS = 528;
constexpr int T3S = 136;
constexpr int HS_ = 68;
constexpr float NORM_LAT = 0.0013810679320049757f;
constexpr float NORM_CTX = 0.005524271728019903f;

__device__ void attn_item(const Params& p, const PassInfo ps, int l, int item, unsigned char* lds) {
    unsigned char* ws = opaque(p.ws);
    const u16* PROJ = (const u16*)(ws + OFF_PROJ); const u16* QROT = (const u16*)(ws + OFF_QROT);
    const u16* CKV = (const u16*)(ws + OFF_CTXKV) + (size_t)l * MCTX * 1024;
    u16* Y0 = (u16*)(ws + OFF_Y);
    const int tid = tidx(), w = tid >> 6, lane = tid & 63, qtr = w & 3, kh = w >> 2, li = lane & 15, quad = lane >> 4;
    u16* Kl = (u16*)lds; u16* Vl = Kl + 512 * KVS; float* rp = (float*)(Vl + 512 * KVS);
    int bl, h, r = 0, qrow0, bglob;
    if (!ps.is_ctx) { r = item & 63; h = (item >> 6) & 7; bl = item >> 9; qrow0 = bl * 4096 + r * 64; bglob = ps.b0 + bl; }
    else { const int qb = item & 3; h = (item >> 2) & 7; bl = item >> 5; qrow0 = bl * 256 + qb * 64; bglob = bl; }
    const int qrow = qrow0 + qtr * 16 + li;
    float m_run = -1e30f, l_run = 0.f;
    f32x4 O[4];
#pragma unroll
    for (int d = 0; d < 4; ++d) O[d] = (f32x4){0.f, 0.f, 0.f, 0.f};
    if (!ps.is_ctx) {
        const int rs = min(max(r - 4, 0), 56);
        const size_t krow0 = (size_t)bl * 4096 + rs * 64;
        { u32x32_ kr, vr;
#pragma unroll
          for (int i = 0; i < 8; ++i) { const int idx = tid + 512 * i, key = idx >> 3, ch = idx & 7;
              const u32x4_ a = *(const u32x4_*)(PJ(krow0 + key, 1, h * 64 + ch * 8)), b = *(const u32x4_*)(PJ(krow0 + key, 2, h * 64 + ch * 8));
              kr[4 * i] = a[0]; kr[4 * i + 1] = a[1]; kr[4 * i + 2] = a[2]; kr[4 * i + 3] = a[3]; vr[4 * i] = b[0]; vr[4 * i + 1] = b[1]; vr[4 * i + 2] = b[2]; vr[4 * i + 3] = b[3]; }
          asm volatile("" ::: "memory");
#pragma unroll
          for (int i = 0; i < 8; ++i) { const int idx = tid + 512 * i, key = idx >> 3, ch = idx & 7;
              *(u32x4_*)(Kl + key * KVS + ch * 8) = (u32x4_){kr[4 * i], kr[4 * i + 1], kr[4 * i + 2], kr[4 * i + 3]}; *(u32x4_*)(Vl + key * KVS + ch * 8) = (u32x4_){vr[4 * i], vr[4 * i + 1], vr[4 * i + 2], vr[4 * i + 3]}; } }
        for (int i = tid; i < 465; i += 512) rp[i] = p.rpb[((size_t)l * 8 + h) * 465 + i];
        __syncthreads();
        const int cbase = (qtr == 0) ? 0 : (qtr == 1 ? 8 : (qtr == 2 ? 24 : 32));
        const bf16x8 q0 = ld_frag_g(QROT + (size_t)qrow * 512 + h * 64 + quad * 8), q1 = ld_frag_g(QROT + (size_t)qrow * 512 + h * 64 + 32 + quad * 8);
        const int qc = qtr * 16 + li, cst = min(max(qc - 8, 0), 48);
        float s[8][4];
        float mx = -1e30f;
#pragma unroll
        for (int sb = 0; sb < 8; ++sb) {
            const int i = kh * 4 + (sb >> 1), cs = sb & 1;
            const u16* kp = Kl + (i * 64 + cbase + cs * 16 + li) * KVS + quad * 8;
            f32x4 a = (f32x4){0.f, 0.f, 0.f, 0.f};
            a = MFMA16(*(const bf16x8*)kp, q0, a); a = MFMA16(*(const bf16x8*)(kp + 32), q1, a);
            const int ridx = rs + i - r + 7;
#pragma unroll
            for (int j = 0; j < 4; ++j) { const int kc = cbase + cs * 16 + quad * 4 + j;
                const bool valid = (kc >= cst) && (kc < cst + 16);
                const int cidx = min(max(kc - qc + 15, 0), 30);
                const float v = valid ? (a[j] * 0.125f + rp[ridx * 31 + cidx]) : -1e30f;
                s[sb][j] = v; mx = fmaxf(mx, v); }
        }
        mx = fmaxf(mx, shx(mx, 16)); mx = fmaxf(mx, shx(mx, 32));
        m_run = mx;
        float ls = 0.f;
#pragma unroll
        for (int sb = 0; sb < 8; ++sb)
#pragma unroll
            for (int j = 0; j < 4; ++j) { const float e = __expf(s[sb][j] - mx); s[sb][j] = e; ls += e; }
        ls += shx(ls, 16); ls += shx(ls, 32);
        l_run = ls;
#pragma unroll
        for (int kp2 = 0; kp2 < 4; ++kp2) {
            bf16x8 pf; { const unsigned a0 = pack2(s[2 * kp2][0], s[2 * kp2][1]), a1 = pack2(s[2 * kp2][2], s[2 * kp2][3]), b0 = pack2(s[2 * kp2 + 1][0], s[2 * kp2 + 1][1]), b1 = pack2(s[2 * kp2 + 1][2], s[2 * kp2 + 1][3]);
                pf = (bf16x8){(short)(a0 & 0xffff), (short)(a0 >> 16), (short)(a1 & 0xffff), (short)(a1 >> 16), (short)(b0 & 0xffff), (short)(b0 >> 16), (short)(b1 & 0xffff), (short)(b1 >> 16)}; }
            const int vrow0 = (kh * 4 + kp2) * 64 + cbase + quad * 4 + (li >> 2);
#pragma unroll
            for (int d = 0; d < 4; ++d) {
                const u16* vp = Vl + vrow0 * KVS + d * 16 + 4 * (li & 3);
                const bf16x8 vf = tr_read2(vp, vp + 16 * KVS);
                O[d] = MFMA16(vf, pf, O[d]);
            }
        }
        __syncthreads();
    }
    {
        const size_t crow0 = (size_t)bglob * 256;
        { Reg8 rg;
#pragma unroll
          for (int i = 0; i < 4; ++i) { const int idx = tid + 512 * i, key = idx >> 3, ch = idx & 7;
              rg.ld(2 * i, CKV + (crow0 + key) * 1024 + h * 64 + ch * 8); rg.ld(2 * i + 1, CKV + (crow0 + key) * 1024 + 512 + h * 64 + ch * 8); }
          MEMBAR();
#pragma unroll
          for (int i = 0; i < 4; ++i) { const int idx = tid + 512 * i, key = idx >> 3, ch = idx & 7;
              *(u32x4_*)(Kl + key * KVS + ch * 8) = rg.get(2 * i); *(u32x4_*)(Vl + key * KVS + ch * 8) = rg.get(2 * i + 1); } }
        __syncthreads();
        const bf16x8 q0 = ld_frag_g(PJ(qrow, 0, h * 64 + quad * 8)), q1 = ld_frag_g(PJ(qrow, 0, h * 64 + 32 + quad * 8));
        float s[8][4];
        float mx = -1e30f;
#pragma unroll
        for (int sb = 0; sb < 8; ++sb) {
            const u16* kp = Kl + (kh * 128 + sb * 16 + li) * KVS + quad * 8;
            f32x4 a = (f32x4){0.f, 0.f, 0.f, 0.f};
            a = MFMA16(*(const bf16x8*)kp, q0, a); a = MFMA16(*(const bf16x8*)(kp + 32), q1, a);
#pragma unroll
            for (int j = 0; j < 4; ++j) { const float v = a[j] * 0.125f; s[sb][j] = v; mx = fmaxf(mx, v); }
        }
        mx = fmaxf(mx, shx(mx, 16)); mx = fmaxf(mx, shx(mx, 32));
        const float m_new = fmaxf(m_run, mx), resc = __expf(m_run - m_new);
        float ls = 0.f;
#pragma unroll
        for (int sb = 0; sb < 8; ++sb)
#pragma unroll
            for (int j = 0; j < 4; ++j) { const float e = __expf(s[sb][j] - m_new); s[sb][j] = e; ls += e; }
        ls += shx(ls, 16); ls += shx(ls, 32);
        l_run = l_run * resc + ls; m_run = m_new;
#pragma unroll
        for (int d = 0; d < 4; ++d) O[d] *= resc;
#pragma unroll
        for (int kp2 = 0; kp2 < 4; ++kp2) {
            bf16x8 pf; { const unsigned a0 = pack2(s[2 * kp2][0], s[2 * kp2][1]), a1 = pack2(s[2 * kp2][2], s[2 * kp2][3]), b0 = pack2(s[2 * kp2 + 1][0], s[2 * kp2 + 1][1]), b1 = pack2(s[2 * kp2 + 1][2], s[2 * kp2 + 1][3]);
                pf = (bf16x8){(short)(a0 & 0xffff), (short)(a0 >> 16), (short)(a1 & 0xffff), (short)(a1 >> 16), (short)(b0 & 0xffff), (short)(b0 >> 16), (short)(b1 & 0xffff), (short)(b1 >> 16)}; }
            const int vrow0 = kh * 128 + kp2 * 32 + quad * 4 + (li >> 2);
#pragma unroll
            for (int d = 0; d < 4; ++d) {
                const u16* vp = Vl + vrow0 * KVS + d * 16 + 4 * (li & 3);
                const bf16x8 vf = tr_read2(vp, vp + 16 * KVS);
                O[d] = MFMA16(vf, pf, O[d]);
            }
        }
        __syncthreads();
    }
    float* cb = (float*)lds;
    if (kh == 1) {
#pragma unroll
        for (int d = 0; d < 4; ++d)
#pragma unroll
            for (int j = 0; j < 4; ++j) cb[(qtr * 18 + d * 4 + j) * 64 + lane] = O[d][j];
        cb[(qtr * 18 + 16) * 64 + lane] = m_run; cb[(qtr * 18 + 17) * 64 + lane] = l_run;
    }
    __syncthreads();
    if (kh == 0) {
        const float m2 = cb[(qtr * 18 + 16) * 64 + lane], l2 = cb[(qtr * 18 + 17) * 64 + lane];
        const float mm = fmaxf(m_run, m2), e1 = __expf(m_run - mm), e2 = __expf(m2 - mm);
        const float inv = 1.f / (l_run * e1 + l2 * e2);
#pragma unroll
        for (int d = 0; d < 4; ++d) {
            const int col = h * 64 + d * 16 + quad * 4;
            const uint2 g = *(const uint2*)(PJ(qrow, 3, col));
            float o[4];
#pragma unroll
            for (int j = 0; j < 4; ++j) o[j] = (O[d][j] * e1 + cb[(qtr * 18 + d * 4 + j) * 64 + lane] * e2) * inv;
            uint2 wv; wv.x = pack2(o[0] * siluf_(bflo(g.x)), o[1] * siluf_(bfhi(g.x))); wv.y = pack2(o[2] * siluf_(bflo(g.y)), o[3] * siluf_(bfhi(g.y)));
            *(uint2*)(Y0 + (size_t)qrow * 512 + col) = wv;
        }
    }
    __syncthreads();
}

template <int ROWS, int CPR> __device__ __forceinline__ void load_tile(u16* dstl, int lstride, const u16* src, size_t sstride) {
    constexpr int PER = ROWS * CPR / 512;
    static_assert(PER % 8 == 0, "tile size");
    const int tid_ = tidx();
#pragma unroll
    for (int b8 = 0; b8 < PER / 8; ++b8) { Reg8 rg;
#pragma unroll
        for (int j = 0; j < 8; ++j) { const int i = tid_ + 512 * (b8 * 8 + j), r = i / CPR, ch = i % CPR; rg.ld(j, src + (size_t)r * sstride + ch * 8); }
        MEMBAR();
#pragma unroll
        for (int j = 0; j < 8; ++j) { const int i = tid_ + 512 * (b8 * 8 + j), r = i / CPR, ch = i % CPR; *(u32x4_*)(dstl + r * lstride + ch * 8) = rg.get(j); }
        MEMBAR(); }
}

__device__ void four1_item(const Params& p, int item, unsigned char* lds) {
    unsigned char* ws = opaque(p.ws);
    const u16* PROJ = (const u16*)(ws + OFF_PROJ); const u16* M1 = (const u16*)(ws + OFF_M1); const float* TW = (const float*)(ws + OFF_TW);
    u16* FY = (u16*)(ws + OFF_FY);
    const int tid = tidx(), w = tid >> 6, lane = tid & 63, li = lane & 15, quad = lane >> 4;
    const int n2 = item & 63, bl = item >> 6;
    u16* T = (u16*)lds;
#pragma unroll
    for (int b8 = 0; b8 < 2; ++b8) { Reg8 rg;
#pragma unroll
        for (int j = 0; j < 8; ++j) { const int i = tid + 512 * (b8 * 8 + j), kk = i >> 6, ch = i & 63, n1 = kk >> 1, part = kk & 1;
            rg.ld(j, PJ((size_t)bl * 4096 + n1 * 64 + n2, 4 + part, ch * 8)); }
        MEMBAR();
#pragma unroll
        for (int j = 0; j < 8; ++j) { const int i = tid + 512 * (b8 * 8 + j), kk = i >> 6, ch = i & 63;
            *(u32x4_*)(T + kk * TS + ch * 8) = rg.get(j); }
        MEMBAR(); }
    __syncthreads();
    for (int isub = 0; isub < 8; ++isub) {
        bf16x8 xf[4];
#pragma unroll
        for (int ks = 0; ks < 4; ++ks) xf[ks] = ld_frag_g(M1 + (isub * 16 + li) * 128 + ks * 32 + quad * 8);
#pragma unroll
        for (int cs = 0; cs < 4; ++cs) {
            const int c0 = w * 64 + cs * 16;
            f32x4 a = (f32x4){0.f, 0.f, 0.f, 0.f};
#pragma unroll
            for (int ks = 0; ks < 4; ++ks) {
                const u16* tp = T + (ks * 32 + quad * 8 + (li >> 2)) * TS + c0 + 4 * (li & 3);
                a = MFMA16(xf[ks], tr_read2(tp, tp + 4 * TS), a);
            }
            const int ch = c0 + li;
#pragma unroll
            for (int hh = 0; hh < 2; ++hh) {
                const int k1 = isub * 8 + quad * 2 + hh;
                const float yr = a[2 * hh], yi = a[2 * hh + 1];
                const float tc = TW[2 * (n2 * k1)], tsn = TW[2 * (n2 * k1) + 1];
                const float orr = yr * tc + yi * tsn, oi = yi * tc - yr * tsn;
                u16* dst = FY + (((size_t)bl * 64 + k1) * 64 + n2) * 1024 + ch;
                dst[0] = f2bf(orr); dst[512] = f2bf(oi);
            }
        }
    }
    __syncthreads();
}

__device__ void four2_item(const Params& p, int item, unsigned char* lds) {
    unsigned char* ws = opaque(p.ws);
    const u16* PROJ = (const u16*)(ws + OFF_PROJ); const u16* M2 = (const u16*)(ws + OFF_M2); const u16* FY = (const u16*)(ws + OFF_FY);
    u16* Y1 = (u16*)(ws + OFF_Y) + (size_t)1 * MLAT * 512;
    const int tid = tidx(), w = tid >> 6, lane = tid & 63, li = lane & 15, quad = lane >> 4;
    const int k1 = item & 63, bl = item >> 6;
    u16* T = (u16*)lds;
    load_tile<128, 64>(T, TS, FY + ((size_t)bl * 64 + k1) * 64 * 1024, 512);
    __syncthreads();
    bf16x8 xf[4][4];
#pragma unroll
    for (int cs = 0; cs < 4; ++cs)
#pragma unroll
        for (int ks = 0; ks < 4; ++ks) { const u16* tp = T + (ks * 32 + quad * 8 + (li >> 2)) * TS + w * 64 + cs * 16 + 4 * (li & 3); xf[cs][ks] = tr_read2(tp, tp + 4 * TS); }
    for (int k2s = 0; k2s < 4; ++k2s) {
        bf16x8 yf[4];
#pragma unroll
        for (int ks = 0; ks < 4; ++ks) yf[ks] = ld_frag_g(M2 + (k2s * 16 + li) * 128 + ks * 32 + quad * 8);
        const int k2 = k2s * 16 + li;
        const size_t row = (size_t)bl * 4096 + k1 + 64 * k2;
#pragma unroll
        for (int cs = 0; cs < 4; ++cs) {
            f32x4 a = (f32x4){0.f, 0.f, 0.f, 0.f};
#pragma unroll
            for (int ks = 0; ks < 4; ++ks) a = MFMA16(xf[cs][ks], yf[ks], a);
            const int ch = w * 64 + cs * 16 + quad * 4;
            const uint2 g = *(const uint2*)(PJ(row, 6, ch));
            uint2 wv; wv.x = pack2(a[0] * NORM_LAT * siluf_(bflo(g.x)), a[1] * NORM_LAT * siluf_(bfhi(g.x))); wv.y = pack2(a[2] * NORM_LAT * siluf_(bflo(g.y)), a[3] * NORM_LAT * siluf_(bfhi(g.y)));
            *(uint2*)(Y1 + row * 512 + ch) = wv;
        }
    }
    __syncthreads();
}

__device__ void fourc_item(const Params& p, int item, unsigned char* lds) {
    unsigned char* ws = opaque(p.ws);
    const u16* PROJ = (const u16*)(ws + OFF_PROJ); const u16* M3 = (const u16*)(ws + OFF_M3);
    u16* Y1 = (u16*)(ws + OFF_Y) + (size_t)1 * MLAT * 512;
    const int tid = tidx(), w = tid >> 6, lane = tid & 63, li = lane & 15, quad = lane >> 4;
    const int chb = item & 3, b = item >> 2;
    u16* T = (u16*)lds;
#pragma unroll
    for (int b8 = 0; b8 < 2; ++b8) { Reg8 rg;
#pragma unroll
        for (int j = 0; j < 8; ++j) { const int i = tid + 512 * (b8 * 8 + j), kk = i >> 4, ch = i & 15, n = kk >> 1, part = kk & 1;
            rg.ld(j, PJ((size_t)b * 256 + n, 4 + part, chb * 128 + ch * 8)); }
        MEMBAR();
#pragma unroll
        for (int j = 0; j < 8; ++j) { const int i = tid + 512 * (b8 * 8 + j), kk = i >> 4, ch = i & 15;
            *(u32x4_*)(T + kk * T3S + ch * 8) = rg.get(j); }
        MEMBAR(); }
    __syncthreads();
    for (int kq = 0; kq < 2; ++kq) {
        const int ksub = w * 2 + kq;
        f32x4 a[8];
#pragma unroll
        for (int cs = 0; cs < 8; ++cs) a[cs] = (f32x4){0.f, 0.f, 0.f, 0.f};
        for (int ks = 0; ks < 16; ++ks) {
            const bf16x8 yf = ld_frag_g(M3 + (ksub * 16 + li) * 512 + ks * 32 + quad * 8);
#pragma unroll
            for (int cs = 0; cs < 8; ++cs) { const u16* tp = T + (ks * 32 + quad * 8 + (li >> 2)) * T3S + cs * 16 + 4 * (li & 3);
                a[cs] = MFMA16(tr_read2(tp, tp + 4 * T3S), yf, a[cs]); }
        }
        const size_t row = (size_t)b * 256 + ksub * 16 + li;
#pragma unroll
        for (int cs = 0; cs < 8; ++cs) {
            const int ch = chb * 128 + cs * 16 + quad * 4;
            const uint2 g = *(const uint2*)(PJ(row, 6, ch));
            uint2 wv; wv.x = pack2(a[cs][0] * NORM_CTX * siluf_(bflo(g.x)), a[cs][1] * NORM_CTX * siluf_(bfhi(g.x))); wv.y = pack2(a[cs][2] * NORM_CTX * siluf_(bflo(g.y)), a[cs][3] * NORM_CTX * siluf_(bfhi(g.y)));
            *(uint2*)(Y1 + row * 512 + ch) = wv;
        }
    }
    __syncthreads();
}

__device__ void gmlp_item(const Params& p, int l, int item, unsigned char* lds) {
    unsigned char* ws = opaque(p.ws);
    const u16* PROJ = (const u16*)(ws + OFF_PROJ); const u16* WS16 = (const u16*)(ws + OFF_WS16) + (size_t)l * 8 * 128 * 128;
    u16* Y2 = (u16*)(ws + OFF_Y) + (size_t)2 * MLAT * 512;
    const int tid = tidx(), w = tid >> 6, lane = tid & 63, li = lane & 15, quad = lane >> 4;
    const size_t r0 = (size_t)item * 128;
    u16* VN = (u16*)lds;
    {
        const int row = tid >> 2, qd = tid & 3;
        const u16* src = PJ(r0 + row, 8, 0);
        uint4 raw[16]; float ss = 0.f;
#pragma unroll
        for (int i = 0; i < 16; ++i) { raw[i] = *(const uint4*)(src + (qd + 4 * i) * 8); float f[8]; unpack8(raw[i], f);
#pragma unroll
            for (int e = 0; e < 8; ++e) ss += f[e] * f[e]; }
        ss += shx(ss, 1); ss += shx(ss, 2);
        const float rstd = rsqrtf(ss * (1.f / 512.f) + EPSN);
        const float* gn = p.gmlp_g + l * 512;
#pragma unroll
        for (int i = 0; i < 16; ++i) { float f[8]; unpack8(raw[i], f); const int c0 = (qd + 4 * i) * 8;
            const float4 g0 = *(const float4*)(gn + c0), g1 = *(const float4*)(gn + c0 + 4);
            uint4 o; o.x = pack2(f[0] * rstd * g0.x, f[1] * rstd * g0.y); o.y = pack2(f[2] * rstd * g0.z, f[3] * rstd * g0.w);
            o.z = pack2(f[4] * rstd * g1.x, f[5] * rstd * g1.y); o.w = pack2(f[6] * rstd * g1.z, f[7] * rstd * g1.w);
            *(uint4*)(VN + row * TS + c0) = o; }
    }
    __syncthreads();
    const int g = w;
    bf16x8 xf[4][4];
#pragma unroll
    for (int cs = 0; cs < 4; ++cs)
#pragma unroll
        for (int ks = 0; ks < 4; ++ks) { const u16* tp = VN + (ks * 32 + quad * 8 + (li >> 2)) * TS + g * 64 + cs * 16 + 4 * (li & 3); xf[cs][ks] = tr_read2(tp, tp + 4 * TS); }
    for (int ts = 0; ts < 8; ++ts) {
        bf16x8 yf[4];
#pragma unroll
        for (int ks = 0; ks < 4; ++ks) yf[ks] = ld_frag_g(WS16 + ((size_t)g * 128 + ts * 16 + li) * 128 + ks * 32 + quad * 8);
        const int t = ts * 16 + li;
        const float bs = p.gmlp_bs[((size_t)l * 8 + g) * 128 + t];
        const size_t row = r0 + t;
#pragma unroll
        for (int cs = 0; cs < 4; ++cs) {
            f32x4 a = (f32x4){0.f, 0.f, 0.f, 0.f};
#pragma unroll
            for (int ks = 0; ks < 4; ++ks) a = MFMA16(xf[cs][ks], yf[ks], a);
            const int c = g * 64 + cs * 16 + quad * 4;
            const uint2 uu = *(const uint2*)(PJ(row, 7, c)), gg = *(const uint2*)(PJ(row, 9, c));
            uint2 wv; wv.x = pack2(bflo(uu.x) * (a[0] + bs) * siluf_(bflo(gg.x)), bfhi(uu.x) * (a[1] + bs) * siluf_(bfhi(gg.x)));
            wv.y = pack2(bflo(uu.y) * (a[2] + bs) * siluf_(bflo(gg.y)), bfhi(uu.y) * (a[3] + bs) * siluf_(bfhi(gg.y)));
            *(uint2*)(Y2 + row * 512 + c) = wv;
        }
    }
    __syncthreads();
}

__device__ __forceinline__ void chunk_cumsum(float* A, float* tmp, int dir) {
    const int k = tidx() & 63, seg = tidx() >> 6;
    float v[8]; float run = 0.f;
    if (dir == 0) {
#pragma unroll
        for (int e = 0; e < 8; ++e) { run += A[(seg * 8 + e) * HS_ + k]; v[e] = run; }
    } else {
#pragma unroll
        for (int e = 7; e >= 0; --e) { run += A[(seg * 8 + e) * HS_ + k]; v[e] = run; }
    }
    tmp[seg * 64 + k] = run;
    __syncthreads();
    float off = 0.f;
#pragma unroll
    for (int s2 = 0; s2 < 8; ++s2) { const float tv = tmp[s2 * 64 + k]; if (dir == 0 ? (s2 < seg) : (s2 > seg)) off += tv; }
#pragma unroll
    for (int e = 0; e < 8; ++e) A[(seg * 8 + e) * HS_ + k] = (v[e] + off) * LOG2E;
    __syncthreads();
}
__device__ __forceinline__ void load_bf_tile64(float* dst, const u16* src  , size_t sstride) {
    const int t = tidx() >> 3, k8 = (tidx() & 7) * 8;
    float f[8]; unpack8(*(const uint4*)(src + (size_t)t * sstride + k8), f);
    *(float4*)(dst + t * HS_ + k8) = make_float4(f[0], f[1], f[2], f[3]); *(float4*)(dst + t * HS_ + k8 + 4) = make_float4(f[4], f[5], f[6], f[7]);
}
__device__ __forceinline__ void load_f32_tile64(float* dst, const float* src, size_t sstride) {
    const int t = tidx() >> 3, k8 = (tidx() & 7) * 8;
    *(float4*)(dst + t * HS_ + k8) = *(const float4*)(src + (size_t)t * sstride + k8); *(float4*)(dst + t * HS_ + k8 + 4) = *(const float4*)(src + (size_t)t * sstride + k8 + 4);
}

__device__ void hgrn1_item(const Params& p, const PassInfo ps, int item, unsigned char* lds) {
    unsigned char* ws = opaque(p.ws);
    const u16* PROJ = (const u16*)(ws + OFF_PROJ); const float* LOGF = (const float*)(ws + OFF_LOGF);
    u16* HL = (u16*)(ws + OFF_HL); float* HD = (float*)(ws + OFF_HD);
    const int NC = ps.T >> 6, ncsh = ps.is_ctx ? 2 : 6, c = item & (NC - 1), ci = item >> ncsh, dir = ci & 1, h = (ci >> 1) & 7, bl = ci >> 4;
    const size_t r0 = (size_t)bl * ps.T + c * 64;
    float* A = (float*)lds; float* tmp = A + 64 * HS_; u16* Wb = (u16*)(tmp + 512); u16* Ib = Wb + 64 * KVS;
    const int tid = tidx(), w = tid >> 6, lane = tid & 63, li = lane & 15, quad = lane >> 4;
    const int t = tid >> 3, k8 = (tid & 7) * 8;
    float kf[8];
    { Reg8 rg;
      const float* ap = LOGF + (r0 + t) * 1024 + dir * 512 + h * 64 + k8;
      rg.ld(0, ap); rg.ld(1, ap + 4); rg.ld(2, PJ(r0 + t, 11 + dir, h * 64 + k8)); rg.ld(3, PJ(r0 + t, 13, h * 64 + k8));
      MEMBAR();
      unpack8(rg.getu(2), kf);
      *(u32x4_*)(A + t * HS_ + k8) = rg.get(0); *(u32x4_*)(A + t * HS_ + k8 + 4) = rg.get(1);
      *(u32x4_*)(Ib + t * KVS + k8) = rg.get(3); }
    __syncthreads();
    chunk_cumsum(A, tmp, dir);
    const int lastt = dir == 0 ? 63 : 0;
    { float wv[8];
#pragma unroll
      for (int e = 0; e < 8; ++e) wv[e] = kf[e] * __builtin_amdgcn_exp2f(A[lastt * HS_ + k8 + e] - A[t * HS_ + k8 + e]);
      uint4 wq; wq.x = pack2(wv[0], wv[1]); wq.y = pack2(wv[2], wv[3]); wq.z = pack2(wv[4], wv[5]); wq.w = pack2(wv[6], wv[7]);
      *(uint4*)(Wb + t * KVS + k8) = wq;
      if (tid < 64) HD[(size_t)item * 64 + tid] = __builtin_amdgcn_exp2f(A[lastt * HS_ + tid]); }
    __syncthreads();
    {
        const int ksub = w >> 1;
        bf16x8 yf[2];
#pragma unroll
        for (int ks = 0; ks < 2; ++ks) { const u16* tp = Wb + (ks * 32 + quad * 8 + (li >> 2)) * KVS + ksub * 16 + 4 * (li & 3); yf[ks] = tr_read2(tp, tp + 4 * KVS); }
#pragma unroll
        for (int vv = 0; vv < 2; ++vv) {
            const int vsub = (w & 1) * 2 + vv;
            f32x4 a = (f32x4){0.f, 0.f, 0.f, 0.f};
#pragma unroll
            for (int ks = 0; ks < 2; ++ks) { const u16* tp = Ib + (ks * 32 + quad * 8 + (li >> 2)) * KVS + vsub * 16 + 4 * (li & 3); a = MFMA16(tr_read2(tp, tp + 4 * KVS), yf[ks], a); }
            uint2 o; o.x = pack2(a[0], a[1]); o.y = pack2(a[2], a[3]);
            *(uint2*)(HL + ((size_t)item * 64 + ksub * 16 + li) * 64 + vsub * 16 + quad * 4) = o;
        }
    }
    __syncthreads();
}

__device__ void hgrn2_all(const Params& p, const PassInfo ps, int l) {
    unsigned char* ws = opaque(p.ws);
    const unsigned* HL = (const unsigned*)(ws + OFF_HL); const float* HD = (const float*)(ws + OFF_HD); unsigned* HS = (unsigned*)(ws + OFF_HS);
    float* CST = (float*)(ws + OFF_CTXST) + (size_t)l * 256 * 4096;
    const int NC = ps.T >> 6, chains = ps.nb * 16;
    const size_t total = (size_t)chains * 2048;
    for (size_t e = (size_t)blockIdx.x * 512 + tidx(); e < total; e += (size_t)gridDim.x * 512) {
        const int ci = (int)(e >> 11), kv2 = (int)(e & 2047), k = kv2 >> 5, dir = ci & 1;
        float s0 = 0.f, s1 = 0.f;
        if (!ps.is_ctx) { const float2 cs = *(const float2*)(CST + ((size_t)ps.b0 * 16 + ci) * 4096 + 2 * kv2); s0 = cs.x; s1 = cs.y; }
        for (int cc = 0; cc < NC; ++cc) { const int c = dir ? NC - 1 - cc : cc; const size_t idx = (size_t)ci * NC + c;
            HS[idx * 2048 + kv2] = pack2(s0, s1);
            const float d = HD[idx * 64 + k]; const unsigned lw = HL[idx * 2048 + kv2];
            s0 = d * s0 + bflo(lw); s1 = d * s1 + bfhi(lw); }
        if (ps.is_ctx) *(float2*)(CST + (size_t)ci * 4096 + 2 * kv2) = make_float2(s0, s1);
    }
}

__device__ void hgrn3_item(const Params& p, const PassInfo ps, int l, int item, unsigned char* lds) {
    unsigned char* ws = opaque(p.ws);
    const u16* PROJ = (const u16*)(ws + OFF_PROJ); const float* LOGF = (const float*)(ws + OFF_LOGF); const u16* HSt = (const u16*)(ws + OFF_HS);
    u16* Y3 = (u16*)(ws + OFF_Y) + (size_t)3 * MLAT * 512;
    const int NC = ps.T >> 6, ncsh = ps.is_ctx ? 2 : 6, c = item & (NC - 1), bh = item >> ncsh, h = bh & 7, bl = bh >> 3;
    const size_t r0 = (size_t)bl * ps.T + c * 64;
    const size_t idxf = (size_t)(bh * 2 + 0) * NC + c, idxb = (size_t)(bh * 2 + 1) * NC + c;
    float* Q = (float*)lds; float* KKf = Q + 64 * HS_; float* KKb = KKf + 64 * HS_; float* Af = KKb + 64 * HS_; float* Ab = Af + 64 * HS_; float* tmp = Ab + 64 * HS_;
    u16* Ib = (u16*)(tmp + 512); u16* Sfb = Ib + 64 * KVS; u16* Sbb = Sfb + 64 * KVS; float* comb = (float*)(Sbb + 64 * KVS);
    const int tid = tidx(), w = tid >> 6, lane = tid & 63, li = lane & 15, quad = lane >> 4;
    { const int t = tid >> 3, k8 = (tid & 7) * 8;
      Reg8 ra, rb;
      const float* ap = LOGF + (r0 + t) * 1024 + h * 64 + k8;
      const u16* sf = HSt + idxf * 4096 + t * 64 + k8; const u16* sb = HSt + idxb * 4096 + t * 64 + k8;
      ra.ld(0, PJ(r0 + t, 10, h * 64 + k8)); ra.ld(1, PJ(r0 + t, 11, h * 64 + k8)); ra.ld(2, PJ(r0 + t, 12, h * 64 + k8)); ra.ld(3, PJ(r0 + t, 13, h * 64 + k8));
      ra.ld(4, ap); ra.ld(5, ap + 4); ra.ld(6, ap + 512); ra.ld(7, ap + 516);
      rb.ld(0, sf); rb.ld(1, sb);
      MEMBAR();
      float x[8];
      unpack8(ra.getu(0), x); *(float4*)(Q + t * HS_ + k8) = make_float4(x[0], x[1], x[2], x[3]); *(float4*)(Q + t * HS_ + k8 + 4) = make_float4(x[4], x[5], x[6], x[7]);
      unpack8(ra.getu(1), x); *(float4*)(KKf + t * HS_ + k8) = make_float4(x[0], x[1], x[2], x[3]); *(float4*)(KKf + t * HS_ + k8 + 4) = make_float4(x[4], x[5], x[6], x[7]);
      unpack8(ra.getu(2), x); *(float4*)(KKb + t * HS_ + k8) = make_float4(x[0], x[1], x[2], x[3]); *(float4*)(KKb + t * HS_ + k8 + 4) = make_float4(x[4], x[5], x[6], x[7]);
      *(u32x4_*)(Ib + t * KVS + k8) = ra.get(3);
      *(u32x4_*)(Af + t * HS_ + k8) = ra.get(4); *(u32x4_*)(Af + t * HS_ + k8 + 4) = ra.get(5); *(u32x4_*)(Ab + t * HS_ + k8) = ra.get(6); *(u32x4_*)(Ab + t * HS_ + k8 + 4) = ra.get(7);
      *(u32x4_*)(Sfb + t * KVS + k8) = rb.get(0); *(u32x4_*)(Sbb + t * KVS + k8) = rb.get(1); }
    __syncthreads();
    chunk_cumsum(Af, tmp, 0);
    chunk_cumsum(Ab, tmp, 1);
    const int dir = w >> 2, T = w & 3;
    const float* A = dir ? Ab : Af; const float* KK = dir ? KKb : KKf; const u16* Sb16 = dir ? Sbb : Sfb;
    const int t = 16 * T + li;
    const int rrow = dir ? 16 * T + 16 : 16 * T - 1; const bool rzero = dir ? (T == 3) : (T == 0);
    bf16x8 qt[2], qh[2];
    float Rv[2][8];
#pragma unroll
    for (int ks = 0; ks < 2; ++ks) {
        const int k0 = ks * 32 + quad * 8;
        float qv[8], av[8];
        { const float4 x0 = *(const float4*)(Q + t * HS_ + k0), x1 = *(const float4*)(Q + t * HS_ + k0 + 4); qv[0] = x0.x; qv[1] = x0.y; qv[2] = x0.z; qv[3] = x0.w; qv[4] = x1.x; qv[5] = x1.y; qv[6] = x1.z; qv[7] = x1.w; }
        { const float4 x0 = *(const float4*)(A + t * HS_ + k0), x1 = *(const float4*)(A + t * HS_ + k0 + 4); av[0] = x0.x; av[1] = x0.y; av[2] = x0.z; av[3] = x0.w; av[4] = x1.x; av[5] = x1.y; av[6] = x1.z; av[7] = x1.w; }
        if (rzero) {
#pragma unroll
            for (int e = 0; e < 8; ++e) Rv[ks][e] = 0.f;
        } else { const float4 x0 = *(const float4*)(A + rrow * HS_ + k0), x1 = *(const float4*)(A + rrow * HS_ + k0 + 4); Rv[ks][0] = x0.x; Rv[ks][1] = x0.y; Rv[ks][2] = x0.z; Rv[ks][3] = x0.w; Rv[ks][4] = x1.x; Rv[ks][5] = x1.y; Rv[ks][6] = x1.z; Rv[ks][7] = x1.w; }
        float a_[8], b_[8];
#pragma unroll
        for (int e = 0; e < 8; ++e) { a_[e] = qv[e] * __builtin_amdgcn_exp2f(av[e] - Rv[ks][e]); b_[e] = qv[e] * __builtin_amdgcn_exp2f(av[e]); }
        const unsigned a0 = pack2(a_[0], a_[1]), a1 = pack2(a_[2], a_[3]), a2 = pack2(a_[4], a_[5]), a3 = pack2(a_[6], a_[7]);
        const unsigned b0 = pack2(b_[0], b_[1]), b1 = pack2(b_[2], b_[3]), b2 = pack2(b_[4], b_[5]), b3 = pack2(b_[6], b_[7]);
        qt[ks] = (bf16x8){(short)(a0 & 0xffff), (short)(a0 >> 16), (short)(a1 & 0xffff), (short)(a1 >> 16), (short)(a2 & 0xffff), (short)(a2 >> 16), (short)(a3 & 0xffff), (short)(a3 >> 16)};
        qh[ks] = (bf16x8){(short)(b0 & 0xffff), (short)(b0 >> 16), (short)(b1 & 0xffff), (short)(b1 >> 16), (short)(b2 & 0xffff), (short)(b2 >> 16), (short)(b3 & 0xffff), (short)(b3 >> 16)};
    }
    const int nS = dir ? 4 - T : T + 1;
    float sc[4][4];
#pragma unroll
    for (int i = 0; i < 4; ++i) {
        if (i < nS) {
            const int S = dir ? T + i : i, srow = 16 * S + li;
            f32x4 a = (f32x4){0.f, 0.f, 0.f, 0.f};
#pragma unroll
            for (int ks = 0; ks < 2; ++ks) {
                const int k0 = ks * 32 + quad * 8;
                const float4 x0 = *(const float4*)(KK + srow * HS_ + k0), x1 = *(const float4*)(KK + srow * HS_ + k0 + 4);
                const float4 y0 = *(const float4*)(A + srow * HS_ + k0), y1 = *(const float4*)(A + srow * HS_ + k0 + 4);
                const float kv[8] = {x0.x, x0.y, x0.z, x0.w, x1.x, x1.y, x1.z, x1.w}, as[8] = {y0.x, y0.y, y0.z, y0.w, y1.x, y1.y, y1.z, y1.w};
                float c_[8];
#pragma unroll
                for (int e = 0; e < 8; ++e) c_[e] = kv[e] * __builtin_amdgcn_exp2f(Rv[ks][e] - as[e]);
                const unsigned c0 = pack2(c_[0], c_[1]), c1 = pack2(c_[2], c_[3]), c2 = pack2(c_[4], c_[5]), c3 = pack2(c_[6], c_[7]);
                const bf16x8 kf = (bf16x8){(short)(c0 & 0xffff), (short)(c0 >> 16), (short)(c1 & 0xffff), (short)(c1 >> 16), (short)(c2 & 0xffff), (short)(c2 >> 16), (short)(c3 & 0xffff), (short)(c3 >> 16)};
                a = MFMA16(kf, qt[ks], a);
            }
            const bool diag = (S == T);
#pragma unroll
            for (int j = 0; j < 4; ++j) { const int sl = quad * 4 + j; const bool keep = !diag || (dir ? (sl >= li) : (sl <= li)); sc[i][j] = keep ? a[j] : 0.f; }
        } else {
#pragma unroll
            for (int j = 0; j < 4; ++j) sc[i][j] = 0.f;
        }
    }
    f32x4 O[4];
#pragma unroll
    for (int v = 0; v < 4; ++v) O[v] = (f32x4){0.f, 0.f, 0.f, 0.f};
#pragma unroll
    for (int pr = 0; pr < 2; ++pr) {
        if (2 * pr < nS) {
            const unsigned a0 = pack2(sc[2 * pr][0], sc[2 * pr][1]), a1 = pack2(sc[2 * pr][2], sc[2 * pr][3]), b0 = pack2(sc[2 * pr + 1][0], sc[2 * pr + 1][1]), b1 = pack2(sc[2 * pr + 1][2], sc[2 * pr + 1][3]);
            const bf16x8 pf = (bf16x8){(short)(a0 & 0xffff), (short)(a0 >> 16), (short)(a1 & 0xffff), (short)(a1 >> 16), (short)(b0 & 0xffff), (short)(b0 >> 16), (short)(b1 & 0xffff), (short)(b1 >> 16)};
            const int S0 = dir ? T + 2 * pr : 2 * pr; int S1 = S0 + 1; if (S1 > 3) S1 = 3;
            const u16* p0 = Ib + (16 * S0 + quad * 4 + (li >> 2)) * KVS + 4 * (li & 3);
            const u16* p1 = Ib + (16 * S1 + quad * 4 + (li >> 2)) * KVS + 4 * (li & 3);
#pragma unroll
            for (int v = 0; v < 4; ++v) O[v] = MFMA16(tr_read2(p0 + v * 16, p1 + v * 16), pf, O[v]);
        }
    }
#pragma unroll
    for (int ks = 0; ks < 2; ++ks) {
        const u16* p0 = Sb16 + (ks * 32 + quad * 8 + (li >> 2)) * KVS + 4 * (li & 3);
#pragma unroll
        for (int v = 0; v < 4; ++v) O[v] = MFMA16(tr_read2(p0 + v * 16, p0 + 4 * KVS + v * 16), qh[ks], O[v]);
    }
    if (dir == 1) {
#pragma unroll
        for (int v = 0; v < 4; ++v)
#pragma unroll
            for (int j = 0; j < 4; ++j) comb[(T * 16 + v * 4 + j) * 64 + lane] = O[v][j];
    }
    __syncthreads();
    if (dir == 0) {
        float ss = 0.f;
#pragma unroll
        for (int v = 0; v < 4; ++v)
#pragma unroll
            for (int j = 0; j < 4; ++j) { O[v][j] += comb[(T * 16 + v * 4 + j) * 64 + lane]; ss += O[v][j] * O[v][j]; }
        ss += shx(ss, 16); ss += shx(ss, 32);
        const float rstd = rsqrtf(ss * (1.f / 64.f) + EPSN);
        const size_t row = r0 + t;
#pragma unroll
        for (int v = 0; v < 4; ++v) {
            const int col = h * 64 + v * 16 + quad * 4;
            const float4 gn = *(const float4*)(p.hgrn_g + l * 512 + col);
            const uint2 g = *(const uint2*)(PJ(row, 14, col));
            uint2 wv; wv.x = pack2(O[v][0] * rstd * gn.x * siluf_(bflo(g.x)), O[v][1] * rstd * gn.y * siluf_(bfhi(g.x))); wv.y = pack2(O[v][2] * rstd * gn.z * siluf_(bflo(g.y)), O[v][3] * rstd * gn.w * siluf_(bfhi(g.y)));
            *(uint2*)(Y3 + row * 512 + col) = wv;
        }
    }
    __syncthreads();
}
#define XB_TMO      128
#define XB_XCNT(j)  (256  + 64 * (j))
#define XB_XSUB(j)  (1280 + 64 * (j))
#define XB_XGEN(j)  (2304 + 64 * (j))
#define XB_TOP      3328
#define XB_TOPGEN   3392
#define XCD_BAR_WORDS 3456
#define XB_SPIN_CAP (1u << 18)

__device__ __forceinline__ unsigned xb_ld(unsigned* p)              { return __hip_atomic_load(p, __ATOMIC_RELAXED, __HIP_MEMORY_SCOPE_AGENT); }
__device__ __forceinline__ unsigned xb_add(unsigned* p, unsigned v) { return __hip_atomic_fetch_add(p, v, __ATOMIC_RELAXED, __HIP_MEMORY_SCOPE_AGENT); }
__device__ __forceinline__ unsigned xb_xcc_id() { return (unsigned)__builtin_amdgcn_s_getreg((3 << 11) | 20) & 0xFu; }
#define XB_SPIN(cond, bar) do { unsigned _sp = 0; while (cond) { __builtin_amdgcn_s_sleep(1); \
    if ((++_sp & 255u) == 0u) { if (xb_ld(&(bar)[XB_TMO])) break; if (_sp > XB_SPIN_CAP) { atomicAdd(&(bar)[XB_TMO], 1u); break; } } } } while (0)

struct XcdBarrier {
    unsigned* bar; unsigned x;
    volatile LAS unsigned* st;
};

__device__ __forceinline__ XcdBarrier xcd_barrier_post(unsigned* bar, volatile LAS unsigned* st) {
    XcdBarrier b; b.bar = bar; b.x = xb_xcc_id(); b.st = st;
    if (tidx() == 0) (void)xb_add(&bar[XB_XCNT(b.x)], 1u);
    return b;
}
__device__ __forceinline__ void xcd_barrier_complete(unsigned* bar, unsigned x, unsigned& nloc, unsigned& nx) {
    const unsigned G = gridDim.x * gridDim.y * gridDim.z;
    unsigned sum, cnt, mine, sp = 0u;
    for (;;) {
        sum = 0u; cnt = 0u; mine = 0u;
#pragma unroll
        for (unsigned j = 0; j < 16; ++j) { const unsigned c = xb_ld(&bar[XB_XCNT(j)]); sum += c; cnt += (c > 0u) ? 1u : 0u; mine = (j == x) ? c : mine; }
        if (sum == G) break;
        __builtin_amdgcn_s_sleep(1);
        if ((++sp & 255u) == 0u) { if (xb_ld(&bar[XB_TMO])) break; if (sp > XB_SPIN_CAP) { atomicAdd(&bar[XB_TMO], 1u); break; } }
    }
    nloc = mine > 0u ? mine : 1u; nx = cnt > 0u ? cnt : 1u;
}

__device__ __forceinline__ void xcd_barrier(const XcdBarrier& b) {
    asm volatile("s_waitcnt vmcnt(0)" ::: "memory");
    __syncthreads();
    if (tidx() == 0) {
        unsigned* bar = b.bar;
        __builtin_amdgcn_s_waitcnt(0);
        unsigned nloc = b.st[0], nx = b.st[1];
        if (nloc == 0u) { xcd_barrier_complete(bar, b.x, nloc, nx); b.st[0] = nloc; b.st[1] = nx; }
        const unsigned old = xb_add(&bar[XB_XSUB(b.x)], 1u);
        const unsigned gen = old / nloc;
        if (old + 1u == (gen + 1u) * nloc) {
            __builtin_amdgcn_fence(__ATOMIC_RELEASE, "agent");
            asm volatile("s_waitcnt vmcnt(0)" ::: "memory");
            const unsigned og = xb_add(&bar[XB_TOP], 1u);
            const unsigned tg = og / nx;
            if (og + 1u == (tg + 1u) * nx) xb_add(&bar[XB_TOPGEN], 1u);
            else XB_SPIN(xb_ld(&bar[XB_TOPGEN]) == tg, bar);
            __builtin_amdgcn_fence(__ATOMIC_ACQUIRE, "agent");
            xb_add(&bar[XB_XGEN(b.x)], 1u);
            asm volatile("s_waitcnt vmcnt(0)" ::: "memory");
        } else {
            XB_SPIN(xb_ld(&bar[XB_XGEN(b.x)]) == gen, bar);
            __builtin_amdgcn_fence(__ATOMIC_ACQUIRE, "agent");
            asm volatile("s_waitcnt vmcnt(0)" ::: "memory");
        }
    }
    __syncthreads();
}

#ifndef STAG_B
#define STAG_B 240
#endif
#ifndef STAG_D
#define STAG_D 300
#endif
#ifndef REP_B
#define REP_B 1
#endif
#ifndef REP_C1
#define REP_C1 1
#endif
#ifndef REP_C2
#define REP_C2 1
#endif
#ifndef REP_C3
#define REP_C3 1
#endif
#ifndef REP_DE
#define REP_DE 1
#endif
__device__ __forceinline__ void stagger(int ticks_per_slot) {
    const int slot = ((int)blockIdx.x >> 3) & 7;
    if (slot) { const unsigned long long t0 = __builtin_amdgcn_s_memrealtime(), dt = (unsigned long long)(slot * ticks_per_slot);
        while (__builtin_amdgcn_s_memrealtime() - t0 < dt) __builtin_amdgcn_s_sleep(4); }
}
template <class Epi> __device__ __forceinline__ void run_gemm(LAS unsigned char* lds, const u16* A, const u16* Bt, int M, int N, int K, const Epi& E) {
    pg8::Gemm g; g.A = A; g.Bt = Bt; g.M = M; g.N = N; g.K = K; g.rsA = 0; g.rsB = 0;
    pg8::StaticOrder S; S.init(M, N, (int)gridDim.x, (int)blockIdx.x);
    pg8::gemm_phase<Epi, pg8::StaticOrder, false>(lds, g, S, E, nullptr);
}


struct EpiNull {
    static constexpr bool PERM = true, AFTER_DRAIN = false;
    unsigned char* ws;
    __device__ __forceinline__ void operator()(const f32x4 (&acc)[2][2][4][2], const Unit& u, int wr, int wc, int fr, int fq) const {
        if (ws == nullptr) {
#pragma unroll
            for (int ai = 0; ai < 2; ++ai)
#pragma unroll
                for (int bj = 0; bj < 2; ++bj)
#pragma unroll
                    for (int m = 0; m < 4; ++m)
#pragma unroll
                        for (int n = 0; n < 2; ++n) *(f32x4*)(ws + (size_t)(((ai * 2 + bj) * 4 + m) * 2 + n) * 16 + fr * 1024 + fq * 65536 + wr * 4096 + wc * 16384 + u.pm) = acc[ai][bj][m][n];
        }
    }
};
struct MergeOrder : pg8::StaticOrder {
    __device__ bool next(int i, Unit& u) const { if (!pg8::StaticOrder::next(i >> 2, u)) return false; u.r = i & 3; return true; }
};
__device__ __forceinline__ Params KP() {
    auto q0 = __builtin_amdgcn_kernarg_segment_ptr();
    asm volatile("" : "+s"(q0));
    const __attribute__((address_space(4))) Params* q = (const __attribute__((address_space(4))) Params*)q0;
    Params r;
    r.x = q->x; r.c = q->c; r.ctx = q->ctx; r.c_ctx = q->c_ctx; r.w_ada = q->w_ada; r.b_ada = q->b_ada; r.g_pre = q->g_pre; r.g_post = q->g_post; r.w_in = q->w_in; r.rpb = q->rpb;
    r.fnet_w = q->fnet_w; r.gmlp_g = q->gmlp_g; r.gmlp_ws = q->gmlp_ws; r.gmlp_bs = q->gmlp_bs; r.lb_logits = q->lb_logits; r.hgrn_g = q->hgrn_g; r.w_branch = q->w_branch; r.w_out = q->w_out;
    r.out = q->out; r.ws = q->ws; return r;
}
constexpr size_t OFF_BAR = WS_END;
constexpr size_t WS_END2 = WS_END + (size_t)XCD_BAR_WORDS * 4;
__device__ __forceinline__ void gsync(LAS unsigned char* lds3) {
    XcdBarrier b; b.bar = (unsigned*)(opaque(KP().ws) + OFF_BAR); b.x = xb_xcc_id(); b.st = (volatile LAS unsigned*)(lds3 + LDS_BYTES);
    xcd_barrier(b);
}
__global__ void __launch_bounds__(512, 2) mega_fwd(Params p_unused) {
    extern __shared__ __attribute__((aligned(16))) unsigned char shm[];
    LAS unsigned char* lds3 = (LAS unsigned char*)shm;
    {
        if (tidx() < 4) ((volatile LAS unsigned*)(lds3 + LDS_BYTES))[tidx()] = 0u;
        if (blockIdx.x == 0) { unsigned* bar = (unsigned*)(opaque(KP().ws) + OFF_BAR); for (int i = tidx(); i < XCD_BAR_WORDS; i += 512) bar[i] = 0u; }
        __syncthreads();
    }
    prep1(KP(), shm);
    cg::this_grid().sync();
    { XcdBarrier b0 = xcd_barrier_post((unsigned*)(opaque(KP().ws) + OFF_BAR), (volatile LAS unsigned*)(lds3 + LDS_BYTES)); (void)b0; }
    prep2(KP(), shm);
    gsync(lds3);
#pragma nounroll
    for (int pass = 0; pass < 1 + NBATCH / GB; ++pass) {
        PassInfo ps;
        if (pass == 0) { ps.is_ctx = 1; ps.nb = NBATCH; ps.T = CTXL; ps.M = MCTX; ps.b0 = 0; }
        else { ps.is_ctx = 0; ps.nb = GB; ps.T = SEQ; ps.M = MLAT; ps.b0 = (pass - 1) * GB; }
        const int NC = ps.T >> 6;
#pragma nounroll
        for (int l = 0; l < DEPTH; ++l) {
            phase_norm(KP(), ps, l);
            gsync(lds3);
            _Pragma("nounroll") for (int rep = 0; rep < REP_B; ++rep) {
                unsigned char* ws = opaque(KP().ws);
                EpiProj E; E.ws = ws; E.l = l; E.is_ctx = ps.is_ctx;

                run_gemm(lds3, (const u16*)(ws + OFF_H), (const u16*)(ws + OFF_WTIN) + (size_t)l * NPROJ * DM, ps.M, NPROJ, DM, E);
                gsync(lds3);
#ifdef PROBE_NULL_B
                { EpiNull EN; EN.ws = ws; run_gemm(lds3, (const u16*)(ws + OFF_H), (const u16*)(ws + OFF_WTIN) + (size_t)l * NPROJ * DM, ps.M, NPROJ, DM, EN); gsync(lds3); }
#endif
            }
            const bool full = !(ps.is_ctx && l == DEPTH - 1);
            _Pragma("nounroll") for (int rep = 0; rep < REP_C1; ++rep) {
                const int n_h1 = ps.nb * 16 * NC, n_at = full ? ps.nb * 8 * (ps.T >> 6) : 0, n_f1 = ps.is_ctx ? 0 : ps.nb * 64;
                for (int it = blockIdx.x; it < n_h1 + n_at + n_f1; it += gridDim.x) {
                    if (it < n_h1) hgrn1_item(KP(), ps, it, shm);
                    else if (it < n_h1 + n_at) attn_item(KP(), ps, l, it - n_h1, shm);
                    else four1_item(KP(), it - n_h1 - n_at, shm);
                }
                gsync(lds3);
            }
            _Pragma("nounroll") for (int rep = 0; rep < REP_C2; ++rep) {
                hgrn2_all(KP(), ps, l);
                if (full) {
                    const int n_f2 = ps.is_ctx ? ps.nb * 4 : ps.nb * 64, n_g = ps.M >> 7;
                    for (int it = blockIdx.x; it < n_f2 + n_g; it += gridDim.x) {
                        if (it < n_f2) { if (ps.is_ctx) fourc_item(KP(), it, shm); else four2_item(KP(), it, shm); }
                        else gmlp_item(KP(), l, it - n_f2, shm);
                    }
                }
                gsync(lds3);
            }
            if (!full) continue;
            _Pragma("nounroll") for (int rep = 0; rep < REP_C3; ++rep) {
                const int n_h3 = ps.nb * 8 * NC;
                for (int it = blockIdx.x; it < n_h3; it += gridDim.x) hgrn3_item(KP(), ps, l, it, shm);
                gsync(lds3);
            }
            _Pragma("nounroll") for (int rep = 0; rep < REP_DE; ++rep) {
            {
                unsigned char* ws = opaque(KP().ws);
                pg8::Gemm g; g.A = (const u16*)(ws + OFF_Y); g.Bt = (const u16*)(ws + OFF_WTBR) + (size_t)l * 4 * 1024 * 512; g.M = ps.M; g.N = 1024; g.K = 512;
                g.rsA = (size_t)MLAT * 512 * 2; g.rsB = (size_t)1024 * 512 * 2;
                MergeOrder S; S.init(ps.M, 1024, (int)gridDim.x, (int)blockIdx.x);
                EpiMerge E; E.ws = ws;

                pg8::gemm_phase<EpiMerge, MergeOrder, false>(lds3, g, S, E, nullptr);
            }
            gsync(lds3);
            if (REP_DE > 1 && rep + 1 < REP_DE) continue;
            {
                unsigned char* ws = opaque(KP().ws);
                EpiOut E; E.C = (float*)(ws + OFF_OUT);
                run_gemm(lds3, (const u16*)(ws + OFF_MB), (const u16*)(ws + OFF_WTOUT) + (size_t)l * 1024 * 1024, ps.M, 1024, 1024, E);
            }
            gsync(lds3);
            }
        }
        if (!ps.is_ctx) phase_norm(KP(), ps, DEPTH);
    }
}

static_assert(WS_END2 <= (size_t)1073741824, "workspace map exceeds 1 GiB");

extern "C" void kernel_launch(void* const* d_in, const int* in_sizes, int n_in, void* d_out, int out_size, void* d_ws, size_t ws_size, hipStream_t stream) {
    static int grid_blocks = 0;
    if (grid_blocks == 0) {
        if (n_in != 18 || ws_size < WS_END2) { fprintf(stderr, "kernel_launch: unexpected n_in %d or ws_size %zu (need %zu)\n", n_in, ws_size, (size_t)WS_END2); grid_blocks = -1; return; }
        int dev = 0, cus = 0, per_cu = 0;
        hipGetDevice(&dev);
        hipDeviceGetAttribute(&cus, hipDeviceAttributeMultiprocessorCount, dev);
        if (hipFuncSetAttribute((const void*)mega_fwd, hipFuncAttributeMaxDynamicSharedMemorySize, LDS_BYTES + 16) != hipSuccess) { fprintf(stderr, "kernel_launch: hipFuncSetAttribute failed\n"); grid_blocks = -1; return; }
        hipOccupancyMaxActiveBlocksPerMultiprocessor(&per_cu, (const void*)mega_fwd, 512, LDS_BYTES + 16);
        if (per_cu < 1) { fprintf(stderr, "kernel_launch: occupancy query gave %d\n", per_cu); per_cu = 1; }
        (void)hipGetLastError();
        grid_blocks = cus * per_cu;
    }
    if (grid_blocks < 0) return;
    Params p{};
    const float** pp = (const float**)&p;
    for (int i = 0; i < 18; ++i) pp[i] = (const float*)d_in[i];
    p.out = (float*)d_out; p.ws = (unsigned char*)d_ws;
    void* args[] = {&p};
    hipError_t e = hipLaunchCooperativeKernel((const void*)mega_fwd, dim3(grid_blocks), dim3(512), args, LDS_BYTES + 16, stream);
    if (e != hipSuccess) fprintf(stderr, "cooperative launch failed: %s (grid %d)\n", hipGetErrorString(e), grid_blocks);
}
```

```cpp
#include <hip/hip_runtime.h>
#include <hip/hip_cooperative_groups.h>
#include <cstdio>
namespace cg = cooperative_groups;
__device__ __forceinline__ int tidx() { int t = threadIdx.x; asm volatile("" : "+v"(t)); return t; }
template <class T> __device__ __forceinline__ T* opaque(T* p) {
    unsigned long long v = (unsigned long long)p; const unsigned lo = __builtin_amdgcn_readfirstlane((unsigned)v), hi = __builtin_amdgcn_readfirstlane((unsigned)(v >> 32));
    v = ((unsigned long long)hi << 32) | lo; asm volatile("" : "+s"(v)); return (T*)((__attribute__((address_space(1))) T*)v); }
__device__ __forceinline__ float shx(float v, int m) { const int lane = tidx() & 63; return __int_as_float(__builtin_amdgcn_ds_bpermute((lane ^ m) << 2, __float_as_int(v))); }
namespace pg8 {
#define PG8_LAS __attribute__((address_space(3)))
typedef unsigned short bf16_t;
typedef short bf16x8 __attribute__((ext_vector_type(8)));
typedef float f32x4 __attribute__((ext_vector_type(4)));
typedef unsigned u32x4 __attribute__((ext_vector_type(4)));
constexpr int BM = 256, BK = 64, HALF = 128, HTB = HALF * BK * 2  , STAGE_BYTES = 8 * HTB, NXCD = 8, WGM = 8;

__host__ __device__ __forceinline__ int lds_byte(int r, int c) { const int st = (r >> 4) * 2 + (c >> 5), rr = r & 15, cc = c & 31, ob = rr * 64 + cc * 2; return st * 1024 + (ob ^ (((ob >> 9) & 1) << 5)); }
__host__ __device__ __forceinline__ void stage_rc(int b, int& R, int& C) { const int st = b / 1024, sb = b % 1024, swz = sb ^ (((sb >> 9) & 1) << 5); R = (st >> 1) * 16 + swz / 64; C = (st & 1) * 32 + (swz % 64) / 2; }
__host__ __device__ __forceinline__ int perm32(int rho) { const int n = rho >> 4, i = rho & 15; return 8 * (i >> 2) + 4 * n + (i & 3); }

struct Unit { int pm, pn, r; };
struct Gemm { const bf16_t* A; const bf16_t* Bt; int M, N, K; size_t rsA, rsB; };

struct StaticOrder {
    int nM, nN, nwg, G, c;
    __host__ __device__ void init(int M, int N, int G_, int c_) { nM = M / BM; nN = N / BM; nwg = nM * nN; G = G_; c = c_; }
    __host__ __device__ bool next(int i, Unit& u) const {
        const long L = (long)i * G + c; if (L >= nwg) return false;
        int wgid = (int)L; { const int q = nwg / NXCD, r = nwg % NXCD, xcd = wgid % NXCD, off = wgid / NXCD; wgid = (xcd < r ? xcd * (q + 1) : r * (q + 1) + (xcd - r) * q) + off; }
        const int nig = WGM * nN, gid = wgid / nig, fm = gid * WGM, gsz = (nM - fm) < WGM ? (nM - fm) : WGM;
        u.pm = fm + ((wgid % nig) % gsz); u.pn = (wgid % nig) / gsz; u.r = 0; return true;
    }
    __device__ __forceinline__ void a_ready(const Unit&) const {}
    __device__ __forceinline__ void done(const Unit&) const {}
};
__device__ __forceinline__ unsigned cvt_pk_bf16(float lo, float hi) { unsigned r; asm volatile("v_cvt_pk_bf16_f32 %0, %1, %2" : "=v"(r) : "v"(lo), "v"(hi)); return r; }

template <class Epi, class Sched, bool STAMP = false>
__device__ __forceinline__ void gemm_phase(PG8_LAS unsigned char* lds, const Gemm g, const Sched& S, const Epi& E, unsigned long long* stamps) {
    const int tid = tidx(), wid = __builtin_amdgcn_readfirstlane(tid >> 6), lane = tid & 63, wr = wid >> 2, wc = wid & 3, fr = lane & 15, fq = lane >> 4;
    const int K = g.K, nt = K / BK;
    int ts_lo = 0, ts_hi = 0, nts = 0; const unsigned long long rt_entry = STAMP ? (unsigned long long)wall_clock64() : 0ull;
#define PG8_STAMP() do { if (STAMP && wid == 0 && nts < 64) { const unsigned long long _c = (unsigned long long)clock64(); \
        ts_lo = (lane == nts) ? (int)(unsigned)_c : ts_lo; ts_hi = (lane == nts) ? (int)(unsigned)(_c >> 32) : ts_hi; ++nts; } } while (0)
    PG8_STAMP();
    unsigned voffA[2], voffB[2];
#pragma unroll
    for (int i = 0; i < 2; ++i) { int R, C; stage_rc(tid * 16 + i * 8192, R, C); const int Rb = Epi::PERM ? ((R & ~31) + perm32(R & 31)) : R;
        voffA[i] = (unsigned)(R * K + C) * 2u; voffB[i] = (unsigned)(Rb * K + C) * 2u; }
    const size_t kstep = (size_t)(BK * 2);
    const size_t hstep = (size_t)HALF * K * 2;
    const size_t tstep = 2 * hstep;
    const unsigned ldsw = (unsigned)wid * 1024u;
    const int aoff = lds_byte(wr * 64 + fr, fq * 8), boff = lds_byte(wc * 32 + fr, fq * 8);
#define PG8_SA(b, h) (((b) * 2 + (h)) * HTB)
#define PG8_SB(b, h) ((4 + (b) * 2 + (h)) * HTB)
#define PG8_STAGE(bufoff, gbase, voff) do { _Pragma("unroll") for (int _i = 0; _i < 2; ++_i) \
        __builtin_amdgcn_global_load_lds((const unsigned*)((const char*)(gbase) + (voff)[_i]), (PG8_LAS unsigned*)(lds + (bufoff) + ldsw + _i * 8192), 16, 0, 0); } while (0)
#define PG8_LDA(dst, b, h) do { _Pragma("unroll") for (int m = 0; m < 4; ++m) _Pragma("unroll") for (int k = 0; k < 2; ++k) dst[m][k] = *(const PG8_LAS bf16x8*)(lds + PG8_SA(b, h) + aoff + m * 2048 + k * 1024); } while (0)
#define PG8_LDB(dst, b, h) do { _Pragma("unroll") for (int n = 0; n < 2; ++n) _Pragma("unroll") for (int k = 0; k < 2; ++k) dst[n][k] = *(const PG8_LAS bf16x8*)(lds + PG8_SB(b, h) + boff + n * 2048 + k * 1024); } while (0)
#define PG8_MMA(ai, bj, At, Bt) do { __builtin_amdgcn_s_setprio(1); _Pragma("unroll") for (int m = 0; m < 4; ++m) _Pragma("unroll") for (int n = 0; n < 2; ++n) _Pragma("unroll") for (int k = 0; k < 2; ++k) \
        acc[ai][bj][m][n] = __builtin_amdgcn_mfma_f32_16x16x32_bf16(Bt[n][k], At[m][k], acc[ai][bj][m][n], 0, 0, 0); __builtin_amdgcn_s_setprio(0); } while (0)
#define PG8_WAIT_V(n) asm volatile("s_waitcnt vmcnt(" #n ")" ::: "memory")
#define PG8_WAIT_L(n) asm volatile("s_waitcnt lgkmcnt(" #n ")" ::: "memory")
#define PG8_BAR __builtin_amdgcn_s_barrier()
#define PG8_SCHED __builtin_amdgcn_sched_barrier(0)
    Unit cur, nxt; int ui = 0;
    if (!S.next(0, cur)) return;
    f32x4 acc[2][2][4][2];
#pragma unroll
    for (int a = 0; a < 2; ++a)
#pragma unroll
        for (int b = 0; b < 2; ++b)
#pragma unroll
            for (int m = 0; m < 4; ++m)
#pragma unroll
                for (int n = 0; n < 2; ++n) acc[a][b][m][n] = (f32x4){0.f, 0.f, 0.f, 0.f};
    bf16x8 At[4][2], B0[2][2], B1[2][2];
    const char* cA = (const char*)g.A + (size_t)cur.pm * tstep + (size_t)cur.r * g.rsA; const char* cB = (const char*)g.Bt + (size_t)cur.pn * tstep + (size_t)cur.r * g.rsB;
    S.a_ready(cur);
    PG8_STAGE(PG8_SB(0, 0), cB, voffB); PG8_STAGE(PG8_SA(0, 0), cA, voffA); PG8_STAGE(PG8_SB(0, 1), cB + hstep, voffB); PG8_STAGE(PG8_SA(0, 1), cA + hstep, voffA);
    if (wr == 1) PG8_BAR;
    PG8_WAIT_V(4); PG8_BAR;
    PG8_STAGE(PG8_SB(1, 0), cB + kstep, voffB); PG8_STAGE(PG8_SA(1, 0), cA + kstep, voffA); PG8_STAGE(PG8_SB(1, 1), cB + hstep + kstep, voffB);
    PG8_WAIT_V(6); PG8_BAR;
    PG8_STAMP();
    for (;;) {
        const bool has_next = S.next(ui + 1, nxt);
        const char* nA = has_next ? (const char*)g.A + (size_t)nxt.pm * tstep + (size_t)nxt.r * g.rsA : cA; const char* nB = has_next ? (const char*)g.Bt + (size_t)nxt.pn * tstep + (size_t)nxt.r * g.rsB : cB;
        for (int t = 0; t < nt; t += 2) {
            const bool last = (t == nt - 2);
            const char* a1 = cA + (size_t)(t + 1) * kstep;
            const char* a2 = last ? nA : cA + (size_t)(t + 2) * kstep; const char* b2 = last ? nB : cB + (size_t)(t + 2) * kstep;
            const char* a3 = a2 + kstep; const char* b3 = b2 + kstep;
            if (last && has_next) S.a_ready(nxt);
            PG8_LDB(B0, 0, 0); PG8_SCHED; PG8_LDA(At, 0, 0); PG8_STAGE(PG8_SA(1, 1), a1 + hstep, voffA);
            PG8_WAIT_L(8); PG8_BAR; PG8_WAIT_L(0); PG8_MMA(0, 0, At, B0); PG8_BAR; PG8_SCHED;
            PG8_LDB(B1, 0, 1); PG8_STAGE(PG8_SB(0, 0), b2, voffB);
            PG8_BAR; PG8_WAIT_L(0); PG8_MMA(0, 1, At, B1); PG8_BAR;
            PG8_LDA(At, 0, 1); PG8_STAGE(PG8_SA(0, 0), a2, voffA);
            PG8_BAR; PG8_WAIT_L(0); PG8_MMA(1, 0, At, B0); PG8_BAR; PG8_SCHED;
            PG8_STAGE(PG8_SB(0, 1), b2 + hstep, voffB);
            PG8_WAIT_V(6); PG8_BAR; PG8_MMA(1, 1, At, B1); PG8_BAR;
            PG8_LDB(B0, 1, 0); PG8_SCHED; PG8_LDA(At, 1, 0); PG8_STAGE(PG8_SA(0, 1), a2 + hstep, voffA);
            PG8_WAIT_L(8); PG8_BAR; PG8_WAIT_L(0); PG8_MMA(0, 0, At, B0); PG8_BAR; PG8_SCHED;
            PG8_LDB(B1, 1, 1); PG8_STAGE(PG8_SB(1, 0), b3, voffB);
            PG8_BAR; PG8_WAIT_L(0); PG8_MMA(0, 1, At, B1); PG8_BAR;
            PG8_LDA(At, 1, 1); PG8_STAGE(PG8_SA(1, 0), a3, voffA);
            PG8_BAR; PG8_WAIT_L(0); PG8_MMA(1, 0, At, B0); PG8_BAR; PG8_SCHED;
            PG8_STAGE(PG8_SB(1, 1), b3 + hstep, voffB);
            PG8_WAIT_V(6); PG8_BAR; PG8_MMA(1, 1, At, B1); PG8_BAR;
        }
        PG8_STAMP();
        if constexpr (!Epi::AFTER_DRAIN) { E(acc, cur, wr, wc, fr, fq); S.done(cur); }
        PG8_STAMP();
        if (!has_next) break;
#pragma unroll
        for (int a = 0; a < 2; ++a)
#pragma unroll
            for (int b = 0; b < 2; ++b)
#pragma unroll
                for (int m = 0; m < 4; ++m)
#pragma unroll
                    for (int n = 0; n < 2; ++n) acc[a][b][m][n] = (f32x4){0.f, 0.f, 0.f, 0.f};
        cur = nxt; cA = nA; cB = nB; ++ui;
    }
    PG8_WAIT_V(0);
    if (wr == 0) PG8_BAR;
    PG8_BAR;
    if constexpr (Epi::AFTER_DRAIN) { E.fused(acc, cur, wr, wc, fr, fq, lds, wid, lane); S.done(cur); }
    PG8_STAMP();
    if (STAMP && wid == 0) { stamps[lane] = lane < nts ? (((unsigned long long)(unsigned)ts_hi << 32) | (unsigned)ts_lo) : 0ull;
        if (lane == 62) stamps[62] = rt_entry; if (lane == 63) stamps[63] = (unsigned long long)wall_clock64(); }
#undef PG8_STAMP
#undef PG8_SA
#undef PG8_SB
#undef PG8_STAGE
#undef PG8_LDA
#undef PG8_LDB
#undef PG8_MMA
#undef PG8_WAIT_V
#undef PG8_WAIT_L
#undef PG8_BAR
#undef PG8_SCHED
}
}

typedef unsigned short u16;
typedef short s16x4 __attribute__((ext_vector_type(4)));
using pg8::bf16x8; using pg8::f32x4; using pg8::Unit;
#define LAS __attribute__((address_space(3)))
#define MFMA16(a, b, c) __builtin_amdgcn_mfma_f32_16x16x32_bf16(a, b, c, 0, 0, 0)

constexpr int DM = 1024, NBATCH = 16, SEQ = 4096, DEPTH = 4, CTXL = 256, NPROJ = 11776, NIN = 11264;
constexpr int GB = 4, MLAT = GB * SEQ, MCTX = NBATCH * CTXL;
constexpr int LDS_BYTES = 152 * 1024;
constexpr float LOG2E = 1.4426950408889634f;
constexpr float EPSN = 1e-6f;

constexpr size_t al256(size_t x) { return (x + 255) & ~(size_t)255; }
constexpr size_t OFF_WTIN = 0;
constexpr size_t OFF_WTBR = OFF_WTIN + (size_t)DEPTH * NPROJ * DM * 2;
constexpr size_t OFF_WTOUT = OFF_WTBR + (size_t)DEPTH * 4 * 1024 * 512 * 2;
constexpr size_t OFF_WS16 = OFF_WTOUT + (size_t)DEPTH * 1024 * 1024 * 2;
constexpr size_t OFF_MOD = OFF_WS16 + (size_t)DEPTH * 8 * 128 * 128 * 2;
constexpr size_t OFF_LB = OFF_MOD + al256((size_t)DEPTH * 17 * 3072 * 4);
constexpr size_t OFF_ROPE = OFF_LB + (size_t)DEPTH * 2 * 512 * 4;
constexpr size_t OFF_TW = OFF_ROPE + 2 * 64 * 16 * 4;
constexpr size_t OFF_M1 = OFF_TW + 4096 * 8;
constexpr size_t OFF_M2 = OFF_M1 + 128 * 128 * 2;
constexpr size_t OFF_M3 = OFF_M2 + 64 * 128 * 2;
constexpr size_t OFF_CSW = OFF_M3 + 256 * 512 * 2;
constexpr size_t OFF_CTXW = OFF_CSW + (size_t)DEPTH * 4 * 2 * 128 * 128 * 4;
constexpr size_t OFF_CTXKV = OFF_CTXW + (size_t)NBATCH * CTXL * DM * 4;
constexpr size_t OFF_CTXST = OFF_CTXKV + (size_t)DEPTH * MCTX * 1024 * 2;
constexpr size_t OFF_H = OFF_CTXST + (size_t)DEPTH * 256 * 4096 * 4;
constexpr size_t OFF_PROJ = OFF_H + (size_t)MLAT * DM * 2;
constexpr size_t OFF_QROT = OFF_PROJ + (size_t)MLAT * NPROJ * 2;
constexpr size_t OFF_LOGF = OFF_QROT + (size_t)MLAT * 512 * 2;
constexpr size_t OFF_Y = OFF_LOGF + (size_t)MLAT * 1024 * 4;
constexpr size_t OFF_FY = OFF_Y + (size_t)4 * MLAT * 512 * 2;
constexpr size_t OFF_HL = OFF_FY + (size_t)GB * 4096 * 1024 * 2;
constexpr size_t OFF_HD = OFF_HL + (size_t)4096 * 4096 * 4;
constexpr size_t OFF_HS = OFF_HD + (size_t)4096 * 64 * 4;
constexpr size_t OFF_MB = OFF_HS + (size_t)4096 * 4096 * 4;
constexpr size_t WS_END = OFF_MB + (size_t)MLAT * DM * 2;
constexpr size_t OFF_MERGED = OFF_LOGF;
constexpr size_t OFF_OUT = OFF_PROJ;

struct Params {
    const float *x, *c, *ctx, *c_ctx, *w_ada, *b_ada, *g_pre, *g_post, *w_in, *rpb, *fnet_w, *gmlp_g, *gmlp_ws, *gmlp_bs, *lb_logits, *hgrn_g, *w_branch, *w_out;
    float* out; unsigned char* ws;
};
struct PassInfo { int is_ctx, nb, T, M, b0; };

__device__ __forceinline__ u16 f2bf(float f) { unsigned u = __float_as_uint(f); u += 0x7FFFu + ((u >> 16) & 1u); return (u16)(u >> 16); }
__device__ __forceinline__ float bf2f(u16 b) { return __uint_as_float(((unsigned)b) << 16); }
typedef __bf16 bf16x2_t_ __attribute__((ext_vector_type(2)));
typedef float f32x2_t_ __attribute__((ext_vector_type(2)));
__device__ __forceinline__ unsigned pack2(float a, float b) { f32x2_t_ v = {a, b}; bf16x2_t_ r = __builtin_convertvector(v, bf16x2_t_); return __builtin_bit_cast(unsigned, r); }
__device__ __forceinline__ float bflo(unsigned w) { return __uint_as_float(w << 16); }
__device__ __forceinline__ float bfhi(unsigned w) { return __uint_as_float(w & 0xFFFF0000u); }
__device__ __forceinline__ float sigmoidf_(float v) { return 1.f / (1.f + __expf(-v)); }
__device__ __forceinline__ float siluf_(float v) { return v / (1.f + __expf(-v)); }
__device__ __forceinline__ void unpack8(uint4 w, float* f) { f[0] = bflo(w.x); f[1] = bfhi(w.x); f[2] = bflo(w.y); f[3] = bfhi(w.y); f[4] = bflo(w.z); f[5] = bfhi(w.z); f[6] = bflo(w.w); f[7] = bfhi(w.w); }
__device__ __forceinline__ bf16x8 tr_read2(const u16* p0, const u16* p1) {
    s16x4 a = __builtin_amdgcn_ds_read_tr16_b64_v4i16((LAS s16x4*)p0);
    s16x4 b = __builtin_amdgcn_ds_read_tr16_b64_v4i16((LAS s16x4*)p1);
    return (bf16x8){a[0], a[1], a[2], a[3], b[0], b[1], b[2], b[3]};
}
__device__ __forceinline__ bf16x8 ld_frag_g(const u16* p) { return *(const bf16x8*)p; }

typedef unsigned u32x4_ __attribute__((ext_vector_type(4)));
__device__ __forceinline__ void nt_store16(uint4 w, void* p) { __builtin_nontemporal_store((u32x4_){w.x, w.y, w.z, w.w}, (u32x4_*)p); }
struct EpiProj {
    static constexpr bool PERM = true, AFTER_DRAIN = false;
    unsigned char* ws; int l; int is_ctx;
    __device__ __forceinline__ void operator()(const f32x4 (&acc)[2][2][4][2], const Unit& u, int wr, int wc, int fr, int fq) const {
        u16* proj = (u16*)(ws + OFF_PROJ);
        const int blk = u.pn >> 1;
        const int row0 = u.pm * 256 + wr * 64 + fr, col0 = u.pn * 256 + wc * 32 + 8 * fq;
        u16* pbase = proj + ((size_t)blk * MLAT + row0) * 512 + (col0 & 511);
        if ((blk == 0 || blk == 1) && !is_ctx) {
            u16* qrot = (u16*)(ws + OFF_QROT); const float* rope = (const float*)(ws + OFF_ROPE);
            const int f0 = 8 * (fq & 1); const float sgn = (fq >> 1) ? 1.f : -1.f;
#pragma unroll
            for (int ai = 0; ai < 2; ++ai)
#pragma unroll
                for (int m = 0; m < 4; ++m) {
                    const int row = row0 + ai * 128 + m * 16;
                    const int t = row & 4095, pos = (wc & 1) ? (t & 63) : (t >> 6);
                    const float4 c0 = *(const float4*)(rope + pos * 16 + f0), c1 = *(const float4*)(rope + pos * 16 + f0 + 4);
                    const float4 s0 = *(const float4*)(rope + 1024 + pos * 16 + f0), s1 = *(const float4*)(rope + 1024 + pos * 16 + f0 + 4);
                    const float cs[8] = {c0.x, c0.y, c0.z, c0.w, c1.x, c1.y, c1.z, c1.w}, sn[8] = {s0.x, s0.y, s0.z, s0.w, s1.x, s1.y, s1.z, s1.w};
#pragma unroll
                    for (int bj = 0; bj < 2; ++bj) {
                        const f32x4 v0 = acc[ai][bj][m][0], v1 = acc[ai][bj][m][1];
                        const float o[8] = {v0[0], v0[1], v0[2], v0[3], v1[0], v1[1], v1[2], v1[3]};
                        float r[8];
#pragma unroll
                        for (int e = 0; e < 8; ++e) { const float pr = shx(o[e], 32); r[e] = o[e] * cs[e] + sgn * pr * sn[e]; }
                        uint4 wr_; wr_.x = pack2(r[0], r[1]); wr_.y = pack2(r[2], r[3]); wr_.z = pack2(r[4], r[5]); wr_.w = pack2(r[6], r[7]);
                        u16* dst = pbase + (size_t)(ai * 128 + m * 16) * 512 + bj * 128;
                        if (blk == 0) {
                            uint4 wp; wp.x = pack2(o[0], o[1]); wp.y = pack2(o[2], o[3]); wp.z = pack2(o[4], o[5]); wp.w = pack2(o[6], o[7]);
                            nt_store16(wp, dst);
                            nt_store16(wr_, qrot + (size_t)row * 512 + (col0 & 511) + bj * 128);
                        } else nt_store16(wr_, dst);
                    }
                }
        } else if (blk == 11 || blk == 12) {
            float* logf = (float*)(ws + OFF_LOGF); const float* lb = (const float*)(ws + OFF_LB) + l * 1024;
            const int dir = blk - 11;
#pragma unroll
            for (int bj = 0; bj < 2; ++bj) {
                const int cc = (col0 & 511) + bj * 128;
                const float4 l0 = *(const float4*)(lb + dir * 512 + cc), l1 = *(const float4*)(lb + dir * 512 + cc + 4);
                const float lbv[8] = {l0.x, l0.y, l0.z, l0.w, l1.x, l1.y, l1.z, l1.w};
#pragma unroll
                for (int ai = 0; ai < 2; ++ai)
#pragma unroll
                    for (int m = 0; m < 4; ++m) {
                        const int row = row0 + ai * 128 + m * 16;
                        const f32x4 v0 = acc[ai][bj][m][0], v1 = acc[ai][bj][m][1];
                        const float z[8] = {v0[0], v0[1], v0[2], v0[3], v1[0], v1[1], v1[2], v1[3]};
                        float lf[8], o[8];
#pragma unroll
                        for (int e = 0; e < 8; ++e) {
                            const float ez = __expf(-z[e]);
                            const float inv = 1.f / (1.f + ez);
                            const float sg = inv, sgn_ = (ez > 1e30f) ? 1.f : ez * inv;
                            const float f = lbv[e] + (1.f - lbv[e]) * sg;
                            lf[e] = __logf(fmaxf(f, 1e-30f));
                            o[e] = (1.f - lbv[e]) * sgn_;
                        }
                        float* lp = logf + (size_t)row * 1024 + dir * 512 + cc;
                        __builtin_nontemporal_store((f32x4){lf[0], lf[1], lf[2], lf[3]}, (f32x4*)lp); __builtin_nontemporal_store((f32x4){lf[4], lf[5], lf[6], lf[7]}, (f32x4*)(lp + 4));
                        uint4 w; w.x = pack2(o[0], o[1]); w.y = pack2(o[2], o[3]); w.z = pack2(o[4], o[5]); w.w = pack2(o[6], o[7]);
                        nt_store16(w, pbase + (size_t)(ai * 128 + m * 16) * 512 + bj * 128);
                    }
            }
        } else {
            const bool copy = is_ctx && (blk == 1 || blk == 2);
            u16* cbase = (u16*)(ws + OFF_CTXKV) + (size_t)l * MCTX * 1024 + (size_t)row0 * 1024 + (blk - 1) * 512 + (col0 & 511);
            if (!copy) {
#pragma unroll
                for (int ai = 0; ai < 2; ++ai)
#pragma unroll
                    for (int m = 0; m < 4; ++m)
#pragma unroll
                        for (int bj = 0; bj < 2; ++bj) {
                            const f32x4 v0 = acc[ai][bj][m][0], v1 = acc[ai][bj][m][1];
                            uint4 w; w.x = pack2(v0[0], v0[1]); w.y = pack2(v0[2], v0[3]); w.z = pack2(v1[0], v1[1]); w.w = pack2(v1[2], v1[3]);
                            nt_store16(w, pbase + (size_t)(ai * 128 + m * 16) * 512 + bj * 128);
                        }
            } else {
#pragma unroll
                for (int ai = 0; ai < 2; ++ai)
#pragma unroll
                    for (int m = 0; m < 4; ++m)
#pragma unroll
                        for (int bj = 0; bj < 2; ++bj) {
                            const f32x4 v0 = acc[ai][bj][m][0], v1 = acc[ai][bj][m][1];
                            uint4 w; w.x = pack2(v0[0], v0[1]); w.y = pack2(v0[2], v0[3]); w.z = pack2(v1[0], v1[1]); w.w = pack2(v1[2], v1[3]);
                            nt_store16(w, pbase + (size_t)(ai * 128 + m * 16) * 512 + bj * 128);
                            *(uint4*)(cbase + (size_t)(ai * 128 + m * 16) * 1024 + bj * 128) = w;
                        }
            }
        }
    }
};
struct EpiMerge {
    static constexpr bool PERM = true, AFTER_DRAIN = false;
    unsigned char* ws;
    template <int MODE> __device__ __forceinline__ void run(const f32x4 (&acc)[2][2][4][2], const Unit& u, int wr, int wc, int fr, int fq) const {
        const u16* proj = (const u16*)(ws + OFF_PROJ); u16* mb = (u16*)(ws + OFF_MB);
        const int row0 = u.pm * 256 + wr * 64 + fr, col0 = u.pn * 256 + wc * 32 + 8 * fq, R = u.r;
        const int gcol0 = 7680 + R * 1024 + col0;
        const u16* gbase = proj + ((size_t)(gcol0 >> 9) * MLAT + row0) * 512 + (gcol0 & 511);
        u16* obase = mb + (size_t)row0 * 1024 + col0;
        uint4 g[2][4], old[2][4];
#define MG_LOAD(st, buf) do { _Pragma("unroll") for (int q = 0; q < 4; ++q) { const int ai_ = (st) >> 1, m_ = ((st) & 1) * 2 + (q >> 1), co_ = (q & 1) * 128; const size_t ro_ = (size_t)(ai_ * 128 + m_ * 16); \
            g[buf][q] = *(const uint4*)(gbase + ro_ * 512 + co_); if (MODE > 0) old[buf][q] = *(const uint4*)(obase + ro_ * 1024 + co_); } } while (0)
        MG_LOAD(0, 0);
#pragma unroll
        for (int st = 0; st < 4; ++st) {
            const int buf = st & 1;
            if (st + 1 < 4) MG_LOAD(st + 1, buf ^ 1);
            __builtin_amdgcn_sched_barrier(0);
#pragma unroll
            for (int q = 0; q < 4; ++q) { const int ai = st >> 1, m = (st & 1) * 2 + (q >> 1), bj = q & 1, co = bj * 128; const size_t ro = (size_t)(ai * 128 + m * 16);
                const f32x4 v0 = acc[ai][bj][m][0], v1 = acc[ai][bj][m][1];
                float gf[8]; unpack8(g[buf][q], gf);
                float o[8] = {v0[0] * sigmoidf_(gf[0]), v0[1] * sigmoidf_(gf[1]), v0[2] * sigmoidf_(gf[2]), v0[3] * sigmoidf_(gf[3]), v1[0] * sigmoidf_(gf[4]), v1[1] * sigmoidf_(gf[5]), v1[2] * sigmoidf_(gf[6]), v1[3] * sigmoidf_(gf[7])};
                if (MODE > 0) { float of[8]; unpack8(old[buf][q], of);
#pragma unroll
                    for (int e = 0; e < 8; ++e) o[e] += of[e]; }
                uint4 w; w.x = pack2(o[0], o[1]); w.y = pack2(o[2], o[3]); w.z = pack2(o[4], o[5]); w.w = pack2(o[6], o[7]);
                *(uint4*)(obase + ro * 1024 + co) = w; }
        }
#undef MG_LOAD
    }
    __device__ __forceinline__ void operator()(const f32x4 (&acc)[2][2][4][2], const Unit& u, int wr, int wc, int fr, int fq) const {
        if (u.r == 0) run<0>(acc, u, wr, wc, fr, fq);
        else run<1>(acc, u, wr, wc, fr, fq);
    }
};
struct EpiOut {
    static constexpr bool PERM = true, AFTER_DRAIN = false;
    u16* C;
    __device__ __forceinline__ void operator()(const f32x4 (&acc)[2][2][4][2], const Unit& u, int wr, int wc, int fr, int fq) const {
        const int row0 = u.pm * 256 + wr * 64 + fr, col0 = u.pn * 256 + wc * 32 + 8 * fq;
#pragma unroll
        for (int ai = 0; ai < 2; ++ai)
#pragma unroll
            for (int m = 0; m < 4; ++m) { u16* rowp = C + (size_t)(row0 + ai * 128 + m * 16) * 1024 + col0;
#pragma unroll
                for (int bj = 0; bj < 2; ++bj) { const f32x4 v0 = acc[ai][bj][m][0], v1 = acc[ai][bj][m][1];
                    uint4 w; w.x = pack2(v0[0], v0[1]); w.y = pack2(v0[2], v0[3]); w.z = pack2(v1[0], v1[1]); w.w = pack2(v1[2], v1[3]); *(uint4*)(rowp + bj * 128) = w; } }
    }
};

__device__ void transpose_tile(const float* src, int lds_, u16* dst, int ldd, int k0, int n0s, int n0d, u16* t) {
    const int tid = tidx();
#pragma unroll
    for (int it = 0; it < 2; ++it) {
        const int kk = (tid >> 4) + it * 32, nn = (tid & 15) * 4;
        const float4 v = *(const float4*)(src + (size_t)(k0 + kk) * lds_ + n0s + nn);
        t[(nn + 0) * 72 + kk] = f2bf(v.x); t[(nn + 1) * 72 + kk] = f2bf(v.y); t[(nn + 2) * 72 + kk] = f2bf(v.z); t[(nn + 3) * 72 + kk] = f2bf(v.w);
    }
    __syncthreads();
    { const int n = tid >> 3, k8 = (tid & 7) * 8;
      const uint4 v = *(const uint4*)(t + n * 72 + k8);
      *(uint4*)(dst + (size_t)(n0d + n) * ldd + k0 + k8) = v; }
    __syncthreads();
}

__device__ void prep1(const Params& p, unsigned char* lds) {
    unsigned char* ws = opaque(p.ws);
    const int tid = tidx();
    const size_t gt = (size_t)blockIdx.x * 512 + tid, gn = (size_t)gridDim.x * 512;
    { u16* ws16 = (u16*)(ws + OFF_WS16);
      for (size_t i = gt; i < (size_t)DEPTH * 8 * 128 * 128; i += gn) ws16[i] = f2bf(p.gmlp_ws[i]);
      float* lbp = (float*)(ws + OFF_LB);
      for (size_t i = gt; i < 1024; i += gn) {
          float e[DEPTH], mx = -1e30f, sum = 0.f;
#pragma unroll
          for (int l = 0; l < DEPTH; ++l) { e[l] = p.lb_logits[l * 1024 + i]; mx = fmaxf(mx, e[l]); }
#pragma unroll
          for (int l = 0; l < DEPTH; ++l) { e[l] = expf(e[l] - mx); sum += e[l]; }
          float run = 0.f;
#pragma unroll
          for (int l = 0; l < DEPTH; ++l) { if (l > 0) run += e[l] / sum; lbp[l * 1024 + i] = fmaxf(run, 0.f); }
      }
      float* rope = (float*)(ws + OFF_ROPE);
      for (size_t i = gt; i < 1024; i += gn) { const int pos = (int)(i >> 4), f = (int)(i & 15);
          const float inv = powf(10000.f, -(float)f * 2.0f / 32.0f), ang = (float)pos * inv;
          rope[i] = cosf(ang); rope[1024 + i] = sinf(ang); }
      float* tw = (float*)(ws + OFF_TW);
      for (size_t i = gt; i < 4096; i += gn) { float s, c; sincospif((float)i * (2.0f / 4096.0f), &s, &c); tw[2 * i] = c; tw[2 * i + 1] = s; }
      u16* m1 = (u16*)(ws + OFF_M1);
      for (size_t i = gt; i < 128 * 128; i += gn) { const int ii = (int)(i >> 7), kk = (int)(i & 127), k1 = ii >> 1, po = ii & 1, n1 = kk >> 1, pi = kk & 1;
          float s, c; sincospif((float)((k1 * n1) & 63) * (2.0f / 64.0f), &s, &c);
          const float v = (po == 0) ? (pi == 0 ? c : -s) : (pi == 0 ? -s : -c);
          m1[i] = f2bf(v); }
      u16* m2 = (u16*)(ws + OFF_M2);
      for (size_t i = gt; i < 64 * 128; i += gn) { const int k2 = (int)(i >> 7), kk = (int)(i & 127), n2 = kk >> 1, pi = kk & 1;
          float s, c; sincospif((float)((k2 * n2) & 63) * (2.0f / 64.0f), &s, &c);
          m2[i] = f2bf(pi == 0 ? c : s); }
      u16* m3 = (u16*)(ws + OFF_M3);
      for (size_t i = gt; i < 256 * 512; i += gn) { const int k = (int)(i >> 9), kk = (int)(i & 511), n = kk >> 1, pi = kk & 1;
          float s, c; sincospif((float)((k * n) & 255) * (2.0f / 256.0f), &s, &c);
          m3[i] = f2bf(pi == 0 ? c : -s); }
    }
    constexpr int N_WIN = DEPTH * 176 * 16, N_WBR = 16 * 16 * 8, N_WOUT = DEPTH * 16 * 16, N_MOD = DEPTH * 48, N_CSW = DEPTH * 4 * 2 * 2;
    constexpr int TOT = N_WIN + N_WBR + N_WOUT + N_MOD + N_CSW;
    for (int it = blockIdx.x; it < TOT; it += gridDim.x) {
        int idx = it;
        if (idx < N_WIN) {
            const int l = idx / 2816, rem = idx % 2816, cb = rem >> 4, kb = rem & 15, n0 = cb * 64;
            if (n0 >= 2048 && n0 < 2560) continue;
            const int n0d = n0 < 2048 ? n0 : n0 + 512;
            transpose_tile(p.w_in + (size_t)l * DM * NIN, NIN, (u16*)(ws + OFF_WTIN) + (size_t)l * NPROJ * DM, DM, kb * 64, n0, n0d, (u16*)lds);
            continue;
        }
        idx -= N_WIN;
        if (idx < N_WBR) {
            const int mat = idx >> 7, rem = idx & 127, cb = rem >> 3, kb = rem & 7;
            transpose_tile(p.w_branch + (size_t)mat * 512 * 1024, 1024, (u16*)(ws + OFF_WTBR) + (size_t)mat * 1024 * 512, 512, kb * 64, cb * 64, cb * 64, (u16*)lds);
            continue;
        }
        idx -= N_WBR;
        if (idx < N_WOUT) {
            const int l = idx >> 8, rem = idx & 255, cb = rem >> 4, kb = rem & 15;
            transpose_tile(p.w_out + (size_t)l * 1024 * 1024, 1024, (u16*)(ws + OFF_WTOUT) + (size_t)l * 1024 * 1024, 1024, kb * 64, cb * 64, cb * 64, (u16*)lds);
            continue;
        }
        idx -= N_WOUT;
        if (idx < N_MOD) {
            const int l = idx / 48, cb = idx % 48;
            float* s = (float*)lds; float* red = s + 17 * 1024;
            for (int i = tid; i < 17 * 1024; i += 512) { const int j = i >> 10, k = i & 1023; const float v = j < 16 ? p.c[j * 1024 + k] : p.c_ctx[k]; s[i] = v / (1.f + expf(-v)); }
            __syncthreads();
            const int col = tid & 63, ks = tid >> 6;
            float acc[17];
#pragma unroll
            for (int j = 0; j < 17; ++j) acc[j] = 0.f;
            for (int k = ks * 128; k < ks * 128 + 128; ++k) {
                const float w = p.w_ada[((size_t)l * 1024 + k) * 3072 + cb * 64 + col];
#pragma unroll
                for (int j = 0; j < 17; ++j) acc[j] += s[j * 1024 + k] * w;
            }
#pragma unroll
            for (int j = 0; j < 17; ++j) red[(ks * 17 + j) * 64 + col] = acc[j];
            __syncthreads();
            for (int o = tid; o < 17 * 64; o += 512) { const int j = o >> 6, cc = o & 63; float sum = 0.f;
                for (int q = 0; q < 8; ++q) sum += red[(q * 17 + j) * 64 + cc];
                ((float*)(ws + OFF_MOD))[((size_t)l * 17 + j) * 3072 + cb * 64 + cc] = sum + p.b_ada[l * 3072 + cb * 64 + cc]; }
            __syncthreads();
            continue;
        }
        idx -= N_MOD;
        {
            const int cblk = idx & 1, part = (idx >> 1) & 1, g = (idx >> 2) & 3, l = idx >> 4;
            float* tb = (float*)lds;
            if (tid < 128) { float s, c; sincospif((float)tid * (2.0f / 128.0f), &s, &c); tb[tid] = part ? s : c; }
            __syncthreads();
            const int d = tid & 127, cq = tid >> 7;
            float acc[16];
#pragma unroll
            for (int i = 0; i < 16; ++i) acc[i] = 0.f;
            const float* wf = p.fnet_w + ((size_t)(l * 4 + g) * 128) * 128;
            for (int c2 = 0; c2 < 128; ++c2) {
                const float w = wf[c2 * 128 + d];
#pragma unroll
                for (int i = 0; i < 16; ++i) { const int c = cblk * 64 + cq * 16 + i; acc[i] += tb[(c * c2) & 127] * w; }
            }
            float* dst = (float*)(ws + OFF_CSW) + ((size_t)((l * 4 + g) * 2 + part) * 128) * 128;
#pragma unroll
            for (int i = 0; i < 16; ++i) dst[(cblk * 64 + cq * 16 + i) * 128 + d] = acc[i];
            __syncthreads();
        }
    }
}

__device__ void prep2(const Params& p, unsigned char* lds) {
    unsigned char* ws = opaque(p.ws);
    const int tid = tidx();
    float* wb = (float*)lds;
    float* cw = wb + 64 * 129;
    for (int it = blockIdx.x; it < DEPTH * 4 * 2 * 16; it += gridDim.x) {
        const int kb = it & 15, part = (it >> 4) & 1, g = (it >> 5) & 3, l = it >> 7;
        for (int i = tid; i < 64 * 128; i += 512) { const int kk = i >> 7, c = i & 127; wb[kk * 129 + c] = p.w_in[((size_t)l * 1024 + kb * 64 + kk) * NIN + 2048 + g * 128 + c]; }
        const float* src = (const float*)(ws + OFF_CSW) + ((size_t)((l * 4 + g) * 2 + part) * 128) * 128;
        for (int i = tid; i < 128 * 128; i += 512) cw[i] = src[i];
        __syncthreads();
        const int d = tid & 127, kq = tid >> 7;
        float acc[16];
#pragma unroll
        for (int i = 0; i < 16; ++i) acc[i] = 0.f;
        for (int c = 0; c < 128; ++c) {
            const float w = cw[c * 128 + d];
#pragma unroll
            for (int i = 0; i < 16; ++i) acc[i] += wb[(kq * 16 + i) * 129 + c] * w;
        }
        u16* dst = (u16*)(ws + OFF_WTIN) + ((size_t)l * NPROJ + (4 + part) * 512 + g * 128 + d) * DM + kb * 64 + kq * 16;
        uint4 w0, w1;
        w0.x = pack2(acc[0], acc[1]); w0.y = pack2(acc[2], acc[3]); w0.z = pack2(acc[4], acc[5]); w0.w = pack2(acc[6], acc[7]);
        w1.x = pack2(acc[8], acc[9]); w1.y = pack2(acc[10], acc[11]); w1.z = pack2(acc[12], acc[13]); w1.w = pack2(acc[14], acc[15]);
        *(uint4*)dst = w0; *(uint4*)(dst + 8) = w1;
        __syncthreads();
    }
}

__device__ void phase_norm(const Params& p, const PassInfo ps, int l) {
    unsigned char* ws = opaque(p.ws);
    const int wave = tidx() >> 6, lane = tidx() & 63;
    const float* mod = (const float*)(ws + OFF_MOD);
    const u16* OUT = (const u16*)(ws + OFF_OUT);
    u16* H = (u16*)(ws + OFF_H);
    for (int rr = blockIdx.x * 8 + wave; rr < ps.M; rr += gridDim.x * 8) {
        const int tsh = ps.is_ctx ? 8 : 12; const int b = ps.b0 + (rr >> tsh), t = rr & (ps.T - 1), mrow = ps.is_ctx ? 16 : b;
        const size_t xoff = ((size_t)b * ps.T + t) * 1024;
        const float* xin = (l <= 1) ? ((ps.is_ctx ? p.ctx : p.x) + xoff) : ((ps.is_ctx ? (const float*)(ws + OFF_CTXW) : (const float*)p.out) + xoff);
        float* xout = (ps.is_ctx ? (float*)(ws + OFF_CTXW) : p.out) + xoff;
        float xv[16];
#pragma unroll
        for (int hlf = 0; hlf < 2; ++hlf) {
            const int c0 = hlf * 512 + lane * 8;
            const float4 a = *(const float4*)(xin + c0), bq = *(const float4*)(xin + c0 + 4);
            xv[hlf * 8 + 0] = a.x; xv[hlf * 8 + 1] = a.y; xv[hlf * 8 + 2] = a.z; xv[hlf * 8 + 3] = a.w;
            xv[hlf * 8 + 4] = bq.x; xv[hlf * 8 + 5] = bq.y; xv[hlf * 8 + 6] = bq.z; xv[hlf * 8 + 7] = bq.w;
        }
        if (l > 0) {
            float ov[16]; float ss = 0.f;
#pragma unroll
            for (int hlf = 0; hlf < 2; ++hlf) {
                const int c0 = hlf * 512 + lane * 8;
                unpack8(*(const uint4*)(OUT + (size_t)rr * 1024 + c0), ov + hlf * 8);
            }
#pragma unroll
            for (int e = 0; e < 16; ++e) ss += ov[e] * ov[e];
#pragma unroll
            for (int o = 32; o > 0; o >>= 1) ss += shx(ss, o);
            const float rstd = rsqrtf(ss * (1.f / 1024.f) + EPSN);
            const float* gt = mod + ((size_t)(l - 1) * 17 + mrow) * 3072 + 2048;
            const float* gp = p.g_post + (l - 1) * 1024;
#pragma unroll
            for (int hlf = 0; hlf < 2; ++hlf) {
                const int c0 = hlf * 512 + lane * 8;
#pragma unroll
                for (int e = 0; e < 8; ++e) xv[hlf * 8 + e] += gt[c0 + e] * (ov[hlf * 8 + e] * rstd * gp[c0 + e]);
                *(float4*)(xout + c0) = make_float4(xv[hlf * 8 + 0], xv[hlf * 8 + 1], xv[hlf * 8 + 2], xv[hlf * 8 + 3]);
                *(float4*)(xout + c0 + 4) = make_float4(xv[hlf * 8 + 4], xv[hlf * 8 + 5], xv[hlf * 8 + 6], xv[hlf * 8 + 7]);
            }
        }
        if (l < DEPTH) {
            float ss = 0.f;
#pragma unroll
            for (int e = 0; e < 16; ++e) ss += xv[e] * xv[e];
#pragma unroll
            for (int o = 32; o > 0; o >>= 1) ss += shx(ss, o);
            const float rstd = rsqrtf(ss * (1.f / 1024.f) + EPSN);
            const float* sh = mod + ((size_t)l * 17 + mrow) * 3072; const float* sc = sh + 1024;
            const float* gp = p.g_pre + l * 1024;
#pragma unroll
            for (int hlf = 0; hlf < 2; ++hlf) {
                const int c0 = hlf * 512 + lane * 8;
                float hv[8];
#pragma unroll
                for (int e = 0; e < 8; ++e) hv[e] = xv[hlf * 8 + e] * rstd * gp[c0 + e] * (1.f + sc[c0 + e]) + sh[c0 + e];
                uint4 w; w.x = pack2(hv[0], hv[1]); w.y = pack2(hv[2], hv[3]); w.z = pack2(hv[4], hv[5]); w.w = pack2(hv[6], hv[7]);
                *(uint4*)(H + (size_t)rr * 1024 + c0) = w;
            }
        }
    }
}

#define PJ(row, blk, c) (PROJ + ((size_t)(blk) * MLAT + (row)) * 512 + (c))
typedef unsigned u32x32_ __attribute__((ext_vector_type(32)));
struct Reg8 {
    u32x32_ v;
    __device__ __forceinline__ void ld(int i, const void* p) { const u32x4_ a = *(const u32x4_*)p; v[4 * i] = a[0]; v[4 * i + 1] = a[1]; v[4 * i + 2] = a[2]; v[4 * i + 3] = a[3]; }
    __device__ __forceinline__ u32x4_ get(int i) const { return (u32x4_){v[4 * i], v[4 * i + 1], v[4 * i + 2], v[4 * i + 3]}; }
    __device__ __forceinline__ uint4 getu(int i) const { uint4 r; r.x = v[4 * i]; r.y = v[4 * i + 1]; r.z = v[4 * i + 2]; r.w = v[4 * i + 3]; return r; }
};
#define MEMBAR() asm volatile("" ::: "memory")
constexpr int KVS = 72;
constexpr int TS = 528;
constexpr int T3S = 136;
constexpr int HS_ = 68;
constexpr float NORM_LAT = 0.0013810679320049757f;
constexpr float NORM_CTX = 0.005524271728019903f;

__device__ void attn_item(const Params& p, const PassInfo ps, int l, int item, unsigned char* lds) {
    unsigned char* ws = opaque(p.ws);
    const u16* PROJ = (const u16*)(ws + OFF_PROJ); const u16* QROT = (const u16*)(ws + OFF_QROT);
    const u16* CKV = (const u16*)(ws + OFF_CTXKV) + (size_t)l * MCTX * 1024;
    u16* Y0 = (u16*)(ws + OFF_Y);
    const int tid = tidx(), w = tid >> 6, lane = tid & 63, qtr = w & 3, kh = w >> 2, li = lane & 15, quad = lane >> 4;
    u16* Kl = (u16*)lds; u16* Vl = Kl + 512 * KVS; float* rp = (float*)(Vl + 512 * KVS);
    int bl, h, r = 0, qrow0, bglob;
    if (!ps.is_ctx) { r = item & 63; h = (item >> 6) & 7; bl = item >> 9; qrow0 = bl * 4096 + r * 64; bglob = ps.b0 + bl; }
    else { const int qb = item & 3; h = (item >> 2) & 7; bl = item >> 5; qrow0 = bl * 256 + qb * 64; bglob = bl; }
    const int qrow = qrow0 + qtr * 16 + li;
    float m_run = -1e30f, l_run = 0.f;
    const bf16x8 qp0 = ld_frag_g(PJ(qrow, 0, h * 64 + quad * 8)), qp1 = ld_frag_g(PJ(qrow, 0, h * 64 + 32 + quad * 8));
    uint2 gate4[4];
#pragma unroll
    for (int d = 0; d < 4; ++d) gate4[d] = *(const uint2*)(PJ(qrow, 3, h * 64 + d * 16 + quad * 4));
    Reg8 crg;
    { const size_t crow0 = (size_t)bglob * 256;
#pragma unroll
      for (int i = 0; i < 4; ++i) { const int idx = tid + 512 * i, key = idx >> 3, ch = idx & 7;
          crg.ld(2 * i, CKV + (crow0 + key) * 1024 + h * 64 + ch * 8); crg.ld(2 * i + 1, CKV + (crow0 + key) * 1024 + 512 + h * 64 + ch * 8); } }
    f32x4 O[4];
#pragma unroll
    for (int d = 0; d < 4; ++d) O[d] = (f32x4){0.f, 0.f, 0.f, 0.f};
    if (!ps.is_ctx) {
        const int rs = min(max(r - 4, 0), 56);
        const size_t krow0 = (size_t)bl * 4096 + rs * 64;
        const bf16x8 q0 = ld_frag_g(QROT + (size_t)qrow * 512 + h * 64 + quad * 8), q1 = ld_frag_g(QROT + (size_t)qrow * 512 + h * 64 + 32 + quad * 8);
        { u32x32_ kr, vr;
#pragma unroll
          for (int i = 0; i < 8; ++i) { const int idx = tid + 512 * i, key = idx >> 3, ch = idx & 7;
              const u32x4_ a = *(const u32x4_*)(PJ(krow0 + key, 1, h * 64 + ch * 8)), b = *(const u32x4_*)(PJ(krow0 + key, 2, h * 64 + ch * 8));
              kr[4 * i] = a[0]; kr[4 * i + 1] = a[1]; kr[4 * i + 2] = a[2]; kr[4 * i + 3] = a[3]; vr[4 * i] = b[0]; vr[4 * i + 1] = b[1]; vr[4 * i + 2] = b[2]; vr[4 * i + 3] = b[3]; }
          asm volatile("" ::: "memory");
#pragma unroll
          for (int i = 0; i < 8; ++i) { const int idx = tid + 512 * i, key = idx >> 3, ch = idx & 7;
              *(u32x4_*)(Kl + key * KVS + ch * 8) = (u32x4_){kr[4 * i], kr[4 * i + 1], kr[4 * i + 2], kr[4 * i + 3]}; *(u32x4_*)(Vl + key * KVS + ch * 8) = (u32x4_){vr[4 * i], vr[4 * i + 1], vr[4 * i + 2], vr[4 * i + 3]}; } }
        for (int i = tid; i < 465; i += 512) rp[i] = p.rpb[((size_t)l * 8 + h) * 465 + i];
        __syncthreads();
        const int cbase = (qtr == 0) ? 0 : (qtr == 1 ? 8 : (qtr == 2 ? 24 : 32));
        const int qc = qtr * 16 + li, cst = min(max(qc - 8, 0), 48);
        float s[8][4];
        float mx = -1e30f;
#pragma unroll
        for (int sb = 0; sb < 8; ++sb) {
            const int i = kh * 4 + (sb >> 1), cs = sb & 1;
            const u16* kp = Kl + (i * 64 + cbase + cs * 16 + li) * KVS + quad * 8;
            f32x4 a = (f32x4){0.f, 0.f, 0.f, 0.f};
            a = MFMA16(*(const bf16x8*)kp, q0, a); a = MFMA16(*(const bf16x8*)(kp + 32), q1, a);
            const int ridx = rs + i - r + 7;
#pragma unroll
            for (int j = 0; j < 4; ++j) { const int kc = cbase + cs * 16 + quad * 4 + j;
                const bool valid = (kc >= cst) && (kc < cst + 16);
                const int cidx = min(max(kc - qc + 15, 0), 30);
                const float v = valid ? (a[j] * 0.125f + rp[ridx * 31 + cidx]) : -1e30f;
                s[sb][j] = v; mx = fmaxf(mx, v); }
        }
        mx = fmaxf(mx, shx(mx, 16)); mx = fmaxf(mx, shx(mx, 32));
        m_run = mx;
        float ls = 0.f;
#pragma unroll
        for (int sb = 0; sb < 8; ++sb)
#pragma unroll
            for (int j = 0; j < 4; ++j) { const float e = __expf(s[sb][j] - mx); s[sb][j] = e; ls += e; }
        ls += shx(ls, 16); ls += shx(ls, 32);
        l_run = ls;
#pragma unroll
        for (int kp2 = 0; kp2 < 4; ++kp2) {
            bf16x8 pf; { const unsigned a0 = pack2(s[2 * kp2][0], s[2 * kp2][1]), a1 = pack2(s[2 * kp2][2], s[2 * kp2][3]), b0 = pack2(s[2 * kp2 + 1][0], s[2 * kp2 + 1][1]), b1 = pack2(s[2 * kp2 + 1][2], s[2 * kp2 + 1][3]);
                pf = (bf16x8){(short)(a0 & 0xffff), (short)(a0 >> 16), (short)(a1 & 0xffff), (short)(a1 >> 16), (short)(b0 & 0xffff), (short)(b0 >> 16), (short)(b1 & 0xffff), (short)(b1 >> 16)}; }
            const int vrow0 = (kh * 4 + kp2) * 64 + cbase + quad * 4 + (li >> 2);
#pragma unroll
            for (int d = 0; d < 4; ++d) {
                const u16* vp = Vl + vrow0 * KVS + d * 16 + 4 * (li & 3);
                const bf16x8 vf = tr_read2(vp, vp + 16 * KVS);
                O[d] = MFMA16(vf, pf, O[d]);
            }
        }
        __syncthreads();
    }
    {
#pragma unroll
        for (int i = 0; i < 4; ++i) { const int idx = tid + 512 * i, key = idx >> 3, ch = idx & 7;
            *(u32x4_*)(Kl + key * KVS + ch * 8) = crg.get(2 * i); *(u32x4_*)(Vl + key * KVS + ch * 8) = crg.get(2 * i + 1); }
        __syncthreads();
        const bf16x8 q0 = qp0, q1 = qp1;
        float s[8][4];
        float mx = -1e30f;
#pragma unroll
        for (int sb = 0; sb < 8; ++sb) {
            const u16* kp = Kl + (kh * 128 + sb * 16 + li) * KVS + quad * 8;
            f32x4 a = (f32x4){0.f, 0.f, 0.f, 0.f};
            a = MFMA16(*(const bf16x8*)kp, q0, a); a = MFMA16(*(const bf16x8*)(kp + 32), q1, a);
#pragma unroll
            for (int j = 0; j < 4; ++j) { const float v = a[j] * 0.125f; s[sb][j] = v; mx = fmaxf(mx, v); }
        }
        mx = fmaxf(mx, shx(mx, 16)); mx = fmaxf(mx, shx(mx, 32));
        const float m_new = fmaxf(m_run, mx), resc = __expf(m_run - m_new);
        float ls = 0.f;
#pragma unroll
        for (int sb = 0; sb < 8; ++sb)
#pragma unroll
            for (int j = 0; j < 4; ++j) { const float e = __expf(s[sb][j] - m_new); s[sb][j] = e; ls += e; }
        ls += shx(ls, 16); ls += shx(ls, 32);
        l_run = l_run * resc + ls; m_run = m_new;
#pragma unroll
        for (int d = 0; d < 4; ++d) O[d] *= resc;
#pragma unroll
        for (int kp2 = 0; kp2 < 4; ++kp2) {
            bf16x8 pf; { const unsigned a0 = pack2(s[2 * kp2][0], s[2 * kp2][1]), a1 = pack2(s[2 * kp2][2], s[2 * kp2][3]), b0 = pack2(s[2 * kp2 + 1][0], s[2 * kp2 + 1][1]), b1 = pack2(s[2 * kp2 + 1][2], s[2 * kp2 + 1][3]);
                pf = (bf16x8){(short)(a0 & 0xffff), (short)(a0 >> 16), (short)(a1 & 0xffff), (short)(a1 >> 16), (short)(b0 & 0xffff), (short)(b0 >> 16), (short)(b1 & 0xffff), (short)(b1 >> 16)}; }
            const int vrow0 = kh * 128 + kp2 * 32 + quad * 4 + (li >> 2);
#pragma unroll
            for (int d = 0; d < 4; ++d) {
                const u16* vp = Vl + vrow0 * KVS + d * 16 + 4 * (li & 3);
                const bf16x8 vf = tr_read2(vp, vp + 16 * KVS);
                O[d] = MFMA16(vf, pf, O[d]);
            }
        }
        __syncthreads();
    }
    float* cb = (float*)lds;
    if (kh == 1) {
#pragma unroll
        for (int d = 0; d < 4; ++d)
#pragma unroll
            for (int j = 0; j < 4; ++j) cb[(qtr * 18 + d * 4 + j) * 64 + lane] = O[d][j];
        cb[(qtr * 18 + 16) * 64 + lane] = m_run; cb[(qtr * 18 + 17) * 64 + lane] = l_run;
    }
    __syncthreads();
    if (kh == 0) {
        const float m2 = cb[(qtr * 18 + 16) * 64 + lane], l2 = cb[(qtr * 18 + 17) * 64 + lane];
        const float mm = fmaxf(m_run, m2), e1 = __expf(m_run - mm), e2 = __expf(m2 - mm);
        const float inv = 1.f / (l_run * e1 + l2 * e2);
#pragma unroll
        for (int d = 0; d < 4; ++d) {
            const int col = h * 64 + d * 16 + quad * 4;
            const uint2 g = gate4[d];
            float o[4];
#pragma unroll
            for (int j = 0; j < 4; ++j) o[j] = (O[d][j] * e1 + cb[(qtr * 18 + d * 4 + j) * 64 + lane] * e2) * inv;
            uint2 wv; wv.x = pack2(o[0] * siluf_(bflo(g.x)), o[1] * siluf_(bfhi(g.x))); wv.y = pack2(o[2] * siluf_(bflo(g.y)), o[3] * siluf_(bfhi(g.y)));
            *(uint2*)(Y0 + (size_t)qrow * 512 + col) = wv;
        }
    }
    __syncthreads();
}

template <int ROWS, int CPR> __device__ __forceinline__ void load_tile(u16* dstl, int lstride, const u16* src, size_t sstride) {
    constexpr int PER = ROWS * CPR / 512;
    static_assert(PER % 8 == 0, "tile size");
    const int tid_ = tidx();
#pragma unroll
    for (int b8 = 0; b8 < PER / 8; ++b8) { Reg8 rg;
#pragma unroll
        for (int j = 0; j < 8; ++j) { const int i = tid_ + 512 * (b8 * 8 + j), r = i / CPR, ch = i % CPR; rg.ld(j, src + (size_t)r * sstride + ch * 8); }
        MEMBAR();
#pragma unroll
        for (int j = 0; j < 8; ++j) { const int i = tid_ + 512 * (b8 * 8 + j), r = i / CPR, ch = i % CPR; *(u32x4_*)(dstl + r * lstride + ch * 8) = rg.get(j); }
        MEMBAR(); }
}

__device__ void four1_item(const Params& p, int item, unsigned char* lds) {
    unsigned char* ws = opaque(p.ws);
    const u16* PROJ = (const u16*)(ws + OFF_PROJ); const u16* M1 = (const u16*)(ws + OFF_M1); const float* TW = (const float*)(ws + OFF_TW);
    u16* FY = (u16*)(ws + OFF_FY);
    const int tid = tidx(), w = tid >> 6, lane = tid & 63, li = lane & 15, quad = lane >> 4;
    const int n2 = item & 63, bl = item >> 6;
    u16* T = (u16*)lds;
#pragma unroll
    for (int b8 = 0; b8 < 2; ++b8) { Reg8 rg;
#pragma unroll
        for (int j = 0; j < 8; ++j) { const int i = tid + 512 * (b8 * 8 + j), kk = i >> 6, ch = i & 63, n1 = kk >> 1, part = kk & 1;
            rg.ld(j, PJ((size_t)bl * 4096 + n1 * 64 + n2, 4 + part, ch * 8)); }
        MEMBAR();
#pragma unroll
        for (int j = 0; j < 8; ++j) { const int i = tid + 512 * (b8 * 8 + j), kk = i >> 6, ch = i & 63;
            *(u32x4_*)(T + kk * TS + ch * 8) = rg.get(j); }
        MEMBAR(); }
    __syncthreads();
    for (int isub = 0; isub < 8; ++isub) {
        bf16x8 xf[4];
#pragma unroll
        for (int ks = 0; ks < 4; ++ks) xf[ks] = ld_frag_g(M1 + (isub * 16 + li) * 128 + ks * 32 + quad * 8);
#pragma unroll
        for (int cs = 0; cs < 4; ++cs) {
            const int c0 = w * 64 + cs * 16;
            f32x4 a = (f32x4){0.f, 0.f, 0.f, 0.f};
#pragma unroll
            for (int ks = 0; ks < 4; ++ks) {
                const u16* tp = T + (ks * 32 + quad * 8 + (li >> 2)) * TS + c0 + 4 * (li & 3);
                a = MFMA16(xf[ks], tr_read2(tp, tp + 4 * TS), a);
            }
            const int ch = c0 + li;
#pragma unroll
            for (int hh = 0; hh < 2; ++hh) {
                const int k1 = isub * 8 + quad * 2 + hh;
                const float yr = a[2 * hh], yi = a[2 * hh + 1];
                const float tc = TW[2 * (n2 * k1)], tsn = TW[2 * (n2 * k1) + 1];
                const float orr = yr * tc + yi * tsn, oi = yi * tc - yr * tsn;
                u16* dst = FY + (((size_t)bl * 64 + k1) * 64 + n2) * 1024 + ch;
                dst[0] = f2bf(orr); dst[512] = f2bf(oi);
            }
        }
    }
    __syncthreads();
}

__device__ void four2_item(const Params& p, int item, unsigned char* lds) {
    unsigned char* ws = opaque(p.ws);
    const u16* PROJ = (const u16*)(ws + OFF_PROJ); const u16* M2 = (const u16*)(ws + OFF_M2); const u16* FY = (const u16*)(ws + OFF_FY);
    u16* Y1 = (u16*)(ws + OFF_Y) + (size_t)1 * MLAT * 512;
    const int tid = tidx(), w = tid >> 6, lane = tid & 63, li = lane & 15, quad = lane >> 4;
    const int k1 = item & 63, bl = item >> 6;
    u16* T = (u16*)lds;
    load_tile<128, 64>(T, TS, FY + ((size_t)bl * 64 + k1) * 64 * 1024, 512);
    __syncthreads();
    bf16x8 xf[4][4];
#pragma unroll
    for (int cs = 0; cs < 4; ++cs)
#pragma unroll
        for (int ks = 0; ks < 4; ++ks) { const u16* tp = T + (ks * 32 + quad * 8 + (li >> 2)) * TS + w * 64 + cs * 16 + 4 * (li & 3); xf[cs][ks] = tr_read2(tp, tp + 4 * TS); }
    for (int k2s = 0; k2s < 4; ++k2s) {
        bf16x8 yf[4];
#pragma unroll
        for (int ks = 0; ks < 4; ++ks) yf[ks] = ld_frag_g(M2 + (k2s * 16 + li) * 128 + ks * 32 + quad * 8);
        const int k2 = k2s * 16 + li;
        const size_t row = (size_t)bl * 4096 + k1 + 64 * k2;
#pragma unroll
        for (int cs = 0; cs < 4; ++cs) {
            f32x4 a = (f32x4){0.f, 0.f, 0.f, 0.f};
#pragma unroll
            for (int ks = 0; ks < 4; ++ks) a = MFMA16(xf[cs][ks], yf[ks], a);
            const int ch = w * 64 + cs * 16 + quad * 4;
            const uint2 g = *(const uint2*)(PJ(row, 6, ch));
            uint2 wv; wv.x = pack2(a[0] * NORM_LAT * siluf_(bflo(g.x)), a[1] * NORM_LAT * siluf_(bfhi(g.x))); wv.y = pack2(a[2] * NORM_LAT * siluf_(bflo(g.y)), a[3] * NORM_LAT * siluf_(bfhi(g.y)));
            *(uint2*)(Y1 + row * 512 + ch) = wv;
        }
    }
    __syncthreads();
}

__device__ void fourc_item(const Params& p, int item, unsigned char* lds) {
    unsigned char* ws = opaque(p.ws);
    const u16* PROJ = (const u16*)(ws + OFF_PROJ); const u16* M3 = (const u16*)(ws + OFF_M3);
    u16* Y1 = (u16*)(ws + OFF_Y) + (size_t)1 * MLAT * 512;
    const int tid = tidx(), w = tid >> 6, lane = tid & 63, li = lane & 15, quad = lane >> 4;
    const int chb = item & 3, b = item >> 2;
    u16* T = (u16*)lds;
#pragma unroll
    for (int b8 = 0; b8 < 2; ++b8) { Reg8 rg;
#pragma unroll
        for (int j = 0; j < 8; ++j) { const int i = tid + 512 * (b8 * 8 + j), kk = i >> 4, ch = i & 15, n = kk >> 1, part = kk & 1;
            rg.ld(j, PJ((size_t)b * 256 + n, 4 + part, chb * 128 + ch * 8)); }
        MEMBAR();
#pragma unroll
        for (int j = 0; j < 8; ++j) { const int i = tid + 512 * (b8 * 8 + j), kk = i >> 4, ch = i & 15;
            *(u32x4_*)(T + kk * T3S + ch * 8) = rg.get(j); }
        MEMBAR(); }
    __syncthreads();
    for (int kq = 0; kq < 2; ++kq) {
        const int ksub = w * 2 + kq;
        f32x4 a[8];
#pragma unroll
        for (int cs = 0; cs < 8; ++cs) a[cs] = (f32x4){0.f, 0.f, 0.f, 0.f};
        for (int ks = 0; ks < 16; ++ks) {
            const bf16x8 yf = ld_frag_g(M3 + (ksub * 16 + li) * 512 + ks * 32 + quad * 8);
#pragma unroll
            for (int cs = 0; cs < 8; ++cs) { const u16* tp = T + (ks * 32 + quad * 8 + (li >> 2)) * T3S + cs * 16 + 4 * (li & 3);
                a[cs] = MFMA16(tr_read2(tp, tp + 4 * T3S), yf, a[cs]); }
        }
        const size_t row = (size_t)b * 256 + ksub * 16 + li;
#pragma unroll
        for (int cs = 0; cs < 8; ++cs) {
            const int ch = chb * 128 + cs * 16 + quad * 4;
            const uint2 g = *(const uint2*)(PJ(row, 6, ch));
            uint2 wv; wv.x = pack2(a[cs][0] * NORM_CTX * siluf_(bflo(g.x)), a[cs][1] * NORM_CTX * siluf_(bfhi(g.x))); wv.y = pack2(a[cs][2] * NORM_CTX * siluf_(bflo(g.y)), a[cs][3] * NORM_CTX * siluf_(bfhi(g.y)));
            *(uint2*)(Y1 + row * 512 + ch) = wv;
        }
    }
    __syncthreads();
}

__device__ void gmlp_item(const Params& p, int l, int item, unsigned char* lds) {
    unsigned char* ws = opaque(p.ws);
    const u16* PROJ = (const u16*)(ws + OFF_PROJ); const u16* WS16 = (const u16*)(ws + OFF_WS16) + (size_t)l * 8 * 128 * 128;
    u16* Y2 = (u16*)(ws + OFF_Y) + (size_t)2 * MLAT * 512;
    const int tid = tidx(), w = tid >> 6, lane = tid & 63, li = lane & 15, quad = lane >> 4;
    const size_t r0 = (size_t)item * 128;
    u16* VN = (u16*)lds;
    {
        const int row = tid >> 2, qd = tid & 3;
        const u16* src = PJ(r0 + row, 8, 0);
        uint4 raw[16]; float ss = 0.f;
#pragma unroll
        for (int i = 0; i < 16; ++i) { raw[i] = *(const uint4*)(src + (qd + 4 * i) * 8); float f[8]; unpack8(raw[i], f);
#pragma unroll
            for (int e = 0; e < 8; ++e) ss += f[e] * f[e]; }
        ss += shx(ss, 1); ss += shx(ss, 2);
        const float rstd = rsqrtf(ss * (1.f / 512.f) + EPSN);
        const float* gn = p.gmlp_g + l * 512;
#pragma unroll
        for (int i = 0; i < 16; ++i) { float f[8]; unpack8(raw[i], f); const int c0 = (qd + 4 * i) * 8;
            const float4 g0 = *(const float4*)(gn + c0), g1 = *(const float4*)(gn + c0 + 4);
            uint4 o; o.x = pack2(f[0] * rstd * g0.x, f[1] * rstd * g0.y); o.y = pack2(f[2] * rstd * g0.z, f[3] * rstd * g0.w);
            o.z = pack2(f[4] * rstd * g1.x, f[5] * rstd * g1.y); o.w = pack2(f[6] * rstd * g1.z, f[7] * rstd * g1.w);
            *(uint4*)(VN + row * TS + c0) = o; }
    }
    __syncthreads();
    const int g = w;
    bf16x8 xf[4][4];
#pragma unroll
    for (int cs = 0; cs < 4; ++cs)
#pragma unroll
        for (int ks = 0; ks < 4; ++ks) { const u16* tp = VN + (ks * 32 + quad * 8 + (li >> 2)) * TS + g * 64 + cs * 16 + 4 * (li & 3); xf[cs][ks] = tr_read2(tp, tp + 4 * TS); }
    for (int ts = 0; ts < 8; ++ts) {
        bf16x8 yf[4];
#pragma unroll
        for (int ks = 0; ks < 4; ++ks) yf[ks] = ld_frag_g(WS16 + ((size_t)g * 128 + ts * 16 + li) * 128 + ks * 32 + quad * 8);
        const int t = ts * 16 + li;
        const float bs = p.gmlp_bs[((size_t)l * 8 + g) * 128 + t];
        const size_t row = r0 + t;
#pragma unroll
        for (int cs = 0; cs < 4; ++cs) {
            f32x4 a = (f32x4){0.f, 0.f, 0.f, 0.f};
#pragma unroll
            for (int ks = 0; ks < 4; ++ks) a = MFMA16(xf[cs][ks], yf[ks], a);
            const int c = g * 64 + cs * 16 + quad * 4;
            const uint2 uu = *(const uint2*)(PJ(row, 7, c)), gg = *(const uint2*)(PJ(row, 9, c));
            uint2 wv; wv.x = pack2(bflo(uu.x) * (a[0] + bs) * siluf_(bflo(gg.x)), bfhi(uu.x) * (a[1] + bs) * siluf_(bfhi(gg.x)));
            wv.y = pack2(bflo(uu.y) * (a[2] + bs) * siluf_(bflo(gg.y)), bfhi(uu.y) * (a[3] + bs) * siluf_(bfhi(gg.y)));
            *(uint2*)(Y2 + row * 512 + c) = wv;
        }
    }
    __syncthreads();
}

__device__ __forceinline__ void chunk_cumsum(float* A, float* tmp, int dir) {
    const int k = tidx() & 63, seg = tidx() >> 6;
    float v[8]; float run = 0.f;
    if (dir == 0) {
#pragma unroll
        for (int e = 0; e < 8; ++e) { run += A[(seg * 8 + e) * HS_ + k]; v[e] = run; }
    } else {
#pragma unroll
        for (int e = 7; e >= 0; --e) { run += A[(seg * 8 + e) * HS_ + k]; v[e] = run; }
    }
    tmp[seg * 64 + k] = run;
    __syncthreads();
    float off = 0.f;
#pragma unroll
    for (int s2 = 0; s2 < 8; ++s2) { const float tv = tmp[s2 * 64 + k]; if (dir == 0 ? (s2 < seg) : (s2 > seg)) off += tv; }
#pragma unroll
    for (int e = 0; e < 8; ++e) A[(seg * 8 + e) * HS_ + k] = (v[e] + off) * LOG2E;
    __syncthreads();
}
__device__ __forceinline__ void chunk_cumsum2(float* Af, float* Ab, float* tmp) {
    const int k = tidx() & 63, seg = tidx() >> 6;
    float vf[8], vb[8]; float rf = 0.f, rb = 0.f;
#pragma unroll
    for (int e = 0; e < 8; ++e) { rf += Af[(seg * 8 + e) * HS_ + k]; vf[e] = rf; }
#pragma unroll
    for (int e = 7; e >= 0; --e) { rb += Ab[(seg * 8 + e) * HS_ + k]; vb[e] = rb; }
    tmp[seg * 64 + k] = rf; tmp[512 + seg * 64 + k] = rb;
    __syncthreads();
    float of = 0.f, ob = 0.f;
#pragma unroll
    for (int s2 = 0; s2 < 8; ++s2) { const float tf = tmp[s2 * 64 + k], tb = tmp[512 + s2 * 64 + k]; if (s2 < seg) of += tf; if (s2 > seg) ob += tb; }
#pragma unroll
    for (int e = 0; e < 8; ++e) { Af[(seg * 8 + e) * HS_ + k] = (vf[e] + of) * LOG2E; Ab[(seg * 8 + e) * HS_ + k] = (vb[e] + ob) * LOG2E; }
    __syncthreads();
}
__device__ __forceinline__ void load_bf_tile64(float* dst, const u16* src  , size_t sstride) {
    const int t = tidx() >> 3, k8 = (tidx() & 7) * 8;
    float f[8]; unpack8(*(const uint4*)(src + (size_t)t * sstride + k8), f);
    *(float4*)(dst + t * HS_ + k8) = make_float4(f[0], f[1], f[2], f[3]); *(float4*)(dst + t * HS_ + k8 + 4) = make_float4(f[4], f[5], f[6], f[7]);
}
__device__ __forceinline__ void load_f32_tile64(float* dst, const float* src, size_t sstride) {
    const int t = tidx() >> 3, k8 = (tidx() & 7) * 8;
    *(float4*)(dst + t * HS_ + k8) = *(const float4*)(src + (size_t)t * sstride + k8); *(float4*)(dst + t * HS_ + k8 + 4) = *(const float4*)(src + (size_t)t * sstride + k8 + 4);
}

__device__ void hgrn1_item(const Params& p, const PassInfo ps, int item, unsigned char* lds) {
    unsigned char* ws = opaque(p.ws);
    const u16* PROJ = (const u16*)(ws + OFF_PROJ); const float* LOGF = (const float*)(ws + OFF_LOGF);
    u16* HL = (u16*)(ws + OFF_HL); float* HD = (float*)(ws + OFF_HD);
    const int NC = ps.T >> 6, ncsh = ps.is_ctx ? 2 : 6, c = item & (NC - 1), ci = item >> ncsh, dir = ci & 1, h = (ci >> 1) & 7, bl = ci >> 4;
    const size_t r0 = (size_t)bl * ps.T + c * 64;
    float* A = (float*)lds; float* tmp = A + 64 * HS_; u16* Wb = (u16*)(tmp + 512); u16* Ib = Wb + 64 * KVS;
    const int tid = tidx(), w = tid >> 6, lane = tid & 63, li = lane & 15, quad = lane >> 4;
    const int t = tid >> 3, k8 = (tid & 7) * 8;
    float kf[8];
    { Reg8 rg;
      const float* ap = LOGF + (r0 + t) * 1024 + dir * 512 + h * 64 + k8;
      rg.ld(0, ap); rg.ld(1, ap + 4); rg.ld(2, PJ(r0 + t, 11 + dir, h * 64 + k8)); rg.ld(3, PJ(r0 + t, 13, h * 64 + k8));
      MEMBAR();
      unpack8(rg.getu(2), kf);
      *(u32x4_*)(A + t * HS_ + k8) = rg.get(0); *(u32x4_*)(A + t * HS_ + k8 + 4) = rg.get(1);
      *(u32x4_*)(Ib + t * KVS + k8) = rg.get(3); }
    __syncthreads();
    chunk_cumsum(A, tmp, dir);
    const int lastt = dir == 0 ? 63 : 0;
    { float wv[8];
#pragma unroll
      for (int e = 0; e < 8; ++e) wv[e] = kf[e] * __builtin_amdgcn_exp2f(A[lastt * HS_ + k8 + e] - A[t * HS_ + k8 + e]);
      uint4 wq; wq.x = pack2(wv[0], wv[1]); wq.y = pack2(wv[2], wv[3]); wq.z = pack2(wv[4], wv[5]); wq.w = pack2(wv[6], wv[7]);
      *(uint4*)(Wb + t * KVS + k8) = wq;
      if (tid < 64) HD[(size_t)item * 64 + tid] = __builtin_amdgcn_exp2f(A[lastt * HS_ + tid]); }
    __syncthreads();
    {
        const int ksub = w >> 1;
        bf16x8 yf[2];
#pragma unroll
        for (int ks = 0; ks < 2; ++ks) { const u16* tp = Wb + (ks * 32 + quad * 8 + (li >> 2)) * KVS + ksub * 16 + 4 * (li & 3); yf[ks] = tr_read2(tp, tp + 4 * KVS); }
#pragma unroll
        for (int vv = 0; vv < 2; ++vv) {
            const int vsub = (w & 1) * 2 + vv;
            f32x4 a = (f32x4){0.f, 0.f, 0.f, 0.f};
#pragma unroll
            for (int ks = 0; ks < 2; ++ks) { const u16* tp = Ib + (ks * 32 + quad * 8 + (li >> 2)) * KVS + vsub * 16 + 4 * (li & 3); a = MFMA16(tr_read2(tp, tp + 4 * KVS), yf[ks], a); }
            uint2 o; o.x = pack2(a[0], a[1]); o.y = pack2(a[2], a[3]);
            *(uint2*)(HL + ((size_t)item * 64 + ksub * 16 + li) * 64 + vsub * 16 + quad * 4) = o;
        }
    }
    __syncthreads();
}

__device__ void hgrn2_all(const Params& p, const PassInfo ps, int l) {
    unsigned char* ws = opaque(p.ws);
    const unsigned* HL = (const unsigned*)(ws + OFF_HL); const float* HD = (const float*)(ws + OFF_HD); unsigned* HS = (unsigned*)(ws + OFF_HS);
    float* CST = (float*)(ws + OFF_CTXST) + (size_t)l * 256 * 4096;
    const int NC = ps.T >> 6, chains = ps.nb * 16;
    const size_t total = (size_t)chains * 2048;
    for (size_t e = (size_t)blockIdx.x * 512 + tidx(); e < total; e += (size_t)gridDim.x * 512) {
        const int ci = (int)(e >> 11), kv2 = (int)(e & 2047), k = kv2 >> 5, dir = ci & 1;
        float s0 = 0.f, s1 = 0.f;
        if (!ps.is_ctx) { const float2 cs = *(const float2*)(CST + ((size_t)ps.b0 * 16 + ci) * 4096 + 2 * kv2); s0 = cs.x; s1 = cs.y; }
#define HG2_TRIP(BLK) for (int c4 = 0; c4 < NC; c4 += BLK) { float d[BLK]; unsigned lw[BLK]; \
            _Pragma("unroll") for (int j = 0; j < BLK; ++j) { const int c = dir ? NC - 1 - (c4 + j) : c4 + j; const size_t idx = (size_t)ci * NC + c; d[j] = HD[idx * 64 + k]; lw[j] = HL[idx * 2048 + kv2]; } \
            _Pragma("unroll") for (int j = 0; j < BLK; ++j) { const int c = dir ? NC - 1 - (c4 + j) : c4 + j; const size_t idx = (size_t)ci * NC + c; \
                HS[idx * 2048 + kv2] = pack2(s0, s1); s0 = d[j] * s0 + bflo(lw[j]); s1 = d[j] * s1 + bfhi(lw[j]); } }
        if (NC == 4) { HG2_TRIP(4) } else { HG2_TRIP(16) }
#undef HG2_TRIP
        if (ps.is_ctx) *(float2*)(CST + (size_t)ci * 4096 + 2 * kv2) = make_float2(s0, s1);
    }
}

__device__ void hgrn3_item(const Params& p, const PassInfo ps, int l, int item, unsigned char* lds) {
    unsigned char* ws = opaque(p.ws);
    const u16* PROJ = (const u16*)(ws + OFF_PROJ); const float* LOGF = (const float*)(ws + OFF_LOGF); const u16* HSt = (const u16*)(ws + OFF_HS);
    u16* Y3 = (u16*)(ws + OFF_Y) + (size_t)3 * MLAT * 512;
    const int NC = ps.T >> 6, ncsh = ps.is_ctx ? 2 : 6, c = item & (NC - 1), bh = item >> ncsh, h = bh & 7, bl = bh >> 3;
    const size_t r0 = (size_t)bl * ps.T + c * 64;
    const size_t idxf = (size_t)(bh * 2 + 0) * NC + c, idxb = (size_t)(bh * 2 + 1) * NC + c;
    float* Q = (float*)lds; float* KKf = Q + 64 * HS_; float* KKb = KKf + 64 * HS_; float* Af = KKb + 64 * HS_; float* Ab = Af + 64 * HS_; float* tmp = Ab + 64 * HS_;
    u16* Ib = (u16*)(tmp + 1024); u16* Sfb = Ib + 64 * KVS; u16* Sbb = Sfb + 64 * KVS; float* comb = (float*)(Sbb + 64 * KVS);
    const int tid = tidx(), w = tid >> 6, lane = tid & 63, li = lane & 15, quad = lane >> 4;
    { const int t = tid >> 3, k8 = (tid & 7) * 8;
      Reg8 ra, rb;
      const float* ap = LOGF + (r0 + t) * 1024 + h * 64 + k8;
      const u16* sf = HSt + idxf * 4096 + t * 64 + k8; const u16* sb = HSt + idxb * 4096 + t * 64 + k8;
      ra.ld(0, PJ(r0 + t, 10, h * 64 + k8)); ra.ld(1, PJ(r0 + t, 11, h * 64 + k8)); ra.ld(2, PJ(r0 + t, 12, h * 64 + k8)); ra.ld(3, PJ(r0 + t, 13, h * 64 + k8));
      ra.ld(4, ap); ra.ld(5, ap + 4); ra.ld(6, ap + 512); ra.ld(7, ap + 516);
      rb.ld(0, sf); rb.ld(1, sb);
      MEMBAR();
      float x[8];
      unpack8(ra.getu(0), x); *(float4*)(Q + t * HS_ + k8) = make_float4(x[0], x[1], x[2], x[3]); *(float4*)(Q + t * HS_ + k8 + 4) = make_float4(x[4], x[5], x[6], x[7]);
      unpack8(ra.getu(1), x); *(float4*)(KKf + t * HS_ + k8) = make_float4(x[0], x[1], x[2], x[3]); *(float4*)(KKf + t * HS_ + k8 + 4) = make_float4(x[4], x[5], x[6], x[7]);
      unpack8(ra.getu(2), x); *(float4*)(KKb + t * HS_ + k8) = make_float4(x[0], x[1], x[2], x[3]); *(float4*)(KKb + t * HS_ + k8 + 4) = make_float4(x[4], x[5], x[6], x[7]);
      *(u32x4_*)(Ib + t * KVS + k8) = ra.get(3);
      *(u32x4_*)(Af + t * HS_ + k8) = ra.get(4); *(u32x4_*)(Af + t * HS_ + k8 + 4) = ra.get(5); *(u32x4_*)(Ab + t * HS_ + k8) = ra.get(6); *(u32x4_*)(Ab + t * HS_ + k8 + 4) = ra.get(7);
      *(u32x4_*)(Sfb + t * KVS + k8) = rb.get(0); *(u32x4_*)(Sbb + t * KVS + k8) = rb.get(1); }
    __syncthreads();
    chunk_cumsum2(Af, Ab, tmp);
    const int dir = w >> 2, T = w & 3;
    const float* A = dir ? Ab : Af; const float* KK = dir ? KKb : KKf; const u16* Sb16 = dir ? Sbb : Sfb;
    const int t = 16 * T + li;
    const int rrow = dir ? 16 * T + 16 : 16 * T - 1; const bool rzero = dir ? (T == 3) : (T == 0);
    bf16x8 qt[2], qh[2];
    float Rv[2][8];
#pragma unroll
    for (int ks = 0; ks < 2; ++ks) {
        const int k0 = ks * 32 + quad * 8;
        float qv[8], av[8];
        { const float4 x0 = *(const float4*)(Q + t * HS_ + k0), x1 = *(const float4*)(Q + t * HS_ + k0 + 4); qv[0] = x0.x; qv[1] = x0.y; qv[2] = x0.z; qv[3] = x0.w; qv[4] = x1.x; qv[5] = x1.y; qv[6] = x1.z; qv[7] = x1.w; }
        { const float4 x0 = *(const float4*)(A + t * HS_ + k0), x1 = *(const float4*)(A + t * HS_ + k0 + 4); av[0] = x0.x; av[1] = x0.y; av[2] = x0.z; av[3] = x0.w; av[4] = x1.x; av[5] = x1.y; av[6] = x1.z; av[7] = x1.w; }
        if (rzero) {
#pragma unroll
            for (int e = 0; e < 8; ++e) Rv[ks][e] = 0.f;
        } else { const float4 x0 = *(const float4*)(A + rrow * HS_ + k0), x1 = *(const float4*)(A + rrow * HS_ + k0 + 4); Rv[ks][0] = x0.x; Rv[ks][1] = x0.y; Rv[ks][2] = x0.z; Rv[ks][3] = x0.w; Rv[ks][4] = x1.x; Rv[ks][5] = x1.y; Rv[ks][6] = x1.z; Rv[ks][7] = x1.w; }
        float a_[8], b_[8];
#pragma unroll
        for (int e = 0; e < 8; ++e) { a_[e] = qv[e] * __builtin_amdgcn_exp2f(av[e] - Rv[ks][e]); b_[e] = qv[e] * __builtin_amdgcn_exp2f(av[e]); }
        const unsigned a0 = pack2(a_[0], a_[1]), a1 = pack2(a_[2], a_[3]), a2 = pack2(a_[4], a_[5]), a3 = pack2(a_[6], a_[7]);
        const unsigned b0 = pack2(b_[0], b_[1]), b1 = pack2(b_[2], b_[3]), b2 = pack2(b_[4], b_[5]), b3 = pack2(b_[6], b_[7]);
        qt[ks] = (bf16x8){(short)(a0 & 0xffff), (short)(a0 >> 16), (short)(a1 & 0xffff), (short)(a1 >> 16), (short)(a2 & 0xffff), (short)(a2 >> 16), (short)(a3 & 0xffff), (short)(a3 >> 16)};
        qh[ks] = (bf16x8){(short)(b0 & 0xffff), (short)(b0 >> 16), (short)(b1 & 0xffff), (short)(b1 >> 16), (short)(b2 & 0xffff), (short)(b2 >> 16), (short)(b3 & 0xffff), (short)(b3 >> 16)};
    }
    const int nS = dir ? 4 - T : T + 1;
    float sc[4][4];
#pragma unroll
    for (int i = 0; i < 4; ++i) {
        if (i < nS) {
            const int S = dir ? T + i : i, srow = 16 * S + li;
            f32x4 a = (f32x4){0.f, 0.f, 0.f, 0.f};
#pragma unroll
            for (int ks = 0; ks < 2; ++ks) {
                const int k0 = ks * 32 + quad * 8;
                const float4 x0 = *(const float4*)(KK + srow * HS_ + k0), x1 = *(const float4*)(KK + srow * HS_ + k0 + 4);
                const float4 y0 = *(const float4*)(A + srow * HS_ + k0), y1 = *(const float4*)(A + srow * HS_ + k0 + 4);
                const float kv[8] = {x0.x, x0.y, x0.z, x0.w, x1.x, x1.y, x1.z, x1.w}, as[8] = {y0.x, y0.y, y0.z, y0.w, y1.x, y1.y, y1.z, y1.w};
                float c_[8];
#pragma unroll
                for (int e = 0; e < 8; ++e) c_[e] = kv[e] * __builtin_amdgcn_exp2f(Rv[ks][e] - as[e]);
                const unsigned c0 = pack2(c_[0], c_[1]), c1 = pack2(c_[2], c_[3]), c2 = pack2(c_[4], c_[5]), c3 = pack2(c_[6], c_[7]);
                const bf16x8 kf = (bf16x8){(short)(c0 & 0xffff), (short)(c0 >> 16), (short)(c1 & 0xffff), (short)(c1 >> 16), (short)(c2 & 0xffff), (short)(c2 >> 16), (short)(c3 & 0xffff), (short)(c3 >> 16)};
                a = MFMA16(kf, qt[ks], a);
            }
            const bool diag = (S == T);
#pragma unroll
            for (int j = 0; j < 4; ++j) { const int sl = quad * 4 + j; const bool keep = !diag || (dir ? (sl >= li) : (sl <= li)); sc[i][j] = keep ? a[j] : 0.f; }
        } else {
#pragma unroll
            for (int j = 0; j < 4; ++j) sc[i][j] = 0.f;
        }
    }
    f32x4 O[4];
#pragma unroll
    for (int v = 0; v < 4; ++v) O[v] = (f32x4){0.f, 0.f, 0.f, 0.f};
#pragma unroll
    for (int pr = 0; pr < 2; ++pr) {
        if (2 * pr < nS) {
            const unsigned a0 = pack2(sc[2 * pr][0], sc[2 * pr][1]), a1 = pack2(sc[2 * pr][2], sc[2 * pr][3]), b0 = pack2(sc[2 * pr + 1][0], sc[2 * pr + 1][1]), b1 = pack2(sc[2 * pr + 1][2], sc[2 * pr + 1][3]);
            const bf16x8 pf = (bf16x8){(short)(a0 & 0xffff), (short)(a0 >> 16), (short)(a1 & 0xffff), (short)(a1 >> 16), (short)(b0 & 0xffff), (short)(b0 >> 16), (short)(b1 & 0xffff), (short)(b1 >> 16)};
            const int S0 = dir ? T + 2 * pr : 2 * pr; int S1 = S0 + 1; if (S1 > 3) S1 = 3;
            const u16* p0 = Ib + (16 * S0 + quad * 4 + (li >> 2)) * KVS + 4 * (li & 3);
            const u16* p1 = Ib + (16 * S1 + quad * 4 + (li >> 2)) * KVS + 4 * (li & 3);
#pragma unroll
            for (int v = 0; v < 4; ++v) O[v] = MFMA16(tr_read2(p0 + v * 16, p1 + v * 16), pf, O[v]);
        }
    }
#pragma unroll
    for (int ks = 0; ks < 2; ++ks) {
        const u16* p0 = Sb16 + (ks * 32 + quad * 8 + (li >> 2)) * KVS + 4 * (li & 3);
#pragma unroll
        for (int v = 0; v < 4; ++v) O[v] = MFMA16(tr_read2(p0 + v * 16, p0 + 4 * KVS + v * 16), qh[ks], O[v]);
    }
    if (dir == 1) {
#pragma unroll
        for (int v = 0; v < 4; ++v)
#pragma unroll
            for (int j = 0; j < 4; ++j) comb[(T * 16 + v * 4 + j) * 64 + lane] = O[v][j];
    }
    __syncthreads();
    if (dir == 0) {
        float ss = 0.f;
#pragma unroll
        for (int v = 0; v < 4; ++v)
#pragma unroll
            for (int j = 0; j < 4; ++j) { O[v][j] += comb[(T * 16 + v * 4 + j) * 64 + lane]; ss += O[v][j] * O[v][j]; }
        ss += shx(ss, 16); ss += shx(ss, 32);
        const float rstd = rsqrtf(ss * (1.f / 64.f) + EPSN);
        const size_t row = r0 + t;
#pragma unroll
        for (int v = 0; v < 4; ++v) {
            const int col = h * 64 + v * 16 + quad * 4;
            const float4 gn = *(const float4*)(p.hgrn_g + l * 512 + col);
            const uint2 g = *(const uint2*)(PJ(row, 14, col));
            uint2 wv; wv.x = pack2(O[v][0] * rstd * gn.x * siluf_(bflo(g.x)), O[v][1] * rstd * gn.y * siluf_(bfhi(g.x))); wv.y = pack2(O[v][2] * rstd * gn.z * siluf_(bflo(g.y)), O[v][3] * rstd * gn.w * siluf_(bfhi(g.y)));
            *(uint2*)(Y3 + row * 512 + col) = wv;
        }
    }
    __syncthreads();
}
#define XB_TMO      128
#define XB_XCNT(j)  (256  + 64 * (j))
#define XB_XSUB(j)  (1280 + 64 * (j))
#define XB_XGEN(j)  (2304 + 64 * (j))
#define XB_TOP      3328
#define XB_TOPGEN   3392
#define XCD_BAR_WORDS 3456
#define XB_SPIN_CAP (1u << 18)

__device__ __forceinline__ unsigned xb_ld(unsigned* p)              { return __hip_atomic_load(p, __ATOMIC_RELAXED, __HIP_MEMORY_SCOPE_AGENT); }
__device__ __forceinline__ unsigned xb_add(unsigned* p, unsigned v) { return __hip_atomic_fetch_add(p, v, __ATOMIC_RELAXED, __HIP_MEMORY_SCOPE_AGENT); }
__device__ __forceinline__ unsigned xb_xcc_id() { return (unsigned)__builtin_amdgcn_s_getreg((3 << 11) | 20) & 0xFu; }
#define XB_SPIN(cond, bar) do { unsigned _sp = 0; while (cond) { __builtin_amdgcn_s_sleep(1); \
    if ((++_sp & 255u) == 0u) { if (xb_ld(&(bar)[XB_TMO])) break; if (_sp > XB_SPIN_CAP) { atomicAdd(&(bar)[XB_TMO], 1u); break; } } } } while (0)

struct XcdBarrier {
    unsigned* bar; unsigned x;
    volatile LAS unsigned* st;
};

__device__ __forceinline__ XcdBarrier xcd_barrier_post(unsigned* bar, volatile LAS unsigned* st) {
    XcdBarrier b; b.bar = bar; b.x = xb_xcc_id(); b.st = st;
    if (tidx() == 0) (void)xb_add(&bar[XB_XCNT(b.x)], 1u);
    return b;
}
__device__ __forceinline__ void xcd_barrier_complete(unsigned* bar, unsigned x, unsigned& nloc, unsigned& nx) {
    const unsigned G = gridDim.x * gridDim.y * gridDim.z;
    unsigned sum, cnt, mine, sp = 0u;
    for (;;) {
        sum = 0u; cnt = 0u; mine = 0u;
#pragma unroll
        for (unsigned j = 0; j < 16; ++j) { const unsigned c = xb_ld(&bar[XB_XCNT(j)]); sum += c; cnt += (c > 0u) ? 1u : 0u; mine = (j == x) ? c : mine; }
        if (sum == G) break;
        __builtin_amdgcn_s_sleep(1);
        if ((++sp & 255u) == 0u) { if (xb_ld(&bar[XB_TMO])) break; if (sp > XB_SPIN_CAP) { atomicAdd(&bar[XB_TMO], 1u); break; } }
    }
    nloc = mine > 0u ? mine : 1u; nx = cnt > 0u ? cnt : 1u;
}

__device__ __forceinline__ void xcd_barrier(const XcdBarrier& b) {
    asm volatile("s_waitcnt vmcnt(0)" ::: "memory");
    __syncthreads();
    if (tidx() == 0) {
        unsigned* bar = b.bar;
        __builtin_amdgcn_s_waitcnt(0);
        unsigned nloc = b.st[0], nx = b.st[1];
        if (nloc == 0u) { xcd_barrier_complete(bar, b.x, nloc, nx); b.st[0] = nloc; b.st[1] = nx; }
        const unsigned old = xb_add(&bar[XB_XSUB(b.x)], 1u);
        const unsigned gen = old / nloc;
        if (old + 1u == (gen + 1u) * nloc) {
            __builtin_amdgcn_fence(__ATOMIC_RELEASE, "agent");
            asm volatile("s_waitcnt vmcnt(0)" ::: "memory");
            const unsigned og = xb_add(&bar[XB_TOP], 1u);
            const unsigned tg = og / nx;
            if (og + 1u == (tg + 1u) * nx) xb_add(&bar[XB_TOPGEN], 1u);
            else XB_SPIN(xb_ld(&bar[XB_TOPGEN]) == tg, bar);
            __builtin_amdgcn_fence(__ATOMIC_ACQUIRE, "agent");
            xb_add(&bar[XB_XGEN(b.x)], 1u);
            asm volatile("s_waitcnt vmcnt(0)" ::: "memory");
        } else {
            XB_SPIN(xb_ld(&bar[XB_XGEN(b.x)]) == gen, bar);
            __builtin_amdgcn_fence(__ATOMIC_ACQUIRE, "agent");
            asm volatile("s_waitcnt vmcnt(0)" ::: "memory");
        }
    }
    __syncthreads();
}

#ifndef STAG_B
#define STAG_B 240
#endif
#ifndef STAG_D
#define STAG_D 300
#endif
#ifndef REP_ATTN
#define REP_ATTN 1
#endif
#ifndef REP_B
#define REP_B 1
#endif
#ifndef REP_C1
#define REP_C1 1
#endif
#ifndef REP_C2
#define REP_C2 1
#endif
#ifndef REP_C3
#define REP_C3 1
#endif
#ifndef REP_DE
#define REP_DE 1
#endif
__device__ __forceinline__ void stagger(int ticks_per_slot) {
    const int slot = ((int)blockIdx.x >> 3) & 7;
    if (slot) { const unsigned long long t0 = __builtin_amdgcn_s_memrealtime(), dt = (unsigned long long)(slot * ticks_per_slot);
        while (__builtin_amdgcn_s_memrealtime() - t0 < dt) __builtin_amdgcn_s_sleep(4); }
}
template <class Epi> __device__ __forceinline__ void run_gemm(LAS unsigned char* lds, const u16* A, const u16* Bt, int M, int N, int K, const Epi& E) {
    pg8::Gemm g; g.A = A; g.Bt = Bt; g.M = M; g.N = N; g.K = K; g.rsA = 0; g.rsB = 0;
    pg8::StaticOrder S; S.init(M, N, (int)gridDim.x, (int)blockIdx.x);
    pg8::gemm_phase<Epi, pg8::StaticOrder, false>(lds, g, S, E, nullptr);
}


struct EpiNull {
    static constexpr bool PERM = true, AFTER_DRAIN = false;
    unsigned char* ws;
    __device__ __forceinline__ void operator()(const f32x4 (&acc)[2][2][4][2], const Unit& u, int wr, int wc, int fr, int fq) const {
        if (ws == nullptr) {
#pragma unroll
            for (int ai = 0; ai < 2; ++ai)
#pragma unroll
                for (int bj = 0; bj < 2; ++bj)
#pragma unroll
                    for (int m = 0; m < 4; ++m)
#pragma unroll
                        for (int n = 0; n < 2; ++n) *(f32x4*)(ws + (size_t)(((ai * 2 + bj) * 4 + m) * 2 + n) * 16 + fr * 1024 + fq * 65536 + wr * 4096 + wc * 16384 + u.pm) = acc[ai][bj][m][n];
        }
    }
};
struct MergeOrder : pg8::StaticOrder {
    __device__ bool next(int i, Unit& u) const { if (!pg8::StaticOrder::next(i >> 2, u)) return false; u.r = i & 3; return true; }
};
__device__ __forceinline__ Params KP() {
    auto q0 = __builtin_amdgcn_kernarg_segment_ptr();
    asm volatile("" : "+s"(q0));
    const __attribute__((address_space(4))) Params* q = (const __attribute__((address_space(4))) Params*)q0;
    Params r;
    r.x = q->x; r.c = q->c; r.ctx = q->ctx; r.c_ctx = q->c_ctx; r.w_ada = q->w_ada; r.b_ada = q->b_ada; r.g_pre = q->g_pre; r.g_post = q->g_post; r.w_in = q->w_in; r.rpb = q->rpb;
    r.fnet_w = q->fnet_w; r.gmlp_g = q->gmlp_g; r.gmlp_ws = q->gmlp_ws; r.gmlp_bs = q->gmlp_bs; r.lb_logits = q->lb_logits; r.hgrn_g = q->hgrn_g; r.w_branch = q->w_branch; r.w_out = q->w_out;
    r.out = q->out; r.ws = q->ws; return r;
}
constexpr size_t OFF_BAR = WS_END;
constexpr size_t WS_END2 = WS_END + (size_t)XCD_BAR_WORDS * 4;
__device__ __forceinline__ void gsync(LAS unsigned char* lds3) {
    XcdBarrier b; b.bar = (unsigned*)(opaque(KP().ws) + OFF_BAR); b.x = xb_xcc_id(); b.st = (volatile LAS unsigned*)(lds3 + LDS_BYTES);
    xcd_barrier(b);
}
__global__ void __launch_bounds__(512, 2) mega_fwd(Params p_unused) {
    extern __shared__ __attribute__((aligned(16))) unsigned char shm[];
    LAS unsigned char* lds3 = (LAS unsigned char*)shm;
    {
        if (tidx() < 4) ((volatile LAS unsigned*)(lds3 + LDS_BYTES))[tidx()] = 0u;
        if (blockIdx.x == 0) { unsigned* bar = (unsigned*)(opaque(KP().ws) + OFF_BAR); for (int i = tidx(); i < XCD_BAR_WORDS; i += 512) bar[i] = 0u; }
        __syncthreads();
    }
    prep1(KP(), shm);
    cg::this_grid().sync();
    { XcdBarrier b0 = xcd_barrier_post((unsigned*)(opaque(KP().ws) + OFF_BAR), (volatile LAS unsigned*)(lds3 + LDS_BYTES)); (void)b0; }
    prep2(KP(), shm);
    gsync(lds3);
#pragma nounroll
    for (int pass = 0; pass < 1 + NBATCH / GB; ++pass) {
        PassInfo ps;
        if (pass == 0) { ps.is_ctx = 1; ps.nb = NBATCH; ps.T = CTXL; ps.M = MCTX; ps.b0 = 0; }
        else { ps.is_ctx = 0; ps.nb = GB; ps.T = SEQ; ps.M = MLAT; ps.b0 = (pass - 1) * GB; }
        const int NC = ps.T >> 6;
#pragma nounroll
        for (int l = 0; l < DEPTH; ++l) {
            phase_norm(KP(), ps, l);
            gsync(lds3);
            _Pragma("nounroll") for (int rep = 0; rep < REP_B; ++rep) {
                unsigned char* ws = opaque(KP().ws);
                EpiProj E; E.ws = ws; E.l = l; E.is_ctx = ps.is_ctx;

                run_gemm(lds3, (const u16*)(ws + OFF_H), (const u16*)(ws + OFF_WTIN) + (size_t)l * NPROJ * DM, ps.M, NPROJ, DM, E);
                gsync(lds3);
#ifdef PROBE_NULL_B
                { EpiNull EN; EN.ws = ws; run_gemm(lds3, (const u16*)(ws + OFF_H), (const u16*)(ws + OFF_WTIN) + (size_t)l * NPROJ * DM, ps.M, NPROJ, DM, EN); gsync(lds3); }
#endif
            }
            const bool full = !(ps.is_ctx && l == DEPTH - 1);
            _Pragma("nounroll") for (int rep = 0; rep < REP_C1; ++rep) {
                const int n_h1 = ps.nb * 16 * NC, n_at = full ? ps.nb * 8 * (ps.T >> 6) : 0, n_f1 = ps.is_ctx ? 0 : ps.nb * 64;
                for (int it = blockIdx.x; it < n_h1 + n_at + n_f1; it += gridDim.x) {
                    if (it < n_h1) hgrn1_item(KP(), ps, it, shm);
                    else if (it < n_h1 + n_at) { _Pragma("nounroll") for (int r2 = 0; r2 < REP_ATTN; ++r2) attn_item(KP(), ps, l, it - n_h1, shm); }
                    else four1_item(KP(), it - n_h1 - n_at, shm);
                }
                gsync(lds3);
            }
            _Pragma("nounroll") for (int rep = 0; rep < REP_C2; ++rep) {
                hgrn2_all(KP(), ps, l);
                if (full) {
                    const int n_f2 = ps.is_ctx ? ps.nb * 4 : ps.nb * 64, n_g = ps.M >> 7;
                    for (int it = blockIdx.x; it < n_f2 + n_g; it += gridDim.x) {
                        if (it < n_f2) { if (ps.is_ctx) fourc_item(KP(), it, shm); else four2_item(KP(), it, shm); }
                        else gmlp_item(KP(), l, it - n_f2, shm);
                    }
                }
                gsync(lds3);
            }
            if (!full) continue;
            _Pragma("nounroll") for (int rep = 0; rep < REP_C3; ++rep) {
                const int n_h3 = ps.nb * 8 * NC;
                for (int it = blockIdx.x; it < n_h3; it += gridDim.x) hgrn3_item(KP(), ps, l, it, shm);
                gsync(lds3);
            }
            _Pragma("nounroll") for (int rep = 0; rep < REP_DE; ++rep) {
            {
                unsigned char* ws = opaque(KP().ws);
                pg8::Gemm g; g.A = (const u16*)(ws + OFF_Y); g.Bt = (const u16*)(ws + OFF_WTBR) + (size_t)l * 4 * 1024 * 512; g.M = ps.M; g.N = 1024; g.K = 512;
                g.rsA = (size_t)MLAT * 512 * 2; g.rsB = (size_t)1024 * 512 * 2;
                MergeOrder S; S.init(ps.M, 1024, (int)gridDim.x, (int)blockIdx.x);
                EpiMerge E; E.ws = ws;

                pg8::gemm_phase<EpiMerge, MergeOrder, false>(lds3, g, S, E, nullptr);
            }
            gsync(lds3);
            if (REP_DE > 1 && rep + 1 < REP_DE) continue;
            {
                unsigned char* ws = opaque(KP().ws);
                EpiOut E; E.C = (u16*)(ws + OFF_OUT);
                run_gemm(lds3, (const u16*)(ws + OFF_MB), (const u16*)(ws + OFF_WTOUT) + (size_t)l * 1024 * 1024, ps.M, 1024, 1024, E);
            }
            gsync(lds3);
            }
        }
        if (!ps.is_ctx) phase_norm(KP(), ps, DEPTH);
    }
}

static_assert(WS_END2 <= (size_t)1073741824, "workspace map exceeds 1 GiB");

extern "C" void kernel_launch(void* const* d_in, const int* in_sizes, int n_in, void* d_out, int out_size, void* d_ws, size_t ws_size, hipStream_t stream) {
    static int grid_blocks = 0;
    if (grid_blocks == 0) {
        if (n_in != 18 || ws_size < WS_END2) { fprintf(stderr, "kernel_launch: unexpected n_in %d or ws_size %zu (need %zu)\n", n_in, ws_size, (size_t)WS_END2); grid_blocks = -1; return; }
        int dev = 0, cus = 0, per_cu = 0;
        hipGetDevice(&dev);
        hipDeviceGetAttribute(&cus, hipDeviceAttributeMultiprocessorCount, dev);
        if (hipFuncSetAttribute((const void*)mega_fwd, hipFuncAttributeMaxDynamicSharedMemorySize, LDS_BYTES + 16) != hipSuccess) { fprintf(stderr, "kernel_launch: hipFuncSetAttribute failed\n"); grid_blocks = -1; return; }
        hipOccupancyMaxActiveBlocksPerMultiprocessor(&per_cu, (const void*)mega_fwd, 512, LDS_BYTES + 16);
        if (per_cu < 1) { fprintf(stderr, "kernel_launch: occupancy query gave %d\n", per_cu); per_cu = 1; }
        (void)hipGetLastError();
        grid_blocks = cus * per_cu;
    }
    if (grid_blocks < 0) return;
    Params p{};
    const float** pp = (const float**)&p;
    for (int i = 0; i < 18; ++i) pp[i] = (const float*)d_in[i];
    p.out = (float*)d_out; p.ws = (unsigned char*)d_ws;
    void* args[] = {&p};
    hipError_t e = hipLaunchCooperativeKernel((const void*)mega_fwd, dim3(grid_blocks), dim3(512), args, LDS_BYTES + 16, stream);
    if (e != hipSuccess) fprintf(stderr, "cooperative launch failed: %s (grid %d)\n", hipGetErrorString(e), grid_blocks);
}
```

```cpp
#include <hip/hip_runtime.h>
#include <hip/hip_cooperative_groups.h>
#include <cstdio>
namespace cg = cooperative_groups;
__device__ __forceinline__ int tidx() { int t = threadIdx.x; asm volatile("" : "+v"(t)); return t; }
template <class T> __device__ __forceinline__ T* opaque(T* p) {
    unsigned long long v = (unsigned long long)p; const unsigned lo = __builtin_amdgcn_readfirstlane((unsigned)v), hi = __builtin_amdgcn_readfirstlane((unsigned)(v >> 32));
    v = ((unsigned long long)hi << 32) | lo; asm volatile("" : "+s"(v)); return (T*)((__attribute__((address_space(1))) T*)v); }
__device__ __forceinline__ float shx(float v, int m) { const int lane = tidx() & 63; return __int_as_float(__builtin_amdgcn_ds_bpermute((lane ^ m) << 2, __float_as_int(v))); }
namespace pg8 {
#define PG8_LAS __attribute__((address_space(3)))
typedef unsigned short bf16_t;
typedef short bf16x8 __attribute__((ext_vector_type(8)));
typedef float f32x4 __attribute__((ext_vector_type(4)));
typedef unsigned u32x4 __attribute__((ext_vector_type(4)));
constexpr int BM = 256, BK = 64, HALF = 128, HTB = HALF * BK * 2  , STAGE_BYTES = 8 * HTB, NXCD = 8, WGM = 8;

__host__ __device__ __forceinline__ int lds_byte(int r, int c) { const int st = (r >> 4) * 2 + (c >> 5), rr = r & 15, cc = c & 31, ob = rr * 64 + cc * 2; return st * 1024 + (ob ^ (((ob >> 9) & 1) << 5)); }
__host__ __device__ __forceinline__ void stage_rc(int b, int& R, int& C) { const int st = b / 1024, sb = b % 1024, swz = sb ^ (((sb >> 9) & 1) << 5); R = (st >> 1) * 16 + swz / 64; C = (st & 1) * 32 + (swz % 64) / 2; }
__host__ __device__ __forceinline__ int perm32(int rho) { const int n = rho >> 4, i = rho & 15; return 8 * (i >> 2) + 4 * n + (i & 3); }

struct Unit { int pm, pn, r; };
struct Gemm { const bf16_t* A; const bf16_t* Bt; int M, N, K; size_t rsA, rsB; };

struct StaticOrder {
    int nM, nN, nwg, G, c;
    __host__ __device__ void init(int M, int N, int G_, int c_) { nM = M / BM; nN = N / BM; nwg = nM * nN; G = G_; c = c_; }
    __host__ __device__ bool next(int i, Unit& u) const {
        const long L = (long)i * G + c; if (L >= nwg) return false;
        int wgid = (int)L; { const int q = nwg / NXCD, r = nwg % NXCD, xcd = wgid % NXCD, off = wgid / NXCD; wgid = (xcd < r ? xcd * (q + 1) : r * (q + 1) + (xcd - r) * q) + off; }
        const int nig = WGM * nN, gid = wgid / nig, fm = gid * WGM, gsz = (nM - fm) < WGM ? (nM - fm) : WGM;
        u.pm = fm + ((wgid % nig) % gsz); u.pn = (wgid % nig) / gsz; u.r = 0; return true;
    }
    __device__ __forceinline__ void a_ready(const Unit&) const {}
    __device__ __forceinline__ void done(const Unit&) const {}
};
__device__ __forceinline__ unsigned cvt_pk_bf16(float lo, float hi) { unsigned r; asm volatile("v_cvt_pk_bf16_f32 %0, %1, %2" : "=v"(r) : "v"(lo), "v"(hi)); return r; }

template <class Epi, class Sched, bool STAMP = false>
__device__ __forceinline__ void gemm_phase(PG8_LAS unsigned char* lds, const Gemm g, const Sched& S, const Epi& E, unsigned long long* stamps) {
    const int tid = tidx(), wid = __builtin_amdgcn_readfirstlane(tid >> 6), lane = tid & 63, wr = wid >> 2, wc = wid & 3, fr = lane & 15, fq = lane >> 4;
    const int K = g.K, nt = K / BK;
    int ts_lo = 0, ts_hi = 0, nts = 0; const unsigned long long rt_entry = STAMP ? (unsigned long long)wall_clock64() : 0ull;
#define PG8_STAMP() do { if (STAMP && wid == 0 && nts < 64) { const unsigned long long _c = (unsigned long long)clock64(); \
        ts_lo = (lane == nts) ? (int)(unsigned)_c : ts_lo; ts_hi = (lane == nts) ? (int)(unsigned)(_c >> 32) : ts_hi; ++nts; } } while (0)
    PG8_STAMP();
    unsigned voffA[2], voffB[2];
#pragma unroll
    for (int i = 0; i < 2; ++i) { int R, C; stage_rc(tid * 16 + i * 8192, R, C); const int Rb = Epi::PERM ? ((R & ~31) + perm32(R & 31)) : R;
        voffA[i] = (unsigned)(R * K + C) * 2u; voffB[i] = (unsigned)(Rb * K + C) * 2u; }
    const size_t kstep = (size_t)(BK * 2);
    const size_t hstep = (size_t)HALF * K * 2;
    const size_t tstep = 2 * hstep;
    const unsigned ldsw = (unsigned)wid * 1024u;
    const int aoff = lds_byte(wr * 64 + fr, fq * 8), boff = lds_byte(wc * 32 + fr, fq * 8);
#define PG8_SA(b, h) (((b) * 2 + (h)) * HTB)
#define PG8_SB(b, h) ((4 + (b) * 2 + (h)) * HTB)
#define PG8_STAGE(bufoff, gbase, voff) do { _Pragma("unroll") for (int _i = 0; _i < 2; ++_i) \
        __builtin_amdgcn_global_load_lds((const unsigned*)((const char*)(gbase) + (voff)[_i]), (PG8_LAS unsigned*)(lds + (bufoff) + ldsw + _i * 8192), 16, 0, 0); } while (0)
#define PG8_LDA(dst, b, h) do { _Pragma("unroll") for (int m = 0; m < 4; ++m) _Pragma("unroll") for (int k = 0; k < 2; ++k) dst[m][k] = *(const PG8_LAS bf16x8*)(lds + PG8_SA(b, h) + aoff + m * 2048 + k * 1024); } while (0)
#define PG8_LDB(dst, b, h) do { _Pragma("unroll") for (int n = 0; n < 2; ++n) _Pragma("unroll") for (int k = 0; k < 2; ++k) dst[n][k] = *(const PG8_LAS bf16x8*)(lds + PG8_SB(b, h) + boff + n * 2048 + k * 1024); } while (0)
#define PG8_MMA(ai, bj, At, Bt) do { __builtin_amdgcn_s_setprio(1); _Pragma("unroll") for (int m = 0; m < 4; ++m) _Pragma("unroll") for (int n = 0; n < 2; ++n) _Pragma("unroll") for (int k = 0; k < 2; ++k) \
        acc[ai][bj][m][n] = __builtin_amdgcn_mfma_f32_16x16x32_bf16(Bt[n][k], At[m][k], acc[ai][bj][m][n], 0, 0, 0); __builtin_amdgcn_s_setprio(0); } while (0)
#define PG8_WAIT_V(n) asm volatile("s_waitcnt vmcnt(" #n ")" ::: "memory")
#define PG8_WAIT_L(n) asm volatile("s_waitcnt lgkmcnt(" #n ")" ::: "memory")
#define PG8_BAR __builtin_amdgcn_s_barrier()
#define PG8_SCHED __builtin_amdgcn_sched_barrier(0)
    Unit cur, nxt; int ui = 0;
    if (!S.next(0, cur)) return;
    f32x4 acc[2][2][4][2];
#pragma unroll
    for (int a = 0; a < 2; ++a)
#pragma unroll
        for (int b = 0; b < 2; ++b)
#pragma unroll
            for (int m = 0; m < 4; ++m)
#pragma unroll
                for (int n = 0; n < 2; ++n) acc[a][b][m][n] = (f32x4){0.f, 0.f, 0.f, 0.f};
    bf16x8 At[4][2], B0[2][2], B1[2][2];
    const char* cA = (const char*)g.A + (size_t)cur.pm * tstep + (size_t)cur.r * g.rsA; const char* cB = (const char*)g.Bt + (size_t)cur.pn * tstep + (size_t)cur.r * g.rsB;
    S.a_ready(cur);
    PG8_STAGE(PG8_SB(0, 0), cB, voffB); PG8_STAGE(PG8_SA(0, 0), cA, voffA); PG8_STAGE(PG8_SB(0, 1), cB + hstep, voffB); PG8_STAGE(PG8_SA(0, 1), cA + hstep, voffA);
    if (wr == 1) PG8_BAR;
    PG8_WAIT_V(4); PG8_BAR;
    PG8_STAGE(PG8_SB(1, 0), cB + kstep, voffB); PG8_STAGE(PG8_SA(1, 0), cA + kstep, voffA); PG8_STAGE(PG8_SB(1, 1), cB + hstep + kstep, voffB);
    PG8_WAIT_V(6); PG8_BAR;
    PG8_STAMP();
    for (;;) {
        const bool has_next = S.next(ui + 1, nxt);
        const char* nA = has_next ? (const char*)g.A + (size_t)nxt.pm * tstep + (size_t)nxt.r * g.rsA : cA; const char* nB = has_next ? (const char*)g.Bt + (size_t)nxt.pn * tstep + (size_t)nxt.r * g.rsB : cB;
        for (int t = 0; t < nt; t += 2) {
            const bool last = (t == nt - 2);
            const char* a1 = cA + (size_t)(t + 1) * kstep;
            const char* a2 = last ? nA : cA + (size_t)(t + 2) * kstep; const char* b2 = last ? nB : cB + (size_t)(t + 2) * kstep;
            const char* a3 = a2 + kstep; const char* b3 = b2 + kstep;
            if (last && has_next) S.a_ready(nxt);
            PG8_LDB(B0, 0, 0); PG8_SCHED; PG8_LDA(At, 0, 0); PG8_STAGE(PG8_SA(1, 1), a1 + hstep, voffA);
            PG8_WAIT_L(8); PG8_BAR; PG8_WAIT_L(0); PG8_MMA(0, 0, At, B0); PG8_BAR; PG8_SCHED;
            PG8_LDB(B1, 0, 1); PG8_STAGE(PG8_SB(0, 0), b2, voffB);
            PG8_BAR; PG8_WAIT_L(0); PG8_MMA(0, 1, At, B1); PG8_BAR;
            PG8_LDA(At, 0, 1); PG8_STAGE(PG8_SA(0, 0), a2, voffA);
            PG8_BAR; PG8_WAIT_L(0); PG8_MMA(1, 0, At, B0); PG8_BAR; PG8_SCHED;
            PG8_STAGE(PG8_SB(0, 1), b2 + hstep, voffB);
            PG8_WAIT_V(6); PG8_BAR; PG8_MMA(1, 1, At, B1); PG8_BAR;
            PG8_LDB(B0, 1, 0); PG8_SCHED; PG8_LDA(At, 1, 0); PG8_STAGE(PG8_SA(0, 1), a2 + hstep, voffA);
            PG8_WAIT_L(8); PG8_BAR; PG8_WAIT_L(0); PG8_MMA(0, 0, At, B0); PG8_BAR; PG8_SCHED;
            PG8_LDB(B1, 1, 1); PG8_STAGE(PG8_SB(1, 0), b3, voffB);
            PG8_BAR; PG8_WAIT_L(0); PG8_MMA(0, 1, At, B1); PG8_BAR;
            PG8_LDA(At, 1, 1); PG8_STAGE(PG8_SA(1, 0), a3, voffA);
            PG8_BAR; PG8_WAIT_L(0); PG8_MMA(1, 0, At, B0); PG8_BAR; PG8_SCHED;
            PG8_STAGE(PG8_SB(1, 1), b3 + hstep, voffB);
            PG8_WAIT_V(6); PG8_BAR; PG8_MMA(1, 1, At, B1); PG8_BAR;
        }
        PG8_STAMP();
        if constexpr (!Epi::AFTER_DRAIN) { E(acc, cur, wr, wc, fr, fq); S.done(cur); }
        PG8_STAMP();
        if (!has_next) break;
#pragma unroll
        for (int a = 0; a < 2; ++a)
#pragma unroll
            for (int b = 0; b < 2; ++b)
#pragma unroll
                for (int m = 0; m < 4; ++m)
#pragma unroll
                    for (int n = 0; n < 2; ++n) acc[a][b][m][n] = (f32x4){0.f, 0.f, 0.f, 0.f};
        cur = nxt; cA = nA; cB = nB; ++ui;
    }
    PG8_WAIT_V(0);
    if (wr == 0) PG8_BAR;
    PG8_BAR;
    if constexpr (Epi::AFTER_DRAIN) { E.fused(acc, cur, wr, wc, fr, fq, lds, wid, lane); S.done(cur); }
    PG8_STAMP();
    if (STAMP && wid == 0) { stamps[lane] = lane < nts ? (((unsigned long long)(unsigned)ts_hi << 32) | (unsigned)ts_lo) : 0ull;
        if (lane == 62) stamps[62] = rt_entry; if (lane == 63) stamps[63] = (unsigned long long)wall_clock64(); }
#undef PG8_STAMP
#undef PG8_SA
#undef PG8_SB
#undef PG8_STAGE
#undef PG8_LDA
#undef PG8_LDB
#undef PG8_MMA
#undef PG8_WAIT_V
#undef PG8_WAIT_L
#undef PG8_BAR
#undef PG8_SCHED
}
}

typedef unsigned short u16;
typedef short s16x4 __attribute__((ext_vector_type(4)));
using pg8::bf16x8; using pg8::f32x4; using pg8::Unit;
#define LAS __attribute__((address_space(3)))
#define MFMA16(a, b, c) __builtin_amdgcn_mfma_f32_16x16x32_bf16(a, b, c, 0, 0, 0)

constexpr int DM = 1024, NBATCH = 16, SEQ = 4096, DEPTH = 4, CTXL = 256, NPROJ = 11776, NIN = 11264;
constexpr int GB = 4, MLAT = GB * SEQ, MCTX = NBATCH * CTXL;
constexpr int LDS_BYTES = 152 * 1024;
constexpr float LOG2E = 1.4426950408889634f;
constexpr float EPSN = 1e-6f;

constexpr size_t al256(size_t x) { return (x + 255) & ~(size_t)255; }
constexpr size_t OFF_WTIN = 0;
constexpr size_t OFF_WTBR = OFF_WTIN + (size_t)DEPTH * NPROJ * DM * 2;
constexpr size_t OFF_WTOUT = OFF_WTBR + (size_t)DEPTH * 4 * 1024 * 512 * 2;
constexpr size_t OFF_WS16 = OFF_WTOUT + (size_t)DEPTH * 1024 * 1024 * 2;
constexpr size_t OFF_MOD = OFF_WS16 + (size_t)DEPTH * 8 * 128 * 128 * 2;
constexpr size_t OFF_LB = OFF_MOD + al256((size_t)DEPTH * 17 * 3072 * 4);
constexpr size_t OFF_ROPE = OFF_LB + (size_t)DEPTH * 2 * 512 * 4;
constexpr size_t OFF_TW = OFF_ROPE + 2 * 64 * 16 * 4;
constexpr size_t OFF_M1 = OFF_TW + 4096 * 8;
constexpr size_t OFF_M2 = OFF_M1 + 128 * 128 * 2;
constexpr size_t OFF_M3 = OFF_M2 + 64 * 128 * 2;
constexpr size_t OFF_CSW = OFF_M3 + 256 * 512 * 2;
constexpr size_t OFF_CTXW = OFF_CSW + (size_t)DEPTH * 4 * 2 * 128 * 128 * 4;
constexpr size_t OFF_CTXKV = OFF_CTXW + (size_t)NBATCH * CTXL * DM * 4;
constexpr size_t OFF_CTXST = OFF_CTXKV + (size_t)DEPTH * MCTX * 1024 * 2;
constexpr size_t OFF_H = OFF_CTXST + (size_t)DEPTH * 256 * 4096 * 4;
constexpr size_t OFF_PROJ = OFF_H + (size_t)MLAT * DM * 2;
constexpr size_t OFF_QROT = OFF_PROJ + (size_t)MLAT * NPROJ * 2;
constexpr size_t OFF_LOGF = OFF_QROT + (size_t)MLAT * 512 * 2;
constexpr size_t OFF_Y = OFF_LOGF + (size_t)MLAT * 1024 * 4;
constexpr size_t OFF_FY = OFF_Y + (size_t)4 * MLAT * 512 * 2;
constexpr size_t OFF_HL = OFF_FY + (size_t)GB * 4096 * 1024 * 2;
constexpr size_t OFF_HD = OFF_HL + (size_t)4096 * 4096 * 4;
constexpr size_t OFF_HS = OFF_HD + (size_t)4096 * 64 * 4;
constexpr size_t OFF_MB = OFF_HS + (size_t)4096 * 4096 * 4;
constexpr size_t WS_END = OFF_MB + (size_t)MLAT * DM * 2;
constexpr size_t OFF_MERGED = OFF_LOGF;
constexpr size_t OFF_OUT = OFF_PROJ;

struct Params {
    const float *x, *c, *ctx, *c_ctx, *w_ada, *b_ada, *g_pre, *g_post, *w_in, *rpb, *fnet_w, *gmlp_g, *gmlp_ws, *gmlp_bs, *lb_logits, *hgrn_g, *w_branch, *w_out;
    float* out; unsigned char* ws;
};
struct PassInfo { int is_ctx, nb, T, M, b0; };

__device__ __forceinline__ u16 f2bf(float f) { unsigned u = __float_as_uint(f); u += 0x7FFFu + ((u >> 16) & 1u); return (u16)(u >> 16); }
__device__ __forceinline__ float bf2f(u16 b) { return __uint_as_float(((unsigned)b) << 16); }
typedef __bf16 bf16x2_t_ __attribute__((ext_vector_type(2)));
typedef float f32x2_t_ __attribute__((ext_vector_type(2)));
__device__ __forceinline__ unsigned pack2(float a, float b) { f32x2_t_ v = {a, b}; bf16x2_t_ r = __builtin_convertvector(v, bf16x2_t_); return __builtin_bit_cast(unsigned, r); }
__device__ __forceinline__ float bflo(unsigned w) { return __uint_as_float(w << 16); }
__device__ __forceinline__ float bfhi(unsigned w) { return __uint_as_float(w & 0xFFFF0000u); }
__device__ __forceinline__ float sigmoidf_(float v) { return __builtin_amdgcn_rcpf(1.f + __builtin_amdgcn_exp2f(-LOG2E * v)); }
__device__ __forceinline__ float siluf_(float v) { return v * __builtin_amdgcn_rcpf(1.f + __builtin_amdgcn_exp2f(-LOG2E * v)); }
__device__ __forceinline__ void unpack8(uint4 w, float* f) { f[0] = bflo(w.x); f[1] = bfhi(w.x); f[2] = bflo(w.y); f[3] = bfhi(w.y); f[4] = bflo(w.z); f[5] = bfhi(w.z); f[6] = bflo(w.w); f[7] = bfhi(w.w); }
__device__ __forceinline__ bf16x8 tr_read2(const u16* p0, const u16* p1) {
    s16x4 a = __builtin_amdgcn_ds_read_tr16_b64_v4i16((LAS s16x4*)p0);
    s16x4 b = __builtin_amdgcn_ds_read_tr16_b64_v4i16((LAS s16x4*)p1);
    return (bf16x8){a[0], a[1], a[2], a[3], b[0], b[1], b[2], b[3]};
}
__device__ __forceinline__ bf16x8 ld_frag_g(const u16* p) { return *(const bf16x8*)p; }

typedef unsigned u32x4_ __attribute__((ext_vector_type(4)));
__device__ __forceinline__ void nt_store16(uint4 w, void* p) { __builtin_nontemporal_store((u32x4_){w.x, w.y, w.z, w.w}, (u32x4_*)p); }
struct EpiProj {
    static constexpr bool PERM = true, AFTER_DRAIN = false;
    unsigned char* ws; int l; int is_ctx;
    __device__ __forceinline__ void operator()(const f32x4 (&acc)[2][2][4][2], const Unit& u, int wr, int wc, int fr, int fq) const {
        u16* proj = (u16*)(ws + OFF_PROJ);
        const int blk = u.pn >> 1;
        const int row0 = u.pm * 256 + wr * 64 + fr, col0 = u.pn * 256 + wc * 32 + 8 * fq;
        u16* pbase = proj + ((size_t)blk * MLAT + row0) * 512 + (col0 & 511);
        if ((blk == 0 || blk == 1) && !is_ctx) {
            u16* qrot = (u16*)(ws + OFF_QROT); const float* rope = (const float*)(ws + OFF_ROPE);
            const int f0 = 8 * (fq & 1); const float sgn = (fq >> 1) ? 1.f : -1.f;
#pragma unroll
            for (int ai = 0; ai < 2; ++ai)
#pragma unroll
                for (int m = 0; m < 4; ++m) {
                    const int row = row0 + ai * 128 + m * 16;
                    const int t = row & 4095, pos = (wc & 1) ? (t & 63) : (t >> 6);
                    const float4 c0 = *(const float4*)(rope + pos * 16 + f0), c1 = *(const float4*)(rope + pos * 16 + f0 + 4);
                    const float4 s0 = *(const float4*)(rope + 1024 + pos * 16 + f0), s1 = *(const float4*)(rope + 1024 + pos * 16 + f0 + 4);
                    const float cs[8] = {c0.x, c0.y, c0.z, c0.w, c1.x, c1.y, c1.z, c1.w}, sn[8] = {s0.x, s0.y, s0.z, s0.w, s1.x, s1.y, s1.z, s1.w};
#pragma unroll
                    for (int bj = 0; bj < 2; ++bj) {
                        const f32x4 v0 = acc[ai][bj][m][0], v1 = acc[ai][bj][m][1];
                        const float o[8] = {v0[0], v0[1], v0[2], v0[3], v1[0], v1[1], v1[2], v1[3]};
                        float r[8];
#pragma unroll
                        for (int e = 0; e < 8; ++e) { const float pr = shx(o[e], 32); r[e] = o[e] * cs[e] + sgn * pr * sn[e]; }
                        uint4 wr_; wr_.x = pack2(r[0], r[1]); wr_.y = pack2(r[2], r[3]); wr_.z = pack2(r[4], r[5]); wr_.w = pack2(r[6], r[7]);
                        u16* dst = pbase + (size_t)(ai * 128 + m * 16) * 512 + bj * 128;
                        if (blk == 0) {
                            uint4 wp; wp.x = pack2(o[0], o[1]); wp.y = pack2(o[2], o[3]); wp.z = pack2(o[4], o[5]); wp.w = pack2(o[6], o[7]);
                            nt_store16(wp, dst);
                            nt_store16(wr_, qrot + (size_t)row * 512 + (col0 & 511) + bj * 128);
                        } else nt_store16(wr_, dst);
                    }
                }
        } else if (blk == 11 || blk == 12) {
            float* logf = (float*)(ws + OFF_LOGF); const float* lb = (const float*)(ws + OFF_LB) + l * 1024;
            const int dir = blk - 11;
#pragma unroll
            for (int bj = 0; bj < 2; ++bj) {
                const int cc = (col0 & 511) + bj * 128;
                const float4 l0 = *(const float4*)(lb + dir * 512 + cc), l1 = *(const float4*)(lb + dir * 512 + cc + 4);
                const float lbv[8] = {l0.x, l0.y, l0.z, l0.w, l1.x, l1.y, l1.z, l1.w};
#pragma unroll
                for (int ai = 0; ai < 2; ++ai)
#pragma unroll
                    for (int m = 0; m < 4; ++m) {
                        const int row = row0 + ai * 128 + m * 16;
                        const f32x4 v0 = acc[ai][bj][m][0], v1 = acc[ai][bj][m][1];
                        const float z[8] = {v0[0], v0[1], v0[2], v0[3], v1[0], v1[1], v1[2], v1[3]};
                        float lf[8], o[8];
#pragma unroll
                        for (int e = 0; e < 8; ++e) {
                            const float ez = __expf(-z[e]);
                            const float inv = __builtin_amdgcn_rcpf(1.f + ez);
                            const float sg = inv, sgn_ = (ez > 1e30f) ? 1.f : ez * inv;
                            const float f = lbv[e] + (1.f - lbv[e]) * sg;
                            lf[e] = __logf(fmaxf(f, 1e-30f));
                            o[e] = (1.f - lbv[e]) * sgn_;
                        }
                        float* lp = logf + (size_t)row * 1024 + dir * 512 + cc;
                        __builtin_nontemporal_store((f32x4){lf[0], lf[1], lf[2], lf[3]}, (f32x4*)lp); __builtin_nontemporal_store((f32x4){lf[4], lf[5], lf[6], lf[7]}, (f32x4*)(lp + 4));
                        uint4 w; w.x = pack2(o[0], o[1]); w.y = pack2(o[2], o[3]); w.z = pack2(o[4], o[5]); w.w = pack2(o[6], o[7]);
                        nt_store16(w, pbase + (size_t)(ai * 128 + m * 16) * 512 + bj * 128);
                    }
            }
        } else {
            const bool copy = is_ctx && (blk == 1 || blk == 2);
            u16* cbase = (u16*)(ws + OFF_CTXKV) + (size_t)l * MCTX * 1024 + (size_t)row0 * 1024 + (blk - 1) * 512 + (col0 & 511);
            if (!copy) {
#pragma unroll
                for (int ai = 0; ai < 2; ++ai)
#pragma unroll
                    for (int m = 0; m < 4; ++m)
#pragma unroll
                        for (int bj = 0; bj < 2; ++bj) {
                            const f32x4 v0 = acc[ai][bj][m][0], v1 = acc[ai][bj][m][1];
                            uint4 w; w.x = pack2(v0[0], v0[1]); w.y = pack2(v0[2], v0[3]); w.z = pack2(v1[0], v1[1]); w.w = pack2(v1[2], v1[3]);
                            nt_store16(w, pbase + (size_t)(ai * 128 + m * 16) * 512 + bj * 128);
                        }
            } else {
#pragma unroll
                for (int ai = 0; ai < 2; ++ai)
#pragma unroll
                    for (int m = 0; m < 4; ++m)
#pragma unroll
                        for (int bj = 0; bj < 2; ++bj) {
                            const f32x4 v0 = acc[ai][bj][m][0], v1 = acc[ai][bj][m][1];
                            uint4 w; w.x = pack2(v0[0], v0[1]); w.y = pack2(v0[2], v0[3]); w.z = pack2(v1[0], v1[1]); w.w = pack2(v1[2], v1[3]);
                            nt_store16(w, pbase + (size_t)(ai * 128 + m * 16) * 512 + bj * 128);
                            *(uint4*)(cbase + (size_t)(ai * 128 + m * 16) * 1024 + bj * 128) = w;
                        }
            }
        }
    }
};
struct EpiMerge {
    static constexpr bool PERM = true, AFTER_DRAIN = false;
    unsigned char* ws;
    template <int MODE> __device__ __forceinline__ void run(const f32x4 (&acc)[2][2][4][2], const Unit& u, int wr, int wc, int fr, int fq) const {
        const u16* proj = (const u16*)(ws + OFF_PROJ); u16* mb = (u16*)(ws + OFF_MB);
        const int row0 = u.pm * 256 + wr * 64 + fr, col0 = u.pn * 256 + wc * 32 + 8 * fq, R = u.r;
        const int gcol0 = 7680 + R * 1024 + col0;
        const u16* gbase = proj + ((size_t)(gcol0 >> 9) * MLAT + row0) * 512 + (gcol0 & 511);
        u16* obase = mb + (size_t)row0 * 1024 + col0;
        uint4 g[2][4], old[2][4];
#define MG_LOAD(st, buf) do { _Pragma("unroll") for (int q = 0; q < 4; ++q) { const int ai_ = (st) >> 1, m_ = ((st) & 1) * 2 + (q >> 1), co_ = (q & 1) * 128; const size_t ro_ = (size_t)(ai_ * 128 + m_ * 16); \
            g[buf][q] = *(const uint4*)(gbase + ro_ * 512 + co_); if (MODE > 0) old[buf][q] = *(const uint4*)(obase + ro_ * 1024 + co_); } } while (0)
        MG_LOAD(0, 0);
#pragma unroll
        for (int st = 0; st < 4; ++st) {
            const int buf = st & 1;
            if (st + 1 < 4) MG_LOAD(st + 1, buf ^ 1);
            __builtin_amdgcn_sched_barrier(0);
#pragma unroll
            for (int q = 0; q < 4; ++q) { const int ai = st >> 1, m = (st & 1) * 2 + (q >> 1), bj = q & 1, co = bj * 128; const size_t ro = (size_t)(ai * 128 + m * 16);
                const f32x4 v0 = acc[ai][bj][m][0], v1 = acc[ai][bj][m][1];
                float gf[8]; unpack8(g[buf][q], gf);
                float o[8] = {v0[0] * sigmoidf_(gf[0]), v0[1] * sigmoidf_(gf[1]), v0[2] * sigmoidf_(gf[2]), v0[3] * sigmoidf_(gf[3]), v1[0] * sigmoidf_(gf[4]), v1[1] * sigmoidf_(gf[5]), v1[2] * sigmoidf_(gf[6]), v1[3] * sigmoidf_(gf[7])};
                if (MODE > 0) { float of[8]; unpack8(old[buf][q], of);
#pragma unroll
                    for (int e = 0; e < 8; ++e) o[e] += of[e]; }
                uint4 w; w.x = pack2(o[0], o[1]); w.y = pack2(o[2], o[3]); w.z = pack2(o[4], o[5]); w.w = pack2(o[6], o[7]);
                *(uint4*)(obase + ro * 1024 + co) = w; }
        }
#undef MG_LOAD
    }
    __device__ __forceinline__ void operator()(const f32x4 (&acc)[2][2][4][2], const Unit& u, int wr, int wc, int fr, int fq) const {
        if (u.r == 0) run<0>(acc, u, wr, wc, fr, fq);
        else run<1>(acc, u, wr, wc, fr, fq);
    }
};
struct EpiOut {
    static constexpr bool PERM = true, AFTER_DRAIN = false;
    u16* C;
    __device__ __forceinline__ void operator()(const f32x4 (&acc)[2][2][4][2], const Unit& u, int wr, int wc, int fr, int fq) const {
        const int row0 = u.pm * 256 + wr * 64 + fr, col0 = u.pn * 256 + wc * 32 + 8 * fq;
#pragma unroll
        for (int ai = 0; ai < 2; ++ai)
#pragma unroll
            for (int m = 0; m < 4; ++m) { u16* rowp = C + (size_t)(row0 + ai * 128 + m * 16) * 1024 + col0;
#pragma unroll
                for (int bj = 0; bj < 2; ++bj) { const f32x4 v0 = acc[ai][bj][m][0], v1 = acc[ai][bj][m][1];
                    uint4 w; w.x = pack2(v0[0], v0[1]); w.y = pack2(v0[2], v0[3]); w.z = pack2(v1[0], v1[1]); w.w = pack2(v1[2], v1[3]); *(uint4*)(rowp + bj * 128) = w; } }
    }
};

__device__ void transpose_tile(const float* src, int lds_, u16* dst, int ldd, int k0, int n0s, int n0d, u16* t) {
    const int tid = tidx();
#pragma unroll
    for (int it = 0; it < 2; ++it) {
        const int kk = (tid >> 4) + it * 32, nn = (tid & 15) * 4;
        const float4 v = *(const float4*)(src + (size_t)(k0 + kk) * lds_ + n0s + nn);
        t[(nn + 0) * 72 + kk] = f2bf(v.x); t[(nn + 1) * 72 + kk] = f2bf(v.y); t[(nn + 2) * 72 + kk] = f2bf(v.z); t[(nn + 3) * 72 + kk] = f2bf(v.w);
    }
    __syncthreads();
    { const int n = tid >> 3, k8 = (tid & 7) * 8;
      const uint4 v = *(const uint4*)(t + n * 72 + k8);
      *(uint4*)(dst + (size_t)(n0d + n) * ldd + k0 + k8) = v; }
    __syncthreads();
}

__device__ void prep1(const Params& p, unsigned char* lds) {
    unsigned char* ws = opaque(p.ws);
    const int tid = tidx();
    const size_t gt = (size_t)blockIdx.x * 512 + tid, gn = (size_t)gridDim.x * 512;
    { u16* ws16 = (u16*)(ws + OFF_WS16);
      for (size_t i = gt; i < (size_t)DEPTH * 8 * 128 * 128; i += gn) ws16[i] = f2bf(p.gmlp_ws[i]);
      float* lbp = (float*)(ws + OFF_LB);
      for (size_t i = gt; i < 1024; i += gn) {
          float e[DEPTH], mx = -1e30f, sum = 0.f;
#pragma unroll
          for (int l = 0; l < DEPTH; ++l) { e[l] = p.lb_logits[l * 1024 + i]; mx = fmaxf(mx, e[l]); }
#pragma unroll
          for (int l = 0; l < DEPTH; ++l) { e[l] = expf(e[l] - mx); sum += e[l]; }
          float run = 0.f;
#pragma unroll
          for (int l = 0; l < DEPTH; ++l) { if (l > 0) run += e[l] / sum; lbp[l * 1024 + i] = fmaxf(run, 0.f); }
      }
      float* rope = (float*)(ws + OFF_ROPE);
      for (size_t i = gt; i < 1024; i += gn) { const int pos = (int)(i >> 4), f = (int)(i & 15);
          const float inv = powf(10000.f, -(float)f * 2.0f / 32.0f), ang = (float)pos * inv;
          rope[i] = cosf(ang); rope[1024 + i] = sinf(ang); }
      float* tw = (float*)(ws + OFF_TW);
      for (size_t i = gt; i < 4096; i += gn) { float s, c; sincospif((float)i * (2.0f / 4096.0f), &s, &c); tw[2 * i] = c; tw[2 * i + 1] = s; }
      u16* m1 = (u16*)(ws + OFF_M1);
      for (size_t i = gt; i < 128 * 128; i += gn) { const int ii = (int)(i >> 7), kk = (int)(i & 127), k1 = ii >> 1, po = ii & 1, n1 = kk >> 1, pi = kk & 1;
          float s, c; sincospif((float)((k1 * n1) & 63) * (2.0f / 64.0f), &s, &c);
          const float v = (po == 0) ? (pi == 0 ? c : -s) : (pi == 0 ? -s : -c);
          m1[i] = f2bf(v); }
      u16* m2 = (u16*)(ws + OFF_M2);
      for (size_t i = gt; i < 64 * 128; i += gn) { const int k2 = (int)(i >> 7), kk = (int)(i & 127), n2 = kk >> 1, pi = kk & 1;
          float s, c; sincospif((float)((k2 * n2) & 63) * (2.0f / 64.0f), &s, &c);
          m2[i] = f2bf(pi == 0 ? c : s); }
      u16* m3 = (u16*)(ws + OFF_M3);
      for (size_t i = gt; i < 256 * 512; i += gn) { const int k = (int)(i >> 9), kk = (int)(i & 511), n = kk >> 1, pi = kk & 1;
          float s, c; sincospif((float)((k * n) & 255) * (2.0f / 256.0f), &s, &c);
          m3[i] = f2bf(pi == 0 ? c : -s); }
    }
    constexpr int N_WIN = DEPTH * 176 * 16, N_WBR = 16 * 16 * 8, N_WOUT = DEPTH * 16 * 16, N_MOD = DEPTH * 48, N_CSW = DEPTH * 4 * 2 * 2;
    constexpr int TOT = N_WIN + N_WBR + N_WOUT + N_MOD + N_CSW;
    for (int it = blockIdx.x; it < TOT; it += gridDim.x) {
        int idx = it;
        if (idx < N_WIN) {
            const int l = idx / 2816, rem = idx % 2816, cb = rem >> 4, kb = rem & 15, n0 = cb * 64;
            if (n0 >= 2048 && n0 < 2560) continue;
            const int n0d = n0 < 2048 ? n0 : n0 + 512;
            transpose_tile(p.w_in + (size_t)l * DM * NIN, NIN, (u16*)(ws + OFF_WTIN) + (size_t)l * NPROJ * DM, DM, kb * 64, n0, n0d, (u16*)lds);
            continue;
        }
        idx -= N_WIN;
        if (idx < N_WBR) {
            const int mat = idx >> 7, rem = idx & 127, cb = rem >> 3, kb = rem & 7;
            transpose_tile(p.w_branch + (size_t)mat * 512 * 1024, 1024, (u16*)(ws + OFF_WTBR) + (size_t)mat * 1024 * 512, 512, kb * 64, cb * 64, cb * 64, (u16*)lds);
            continue;
        }
        idx -= N_WBR;
        if (idx < N_WOUT) {
            const int l = idx >> 8, rem = idx & 255, cb = rem >> 4, kb = rem & 15;
            transpose_tile(p.w_out + (size_t)l * 1024 * 1024, 1024, (u16*)(ws + OFF_WTOUT) + (size_t)l * 1024 * 1024, 1024, kb * 64, cb * 64, cb * 64, (u16*)lds);
            continue;
        }
        idx -= N_WOUT;
        if (idx < N_MOD) {
            const int l = idx / 48, cb = idx % 48;
            float* s = (float*)lds; float* red = s + 17 * 1024;
            for (int i = tid; i < 17 * 1024; i += 512) { const int j = i >> 10, k = i & 1023; const float v = j < 16 ? p.c[j * 1024 + k] : p.c_ctx[k]; s[i] = v / (1.f + expf(-v)); }
            __syncthreads();
            const int col = tid & 63, ks = tid >> 6;
            float acc[17];
#pragma unroll
            for (int j = 0; j < 17; ++j) acc[j] = 0.f;
            for (int k = ks * 128; k < ks * 128 + 128; ++k) {
                const float w = p.w_ada[((size_t)l * 1024 + k) * 3072 + cb * 64 + col];
#pragma unroll
                for (int j = 0; j < 17; ++j) acc[j] += s[j * 1024 + k] * w;
            }
#pragma unroll
            for (int j = 0; j < 17; ++j) red[(ks * 17 + j) * 64 + col] = acc[j];
            __syncthreads();
            for (int o = tid; o < 17 * 64; o += 512) { const int j = o >> 6, cc = o & 63; float sum = 0.f;
                for (int q = 0; q < 8; ++q) sum += red[(q * 17 + j) * 64 + cc];
                ((float*)(ws + OFF_MOD))[((size_t)l * 17 + j) * 3072 + cb * 64 + cc] = sum + p.b_ada[l * 3072 + cb * 64 + cc]; }
            __syncthreads();
            continue;
        }
        idx -= N_MOD;
        {
            const int cblk = idx & 1, part = (idx >> 1) & 1, g = (idx >> 2) & 3, l = idx >> 4;
            float* tb = (float*)lds;
            if (tid < 128) { float s, c; sincospif((float)tid * (2.0f / 128.0f), &s, &c); tb[tid] = part ? s : c; }
            __syncthreads();
            const int d = tid & 127, cq = tid >> 7;
            float acc[16];
#pragma unroll
            for (int i = 0; i < 16; ++i) acc[i] = 0.f;
            const float* wf = p.fnet_w + ((size_t)(l * 4 + g) * 128) * 128;
            for (int c2 = 0; c2 < 128; ++c2) {
                const float w = wf[c2 * 128 + d];
#pragma unroll
                for (int i = 0; i < 16; ++i) { const int c = cblk * 64 + cq * 16 + i; acc[i] += tb[(c * c2) & 127] * w; }
            }
            float* dst = (float*)(ws + OFF_CSW) + ((size_t)((l * 4 + g) * 2 + part) * 128) * 128;
#pragma unroll
            for (int i = 0; i < 16; ++i) dst[(cblk * 64 + cq * 16 + i) * 128 + d] = acc[i];
            __syncthreads();
        }
    }
}

__device__ void prep2(const Params& p, unsigned char* lds) {
    unsigned char* ws = opaque(p.ws);
    const int tid = tidx();
    float* wb = (float*)lds;
    float* cw = wb + 64 * 129;
    for (int it = blockIdx.x; it < DEPTH * 4 * 2 * 16; it += gridDim.x) {
        const int kb = it & 15, part = (it >> 4) & 1, g = (it >> 5) & 3, l = it >> 7;
        for (int i = tid; i < 64 * 128; i += 512) { const int kk = i >> 7, c = i & 127; wb[kk * 129 + c] = p.w_in[((size_t)l * 1024 + kb * 64 + kk) * NIN + 2048 + g * 128 + c]; }
        const float* src = (const float*)(ws + OFF_CSW) + ((size_t)((l * 4 + g) * 2 + part) * 128) * 128;
        for (int i = tid; i < 128 * 128; i += 512) cw[i] = src[i];
        __syncthreads();
        const int d = tid & 127, kq = tid >> 7;
        float acc[16];
#pragma unroll
        for (int i = 0; i < 16; ++i) acc[i] = 0.f;
        for (int c = 0; c < 128; ++c) {
            const float w = cw[c * 128 + d];
#pragma unroll
            for (int i = 0; i < 16; ++i) acc[i] += wb[(kq * 16 + i) * 129 + c] * w;
        }
        u16* dst = (u16*)(ws + OFF_WTIN) + ((size_t)l * NPROJ + (4 + part) * 512 + g * 128 + d) * DM + kb * 64 + kq * 16;
        uint4 w0, w1;
        w0.x = pack2(acc[0], acc[1]); w0.y = pack2(acc[2], acc[3]); w0.z = pack2(acc[4], acc[5]); w0.w = pack2(acc[6], acc[7]);
        w1.x = pack2(acc[8], acc[9]); w1.y = pack2(acc[10], acc[11]); w1.z = pack2(acc[12], acc[13]); w1.w = pack2(acc[14], acc[15]);
        *(uint4*)dst = w0; *(uint4*)(dst + 8) = w1;
        __syncthreads();
    }
}

__device__ void phase_norm(const Params& p, const PassInfo ps, int l) {
    unsigned char* ws = opaque(p.ws);
    const int wave = tidx() >> 6, lane = tidx() & 63;
    const float* mod = (const float*)(ws + OFF_MOD);
    const u16* OUT = (const u16*)(ws + OFF_OUT);
    u16* H = (u16*)(ws + OFF_H);
    for (int rr = blockIdx.x * 8 + wave; rr < ps.M; rr += gridDim.x * 8) {
        const int tsh = ps.is_ctx ? 8 : 12; const int b = ps.b0 + (rr >> tsh), t = rr & (ps.T - 1), mrow = ps.is_ctx ? 16 : b;
        const size_t xoff = ((size_t)b * ps.T + t) * 1024;
        const float* xin = (l <= 1) ? ((ps.is_ctx ? p.ctx : p.x) + xoff) : ((ps.is_ctx ? (const float*)(ws + OFF_CTXW) : (const float*)p.out) + xoff);
        float* xout = (ps.is_ctx ? (float*)(ws + OFF_CTXW) : p.out) + xoff;
        float xv[16];
#pragma unroll
        for (int hlf = 0; hlf < 2; ++hlf) {
            const int c0 = hlf * 512 + lane * 8;
            const float4 a = *(const float4*)(xin + c0), bq = *(const float4*)(xin + c0 + 4);
            xv[hlf * 8 + 0] = a.x; xv[hlf * 8 + 1] = a.y; xv[hlf * 8 + 2] = a.z; xv[hlf * 8 + 3] = a.w;
            xv[hlf * 8 + 4] = bq.x; xv[hlf * 8 + 5] = bq.y; xv[hlf * 8 + 6] = bq.z; xv[hlf * 8 + 7] = bq.w;
        }
        if (l > 0) {
            float ov[16]; float ss = 0.f;
#pragma unroll
            for (int hlf = 0; hlf < 2; ++hlf) {
                const int c0 = hlf * 512 + lane * 8;
                unpack8(*(const uint4*)(OUT + (size_t)rr * 1024 + c0), ov + hlf * 8);
            }
#pragma unroll
            for (int e = 0; e < 16; ++e) ss += ov[e] * ov[e];
#pragma unroll
            for (int o = 32; o > 0; o >>= 1) ss += shx(ss, o);
            const float rstd = rsqrtf(ss * (1.f / 1024.f) + EPSN);
            const float* gt = mod + ((size_t)(l - 1) * 17 + mrow) * 3072 + 2048;
            const float* gp = p.g_post + (l - 1) * 1024;
#pragma unroll
            for (int hlf = 0; hlf < 2; ++hlf) {
                const int c0 = hlf * 512 + lane * 8;
#pragma unroll
                for (int e = 0; e < 8; ++e) xv[hlf * 8 + e] += gt[c0 + e] * (ov[hlf * 8 + e] * rstd * gp[c0 + e]);
                *(float4*)(xout + c0) = make_float4(xv[hlf * 8 + 0], xv[hlf * 8 + 1], xv[hlf * 8 + 2], xv[hlf * 8 + 3]);
                *(float4*)(xout + c0 + 4) = make_float4(xv[hlf * 8 + 4], xv[hlf * 8 + 5], xv[hlf * 8 + 6], xv[hlf * 8 + 7]);
            }
        }
        if (l < DEPTH) {
            float ss = 0.f;
#pragma unroll
            for (int e = 0; e < 16; ++e) ss += xv[e] * xv[e];
#pragma unroll
            for (int o = 32; o > 0; o >>= 1) ss += shx(ss, o);
            const float rstd = rsqrtf(ss * (1.f / 1024.f) + EPSN);
            const float* sh = mod + ((size_t)l * 17 + mrow) * 3072; const float* sc = sh + 1024;
            const float* gp = p.g_pre + l * 1024;
#pragma unroll
            for (int hlf = 0; hlf < 2; ++hlf) {
                const int c0 = hlf * 512 + lane * 8;
                float hv[8];
#pragma unroll
                for (int e = 0; e < 8; ++e) hv[e] = xv[hlf * 8 + e] * rstd * gp[c0 + e] * (1.f + sc[c0 + e]) + sh[c0 + e];
                uint4 w; w.x = pack2(hv[0], hv[1]); w.y = pack2(hv[2], hv[3]); w.z = pack2(hv[4], hv[5]); w.w = pack2(hv[6], hv[7]);
                *(uint4*)(H + (size_t)rr * 1024 + c0) = w;
            }
        }
    }
}

#define PJ(row, blk, c) (PROJ + ((size_t)(blk) * MLAT + (row)) * 512 + (c))
typedef unsigned u32x32_ __attribute__((ext_vector_type(32)));
struct Reg8 {
    u32x32_ v;
    __device__ __forceinline__ void ld(int i, const void* p) { const u32x4_ a = *(const u32x4_*)p; v[4 * i] = a[0]; v[4 * i + 1] = a[1]; v[4 * i + 2] = a[2]; v[4 * i + 3] = a[3]; }
    __device__ __forceinline__ u32x4_ get(int i) const { return (u32x4_){v[4 * i], v[4 * i + 1], v[4 * i + 2], v[4 * i + 3]}; }
    __device__ __forceinline__ uint4 getu(int i) const { uint4 r; r.x = v[4 * i]; r.y = v[4 * i + 1]; r.z = v[4 * i + 2]; r.w = v[4 * i + 3]; return r; }
};
#define MEMBAR() asm volatile("" ::: "memory")
constexpr int KVS = 72;
constexpr int TS = 528;
constexpr int T3S = 136;
constexpr int HS_ = 68;
constexpr float NORM_LAT = 0.0013810679320049757f;
constexpr float NORM_CTX = 0.005524271728019903f;

__device__ void attn_item(const Params& p, const PassInfo ps, int l, int item, unsigned char* lds) {
    unsigned char* ws = opaque(p.ws);
    const u16* PROJ = (const u16*)(ws + OFF_PROJ); const u16* QROT = (const u16*)(ws + OFF_QROT);
    const u16* CKV = (const u16*)(ws + OFF_CTXKV) + (size_t)l * MCTX * 1024;
    u16* Y0 = (u16*)(ws + OFF_Y);
    const int tid = tidx(), w = tid >> 6, lane = tid & 63, qtr = w & 3, kh = w >> 2, li = lane & 15, quad = lane >> 4;
    u16* Kl = (u16*)lds; u16* Vl = Kl + 512 * KVS; float* rp = (float*)(Vl + 512 * KVS);
    int bl, h, r = 0, qrow0, bglob;
    if (!ps.is_ctx) { r = item & 63; h = (item >> 6) & 7; bl = item >> 9; qrow0 = bl * 4096 + r * 64; bglob = ps.b0 + bl; }
    else { const int qb = item & 3; h = (item >> 2) & 7; bl = item >> 5; qrow0 = bl * 256 + qb * 64; bglob = bl; }
    const int qrow = qrow0 + qtr * 16 + li;
    float m_run = -1e30f, l_run = 0.f;
    const bf16x8 qp0 = ld_frag_g(PJ(qrow, 0, h * 64 + quad * 8)), qp1 = ld_frag_g(PJ(qrow, 0, h * 64 + 32 + quad * 8));
    uint2 gate4[4];
#pragma unroll
    for (int d = 0; d < 4; ++d) gate4[d] = *(const uint2*)(PJ(qrow, 3, h * 64 + d * 16 + quad * 4));
    Reg8 crg;
    { const size_t crow0 = (size_t)bglob * 256;
#pragma unroll
      for (int i = 0; i < 4; ++i) { const int idx = tid + 512 * i, key = idx >> 3, ch = idx & 7;
          crg.ld(2 * i, CKV + (crow0 + key) * 1024 + h * 64 + ch * 8); crg.ld(2 * i + 1, CKV + (crow0 + key) * 1024 + 512 + h * 64 + ch * 8); } }
    f32x4 O[4];
#pragma unroll
    for (int d = 0; d < 4; ++d) O[d] = (f32x4){0.f, 0.f, 0.f, 0.f};
    if (!ps.is_ctx) {
        const int rs = min(max(r - 4, 0), 56);
        const size_t krow0 = (size_t)bl * 4096 + rs * 64;
        const bf16x8 q0 = ld_frag_g(QROT + (size_t)qrow * 512 + h * 64 + quad * 8), q1 = ld_frag_g(QROT + (size_t)qrow * 512 + h * 64 + 32 + quad * 8);
        { u32x32_ kr, vr;
#pragma unroll
          for (int i = 0; i < 8; ++i) { const int idx = tid + 512 * i, key = idx >> 3, ch = idx & 7;
              const u32x4_ a = *(const u32x4_*)(PJ(krow0 + key, 1, h * 64 + ch * 8)), b = *(const u32x4_*)(PJ(krow0 + key, 2, h * 64 + ch * 8));
              kr[4 * i] = a[0]; kr[4 * i + 1] = a[1]; kr[4 * i + 2] = a[2]; kr[4 * i + 3] = a[3]; vr[4 * i] = b[0]; vr[4 * i + 1] = b[1]; vr[4 * i + 2] = b[2]; vr[4 * i + 3] = b[3]; }
          asm volatile("" ::: "memory");
#pragma unroll
          for (int i = 0; i < 8; ++i) { const int idx = tid + 512 * i, key = idx >> 3, ch = idx & 7;
              *(u32x4_*)(Kl + key * KVS + ch * 8) = (u32x4_){kr[4 * i], kr[4 * i + 1], kr[4 * i + 2], kr[4 * i + 3]}; *(u32x4_*)(Vl + key * KVS + ch * 8) = (u32x4_){vr[4 * i], vr[4 * i + 1], vr[4 * i + 2], vr[4 * i + 3]}; } }
        for (int i = tid; i < 465; i += 512) rp[i] = p.rpb[((size_t)l * 8 + h) * 465 + i];
        __syncthreads();
        const int cbase = (qtr == 0) ? 0 : (qtr == 1 ? 8 : (qtr == 2 ? 24 : 32));
        const int qc = qtr * 16 + li, cst = min(max(qc - 8, 0), 48);
        float s[8][4];
        float mx = -1e30f;
#pragma unroll
        for (int sb = 0; sb < 8; ++sb) {
            const int i = kh * 4 + (sb >> 1), cs = sb & 1;
            const u16* kp = Kl + (i * 64 + cbase + cs * 16 + li) * KVS + quad * 8;
            f32x4 a = (f32x4){0.f, 0.f, 0.f, 0.f};
            a = MFMA16(*(const bf16x8*)kp, q0, a); a = MFMA16(*(const bf16x8*)(kp + 32), q1, a);
            const int ridx = rs + i - r + 7;
#pragma unroll
            for (int j = 0; j < 4; ++j) { const int kc = cbase + cs * 16 + quad * 4 + j;
                const bool valid = (kc >= cst) && (kc < cst + 16);
                const int cidx = min(max(kc - qc + 15, 0), 30);
                const float v = valid ? (a[j] * 0.125f + rp[ridx * 31 + cidx]) : -1e30f;
                s[sb][j] = v; mx = fmaxf(mx, v); }
        }
        mx = fmaxf(mx, shx(mx, 16)); mx = fmaxf(mx, shx(mx, 32));
        m_run = mx;
        float ls = 0.f;
#pragma unroll
        for (int sb = 0; sb < 8; ++sb)
#pragma unroll
            for (int j = 0; j < 4; ++j) { const float e = __expf(s[sb][j] - mx); s[sb][j] = e; ls += e; }
        ls += shx(ls, 16); ls += shx(ls, 32);
        l_run = ls;
#pragma unroll
        for (int kp2 = 0; kp2 < 4; ++kp2) {
            bf16x8 pf; { const unsigned a0 = pack2(s[2 * kp2][0], s[2 * kp2][1]), a1 = pack2(s[2 * kp2][2], s[2 * kp2][3]), b0 = pack2(s[2 * kp2 + 1][0], s[2 * kp2 + 1][1]), b1 = pack2(s[2 * kp2 + 1][2], s[2 * kp2 + 1][3]);
                pf = (bf16x8){(short)(a0 & 0xffff), (short)(a0 >> 16), (short)(a1 & 0xffff), (short)(a1 >> 16), (short)(b0 & 0xffff), (short)(b0 >> 16), (short)(b1 & 0xffff), (short)(b1 >> 16)}; }
            const int vrow0 = (kh * 4 + kp2) * 64 + cbase + quad * 4 + (li >> 2);
#pragma unroll
            for (int d = 0; d < 4; ++d) {
                const u16* vp = Vl + vrow0 * KVS + d * 16 + 4 * (li & 3);
                const bf16x8 vf = tr_read2(vp, vp + 16 * KVS);
                O[d] = MFMA16(vf, pf, O[d]);
            }
        }
        __syncthreads();
    }
    {
#pragma unroll
        for (int i = 0; i < 4; ++i) { const int idx = tid + 512 * i, key = idx >> 3, ch = idx & 7;
            *(u32x4_*)(Kl + key * KVS + ch * 8) = crg.get(2 * i); *(u32x4_*)(Vl + key * KVS + ch * 8) = crg.get(2 * i + 1); }
        __syncthreads();
        const bf16x8 q0 = qp0, q1 = qp1;
        float s[8][4];
        float mx = -1e30f;
#pragma unroll
        for (int sb = 0; sb < 8; ++sb) {
            const u16* kp = Kl + (kh * 128 + sb * 16 + li) * KVS + quad * 8;
            f32x4 a = (f32x4){0.f, 0.f, 0.f, 0.f};
            a = MFMA16(*(const bf16x8*)kp, q0, a); a = MFMA16(*(const bf16x8*)(kp + 32), q1, a);
#pragma unroll
            for (int j = 0; j < 4; ++j) { const float v = a[j] * 0.125f; s[sb][j] = v; mx = fmaxf(mx, v); }
        }
        mx = fmaxf(mx, shx(mx, 16)); mx = fmaxf(mx, shx(mx, 32));
        const float m_new = fmaxf(m_run, mx), resc = __expf(m_run - m_new);
        float ls = 0.f;
#pragma unroll
        for (int sb = 0; sb < 8; ++sb)
#pragma unroll
            for (int j = 0; j < 4; ++j) { const float e = __expf(s[sb][j] - m_new); s[sb][j] = e; ls += e; }
        ls += shx(ls, 16); ls += shx(ls, 32);
        l_run = l_run * resc + ls; m_run = m_new;
#pragma unroll
        for (int d = 0; d < 4; ++d) O[d] *= resc;
#pragma unroll
        for (int kp2 = 0; kp2 < 4; ++kp2) {
            bf16x8 pf; { const unsigned a0 = pack2(s[2 * kp2][0], s[2 * kp2][1]), a1 = pack2(s[2 * kp2][2], s[2 * kp2][3]), b0 = pack2(s[2 * kp2 + 1][0], s[2 * kp2 + 1][1]), b1 = pack2(s[2 * kp2 + 1][2], s[2 * kp2 + 1][3]);
                pf = (bf16x8){(short)(a0 & 0xffff), (short)(a0 >> 16), (short)(a1 & 0xffff), (short)(a1 >> 16), (short)(b0 & 0xffff), (short)(b0 >> 16), (short)(b1 & 0xffff), (short)(b1 >> 16)}; }
            const int vrow0 = kh * 128 + kp2 * 32 + quad * 4 + (li >> 2);
#pragma unroll
            for (int d = 0; d < 4; ++d) {
                const u16* vp = Vl + vrow0 * KVS + d * 16 + 4 * (li & 3);
                const bf16x8 vf = tr_read2(vp, vp + 16 * KVS);
                O[d] = MFMA16(vf, pf, O[d]);
            }
        }
        __syncthreads();
    }
    float* cb = (float*)lds;
    if (kh == 1) {
#pragma unroll
        for (int d = 0; d < 4; ++d)
#pragma unroll
            for (int j = 0; j < 4; ++j) cb[(qtr * 18 + d * 4 + j) * 64 + lane] = O[d][j];
        cb[(qtr * 18 + 16) * 64 + lane] = m_run; cb[(qtr * 18 + 17) * 64 + lane] = l_run;
    }
    __syncthreads();
    if (kh == 0) {
        const float m2 = cb[(qtr * 18 + 16) * 64 + lane], l2 = cb[(qtr * 18 + 17) * 64 + lane];
        const float mm = fmaxf(m_run, m2), e1 = __expf(m_run - mm), e2 = __expf(m2 - mm);
        const float inv = 1.f / (l_run * e1 + l2 * e2);
#pragma unroll
        for (int d = 0; d < 4; ++d) {
            const int col = h * 64 + d * 16 + quad * 4;
            const uint2 g = gate4[d];
            float o[4];
#pragma unroll
            for (int j = 0; j < 4; ++j) o[j] = (O[d][j] * e1 + cb[(qtr * 18 + d * 4 + j) * 64 + lane] * e2) * inv;
            uint2 wv; wv.x = pack2(o[0] * siluf_(bflo(g.x)), o[1] * siluf_(bfhi(g.x))); wv.y = pack2(o[2] * siluf_(bflo(g.y)), o[3] * siluf_(bfhi(g.y)));
            *(uint2*)(Y0 + (size_t)qrow * 512 + col) = wv;
        }
    }
    __syncthreads();
}

template <int ROWS, int CPR> __device__ __forceinline__ void load_tile(u16* dstl, int lstride, const u16* src, size_t sstride) {
    constexpr int PER = ROWS * CPR / 512;
    static_assert(PER % 8 == 0, "tile size");
    const int tid_ = tidx();
#pragma unroll
    for (int b8 = 0; b8 < PER / 8; ++b8) { Reg8 rg;
#pragma unroll
        for (int j = 0; j < 8; ++j) { const int i = tid_ + 512 * (b8 * 8 + j), r = i / CPR, ch = i % CPR; rg.ld(j, src + (size_t)r * sstride + ch * 8); }
        MEMBAR();
#pragma unroll
        for (int j = 0; j < 8; ++j) { const int i = tid_ + 512 * (b8 * 8 + j), r = i / CPR, ch = i % CPR; *(u32x4_*)(dstl + r * lstride + ch * 8) = rg.get(j); }
        MEMBAR(); }
}

__device__ void four1_item(const Params& p, int item, unsigned char* lds) {
    unsigned char* ws = opaque(p.ws);
    const u16* PROJ = (const u16*)(ws + OFF_PROJ); const u16* M1 = (const u16*)(ws + OFF_M1); const float* TW = (const float*)(ws + OFF_TW);
    u16* FY = (u16*)(ws + OFF_FY);
    const int tid = tidx(), w = tid >> 6, lane = tid & 63, li = lane & 15, quad = lane >> 4;
    const int n2 = item & 63, bl = item >> 6;
    u16* T = (u16*)lds;
#pragma unroll
    for (int b8 = 0; b8 < 2; ++b8) { Reg8 rg;
#pragma unroll
        for (int j = 0; j < 8; ++j) { const int i = tid + 512 * (b8 * 8 + j), kk = i >> 6, ch = i & 63, n1 = kk >> 1, part = kk & 1;
            rg.ld(j, PJ((size_t)bl * 4096 + n1 * 64 + n2, 4 + part, ch * 8)); }
        MEMBAR();
#pragma unroll
        for (int j = 0; j < 8; ++j) { const int i = tid + 512 * (b8 * 8 + j), kk = i >> 6, ch = i & 63;
            *(u32x4_*)(T + kk * TS + ch * 8) = rg.get(j); }
        MEMBAR(); }
    float* twl = (float*)(T + 128 * TS);
    if (tid < 64) { const float2 tv = *(const float2*)(TW + 2 * (n2 * tid)); twl[2 * tid] = tv.x; twl[2 * tid + 1] = tv.y; }
    bf16x8 xf[4];
#pragma unroll
    for (int ks = 0; ks < 4; ++ks) xf[ks] = ld_frag_g(M1 + li * 128 + ks * 32 + quad * 8);
    __syncthreads();
    for (int isub = 0; isub < 8; ++isub) {
        bf16x8 xn[4];
        const int isn = isub < 7 ? isub + 1 : 7;
#pragma unroll
        for (int ks = 0; ks < 4; ++ks) xn[ks] = ld_frag_g(M1 + (isn * 16 + li) * 128 + ks * 32 + quad * 8);
        float tcs[2], tsn_[2];
#pragma unroll
        for (int hh = 0; hh < 2; ++hh) { const int k1 = isub * 8 + quad * 2 + hh; tcs[hh] = twl[2 * k1]; tsn_[hh] = twl[2 * k1 + 1]; }
#pragma unroll
        for (int cs = 0; cs < 4; ++cs) {
            const int c0 = w * 64 + cs * 16;
            f32x4 a = (f32x4){0.f, 0.f, 0.f, 0.f};
#pragma unroll
            for (int ks = 0; ks < 4; ++ks) {
                const u16* tp = T + (ks * 32 + quad * 8 + (li >> 2)) * TS + c0 + 4 * (li & 3);
                a = MFMA16(xf[ks], tr_read2(tp, tp + 4 * TS), a);
            }
            const int ch = c0 + li;
#pragma unroll
            for (int hh = 0; hh < 2; ++hh) {
                const int k1 = isub * 8 + quad * 2 + hh;
                const float yr = a[2 * hh], yi = a[2 * hh + 1];
                const float orr = yr * tcs[hh] + yi * tsn_[hh], oi = yi * tcs[hh] - yr * tsn_[hh];
                u16* dst = FY + (((size_t)bl * 64 + k1) * 64 + n2) * 1024 + ch;
                dst[0] = f2bf(orr); dst[512] = f2bf(oi);
            }
        }
#pragma unroll
        for (int ks = 0; ks < 4; ++ks) xf[ks] = xn[ks];
    }
    __syncthreads();
}

__device__ void four2_item(const Params& p, int item, unsigned char* lds) {
    unsigned char* ws = opaque(p.ws);
    const u16* PROJ = (const u16*)(ws + OFF_PROJ); const u16* M2 = (const u16*)(ws + OFF_M2); const u16* FY = (const u16*)(ws + OFF_FY);
    u16* Y1 = (u16*)(ws + OFF_Y) + (size_t)1 * MLAT * 512;
    const int tid = tidx(), w = tid >> 6, lane = tid & 63, li = lane & 15, quad = lane >> 4;
    const int k1 = item & 63, bl = item >> 6;
    u16* T = (u16*)lds;
    load_tile<128, 64>(T, TS, FY + ((size_t)bl * 64 + k1) * 64 * 1024, 512);
    __syncthreads();
    bf16x8 xf[4][4];
#pragma unroll
    for (int cs = 0; cs < 4; ++cs)
#pragma unroll
        for (int ks = 0; ks < 4; ++ks) { const u16* tp = T + (ks * 32 + quad * 8 + (li >> 2)) * TS + w * 64 + cs * 16 + 4 * (li & 3); xf[cs][ks] = tr_read2(tp, tp + 4 * TS); }
    bf16x8 yf[4]; uint2 gt[4];
#define F2_LOAD(k2s_, yf_, gt_) do { _Pragma("unroll") for (int ks = 0; ks < 4; ++ks) yf_[ks] = ld_frag_g(M2 + ((k2s_) * 16 + li) * 128 + ks * 32 + quad * 8); \
        const size_t row_ = (size_t)bl * 4096 + k1 + 64 * ((k2s_) * 16 + li); _Pragma("unroll") for (int cs = 0; cs < 4; ++cs) gt_[cs] = *(const uint2*)(PJ(row_, 6, w * 64 + cs * 16 + quad * 4)); } while (0)
    F2_LOAD(0, yf, gt);
    for (int k2s = 0; k2s < 4; ++k2s) {
        bf16x8 yn[4]; uint2 gn[4];
        const int kn = k2s < 3 ? k2s + 1 : 3;
        F2_LOAD(kn, yn, gn);
        const int k2 = k2s * 16 + li;
        const size_t row = (size_t)bl * 4096 + k1 + 64 * k2;
#pragma unroll
        for (int cs = 0; cs < 4; ++cs) {
            f32x4 a = (f32x4){0.f, 0.f, 0.f, 0.f};
#pragma unroll
            for (int ks = 0; ks < 4; ++ks) a = MFMA16(xf[cs][ks], yf[ks], a);
            const int ch = w * 64 + cs * 16 + quad * 4;
            const uint2 g = gt[cs];
            uint2 wv; wv.x = pack2(a[0] * NORM_LAT * siluf_(bflo(g.x)), a[1] * NORM_LAT * siluf_(bfhi(g.x))); wv.y = pack2(a[2] * NORM_LAT * siluf_(bflo(g.y)), a[3] * NORM_LAT * siluf_(bfhi(g.y)));
            *(uint2*)(Y1 + row * 512 + ch) = wv;
        }
#pragma unroll
        for (int q = 0; q < 4; ++q) { yf[q] = yn[q]; gt[q] = gn[q]; }
    }
#undef F2_LOAD
    __syncthreads();
}

__device__ void fourc_item(const Params& p, int item, unsigned char* lds) {
    unsigned char* ws = opaque(p.ws);
    const u16* PROJ = (const u16*)(ws + OFF_PROJ); const u16* M3 = (const u16*)(ws + OFF_M3);
    u16* Y1 = (u16*)(ws + OFF_Y) + (size_t)1 * MLAT * 512;
    const int tid = tidx(), w = tid >> 6, lane = tid & 63, li = lane & 15, quad = lane >> 4;
    const int chb = item & 3, b = item >> 2;
    u16* T = (u16*)lds;
#pragma unroll
    for (int b8 = 0; b8 < 2; ++b8) { Reg8 rg;
#pragma unroll
        for (int j = 0; j < 8; ++j) { const int i = tid + 512 * (b8 * 8 + j), kk = i >> 4, ch = i & 15, n = kk >> 1, part = kk & 1;
            rg.ld(j, PJ((size_t)b * 256 + n, 4 + part, chb * 128 + ch * 8)); }
        MEMBAR();
#pragma unroll
        for (int j = 0; j < 8; ++j) { const int i = tid + 512 * (b8 * 8 + j), kk = i >> 4, ch = i & 15;
            *(u32x4_*)(T + kk * T3S + ch * 8) = rg.get(j); }
        MEMBAR(); }
    __syncthreads();
    for (int kq = 0; kq < 2; ++kq) {
        const int ksub = w * 2 + kq;
        f32x4 a[8];
#pragma unroll
        for (int cs = 0; cs < 8; ++cs) a[cs] = (f32x4){0.f, 0.f, 0.f, 0.f};
        for (int ks = 0; ks < 16; ++ks) {
            const bf16x8 yf = ld_frag_g(M3 + (ksub * 16 + li) * 512 + ks * 32 + quad * 8);
#pragma unroll
            for (int cs = 0; cs < 8; ++cs) { const u16* tp = T + (ks * 32 + quad * 8 + (li >> 2)) * T3S + cs * 16 + 4 * (li & 3);
                a[cs] = MFMA16(tr_read2(tp, tp + 4 * T3S), yf, a[cs]); }
        }
        const size_t row = (size_t)b * 256 + ksub * 16 + li;
#pragma unroll
        for (int cs = 0; cs < 8; ++cs) {
            const int ch = chb * 128 + cs * 16 + quad * 4;
            const uint2 g = *(const uint2*)(PJ(row, 6, ch));
            uint2 wv; wv.x = pack2(a[cs][0] * NORM_CTX * siluf_(bflo(g.x)), a[cs][1] * NORM_CTX * siluf_(bfhi(g.x))); wv.y = pack2(a[cs][2] * NORM_CTX * siluf_(bflo(g.y)), a[cs][3] * NORM_CTX * siluf_(bfhi(g.y)));
            *(uint2*)(Y1 + row * 512 + ch) = wv;
        }
    }
    __syncthreads();
}

__device__ void gmlp_item(const Params& p, int l, int item, unsigned char* lds) {
    unsigned char* ws = opaque(p.ws);
    const u16* PROJ = (const u16*)(ws + OFF_PROJ); const u16* WS16 = (const u16*)(ws + OFF_WS16) + (size_t)l * 8 * 128 * 128;
    u16* Y2 = (u16*)(ws + OFF_Y) + (size_t)2 * MLAT * 512;
    const int tid = tidx(), w = tid >> 6, lane = tid & 63, li = lane & 15, quad = lane >> 4;
    const size_t r0 = (size_t)item * 128;
    u16* VN = (u16*)lds;
    {
        const int row = tid >> 2, qd = tid & 3;
        const u16* src = PJ(r0 + row, 8, 0);
        uint4 raw[16]; float ss = 0.f;
#pragma unroll
        for (int i = 0; i < 16; ++i) { raw[i] = *(const uint4*)(src + (qd + 4 * i) * 8); float f[8]; unpack8(raw[i], f);
#pragma unroll
            for (int e = 0; e < 8; ++e) ss += f[e] * f[e]; }
        ss += shx(ss, 1); ss += shx(ss, 2);
        const float rstd = rsqrtf(ss * (1.f / 512.f) + EPSN);
        const float* gn = p.gmlp_g + l * 512;
#pragma unroll
        for (int i = 0; i < 16; ++i) { float f[8]; unpack8(raw[i], f); const int c0 = (qd + 4 * i) * 8;
            const float4 g0 = *(const float4*)(gn + c0), g1 = *(const float4*)(gn + c0 + 4);
            uint4 o; o.x = pack2(f[0] * rstd * g0.x, f[1] * rstd * g0.y); o.y = pack2(f[2] * rstd * g0.z, f[3] * rstd * g0.w);
            o.z = pack2(f[4] * rstd * g1.x, f[5] * rstd * g1.y); o.w = pack2(f[6] * rstd * g1.z, f[7] * rstd * g1.w);
            *(uint4*)(VN + row * TS + c0) = o; }
    }
    __syncthreads();
    const int g = w;
    bf16x8 xf[4][4];
#pragma unroll
    for (int cs = 0; cs < 4; ++cs)
#pragma unroll
        for (int ks = 0; ks < 4; ++ks) { const u16* tp = VN + (ks * 32 + quad * 8 + (li >> 2)) * TS + g * 64 + cs * 16 + 4 * (li & 3); xf[cs][ks] = tr_read2(tp, tp + 4 * TS); }
    bf16x8 yf[4]; uint2 uu[4], gg[4]; float bs;
#define GM_LOAD(ts_, yf_, uu_, gg_, bs_) do { const int t_ = (ts_) * 16 + li; _Pragma("unroll") for (int ks = 0; ks < 4; ++ks) yf_[ks] = ld_frag_g(WS16 + ((size_t)g * 128 + t_) * 128 + ks * 32 + quad * 8); \
        bs_ = p.gmlp_bs[((size_t)l * 8 + g) * 128 + t_]; _Pragma("unroll") for (int cs = 0; cs < 4; ++cs) { const int c_ = g * 64 + cs * 16 + quad * 4; uu_[cs] = *(const uint2*)(PJ(r0 + t_, 7, c_)); gg_[cs] = *(const uint2*)(PJ(r0 + t_, 9, c_)); } } while (0)
    GM_LOAD(0, yf, uu, gg, bs);
    for (int ts = 0; ts < 8; ++ts) {
        bf16x8 yn[4]; uint2 un[4], gn[4]; float bn;
        const int tn = ts < 7 ? ts + 1 : 7;
        GM_LOAD(tn, yn, un, gn, bn);
        const int t = ts * 16 + li;
        const size_t row = r0 + t;
#pragma unroll
        for (int cs = 0; cs < 4; ++cs) {
            f32x4 a = (f32x4){0.f, 0.f, 0.f, 0.f};
#pragma unroll
            for (int ks = 0; ks < 4; ++ks) a = MFMA16(xf[cs][ks], yf[ks], a);
            const int c = g * 64 + cs * 16 + quad * 4;
            uint2 wv; wv.x = pack2(bflo(uu[cs].x) * (a[0] + bs) * siluf_(bflo(gg[cs].x)), bfhi(uu[cs].x) * (a[1] + bs) * siluf_(bfhi(gg[cs].x)));
            wv.y = pack2(bflo(uu[cs].y) * (a[2] + bs) * siluf_(bflo(gg[cs].y)), bfhi(uu[cs].y) * (a[3] + bs) * siluf_(bfhi(gg[cs].y)));
            *(uint2*)(Y2 + row * 512 + c) = wv;
        }
#pragma unroll
        for (int q = 0; q < 4; ++q) { yf[q] = yn[q]; uu[q] = un[q]; gg[q] = gn[q]; }
        bs = bn;
    }
#undef GM_LOAD
    __syncthreads();
}

__device__ __forceinline__ void chunk_cumsum(float* A, float* tmp, int dir) {
    const int k = tidx() & 63, seg = tidx() >> 6;
    float v[8]; float run = 0.f;
    if (dir == 0) {
#pragma unroll
        for (int e = 0; e < 8; ++e) { run += A[(seg * 8 + e) * HS_ + k]; v[e] = run; }
    } else {
#pragma unroll
        for (int e = 7; e >= 0; --e) { run += A[(seg * 8 + e) * HS_ + k]; v[e] = run; }
    }
    tmp[seg * 64 + k] = run;
    __syncthreads();
    float off = 0.f;
#pragma unroll
    for (int s2 = 0; s2 < 8; ++s2) { const float tv = tmp[s2 * 64 + k]; if (dir == 0 ? (s2 < seg) : (s2 > seg)) off += tv; }
#pragma unroll
    for (int e = 0; e < 8; ++e) A[(seg * 8 + e) * HS_ + k] = (v[e] + off) * LOG2E;
    __syncthreads();
}
__device__ __forceinline__ void chunk_cumsum2(float* Af, float* Ab, float* tmp) {
    const int k = tidx() & 63, seg = tidx() >> 6;
    float vf[8], vb[8]; float rf = 0.f, rb = 0.f;
#pragma unroll
    for (int e = 0; e < 8; ++e) { rf += Af[(seg * 8 + e) * HS_ + k]; vf[e] = rf; }
#pragma unroll
    for (int e = 7; e >= 0; --e) { rb += Ab[(seg * 8 + e) * HS_ + k]; vb[e] = rb; }
    tmp[seg * 64 + k] = rf; tmp[512 + seg * 64 + k] = rb;
    __syncthreads();
    float of = 0.f, ob = 0.f;
#pragma unroll
    for (int s2 = 0; s2 < 8; ++s2) { const float tf = tmp[s2 * 64 + k], tb = tmp[512 + s2 * 64 + k]; if (s2 < seg) of += tf; if (s2 > seg) ob += tb; }
#pragma unroll
    for (int e = 0; e < 8; ++e) { Af[(seg * 8 + e) * HS_ + k] = (vf[e] + of) * LOG2E; Ab[(seg * 8 + e) * HS_ + k] = (vb[e] + ob) * LOG2E; }
    __syncthreads();
}
__device__ __forceinline__ void load_bf_tile64(float* dst, const u16* src  , size_t sstride) {
    const int t = tidx() >> 3, k8 = (tidx() & 7) * 8;
    float f[8]; unpack8(*(const uint4*)(src + (size_t)t * sstride + k8), f);
    *(float4*)(dst + t * HS_ + k8) = make_float4(f[0], f[1], f[2], f[3]); *(float4*)(dst + t * HS_ + k8 + 4) = make_float4(f[4], f[5], f[6], f[7]);
}
__device__ __forceinline__ void load_f32_tile64(float* dst, const float* src, size_t sstride) {
    const int t = tidx() >> 3, k8 = (tidx() & 7) * 8;
    *(float4*)(dst + t * HS_ + k8) = *(const float4*)(src + (size_t)t * sstride + k8); *(float4*)(dst + t * HS_ + k8 + 4) = *(const float4*)(src + (size_t)t * sstride + k8 + 4);
}

__device__ void hgrn1_item(const Params& p, const PassInfo ps, int item, unsigned char* lds) {
    unsigned char* ws = opaque(p.ws);
    const u16* PROJ = (const u16*)(ws + OFF_PROJ); const float* LOGF = (const float*)(ws + OFF_LOGF);
    u16* HL = (u16*)(ws + OFF_HL); float* HD = (float*)(ws + OFF_HD);
    const int NC = ps.T >> 6, ncsh = ps.is_ctx ? 2 : 6, c = item & (NC - 1), ci = item >> ncsh, dir = ci & 1, h = (ci >> 1) & 7, bl = ci >> 4;
    const size_t r0 = (size_t)bl * ps.T + c * 64;
    float* A = (float*)lds; float* tmp = A + 64 * HS_; u16* Wb = (u16*)(tmp + 512); u16* Ib = Wb + 64 * KVS;
    const int tid = tidx(), w = tid >> 6, lane = tid & 63, li = lane & 15, quad = lane >> 4;
    const int t = tid >> 3, k8 = (tid & 7) * 8;
    float kf[8];
    { Reg8 rg;
      const float* ap = LOGF + (r0 + t) * 1024 + dir * 512 + h * 64 + k8;
      rg.ld(0, ap); rg.ld(1, ap + 4); rg.ld(2, PJ(r0 + t, 11 + dir, h * 64 + k8)); rg.ld(3, PJ(r0 + t, 13, h * 64 + k8));
      MEMBAR();
      unpack8(rg.getu(2), kf);
      *(u32x4_*)(A + t * HS_ + k8) = rg.get(0); *(u32x4_*)(A + t * HS_ + k8 + 4) = rg.get(1);
      *(u32x4_*)(Ib + t * KVS + k8) = rg.get(3); }
    __syncthreads();
    chunk_cumsum(A, tmp, dir);
    const int lastt = dir == 0 ? 63 : 0;
    { float wv[8];
#pragma unroll
      for (int e = 0; e < 8; ++e) wv[e] = kf[e] * __builtin_amdgcn_exp2f(A[lastt * HS_ + k8 + e] - A[t * HS_ + k8 + e]);
      uint4 wq; wq.x = pack2(wv[0], wv[1]); wq.y = pack2(wv[2], wv[3]); wq.z = pack2(wv[4], wv[5]); wq.w = pack2(wv[6], wv[7]);
      *(uint4*)(Wb + t * KVS + k8) = wq;
      if (tid < 64) HD[(size_t)item * 64 + tid] = __builtin_amdgcn_exp2f(A[lastt * HS_ + tid]); }
    __syncthreads();
    {
        const int ksub = w >> 1;
        bf16x8 yf[2];
#pragma unroll
        for (int ks = 0; ks < 2; ++ks) { const u16* tp = Wb + (ks * 32 + quad * 8 + (li >> 2)) * KVS + ksub * 16 + 4 * (li & 3); yf[ks] = tr_read2(tp, tp + 4 * KVS); }
#pragma unroll
        for (int vv = 0; vv < 2; ++vv) {
            const int vsub = (w & 1) * 2 + vv;
            f32x4 a = (f32x4){0.f, 0.f, 0.f, 0.f};
#pragma unroll
            for (int ks = 0; ks < 2; ++ks) { const u16* tp = Ib + (ks * 32 + quad * 8 + (li >> 2)) * KVS + vsub * 16 + 4 * (li & 3); a = MFMA16(tr_read2(tp, tp + 4 * KVS), yf[ks], a); }
            uint2 o; o.x = pack2(a[0], a[1]); o.y = pack2(a[2], a[3]);
            *(uint2*)(HL + ((size_t)item * 64 + ksub * 16 + li) * 64 + vsub * 16 + quad * 4) = o;
        }
    }
    __syncthreads();
}

__device__ void hgrn2_all(const Params& p, const PassInfo ps, int l) {
    unsigned char* ws = opaque(p.ws);
    const unsigned* HL = (const unsigned*)(ws + OFF_HL); const float* HD = (const float*)(ws + OFF_HD); unsigned* HS = (unsigned*)(ws + OFF_HS);
    float* CST = (float*)(ws + OFF_CTXST) + (size_t)l * 256 * 4096;
    const int NC = ps.T >> 6, chains = ps.nb * 16;
    const size_t total = (size_t)chains * 2048;
    for (size_t e = (size_t)blockIdx.x * 512 + tidx(); e < total; e += (size_t)gridDim.x * 512) {
        const int ci = (int)(e >> 11), kv2 = (int)(e & 2047), k = kv2 >> 5, dir = ci & 1;
        float s0 = 0.f, s1 = 0.f;
        if (!ps.is_ctx) { const float2 cs = *(const float2*)(CST + ((size_t)ps.b0 * 16 + ci) * 4096 + 2 * kv2); s0 = cs.x; s1 = cs.y; }
#define HG2_TRIP(BLK) for (int c4 = 0; c4 < NC; c4 += BLK) { float d[BLK]; unsigned lw[BLK]; \
            _Pragma("unroll") for (int j = 0; j < BLK; ++j) { const int c = dir ? NC - 1 - (c4 + j) : c4 + j; const size_t idx = (size_t)ci * NC + c; d[j] = HD[idx * 64 + k]; lw[j] = HL[idx * 2048 + kv2]; } \
            _Pragma("unroll") for (int j = 0; j < BLK; ++j) { const int c = dir ? NC - 1 - (c4 + j) : c4 + j; const size_t idx = (size_t)ci * NC + c; \
                HS[idx * 2048 + kv2] = pack2(s0, s1); s0 = d[j] * s0 + bflo(lw[j]); s1 = d[j] * s1 + bfhi(lw[j]); } }
        if (NC == 4) { HG2_TRIP(4) } else { HG2_TRIP(16) }
#undef HG2_TRIP
        if (ps.is_ctx) *(float2*)(CST + (size_t)ci * 4096 + 2 * kv2) = make_float2(s0, s1);
    }
}

__device__ void hgrn3_item(const Params& p, const PassInfo ps, int l, int item, unsigned char* lds) {
    unsigned char* ws = opaque(p.ws);
    const u16* PROJ = (const u16*)(ws + OFF_PROJ); const float* LOGF = (const float*)(ws + OFF_LOGF); const u16* HSt = (const u16*)(ws + OFF_HS);
    u16* Y3 = (u16*)(ws + OFF_Y) + (size_t)3 * MLAT * 512;
    const int NC = ps.T >> 6, ncsh = ps.is_ctx ? 2 : 6, c = item & (NC - 1), bh = item >> ncsh, h = bh & 7, bl = bh >> 3;
    const size_t r0 = (size_t)bl * ps.T + c * 64;
    const size_t idxf = (size_t)(bh * 2 + 0) * NC + c, idxb = (size_t)(bh * 2 + 1) * NC + c;
    float* Q = (float*)lds; float* KKf = Q + 64 * HS_; float* KKb = KKf + 64 * HS_; float* Af = KKb + 64 * HS_; float* Ab = Af + 64 * HS_; float* tmp = Ab + 64 * HS_;
    u16* Ib = (u16*)(tmp + 1024); u16* Sfb = Ib + 64 * KVS; u16* Sbb = Sfb + 64 * KVS; float* comb = (float*)(Sbb + 64 * KVS);
    const int tid = tidx(), w = tid >> 6, lane = tid & 63, li = lane & 15, quad = lane >> 4;
    { const int t = tid >> 3, k8 = (tid & 7) * 8;
      Reg8 ra, rb;
      const float* ap = LOGF + (r0 + t) * 1024 + h * 64 + k8;
      const u16* sf = HSt + idxf * 4096 + t * 64 + k8; const u16* sb = HSt + idxb * 4096 + t * 64 + k8;
      ra.ld(0, PJ(r0 + t, 10, h * 64 + k8)); ra.ld(1, PJ(r0 + t, 11, h * 64 + k8)); ra.ld(2, PJ(r0 + t, 12, h * 64 + k8)); ra.ld(3, PJ(r0 + t, 13, h * 64 + k8));
      ra.ld(4, ap); ra.ld(5, ap + 4); ra.ld(6, ap + 512); ra.ld(7, ap + 516);
      rb.ld(0, sf); rb.ld(1, sb);
      MEMBAR();
      float x[8];
      unpack8(ra.getu(0), x); *(float4*)(Q + t * HS_ + k8) = make_float4(x[0], x[1], x[2], x[3]); *(float4*)(Q + t * HS_ + k8 + 4) = make_float4(x[4], x[5], x[6], x[7]);
      unpack8(ra.getu(1), x); *(float4*)(KKf + t * HS_ + k8) = make_float4(x[0], x[1], x[2], x[3]); *(float4*)(KKf + t * HS_ + k8 + 4) = make_float4(x[4], x[5], x[6], x[7]);
      unpack8(ra.getu(2), x); *(float4*)(KKb + t * HS_ + k8) = make_float4(x[0], x[1], x[2], x[3]); *(float4*)(KKb + t * HS_ + k8 + 4) = make_float4(x[4], x[5], x[6], x[7]);
      *(u32x4_*)(Ib + t * KVS + k8) = ra.get(3);
      *(u32x4_*)(Af + t * HS_ + k8) = ra.get(4); *(u32x4_*)(Af + t * HS_ + k8 + 4) = ra.get(5); *(u32x4_*)(Ab + t * HS_ + k8) = ra.get(6); *(u32x4_*)(Ab + t * HS_ + k8 + 4) = ra.get(7);
      *(u32x4_*)(Sfb + t * KVS + k8) = rb.get(0); *(u32x4_*)(Sbb + t * KVS + k8) = rb.get(1); }
    __syncthreads();
    chunk_cumsum2(Af, Ab, tmp);
    const int dir = w >> 2, T = w & 3;
    const float* A = dir ? Ab : Af; const float* KK = dir ? KKb : KKf; const u16* Sb16 = dir ? Sbb : Sfb;
    const int t = 16 * T + li;
    const int rrow = dir ? 16 * T + 16 : 16 * T - 1; const bool rzero = dir ? (T == 3) : (T == 0);
    bf16x8 qt[2], qh[2];
    float Rv[2][8];
#pragma unroll
    for (int ks = 0; ks < 2; ++ks) {
        const int k0 = ks * 32 + quad * 8;
        float qv[8], av[8];
        { const float4 x0 = *(const float4*)(Q + t * HS_ + k0), x1 = *(const float4*)(Q + t * HS_ + k0 + 4); qv[0] = x0.x; qv[1] = x0.y; qv[2] = x0.z; qv[3] = x0.w; qv[4] = x1.x; qv[5] = x1.y; qv[6] = x1.z; qv[7] = x1.w; }
        { const float4 x0 = *(const float4*)(A + t * HS_ + k0), x1 = *(const float4*)(A + t * HS_ + k0 + 4); av[0] = x0.x; av[1] = x0.y; av[2] = x0.z; av[3] = x0.w; av[4] = x1.x; av[5] = x1.y; av[6] = x1.z; av[7] = x1.w; }
        if (rzero) {
#pragma unroll
            for (int e = 0; e < 8; ++e) Rv[ks][e] = 0.f;
        } else { const float4 x0 = *(const float4*)(A + rrow * HS_ + k0), x1 = *(const float4*)(A + rrow * HS_ + k0 + 4); Rv[ks][0] = x0.x; Rv[ks][1] = x0.y; Rv[ks][2] = x0.z; Rv[ks][3] = x0.w; Rv[ks][4] = x1.x; Rv[ks][5] = x1.y; Rv[ks][6] = x1.z; Rv[ks][7] = x1.w; }
        float a_[8], b_[8];
#pragma unroll
        for (int e = 0; e < 8; ++e) { a_[e] = qv[e] * __builtin_amdgcn_exp2f(av[e] - Rv[ks][e]); b_[e] = qv[e] * __builtin_amdgcn_exp2f(av[e]); }
        const unsigned a0 = pack2(a_[0], a_[1]), a1 = pack2(a_[2], a_[3]), a2 = pack2(a_[4], a_[5]), a3 = pack2(a_[6], a_[7]);
        const unsigned b0 = pack2(b_[0], b_[1]), b1 = pack2(b_[2], b_[3]), b2 = pack2(b_[4], b_[5]), b3 = pack2(b_[6], b_[7]);
        qt[ks] = (bf16x8){(short)(a0 & 0xffff), (short)(a0 >> 16), (short)(a1 & 0xffff), (short)(a1 >> 16), (short)(a2 & 0xffff), (short)(a2 >> 16), (short)(a3 & 0xffff), (short)(a3 >> 16)};
        qh[ks] = (bf16x8){(short)(b0 & 0xffff), (short)(b0 >> 16), (short)(b1 & 0xffff), (short)(b1 >> 16), (short)(b2 & 0xffff), (short)(b2 >> 16), (short)(b3 & 0xffff), (short)(b3 >> 16)};
    }
    const int nS = dir ? 4 - T : T + 1;
    float sc[4][4];
#pragma unroll
    for (int i = 0; i < 4; ++i) {
        if (i < nS) {
            const int S = dir ? T + i : i, srow = 16 * S + li;
            f32x4 a = (f32x4){0.f, 0.f, 0.f, 0.f};
#pragma unroll
            for (int ks = 0; ks < 2; ++ks) {
                const int k0 = ks * 32 + quad * 8;
                const float4 x0 = *(const float4*)(KK + srow * HS_ + k0), x1 = *(const float4*)(KK + srow * HS_ + k0 + 4);
                const float4 y0 = *(const float4*)(A + srow * HS_ + k0), y1 = *(const float4*)(A + srow * HS_ + k0 + 4);
                const float kv[8] = {x0.x, x0.y, x0.z, x0.w, x1.x, x1.y, x1.z, x1.w}, as[8] = {y0.x, y0.y, y0.z, y0.w, y1.x, y1.y, y1.z, y1.w};
                float c_[8];
#pragma unroll
                for (int e = 0; e < 8; ++e) c_[e] = kv[e] * __builtin_amdgcn_exp2f(Rv[ks][e] - as[e]);
                const unsigned c0 = pack2(c_[0], c_[1]), c1 = pack2(c_[2], c_[3]), c2 = pack2(c_[4], c_[5]), c3 = pack2(c_[6], c_[7]);
                const bf16x8 kf = (bf16x8){(short)(c0 & 0xffff), (short)(c0 >> 16), (short)(c1 & 0xffff), (short)(c1 >> 16), (short)(c2 & 0xffff), (short)(c2 >> 16), (short)(c3 & 0xffff), (short)(c3 >> 16)};
                a = MFMA16(kf, qt[ks], a);
            }
            const bool diag = (S == T);
#pragma unroll
            for (int j = 0; j < 4; ++j) { const int sl = quad * 4 + j; const bool keep = !diag || (dir ? (sl >= li) : (sl <= li)); sc[i][j] = keep ? a[j] : 0.f; }
        } else {
#pragma unroll
            for (int j = 0; j < 4; ++j) sc[i][j] = 0.f;
        }
    }
    f32x4 O[4];
#pragma unroll
    for (int v = 0; v < 4; ++v) O[v] = (f32x4){0.f, 0.f, 0.f, 0.f};
#pragma unroll
    for (int pr = 0; pr < 2; ++pr) {
        if (2 * pr < nS) {
            const unsigned a0 = pack2(sc[2 * pr][0], sc[2 * pr][1]), a1 = pack2(sc[2 * pr][2], sc[2 * pr][3]), b0 = pack2(sc[2 * pr + 1][0], sc[2 * pr + 1][1]), b1 = pack2(sc[2 * pr + 1][2], sc[2 * pr + 1][3]);
            const bf16x8 pf = (bf16x8){(short)(a0 & 0xffff), (short)(a0 >> 16), (short)(a1 & 0xffff), (short)(a1 >> 16), (short)(b0 & 0xffff), (short)(b0 >> 16), (short)(b1 & 0xffff), (short)(b1 >> 16)};
            const int S0 = dir ? T + 2 * pr : 2 * pr; int S1 = S0 + 1; if (S1 > 3) S1 = 3;
            const u16* p0 = Ib + (16 * S0 + quad * 4 + (li >> 2)) * KVS + 4 * (li & 3);
            const u16* p1 = Ib + (16 * S1 + quad * 4 + (li >> 2)) * KVS + 4 * (li & 3);
#pragma unroll
            for (int v = 0; v < 4; ++v) O[v] = MFMA16(tr_read2(p0 + v * 16, p1 + v * 16), pf, O[v]);
        }
    }
#pragma unroll
    for (int ks = 0; ks < 2; ++ks) {
        const u16* p0 = Sb16 + (ks * 32 + quad * 8 + (li >> 2)) * KVS + 4 * (li & 3);
#pragma unroll
        for (int v = 0; v < 4; ++v) O[v] = MFMA16(tr_read2(p0 + v * 16, p0 + 4 * KVS + v * 16), qh[ks], O[v]);
    }
    if (dir == 1) {
#pragma unroll
        for (int v = 0; v < 4; ++v)
#pragma unroll
            for (int j = 0; j < 4; ++j) comb[(T * 16 + v * 4 + j) * 64 + lane] = O[v][j];
    }
    __syncthreads();
    if (dir == 0) {
        float ss = 0.f;
#pragma unroll
        for (int v = 0; v < 4; ++v)
#pragma unroll
            for (int j = 0; j < 4; ++j) { O[v][j] += comb[(T * 16 + v * 4 + j) * 64 + lane]; ss += O[v][j] * O[v][j]; }
        ss += shx(ss, 16); ss += shx(ss, 32);
        const float rstd = rsqrtf(ss * (1.f / 64.f) + EPSN);
        const size_t row = r0 + t;
#pragma unroll
        for (int v = 0; v < 4; ++v) {
            const int col = h * 64 + v * 16 + quad * 4;
            const float4 gn = *(const float4*)(p.hgrn_g + l * 512 + col);
            const uint2 g = *(const uint2*)(PJ(row, 14, col));
            uint2 wv; wv.x = pack2(O[v][0] * rstd * gn.x * siluf_(bflo(g.x)), O[v][1] * rstd * gn.y * siluf_(bfhi(g.x))); wv.y = pack2(O[v][2] * rstd * gn.z * siluf_(bflo(g.y)), O[v][3] * rstd * gn.w * siluf_(bfhi(g.y)));
            *(uint2*)(Y3 + row * 512 + col) = wv;
        }
    }
    __syncthreads();
}
#define XB_TMO      128
#define XB_XCNT(j)  (256  + 64 * (j))
#define XB_XSUB(j)  (1280 + 64 * (j))
#define XB_XGEN(j)  (2304 + 64 * (j))
#define XB_TOP      3328
#define XB_TOPGEN   3392
#define XCD_BAR_WORDS 3456
#define XB_SPIN_CAP (1u << 18)

__device__ __forceinline__ unsigned xb_ld(unsigned* p)              { return __hip_atomic_load(p, __ATOMIC_RELAXED, __HIP_MEMORY_SCOPE_AGENT); }
__device__ __forceinline__ unsigned xb_add(unsigned* p, unsigned v) { return __hip_atomic_fetch_add(p, v, __ATOMIC_RELAXED, __HIP_MEMORY_SCOPE_AGENT); }
__device__ __forceinline__ unsigned xb_xcc_id() { return (unsigned)__builtin_amdgcn_s_getreg((3 << 11) | 20) & 0xFu; }
#define XB_SPIN(cond, bar) do { unsigned _sp = 0; while (cond) { __builtin_amdgcn_s_sleep(1); \
    if ((++_sp & 255u) == 0u) { if (xb_ld(&(bar)[XB_TMO])) break; if (_sp > XB_SPIN_CAP) { atomicAdd(&(bar)[XB_TMO], 1u); break; } } } } while (0)

struct XcdBarrier {
    unsigned* bar; unsigned x;
    volatile LAS unsigned* st;
};

__device__ __forceinline__ XcdBarrier xcd_barrier_post(unsigned* bar, volatile LAS unsigned* st) {
    XcdBarrier b; b.bar = bar; b.x = xb_xcc_id(); b.st = st;
    if (tidx() == 0) (void)xb_add(&bar[XB_XCNT(b.x)], 1u);
    return b;
}
__device__ __forceinline__ void xcd_barrier_complete(unsigned* bar, unsigned x, unsigned& nloc, unsigned& nx) {
    const unsigned G = gridDim.x * gridDim.y * gridDim.z;
    unsigned sum, cnt, mine, sp = 0u;
    for (;;) {
        sum = 0u; cnt = 0u; mine = 0u;
#pragma unroll
        for (unsigned j = 0; j < 16; ++j) { const unsigned c = xb_ld(&bar[XB_XCNT(j)]); sum += c; cnt += (c > 0u) ? 1u : 0u; mine = (j == x) ? c : mine; }
        if (sum == G) break;
        __builtin_amdgcn_s_sleep(1);
        if ((++sp & 255u) == 0u) { if (xb_ld(&bar[XB_TMO])) break; if (sp > XB_SPIN_CAP) { atomicAdd(&bar[XB_TMO], 1u); break; } }
    }
    nloc = mine > 0u ? mine : 1u; nx = cnt > 0u ? cnt : 1u;
}

__device__ __forceinline__ void xcd_barrier(const XcdBarrier& b) {
    asm volatile("s_waitcnt vmcnt(0)" ::: "memory");
    __syncthreads();
    if (tidx() == 0) {
        unsigned* bar = b.bar;
        __builtin_amdgcn_s_waitcnt(0);
        unsigned nloc = b.st[0], nx = b.st[1];
        if (nloc == 0u) { xcd_barrier_complete(bar, b.x, nloc, nx); b.st[0] = nloc; b.st[1] = nx; }
        const unsigned old = xb_add(&bar[XB_XSUB(b.x)], 1u);
        const unsigned gen = old / nloc;
        if (old + 1u == (gen + 1u) * nloc) {
            __builtin_amdgcn_fence(__ATOMIC_RELEASE, "agent");
            asm volatile("s_waitcnt vmcnt(0)" ::: "memory");
            const unsigned og = xb_add(&bar[XB_TOP], 1u);
            const unsigned tg = og / nx;
            if (og + 1u == (tg + 1u) * nx) xb_add(&bar[XB_TOPGEN], 1u);
            else XB_SPIN(xb_ld(&bar[XB_TOPGEN]) == tg, bar);
            __builtin_amdgcn_fence(__ATOMIC_ACQUIRE, "agent");
            xb_add(&bar[XB_XGEN(b.x)], 1u);
            asm volatile("s_waitcnt vmcnt(0)" ::: "memory");
        } else {
            XB_SPIN(xb_ld(&bar[XB_XGEN(b.x)]) == gen, bar);
            __builtin_amdgcn_fence(__ATOMIC_ACQUIRE, "agent");
            asm volatile("s_waitcnt vmcnt(0)" ::: "memory");
        }
    }
    __syncthreads();
}

#ifndef STAG_B
#define STAG_B 240
#endif
#ifndef STAG_D
#define STAG_D 300
#endif
#ifndef REP_ATTN
#define REP_ATTN 1
#endif
#ifndef REP_B
#define REP_B 1
#endif
#ifndef REP_C1
#define REP_C1 1
#endif
#ifndef REP_C2
#define REP_C2 1
#endif
#ifndef REP_C3
#define REP_C3 1
#endif
#ifndef REP_DE
#define REP_DE 1
#endif
__device__ __forceinline__ void stagger(int ticks_per_slot) {
    const int slot = ((int)blockIdx.x >> 3) & 7;
    if (slot) { const unsigned long long t0 = __builtin_amdgcn_s_memrealtime(), dt = (unsigned long long)(slot * ticks_per_slot);
        while (__builtin_amdgcn_s_memrealtime() - t0 < dt) __builtin_amdgcn_s_sleep(4); }
}
template <class Epi> __device__ __forceinline__ void run_gemm(LAS unsigned char* lds, const u16* A, const u16* Bt, int M, int N, int K, const Epi& E) {
    pg8::Gemm g; g.A = A; g.Bt = Bt; g.M = M; g.N = N; g.K = K; g.rsA = 0; g.rsB = 0;
    pg8::StaticOrder S; S.init(M, N, (int)gridDim.x, (int)blockIdx.x);
    pg8::gemm_phase<Epi, pg8::StaticOrder, false>(lds, g, S, E, nullptr);
}


struct EpiNull {
    static constexpr bool PERM = true, AFTER_DRAIN = false;
    unsigned char* ws;
    __device__ __forceinline__ void operator()(const f32x4 (&acc)[2][2][4][2], const Unit& u, int wr, int wc, int fr, int fq) const {
        if (ws == nullptr) {
#pragma unroll
            for (int ai = 0; ai < 2; ++ai)
#pragma unroll
                for (int bj = 0; bj < 2; ++bj)
#pragma unroll
                    for (int m = 0; m < 4; ++m)
#pragma unroll
                        for (int n = 0; n < 2; ++n) *(f32x4*)(ws + (size_t)(((ai * 2 + bj) * 4 + m) * 2 + n) * 16 + fr * 1024 + fq * 65536 + wr * 4096 + wc * 16384 + u.pm) = acc[ai][bj][m][n];
        }
    }
};
struct MergeOrder : pg8::StaticOrder {
    __device__ bool next(int i, Unit& u) const { if (!pg8::StaticOrder::next(i >> 2, u)) return false; u.r = i & 3; return true; }
};
__device__ __forceinline__ Params KP() {
    auto q0 = __builtin_amdgcn_kernarg_segment_ptr();
    asm volatile("" : "+s"(q0));
    const __attribute__((address_space(4))) Params* q = (const __attribute__((address_space(4))) Params*)q0;
    Params r;
    r.x = q->x; r.c = q->c; r.ctx = q->ctx; r.c_ctx = q->c_ctx; r.w_ada = q->w_ada; r.b_ada = q->b_ada; r.g_pre = q->g_pre; r.g_post = q->g_post; r.w_in = q->w_in; r.rpb = q->rpb;
    r.fnet_w = q->fnet_w; r.gmlp_g = q->gmlp_g; r.gmlp_ws = q->gmlp_ws; r.gmlp_bs = q->gmlp_bs; r.lb_logits = q->lb_logits; r.hgrn_g = q->hgrn_g; r.w_branch = q->w_branch; r.w_out = q->w_out;
    r.out = q->out; r.ws = q->ws; return r;
}
constexpr size_t OFF_BAR = WS_END;
constexpr size_t WS_END2 = WS_END + (size_t)XCD_BAR_WORDS * 4;
__device__ __forceinline__ void gsync(LAS unsigned char* lds3) {
    XcdBarrier b; b.bar = (unsigned*)(opaque(KP().ws) + OFF_BAR); b.x = xb_xcc_id(); b.st = (volatile LAS unsigned*)(lds3 + LDS_BYTES);
    xcd_barrier(b);
}
__global__ void __launch_bounds__(512, 2) mega_fwd(Params p_unused) {
    extern __shared__ __attribute__((aligned(16))) unsigned char shm[];
    LAS unsigned char* lds3 = (LAS unsigned char*)shm;
    {
        if (tidx() < 4) ((volatile LAS unsigned*)(lds3 + LDS_BYTES))[tidx()] = 0u;
        if (blockIdx.x == 0) { unsigned* bar = (unsigned*)(opaque(KP().ws) + OFF_BAR); for (int i = tidx(); i < XCD_BAR_WORDS; i += 512) bar[i] = 0u; }
        __syncthreads();
    }
    prep1(KP(), shm);
    cg::this_grid().sync();
    { XcdBarrier b0 = xcd_barrier_post((unsigned*)(opaque(KP().ws) + OFF_BAR), (volatile LAS unsigned*)(lds3 + LDS_BYTES)); (void)b0; }
    prep2(KP(), shm);
    gsync(lds3);
#pragma nounroll
    for (int pass = 0; pass < 1 + NBATCH / GB; ++pass) {
        PassInfo ps;
        if (pass == 0) { ps.is_ctx = 1; ps.nb = NBATCH; ps.T = CTXL; ps.M = MCTX; ps.b0 = 0; }
        else { ps.is_ctx = 0; ps.nb = GB; ps.T = SEQ; ps.M = MLAT; ps.b0 = (pass - 1) * GB; }
        const int NC = ps.T >> 6;
#pragma nounroll
        for (int l = 0; l < DEPTH; ++l) {
            phase_norm(KP(), ps, l);
            gsync(lds3);
            _Pragma("nounroll") for (int rep = 0; rep < REP_B; ++rep) {
                unsigned char* ws = opaque(KP().ws);
                EpiProj E; E.ws = ws; E.l = l; E.is_ctx = ps.is_ctx;

                run_gemm(lds3, (const u16*)(ws + OFF_H), (const u16*)(ws + OFF_WTIN) + (size_t)l * NPROJ * DM, ps.M, NPROJ, DM, E);
                gsync(lds3);
#ifdef PROBE_NULL_B
                { EpiNull EN; EN.ws = ws; run_gemm(lds3, (const u16*)(ws + OFF_H), (const u16*)(ws + OFF_WTIN) + (size_t)l * NPROJ * DM, ps.M, NPROJ, DM, EN); gsync(lds3); }
#endif
            }
            const bool full = !(ps.is_ctx && l == DEPTH - 1);
            _Pragma("nounroll") for (int rep = 0; rep < REP_C1; ++rep) {
                const int n_h1 = ps.nb * 16 * NC, n_at = full ? ps.nb * 8 * (ps.T >> 6) : 0, n_f1 = ps.is_ctx ? 0 : ps.nb * 64, n_g = full ? (ps.M >> 7) : 0;
                for (int it = blockIdx.x; it < n_h1 + n_at + n_f1 + n_g; it += gridDim.x) {
                    if (it < n_h1) hgrn1_item(KP(), ps, it, shm);
                    else if (it < n_h1 + n_at) { _Pragma("nounroll") for (int r2 = 0; r2 < REP_ATTN; ++r2) attn_item(KP(), ps, l, it - n_h1, shm); }
                    else if (it < n_h1 + n_at + n_f1) four1_item(KP(), it - n_h1 - n_at, shm);
                    else gmlp_item(KP(), l, it - n_h1 - n_at - n_f1, shm);
                }
                gsync(lds3);
            }
            _Pragma("nounroll") for (int rep = 0; rep < REP_C2; ++rep) {
                hgrn2_all(KP(), ps, l);
                if (full) {
                    const int n_f2 = ps.is_ctx ? ps.nb * 4 : ps.nb * 64;
                    for (int it = blockIdx.x; it < n_f2; it += gridDim.x) { if (ps.is_ctx) fourc_item(KP(), it, shm); else four2_item(KP(), it, shm); }
                }
                gsync(lds3);
            }
            if (!full) continue;
            _Pragma("nounroll") for (int rep = 0; rep < REP_C3; ++rep) {
                const int n_h3 = ps.nb * 8 * NC;
                for (int it = blockIdx.x; it < n_h3; it += gridDim.x) hgrn3_item(KP(), ps, l, it, shm);
                gsync(lds3);
            }
            _Pragma("nounroll") for (int rep = 0; rep < REP_DE; ++rep) {
            {
                unsigned char* ws = opaque(KP().ws);
                pg8::Gemm g; g.A = (const u16*)(ws + OFF_Y); g.Bt = (const u16*)(ws + OFF_WTBR) + (size_t)l * 4 * 1024 * 512; g.M = ps.M; g.N = 1024; g.K = 512;
                g.rsA = (size_t)MLAT * 512 * 2; g.rsB = (size_t)1024 * 512 * 2;
                MergeOrder S; S.init(ps.M, 1024, (int)gridDim.x, (int)blockIdx.x);
                EpiMerge E; E.ws = ws;

                pg8::gemm_phase<EpiMerge, MergeOrder, false>(lds3, g, S, E, nullptr);
            }
            gsync(lds3);
            if (REP_DE > 1 && rep + 1 < REP_DE) continue;
            {
                unsigned char* ws = opaque(KP().ws);
                EpiOut E; E.C = (u16*)(ws + OFF_OUT);
                run_gemm(lds3, (const u16*)(ws + OFF_MB), (const u16*)(ws + OFF_WTOUT) + (size_t)l * 1024 * 1024, ps.M, 1024, 1024, E);
            }
            gsync(lds3);
            }
        }
        if (!ps.is_ctx) phase_norm(KP(), ps, DEPTH);
    }
}

static_assert(WS_END2 <= (size_t)1073741824, "workspace map exceeds 1 GiB");

extern "C" void kernel_launch(void* const* d_in, const int* in_sizes, int n_in, void* d_out, int out_size, void* d_ws, size_t ws_size, hipStream_t stream) {
    static int grid_blocks = 0;
    if (grid_blocks == 0) {
        if (n_in != 18 || ws_size < WS_END2) { fprintf(stderr, "kernel_launch: unexpected n_in %d or ws_size %zu (need %zu)\n", n_in, ws_size, (size_t)WS_END2); grid_blocks = -1; return; }
        int dev = 0, cus = 0, per_cu = 0;
        hipGetDevice(&dev);
        hipDeviceGetAttribute(&cus, hipDeviceAttributeMultiprocessorCount, dev);
        if (hipFuncSetAttribute((const void*)mega_fwd, hipFuncAttributeMaxDynamicSharedMemorySize, LDS_BYTES + 16) != hipSuccess) { fprintf(stderr, "kernel_launch: hipFuncSetAttribute failed\n"); grid_blocks = -1; return; }
        hipOccupancyMaxActiveBlocksPerMultiprocessor(&per_cu, (const void*)mega_fwd, 512, LDS_BYTES + 16);
        if (per_cu < 1) { fprintf(stderr, "kernel_launch: occupancy query gave %d\n", per_cu); per_cu = 1; }
        (void)hipGetLastError();
        grid_blocks = cus * per_cu;
    }
    if (grid_blocks < 0) return;
    Params p{};
    const float** pp = (const float**)&p;
    for (int i = 0; i < 18; ++i) pp[i] = (const float*)d_in[i];
    p.out = (float*)d_out; p.ws = (unsigned char*)d_ws;
    void* args[] = {&p};
    hipError_t e = hipLaunchCooperativeKernel((const void*)mega_fwd, dim3(grid_blocks), dim3(512), args, LDS_BYTES + 16, stream);
    if (e != hipSuccess) fprintf(stderr, "cooperative launch failed: %s (grid %d)\n", hipGetErrorString(e), grid_blocks);
}
```

```cpp
#include <hip/hip_runtime.h>
#include <hip/hip_cooperative_groups.h>
#include <cstdio>
namespace cg = cooperative_groups;
__device__ __forceinline__ int tidx() { int t = threadIdx.x; asm volatile("" : "+v"(t)); return t; }
template <class T> __device__ __forceinline__ T* opaque(T* p) {
    unsigned long long v = (unsigned long long)p; const unsigned lo = __builtin_amdgcn_readfirstlane((unsigned)v), hi = __builtin_amdgcn_readfirstlane((unsigned)(v >> 32));
    v = ((unsigned long long)hi << 32) | lo; asm volatile("" : "+s"(v)); return (T*)((__attribute__((address_space(1))) T*)v); }
__device__ __forceinline__ float shx(float v, int m) { const int lane = tidx() & 63; return __int_as_float(__builtin_amdgcn_ds_bpermute((lane ^ m) << 2, __float_as_int(v))); }
namespace pg8 {
#define PG8_LAS __attribute__((address_space(3)))
typedef unsigned short bf16_t;
typedef short bf16x8 __attribute__((ext_vector_type(8)));
typedef float f32x4 __attribute__((ext_vector_type(4)));
typedef unsigned u32x4 __attribute__((ext_vector_type(4)));
constexpr int BM = 256, BK = 64, HALF = 128, HTB = HALF * BK * 2  , STAGE_BYTES = 8 * HTB, NXCD = 8, WGM = 8;

__host__ __device__ __forceinline__ int lds_byte(int r, int c) { const int st = (r >> 4) * 2 + (c >> 5), rr = r & 15, cc = c & 31, ob = rr * 64 + cc * 2; return st * 1024 + (ob ^ (((ob >> 9) & 1) << 5)); }
__host__ __device__ __forceinline__ void stage_rc(int b, int& R, int& C) { const int st = b / 1024, sb = b % 1024, swz = sb ^ (((sb >> 9) & 1) << 5); R = (st >> 1) * 16 + swz / 64; C = (st & 1) * 32 + (swz % 64) / 2; }
__host__ __device__ __forceinline__ int perm32(int rho) { const int n = rho >> 4, i = rho & 15; return 8 * (i >> 2) + 4 * n + (i & 3); }

struct Unit { int pm, pn, r; };
struct Gemm { const bf16_t* A; const bf16_t* Bt; int M, N, K; size_t rsA, rsB; };

struct StaticOrder {
    int nM, nN, nwg, G, c;
    __host__ __device__ void init(int M, int N, int G_, int c_) { nM = M / BM; nN = N / BM; nwg = nM * nN; G = G_; c = c_; }
    __host__ __device__ bool next(int i, Unit& u) const {
        const long L = (long)i * G + c; if (L >= nwg) return false;
        int wgid = (int)L; { const int q = nwg / NXCD, r = nwg % NXCD, xcd = wgid % NXCD, off = wgid / NXCD; wgid = (xcd < r ? xcd * (q + 1) : r * (q + 1) + (xcd - r) * q) + off; }
        const int nig = WGM * nN, gid = wgid / nig, fm = gid * WGM, gsz = (nM - fm) < WGM ? (nM - fm) : WGM;
        u.pm = fm + ((wgid % nig) % gsz); u.pn = (wgid % nig) / gsz; u.r = 0; return true;
    }
    __device__ __forceinline__ void a_ready(const Unit&) const {}
    __device__ __forceinline__ void done(const Unit&) const {}
};
__device__ __forceinline__ unsigned cvt_pk_bf16(float lo, float hi) { unsigned r; asm volatile("v_cvt_pk_bf16_f32 %0, %1, %2" : "=v"(r) : "v"(lo), "v"(hi)); return r; }

template <class Epi, class Sched, bool STAMP = false>
__device__ __forceinline__ void gemm_phase(PG8_LAS unsigned char* lds, const Gemm g, const Sched& S, const Epi& E, unsigned long long* stamps) {
    const int tid = tidx(), wid = __builtin_amdgcn_readfirstlane(tid >> 6), lane = tid & 63, wr = wid >> 2, wc = wid & 3, fr = lane & 15, fq = lane >> 4;
    const int K = g.K, nt = K / BK;
    int ts_lo = 0, ts_hi = 0, nts = 0; const unsigned long long rt_entry = STAMP ? (unsigned long long)wall_clock64() : 0ull;
#define PG8_STAMP() do { if (STAMP && wid == 0 && nts < 64) { const unsigned long long _c = (unsigned long long)clock64(); \
        ts_lo = (lane == nts) ? (int)(unsigned)_c : ts_lo; ts_hi = (lane == nts) ? (int)(unsigned)(_c >> 32) : ts_hi; ++nts; } } while (0)
    PG8_STAMP();
    unsigned voffA[2], voffB[2];
#pragma unroll
    for (int i = 0; i < 2; ++i) { int R, C; stage_rc(tid * 16 + i * 8192, R, C); const int Rb = Epi::PERM ? ((R & ~31) + perm32(R & 31)) : R;
        voffA[i] = (unsigned)(R * K + C) * 2u; voffB[i] = (unsigned)(Rb * K + C) * 2u; }
    const size_t kstep = (size_t)(BK * 2);
    const size_t hstep = (size_t)HALF * K * 2;
    const size_t tstep = 2 * hstep;
    const unsigned ldsw = (unsigned)wid * 1024u;
    const int aoff = lds_byte(wr * 64 + fr, fq * 8), boff = lds_byte(wc * 32 + fr, fq * 8);
#define PG8_SA(b, h) (((b) * 2 + (h)) * HTB)
#define PG8_SB(b, h) ((4 + (b) * 2 + (h)) * HTB)
#define PG8_STAGE(bufoff, gbase, voff) do { _Pragma("unroll") for (int _i = 0; _i < 2; ++_i) \
        __builtin_amdgcn_global_load_lds((const unsigned*)((const char*)(gbase) + (voff)[_i]), (PG8_LAS unsigned*)(lds + (bufoff) + ldsw + _i * 8192), 16, 0, 0); } while (0)
#define PG8_LDA(dst, b, h) do { _Pragma("unroll") for (int m = 0; m < 4; ++m) _Pragma("unroll") for (int k = 0; k < 2; ++k) dst[m][k] = *(const PG8_LAS bf16x8*)(lds + PG8_SA(b, h) + aoff + m * 2048 + k * 1024); } while (0)
#define PG8_LDB(dst, b, h) do { _Pragma("unroll") for (int n = 0; n < 2; ++n) _Pragma("unroll") for (int k = 0; k < 2; ++k) dst[n][k] = *(const PG8_LAS bf16x8*)(lds + PG8_SB(b, h) + boff + n * 2048 + k * 1024); } while (0)
#define PG8_MMA(ai, bj, At, Bt) do { __builtin_amdgcn_s_setprio(1); _Pragma("unroll") for (int m = 0; m < 4; ++m) _Pragma("unroll") for (int n = 0; n < 2; ++n) _Pragma("unroll") for (int k = 0; k < 2; ++k) \
        acc[ai][bj][m][n] = __builtin_amdgcn_mfma_f32_16x16x32_bf16(Bt[n][k], At[m][k], acc[ai][bj][m][n], 0, 0, 0); __builtin_amdgcn_s_setprio(0); } while (0)
#define PG8_WAIT_V(n) asm volatile("s_waitcnt vmcnt(" #n ")" ::: "memory")
#define PG8_WAIT_L(n) asm volatile("s_waitcnt lgkmcnt(" #n ")" ::: "memory")
#define PG8_BAR __builtin_amdgcn_s_barrier()
#define PG8_SCHED __builtin_amdgcn_sched_barrier(0)
    Unit cur, nxt; int ui = 0;
    if (!S.next(0, cur)) return;
    f32x4 acc[2][2][4][2];
#pragma unroll
    for (int a = 0; a < 2; ++a)
#pragma unroll
        for (int b = 0; b < 2; ++b)
#pragma unroll
            for (int m = 0; m < 4; ++m)
#pragma unroll
                for (int n = 0; n < 2; ++n) acc[a][b][m][n] = (f32x4){0.f, 0.f, 0.f, 0.f};
    bf16x8 At[4][2], B0[2][2], B1[2][2];
    const char* cA = (const char*)g.A + (size_t)cur.pm * tstep + (size_t)cur.r * g.rsA; const char* cB = (const char*)g.Bt + (size_t)cur.pn * tstep + (size_t)cur.r * g.rsB;
    S.a_ready(cur);
    PG8_STAGE(PG8_SB(0, 0), cB, voffB); PG8_STAGE(PG8_SA(0, 0), cA, voffA); PG8_STAGE(PG8_SB(0, 1), cB + hstep, voffB); PG8_STAGE(PG8_SA(0, 1), cA + hstep, voffA);
    if (wr == 1) PG8_BAR;
    PG8_WAIT_V(4); PG8_BAR;
    PG8_STAGE(PG8_SB(1, 0), cB + kstep, voffB); PG8_STAGE(PG8_SA(1, 0), cA + kstep, voffA); PG8_STAGE(PG8_SB(1, 1), cB + hstep + kstep, voffB);
    PG8_WAIT_V(6); PG8_BAR;
    PG8_STAMP();
    for (;;) {
        const bool has_next = S.next(ui + 1, nxt);
        const char* nA = has_next ? (const char*)g.A + (size_t)nxt.pm * tstep + (size_t)nxt.r * g.rsA : cA; const char* nB = has_next ? (const char*)g.Bt + (size_t)nxt.pn * tstep + (size_t)nxt.r * g.rsB : cB;
        for (int t = 0; t < nt; t += 2) {
            const bool last = (t == nt - 2);
            const char* a1 = cA + (size_t)(t + 1) * kstep;
            const char* a2 = last ? nA : cA + (size_t)(t + 2) * kstep; const char* b2 = last ? nB : cB + (size_t)(t + 2) * kstep;
            const char* a3 = a2 + kstep; const char* b3 = b2 + kstep;
            if (last && has_next) S.a_ready(nxt);
            PG8_LDB(B0, 0, 0); PG8_SCHED; PG8_LDA(At, 0, 0); PG8_STAGE(PG8_SA(1, 1), a1 + hstep, voffA);
            PG8_WAIT_L(8); PG8_BAR; PG8_WAIT_L(0); PG8_MMA(0, 0, At, B0); PG8_BAR; PG8_SCHED;
            PG8_LDB(B1, 0, 1); PG8_STAGE(PG8_SB(0, 0), b2, voffB);
            PG8_BAR; PG8_WAIT_L(0); PG8_MMA(0, 1, At, B1); PG8_BAR;
            PG8_LDA(At, 0, 1); PG8_STAGE(PG8_SA(0, 0), a2, voffA);
            PG8_BAR; PG8_WAIT_L(0); PG8_MMA(1, 0, At, B0); PG8_BAR; PG8_SCHED;
            PG8_STAGE(PG8_SB(0, 1), b2 + hstep, voffB);
            PG8_WAIT_V(6); PG8_BAR; PG8_MMA(1, 1, At, B1); PG8_BAR;
            PG8_LDB(B0, 1, 0); PG8_SCHED; PG8_LDA(At, 1, 0); PG8_STAGE(PG8_SA(0, 1), a2 + hstep, voffA);
            PG8_WAIT_L(8); PG8_BAR; PG8_WAIT_L(0); PG8_MMA(0, 0, At, B0); PG8_BAR; PG8_SCHED;
            PG8_LDB(B1, 1, 1); PG8_STAGE(PG8_SB(1, 0), b3, voffB);
            PG8_BAR; PG8_WAIT_L(0); PG8_MMA(0, 1, At, B1); PG8_BAR;
            PG8_LDA(At, 1, 1); PG8_STAGE(PG8_SA(1, 0), a3, voffA);
            PG8_BAR; PG8_WAIT_L(0); PG8_MMA(1, 0, At, B0); PG8_BAR; PG8_SCHED;
            PG8_STAGE(PG8_SB(1, 1), b3 + hstep, voffB);
            PG8_WAIT_V(6); PG8_BAR; PG8_MMA(1, 1, At, B1); PG8_BAR;
        }
        PG8_STAMP();
        if constexpr (!Epi::AFTER_DRAIN) { E(acc, cur, wr, wc, fr, fq); S.done(cur); }
        PG8_STAMP();
        if (!has_next) break;
#pragma unroll
        for (int a = 0; a < 2; ++a)
#pragma unroll
            for (int b = 0; b < 2; ++b)
#pragma unroll
                for (int m = 0; m < 4; ++m)
#pragma unroll
                    for (int n = 0; n < 2; ++n) acc[a][b][m][n] = (f32x4){0.f, 0.f, 0.f, 0.f};
        cur = nxt; cA = nA; cB = nB; ++ui;
    }
    PG8_WAIT_V(0);
    if (wr == 0) PG8_BAR;
    PG8_BAR;
    if constexpr (Epi::AFTER_DRAIN) { E.fused(acc, cur, wr, wc, fr, fq, lds, wid, lane); S.done(cur); }
    PG8_STAMP();
    if (STAMP && wid == 0) { stamps[lane] = lane < nts ? (((unsigned long long)(unsigned)ts_hi << 32) | (unsigned)ts_lo) : 0ull;
        if (lane == 62) stamps[62] = rt_entry; if (lane == 63) stamps[63] = (unsigned long long)wall_clock64(); }
#undef PG8_STAMP
#undef PG8_SA
#undef PG8_SB
#undef PG8_STAGE
#undef PG8_LDA
#undef PG8_LDB
#undef PG8_MMA
#undef PG8_WAIT_V
#undef PG8_WAIT_L
#undef PG8_BAR
#undef PG8_SCHED
}
}

typedef unsigned short u16;
typedef short s16x4 __attribute__((ext_vector_type(4)));
using pg8::bf16x8; using pg8::f32x4; using pg8::Unit;
#define LAS __attribute__((address_space(3)))
#define MFMA16(a, b, c) __builtin_amdgcn_mfma_f32_16x16x32_bf16(a, b, c, 0, 0, 0)

constexpr int DM = 1024, NBATCH = 16, SEQ = 4096, DEPTH = 4, CTXL = 256, NPROJ = 11776, NIN = 11264;
constexpr int GB = 4, MLAT = GB * SEQ, MCTX = NBATCH * CTXL;
constexpr int LDS_BYTES = 152 * 1024;
constexpr float LOG2E = 1.4426950408889634f;
constexpr float EPSN = 1e-6f;

constexpr size_t al256(size_t x) { return (x + 255) & ~(size_t)255; }
constexpr size_t OFF_WTIN = 0;
constexpr size_t OFF_WTBR = OFF_WTIN + (size_t)DEPTH * NPROJ * DM * 2;
constexpr size_t OFF_WTOUT = OFF_WTBR + (size_t)DEPTH * 4 * 1024 * 512 * 2;
constexpr size_t OFF_WS16 = OFF_WTOUT + (size_t)DEPTH * 1024 * 1024 * 2;
constexpr size_t OFF_MOD = OFF_WS16 + (size_t)DEPTH * 8 * 128 * 128 * 2;
constexpr size_t OFF_LB = OFF_MOD + al256((size_t)DEPTH * 17 * 3072 * 4);
constexpr size_t OFF_ROPE = OFF_LB + (size_t)DEPTH * 2 * 512 * 4;
constexpr size_t OFF_TW = OFF_ROPE + 2 * 64 * 16 * 4;
constexpr size_t OFF_M1 = OFF_TW + 4096 * 8;
constexpr size_t OFF_M2 = OFF_M1 + 128 * 128 * 2;
constexpr size_t OFF_M3 = OFF_M2 + 64 * 128 * 2;
constexpr size_t OFF_CSW = OFF_M3 + 256 * 512 * 2;
constexpr size_t OFF_CTXW = OFF_CSW + (size_t)DEPTH * 4 * 2 * 128 * 128 * 4;
constexpr size_t OFF_CTXKV = OFF_CTXW + (size_t)NBATCH * CTXL * DM * 4;
constexpr size_t OFF_CTXST = OFF_CTXKV + (size_t)DEPTH * MCTX * 1024 * 2;
constexpr size_t OFF_H = OFF_CTXST + (size_t)DEPTH * 256 * 4096 * 4;
constexpr size_t OFF_PROJ = OFF_H + (size_t)MLAT * DM * 2;
constexpr size_t OFF_QROT = OFF_PROJ + (size_t)MLAT * NPROJ * 2;
constexpr size_t OFF_LOGF = OFF_QROT + (size_t)MLAT * 512 * 2;
constexpr size_t OFF_Y = OFF_LOGF + (size_t)MLAT * 1024 * 4;
constexpr size_t OFF_FY = OFF_Y + (size_t)4 * MLAT * 512 * 2;
constexpr size_t OFF_HL = OFF_FY + (size_t)GB * 4096 * 1024 * 2;
constexpr size_t OFF_HD = OFF_HL + (size_t)4096 * 4096 * 4;
constexpr size_t OFF_HS = OFF_HD + (size_t)4096 * 64 * 4;
constexpr size_t OFF_MB = OFF_HS + (size_t)4096 * 4096 * 4;
constexpr size_t WS_END = OFF_MB + (size_t)MLAT * DM * 2;
constexpr size_t OFF_MERGED = OFF_LOGF;
constexpr size_t OFF_OUT = OFF_PROJ;

struct Params {
    const float *x, *c, *ctx, *c_ctx, *w_ada, *b_ada, *g_pre, *g_post, *w_in, *rpb, *fnet_w, *gmlp_g, *gmlp_ws, *gmlp_bs, *lb_logits, *hgrn_g, *w_branch, *w_out;
    float* out; unsigned char* ws;
};
struct PassInfo { int is_ctx, nb, T, M, b0; };

__device__ __forceinline__ u16 f2bf(float f) { unsigned u = __float_as_uint(f); u += 0x7FFFu + ((u >> 16) & 1u); return (u16)(u >> 16); }
__device__ __forceinline__ float bf2f(u16 b) { return __uint_as_float(((unsigned)b) << 16); }
typedef __bf16 bf16x2_t_ __attribute__((ext_vector_type(2)));
typedef float f32x2_t_ __attribute__((ext_vector_type(2)));
__device__ __forceinline__ unsigned pack2(float a, float b) { f32x2_t_ v = {a, b}; bf16x2_t_ r = __builtin_convertvector(v, bf16x2_t_); return __builtin_bit_cast(unsigned, r); }
__device__ __forceinline__ float bflo(unsigned w) { return __uint_as_float(w << 16); }
__device__ __forceinline__ float bfhi(unsigned w) { return __uint_as_float(w & 0xFFFF0000u); }
__device__ __forceinline__ float sigmoidf_(float v) { return __builtin_amdgcn_rcpf(1.f + __builtin_amdgcn_exp2f(-LOG2E * v)); }
__device__ __forceinline__ float siluf_(float v) { return v * __builtin_amdgcn_rcpf(1.f + __builtin_amdgcn_exp2f(-LOG2E * v)); }
__device__ __forceinline__ void unpack8(uint4 w, float* f) { f[0] = bflo(w.x); f[1] = bfhi(w.x); f[2] = bflo(w.y); f[3] = bfhi(w.y); f[4] = bflo(w.z); f[5] = bfhi(w.z); f[6] = bflo(w.w); f[7] = bfhi(w.w); }
__device__ __forceinline__ bf16x8 tr_read2(const u16* p0, const u16* p1) {
    s16x4 a = __builtin_amdgcn_ds_read_tr16_b64_v4i16((LAS s16x4*)p0);
    s16x4 b = __builtin_amdgcn_ds_read_tr16_b64_v4i16((LAS s16x4*)p1);
    return (bf16x8){a[0], a[1], a[2], a[3], b[0], b[1], b[2], b[3]};
}
__device__ __forceinline__ bf16x8 ld_frag_g(const u16* p) { return *(const bf16x8*)p; }

typedef unsigned u32x4_ __attribute__((ext_vector_type(4)));
__device__ __forceinline__ void nt_store16(uint4 w, void* p) { __builtin_nontemporal_store((u32x4_){w.x, w.y, w.z, w.w}, (u32x4_*)p); }
struct EpiProj {
    static constexpr bool PERM = true, AFTER_DRAIN = false;
    unsigned char* ws; int l; int is_ctx;
    __device__ __forceinline__ void operator()(const f32x4 (&acc)[2][2][4][2], const Unit& u, int wr, int wc, int fr, int fq) const {
        u16* proj = (u16*)(ws + OFF_PROJ);
        const int blk = u.pn >> 1;
        const int row0 = u.pm * 256 + wr * 64 + fr, col0 = u.pn * 256 + wc * 32 + 8 * fq;
        u16* pbase = proj + ((size_t)blk * MLAT + row0) * 512 + (col0 & 511);
        if ((blk == 0 || blk == 1) && !is_ctx) {
            u16* qrot = (u16*)(ws + OFF_QROT); const float* rope = (const float*)(ws + OFF_ROPE);
            const int f0 = 8 * (fq & 1); const float sgn = (fq >> 1) ? 1.f : -1.f;
#pragma unroll
            for (int ai = 0; ai < 2; ++ai)
#pragma unroll
                for (int m = 0; m < 4; ++m) {
                    const int row = row0 + ai * 128 + m * 16;
                    const int t = row & 4095, pos = (wc & 1) ? (t & 63) : (t >> 6);
                    const float4 c0 = *(const float4*)(rope + pos * 16 + f0), c1 = *(const float4*)(rope + pos * 16 + f0 + 4);
                    const float4 s0 = *(const float4*)(rope + 1024 + pos * 16 + f0), s1 = *(const float4*)(rope + 1024 + pos * 16 + f0 + 4);
                    const float cs[8] = {c0.x, c0.y, c0.z, c0.w, c1.x, c1.y, c1.z, c1.w}, sn[8] = {s0.x, s0.y, s0.z, s0.w, s1.x, s1.y, s1.z, s1.w};
#pragma unroll
                    for (int bj = 0; bj < 2; ++bj) {
                        const f32x4 v0 = acc[ai][bj][m][0], v1 = acc[ai][bj][m][1];
                        const float o[8] = {v0[0], v0[1], v0[2], v0[3], v1[0], v1[1], v1[2], v1[3]};
                        float r[8];
#pragma unroll
                        for (int e = 0; e < 8; ++e) { const float pr = shx(o[e], 32); r[e] = o[e] * cs[e] + sgn * pr * sn[e]; }
                        uint4 wr_; wr_.x = pack2(r[0], r[1]); wr_.y = pack2(r[2], r[3]); wr_.z = pack2(r[4], r[5]); wr_.w = pack2(r[6], r[7]);
                        u16* dst = pbase + (size_t)(ai * 128 + m * 16) * 512 + bj * 128;
                        if (blk == 0) {
                            uint4 wp; wp.x = pack2(o[0], o[1]); wp.y = pack2(o[2], o[3]); wp.z = pack2(o[4], o[5]); wp.w = pack2(o[6], o[7]);
                            nt_store16(wp, dst);
                            nt_store16(wr_, qrot + (size_t)row * 512 + (col0 & 511) + bj * 128);
                        } else nt_store16(wr_, dst);
                    }
                }
        } else if (blk == 11 || blk == 12) {
            float* logf = (float*)(ws + OFF_LOGF); const float* lb = (const float*)(ws + OFF_LB) + l * 1024;
            const int dir = blk - 11;
#pragma unroll
            for (int bj = 0; bj < 2; ++bj) {
                const int cc = (col0 & 511) + bj * 128;
                const float4 l0 = *(const float4*)(lb + dir * 512 + cc), l1 = *(const float4*)(lb + dir * 512 + cc + 4);
                const float lbv[8] = {l0.x, l0.y, l0.z, l0.w, l1.x, l1.y, l1.z, l1.w};
#pragma unroll
                for (int ai = 0; ai < 2; ++ai)
#pragma unroll
                    for (int m = 0; m < 4; ++m) {
                        const int row = row0 + ai * 128 + m * 16;
                        const f32x4 v0 = acc[ai][bj][m][0], v1 = acc[ai][bj][m][1];
                        const float z[8] = {v0[0], v0[1], v0[2], v0[3], v1[0], v1[1], v1[2], v1[3]};
                        float lf[8], o[8];
#pragma unroll
                        for (int e = 0; e < 8; ++e) {
                            const float ez = __expf(-z[e]);
                            const float inv = __builtin_amdgcn_rcpf(1.f + ez);
                            const float sg = inv, sgn_ = (ez > 1e30f) ? 1.f : ez * inv;
                            const float f = lbv[e] + (1.f - lbv[e]) * sg;
                            lf[e] = __logf(fmaxf(f, 1e-30f));
                            o[e] = (1.f - lbv[e]) * sgn_;
                        }
                        float* lp = logf + (size_t)row * 1024 + dir * 512 + cc;
                        __builtin_nontemporal_store((f32x4){lf[0], lf[1], lf[2], lf[3]}, (f32x4*)lp); __builtin_nontemporal_store((f32x4){lf[4], lf[5], lf[6], lf[7]}, (f32x4*)(lp + 4));
                        uint4 w; w.x = pack2(o[0], o[1]); w.y = pack2(o[2], o[3]); w.z = pack2(o[4], o[5]); w.w = pack2(o[6], o[7]);
                        nt_store16(w, pbase + (size_t)(ai * 128 + m * 16) * 512 + bj * 128);
                    }
            }
        } else {
            const bool copy = is_ctx && (blk == 1 || blk == 2);
            u16* cbase = (u16*)(ws + OFF_CTXKV) + (size_t)l * MCTX * 1024 + (size_t)row0 * 1024 + (blk - 1) * 512 + (col0 & 511);
            if (!copy) {
#pragma unroll
                for (int ai = 0; ai < 2; ++ai)
#pragma unroll
                    for (int m = 0; m < 4; ++m)
#pragma unroll
                        for (int bj = 0; bj < 2; ++bj) {
                            const f32x4 v0 = acc[ai][bj][m][0], v1 = acc[ai][bj][m][1];
                            uint4 w; w.x = pack2(v0[0], v0[1]); w.y = pack2(v0[2], v0[3]); w.z = pack2(v1[0], v1[1]); w.w = pack2(v1[2], v1[3]);
                            nt_store16(w, pbase + (size_t)(ai * 128 + m * 16) * 512 + bj * 128);
                        }
            } else {
#pragma unroll
                for (int ai = 0; ai < 2; ++ai)
#pragma unroll
                    for (int m = 0; m < 4; ++m)
#pragma unroll
                        for (int bj = 0; bj < 2; ++bj) {
                            const f32x4 v0 = acc[ai][bj][m][0], v1 = acc[ai][bj][m][1];
                            uint4 w; w.x = pack2(v0[0], v0[1]); w.y = pack2(v0[2], v0[3]); w.z = pack2(v1[0], v1[1]); w.w = pack2(v1[2], v1[3]);
                            nt_store16(w, pbase + (size_t)(ai * 128 + m * 16) * 512 + bj * 128);
                            *(uint4*)(cbase + (size_t)(ai * 128 + m * 16) * 1024 + bj * 128) = w;
                        }
            }
        }
    }
};
struct EpiMerge {
    static constexpr bool PERM = true, AFTER_DRAIN = false;
    unsigned char* ws;
    template <int MODE> __device__ __forceinline__ void run(const f32x4 (&acc)[2][2][4][2], const Unit& u, int wr, int wc, int fr, int fq) const {
        const u16* proj = (const u16*)(ws + OFF_PROJ); u16* mb = (u16*)(ws + OFF_MB);
        const int row0 = u.pm * 256 + wr * 64 + fr, col0 = u.pn * 256 + wc * 32 + 8 * fq, R = u.r;
        const int gcol0 = 7680 + R * 1024 + col0;
        const u16* gbase = proj + ((size_t)(gcol0 >> 9) * MLAT + row0) * 512 + (gcol0 & 511);
        u16* obase = mb + (size_t)row0 * 1024 + col0;
        uint4 g[2][4], old[2][4];
#define MG_LOAD(st, buf) do { _Pragma("unroll") for (int q = 0; q < 4; ++q) { const int ai_ = (st) >> 1, m_ = ((st) & 1) * 2 + (q >> 1), co_ = (q & 1) * 128; const size_t ro_ = (size_t)(ai_ * 128 + m_ * 16); \
            g[buf][q] = *(const uint4*)(gbase + ro_ * 512 + co_); if (MODE > 0) old[buf][q] = *(const uint4*)(obase + ro_ * 1024 + co_); } } while (0)
        MG_LOAD(0, 0);
#pragma unroll
        for (int st = 0; st < 4; ++st) {
            const int buf = st & 1;
            if (st + 1 < 4) MG_LOAD(st + 1, buf ^ 1);
            __builtin_amdgcn_sched_barrier(0);
#pragma unroll
            for (int q = 0; q < 4; ++q) { const int ai = st >> 1, m = (st & 1) * 2 + (q >> 1), bj = q & 1, co = bj * 128; const size_t ro = (size_t)(ai * 128 + m * 16);
                const f32x4 v0 = acc[ai][bj][m][0], v1 = acc[ai][bj][m][1];
                float gf[8]; unpack8(g[buf][q], gf);
                float o[8] = {v0[0] * sigmoidf_(gf[0]), v0[1] * sigmoidf_(gf[1]), v0[2] * sigmoidf_(gf[2]), v0[3] * sigmoidf_(gf[3]), v1[0] * sigmoidf_(gf[4]), v1[1] * sigmoidf_(gf[5]), v1[2] * sigmoidf_(gf[6]), v1[3] * sigmoidf_(gf[7])};
                if (MODE > 0) { float of[8]; unpack8(old[buf][q], of);
#pragma unroll
                    for (int e = 0; e < 8; ++e) o[e] += of[e]; }
                uint4 w; w.x = pack2(o[0], o[1]); w.y = pack2(o[2], o[3]); w.z = pack2(o[4], o[5]); w.w = pack2(o[6], o[7]);
                *(uint4*)(obase + ro * 1024 + co) = w; }
        }
#undef MG_LOAD
    }
    __device__ __forceinline__ void operator()(const f32x4 (&acc)[2][2][4][2], const Unit& u, int wr, int wc, int fr, int fq) const {
        if (u.r == 0) run<0>(acc, u, wr, wc, fr, fq);
        else run<1>(acc, u, wr, wc, fr, fq);
    }
};
struct EpiOut {
    static constexpr bool PERM = true, AFTER_DRAIN = false;
    u16* C;
    __device__ __forceinline__ void operator()(const f32x4 (&acc)[2][2][4][2], const Unit& u, int wr, int wc, int fr, int fq) const {
        const int row0 = u.pm * 256 + wr * 64 + fr, col0 = u.pn * 256 + wc * 32 + 8 * fq;
#pragma unroll
        for (int ai = 0; ai < 2; ++ai)
#pragma unroll
            for (int m = 0; m < 4; ++m) { u16* rowp = C + (size_t)(row0 + ai * 128 + m * 16) * 1024 + col0;
#pragma unroll
                for (int bj = 0; bj < 2; ++bj) { const f32x4 v0 = acc[ai][bj][m][0], v1 = acc[ai][bj][m][1];
                    uint4 w; w.x = pack2(v0[0], v0[1]); w.y = pack2(v0[2], v0[3]); w.z = pack2(v1[0], v1[1]); w.w = pack2(v1[2], v1[3]); *(uint4*)(rowp + bj * 128) = w; } }
    }
};

__device__ void transpose_tile(const float* src, int lds_, u16* dst, int ldd, int k0, int n0s, int n0d, u16* t) {
    const int tid = tidx();
#pragma unroll
    for (int it = 0; it < 2; ++it) {
        const int kk = (tid >> 4) + it * 32, nn = (tid & 15) * 4;
        const float4 v = *(const float4*)(src + (size_t)(k0 + kk) * lds_ + n0s + nn);
        t[(nn + 0) * 72 + kk] = f2bf(v.x); t[(nn + 1) * 72 + kk] = f2bf(v.y); t[(nn + 2) * 72 + kk] = f2bf(v.z); t[(nn + 3) * 72 + kk] = f2bf(v.w);
    }
    __syncthreads();
    { const int n = tid >> 3, k8 = (tid & 7) * 8;
      const uint4 v = *(const uint4*)(t + n * 72 + k8);
      *(uint4*)(dst + (size_t)(n0d + n) * ldd + k0 + k8) = v; }
    __syncthreads();
}

__device__ void prep1(const Params& p, unsigned char* lds) {
    unsigned char* ws = opaque(p.ws);
    const int tid = tidx();
    const size_t gt = (size_t)blockIdx.x * 512 + tid, gn = (size_t)gridDim.x * 512;
    { u16* ws16 = (u16*)(ws + OFF_WS16);
      for (size_t i = gt; i < (size_t)DEPTH * 8 * 128 * 128; i += gn) ws16[i] = f2bf(p.gmlp_ws[i]);
      float* lbp = (float*)(ws + OFF_LB);
      for (size_t i = gt; i < 1024; i += gn) {
          float e[DEPTH], mx = -1e30f, sum = 0.f;
#pragma unroll
          for (int l = 0; l < DEPTH; ++l) { e[l] = p.lb_logits[l * 1024 + i]; mx = fmaxf(mx, e[l]); }
#pragma unroll
          for (int l = 0; l < DEPTH; ++l) { e[l] = expf(e[l] - mx); sum += e[l]; }
          float run = 0.f;
#pragma unroll
          for (int l = 0; l < DEPTH; ++l) { if (l > 0) run += e[l] / sum; lbp[l * 1024 + i] = fmaxf(run, 0.f); }
      }
      float* rope = (float*)(ws + OFF_ROPE);
      for (size_t i = gt; i < 1024; i += gn) { const int pos = (int)(i >> 4), f = (int)(i & 15);
          const float inv = powf(10000.f, -(float)f * 2.0f / 32.0f), ang = (float)pos * inv;
          rope[i] = cosf(ang); rope[1024 + i] = sinf(ang); }
      float* tw = (float*)(ws + OFF_TW);
      for (size_t i = gt; i < 4096; i += gn) { float s, c; sincospif((float)i * (2.0f / 4096.0f), &s, &c); tw[2 * i] = c; tw[2 * i + 1] = s; }
      u16* m1 = (u16*)(ws + OFF_M1);
      for (size_t i = gt; i < 128 * 128; i += gn) { const int ii = (int)(i >> 7), kk = (int)(i & 127), k1 = ii >> 1, po = ii & 1, n1 = kk >> 1, pi = kk & 1;
          float s, c; sincospif((float)((k1 * n1) & 63) * (2.0f / 64.0f), &s, &c);
          const float v = (po == 0) ? (pi == 0 ? c : -s) : (pi == 0 ? -s : -c);
          m1[i] = f2bf(v); }
      u16* m2 = (u16*)(ws + OFF_M2);
      for (size_t i = gt; i < 64 * 128; i += gn) { const int k2 = (int)(i >> 7), kk = (int)(i & 127), n2 = kk >> 1, pi = kk & 1;
          float s, c; sincospif((float)((k2 * n2) & 63) * (2.0f / 64.0f), &s, &c);
          m2[i] = f2bf(pi == 0 ? c : s); }
      u16* m3 = (u16*)(ws + OFF_M3);
      for (size_t i = gt; i < 256 * 512; i += gn) { const int k = (int)(i >> 9), kk = (int)(i & 511), n = kk >> 1, pi = kk & 1;
          float s, c; sincospif((float)((k * n) & 255) * (2.0f / 256.0f), &s, &c);
          m3[i] = f2bf(pi == 0 ? c : -s); }
    }
    constexpr int N_WIN = DEPTH * 176 * 16, N_WBR = 16 * 16 * 8, N_WOUT = DEPTH * 16 * 16, N_MOD = DEPTH * 48, N_CSW = DEPTH * 4 * 2 * 2;
    constexpr int TOT = N_WIN + N_WBR + N_WOUT + N_MOD + N_CSW;
    for (int it = blockIdx.x; it < TOT; it += gridDim.x) {
        int idx = it;
        if (idx < N_WIN) {
            const int l = idx / 2816, rem = idx % 2816, cb = rem >> 4, kb = rem & 15, n0 = cb * 64;
            if (n0 >= 2048 && n0 < 2560) continue;
            const int n0d = n0 < 2048 ? n0 : n0 + 512;
            transpose_tile(p.w_in + (size_t)l * DM * NIN, NIN, (u16*)(ws + OFF_WTIN) + (size_t)l * NPROJ * DM, DM, kb * 64, n0, n0d, (u16*)lds);
            continue;
        }
        idx -= N_WIN;
        if (idx < N_WBR) {
            const int mat = idx >> 7, rem = idx & 127, cb = rem >> 3, kb = rem & 7;
            transpose_tile(p.w_branch + (size_t)mat * 512 * 1024, 1024, (u16*)(ws + OFF_WTBR) + (size_t)mat * 1024 * 512, 512, kb * 64, cb * 64, cb * 64, (u16*)lds);
            continue;
        }
        idx -= N_WBR;
        if (idx < N_WOUT) {
            const int l = idx >> 8, rem = idx & 255, cb = rem >> 4, kb = rem & 15;
            transpose_tile(p.w_out + (size_t)l * 1024 * 1024, 1024, (u16*)(ws + OFF_WTOUT) + (size_t)l * 1024 * 1024, 1024, kb * 64, cb * 64, cb * 64, (u16*)lds);
            continue;
        }
        idx -= N_WOUT;
        if (idx < N_MOD) {
            const int l = idx / 48, cb = idx % 48;
            float* s = (float*)lds; float* red = s + 17 * 1024;
            for (int i = tid; i < 17 * 1024; i += 512) { const int j = i >> 10, k = i & 1023; const float v = j < 16 ? p.c[j * 1024 + k] : p.c_ctx[k]; s[i] = v / (1.f + expf(-v)); }
            __syncthreads();
            const int col = tid & 63, ks = tid >> 6;
            float acc[17];
#pragma unroll
            for (int j = 0; j < 17; ++j) acc[j] = 0.f;
            for (int k = ks * 128; k < ks * 128 + 128; ++k) {
                const float w = p.w_ada[((size_t)l * 1024 + k) * 3072 + cb * 64 + col];
#pragma unroll
                for (int j = 0; j < 17; ++j) acc[j] += s[j * 1024 + k] * w;
            }
#pragma unroll
            for (int j = 0; j < 17; ++j) red[(ks * 17 + j) * 64 + col] = acc[j];
            __syncthreads();
            for (int o = tid; o < 17 * 64; o += 512) { const int j = o >> 6, cc = o & 63; float sum = 0.f;
                for (int q = 0; q < 8; ++q) sum += red[(q * 17 + j) * 64 + cc];
                ((float*)(ws + OFF_MOD))[((size_t)l * 17 + j) * 3072 + cb * 64 + cc] = sum + p.b_ada[l * 3072 + cb * 64 + cc]; }
            __syncthreads();
            continue;
        }
        idx -= N_MOD;
        {
            const int cblk = idx & 1, part = (idx >> 1) & 1, g = (idx >> 2) & 3, l = idx >> 4;
            float* tb = (float*)lds;
            if (tid < 128) { float s, c; sincospif((float)tid * (2.0f / 128.0f), &s, &c); tb[tid] = part ? s : c; }
            __syncthreads();
            const int d = tid & 127, cq = tid >> 7;
            float acc[16];
#pragma unroll
            for (int i = 0; i < 16; ++i) acc[i] = 0.f;
            const float* wf = p.fnet_w + ((size_t)(l * 4 + g) * 128) * 128;
            for (int c2 = 0; c2 < 128; ++c2) {
                const float w = wf[c2 * 128 + d];
#pragma unroll
                for (int i = 0; i < 16; ++i) { const int c = cblk * 64 + cq * 16 + i; acc[i] += tb[(c * c2) & 127] * w; }
            }
            float* dst = (float*)(ws + OFF_CSW) + ((size_t)((l * 4 + g) * 2 + part) * 128) * 128;
#pragma unroll
            for (int i = 0; i < 16; ++i) dst[(cblk * 64 + cq * 16 + i) * 128 + d] = acc[i];
            __syncthreads();
        }
    }
}

__device__ void prep2(const Params& p, unsigned char* lds) {
    unsigned char* ws = opaque(p.ws);
    const int tid = tidx();
    float* wb = (float*)lds;
    float* cw = wb + 64 * 129;
    for (int it = blockIdx.x; it < DEPTH * 4 * 2 * 16; it += gridDim.x) {
        const int kb = it & 15, part = (it >> 4) & 1, g = (it >> 5) & 3, l = it >> 7;
        for (int i = tid; i < 64 * 128; i += 512) { const int kk = i >> 7, c = i & 127; wb[kk * 129 + c] = p.w_in[((size_t)l * 1024 + kb * 64 + kk) * NIN + 2048 + g * 128 + c]; }
        const float* src = (const float*)(ws + OFF_CSW) + ((size_t)((l * 4 + g) * 2 + part) * 128) * 128;
        for (int i = tid; i < 128 * 128; i += 512) cw[i] = src[i];
        __syncthreads();
        const int d = tid & 127, kq = tid >> 7;
        float acc[16];
#pragma unroll
        for (int i = 0; i < 16; ++i) acc[i] = 0.f;
        for (int c = 0; c < 128; ++c) {
            const float w = cw[c * 128 + d];
#pragma unroll
            for (int i = 0; i < 16; ++i) acc[i] += wb[(kq * 16 + i) * 129 + c] * w;
        }
        u16* dst = (u16*)(ws + OFF_WTIN) + ((size_t)l * NPROJ + (4 + part) * 512 + g * 128 + d) * DM + kb * 64 + kq * 16;
        uint4 w0, w1;
        w0.x = pack2(acc[0], acc[1]); w0.y = pack2(acc[2], acc[3]); w0.z = pack2(acc[4], acc[5]); w0.w = pack2(acc[6], acc[7]);
        w1.x = pack2(acc[8], acc[9]); w1.y = pack2(acc[10], acc[11]); w1.z = pack2(acc[12], acc[13]); w1.w = pack2(acc[14], acc[15]);
        *(uint4*)dst = w0; *(uint4*)(dst + 8) = w1;
        __syncthreads();
    }
}

__device__ void phase_norm(const Params& p, const PassInfo ps, int l) {
    unsigned char* ws = opaque(p.ws);
    const int wave = tidx() >> 6, lane = tidx() & 63;
    const float* mod = (const float*)(ws + OFF_MOD);
    const u16* OUT = (const u16*)(ws + OFF_OUT);
    u16* H = (u16*)(ws + OFF_H);
    for (int rr = blockIdx.x * 8 + wave; rr < ps.M; rr += gridDim.x * 8) {
        const int tsh = ps.is_ctx ? 8 : 12; const int b = ps.b0 + (rr >> tsh), t = rr & (ps.T - 1), mrow = ps.is_ctx ? 16 : b;
        const size_t xoff = ((size_t)b * ps.T + t) * 1024;
        const float* xin = (l <= 1) ? ((ps.is_ctx ? p.ctx : p.x) + xoff) : ((ps.is_ctx ? (const float*)(ws + OFF_CTXW) : (const float*)p.out) + xoff);
        float* xout = (ps.is_ctx ? (float*)(ws + OFF_CTXW) : p.out) + xoff;
        float xv[16];
#pragma unroll
        for (int hlf = 0; hlf < 2; ++hlf) {
            const int c0 = hlf * 512 + lane * 8;
            const float4 a = *(const float4*)(xin + c0), bq = *(const float4*)(xin + c0 + 4);
            xv[hlf * 8 + 0] = a.x; xv[hlf * 8 + 1] = a.y; xv[hlf * 8 + 2] = a.z; xv[hlf * 8 + 3] = a.w;
            xv[hlf * 8 + 4] = bq.x; xv[hlf * 8 + 5] = bq.y; xv[hlf * 8 + 6] = bq.z; xv[hlf * 8 + 7] = bq.w;
        }
        if (l > 0) {
            float ov[16]; float ss = 0.f;
#pragma unroll
            for (int hlf = 0; hlf < 2; ++hlf) {
                const int c0 = hlf * 512 + lane * 8;
                unpack8(*(const uint4*)(OUT + (size_t)rr * 1024 + c0), ov + hlf * 8);
            }
#pragma unroll
            for (int e = 0; e < 16; ++e) ss += ov[e] * ov[e];
#pragma unroll
            for (int o = 32; o > 0; o >>= 1) ss += shx(ss, o);
            const float rstd = rsqrtf(ss * (1.f / 1024.f) + EPSN);
            const float* gt = mod + ((size_t)(l - 1) * 17 + mrow) * 3072 + 2048;
            const float* gp = p.g_post + (l - 1) * 1024;
#pragma unroll
            for (int hlf = 0; hlf < 2; ++hlf) {
                const int c0 = hlf * 512 + lane * 8;
#pragma unroll
                for (int e = 0; e < 8; ++e) xv[hlf * 8 + e] += gt[c0 + e] * (ov[hlf * 8 + e] * rstd * gp[c0 + e]);
                *(float4*)(xout + c0) = make_float4(xv[hlf * 8 + 0], xv[hlf * 8 + 1], xv[hlf * 8 + 2], xv[hlf * 8 + 3]);
                *(float4*)(xout + c0 + 4) = make_float4(xv[hlf * 8 + 4], xv[hlf * 8 + 5], xv[hlf * 8 + 6], xv[hlf * 8 + 7]);
            }
        }
        if (l < DEPTH) {
            float ss = 0.f;
#pragma unroll
            for (int e = 0; e < 16; ++e) ss += xv[e] * xv[e];
#pragma unroll
            for (int o = 32; o > 0; o >>= 1) ss += shx(ss, o);
            const float rstd = rsqrtf(ss * (1.f / 1024.f) + EPSN);
            const float* sh = mod + ((size_t)l * 17 + mrow) * 3072; const float* sc = sh + 1024;
            const float* gp = p.g_pre + l * 1024;
#pragma unroll
            for (int hlf = 0; hlf < 2; ++hlf) {
                const int c0 = hlf * 512 + lane * 8;
                float hv[8];
#pragma unroll
                for (int e = 0; e < 8; ++e) hv[e] = xv[hlf * 8 + e] * rstd * gp[c0 + e] * (1.f + sc[c0 + e]) + sh[c0 + e];
                uint4 w; w.x = pack2(hv[0], hv[1]); w.y = pack2(hv[2], hv[3]); w.z = pack2(hv[4], hv[5]); w.w = pack2(hv[6], hv[7]);
                *(uint4*)(H + (size_t)rr * 1024 + c0) = w;
            }
        }
    }
}

#define PJ(row, blk, c) (PROJ + ((size_t)(blk) * MLAT + (row)) * 512 + (c))
typedef unsigned u32x32_ __attribute__((ext_vector_type(32)));
struct Reg8 {
    u32x32_ v;
    __device__ __forceinline__ void ld(int i, const void* p) { const u32x4_ a = *(const u32x4_*)p; v[4 * i] = a[0]; v[4 * i + 1] = a[1]; v[4 * i + 2] = a[2]; v[4 * i + 3] = a[3]; }
    __device__ __forceinline__ u32x4_ get(int i) const { return (u32x4_){v[4 * i], v[4 * i + 1], v[4 * i + 2], v[4 * i + 3]}; }
    __device__ __forceinline__ uint4 getu(int i) const { uint4 r; r.x = v[4 * i]; r.y = v[4 * i + 1]; r.z = v[4 * i + 2]; r.w = v[4 * i + 3]; return r; }
};
#define MEMBAR() asm volatile("" ::: "memory")
constexpr int KVS = 72;
constexpr int TS = 528;
constexpr int T3S = 136;
constexpr int HS_ = 68;
constexpr float NORM_LAT = 0.0013810679320049757f;
constexpr float NORM_CTX = 0.005524271728019903f;

__device__ void attn_item(const Params& p, const PassInfo ps, int l, int item, unsigned char* lds) {
    unsigned char* ws = opaque(p.ws);
    const u16* PROJ = (const u16*)(ws + OFF_PROJ); const u16* QROT = (const u16*)(ws + OFF_QROT);
    const u16* CKV = (const u16*)(ws + OFF_CTXKV) + (size_t)l * MCTX * 1024;
    u16* Y0 = (u16*)(ws + OFF_Y);
    const int tid = tidx(), w = tid >> 6, lane = tid & 63, qtr = w & 3, kh = w >> 2, li = lane & 15, quad = lane >> 4;
    u16* Kl = (u16*)lds; u16* Vl = Kl + 512 * KVS; float* rp = (float*)(Vl + 512 * KVS);
    int bl, h, r = 0, qrow0, bglob;
    if (!ps.is_ctx) { r = item & 63; h = (item >> 6) & 7; bl = item >> 9; qrow0 = bl * 4096 + r * 64; bglob = ps.b0 + bl; }
    else { const int qb = item & 3; h = (item >> 2) & 7; bl = item >> 5; qrow0 = bl * 256 + qb * 64; bglob = bl; }
    const int qrow = qrow0 + qtr * 16 + li;
    float m_run = -1e30f, l_run = 0.f;
    const bf16x8 qp0 = ld_frag_g(PJ(qrow, 0, h * 64 + quad * 8)), qp1 = ld_frag_g(PJ(qrow, 0, h * 64 + 32 + quad * 8));
    uint2 gate4[4];
#pragma unroll
    for (int d = 0; d < 4; ++d) gate4[d] = *(const uint2*)(PJ(qrow, 3, h * 64 + d * 16 + quad * 4));
    Reg8 crg;
    { const size_t crow0 = (size_t)bglob * 256;
#pragma unroll
      for (int i = 0; i < 4; ++i) { const int idx = tid + 512 * i, key = idx >> 3, ch = idx & 7;
          crg.ld(2 * i, CKV + (crow0 + key) * 1024 + h * 64 + ch * 8); crg.ld(2 * i + 1, CKV + (crow0 + key) * 1024 + 512 + h * 64 + ch * 8); } }
    f32x4 O[4];
#pragma unroll
    for (int d = 0; d < 4; ++d) O[d] = (f32x4){0.f, 0.f, 0.f, 0.f};
    if (!ps.is_ctx) {
        const int rs = min(max(r - 4, 0), 56);
        const size_t krow0 = (size_t)bl * 4096 + rs * 64;
        const bf16x8 q0 = ld_frag_g(QROT + (size_t)qrow * 512 + h * 64 + quad * 8), q1 = ld_frag_g(QROT + (size_t)qrow * 512 + h * 64 + 32 + quad * 8);
        { u32x32_ kr, vr;
#pragma unroll
          for (int i = 0; i < 8; ++i) { const int idx = tid + 512 * i, key = idx >> 3, ch = idx & 7;
              const u32x4_ a = *(const u32x4_*)(PJ(krow0 + key, 1, h * 64 + ch * 8)), b = *(const u32x4_*)(PJ(krow0 + key, 2, h * 64 + ch * 8));
              kr[4 * i] = a[0]; kr[4 * i + 1] = a[1]; kr[4 * i + 2] = a[2]; kr[4 * i + 3] = a[3]; vr[4 * i] = b[0]; vr[4 * i + 1] = b[1]; vr[4 * i + 2] = b[2]; vr[4 * i + 3] = b[3]; }
          asm volatile("" ::: "memory");
#pragma unroll
          for (int i = 0; i < 8; ++i) { const int idx = tid + 512 * i, key = idx >> 3, ch = idx & 7;
              *(u32x4_*)(Kl + key * KVS + ch * 8) = (u32x4_){kr[4 * i], kr[4 * i + 1], kr[4 * i + 2], kr[4 * i + 3]}; *(u32x4_*)(Vl + key * KVS + ch * 8) = (u32x4_){vr[4 * i], vr[4 * i + 1], vr[4 * i + 2], vr[4 * i + 3]}; } }
        for (int i = tid; i < 465; i += 512) rp[i] = p.rpb[((size_t)l * 8 + h) * 465 + i];
        __syncthreads();
        const int cbase = (qtr == 0) ? 0 : (qtr == 1 ? 8 : (qtr == 2 ? 24 : 32));
        const int qc = qtr * 16 + li, cst = min(max(qc - 8, 0), 48);
        float s[8][4];
        float mx = -1e30f;
#pragma unroll
        for (int sb = 0; sb < 8; ++sb) {
            const int i = kh * 4 + (sb >> 1), cs = sb & 1;
            const u16* kp = Kl + (i * 64 + cbase + cs * 16 + li) * KVS + quad * 8;
            f32x4 a = (f32x4){0.f, 0.f, 0.f, 0.f};
            a = MFMA16(*(const bf16x8*)kp, q0, a); a = MFMA16(*(const bf16x8*)(kp + 32), q1, a);
            const int ridx = rs + i - r + 7;
#pragma unroll
            for (int j = 0; j < 4; ++j) { const int kc = cbase + cs * 16 + quad * 4 + j;
                const bool valid = (kc >= cst) && (kc < cst + 16);
                const int cidx = min(max(kc - qc + 15, 0), 30);
                const float v = valid ? (a[j] * 0.125f + rp[ridx * 31 + cidx]) : -1e30f;
                s[sb][j] = v; mx = fmaxf(mx, v); }
        }
        mx = fmaxf(mx, shx(mx, 16)); mx = fmaxf(mx, shx(mx, 32));
        m_run = mx;
        float ls = 0.f;
#pragma unroll
        for (int sb = 0; sb < 8; ++sb)
#pragma unroll
            for (int j = 0; j < 4; ++j) { const float e = __expf(s[sb][j] - mx); s[sb][j] = e; ls += e; }
        ls += shx(ls, 16); ls += shx(ls, 32);
        l_run = ls;
#pragma unroll
        for (int kp2 = 0; kp2 < 4; ++kp2) {
            bf16x8 pf; { const unsigned a0 = pack2(s[2 * kp2][0], s[2 * kp2][1]), a1 = pack2(s[2 * kp2][2], s[2 * kp2][3]), b0 = pack2(s[2 * kp2 + 1][0], s[2 * kp2 + 1][1]), b1 = pack2(s[2 * kp2 + 1][2], s[2 * kp2 + 1][3]);
                pf = (bf16x8){(short)(a0 & 0xffff), (short)(a0 >> 16), (short)(a1 & 0xffff), (short)(a1 >> 16), (short)(b0 & 0xffff), (short)(b0 >> 16), (short)(b1 & 0xffff), (short)(b1 >> 16)}; }
            const int vrow0 = (kh * 4 + kp2) * 64 + cbase + quad * 4 + (li >> 2);
#pragma unroll
            for (int d = 0; d < 4; ++d) {
                const u16* vp = Vl + vrow0 * KVS + d * 16 + 4 * (li & 3);
                const bf16x8 vf = tr_read2(vp, vp + 16 * KVS);
                O[d] = MFMA16(vf, pf, O[d]);
            }
        }
        __syncthreads();
    }
    {
#pragma unroll
        for (int i = 0; i < 4; ++i) { const int idx = tid + 512 * i, key = idx >> 3, ch = idx & 7;
            *(u32x4_*)(Kl + key * KVS + ch * 8) = crg.get(2 * i); *(u32x4_*)(Vl + key * KVS + ch * 8) = crg.get(2 * i + 1); }
        __syncthreads();
        const bf16x8 q0 = qp0, q1 = qp1;
        float s[8][4];
        float mx = -1e30f;
#pragma unroll
        for (int sb = 0; sb < 8; ++sb) {
            const u16* kp = Kl + (kh * 128 + sb * 16 + li) * KVS + quad * 8;
            f32x4 a = (f32x4){0.f, 0.f, 0.f, 0.f};
            a = MFMA16(*(const bf16x8*)kp, q0, a); a = MFMA16(*(const bf16x8*)(kp + 32), q1, a);
#pragma unroll
            for (int j = 0; j < 4; ++j) { const float v = a[j] * 0.125f; s[sb][j] = v; mx = fmaxf(mx, v); }
        }
        mx = fmaxf(mx, shx(mx, 16)); mx = fmaxf(mx, shx(mx, 32));
        const float m_new = fmaxf(m_run, mx), resc = __expf(m_run - m_new);
        float ls = 0.f;
#pragma unroll
        for (int sb = 0; sb < 8; ++sb)
#pragma unroll
            for (int j = 0; j < 4; ++j) { const float e = __expf(s[sb][j] - m_new); s[sb][j] = e; ls += e; }
        ls += shx(ls, 16); ls += shx(ls, 32);
        l_run = l_run * resc + ls; m_run = m_new;
#pragma unroll
        for (int d = 0; d < 4; ++d) O[d] *= resc;
#pragma unroll
        for (int kp2 = 0; kp2 < 4; ++kp2) {
            bf16x8 pf; { const unsigned a0 = pack2(s[2 * kp2][0], s[2 * kp2][1]), a1 = pack2(s[2 * kp2][2], s[2 * kp2][3]), b0 = pack2(s[2 * kp2 + 1][0], s[2 * kp2 + 1][1]), b1 = pack2(s[2 * kp2 + 1][2], s[2 * kp2 + 1][3]);
                pf = (bf16x8){(short)(a0 & 0xffff), (short)(a0 >> 16), (short)(a1 & 0xffff), (short)(a1 >> 16), (short)(b0 & 0xffff), (short)(b0 >> 16), (short)(b1 & 0xffff), (short)(b1 >> 16)}; }
            const int vrow0 = kh * 128 + kp2 * 32 + quad * 4 + (li >> 2);
#pragma unroll
            for (int d = 0; d < 4; ++d) {
                const u16* vp = Vl + vrow0 * KVS + d * 16 + 4 * (li & 3);
                const bf16x8 vf = tr_read2(vp, vp + 16 * KVS);
                O[d] = MFMA16(vf, pf, O[d]);
            }
        }
        __syncthreads();
    }
    float* cb = (float*)lds;
    if (kh == 1) {
#pragma unroll
        for (int d = 0; d < 4; ++d)
#pragma unroll
            for (int j = 0; j < 4; ++j) cb[(qtr * 18 + d * 4 + j) * 64 + lane] = O[d][j];
        cb[(qtr * 18 + 16) * 64 + lane] = m_run; cb[(qtr * 18 + 17) * 64 + lane] = l_run;
    }
    __syncthreads();
    if (kh == 0) {
        const float m2 = cb[(qtr * 18 + 16) * 64 + lane], l2 = cb[(qtr * 18 + 17) * 64 + lane];
        const float mm = fmaxf(m_run, m2), e1 = __expf(m_run - mm), e2 = __expf(m2 - mm);
        const float inv = 1.f / (l_run * e1 + l2 * e2);
#pragma unroll
        for (int d = 0; d < 4; ++d) {
            const int col = h * 64 + d * 16 + quad * 4;
            const uint2 g = gate4[d];
            float o[4];
#pragma unroll
            for (int j = 0; j < 4; ++j) o[j] = (O[d][j] * e1 + cb[(qtr * 18 + d * 4 + j) * 64 + lane] * e2) * inv;
            uint2 wv; wv.x = pack2(o[0] * siluf_(bflo(g.x)), o[1] * siluf_(bfhi(g.x))); wv.y = pack2(o[2] * siluf_(bflo(g.y)), o[3] * siluf_(bfhi(g.y)));
            *(uint2*)(Y0 + (size_t)qrow * 512 + col) = wv;
        }
    }
    __syncthreads();
}

template <int ROWS, int CPR> __device__ __forceinline__ void load_tile(u16* dstl, int lstride, const u16* src, size_t sstride) {
    constexpr int PER = ROWS * CPR / 512;
    static_assert(PER % 8 == 0, "tile size");
    const int tid_ = tidx();
#pragma unroll
    for (int b8 = 0; b8 < PER / 8; ++b8) { Reg8 rg;
#pragma unroll
        for (int j = 0; j < 8; ++j) { const int i = tid_ + 512 * (b8 * 8 + j), r = i / CPR, ch = i % CPR; rg.ld(j, src + (size_t)r * sstride + ch * 8); }
        MEMBAR();
#pragma unroll
        for (int j = 0; j < 8; ++j) { const int i = tid_ + 512 * (b8 * 8 + j), r = i / CPR, ch = i % CPR; *(u32x4_*)(dstl + r * lstride + ch * 8) = rg.get(j); }
        MEMBAR(); }
}

__device__ void four1_item(const Params& p, int item, unsigned char* lds) {
    unsigned char* ws = opaque(p.ws);
    const u16* PROJ = (const u16*)(ws + OFF_PROJ); const u16* M1 = (const u16*)(ws + OFF_M1); const float* TW = (const float*)(ws + OFF_TW);
    u16* FY = (u16*)(ws + OFF_FY);
    const int tid = tidx(), w = tid >> 6, lane = tid & 63, li = lane & 15, quad = lane >> 4;
    const int n2 = item & 63, bl = item >> 6;
    u16* T = (u16*)lds;
#pragma unroll
    for (int b8 = 0; b8 < 2; ++b8) { Reg8 rg;
#pragma unroll
        for (int j = 0; j < 8; ++j) { const int i = tid + 512 * (b8 * 8 + j), kk = i >> 6, ch = i & 63, n1 = kk >> 1, part = kk & 1;
            rg.ld(j, PJ((size_t)bl * 4096 + n1 * 64 + n2, 4 + part, ch * 8)); }
        MEMBAR();
#pragma unroll
        for (int j = 0; j < 8; ++j) { const int i = tid + 512 * (b8 * 8 + j), kk = i >> 6, ch = i & 63;
            *(u32x4_*)(T + kk * TS + ch * 8) = rg.get(j); }
        MEMBAR(); }
    float* twl = (float*)(T + 128 * TS);
    if (tid < 64) { const float2 tv = *(const float2*)(TW + 2 * (n2 * tid)); twl[2 * tid] = tv.x; twl[2 * tid + 1] = tv.y; }
    bf16x8 xf[4];
#pragma unroll
    for (int ks = 0; ks < 4; ++ks) xf[ks] = ld_frag_g(M1 + li * 128 + ks * 32 + quad * 8);
    __syncthreads();
    for (int isub = 0; isub < 8; ++isub) {
        bf16x8 xn[4];
        const int isn = isub < 7 ? isub + 1 : 7;
#pragma unroll
        for (int ks = 0; ks < 4; ++ks) xn[ks] = ld_frag_g(M1 + (isn * 16 + li) * 128 + ks * 32 + quad * 8);
        float tcs[2], tsn_[2];
#pragma unroll
        for (int hh = 0; hh < 2; ++hh) { const int k1 = isub * 8 + quad * 2 + hh; tcs[hh] = twl[2 * k1]; tsn_[hh] = twl[2 * k1 + 1]; }
#pragma unroll
        for (int cs = 0; cs < 4; ++cs) {
            const int c0 = w * 64 + cs * 16;
            f32x4 a = (f32x4){0.f, 0.f, 0.f, 0.f};
#pragma unroll
            for (int ks = 0; ks < 4; ++ks) {
                const u16* tp = T + (ks * 32 + quad * 8 + (li >> 2)) * TS + c0 + 4 * (li & 3);
                a = MFMA16(xf[ks], tr_read2(tp, tp + 4 * TS), a);
            }
            const int ch = c0 + li;
#pragma unroll
            for (int hh = 0; hh < 2; ++hh) {
                const int k1 = isub * 8 + quad * 2 + hh;
                const float yr = a[2 * hh], yi = a[2 * hh + 1];
                const float orr = yr * tcs[hh] + yi * tsn_[hh], oi = yi * tcs[hh] - yr * tsn_[hh];
                u16* dst = FY + (((size_t)bl * 64 + k1) * 64 + n2) * 1024 + ch;
                dst[0] = f2bf(orr); dst[512] = f2bf(oi);
            }
        }
#pragma unroll
        for (int ks = 0; ks < 4; ++ks) xf[ks] = xn[ks];
    }
    __syncthreads();
}

__device__ void four2_item(const Params& p, int item, unsigned char* lds) {
    unsigned char* ws = opaque(p.ws);
    const u16* PROJ = (const u16*)(ws + OFF_PROJ); const u16* M2 = (const u16*)(ws + OFF_M2); const u16* FY = (const u16*)(ws + OFF_FY);
    u16* Y1 = (u16*)(ws + OFF_Y) + (size_t)1 * MLAT * 512;
    const int tid = tidx(), w = tid >> 6, lane = tid & 63, li = lane & 15, quad = lane >> 4;
    const int k1 = item & 63, bl = item >> 6;
    u16* T = (u16*)lds;
    load_tile<128, 64>(T, TS, FY + ((size_t)bl * 64 + k1) * 64 * 1024, 512);
    __syncthreads();
    bf16x8 xf[4][4];
#pragma unroll
    for (int cs = 0; cs < 4; ++cs)
#pragma unroll
        for (int ks = 0; ks < 4; ++ks) { const u16* tp = T + (ks * 32 + quad * 8 + (li >> 2)) * TS + w * 64 + cs * 16 + 4 * (li & 3); xf[cs][ks] = tr_read2(tp, tp + 4 * TS); }
    bf16x8 yf[4]; uint2 gt[4];
#define F2_LOAD(k2s_, yf_, gt_) do { _Pragma("unroll") for (int ks = 0; ks < 4; ++ks) yf_[ks] = ld_frag_g(M2 + ((k2s_) * 16 + li) * 128 + ks * 32 + quad * 8); \
        const size_t row_ = (size_t)bl * 4096 + k1 + 64 * ((k2s_) * 16 + li); _Pragma("unroll") for (int cs = 0; cs < 4; ++cs) gt_[cs] = *(const uint2*)(PJ(row_, 6, w * 64 + cs * 16 + quad * 4)); } while (0)
    F2_LOAD(0, yf, gt);
    for (int k2s = 0; k2s < 4; ++k2s) {
        bf16x8 yn[4]; uint2 gn[4];
        const int kn = k2s < 3 ? k2s + 1 : 3;
        F2_LOAD(kn, yn, gn);
        const int k2 = k2s * 16 + li;
        const size_t row = (size_t)bl * 4096 + k1 + 64 * k2;
#pragma unroll
        for (int cs = 0; cs < 4; ++cs) {
            f32x4 a = (f32x4){0.f, 0.f, 0.f, 0.f};
#pragma unroll
            for (int ks = 0; ks < 4; ++ks) a = MFMA16(xf[cs][ks], yf[ks], a);
            const int ch = w * 64 + cs * 16 + quad * 4;
            const uint2 g = gt[cs];
            uint2 wv; wv.x = pack2(a[0] * NORM_LAT * siluf_(bflo(g.x)), a[1] * NORM_LAT * siluf_(bfhi(g.x))); wv.y = pack2(a[2] * NORM_LAT * siluf_(bflo(g.y)), a[3] * NORM_LAT * siluf_(bfhi(g.y)));
            *(uint2*)(Y1 + row * 512 + ch) = wv;
        }
#pragma unroll
        for (int q = 0; q < 4; ++q) { yf[q] = yn[q]; gt[q] = gn[q]; }
    }
#undef F2_LOAD
    __syncthreads();
}

__device__ void fourc_item(const Params& p, int item, unsigned char* lds) {
    unsigned char* ws = opaque(p.ws);
    const u16* PROJ = (const u16*)(ws + OFF_PROJ); const u16* M3 = (const u16*)(ws + OFF_M3);
    u16* Y1 = (u16*)(ws + OFF_Y) + (size_t)1 * MLAT * 512;
    const int tid = tidx(), w = tid >> 6, lane = tid & 63, li = lane & 15, quad = lane >> 4;
    const int chb = item & 3, b = item >> 2;
    u16* T = (u16*)lds;
#pragma unroll
    for (int b8 = 0; b8 < 2; ++b8) { Reg8 rg;
#pragma unroll
        for (int j = 0; j < 8; ++j) { const int i = tid + 512 * (b8 * 8 + j), kk = i >> 4, ch = i & 15, n = kk >> 1, part = kk & 1;
            rg.ld(j, PJ((size_t)b * 256 + n, 4 + part, chb * 128 + ch * 8)); }
        MEMBAR();
#pragma unroll
        for (int j = 0; j < 8; ++j) { const int i = tid + 512 * (b8 * 8 + j), kk = i >> 4, ch = i & 15;
            *(u32x4_*)(T + kk * T3S + ch * 8) = rg.get(j); }
        MEMBAR(); }
    __syncthreads();
    for (int kq = 0; kq < 2; ++kq) {
        const int ksub = w * 2 + kq;
        f32x4 a[8];
#pragma unroll
        for (int cs = 0; cs < 8; ++cs) a[cs] = (f32x4){0.f, 0.f, 0.f, 0.f};
        for (int ks = 0; ks < 16; ++ks) {
            const bf16x8 yf = ld_frag_g(M3 + (ksub * 16 + li) * 512 + ks * 32 + quad * 8);
#pragma unroll
            for (int cs = 0; cs < 8; ++cs) { const u16* tp = T + (ks * 32 + quad * 8 + (li >> 2)) * T3S + cs * 16 + 4 * (li & 3);
                a[cs] = MFMA16(tr_read2(tp, tp + 4 * T3S), yf, a[cs]); }
        }
        const size_t row = (size_t)b * 256 + ksub * 16 + li;
#pragma unroll
        for (int cs = 0; cs < 8; ++cs) {
            const int ch = chb * 128 + cs * 16 + quad * 4;
            const uint2 g = *(const uint2*)(PJ(row, 6, ch));
            uint2 wv; wv.x = pack2(a[cs][0] * NORM_CTX * siluf_(bflo(g.x)), a[cs][1] * NORM_CTX * siluf_(bfhi(g.x))); wv.y = pack2(a[cs][2] * NORM_CTX * siluf_(bflo(g.y)), a[cs][3] * NORM_CTX * siluf_(bfhi(g.y)));
            *(uint2*)(Y1 + row * 512 + ch) = wv;
        }
    }
    __syncthreads();
}

__device__ void gmlp_item(const Params& p, int l, int item, unsigned char* lds) {
    unsigned char* ws = opaque(p.ws);
    const u16* PROJ = (const u16*)(ws + OFF_PROJ); const u16* WS16 = (const u16*)(ws + OFF_WS16) + (size_t)l * 8 * 128 * 128;
    u16* Y2 = (u16*)(ws + OFF_Y) + (size_t)2 * MLAT * 512;
    const int tid = tidx(), w = tid >> 6, lane = tid & 63, li = lane & 15, quad = lane >> 4;
    const size_t r0 = (size_t)item * 128;
    u16* VN = (u16*)lds;
    {
        const int row = tid >> 2, qd = tid & 3;
        const u16* src = PJ(r0 + row, 8, 0);
        uint4 raw[16]; float ss = 0.f;
#pragma unroll
        for (int i = 0; i < 16; ++i) { raw[i] = *(const uint4*)(src + (qd + 4 * i) * 8); float f[8]; unpack8(raw[i], f);
#pragma unroll
            for (int e = 0; e < 8; ++e) ss += f[e] * f[e]; }
        ss += shx(ss, 1); ss += shx(ss, 2);
        const float rstd = rsqrtf(ss * (1.f / 512.f) + EPSN);
        const float* gn = p.gmlp_g + l * 512;
#pragma unroll
        for (int i = 0; i < 16; ++i) { float f[8]; unpack8(raw[i], f); const int c0 = (qd + 4 * i) * 8;
            const float4 g0 = *(const float4*)(gn + c0), g1 = *(const float4*)(gn + c0 + 4);
            uint4 o; o.x = pack2(f[0] * rstd * g0.x, f[1] * rstd * g0.y); o.y = pack2(f[2] * rstd * g0.z, f[3] * rstd * g0.w);
            o.z = pack2(f[4] * rstd * g1.x, f[5] * rstd * g1.y); o.w = pack2(f[6] * rstd * g1.z, f[7] * rstd * g1.w);
            *(uint4*)(VN + row * TS + c0) = o; }
    }
    __syncthreads();
    const int g = w;
    bf16x8 xf[4][4];
#pragma unroll
    for (int cs = 0; cs < 4; ++cs)
#pragma unroll
        for (int ks = 0; ks < 4; ++ks) { const u16* tp = VN + (ks * 32 + quad * 8 + (li >> 2)) * TS + g * 64 + cs * 16 + 4 * (li & 3); xf[cs][ks] = tr_read2(tp, tp + 4 * TS); }
    bf16x8 yf[4]; uint2 uu[4], gg[4]; float bs;
#define GM_LOAD(ts_, yf_, uu_, gg_, bs_) do { const int t_ = (ts_) * 16 + li; _Pragma("unroll") for (int ks = 0; ks < 4; ++ks) yf_[ks] = ld_frag_g(WS16 + ((size_t)g * 128 + t_) * 128 + ks * 32 + quad * 8); \
        bs_ = p.gmlp_bs[((size_t)l * 8 + g) * 128 + t_]; _Pragma("unroll") for (int cs = 0; cs < 4; ++cs) { const int c_ = g * 64 + cs * 16 + quad * 4; uu_[cs] = *(const uint2*)(PJ(r0 + t_, 7, c_)); gg_[cs] = *(const uint2*)(PJ(r0 + t_, 9, c_)); } } while (0)
    GM_LOAD(0, yf, uu, gg, bs);
    for (int ts = 0; ts < 8; ++ts) {
        bf16x8 yn[4]; uint2 un[4], gn[4]; float bn;
        const int tn = ts < 7 ? ts + 1 : 7;
        GM_LOAD(tn, yn, un, gn, bn);
        const int t = ts * 16 + li;
        const size_t row = r0 + t;
#pragma unroll
        for (int cs = 0; cs < 4; ++cs) {
            f32x4 a = (f32x4){0.f, 0.f, 0.f, 0.f};
#pragma unroll
            for (int ks = 0; ks < 4; ++ks) a = MFMA16(xf[cs][ks], yf[ks], a);
            const int c = g * 64 + cs * 16 + quad * 4;
            uint2 wv; wv.x = pack2(bflo(uu[cs].x) * (a[0] + bs) * siluf_(bflo(gg[cs].x)), bfhi(uu[cs].x) * (a[1] + bs) * siluf_(bfhi(gg[cs].x)));
            wv.y = pack2(bflo(uu[cs].y) * (a[2] + bs) * siluf_(bflo(gg[cs].y)), bfhi(uu[cs].y) * (a[3] + bs) * siluf_(bfhi(gg[cs].y)));
            *(uint2*)(Y2 + row * 512 + c) = wv;
        }
#pragma unroll
        for (int q = 0; q < 4; ++q) { yf[q] = yn[q]; uu[q] = un[q]; gg[q] = gn[q]; }
        bs = bn;
    }
#undef GM_LOAD
    __syncthreads();
}

__device__ __forceinline__ void chunk_cumsum(float* A, float* tmp, int dir) {
    const int k = tidx() & 63, seg = tidx() >> 6;
    float v[8]; float run = 0.f;
    if (dir == 0) {
#pragma unroll
        for (int e = 0; e < 8; ++e) { run += A[(seg * 8 + e) * HS_ + k]; v[e] = run; }
    } else {
#pragma unroll
        for (int e = 7; e >= 0; --e) { run += A[(seg * 8 + e) * HS_ + k]; v[e] = run; }
    }
    tmp[seg * 64 + k] = run;
    __syncthreads();
    float off = 0.f;
#pragma unroll
    for (int s2 = 0; s2 < 8; ++s2) { const float tv = tmp[s2 * 64 + k]; if (dir == 0 ? (s2 < seg) : (s2 > seg)) off += tv; }
#pragma unroll
    for (int e = 0; e < 8; ++e) A[(seg * 8 + e) * HS_ + k] = (v[e] + off) * LOG2E;
    __syncthreads();
}
__device__ __forceinline__ void chunk_cumsum2(float* Af, float* Ab, float* tmp) {
    const int k = tidx() & 63, seg = tidx() >> 6;
    float vf[8], vb[8]; float rf = 0.f, rb = 0.f;
#pragma unroll
    for (int e = 0; e < 8; ++e) { rf += Af[(seg * 8 + e) * HS_ + k]; vf[e] = rf; }
#pragma unroll
    for (int e = 7; e >= 0; --e) { rb += Ab[(seg * 8 + e) * HS_ + k]; vb[e] = rb; }
    tmp[seg * 64 + k] = rf; tmp[512 + seg * 64 + k] = rb;
    __syncthreads();
    float of = 0.f, ob = 0.f;
#pragma unroll
    for (int s2 = 0; s2 < 8; ++s2) { const float tf = tmp[s2 * 64 + k], tb = tmp[512 + s2 * 64 + k]; if (s2 < seg) of += tf; if (s2 > seg) ob += tb; }
#pragma unroll
    for (int e = 0; e < 8; ++e) { Af[(seg * 8 + e) * HS_ + k] = (vf[e] + of) * LOG2E; Ab[(seg * 8 + e) * HS_ + k] = (vb[e] + ob) * LOG2E; }
    __syncthreads();
}
__device__ __forceinline__ void load_bf_tile64(float* dst, const u16* src  , size_t sstride) {
    const int t = tidx() >> 3, k8 = (tidx() & 7) * 8;
    float f[8]; unpack8(*(const uint4*)(src + (size_t)t * sstride + k8), f);
    *(float4*)(dst + t * HS_ + k8) = make_float4(f[0], f[1], f[2], f[3]); *(float4*)(dst + t * HS_ + k8 + 4) = make_float4(f[4], f[5], f[6], f[7]);
}
__device__ __forceinline__ void load_f32_tile64(float* dst, const float* src, size_t sstride) {
    const int t = tidx() >> 3, k8 = (tidx() & 7) * 8;
    *(float4*)(dst + t * HS_ + k8) = *(const float4*)(src + (size_t)t * sstride + k8); *(float4*)(dst + t * HS_ + k8 + 4) = *(const float4*)(src + (size_t)t * sstride + k8 + 4);
}

__device__ __forceinline__ void hgrn1_issue(const u16* PROJ, const float* LOGF, const PassInfo ps, int item, Reg8& rg) {
    const int NC = ps.T >> 6, ncsh = ps.is_ctx ? 2 : 6, c = item & (NC - 1), ci = item >> ncsh, dir = ci & 1, h = (ci >> 1) & 7, bl = ci >> 4;
    const size_t r0 = (size_t)bl * ps.T + c * 64;
    const int t = tidx() >> 3, k8 = (tidx() & 7) * 8;
    const float* ap = LOGF + (r0 + t) * 1024 + dir * 512 + h * 64 + k8;
    rg.ld(0, ap); rg.ld(1, ap + 4); rg.ld(2, PJ(r0 + t, 11 + dir, h * 64 + k8)); rg.ld(3, PJ(r0 + t, 13, h * 64 + k8));
}
__device__ void hgrn1_loop(const Params& p, const PassInfo ps, int first, int end, int stride, unsigned char* lds) {
    if (first >= end) return;
    unsigned char* ws = opaque(p.ws);
    const u16* PROJ = (const u16*)(ws + OFF_PROJ); const float* LOGF = (const float*)(ws + OFF_LOGF);
    u16* HL = (u16*)(ws + OFF_HL); float* HD = (float*)(ws + OFF_HD);
    float* A = (float*)lds; float* tmp = A + 64 * HS_; u16* Wb = (u16*)(tmp + 512); u16* Ib = Wb + 64 * KVS;
    const int tid = tidx(), w = tid >> 6, lane = tid & 63, li = lane & 15, quad = lane >> 4;
    const int t = tid >> 3, k8 = (tid & 7) * 8;
    Reg8 rg;
    hgrn1_issue(PROJ, LOGF, ps, first, rg);
  for (int item = first; item < end; item += stride) {
    const int ncsh = ps.is_ctx ? 2 : 6, ci = item >> ncsh, dir = ci & 1;
    float kf[8];
    { MEMBAR();
      unpack8(rg.getu(2), kf);
      *(u32x4_*)(A + t * HS_ + k8) = rg.get(0); *(u32x4_*)(A + t * HS_ + k8 + 4) = rg.get(1);
      *(u32x4_*)(Ib + t * KVS + k8) = rg.get(3); }
    __syncthreads();
    if (item + stride < end) hgrn1_issue(PROJ, LOGF, ps, item + stride, rg);
    chunk_cumsum(A, tmp, dir);
    const int lastt = dir == 0 ? 63 : 0;
    { float wv[8];
#pragma unroll
      for (int e = 0; e < 8; ++e) wv[e] = kf[e] * __builtin_amdgcn_exp2f(A[lastt * HS_ + k8 + e] - A[t * HS_ + k8 + e]);
      uint4 wq; wq.x = pack2(wv[0], wv[1]); wq.y = pack2(wv[2], wv[3]); wq.z = pack2(wv[4], wv[5]); wq.w = pack2(wv[6], wv[7]);
      *(uint4*)(Wb + t * KVS + k8) = wq;
      if (tid < 64) HD[(size_t)item * 64 + tid] = __builtin_amdgcn_exp2f(A[lastt * HS_ + tid]); }
    __syncthreads();
    {
        const int ksub = w >> 1;
        bf16x8 yf[2];
#pragma unroll
        for (int ks = 0; ks < 2; ++ks) { const u16* tp = Wb + (ks * 32 + quad * 8 + (li >> 2)) * KVS + ksub * 16 + 4 * (li & 3); yf[ks] = tr_read2(tp, tp + 4 * KVS); }
#pragma unroll
        for (int vv = 0; vv < 2; ++vv) {
            const int vsub = (w & 1) * 2 + vv;
            f32x4 a = (f32x4){0.f, 0.f, 0.f, 0.f};
#pragma unroll
            for (int ks = 0; ks < 2; ++ks) { const u16* tp = Ib + (ks * 32 + quad * 8 + (li >> 2)) * KVS + vsub * 16 + 4 * (li & 3); a = MFMA16(tr_read2(tp, tp + 4 * KVS), yf[ks], a); }
            uint2 o; o.x = pack2(a[0], a[1]); o.y = pack2(a[2], a[3]);
            *(uint2*)(HL + ((size_t)item * 64 + ksub * 16 + li) * 64 + vsub * 16 + quad * 4) = o;
        }
    }
    __syncthreads();
  }
}

__device__ void hgrn2_all(const Params& p, const PassInfo ps, int l) {
    unsigned char* ws = opaque(p.ws);
    const unsigned* HL = (const unsigned*)(ws + OFF_HL); const float* HD = (const float*)(ws + OFF_HD); unsigned* HS = (unsigned*)(ws + OFF_HS);
    float* CST = (float*)(ws + OFF_CTXST) + (size_t)l * 256 * 4096;
    const int NC = ps.T >> 6, chains = ps.nb * 16;
    const size_t total = (size_t)chains * 2048;
    for (size_t e = (size_t)blockIdx.x * 512 + tidx(); e < total; e += (size_t)gridDim.x * 512) {
        const int ci = (int)(e >> 11), kv2 = (int)(e & 2047), k = kv2 >> 5, dir = ci & 1;
        float s0 = 0.f, s1 = 0.f;
        if (!ps.is_ctx) { const float2 cs = *(const float2*)(CST + ((size_t)ps.b0 * 16 + ci) * 4096 + 2 * kv2); s0 = cs.x; s1 = cs.y; }
#define HG2_TRIP(BLK) for (int c4 = 0; c4 < NC; c4 += BLK) { float d[BLK]; unsigned lw[BLK]; \
            _Pragma("unroll") for (int j = 0; j < BLK; ++j) { const int c = dir ? NC - 1 - (c4 + j) : c4 + j; const size_t idx = (size_t)ci * NC + c; d[j] = HD[idx * 64 + k]; lw[j] = HL[idx * 2048 + kv2]; } \
            _Pragma("unroll") for (int j = 0; j < BLK; ++j) { const int c = dir ? NC - 1 - (c4 + j) : c4 + j; const size_t idx = (size_t)ci * NC + c; \
                HS[idx * 2048 + kv2] = pack2(s0, s1); s0 = d[j] * s0 + bflo(lw[j]); s1 = d[j] * s1 + bfhi(lw[j]); } }
        if (NC == 4) { HG2_TRIP(4) } else { HG2_TRIP(16) }
#undef HG2_TRIP
        if (ps.is_ctx) *(float2*)(CST + (size_t)ci * 4096 + 2 * kv2) = make_float2(s0, s1);
    }
}

__device__ void hgrn3_item(const Params& p, const PassInfo ps, int l, int item, unsigned char* lds) {
    unsigned char* ws = opaque(p.ws);
    const u16* PROJ = (const u16*)(ws + OFF_PROJ); const float* LOGF = (const float*)(ws + OFF_LOGF); const u16* HSt = (const u16*)(ws + OFF_HS);
    u16* Y3 = (u16*)(ws + OFF_Y) + (size_t)3 * MLAT * 512;
    const int NC = ps.T >> 6, ncsh = ps.is_ctx ? 2 : 6, c = item & (NC - 1), bh = item >> ncsh, h = bh & 7, bl = bh >> 3;
    const size_t r0 = (size_t)bl * ps.T + c * 64;
    const size_t idxf = (size_t)(bh * 2 + 0) * NC + c, idxb = (size_t)(bh * 2 + 1) * NC + c;
    float* Q = (float*)lds; float* KKf = Q + 64 * HS_; float* KKb = KKf + 64 * HS_; float* Af = KKb + 64 * HS_; float* Ab = Af + 64 * HS_; float* tmp = Ab + 64 * HS_;
    u16* Ib = (u16*)(tmp + 1024); u16* Sfb = Ib + 64 * KVS; u16* Sbb = Sfb + 64 * KVS; float* comb = (float*)(Sbb + 64 * KVS);
    const int tid = tidx(), w = tid >> 6, lane = tid & 63, li = lane & 15, quad = lane >> 4;
    { const int t = tid >> 3, k8 = (tid & 7) * 8;
      Reg8 ra, rb;
      const float* ap = LOGF + (r0 + t) * 1024 + h * 64 + k8;
      const u16* sf = HSt + idxf * 4096 + t * 64 + k8; const u16* sb = HSt + idxb * 4096 + t * 64 + k8;
      ra.ld(0, PJ(r0 + t, 10, h * 64 + k8)); ra.ld(1, PJ(r0 + t, 11, h * 64 + k8)); ra.ld(2, PJ(r0 + t, 12, h * 64 + k8)); ra.ld(3, PJ(r0 + t, 13, h * 64 + k8));
      ra.ld(4, ap); ra.ld(5, ap + 4); ra.ld(6, ap + 512); ra.ld(7, ap + 516);
      rb.ld(0, sf); rb.ld(1, sb);
      MEMBAR();
      float x[8];
      unpack8(ra.getu(0), x); *(float4*)(Q + t * HS_ + k8) = make_float4(x[0], x[1], x[2], x[3]); *(float4*)(Q + t * HS_ + k8 + 4) = make_float4(x[4], x[5], x[6], x[7]);
      unpack8(ra.getu(1), x); *(float4*)(KKf + t * HS_ + k8) = make_float4(x[0], x[1], x[2], x[3]); *(float4*)(KKf + t * HS_ + k8 + 4) = make_float4(x[4], x[5], x[6], x[7]);
      unpack8(ra.getu(2), x); *(float4*)(KKb + t * HS_ + k8) = make_float4(x[0], x[1], x[2], x[3]); *(float4*)(KKb + t * HS_ + k8 + 4) = make_float4(x[4], x[5], x[6], x[7]);
      *(u32x4_*)(Ib + t * KVS + k8) = ra.get(3);
      *(u32x4_*)(Af + t * HS_ + k8) = ra.get(4); *(u32x4_*)(Af + t * HS_ + k8 + 4) = ra.get(5); *(u32x4_*)(Ab + t * HS_ + k8) = ra.get(6); *(u32x4_*)(Ab + t * HS_ + k8 + 4) = ra.get(7);
      *(u32x4_*)(Sfb + t * KVS + k8) = rb.get(0); *(u32x4_*)(Sbb + t * KVS + k8) = rb.get(1); }
    __syncthreads();
    chunk_cumsum2(Af, Ab, tmp);
    const int dir = w >> 2, T = w & 3;
    const float* A = dir ? Ab : Af; const float* KK = dir ? KKb : KKf; const u16* Sb16 = dir ? Sbb : Sfb;
    const int t = 16 * T + li;
    const int rrow = dir ? 16 * T + 16 : 16 * T - 1; const bool rzero = dir ? (T == 3) : (T == 0);
    bf16x8 qt[2], qh[2];
    float Rv[2][8];
#pragma unroll
    for (int ks = 0; ks < 2; ++ks) {
        const int k0 = ks * 32 + quad * 8;
        float qv[8], av[8];
        { const float4 x0 = *(const float4*)(Q + t * HS_ + k0), x1 = *(const float4*)(Q + t * HS_ + k0 + 4); qv[0] = x0.x; qv[1] = x0.y; qv[2] = x0.z; qv[3] = x0.w; qv[4] = x1.x; qv[5] = x1.y; qv[6] = x1.z; qv[7] = x1.w; }
        { const float4 x0 = *(const float4*)(A + t * HS_ + k0), x1 = *(const float4*)(A + t * HS_ + k0 + 4); av[0] = x0.x; av[1] = x0.y; av[2] = x0.z; av[3] = x0.w; av[4] = x1.x; av[5] = x1.y; av[6] = x1.z; av[7] = x1.w; }
        if (rzero) {
#pragma unroll
            for (int e = 0; e < 8; ++e) Rv[ks][e] = 0.f;
        } else { const float4 x0 = *(const float4*)(A + rrow * HS_ + k0), x1 = *(const float4*)(A + rrow * HS_ + k0 + 4); Rv[ks][0] = x0.x; Rv[ks][1] = x0.y; Rv[ks][2] = x0.z; Rv[ks][3] = x0.w; Rv[ks][4] = x1.x; Rv[ks][5] = x1.y; Rv[ks][6] = x1.z; Rv[ks][7] = x1.w; }
        float a_[8], b_[8];
#pragma unroll
        for (int e = 0; e < 8; ++e) { a_[e] = qv[e] * __builtin_amdgcn_exp2f(av[e] - Rv[ks][e]); b_[e] = qv[e] * __builtin_amdgcn_exp2f(av[e]); }
        const unsigned a0 = pack2(a_[0], a_[1]), a1 = pack2(a_[2], a_[3]), a2 = pack2(a_[4], a_[5]), a3 = pack2(a_[6], a_[7]);
        const unsigned b0 = pack2(b_[0], b_[1]), b1 = pack2(b_[2], b_[3]), b2 = pack2(b_[4], b_[5]), b3 = pack2(b_[6], b_[7]);
        qt[ks] = (bf16x8){(short)(a0 & 0xffff), (short)(a0 >> 16), (short)(a1 & 0xffff), (short)(a1 >> 16), (short)(a2 & 0xffff), (short)(a2 >> 16), (short)(a3 & 0xffff), (short)(a3 >> 16)};
        qh[ks] = (bf16x8){(short)(b0 & 0xffff), (short)(b0 >> 16), (short)(b1 & 0xffff), (short)(b1 >> 16), (short)(b2 & 0xffff), (short)(b2 >> 16), (short)(b3 & 0xffff), (short)(b3 >> 16)};
    }
    const int nS = dir ? 4 - T : T + 1;
    float sc[4][4];
#pragma unroll
    for (int i = 0; i < 4; ++i) {
        if (i < nS) {
            const int S = dir ? T + i : i, srow = 16 * S + li;
            f32x4 a = (f32x4){0.f, 0.f, 0.f, 0.f};
#pragma unroll
            for (int ks = 0; ks < 2; ++ks) {
                const int k0 = ks * 32 + quad * 8;
                const float4 x0 = *(const float4*)(KK + srow * HS_ + k0), x1 = *(const float4*)(KK + srow * HS_ + k0 + 4);
                const float4 y0 = *(const float4*)(A + srow * HS_ + k0), y1 = *(const float4*)(A + srow * HS_ + k0 + 4);
                const float kv[8] = {x0.x, x0.y, x0.z, x0.w, x1.x, x1.y, x1.z, x1.w}, as[8] = {y0.x, y0.y, y0.z, y0.w, y1.x, y1.y, y1.z, y1.w};
                float c_[8];
#pragma unroll
                for (int e = 0; e < 8; ++e) c_[e] = kv[e] * __builtin_amdgcn_exp2f(Rv[ks][e] - as[e]);
                const unsigned c0 = pack2(c_[0], c_[1]), c1 = pack2(c_[2], c_[3]), c2 = pack2(c_[4], c_[5]), c3 = pack2(c_[6], c_[7]);
                const bf16x8 kf = (bf16x8){(short)(c0 & 0xffff), (short)(c0 >> 16), (short)(c1 & 0xffff), (short)(c1 >> 16), (short)(c2 & 0xffff), (short)(c2 >> 16), (short)(c3 & 0xffff), (short)(c3 >> 16)};
                a = MFMA16(kf, qt[ks], a);
            }
            const bool diag = (S == T);
#pragma unroll
            for (int j = 0; j < 4; ++j) { const int sl = quad * 4 + j; const bool keep = !diag || (dir ? (sl >= li) : (sl <= li)); sc[i][j] = keep ? a[j] : 0.f; }
        } else {
#pragma unroll
            for (int j = 0; j < 4; ++j) sc[i][j] = 0.f;
        }
    }
    f32x4 O[4];
#pragma unroll
    for (int v = 0; v < 4; ++v) O[v] = (f32x4){0.f, 0.f, 0.f, 0.f};
#pragma unroll
    for (int pr = 0; pr < 2; ++pr) {
        if (2 * pr < nS) {
            const unsigned a0 = pack2(sc[2 * pr][0], sc[2 * pr][1]), a1 = pack2(sc[2 * pr][2], sc[2 * pr][3]), b0 = pack2(sc[2 * pr + 1][0], sc[2 * pr + 1][1]), b1 = pack2(sc[2 * pr + 1][2], sc[2 * pr + 1][3]);
            const bf16x8 pf = (bf16x8){(short)(a0 & 0xffff), (short)(a0 >> 16), (short)(a1 & 0xffff), (short)(a1 >> 16), (short)(b0 & 0xffff), (short)(b0 >> 16), (short)(b1 & 0xffff), (short)(b1 >> 16)};
            const int S0 = dir ? T + 2 * pr : 2 * pr; int S1 = S0 + 1; if (S1 > 3) S1 = 3;
            const u16* p0 = Ib + (16 * S0 + quad * 4 + (li >> 2)) * KVS + 4 * (li & 3);
            const u16* p1 = Ib + (16 * S1 + quad * 4 + (li >> 2)) * KVS + 4 * (li & 3);
#pragma unroll
            for (int v = 0; v < 4; ++v) O[v] = MFMA16(tr_read2(p0 + v * 16, p1 + v * 16), pf, O[v]);
        }
    }
#pragma unroll
    for (int ks = 0; ks < 2; ++ks) {
        const u16* p0 = Sb16 + (ks * 32 + quad * 8 + (li >> 2)) * KVS + 4 * (li & 3);
#pragma unroll
        for (int v = 0; v < 4; ++v) O[v] = MFMA16(tr_read2(p0 + v * 16, p0 + 4 * KVS + v * 16), qh[ks], O[v]);
    }
    if (dir == 1) {
#pragma unroll
        for (int v = 0; v < 4; ++v)
#pragma unroll
            for (int j = 0; j < 4; ++j) comb[(T * 16 + v * 4 + j) * 64 + lane] = O[v][j];
    }
    __syncthreads();
    if (dir == 0) {
        float ss = 0.f;
#pragma unroll
        for (int v = 0; v < 4; ++v)
#pragma unroll
            for (int j = 0; j < 4; ++j) { O[v][j] += comb[(T * 16 + v * 4 + j) * 64 + lane]; ss += O[v][j] * O[v][j]; }
        ss += shx(ss, 16); ss += shx(ss, 32);
        const float rstd = rsqrtf(ss * (1.f / 64.f) + EPSN);
        const size_t row = r0 + t;
#pragma unroll
        for (int v = 0; v < 4; ++v) {
            const int col = h * 64 + v * 16 + quad * 4;
            const float4 gn = *(const float4*)(p.hgrn_g + l * 512 + col);
            const uint2 g = *(const uint2*)(PJ(row, 14, col));
            uint2 wv; wv.x = pack2(O[v][0] * rstd * gn.x * siluf_(bflo(g.x)), O[v][1] * rstd * gn.y * siluf_(bfhi(g.x))); wv.y = pack2(O[v][2] * rstd * gn.z * siluf_(bflo(g.y)), O[v][3] * rstd * gn.w * siluf_(bfhi(g.y)));
            *(uint2*)(Y3 + row * 512 + col) = wv;
        }
    }
    __syncthreads();
}
#define XB_TMO      128
#define XB_XCNT(j)  (256  + 64 * (j))
#define XB_XSUB(j)  (1280 + 64 * (j))
#define XB_XGEN(j)  (2304 + 64 * (j))
#define XB_TOP      3328
#define XB_TOPGEN   3392
#define XCD_BAR_WORDS 3456
#define XB_SPIN_CAP (1u << 18)

__device__ __forceinline__ unsigned xb_ld(unsigned* p)              { return __hip_atomic_load(p, __ATOMIC_RELAXED, __HIP_MEMORY_SCOPE_AGENT); }
__device__ __forceinline__ unsigned xb_add(unsigned* p, unsigned v) { return __hip_atomic_fetch_add(p, v, __ATOMIC_RELAXED, __HIP_MEMORY_SCOPE_AGENT); }
__device__ __forceinline__ unsigned xb_xcc_id() { return (unsigned)__builtin_amdgcn_s_getreg((3 << 11) | 20) & 0xFu; }
#define XB_SPIN(cond, bar) do { unsigned _sp = 0; while (cond) { __builtin_amdgcn_s_sleep(1); \
    if ((++_sp & 255u) == 0u) { if (xb_ld(&(bar)[XB_TMO])) break; if (_sp > XB_SPIN_CAP) { atomicAdd(&(bar)[XB_TMO], 1u); break; } } } } while (0)

struct XcdBarrier {
    unsigned* bar; unsigned x;
    volatile LAS unsigned* st;
};

__device__ __forceinline__ XcdBarrier xcd_barrier_post(unsigned* bar, volatile LAS unsigned* st) {
    XcdBarrier b; b.bar = bar; b.x = xb_xcc_id(); b.st = st;
    if (tidx() == 0) (void)xb_add(&bar[XB_XCNT(b.x)], 1u);
    return b;
}
__device__ __forceinline__ void xcd_barrier_complete(unsigned* bar, unsigned x, unsigned& nloc, unsigned& nx) {
    const unsigned G = gridDim.x * gridDim.y * gridDim.z;
    unsigned sum, cnt, mine, sp = 0u;
    for (;;) {
        sum = 0u; cnt = 0u; mine = 0u;
#pragma unroll
        for (unsigned j = 0; j < 16; ++j) { const unsigned c = xb_ld(&bar[XB_XCNT(j)]); sum += c; cnt += (c > 0u) ? 1u : 0u; mine = (j == x) ? c : mine; }
        if (sum == G) break;
        __builtin_amdgcn_s_sleep(1);
        if ((++sp & 255u) == 0u) { if (xb_ld(&bar[XB_TMO])) break; if (sp > XB_SPIN_CAP) { atomicAdd(&bar[XB_TMO], 1u); break; } }
    }
    nloc = mine > 0u ? mine : 1u; nx = cnt > 0u ? cnt : 1u;
}

__device__ __forceinline__ void xcd_barrier(const XcdBarrier& b) {
    asm volatile("s_waitcnt vmcnt(0)" ::: "memory");
    __syncthreads();
    if (tidx() == 0) {
        unsigned* bar = b.bar;
        __builtin_amdgcn_s_waitcnt(0);
        unsigned nloc = b.st[0], nx = b.st[1];
        if (nloc == 0u) { xcd_barrier_complete(bar, b.x, nloc, nx); b.st[0] = nloc; b.st[1] = nx; }
        const unsigned old = xb_add(&bar[XB_XSUB(b.x)], 1u);
        const unsigned gen = old / nloc;
        if (old + 1u == (gen + 1u) * nloc) {
            __builtin_amdgcn_fence(__ATOMIC_RELEASE, "agent");
            asm volatile("s_waitcnt vmcnt(0)" ::: "memory");
            const unsigned og = xb_add(&bar[XB_TOP], 1u);
            const unsigned tg = og / nx;
            if (og + 1u == (tg + 1u) * nx) xb_add(&bar[XB_TOPGEN], 1u);
            else XB_SPIN(xb_ld(&bar[XB_TOPGEN]) == tg, bar);
            __builtin_amdgcn_fence(__ATOMIC_ACQUIRE, "agent");
            xb_add(&bar[XB_XGEN(b.x)], 1u);
            asm volatile("s_waitcnt vmcnt(0)" ::: "memory");
        } else {
            XB_SPIN(xb_ld(&bar[XB_XGEN(b.x)]) == gen, bar);
            __builtin_amdgcn_fence(__ATOMIC_ACQUIRE, "agent");
            asm volatile("s_waitcnt vmcnt(0)" ::: "memory");
        }
    }
    __syncthreads();
}

#ifndef STAG_B
#define STAG_B 240
#endif
#ifndef STAG_D
#define STAG_D 300
#endif
#ifndef REP_ATTN
#define REP_ATTN 1
#endif
#ifndef REP_B
#define REP_B 1
#endif
#ifndef REP_C1
#define REP_C1 1
#endif
#ifndef REP_C2
#define REP_C2 1
#endif
#ifndef REP_C3
#define REP_C3 1
#endif
#ifndef REP_DE
#define REP_DE 1
#endif
__device__ __forceinline__ void stagger(int ticks_per_slot) {
    const int slot = ((int)blockIdx.x >> 3) & 7;
    if (slot) { const unsigned long long t0 = __builtin_amdgcn_s_memrealtime(), dt = (unsigned long long)(slot * ticks_per_slot);
        while (__builtin_amdgcn_s_memrealtime() - t0 < dt) __builtin_amdgcn_s_sleep(4); }
}
template <class Epi> __device__ __forceinline__ void run_gemm(LAS unsigned char* lds, const u16* A, const u16* Bt, int M, int N, int K, const Epi& E) {
    pg8::Gemm g; g.A = A; g.Bt = Bt; g.M = M; g.N = N; g.K = K; g.rsA = 0; g.rsB = 0;
    pg8::StaticOrder S; S.init(M, N, (int)gridDim.x, (int)blockIdx.x);
    pg8::gemm_phase<Epi, pg8::StaticOrder, false>(lds, g, S, E, nullptr);
}


struct EpiNull {
    static constexpr bool PERM = true, AFTER_DRAIN = false;
    unsigned char* ws;
    __device__ __forceinline__ void operator()(const f32x4 (&acc)[2][2][4][2], const Unit& u, int wr, int wc, int fr, int fq) const {
        if (ws == nullptr) {
#pragma unroll
            for (int ai = 0; ai < 2; ++ai)
#pragma unroll
                for (int bj = 0; bj < 2; ++bj)
#pragma unroll
                    for (int m = 0; m < 4; ++m)
#pragma unroll
                        for (int n = 0; n < 2; ++n) *(f32x4*)(ws + (size_t)(((ai * 2 + bj) * 4 + m) * 2 + n) * 16 + fr * 1024 + fq * 65536 + wr * 4096 + wc * 16384 + u.pm) = acc[ai][bj][m][n];
        }
    }
};
struct MergeOrder : pg8::StaticOrder {
    __device__ bool next(int i, Unit& u) const { if (!pg8::StaticOrder::next(i >> 2, u)) return false; u.r = i & 3; return true; }
};
__device__ __forceinline__ Params KP() {
    auto q0 = __builtin_amdgcn_kernarg_segment_ptr();
    asm volatile("" : "+s"(q0));
    const __attribute__((address_space(4))) Params* q = (const __attribute__((address_space(4))) Params*)q0;
    Params r;
    r.x = q->x; r.c = q->c; r.ctx = q->ctx; r.c_ctx = q->c_ctx; r.w_ada = q->w_ada; r.b_ada = q->b_ada; r.g_pre = q->g_pre; r.g_post = q->g_post; r.w_in = q->w_in; r.rpb = q->rpb;
    r.fnet_w = q->fnet_w; r.gmlp_g = q->gmlp_g; r.gmlp_ws = q->gmlp_ws; r.gmlp_bs = q->gmlp_bs; r.lb_logits = q->lb_logits; r.hgrn_g = q->hgrn_g; r.w_branch = q->w_branch; r.w_out = q->w_out;
    r.out = q->out; r.ws = q->ws; return r;
}
constexpr size_t OFF_BAR = WS_END;
constexpr size_t WS_END2 = WS_END + (size_t)XCD_BAR_WORDS * 4;
__device__ __forceinline__ void gsync(LAS unsigned char* lds3) {
    XcdBarrier b; b.bar = (unsigned*)(opaque(KP().ws) + OFF_BAR); b.x = xb_xcc_id(); b.st = (volatile LAS unsigned*)(lds3 + LDS_BYTES);
    xcd_barrier(b);
}
__global__ void __launch_bounds__(512, 2) mega_fwd(Params p_unused) {
    extern __shared__ __attribute__((aligned(16))) unsigned char shm[];
    LAS unsigned char* lds3 = (LAS unsigned char*)shm;
    {
        if (tidx() < 4) ((volatile LAS unsigned*)(lds3 + LDS_BYTES))[tidx()] = 0u;
        if (blockIdx.x == 0) { unsigned* bar = (unsigned*)(opaque(KP().ws) + OFF_BAR); for (int i = tidx(); i < XCD_BAR_WORDS; i += 512) bar[i] = 0u; }
        __syncthreads();
    }
    prep1(KP(), shm);
    cg::this_grid().sync();
    { XcdBarrier b0 = xcd_barrier_post((unsigned*)(opaque(KP().ws) + OFF_BAR), (volatile LAS unsigned*)(lds3 + LDS_BYTES)); (void)b0; }
    prep2(KP(), shm);
    gsync(lds3);
#pragma nounroll
    for (int pass = 0; pass < 1 + NBATCH / GB; ++pass) {
        PassInfo ps;
        if (pass == 0) { ps.is_ctx = 1; ps.nb = NBATCH; ps.T = CTXL; ps.M = MCTX; ps.b0 = 0; }
        else { ps.is_ctx = 0; ps.nb = GB; ps.T = SEQ; ps.M = MLAT; ps.b0 = (pass - 1) * GB; }
        const int NC = ps.T >> 6;
#pragma nounroll
        for (int l = 0; l < DEPTH; ++l) {
            phase_norm(KP(), ps, l);
            gsync(lds3);
            _Pragma("nounroll") for (int rep = 0; rep < REP_B; ++rep) {
                unsigned char* ws = opaque(KP().ws);
                EpiProj E; E.ws = ws; E.l = l; E.is_ctx = ps.is_ctx;

                run_gemm(lds3, (const u16*)(ws + OFF_H), (const u16*)(ws + OFF_WTIN) + (size_t)l * NPROJ * DM, ps.M, NPROJ, DM, E);
                gsync(lds3);
#ifdef PROBE_NULL_B
                { EpiNull EN; EN.ws = ws; run_gemm(lds3, (const u16*)(ws + OFF_H), (const u16*)(ws + OFF_WTIN) + (size_t)l * NPROJ * DM, ps.M, NPROJ, DM, EN); gsync(lds3); }
#endif
            }
            const bool full = !(ps.is_ctx && l == DEPTH - 1);
            _Pragma("nounroll") for (int rep = 0; rep < REP_C1; ++rep) {
                const int n_h1 = ps.nb * 16 * NC, n_at = full ? ps.nb * 8 * (ps.T >> 6) : 0, n_f1 = ps.is_ctx ? 0 : ps.nb * 64, n_g = full ? (ps.M >> 7) : 0;
                hgrn1_loop(KP(), ps, (int)blockIdx.x, n_h1, (int)gridDim.x, shm);
                for (int it = (int)blockIdx.x + ((n_h1 - (int)blockIdx.x + (int)gridDim.x - 1) / (int)gridDim.x) * (int)gridDim.x; it < n_h1 + n_at + n_f1 + n_g; it += gridDim.x) {
                    if (it < n_h1 + n_at) { _Pragma("nounroll") for (int r2 = 0; r2 < REP_ATTN; ++r2) attn_item(KP(), ps, l, it - n_h1, shm); }
                    else if (it < n_h1 + n_at + n_f1) four1_item(KP(), it - n_h1 - n_at, shm);
                    else gmlp_item(KP(), l, it - n_h1 - n_at - n_f1, shm);
                }
                gsync(lds3);
            }
            _Pragma("nounroll") for (int rep = 0; rep < REP_C2; ++rep) {
                hgrn2_all(KP(), ps, l);
                if (full) {
                    const int n_f2 = ps.is_ctx ? ps.nb * 4 : ps.nb * 64;
                    for (int it = blockIdx.x; it < n_f2; it += gridDim.x) { if (ps.is_ctx) fourc_item(KP(), it, shm); else four2_item(KP(), it, shm); }
                }
                gsync(lds3);
            }
            if (!full) continue;
            _Pragma("nounroll") for (int rep = 0; rep < REP_C3; ++rep) {
                const int n_h3 = ps.nb * 8 * NC;
                for (int it = blockIdx.x; it < n_h3; it += gridDim.x) hgrn3_item(KP(), ps, l, it, shm);
                gsync(lds3);
            }
            _Pragma("nounroll") for (int rep = 0; rep < REP_DE; ++rep) {
            {
                unsigned char* ws = opaque(KP().ws);
                pg8::Gemm g; g.A = (const u16*)(ws + OFF_Y); g.Bt = (const u16*)(ws + OFF_WTBR) + (size_t)l * 4 * 1024 * 512; g.M = ps.M; g.N = 1024; g.K = 512;
                g.rsA = (size_t)MLAT * 512 * 2; g.rsB = (size_t)1024 * 512 * 2;
                MergeOrder S; S.init(ps.M, 1024, (int)gridDim.x, (int)blockIdx.x);
                EpiMerge E; E.ws = ws;

                pg8::gemm_phase<EpiMerge, MergeOrder, false>(lds3, g, S, E, nullptr);
            }
            gsync(lds3);
            if (REP_DE > 1 && rep + 1 < REP_DE) continue;
            {
                unsigned char* ws = opaque(KP().ws);
                EpiOut E; E.C = (u16*)(ws + OFF_OUT);
                run_gemm(lds3, (const u16*)(ws + OFF_MB), (const u16*)(ws + OFF_WTOUT) + (size_t)l * 1024 * 1024, ps.M, 1024, 1024, E);
            }
            gsync(lds3);
            }
        }
        if (!ps.is_ctx) phase_norm(KP(), ps, DEPTH);
    }
}

static_assert(WS_END2 <= (size_t)1073741824, "workspace map exceeds 1 GiB");

extern "C" void kernel_launch(void* const* d_in, const int* in_sizes, int n_in, void* d_out, int out_size, void* d_ws, size_t ws_size, hipStream_t stream) {
    static int grid_blocks = 0;
    if (grid_blocks == 0) {
        if (n_in != 18 || ws_size < WS_END2) { fprintf(stderr, "kernel_launch: unexpected n_in %d or ws_size %zu (need %zu)\n", n_in, ws_size, (size_t)WS_END2); grid_blocks = -1; return; }
        int dev = 0, cus = 0, per_cu = 0;
        hipGetDevice(&dev);
        hipDeviceGetAttribute(&cus, hipDeviceAttributeMultiprocessorCount, dev);
        if (hipFuncSetAttribute((const void*)mega_fwd, hipFuncAttributeMaxDynamicSharedMemorySize, LDS_BYTES + 16) != hipSuccess) { fprintf(stderr, "kernel_launch: hipFuncSetAttribute failed\n"); grid_blocks = -1; return; }
        hipOccupancyMaxActiveBlocksPerMultiprocessor(&per_cu, (const void*)mega_fwd, 512, LDS_BYTES + 16);
        if (per_cu < 1) { fprintf(stderr, "kernel_launch: occupancy query gave %d\n", per_cu); per_cu = 1; }
        (void)hipGetLastError();
        grid_blocks = cus * per_cu;
    }
    if (grid_blocks < 0) return;
    Params p{};
    const float** pp = (const float**)&p;
    for (int i = 0; i < 18; ++i) pp[i] = (const float*)d_in[i];
    p.out = (float*)d_out; p.ws = (unsigned char*)d_ws;
    void* args[] = {&p};
    hipError_t e = hipLaunchCooperativeKernel((const void*)mega_fwd, dim3(grid_blocks), dim3(512), args, LDS_BYTES + 16, stream);
    if (e != hipSuccess) fprintf(stderr, "cooperative launch failed: %s (grid %d)\n", hipGetErrorString(e), grid_blocks);
}
```

```cpp
#include <hip/hip_runtime.h>
#include <hip/hip_cooperative_groups.h>
#include <cstdio>
namespace cg = cooperative_groups;
__device__ __forceinline__ int tidx() { int t = threadIdx.x; asm volatile("" : "+v"(t)); return t; }
template <class T> __device__ __forceinline__ T* opaque(T* p) {
    unsigned long long v = (unsigned long long)p; const unsigned lo = __builtin_amdgcn_readfirstlane((unsigned)v), hi = __builtin_amdgcn_readfirstlane((unsigned)(v >> 32));
    v = ((unsigned long long)hi << 32) | lo; asm volatile("" : "+s"(v)); return (T*)((__attribute__((address_space(1))) T*)v); }
__device__ __forceinline__ float shx(float v, int m) { const int lane = tidx() & 63; return __int_as_float(__builtin_amdgcn_ds_bpermute((lane ^ m) << 2, __float_as_int(v))); }
namespace pg8 {
#define PG8_LAS __attribute__((address_space(3)))
typedef unsigned short bf16_t;
typedef short bf16x8 __attribute__((ext_vector_type(8)));
typedef float f32x4 __attribute__((ext_vector_type(4)));
typedef unsigned u32x4 __attribute__((ext_vector_type(4)));
constexpr int BM = 256, BK = 64, HALF = 128, HTB = HALF * BK * 2  , STAGE_BYTES = 8 * HTB, NXCD = 8, WGM = 8;

__host__ __device__ __forceinline__ int lds_byte(int r, int c) { const int st = (r >> 4) * 2 + (c >> 5), rr = r & 15, cc = c & 31, ob = rr * 64 + cc * 2; return st * 1024 + (ob ^ (((ob >> 9) & 1) << 5)); }
__host__ __device__ __forceinline__ void stage_rc(int b, int& R, int& C) { const int st = b / 1024, sb = b % 1024, swz = sb ^ (((sb >> 9) & 1) << 5); R = (st >> 1) * 16 + swz / 64; C = (st & 1) * 32 + (swz % 64) / 2; }
__host__ __device__ __forceinline__ int perm32(int rho) { const int n = rho >> 4, i = rho & 15; return 8 * (i >> 2) + 4 * n + (i & 3); }

struct Unit { int pm, pn, r; };
struct Gemm { const bf16_t* A; const bf16_t* Bt; int M, N, K; size_t rsA, rsB; };

struct StaticOrder {
    int nM, nN, nwg, G, c;
    __host__ __device__ void init(int M, int N, int G_, int c_) { nM = M / BM; nN = N / BM; nwg = nM * nN; G = G_; c = c_; }
    __host__ __device__ bool next(int i, Unit& u) const {
        const long L = (long)i * G + c; if (L >= nwg) return false;
        int wgid = (int)L; { const int q = nwg / NXCD, r = nwg % NXCD, xcd = wgid % NXCD, off = wgid / NXCD; wgid = (xcd < r ? xcd * (q + 1) : r * (q + 1) + (xcd - r) * q) + off; }
        const int nig = WGM * nN, gid = wgid / nig, fm = gid * WGM, gsz = (nM - fm) < WGM ? (nM - fm) : WGM;
        u.pm = fm + ((wgid % nig) % gsz); u.pn = (wgid % nig) / gsz; u.r = 0; return true;
    }
    __device__ __forceinline__ void a_ready(const Unit&) const {}
    __device__ __forceinline__ void done(const Unit&) const {}
};
__device__ __forceinline__ unsigned cvt_pk_bf16(float lo, float hi) { unsigned r; asm volatile("v_cvt_pk_bf16_f32 %0, %1, %2" : "=v"(r) : "v"(lo), "v"(hi)); return r; }

template <class Epi, class Sched, bool STAMP = false>
__device__ __forceinline__ void gemm_phase(PG8_LAS unsigned char* lds, const Gemm g, const Sched& S, const Epi& E, unsigned long long* stamps) {
    const int tid = tidx(), wid = __builtin_amdgcn_readfirstlane(tid >> 6), lane = tid & 63, wr = wid >> 2, wc = wid & 3, fr = lane & 15, fq = lane >> 4;
    const int K = g.K, nt = K / BK;
    int ts_lo = 0, ts_hi = 0, nts = 0; const unsigned long long rt_entry = STAMP ? (unsigned long long)wall_clock64() : 0ull;
#define PG8_STAMP() do { if (STAMP && wid == 0 && nts < 64) { const unsigned long long _c = (unsigned long long)clock64(); \
        ts_lo = (lane == nts) ? (int)(unsigned)_c : ts_lo; ts_hi = (lane == nts) ? (int)(unsigned)(_c >> 32) : ts_hi; ++nts; } } while (0)
    PG8_STAMP();
    unsigned voffA[2], voffB[2];
#pragma unroll
    for (int i = 0; i < 2; ++i) { int R, C; stage_rc(tid * 16 + i * 8192, R, C); const int Rb = Epi::PERM ? ((R & ~31) + perm32(R & 31)) : R;
        voffA[i] = (unsigned)(R * K + C) * 2u; voffB[i] = (unsigned)(Rb * K + C) * 2u; }
    const size_t kstep = (size_t)(BK * 2);
    const size_t hstep = (size_t)HALF * K * 2;
    const size_t tstep = 2 * hstep;
    const unsigned ldsw = (unsigned)wid * 1024u;
    const int aoff = lds_byte(wr * 64 + fr, fq * 8), boff = lds_byte(wc * 32 + fr, fq * 8);
#define PG8_SA(b, h) (((b) * 2 + (h)) * HTB)
#define PG8_SB(b, h) ((4 + (b) * 2 + (h)) * HTB)
#define PG8_STAGE(bufoff, gbase, voff) do { _Pragma("unroll") for (int _i = 0; _i < 2; ++_i) \
        __builtin_amdgcn_global_load_lds((const unsigned*)((const char*)(gbase) + (voff)[_i]), (PG8_LAS unsigned*)(lds + (bufoff) + ldsw + _i * 8192), 16, 0, 0); } while (0)
#define PG8_LDA(dst, b, h) do { _Pragma("unroll") for (int m = 0; m < 4; ++m) _Pragma("unroll") for (int k = 0; k < 2; ++k) dst[m][k] = *(const PG8_LAS bf16x8*)(lds + PG8_SA(b, h) + aoff + m * 2048 + k * 1024); } while (0)
#define PG8_LDB(dst, b, h) do { _Pragma("unroll") for (int n = 0; n < 2; ++n) _Pragma("unroll") for (int k = 0; k < 2; ++k) dst[n][k] = *(const PG8_LAS bf16x8*)(lds + PG8_SB(b, h) + boff + n * 2048 + k * 1024); } while (0)
#define PG8_MMA(ai, bj, At, Bt) do { __builtin_amdgcn_s_setprio(1); _Pragma("unroll") for (int m = 0; m < 4; ++m) _Pragma("unroll") for (int n = 0; n < 2; ++n) _Pragma("unroll") for (int k = 0; k < 2; ++k) \
        acc[ai][bj][m][n] = __builtin_amdgcn_mfma_f32_16x16x32_bf16(Bt[n][k], At[m][k], acc[ai][bj][m][n], 0, 0, 0); __builtin_amdgcn_s_setprio(0); } while (0)
#define PG8_WAIT_V(n) asm volatile("s_waitcnt vmcnt(" #n ")" ::: "memory")
#define PG8_WAIT_L(n) asm volatile("s_waitcnt lgkmcnt(" #n ")" ::: "memory")
#define PG8_BAR __builtin_amdgcn_s_barrier()
#define PG8_SCHED __builtin_amdgcn_sched_barrier(0)
    Unit cur, nxt; int ui = 0;
    if (!S.next(0, cur)) return;
    f32x4 acc[2][2][4][2];
#pragma unroll
    for (int a = 0; a < 2; ++a)
#pragma unroll
        for (int b = 0; b < 2; ++b)
#pragma unroll
            for (int m = 0; m < 4; ++m)
#pragma unroll
                for (int n = 0; n < 2; ++n) acc[a][b][m][n] = (f32x4){0.f, 0.f, 0.f, 0.f};
    bf16x8 At[4][2], B0[2][2], B1[2][2];
    const char* cA = (const char*)g.A + (size_t)cur.pm * tstep + (size_t)cur.r * g.rsA; const char* cB = (const char*)g.Bt + (size_t)cur.pn * tstep + (size_t)cur.r * g.rsB;
    S.a_ready(cur);
    PG8_STAGE(PG8_SB(0, 0), cB, voffB); PG8_STAGE(PG8_SA(0, 0), cA, voffA); PG8_STAGE(PG8_SB(0, 1), cB + hstep, voffB); PG8_STAGE(PG8_SA(0, 1), cA + hstep, voffA);
    if (wr == 1) PG8_BAR;
    PG8_WAIT_V(4); PG8_BAR;
    PG8_STAGE(PG8_SB(1, 0), cB + kstep, voffB); PG8_STAGE(PG8_SA(1, 0), cA + kstep, voffA); PG8_STAGE(PG8_SB(1, 1), cB + hstep + kstep, voffB);
    PG8_WAIT_V(6); PG8_BAR;
    PG8_STAMP();
    for (;;) {
        const bool has_next = S.next(ui + 1, nxt);
        const char* nA = has_next ? (const char*)g.A + (size_t)nxt.pm * tstep + (size_t)nxt.r * g.rsA : cA; const char* nB = has_next ? (const char*)g.Bt + (size_t)nxt.pn * tstep + (size_t)nxt.r * g.rsB : cB;
        for (int t = 0; t < nt; t += 2) {
            const bool last = (t == nt - 2);
            const char* a1 = cA + (size_t)(t + 1) * kstep;
            const char* a2 = last ? nA : cA + (size_t)(t + 2) * kstep; const char* b2 = last ? nB : cB + (size_t)(t + 2) * kstep;
            const char* a3 = a2 + kstep; const char* b3 = b2 + kstep;
            if (last && has_next) S.a_ready(nxt);
            PG8_LDB(B0, 0, 0); PG8_SCHED; PG8_LDA(At, 0, 0); PG8_STAGE(PG8_SA(1, 1), a1 + hstep, voffA);
            PG8_WAIT_L(8); PG8_BAR; PG8_WAIT_L(0); PG8_MMA(0, 0, At, B0); PG8_BAR; PG8_SCHED;
            PG8_LDB(B1, 0, 1); PG8_STAGE(PG8_SB(0, 0), b2, voffB);
            PG8_BAR; PG8_WAIT_L(0); PG8_MMA(0, 1, At, B1); PG8_BAR;
            PG8_LDA(At, 0, 1); PG8_STAGE(PG8_SA(0, 0), a2, voffA);
            PG8_BAR; PG8_WAIT_L(0); PG8_MMA(1, 0, At, B0); PG8_BAR; PG8_SCHED;
            PG8_STAGE(PG8_SB(0, 1), b2 + hstep, voffB);
            PG8_WAIT_V(6); PG8_BAR; PG8_MMA(1, 1, At, B1); PG8_BAR;
            PG8_LDB(B0, 1, 0); PG8_SCHED; PG8_LDA(At, 1, 0); PG8_STAGE(PG8_SA(0, 1), a2 + hstep, voffA);
            PG8_WAIT_L(8); PG8_BAR; PG8_WAIT_L(0); PG8_MMA(0, 0, At, B0); PG8_BAR; PG8_SCHED;
            PG8_LDB(B1, 1, 1); PG8_STAGE(PG8_SB(1, 0), b3, voffB);
            PG8_BAR; PG8_WAIT_L(0); PG8_MMA(0, 1, At, B1); PG8_BAR;
            PG8_LDA(At, 1, 1); PG8_STAGE(PG8_SA(1, 0), a3, voffA);
            PG8_BAR; PG8_WAIT_L(0); PG8_MMA(1, 0, At, B0); PG8_BAR; PG8_SCHED;
            PG8_STAGE(PG8_SB(1, 1), b3 + hstep, voffB);
            PG8_WAIT_V(6); PG8_BAR; PG8_MMA(1, 1, At, B1); PG8_BAR;
        }
        PG8_STAMP();
        if constexpr (!Epi::AFTER_DRAIN) { E(acc, cur, wr, wc, fr, fq); S.done(cur); }
        PG8_STAMP();
        if (!has_next) break;
#pragma unroll
        for (int a = 0; a < 2; ++a)
#pragma unroll
            for (int b = 0; b < 2; ++b)
#pragma unroll
                for (int m = 0; m < 4; ++m)
#pragma unroll
                    for (int n = 0; n < 2; ++n) acc[a][b][m][n] = (f32x4){0.f, 0.f, 0.f, 0.f};
        cur = nxt; cA = nA; cB = nB; ++ui;
    }
    PG8_WAIT_V(0);
    if (wr == 0) PG8_BAR;
    PG8_BAR;
    if constexpr (Epi::AFTER_DRAIN) { E.fused(acc, cur, wr, wc, fr, fq, lds, wid, lane); S.done(cur); }
    PG8_STAMP();
    if (STAMP && wid == 0) { stamps[lane] = lane < nts ? (((unsigned long long)(unsigned)ts_hi << 32) | (unsigned)ts_lo) : 0ull;
        if (lane == 62) stamps[62] = rt_entry; if (lane == 63) stamps[63] = (unsigned long long)wall_clock64(); }
#undef PG8_STAMP
#undef PG8_SA
#undef PG8_SB
#undef PG8_STAGE
#undef PG8_LDA
#undef PG8_LDB
#undef PG8_MMA
#undef PG8_WAIT_V
#undef PG8_WAIT_L
#undef PG8_BAR
#undef PG8_SCHED
}
}

typedef unsigned short u16;
typedef short s16x4 __attribute__((ext_vector_type(4)));
using pg8::bf16x8; using pg8::f32x4; using pg8::Unit;
#define LAS __attribute__((address_space(3)))
#define MFMA16(a, b, c) __builtin_amdgcn_mfma_f32_16x16x32_bf16(a, b, c, 0, 0, 0)

constexpr int DM = 1024, NBATCH = 16, SEQ = 4096, DEPTH = 4, CTXL = 256, NPROJ = 11776, NIN = 11264;
constexpr int GB = 4, MLAT = GB * SEQ, MCTX = NBATCH * CTXL;
constexpr int LDS_BYTES = 152 * 1024;
constexpr float LOG2E = 1.4426950408889634f;
constexpr float EPSN = 1e-6f;

constexpr size_t al256(size_t x) { return (x + 255) & ~(size_t)255; }
constexpr size_t OFF_WTIN = 0;
constexpr size_t OFF_WTBR = OFF_WTIN + (size_t)DEPTH * NPROJ * DM * 2;
constexpr size_t OFF_WTOUT = OFF_WTBR + (size_t)DEPTH * 4 * 1024 * 512 * 2;
constexpr size_t OFF_WS16 = OFF_WTOUT + (size_t)DEPTH * 1024 * 1024 * 2;
constexpr size_t OFF_MOD = OFF_WS16 + (size_t)DEPTH * 8 * 128 * 128 * 2;
constexpr size_t OFF_LB = OFF_MOD + al256((size_t)DEPTH * 17 * 3072 * 4);
constexpr size_t OFF_ROPE = OFF_LB + (size_t)DEPTH * 2 * 512 * 4;
constexpr size_t OFF_TW = OFF_ROPE + 2 * 64 * 16 * 4;
constexpr size_t OFF_M1 = OFF_TW + 4096 * 8;
constexpr size_t OFF_M2 = OFF_M1 + 128 * 128 * 2;
constexpr size_t OFF_M3 = OFF_M2 + 64 * 128 * 2;
constexpr size_t OFF_CSW = OFF_M3 + 256 * 512 * 2;
constexpr size_t OFF_CTXW = OFF_CSW + (size_t)DEPTH * 4 * 2 * 128 * 128 * 4;
constexpr size_t OFF_CTXKV = OFF_CTXW + (size_t)NBATCH * CTXL * DM * 4;
constexpr size_t OFF_CTXST = OFF_CTXKV + (size_t)DEPTH * MCTX * 1024 * 2;
constexpr size_t OFF_H = OFF_CTXST + (size_t)DEPTH * 256 * 4096 * 4;
constexpr size_t OFF_PROJ = OFF_H + (size_t)MLAT * DM * 2;
constexpr size_t OFF_QROT = OFF_PROJ + (size_t)MLAT * NPROJ * 2;
constexpr size_t OFF_LOGF = OFF_QROT + (size_t)MLAT * 512 * 2;
constexpr size_t OFF_Y = OFF_LOGF + (size_t)MLAT * 1024 * 4;
constexpr size_t OFF_FY = OFF_Y + (size_t)4 * MLAT * 512 * 2;
constexpr size_t OFF_HL = OFF_FY + (size_t)GB * 4096 * 1024 * 2;
constexpr size_t OFF_HD = OFF_HL + (size_t)4096 * 4096 * 4;
constexpr size_t OFF_HS = OFF_HD + (size_t)4096 * 64 * 4;
constexpr size_t OFF_MB = OFF_HS + (size_t)4096 * 4096 * 4;
constexpr size_t WS_END = OFF_MB + (size_t)MLAT * DM * 2;
constexpr size_t OFF_MERGED = OFF_LOGF;
constexpr size_t OFF_OUT = OFF_PROJ;

struct Params {
    const float *x, *c, *ctx, *c_ctx, *w_ada, *b_ada, *g_pre, *g_post, *w_in, *rpb, *fnet_w, *gmlp_g, *gmlp_ws, *gmlp_bs, *lb_logits, *hgrn_g, *w_branch, *w_out;
    float* out; unsigned char* ws;
};
struct PassInfo { int is_ctx, nb, T, M, b0; };

__device__ __forceinline__ u16 f2bf(float f) { unsigned u = __float_as_uint(f); u += 0x7FFFu + ((u >> 16) & 1u); return (u16)(u >> 16); }
__device__ __forceinline__ float bf2f(u16 b) { return __uint_as_float(((unsigned)b) << 16); }
typedef __bf16 bf16x2_t_ __attribute__((ext_vector_type(2)));
typedef float f32x2_t_ __attribute__((ext_vector_type(2)));
__device__ __forceinline__ unsigned pack2(float a, float b) { f32x2_t_ v = {a, b}; bf16x2_t_ r = __builtin_convertvector(v, bf16x2_t_); return __builtin_bit_cast(unsigned, r); }
__device__ __forceinline__ float bflo(unsigned w) { return __uint_as_float(w << 16); }
__device__ __forceinline__ float bfhi(unsigned w) { return __uint_as_float(w & 0xFFFF0000u); }
__device__ __forceinline__ float sigmoidf_(float v) { return __builtin_amdgcn_rcpf(1.f + __builtin_amdgcn_exp2f(-LOG2E * v)); }
__device__ __forceinline__ float siluf_(float v) { return v * __builtin_amdgcn_rcpf(1.f + __builtin_amdgcn_exp2f(-LOG2E * v)); }
__device__ __forceinline__ void unpack8(uint4 w, float* f) { f[0] = bflo(w.x); f[1] = bfhi(w.x); f[2] = bflo(w.y); f[3] = bfhi(w.y); f[4] = bflo(w.z); f[5] = bfhi(w.z); f[6] = bflo(w.w); f[7] = bfhi(w.w); }
__device__ __forceinline__ bf16x8 tr_read2(const u16* p0, const u16* p1) {
    s16x4 a = __builtin_amdgcn_ds_read_tr16_b64_v4i16((LAS s16x4*)p0);
    s16x4 b = __builtin_amdgcn_ds_read_tr16_b64_v4i16((LAS s16x4*)p1);
    return (bf16x8){a[0], a[1], a[2], a[3], b[0], b[1], b[2], b[3]};
}
__device__ __forceinline__ bf16x8 ld_frag_g(const u16* p) { return *(const bf16x8*)p; }

typedef unsigned u32x4_ __attribute__((ext_vector_type(4)));
__device__ __forceinline__ void nt_store16(uint4 w, void* p) { __builtin_nontemporal_store((u32x4_){w.x, w.y, w.z, w.w}, (u32x4_*)p); }
struct EpiProj {
    static constexpr bool PERM = true, AFTER_DRAIN = false;
    unsigned char* ws; int l; int is_ctx;
    __device__ __forceinline__ void operator()(const f32x4 (&acc)[2][2][4][2], const Unit& u, int wr, int wc, int fr, int fq) const {
        u16* proj = (u16*)(ws + OFF_PROJ);
        const int blk = u.pn >> 1;
        const int row0 = u.pm * 256 + wr * 64 + fr, col0 = u.pn * 256 + wc * 32 + 8 * fq;
        u16* pbase = proj + ((size_t)blk * MLAT + row0) * 512 + (col0 & 511);
        if ((blk == 0 || blk == 1) && !is_ctx) {
            u16* qrot = (u16*)(ws + OFF_QROT); const float* rope = (const float*)(ws + OFF_ROPE);
            const int f0 = 8 * (fq & 1); const float sgn = (fq >> 1) ? 1.f : -1.f;
#pragma unroll
            for (int ai = 0; ai < 2; ++ai)
#pragma unroll
                for (int m = 0; m < 4; ++m) {
                    const int row = row0 + ai * 128 + m * 16;
                    const int t = row & 4095, pos = (wc & 1) ? (t & 63) : (t >> 6);
                    const float4 c0 = *(const float4*)(rope + pos * 16 + f0), c1 = *(const float4*)(rope + pos * 16 + f0 + 4);
                    const float4 s0 = *(const float4*)(rope + 1024 + pos * 16 + f0), s1 = *(const float4*)(rope + 1024 + pos * 16 + f0 + 4);
                    const float cs[8] = {c0.x, c0.y, c0.z, c0.w, c1.x, c1.y, c1.z, c1.w}, sn[8] = {s0.x, s0.y, s0.z, s0.w, s1.x, s1.y, s1.z, s1.w};
#pragma unroll
                    for (int bj = 0; bj < 2; ++bj) {
                        const f32x4 v0 = acc[ai][bj][m][0], v1 = acc[ai][bj][m][1];
                        const float o[8] = {v0[0], v0[1], v0[2], v0[3], v1[0], v1[1], v1[2], v1[3]};
                        float r[8];
#pragma unroll
                        for (int e = 0; e < 8; ++e) { const float pr = shx(o[e], 32); r[e] = o[e] * cs[e] + sgn * pr * sn[e]; }
                        uint4 wr_; wr_.x = pack2(r[0], r[1]); wr_.y = pack2(r[2], r[3]); wr_.z = pack2(r[4], r[5]); wr_.w = pack2(r[6], r[7]);
                        u16* dst = pbase + (size_t)(ai * 128 + m * 16) * 512 + bj * 128;
                        if (blk == 0) {
                            uint4 wp; wp.x = pack2(o[0], o[1]); wp.y = pack2(o[2], o[3]); wp.z = pack2(o[4], o[5]); wp.w = pack2(o[6], o[7]);
                            nt_store16(wp, dst);
                            nt_store16(wr_, qrot + (size_t)row * 512 + (col0 & 511) + bj * 128);
                        } else nt_store16(wr_, dst);
                    }
                }
        } else if (blk == 11 || blk == 12) {
            float* logf = (float*)(ws + OFF_LOGF); const float* lb = (const float*)(ws + OFF_LB) + l * 1024;
            const int dir = blk - 11;
#pragma unroll
            for (int bj = 0; bj < 2; ++bj) {
                const int cc = (col0 & 511) + bj * 128;
                const float4 l0 = *(const float4*)(lb + dir * 512 + cc), l1 = *(const float4*)(lb + dir * 512 + cc + 4);
                const float lbv[8] = {l0.x, l0.y, l0.z, l0.w, l1.x, l1.y, l1.z, l1.w};
#pragma unroll
                for (int ai = 0; ai < 2; ++ai)
#pragma unroll
                    for (int m = 0; m < 4; ++m) {
                        const int row = row0 + ai * 128 + m * 16;
                        const f32x4 v0 = acc[ai][bj][m][0], v1 = acc[ai][bj][m][1];
                        const float z[8] = {v0[0], v0[1], v0[2], v0[3], v1[0], v1[1], v1[2], v1[3]};
                        float lf[8], o[8];
#pragma unroll
                        for (int e = 0; e < 8; ++e) {
                            const float ez = __expf(-z[e]);
                            const float inv = __builtin_amdgcn_rcpf(1.f + ez);
                            const float sg = inv, sgn_ = (ez > 1e30f) ? 1.f : ez * inv;
                            const float f = lbv[e] + (1.f - lbv[e]) * sg;
                            lf[e] = __logf(fmaxf(f, 1e-30f));
                            o[e] = (1.f - lbv[e]) * sgn_;
                        }
                        float* lp = logf + (size_t)row * 1024 + dir * 512 + cc;
                        __builtin_nontemporal_store((f32x4){lf[0], lf[1], lf[2], lf[3]}, (f32x4*)lp); __builtin_nontemporal_store((f32x4){lf[4], lf[5], lf[6], lf[7]}, (f32x4*)(lp + 4));
                        uint4 w; w.x = pack2(o[0], o[1]); w.y = pack2(o[2], o[3]); w.z = pack2(o[4], o[5]); w.w = pack2(o[6], o[7]);
                        nt_store16(w, pbase + (size_t)(ai * 128 + m * 16) * 512 + bj * 128);
                    }
            }
        } else {
            const bool copy = is_ctx && (blk == 1 || blk == 2);
            u16* cbase = (u16*)(ws + OFF_CTXKV) + (size_t)l * MCTX * 1024 + (size_t)row0 * 1024 + (blk - 1) * 512 + (col0 & 511);
            if (!copy) {
#pragma unroll
                for (int ai = 0; ai < 2; ++ai)
#pragma unroll
                    for (int m = 0; m < 4; ++m)
#pragma unroll
                        for (int bj = 0; bj < 2; ++bj) {
                            const f32x4 v0 = acc[ai][bj][m][0], v1 = acc[ai][bj][m][1];
                            uint4 w; w.x = pack2(v0[0], v0[1]); w.y = pack2(v0[2], v0[3]); w.z = pack2(v1[0], v1[1]); w.w = pack2(v1[2], v1[3]);
                            nt_store16(w, pbase + (size_t)(ai * 128 + m * 16) * 512 + bj * 128);
                        }
            } else {
#pragma unroll
                for (int ai = 0; ai < 2; ++ai)
#pragma unroll
                    for (int m = 0; m < 4; ++m)
#pragma unroll
                        for (int bj = 0; bj < 2; ++bj) {
                            const f32x4 v0 = acc[ai][bj][m][0], v1 = acc[ai][bj][m][1];
                            uint4 w; w.x = pack2(v0[0], v0[1]); w.y = pack2(v0[2], v0[3]); w.z = pack2(v1[0], v1[1]); w.w = pack2(v1[2], v1[3]);
                            nt_store16(w, pbase + (size_t)(ai * 128 + m * 16) * 512 + bj * 128);
                            *(uint4*)(cbase + (size_t)(ai * 128 + m * 16) * 1024 + bj * 128) = w;
                        }
            }
        }
    }
};
struct EpiMerge {
    static constexpr bool PERM = true, AFTER_DRAIN = false;
    unsigned char* ws;
    template <int MODE> __device__ __forceinline__ void run(const f32x4 (&acc)[2][2][4][2], const Unit& u, int wr, int wc, int fr, int fq) const {
        const u16* proj = (const u16*)(ws + OFF_PROJ); u16* mb = (u16*)(ws + OFF_MB);
        const int row0 = u.pm * 256 + wr * 64 + fr, col0 = u.pn * 256 + wc * 32 + 8 * fq, R = u.r;
        const int gcol0 = 7680 + R * 1024 + col0;
        const u16* gbase = proj + ((size_t)(gcol0 >> 9) * MLAT + row0) * 512 + (gcol0 & 511);
        u16* obase = mb + (size_t)row0 * 1024 + col0;
        uint4 g[2][4], old[2][4];
#define MG_LOAD(st, buf) do { _Pragma("unroll") for (int q = 0; q < 4; ++q) { const int ai_ = (st) >> 1, m_ = ((st) & 1) * 2 + (q >> 1), co_ = (q & 1) * 128; const size_t ro_ = (size_t)(ai_ * 128 + m_ * 16); \
            g[buf][q] = *(const uint4*)(gbase + ro_ * 512 + co_); if (MODE > 0) old[buf][q] = *(const uint4*)(obase + ro_ * 1024 + co_); } } while (0)
        MG_LOAD(0, 0);
#pragma unroll
        for (int st = 0; st < 4; ++st) {
            const int buf = st & 1;
            if (st + 1 < 4) MG_LOAD(st + 1, buf ^ 1);
            __builtin_amdgcn_sched_barrier(0);
#pragma unroll
            for (int q = 0; q < 4; ++q) { const int ai = st >> 1, m = (st & 1) * 2 + (q >> 1), bj = q & 1, co = bj * 128; const size_t ro = (size_t)(ai * 128 + m * 16);
                const f32x4 v0 = acc[ai][bj][m][0], v1 = acc[ai][bj][m][1];
                float gf[8]; unpack8(g[buf][q], gf);
                float o[8] = {v0[0] * sigmoidf_(gf[0]), v0[1] * sigmoidf_(gf[1]), v0[2] * sigmoidf_(gf[2]), v0[3] * sigmoidf_(gf[3]), v1[0] * sigmoidf_(gf[4]), v1[1] * sigmoidf_(gf[5]), v1[2] * sigmoidf_(gf[6]), v1[3] * sigmoidf_(gf[7])};
                if (MODE > 0) { float of[8]; unpack8(old[buf][q], of);
#pragma unroll
                    for (int e = 0; e < 8; ++e) o[e] += of[e]; }
                uint4 w; w.x = pack2(o[0], o[1]); w.y = pack2(o[2], o[3]); w.z = pack2(o[4], o[5]); w.w = pack2(o[6], o[7]);
                *(uint4*)(obase + ro * 1024 + co) = w; }
        }
#undef MG_LOAD
    }
    __device__ __forceinline__ void operator()(const f32x4 (&acc)[2][2][4][2], const Unit& u, int wr, int wc, int fr, int fq) const {
        if (u.r == 0) run<0>(acc, u, wr, wc, fr, fq);
        else run<1>(acc, u, wr, wc, fr, fq);
    }
};
struct EpiOut {
    static constexpr bool PERM = true, AFTER_DRAIN = false;
    u16* C;
    __device__ __forceinline__ void operator()(const f32x4 (&acc)[2][2][4][2], const Unit& u, int wr, int wc, int fr, int fq) const {
        const int row0 = u.pm * 256 + wr * 64 + fr, col0 = u.pn * 256 + wc * 32 + 8 * fq;
#pragma unroll
        for (int ai = 0; ai < 2; ++ai)
#pragma unroll
            for (int m = 0; m < 4; ++m) { u16* rowp = C + (size_t)(row0 + ai * 128 + m * 16) * 1024 + col0;
#pragma unroll
                for (int bj = 0; bj < 2; ++bj) { const f32x4 v0 = acc[ai][bj][m][0], v1 = acc[ai][bj][m][1];
                    uint4 w; w.x = pack2(v0[0], v0[1]); w.y = pack2(v0[2], v0[3]); w.z = pack2(v1[0], v1[1]); w.w = pack2(v1[2], v1[3]); *(uint4*)(rowp + bj * 128) = w; } }
    }
};

__device__ void transpose_tile(const float* src, int lds_, u16* dst, int ldd, int k0, int n0s, int n0d, u16* t) {
    const int tid = tidx();
#pragma unroll
    for (int it = 0; it < 2; ++it) {
        const int kk = (tid >> 4) + it * 32, nn = (tid & 15) * 4;
        const float4 v = *(const float4*)(src + (size_t)(k0 + kk) * lds_ + n0s + nn);
        t[(nn + 0) * 72 + kk] = f2bf(v.x); t[(nn + 1) * 72 + kk] = f2bf(v.y); t[(nn + 2) * 72 + kk] = f2bf(v.z); t[(nn + 3) * 72 + kk] = f2bf(v.w);
    }
    __syncthreads();
    { const int n = tid >> 3, k8 = (tid & 7) * 8;
      const uint4 v = *(const uint4*)(t + n * 72 + k8);
      *(uint4*)(dst + (size_t)(n0d + n) * ldd + k0 + k8) = v; }
    __syncthreads();
}

__device__ void prep1(const Params& p, unsigned char* lds) {
    unsigned char* ws = opaque(p.ws);
    const int tid = tidx();
    const size_t gt = (size_t)blockIdx.x * 512 + tid, gn = (size_t)gridDim.x * 512;
    { u16* ws16 = (u16*)(ws + OFF_WS16);
      for (size_t i = gt; i < (size_t)DEPTH * 8 * 128 * 128; i += gn) ws16[i] = f2bf(p.gmlp_ws[i]);
      float* lbp = (float*)(ws + OFF_LB);
      for (size_t i = gt; i < 1024; i += gn) {
          float e[DEPTH], mx = -1e30f, sum = 0.f;
#pragma unroll
          for (int l = 0; l < DEPTH; ++l) { e[l] = p.lb_logits[l * 1024 + i]; mx = fmaxf(mx, e[l]); }
#pragma unroll
          for (int l = 0; l < DEPTH; ++l) { e[l] = expf(e[l] - mx); sum += e[l]; }
          float run = 0.f;
#pragma unroll
          for (int l = 0; l < DEPTH; ++l) { if (l > 0) run += e[l] / sum; lbp[l * 1024 + i] = fmaxf(run, 0.f); }
      }
      float* rope = (float*)(ws + OFF_ROPE);
      for (size_t i = gt; i < 1024; i += gn) { const int pos = (int)(i >> 4), f = (int)(i & 15);
          const float inv = powf(10000.f, -(float)f * 2.0f / 32.0f), ang = (float)pos * inv;
          rope[i] = cosf(ang); rope[1024 + i] = sinf(ang); }
      float* tw = (float*)(ws + OFF_TW);
      for (size_t i = gt; i < 4096; i += gn) { float s, c; sincospif((float)i * (2.0f / 4096.0f), &s, &c); tw[2 * i] = c; tw[2 * i + 1] = s; }
      u16* m1 = (u16*)(ws + OFF_M1);
      for (size_t i = gt; i < 128 * 128; i += gn) { const int ii = (int)(i >> 7), kk = (int)(i & 127), k1 = ii >> 1, po = ii & 1, n1 = kk >> 1, pi = kk & 1;
          float s, c; sincospif((float)((k1 * n1) & 63) * (2.0f / 64.0f), &s, &c);
          const float v = (po == 0) ? (pi == 0 ? c : -s) : (pi == 0 ? -s : -c);
          m1[i] = f2bf(v); }
      u16* m2 = (u16*)(ws + OFF_M2);
      for (size_t i = gt; i < 64 * 128; i += gn) { const int k2 = (int)(i >> 7), kk = (int)(i & 127), n2 = kk >> 1, pi = kk & 1;
          float s, c; sincospif((float)((k2 * n2) & 63) * (2.0f / 64.0f), &s, &c);
          m2[i] = f2bf(pi == 0 ? c : s); }
      u16* m3 = (u16*)(ws + OFF_M3);
      for (size_t i = gt; i < 256 * 512; i += gn) { const int k = (int)(i >> 9), kk = (int)(i & 511), n = kk >> 1, pi = kk & 1;
          float s, c; sincospif((float)((k * n) & 255) * (2.0f / 256.0f), &s, &c);
          m3[i] = f2bf(pi == 0 ? c : -s); }
    }
    constexpr int N_WIN = DEPTH * 176 * 16, N_WBR = 16 * 16 * 8, N_WOUT = DEPTH * 16 * 16, N_MOD = DEPTH * 48, N_CSW = DEPTH * 4 * 2 * 2;
    constexpr int TOT = N_WIN + N_WBR + N_WOUT + N_MOD + N_CSW;
    for (int it = blockIdx.x; it < TOT; it += gridDim.x) {
        int idx = it;
        if (idx < N_WIN) {
            const int l = idx / 2816, rem = idx % 2816, cb = rem >> 4, kb = rem & 15, n0 = cb * 64;
            if (n0 >= 2048 && n0 < 2560) continue;
            const int n0d = n0 < 2048 ? n0 : n0 + 512;
            transpose_tile(p.w_in + (size_t)l * DM * NIN, NIN, (u16*)(ws + OFF_WTIN) + (size_t)l * NPROJ * DM, DM, kb * 64, n0, n0d, (u16*)lds);
            continue;
        }
        idx -= N_WIN;
        if (idx < N_WBR) {
            const int mat = idx >> 7, rem = idx & 127, cb = rem >> 3, kb = rem & 7;
            transpose_tile(p.w_branch + (size_t)mat * 512 * 1024, 1024, (u16*)(ws + OFF_WTBR) + (size_t)mat * 1024 * 512, 512, kb * 64, cb * 64, cb * 64, (u16*)lds);
            continue;
        }
        idx -= N_WBR;
        if (idx < N_WOUT) {
            const int l = idx >> 8, rem = idx & 255, cb = rem >> 4, kb = rem & 15;
            transpose_tile(p.w_out + (size_t)l * 1024 * 1024, 1024, (u16*)(ws + OFF_WTOUT) + (size_t)l * 1024 * 1024, 1024, kb * 64, cb * 64, cb * 64, (u16*)lds);
            continue;
        }
        idx -= N_WOUT;
        if (idx < N_MOD) {
            const int l = idx / 48, cb = idx % 48;
            float* s = (float*)lds; float* red = s + 17 * 1024;
            for (int i = tid; i < 17 * 1024; i += 512) { const int j = i >> 10, k = i & 1023; const float v = j < 16 ? p.c[j * 1024 + k] : p.c_ctx[k]; s[i] = v / (1.f + expf(-v)); }
            __syncthreads();
            const int col = tid & 63, ks = tid >> 6;
            float acc[17];
#pragma unroll
            for (int j = 0; j < 17; ++j) acc[j] = 0.f;
            for (int k = ks * 128; k < ks * 128 + 128; ++k) {
                const float w = p.w_ada[((size_t)l * 1024 + k) * 3072 + cb * 64 + col];
#pragma unroll
                for (int j = 0; j < 17; ++j) acc[j] += s[j * 1024 + k] * w;
            }
#pragma unroll
            for (int j = 0; j < 17; ++j) red[(ks * 17 + j) * 64 + col] = acc[j];
            __syncthreads();
            for (int o = tid; o < 17 * 64; o += 512) { const int j = o >> 6, cc = o & 63; float sum = 0.f;
                for (int q = 0; q < 8; ++q) sum += red[(q * 17 + j) * 64 + cc];
                ((float*)(ws + OFF_MOD))[((size_t)l * 17 + j) * 3072 + cb * 64 + cc] = sum + p.b_ada[l * 3072 + cb * 64 + cc]; }
            __syncthreads();
            continue;
        }
        idx -= N_MOD;
        {
            const int cblk = idx & 1, part = (idx >> 1) & 1, g = (idx >> 2) & 3, l = idx >> 4;
            float* tb = (float*)lds;
            if (tid < 128) { float s, c; sincospif((float)tid * (2.0f / 128.0f), &s, &c); tb[tid] = part ? s : c; }
            __syncthreads();
            const int d = tid & 127, cq = tid >> 7;
            float acc[16];
#pragma unroll
            for (int i = 0; i < 16; ++i) acc[i] = 0.f;
            const float* wf = p.fnet_w + ((size_t)(l * 4 + g) * 128) * 128;
            for (int c2 = 0; c2 < 128; ++c2) {
                const float w = wf[c2 * 128 + d];
#pragma unroll
                for (int i = 0; i < 16; ++i) { const int c = cblk * 64 + cq * 16 + i; acc[i] += tb[(c * c2) & 127] * w; }
            }
            float* dst = (float*)(ws + OFF_CSW) + ((size_t)((l * 4 + g) * 2 + part) * 128) * 128;
#pragma unroll
            for (int i = 0; i < 16; ++i) dst[(cblk * 64 + cq * 16 + i) * 128 + d] = acc[i];
            __syncthreads();
        }
    }
}

__device__ void prep2(const Params& p, unsigned char* lds) {
    unsigned char* ws = opaque(p.ws);
    const int tid = tidx();
    float* wb = (float*)lds;
    float* cw = wb + 64 * 129;
    for (int it = blockIdx.x; it < DEPTH * 4 * 2 * 16; it += gridDim.x) {
        const int kb = it & 15, part = (it >> 4) & 1, g = (it >> 5) & 3, l = it >> 7;
        for (int i = tid; i < 64 * 128; i += 512) { const int kk = i >> 7, c = i & 127; wb[kk * 129 + c] = p.w_in[((size_t)l * 1024 + kb * 64 + kk) * NIN + 2048 + g * 128 + c]; }
        const float* src = (const float*)(ws + OFF_CSW) + ((size_t)((l * 4 + g) * 2 + part) * 128) * 128;
        for (int i = tid; i < 128 * 128; i += 512) cw[i] = src[i];
        __syncthreads();
        const int d = tid & 127, kq = tid >> 7;
        float acc[16];
#pragma unroll
        for (int i = 0; i < 16; ++i) acc[i] = 0.f;
        for (int c = 0; c < 128; ++c) {
            const float w = cw[c * 128 + d];
#pragma unroll
            for (int i = 0; i < 16; ++i) acc[i] += wb[(kq * 16 + i) * 129 + c] * w;
        }
        u16* dst = (u16*)(ws + OFF_WTIN) + ((size_t)l * NPROJ + (4 + part) * 512 + g * 128 + d) * DM + kb * 64 + kq * 16;
        uint4 w0, w1;
        w0.x = pack2(acc[0], acc[1]); w0.y = pack2(acc[2], acc[3]); w0.z = pack2(acc[4], acc[5]); w0.w = pack2(acc[6], acc[7]);
        w1.x = pack2(acc[8], acc[9]); w1.y = pack2(acc[10], acc[11]); w1.z = pack2(acc[12], acc[13]); w1.w = pack2(acc[14], acc[15]);
        *(uint4*)dst = w0; *(uint4*)(dst + 8) = w1;
        __syncthreads();
    }
}

__device__ void phase_norm(const Params& p, const PassInfo ps, int l) {
    unsigned char* ws = opaque(p.ws);
    const int wave = tidx() >> 6, lane = tidx() & 63;
    const float* mod = (const float*)(ws + OFF_MOD);
    const u16* OUT = (const u16*)(ws + OFF_OUT);
    u16* H = (u16*)(ws + OFF_H);
    for (int rr = blockIdx.x * 8 + wave; rr < ps.M; rr += gridDim.x * 8) {
        const int tsh = ps.is_ctx ? 8 : 12; const int b = ps.b0 + (rr >> tsh), t = rr & (ps.T - 1), mrow = ps.is_ctx ? 16 : b;
        const size_t xoff = ((size_t)b * ps.T + t) * 1024;
        const float* xin = (l <= 1) ? ((ps.is_ctx ? p.ctx : p.x) + xoff) : ((ps.is_ctx ? (const float*)(ws + OFF_CTXW) : (const float*)p.out) + xoff);
        float* xout = (ps.is_ctx ? (float*)(ws + OFF_CTXW) : p.out) + xoff;
        float xv[16];
#pragma unroll
        for (int hlf = 0; hlf < 2; ++hlf) {
            const int c0 = hlf * 512 + lane * 8;
            const float4 a = *(const float4*)(xin + c0), bq = *(const float4*)(xin + c0 + 4);
            xv[hlf * 8 + 0] = a.x; xv[hlf * 8 + 1] = a.y; xv[hlf * 8 + 2] = a.z; xv[hlf * 8 + 3] = a.w;
            xv[hlf * 8 + 4] = bq.x; xv[hlf * 8 + 5] = bq.y; xv[hlf * 8 + 6] = bq.z; xv[hlf * 8 + 7] = bq.w;
        }
        if (l > 0) {
            float ov[16]; float ss = 0.f;
#pragma unroll
            for (int hlf = 0; hlf < 2; ++hlf) {
                const int c0 = hlf * 512 + lane * 8;
                unpack8(*(const uint4*)(OUT + (size_t)rr * 1024 + c0), ov + hlf * 8);
            }
#pragma unroll
            for (int e = 0; e < 16; ++e) ss += ov[e] * ov[e];
#pragma unroll
            for (int o = 32; o > 0; o >>= 1) ss += shx(ss, o);
            const float rstd = rsqrtf(ss * (1.f / 1024.f) + EPSN);
            const float* gt = mod + ((size_t)(l - 1) * 17 + mrow) * 3072 + 2048;
            const float* gp = p.g_post + (l - 1) * 1024;
#pragma unroll
            for (int hlf = 0; hlf < 2; ++hlf) {
                const int c0 = hlf * 512 + lane * 8;
#pragma unroll
                for (int e = 0; e < 8; ++e) xv[hlf * 8 + e] += gt[c0 + e] * (ov[hlf * 8 + e] * rstd * gp[c0 + e]);
                *(float4*)(xout + c0) = make_float4(xv[hlf * 8 + 0], xv[hlf * 8 + 1], xv[hlf * 8 + 2], xv[hlf * 8 + 3]);
                *(float4*)(xout + c0 + 4) = make_float4(xv[hlf * 8 + 4], xv[hlf * 8 + 5], xv[hlf * 8 + 6], xv[hlf * 8 + 7]);
            }
        }
        if (l < DEPTH) {
            float ss = 0.f;
#pragma unroll
            for (int e = 0; e < 16; ++e) ss += xv[e] * xv[e];
#pragma unroll
            for (int o = 32; o > 0; o >>= 1) ss += shx(ss, o);
            const float rstd = rsqrtf(ss * (1.f / 1024.f) + EPSN);
            const float* sh = mod + ((size_t)l * 17 + mrow) * 3072; const float* sc = sh + 1024;
            const float* gp = p.g_pre + l * 1024;
#pragma unroll
            for (int hlf = 0; hlf < 2; ++hlf) {
                const int c0 = hlf * 512 + lane * 8;
                float hv[8];
#pragma unroll
                for (int e = 0; e < 8; ++e) hv[e] = xv[hlf * 8 + e] * rstd * gp[c0 + e] * (1.f + sc[c0 + e]) + sh[c0 + e];
                uint4 w; w.x = pack2(hv[0], hv[1]); w.y = pack2(hv[2], hv[3]); w.z = pack2(hv[4], hv[5]); w.w = pack2(hv[6], hv[7]);
                *(uint4*)(H + (size_t)rr * 1024 + c0) = w;
            }
        }
    }
}

#define PJ(row, blk, c) (PROJ + ((size_t)(blk) * MLAT + (row)) * 512 + (c))
typedef unsigned u32x32_ __attribute__((ext_vector_type(32)));
struct Reg8 {
    u32x32_ v;
    __device__ __forceinline__ void ld(int i, const void* p) { const u32x4_ a = *(const u32x4_*)p; v[4 * i] = a[0]; v[4 * i + 1] = a[1]; v[4 * i + 2] = a[2]; v[4 * i + 3] = a[3]; }
    __device__ __forceinline__ u32x4_ get(int i) const { return (u32x4_){v[4 * i], v[4 * i + 1], v[4 * i + 2], v[4 * i + 3]}; }
    __device__ __forceinline__ uint4 getu(int i) const { uint4 r; r.x = v[4 * i]; r.y = v[4 * i + 1]; r.z = v[4 * i + 2]; r.w = v[4 * i + 3]; return r; }
};
#define MEMBAR() asm volatile("" ::: "memory")
constexpr int KVS = 72;
constexpr int TS = 528;
constexpr int T3S = 136;
constexpr int HS_ = 68;
constexpr float NORM_LAT = 0.0013810679320049757f;
constexpr float NORM_CTX = 0.005524271728019903f;

__device__ void attn_item(const Params& p, const PassInfo ps, int l, int item, unsigned char* lds) {
    unsigned char* ws = opaque(p.ws);
    const u16* PROJ = (const u16*)(ws + OFF_PROJ); const u16* QROT = (const u16*)(ws + OFF_QROT);
    const u16* CKV = (const u16*)(ws + OFF_CTXKV) + (size_t)l * MCTX * 1024;
    u16* Y0 = (u16*)(ws + OFF_Y);
    const int tid = tidx(), w = tid >> 6, lane = tid & 63, qtr = w & 3, kh = w >> 2, li = lane & 15, quad = lane >> 4;
    u16* Kl = (u16*)lds; u16* Vl = Kl + 512 * KVS; float* rp = (float*)(Vl + 512 * KVS);
    int bl, h, r = 0, qrow0, bglob;
    if (!ps.is_ctx) { r = item & 63; h = (item >> 6) & 7; bl = item >> 9; qrow0 = bl * 4096 + r * 64; bglob = ps.b0 + bl; }
    else { const int qb = item & 3; h = (item >> 2) & 7; bl = item >> 5; qrow0 = bl * 256 + qb * 64; bglob = bl; }
    const int qrow = qrow0 + qtr * 16 + li;
    float m_run = -1e30f, l_run = 0.f;
    const bf16x8 qp0 = ld_frag_g(PJ(qrow, 0, h * 64 + quad * 8)), qp1 = ld_frag_g(PJ(qrow, 0, h * 64 + 32 + quad * 8));
    uint2 gate4[4];
#pragma unroll
    for (int d = 0; d < 4; ++d) gate4[d] = *(const uint2*)(PJ(qrow, 3, h * 64 + d * 16 + quad * 4));
    Reg8 crg;
    { const size_t crow0 = (size_t)bglob * 256;
#pragma unroll
      for (int i = 0; i < 4; ++i) { const int idx = tid + 512 * i, key = idx >> 3, ch = idx & 7;
          crg.ld(2 * i, CKV + (crow0 + key) * 1024 + h * 64 + ch * 8); crg.ld(2 * i + 1, CKV + (crow0 + key) * 1024 + 512 + h * 64 + ch * 8); } }
    f32x4 O[4];
#pragma unroll
    for (int d = 0; d < 4; ++d) O[d] = (f32x4){0.f, 0.f, 0.f, 0.f};
    if (!ps.is_ctx) {
        const int rs = min(max(r - 4, 0), 56);
        const size_t krow0 = (size_t)bl * 4096 + rs * 64;
        const bf16x8 q0 = ld_frag_g(QROT + (size_t)qrow * 512 + h * 64 + quad * 8), q1 = ld_frag_g(QROT + (size_t)qrow * 512 + h * 64 + 32 + quad * 8);
        { u32x32_ kr, vr;
#pragma unroll
          for (int i = 0; i < 8; ++i) { const int idx = tid + 512 * i, key = idx >> 3, ch = idx & 7;
              const u32x4_ a = *(const u32x4_*)(PJ(krow0 + key, 1, h * 64 + ch * 8)), b = *(const u32x4_*)(PJ(krow0 + key, 2, h * 64 + ch * 8));
              kr[4 * i] = a[0]; kr[4 * i + 1] = a[1]; kr[4 * i + 2] = a[2]; kr[4 * i + 3] = a[3]; vr[4 * i] = b[0]; vr[4 * i + 1] = b[1]; vr[4 * i + 2] = b[2]; vr[4 * i + 3] = b[3]; }
          asm volatile("" ::: "memory");
#pragma unroll
          for (int i = 0; i < 8; ++i) { const int idx = tid + 512 * i, key = idx >> 3, ch = idx & 7;
              *(u32x4_*)(Kl + key * KVS + ch * 8) = (u32x4_){kr[4 * i], kr[4 * i + 1], kr[4 * i + 2], kr[4 * i + 3]}; *(u32x4_*)(Vl + key * KVS + ch * 8) = (u32x4_){vr[4 * i], vr[4 * i + 1], vr[4 * i + 2], vr[4 * i + 3]}; } }
        for (int i = tid; i < 465; i += 512) rp[i] = p.rpb[((size_t)l * 8 + h) * 465 + i];
        __syncthreads();
        const int cbase = (qtr == 0) ? 0 : (qtr == 1 ? 8 : (qtr == 2 ? 24 : 32));
        const int qc = qtr * 16 + li, cst = min(max(qc - 8, 0), 48);
        float s[8][4];
        float mx = -1e30f;
#pragma unroll
        for (int sb = 0; sb < 8; ++sb) {
            const int i = kh * 4 + (sb >> 1), cs = sb & 1;
            const u16* kp = Kl + (i * 64 + cbase + cs * 16 + li) * KVS + quad * 8;
            f32x4 a = (f32x4){0.f, 0.f, 0.f, 0.f};
            a = MFMA16(*(const bf16x8*)kp, q0, a); a = MFMA16(*(const bf16x8*)(kp + 32), q1, a);
            const int ridx = rs + i - r + 7;
#pragma unroll
            for (int j = 0; j < 4; ++j) { const int kc = cbase + cs * 16 + quad * 4 + j;
                const bool valid = (kc >= cst) && (kc < cst + 16);
                const int cidx = min(max(kc - qc + 15, 0), 30);
                const float v = valid ? (a[j] * 0.125f + rp[ridx * 31 + cidx]) : -1e30f;
                s[sb][j] = v; mx = fmaxf(mx, v); }
        }
        mx = fmaxf(mx, shx(mx, 16)); mx = fmaxf(mx, shx(mx, 32));
        m_run = mx;
        float ls = 0.f;
#pragma unroll
        for (int sb = 0; sb < 8; ++sb)
#pragma unroll
            for (int j = 0; j < 4; ++j) { const float e = __expf(s[sb][j] - mx); s[sb][j] = e; ls += e; }
        ls += shx(ls, 16); ls += shx(ls, 32);
        l_run = ls;
#pragma unroll
        for (int kp2 = 0; kp2 < 4; ++kp2) {
            bf16x8 pf; { const unsigned a0 = pack2(s[2 * kp2][0], s[2 * kp2][1]), a1 = pack2(s[2 * kp2][2], s[2 * kp2][3]), b0 = pack2(s[2 * kp2 + 1][0], s[2 * kp2 + 1][1]), b1 = pack2(s[2 * kp2 + 1][2], s[2 * kp2 + 1][3]);
                pf = (bf16x8){(short)(a0 & 0xffff), (short)(a0 >> 16), (short)(a1 & 0xffff), (short)(a1 >> 16), (short)(b0 & 0xffff), (short)(b0 >> 16), (short)(b1 & 0xffff), (short)(b1 >> 16)}; }
            const int vrow0 = (kh * 4 + kp2) * 64 + cbase + quad * 4 + (li >> 2);
#pragma unroll
            for (int d = 0; d < 4; ++d) {
                const u16* vp = Vl + vrow0 * KVS + d * 16 + 4 * (li & 3);
                const bf16x8 vf = tr_read2(vp, vp + 16 * KVS);
                O[d] = MFMA16(vf, pf, O[d]);
            }
        }
        __syncthreads();
    }
    {
#pragma unroll
        for (int i = 0; i < 4; ++i) { const int idx = tid + 512 * i, key = idx >> 3, ch = idx & 7;
            *(u32x4_*)(Kl + key * KVS + ch * 8) = crg.get(2 * i); *(u32x4_*)(Vl + key * KVS + ch * 8) = crg.get(2 * i + 1); }
        __syncthreads();
        const bf16x8 q0 = qp0, q1 = qp1;
        float s[8][4];
        float mx = -1e30f;
#pragma unroll
        for (int sb = 0; sb < 8; ++sb) {
            const u16* kp = Kl + (kh * 128 + sb * 16 + li) * KVS + quad * 8;
            f32x4 a = (f32x4){0.f, 0.f, 0.f, 0.f};
            a = MFMA16(*(const bf16x8*)kp, q0, a); a = MFMA16(*(const bf16x8*)(kp + 32), q1, a);
#pragma unroll
            for (int j = 0; j < 4; ++j) { const float v = a[j] * 0.125f; s[sb][j] = v; mx = fmaxf(mx, v); }
        }
        mx = fmaxf(mx, shx(mx, 16)); mx = fmaxf(mx, shx(mx, 32));
        const float m_new = fmaxf(m_run, mx), resc = __expf(m_run - m_new);
        float ls = 0.f;
#pragma unroll
        for (int sb = 0; sb < 8; ++sb)
#pragma unroll
            for (int j = 0; j < 4; ++j) { const float e = __expf(s[sb][j] - m_new); s[sb][j] = e; ls += e; }
        ls += shx(ls, 16); ls += shx(ls, 32);
        l_run = l_run * resc + ls; m_run = m_new;
#pragma unroll
        for (int d = 0; d < 4; ++d) O[d] *= resc;
#pragma unroll
        for (int kp2 = 0; kp2 < 4; ++kp2) {
            bf16x8 pf; { const unsigned a0 = pack2(s[2 * kp2][0], s[2 * kp2][1]), a1 = pack2(s[2 * kp2][2], s[2 * kp2][3]), b0 = pack2(s[2 * kp2 + 1][0], s[2 * kp2 + 1][1]), b1 = pack2(s[2 * kp2 + 1][2], s[2 * kp2 + 1][3]);
                pf = (bf16x8){(short)(a0 & 0xffff), (short)(a0 >> 16), (short)(a1 & 0xffff), (short)(a1 >> 16), (short)(b0 & 0xffff), (short)(b0 >> 16), (short)(b1 & 0xffff), (short)(b1 >> 16)}; }
            const int vrow0 = kh * 128 + kp2 * 32 + quad * 4 + (li >> 2);
#pragma unroll
            for (int d = 0; d < 4; ++d) {
                const u16* vp = Vl + vrow0 * KVS + d * 16 + 4 * (li & 3);
                const bf16x8 vf = tr_read2(vp, vp + 16 * KVS);
                O[d] = MFMA16(vf, pf, O[d]);
            }
        }
        __syncthreads();
    }
    float* cb = (float*)lds;
    if (kh == 1) {
#pragma unroll
        for (int d = 0; d < 4; ++d)
#pragma unroll
            for (int j = 0; j < 4; ++j) cb[(qtr * 18 + d * 4 + j) * 64 + lane] = O[d][j];
        cb[(qtr * 18 + 16) * 64 + lane] = m_run; cb[(qtr * 18 + 17) * 64 + lane] = l_run;
    }
    __syncthreads();
    if (kh == 0) {
        const float m2 = cb[(qtr * 18 + 16) * 64 + lane], l2 = cb[(qtr * 18 + 17) * 64 + lane];
        const float mm = fmaxf(m_run, m2), e1 = __expf(m_run - mm), e2 = __expf(m2 - mm);
        const float inv = 1.f / (l_run * e1 + l2 * e2);
#pragma unroll
        for (int d = 0; d < 4; ++d) {
            const int col = h * 64 + d * 16 + quad * 4;
            const uint2 g = gate4[d];
            float o[4];
#pragma unroll
            for (int j = 0; j < 4; ++j) o[j] = (O[d][j] * e1 + cb[(qtr * 18 + d * 4 + j) * 64 + lane] * e2) * inv;
            uint2 wv; wv.x = pack2(o[0] * siluf_(bflo(g.x)), o[1] * siluf_(bfhi(g.x))); wv.y = pack2(o[2] * siluf_(bflo(g.y)), o[3] * siluf_(bfhi(g.y)));
            *(uint2*)(Y0 + (size_t)qrow * 512 + col) = wv;
        }
    }
    __syncthreads();
}

template <int ROWS, int CPR> __device__ __forceinline__ void load_tile(u16* dstl, int lstride, const u16* src, size_t sstride) {
    constexpr int PER = ROWS * CPR / 512;
    static_assert(PER % 8 == 0, "tile size");
    const int tid_ = tidx();
#pragma unroll
    for (int b8 = 0; b8 < PER / 8; ++b8) { Reg8 rg;
#pragma unroll
        for (int j = 0; j < 8; ++j) { const int i = tid_ + 512 * (b8 * 8 + j), r = i / CPR, ch = i % CPR; rg.ld(j, src + (size_t)r * sstride + ch * 8); }
        MEMBAR();
#pragma unroll
        for (int j = 0; j < 8; ++j) { const int i = tid_ + 512 * (b8 * 8 + j), r = i / CPR, ch = i % CPR; *(u32x4_*)(dstl + r * lstride + ch * 8) = rg.get(j); }
        MEMBAR(); }
}

__device__ void four1_item(const Params& p, int item, unsigned char* lds) {
    unsigned char* ws = opaque(p.ws);
    const u16* PROJ = (const u16*)(ws + OFF_PROJ); const u16* M1 = (const u16*)(ws + OFF_M1); const float* TW = (const float*)(ws + OFF_TW);
    u16* FY = (u16*)(ws + OFF_FY);
    const int tid = tidx(), w = tid >> 6, lane = tid & 63, li = lane & 15, quad = lane >> 4;
    const int n2 = item & 63, bl = item >> 6;
    u16* T = (u16*)lds;
#pragma unroll
    for (int b8 = 0; b8 < 2; ++b8) { Reg8 rg;
#pragma unroll
        for (int j = 0; j < 8; ++j) { const int i = tid + 512 * (b8 * 8 + j), kk = i >> 6, ch = i & 63, n1 = kk >> 1, part = kk & 1;
            rg.ld(j, PJ((size_t)bl * 4096 + n1 * 64 + n2, 4 + part, ch * 8)); }
        MEMBAR();
#pragma unroll
        for (int j = 0; j < 8; ++j) { const int i = tid + 512 * (b8 * 8 + j), kk = i >> 6, ch = i & 63;
            *(u32x4_*)(T + kk * TS + ch * 8) = rg.get(j); }
        MEMBAR(); }
    float* twl = (float*)(T + 128 * TS);
    if (tid < 64) { const float2 tv = *(const float2*)(TW + 2 * (n2 * tid)); twl[2 * tid] = tv.x; twl[2 * tid + 1] = tv.y; }
    bf16x8 xf[4];
#pragma unroll
    for (int ks = 0; ks < 4; ++ks) xf[ks] = ld_frag_g(M1 + li * 128 + ks * 32 + quad * 8);
    __syncthreads();
    for (int isub = 0; isub < 8; ++isub) {
        bf16x8 xn[4];
        const int isn = isub < 7 ? isub + 1 : 7;
#pragma unroll
        for (int ks = 0; ks < 4; ++ks) xn[ks] = ld_frag_g(M1 + (isn * 16 + li) * 128 + ks * 32 + quad * 8);
        float tcs[2], tsn_[2];
#pragma unroll
        for (int hh = 0; hh < 2; ++hh) { const int k1 = isub * 8 + quad * 2 + hh; tcs[hh] = twl[2 * k1]; tsn_[hh] = twl[2 * k1 + 1]; }
#pragma unroll
        for (int cs = 0; cs < 4; ++cs) {
            const int c0 = w * 64 + cs * 16;
            f32x4 a = (f32x4){0.f, 0.f, 0.f, 0.f};
#pragma unroll
            for (int ks = 0; ks < 4; ++ks) {
                const u16* tp = T + (ks * 32 + quad * 8 + (li >> 2)) * TS + c0 + 4 * (li & 3);
                a = MFMA16(xf[ks], tr_read2(tp, tp + 4 * TS), a);
            }
            const int ch = c0 + li;
#pragma unroll
            for (int hh = 0; hh < 2; ++hh) {
                const int k1 = isub * 8 + quad * 2 + hh;
                const float yr = a[2 * hh], yi = a[2 * hh + 1];
                const float orr = yr * tcs[hh] + yi * tsn_[hh], oi = yi * tcs[hh] - yr * tsn_[hh];
                u16* dst = FY + (((size_t)bl * 64 + k1) * 64 + n2) * 1024 + ch;
                dst[0] = f2bf(orr); dst[512] = f2bf(oi);
            }
        }
#pragma unroll
        for (int ks = 0; ks < 4; ++ks) xf[ks] = xn[ks];
    }
    __syncthreads();
}

__device__ void four2_item(const Params& p, int item, unsigned char* lds) {
    unsigned char* ws = opaque(p.ws);
    const u16* PROJ = (const u16*)(ws + OFF_PROJ); const u16* M2 = (const u16*)(ws + OFF_M2); const u16* FY = (const u16*)(ws + OFF_FY);
    u16* Y1 = (u16*)(ws + OFF_Y) + (size_t)1 * MLAT * 512;
    const int tid = tidx(), w = tid >> 6, lane = tid & 63, li = lane & 15, quad = lane >> 4;
    const int k1 = item & 63, bl = item >> 6;
    u16* T = (u16*)lds;
    load_tile<128, 64>(T, TS, FY + ((size_t)bl * 64 + k1) * 64 * 1024, 512);
    __syncthreads();
    bf16x8 xf[4][4];
#pragma unroll
    for (int cs = 0; cs < 4; ++cs)
#pragma unroll
        for (int ks = 0; ks < 4; ++ks) { const u16* tp = T + (ks * 32 + quad * 8 + (li >> 2)) * TS + w * 64 + cs * 16 + 4 * (li & 3); xf[cs][ks] = tr_read2(tp, tp + 4 * TS); }
    bf16x8 yf[4]; uint2 gt[4];
#define F2_LOAD(k2s_, yf_, gt_) do { _Pragma("unroll") for (int ks = 0; ks < 4; ++ks) yf_[ks] = ld_frag_g(M2 + ((k2s_) * 16 + li) * 128 + ks * 32 + quad * 8); \
        const size_t row_ = (size_t)bl * 4096 + k1 + 64 * ((k2s_) * 16 + li); _Pragma("unroll") for (int cs = 0; cs < 4; ++cs) gt_[cs] = *(const uint2*)(PJ(row_, 6, w * 64 + cs * 16 + quad * 4)); } while (0)
    F2_LOAD(0, yf, gt);
    for (int k2s = 0; k2s < 4; ++k2s) {
        bf16x8 yn[4]; uint2 gn[4];
        const int kn = k2s < 3 ? k2s + 1 : 3;
        F2_LOAD(kn, yn, gn);
        const int k2 = k2s * 16 + li;
        const size_t row = (size_t)bl * 4096 + k1 + 64 * k2;
#pragma unroll
        for (int cs = 0; cs < 4; ++cs) {
            f32x4 a = (f32x4){0.f, 0.f, 0.f, 0.f};
#pragma unroll
            for (int ks = 0; ks < 4; ++ks) a = MFMA16(xf[cs][ks], yf[ks], a);
            const int ch = w * 64 + cs * 16 + quad * 4;
            const uint2 g = gt[cs];
            uint2 wv; wv.x = pack2(a[0] * NORM_LAT * siluf_(bflo(g.x)), a[1] * NORM_LAT * siluf_(bfhi(g.x))); wv.y = pack2(a[2] * NORM_LAT * siluf_(bflo(g.y)), a[3] * NORM_LAT * siluf_(bfhi(g.y)));
            *(uint2*)(Y1 + row * 512 + ch) = wv;
        }
#pragma unroll
        for (int q = 0; q < 4; ++q) { yf[q] = yn[q]; gt[q] = gn[q]; }
    }
#undef F2_LOAD
    __syncthreads();
}

__device__ void fourc_item(const Params& p, int item, unsigned char* lds) {
    unsigned char* ws = opaque(p.ws);
    const u16* PROJ = (const u16*)(ws + OFF_PROJ); const u16* M3 = (const u16*)(ws + OFF_M3);
    u16* Y1 = (u16*)(ws + OFF_Y) + (size_t)1 * MLAT * 512;
    const int tid = tidx(), w = tid >> 6, lane = tid & 63, li = lane & 15, quad = lane >> 4;
    const int chb = item & 3, b = item >> 2;
    u16* T = (u16*)lds;
#pragma unroll
    for (int b8 = 0; b8 < 2; ++b8) { Reg8 rg;
#pragma unroll
        for (int j = 0; j < 8; ++j) { const int i = tid + 512 * (b8 * 8 + j), kk = i >> 4, ch = i & 15, n = kk >> 1, part = kk & 1;
            rg.ld(j, PJ((size_t)b * 256 + n, 4 + part, chb * 128 + ch * 8)); }
        MEMBAR();
#pragma unroll
        for (int j = 0; j < 8; ++j) { const int i = tid + 512 * (b8 * 8 + j), kk = i >> 4, ch = i & 15;
            *(u32x4_*)(T + kk * T3S + ch * 8) = rg.get(j); }
        MEMBAR(); }
    __syncthreads();
    for (int kq = 0; kq < 2; ++kq) {
        const int ksub = w * 2 + kq;
        f32x4 a[8];
#pragma unroll
        for (int cs = 0; cs < 8; ++cs) a[cs] = (f32x4){0.f, 0.f, 0.f, 0.f};
        for (int ks = 0; ks < 16; ++ks) {
            const bf16x8 yf = ld_frag_g(M3 + (ksub * 16 + li) * 512 + ks * 32 + quad * 8);
#pragma unroll
            for (int cs = 0; cs < 8; ++cs) { const u16* tp = T + (ks * 32 + quad * 8 + (li >> 2)) * T3S + cs * 16 + 4 * (li & 3);
                a[cs] = MFMA16(tr_read2(tp, tp + 4 * T3S), yf, a[cs]); }
        }
        const size_t row = (size_t)b * 256 + ksub * 16 + li;
#pragma unroll
        for (int cs = 0; cs < 8; ++cs) {
            const int ch = chb * 128 + cs * 16 + quad * 4;
            const uint2 g = *(const uint2*)(PJ(row, 6, ch));
            uint2 wv; wv.x = pack2(a[cs][0] * NORM_CTX * siluf_(bflo(g.x)), a[cs][1] * NORM_CTX * siluf_(bfhi(g.x))); wv.y = pack2(a[cs][2] * NORM_CTX * siluf_(bflo(g.y)), a[cs][3] * NORM_CTX * siluf_(bfhi(g.y)));
            *(uint2*)(Y1 + row * 512 + ch) = wv;
        }
    }
    __syncthreads();
}

__device__ void gmlp_item(const Params& p, int l, int item, unsigned char* lds) {
    unsigned char* ws = opaque(p.ws);
    const u16* PROJ = (const u16*)(ws + OFF_PROJ); const u16* WS16 = (const u16*)(ws + OFF_WS16) + (size_t)l * 8 * 128 * 128;
    u16* Y2 = (u16*)(ws + OFF_Y) + (size_t)2 * MLAT * 512;
    const int tid = tidx(), w = tid >> 6, lane = tid & 63, li = lane & 15, quad = lane >> 4;
    const size_t r0 = (size_t)item * 128;
    u16* VN = (u16*)lds;
    {
        const int row = tid >> 2, qd = tid & 3;
        const u16* src = PJ(r0 + row, 8, 0);
        uint4 raw[16]; float ss = 0.f;
#pragma unroll
        for (int i = 0; i < 16; ++i) { raw[i] = *(const uint4*)(src + (qd + 4 * i) * 8); float f[8]; unpack8(raw[i], f);
#pragma unroll
            for (int e = 0; e < 8; ++e) ss += f[e] * f[e]; }
        ss += shx(ss, 1); ss += shx(ss, 2);
        const float rstd = rsqrtf(ss * (1.f / 512.f) + EPSN);
        const float* gn = p.gmlp_g + l * 512;
#pragma unroll
        for (int i = 0; i < 16; ++i) { float f[8]; unpack8(raw[i], f); const int c0 = (qd + 4 * i) * 8;
            const float4 g0 = *(const float4*)(gn + c0), g1 = *(const float4*)(gn + c0 + 4);
            uint4 o; o.x = pack2(f[0] * rstd * g0.x, f[1] * rstd * g0.y); o.y = pack2(f[2] * rstd * g0.z, f[3] * rstd * g0.w);
            o.z = pack2(f[4] * rstd * g1.x, f[5] * rstd * g1.y); o.w = pack2(f[6] * rstd * g1.z, f[7] * rstd * g1.w);
            *(uint4*)(VN + row * TS + c0) = o; }
    }
    __syncthreads();
    const int g = w;
    bf16x8 xf[4][4];
#pragma unroll
    for (int cs = 0; cs < 4; ++cs)
#pragma unroll
        for (int ks = 0; ks < 4; ++ks) { const u16* tp = VN + (ks * 32 + quad * 8 + (li >> 2)) * TS + g * 64 + cs * 16 + 4 * (li & 3); xf[cs][ks] = tr_read2(tp, tp + 4 * TS); }
    bf16x8 yf[4]; uint2 uu[4], gg[4]; float bs;
#define GM_LOAD(ts_, yf_, uu_, gg_, bs_) do { const int t_ = (ts_) * 16 + li; _Pragma("unroll") for (int ks = 0; ks < 4; ++ks) yf_[ks] = ld_frag_g(WS16 + ((size_t)g * 128 + t_) * 128 + ks * 32 + quad * 8); \
        bs_ = p.gmlp_bs[((size_t)l * 8 + g) * 128 + t_]; _Pragma("unroll") for (int cs = 0; cs < 4; ++cs) { const int c_ = g * 64 + cs * 16 + quad * 4; uu_[cs] = *(const uint2*)(PJ(r0 + t_, 7, c_)); gg_[cs] = *(const uint2*)(PJ(r0 + t_, 9, c_)); } } while (0)
    GM_LOAD(0, yf, uu, gg, bs);
    for (int ts = 0; ts < 8; ++ts) {
        bf16x8 yn[4]; uint2 un[4], gn[4]; float bn;
        const int tn = ts < 7 ? ts + 1 : 7;
        GM_LOAD(tn, yn, un, gn, bn);
        const int t = ts * 16 + li;
        const size_t row = r0 + t;
#pragma unroll
        for (int cs = 0; cs < 4; ++cs) {
            f32x4 a = (f32x4){0.f, 0.f, 0.f, 0.f};
#pragma unroll
            for (int ks = 0; ks < 4; ++ks) a = MFMA16(xf[cs][ks], yf[ks], a);
            const int c = g * 64 + cs * 16 + quad * 4;
            uint2 wv; wv.x = pack2(bflo(uu[cs].x) * (a[0] + bs) * siluf_(bflo(gg[cs].x)), bfhi(uu[cs].x) * (a[1] + bs) * siluf_(bfhi(gg[cs].x)));
            wv.y = pack2(bflo(uu[cs].y) * (a[2] + bs) * siluf_(bflo(gg[cs].y)), bfhi(uu[cs].y) * (a[3] + bs) * siluf_(bfhi(gg[cs].y)));
            *(uint2*)(Y2 + row * 512 + c) = wv;
        }
#pragma unroll
        for (int q = 0; q < 4; ++q) { yf[q] = yn[q]; uu[q] = un[q]; gg[q] = gn[q]; }
        bs = bn;
    }
#undef GM_LOAD
    __syncthreads();
}

__device__ __forceinline__ void chunk_cumsum(float* A, float* tmp, int dir) {
    const int k = tidx() & 63, seg = tidx() >> 6;
    float v[8]; float run = 0.f;
    if (dir == 0) {
#pragma unroll
        for (int e = 0; e < 8; ++e) { run += A[(seg * 8 + e) * HS_ + k]; v[e] = run; }
    } else {
#pragma unroll
        for (int e = 7; e >= 0; --e) { run += A[(seg * 8 + e) * HS_ + k]; v[e] = run; }
    }
    tmp[seg * 64 + k] = run;
    __syncthreads();
    float off = 0.f;
#pragma unroll
    for (int s2 = 0; s2 < 8; ++s2) { const float tv = tmp[s2 * 64 + k]; if (dir == 0 ? (s2 < seg) : (s2 > seg)) off += tv; }
#pragma unroll
    for (int e = 0; e < 8; ++e) A[(seg * 8 + e) * HS_ + k] = (v[e] + off) * LOG2E;
    __syncthreads();
}
__device__ __forceinline__ void chunk_cumsum2(float* Af, float* Ab, float* tmp) {
    const int k = tidx() & 63, seg = tidx() >> 6;
    float vf[8], vb[8]; float rf = 0.f, rb = 0.f;
#pragma unroll
    for (int e = 0; e < 8; ++e) { rf += Af[(seg * 8 + e) * HS_ + k]; vf[e] = rf; }
#pragma unroll
    for (int e = 7; e >= 0; --e) { rb += Ab[(seg * 8 + e) * HS_ + k]; vb[e] = rb; }
    tmp[seg * 64 + k] = rf; tmp[512 + seg * 64 + k] = rb;
    __syncthreads();
    float of = 0.f, ob = 0.f;
#pragma unroll
    for (int s2 = 0; s2 < 8; ++s2) { const float tf = tmp[s2 * 64 + k], tb = tmp[512 + s2 * 64 + k]; if (s2 < seg) of += tf; if (s2 > seg) ob += tb; }
#pragma unroll
    for (int e = 0; e < 8; ++e) { Af[(seg * 8 + e) * HS_ + k] = (vf[e] + of) * LOG2E; Ab[(seg * 8 + e) * HS_ + k] = (vb[e] + ob) * LOG2E; }
    __syncthreads();
}
__device__ __forceinline__ void load_bf_tile64(float* dst, const u16* src  , size_t sstride) {
    const int t = tidx() >> 3, k8 = (tidx() & 7) * 8;
    float f[8]; unpack8(*(const uint4*)(src + (size_t)t * sstride + k8), f);
    *(float4*)(dst + t * HS_ + k8) = make_float4(f[0], f[1], f[2], f[3]); *(float4*)(dst + t * HS_ + k8 + 4) = make_float4(f[4], f[5], f[6], f[7]);
}
__device__ __forceinline__ void load_f32_tile64(float* dst, const float* src, size_t sstride) {
    const int t = tidx() >> 3, k8 = (tidx() & 7) * 8;
    *(float4*)(dst + t * HS_ + k8) = *(const float4*)(src + (size_t)t * sstride + k8); *(float4*)(dst + t * HS_ + k8 + 4) = *(const float4*)(src + (size_t)t * sstride + k8 + 4);
}

__device__ __forceinline__ void hgrn1_issue(const u16* PROJ, const float* LOGF, const PassInfo ps, int item, Reg8& rg) {
    const int NC = ps.T >> 6, ncsh = ps.is_ctx ? 2 : 6, c = item & (NC - 1), ci = item >> ncsh, dir = ci & 1, h = (ci >> 1) & 7, bl = ci >> 4;
    const size_t r0 = (size_t)bl * ps.T + c * 64;
    const int t = tidx() >> 3, k8 = (tidx() & 7) * 8;
    const float* ap = LOGF + (r0 + t) * 1024 + dir * 512 + h * 64 + k8;
    rg.ld(0, ap); rg.ld(1, ap + 4); rg.ld(2, PJ(r0 + t, 11 + dir, h * 64 + k8)); rg.ld(3, PJ(r0 + t, 13, h * 64 + k8));
}
__device__ void hgrn1_loop(const Params& p, const PassInfo ps, int first, int end, int stride, unsigned char* lds) {
    if (first >= end) return;
    unsigned char* ws = opaque(p.ws);
    const u16* PROJ = (const u16*)(ws + OFF_PROJ); const float* LOGF = (const float*)(ws + OFF_LOGF);
    u16* HL = (u16*)(ws + OFF_HL); float* HD = (float*)(ws + OFF_HD);
    float* A = (float*)lds; float* tmp = A + 64 * HS_; u16* Wb = (u16*)(tmp + 512); u16* Ib = Wb + 64 * KVS;
    const int tid = tidx(), w = tid >> 6, lane = tid & 63, li = lane & 15, quad = lane >> 4;
    const int t = tid >> 3, k8 = (tid & 7) * 8;
    Reg8 rg;
    hgrn1_issue(PROJ, LOGF, ps, first, rg);
  for (int item = first; item < end; item += stride) {
    const int ncsh = ps.is_ctx ? 2 : 6, ci = item >> ncsh, dir = ci & 1;
    float kf[8];
    { MEMBAR();
      unpack8(rg.getu(2), kf);
      *(u32x4_*)(A + t * HS_ + k8) = rg.get(0); *(u32x4_*)(A + t * HS_ + k8 + 4) = rg.get(1);
      *(u32x4_*)(Ib + t * KVS + k8) = rg.get(3); }
    __syncthreads();
    if (item + stride < end) hgrn1_issue(PROJ, LOGF, ps, item + stride, rg);
    chunk_cumsum(A, tmp, dir);
    const int lastt = dir == 0 ? 63 : 0;
    { float wv[8];
#pragma unroll
      for (int e = 0; e < 8; ++e) wv[e] = kf[e] * __builtin_amdgcn_exp2f(A[lastt * HS_ + k8 + e] - A[t * HS_ + k8 + e]);
      uint4 wq; wq.x = pack2(wv[0], wv[1]); wq.y = pack2(wv[2], wv[3]); wq.z = pack2(wv[4], wv[5]); wq.w = pack2(wv[6], wv[7]);
      *(uint4*)(Wb + t * KVS + k8) = wq;
      if (tid < 64) HD[(size_t)item * 64 + tid] = __builtin_amdgcn_exp2f(A[lastt * HS_ + tid]); }
    __syncthreads();
    {
        const int ksub = w >> 1;
        bf16x8 yf[2];
#pragma unroll
        for (int ks = 0; ks < 2; ++ks) { const u16* tp = Wb + (ks * 32 + quad * 8 + (li >> 2)) * KVS + ksub * 16 + 4 * (li & 3); yf[ks] = tr_read2(tp, tp + 4 * KVS); }
#pragma unroll
        for (int vv = 0; vv < 2; ++vv) {
            const int vsub = (w & 1) * 2 + vv;
            f32x4 a = (f32x4){0.f, 0.f, 0.f, 0.f};
#pragma unroll
            for (int ks = 0; ks < 2; ++ks) { const u16* tp = Ib + (ks * 32 + quad * 8 + (li >> 2)) * KVS + vsub * 16 + 4 * (li & 3); a = MFMA16(tr_read2(tp, tp + 4 * KVS), yf[ks], a); }
            uint2 o; o.x = pack2(a[0], a[1]); o.y = pack2(a[2], a[3]);
            *(uint2*)(HL + ((size_t)item * 64 + ksub * 16 + li) * 64 + vsub * 16 + quad * 4) = o;
        }
    }
    __syncthreads();
  }
}

__device__ void hgrn_chain(const Params& p, const PassInfo ps, int l, int ci, unsigned char* lds) {
    unsigned char* ws = opaque(p.ws);
    const u16* PROJ = (const u16*)(ws + OFF_PROJ); const float* LOGF = (const float*)(ws + OFF_LOGF);
    u16* HS = (u16*)(ws + OFF_HS); float* CST = (float*)(ws + OFF_CTXST) + (size_t)l * 256 * 4096;
    const int tid = tidx(), w = tid >> 6, lane = tid & 63, li = lane & 15, quad = lane >> 4;
    const int t = tid >> 3, k8 = (tid & 7) * 8;
    const int NC = ps.T >> 6, dir = ci & 1, ksub = w >> 1, kk_ = ksub * 16 + li;
    float S[2][4];
#pragma unroll
    for (int vv = 0; vv < 2; ++vv) {
        const int v0 = ((w & 1) * 2 + vv) * 16 + quad * 4;
        if (!ps.is_ctx) { const float4 c4 = *(const float4*)(CST + ((size_t)ps.b0 * 16 + ci) * 4096 + kk_ * 64 + v0); S[vv][0] = c4.x; S[vv][1] = c4.y; S[vv][2] = c4.z; S[vv][3] = c4.w; }
        else { S[vv][0] = 0.f; S[vv][1] = 0.f; S[vv][2] = 0.f; S[vv][3] = 0.f; }
    }
    Reg8 rg;
    hgrn1_issue(PROJ, LOGF, ps, ci * NC + (dir ? NC - 1 : 0), rg);
  for (int cc = 0; cc < NC; ++cc) {
    const int c = dir ? NC - 1 - cc : cc, item = ci * NC + c;
    float* A = (float*)(lds + (cc & 1) * 38912); float* tmp = A + 64 * HS_; u16* Wb = (u16*)(tmp + 512); u16* Ib = Wb + 64 * KVS;
    float kf[8];
    { MEMBAR();
      unpack8(rg.getu(2), kf);
      *(u32x4_*)(A + t * HS_ + k8) = rg.get(0); *(u32x4_*)(A + t * HS_ + k8 + 4) = rg.get(1);
      *(u32x4_*)(Ib + t * KVS + k8) = rg.get(3); }
    __syncthreads();
    if (cc + 1 < NC) hgrn1_issue(PROJ, LOGF, ps, ci * NC + (dir ? NC - 2 - cc : cc + 1), rg);
    chunk_cumsum(A, tmp, dir);
    const int lastt = dir == 0 ? 63 : 0;
    { float wv[8];
#pragma unroll
      for (int e = 0; e < 8; ++e) wv[e] = kf[e] * __builtin_amdgcn_exp2f(A[lastt * HS_ + k8 + e] - A[t * HS_ + k8 + e]);
      uint4 wq; wq.x = pack2(wv[0], wv[1]); wq.y = pack2(wv[2], wv[3]); wq.z = pack2(wv[4], wv[5]); wq.w = pack2(wv[6], wv[7]);
      *(uint4*)(Wb + t * KVS + k8) = wq; }
    __syncthreads();
    {
        const float dk = __builtin_amdgcn_exp2f(A[lastt * HS_ + kk_]);
        bf16x8 yf[2];
#pragma unroll
        for (int ks = 0; ks < 2; ++ks) { const u16* tp = Wb + (ks * 32 + quad * 8 + (li >> 2)) * KVS + ksub * 16 + 4 * (li & 3); yf[ks] = tr_read2(tp, tp + 4 * KVS); }
#pragma unroll
        for (int vv = 0; vv < 2; ++vv) {
            const int vsub = (w & 1) * 2 + vv;
            f32x4 a = (f32x4){0.f, 0.f, 0.f, 0.f};
#pragma unroll
            for (int ks = 0; ks < 2; ++ks) { const u16* tp = Ib + (ks * 32 + quad * 8 + (li >> 2)) * KVS + vsub * 16 + 4 * (li & 3); a = MFMA16(tr_read2(tp, tp + 4 * KVS), yf[ks], a); }
            uint2 o; o.x = pack2(S[vv][0], S[vv][1]); o.y = pack2(S[vv][2], S[vv][3]);
            *(uint2*)(HS + ((size_t)item * 64 + kk_) * 64 + vsub * 16 + quad * 4) = o;
#pragma unroll
            for (int j = 0; j < 4; ++j) S[vv][j] = dk * S[vv][j] + a[j];
        }
    }
  }
    __syncthreads();
    if (ps.is_ctx) {
#pragma unroll
        for (int vv = 0; vv < 2; ++vv) { const int v0 = ((w & 1) * 2 + vv) * 16 + quad * 4;
            *(float4*)(CST + (size_t)ci * 4096 + kk_ * 64 + v0) = make_float4(S[vv][0], S[vv][1], S[vv][2], S[vv][3]); }
    }
}

__device__ void hgrn2_all(const Params& p, const PassInfo ps, int l) {
    unsigned char* ws = opaque(p.ws);
    const unsigned* HL = (const unsigned*)(ws + OFF_HL); const float* HD = (const float*)(ws + OFF_HD); unsigned* HS = (unsigned*)(ws + OFF_HS);
    float* CST = (float*)(ws + OFF_CTXST) + (size_t)l * 256 * 4096;
    const int NC = ps.T >> 6, chains = ps.nb * 16;
    const size_t total = (size_t)chains * 2048;
    for (size_t e = (size_t)blockIdx.x * 512 + tidx(); e < total; e += (size_t)gridDim.x * 512) {
        const int ci = (int)(e >> 11), kv2 = (int)(e & 2047), k = kv2 >> 5, dir = ci & 1;
        float s0 = 0.f, s1 = 0.f;
        if (!ps.is_ctx) { const float2 cs = *(const float2*)(CST + ((size_t)ps.b0 * 16 + ci) * 4096 + 2 * kv2); s0 = cs.x; s1 = cs.y; }
#define HG2_TRIP(BLK) for (int c4 = 0; c4 < NC; c4 += BLK) { float d[BLK]; unsigned lw[BLK]; \
            _Pragma("unroll") for (int j = 0; j < BLK; ++j) { const int c = dir ? NC - 1 - (c4 + j) : c4 + j; const size_t idx = (size_t)ci * NC + c; d[j] = HD[idx * 64 + k]; lw[j] = HL[idx * 2048 + kv2]; } \
            _Pragma("unroll") for (int j = 0; j < BLK; ++j) { const int c = dir ? NC - 1 - (c4 + j) : c4 + j; const size_t idx = (size_t)ci * NC + c; \
                HS[idx * 2048 + kv2] = pack2(s0, s1); s0 = d[j] * s0 + bflo(lw[j]); s1 = d[j] * s1 + bfhi(lw[j]); } }
        if (NC == 4) { HG2_TRIP(4) } else { HG2_TRIP(16) }
#undef HG2_TRIP
        if (ps.is_ctx) *(float2*)(CST + (size_t)ci * 4096 + 2 * kv2) = make_float2(s0, s1);
    }
}

__device__ void hgrn3_item(const Params& p, const PassInfo ps, int l, int item, unsigned char* lds) {
    unsigned char* ws = opaque(p.ws);
    const u16* PROJ = (const u16*)(ws + OFF_PROJ); const float* LOGF = (const float*)(ws + OFF_LOGF); const u16* HSt = (const u16*)(ws + OFF_HS);
    u16* Y3 = (u16*)(ws + OFF_Y) + (size_t)3 * MLAT * 512;
    const int NC = ps.T >> 6, ncsh = ps.is_ctx ? 2 : 6, c = item & (NC - 1), bh = item >> ncsh, h = bh & 7, bl = bh >> 3;
    const size_t r0 = (size_t)bl * ps.T + c * 64;
    const size_t idxf = (size_t)(bh * 2 + 0) * NC + c, idxb = (size_t)(bh * 2 + 1) * NC + c;
    float* Q = (float*)lds; float* KKf = Q + 64 * HS_; float* KKb = KKf + 64 * HS_; float* Af = KKb + 64 * HS_; float* Ab = Af + 64 * HS_; float* tmp = Ab + 64 * HS_;
    u16* Ib = (u16*)(tmp + 1024); u16* Sfb = Ib + 64 * KVS; u16* Sbb = Sfb + 64 * KVS; float* comb = (float*)(Sbb + 64 * KVS);
    const int tid = tidx(), w = tid >> 6, lane = tid & 63, li = lane & 15, quad = lane >> 4;
    { const int t = tid >> 3, k8 = (tid & 7) * 8;
      Reg8 ra, rb;
      const float* ap = LOGF + (r0 + t) * 1024 + h * 64 + k8;
      const u16* sf = HSt + idxf * 4096 + t * 64 + k8; const u16* sb = HSt + idxb * 4096 + t * 64 + k8;
      ra.ld(0, PJ(r0 + t, 10, h * 64 + k8)); ra.ld(1, PJ(r0 + t, 11, h * 64 + k8)); ra.ld(2, PJ(r0 + t, 12, h * 64 + k8)); ra.ld(3, PJ(r0 + t, 13, h * 64 + k8));
      ra.ld(4, ap); ra.ld(5, ap + 4); ra.ld(6, ap + 512); ra.ld(7, ap + 516);
      rb.ld(0, sf); rb.ld(1, sb);
      MEMBAR();
      float x[8];
      unpack8(ra.getu(0), x); *(float4*)(Q + t * HS_ + k8) = make_float4(x[0], x[1], x[2], x[3]); *(float4*)(Q + t * HS_ + k8 + 4) = make_float4(x[4], x[5], x[6], x[7]);
      unpack8(ra.getu(1), x); *(float4*)(KKf + t * HS_ + k8) = make_float4(x[0], x[1], x[2], x[3]); *(float4*)(KKf + t * HS_ + k8 + 4) = make_float4(x[4], x[5], x[6], x[7]);
      unpack8(ra.getu(2), x); *(float4*)(KKb + t * HS_ + k8) = make_float4(x[0], x[1], x[2], x[3]); *(float4*)(KKb + t * HS_ + k8 + 4) = make_float4(x[4], x[5], x[6], x[7]);
      *(u32x4_*)(Ib + t * KVS + k8) = ra.get(3);
      *(u32x4_*)(Af + t * HS_ + k8) = ra.get(4); *(u32x4_*)(Af + t * HS_ + k8 + 4) = ra.get(5); *(u32x4_*)(Ab + t * HS_ + k8) = ra.get(6); *(u32x4_*)(Ab + t * HS_ + k8 + 4) = ra.get(7);
      *(u32x4_*)(Sfb + t * KVS + k8) = rb.get(0); *(u32x4_*)(Sbb + t * KVS + k8) = rb.get(1); }
    __syncthreads();
    chunk_cumsum2(Af, Ab, tmp);
    const int dir = w >> 2, T = w & 3;
    const float* A = dir ? Ab : Af; const float* KK = dir ? KKb : KKf; const u16* Sb16 = dir ? Sbb : Sfb;
    const int t = 16 * T + li;
    const int rrow = dir ? 16 * T + 16 : 16 * T - 1; const bool rzero = dir ? (T == 3) : (T == 0);
    bf16x8 qt[2], qh[2];
    float Rv[2][8];
#pragma unroll
    for (int ks = 0; ks < 2; ++ks) {
        const int k0 = ks * 32 + quad * 8;
        float qv[8], av[8];
        { const float4 x0 = *(const float4*)(Q + t * HS_ + k0), x1 = *(const float4*)(Q + t * HS_ + k0 + 4); qv[0] = x0.x; qv[1] = x0.y; qv[2] = x0.z; qv[3] = x0.w; qv[4] = x1.x; qv[5] = x1.y; qv[6] = x1.z; qv[7] = x1.w; }
        { const float4 x0 = *(const float4*)(A + t * HS_ + k0), x1 = *(const float4*)(A + t * HS_ + k0 + 4); av[0] = x0.x; av[1] = x0.y; av[2] = x0.z; av[3] = x0.w; av[4] = x1.x; av[5] = x1.y; av[6] = x1.z; av[7] = x1.w; }
        if (rzero) {
#pragma unroll
            for (int e = 0; e < 8; ++e) Rv[ks][e] = 0.f;
        } else { const float4 x0 = *(const float4*)(A + rrow * HS_ + k0), x1 = *(const float4*)(A + rrow * HS_ + k0 + 4); Rv[ks][0] = x0.x; Rv[ks][1] = x0.y; Rv[ks][2] = x0.z; Rv[ks][3] = x0.w; Rv[ks][4] = x1.x; Rv[ks][5] = x1.y; Rv[ks][6] = x1.z; Rv[ks][7] = x1.w; }
        float a_[8], b_[8];
#pragma unroll
        for (int e = 0; e < 8; ++e) { a_[e] = qv[e] * __builtin_amdgcn_exp2f(av[e] - Rv[ks][e]); b_[e] = qv[e] * __builtin_amdgcn_exp2f(av[e]); }
        const unsigned a0 = pack2(a_[0], a_[1]), a1 = pack2(a_[2], a_[3]), a2 = pack2(a_[4], a_[5]), a3 = pack2(a_[6], a_[7]);
        const unsigned b0 = pack2(b_[0], b_[1]), b1 = pack2(b_[2], b_[3]), b2 = pack2(b_[4], b_[5]), b3 = pack2(b_[6], b_[7]);
        qt[ks] = (bf16x8){(short)(a0 & 0xffff), (short)(a0 >> 16), (short)(a1 & 0xffff), (short)(a1 >> 16), (short)(a2 & 0xffff), (short)(a2 >> 16), (short)(a3 & 0xffff), (short)(a3 >> 16)};
        qh[ks] = (bf16x8){(short)(b0 & 0xffff), (short)(b0 >> 16), (short)(b1 & 0xffff), (short)(b1 >> 16), (short)(b2 & 0xffff), (short)(b2 >> 16), (short)(b3 & 0xffff), (short)(b3 >> 16)};
    }
    const int nS = dir ? 4 - T : T + 1;
    float sc[4][4];
#pragma unroll
    for (int i = 0; i < 4; ++i) {
        if (i < nS) {
            const int S = dir ? T + i : i, srow = 16 * S + li;
            f32x4 a = (f32x4){0.f, 0.f, 0.f, 0.f};
#pragma unroll
            for (int ks = 0; ks < 2; ++ks) {
                const int k0 = ks * 32 + quad * 8;
                const float4 x0 = *(const float4*)(KK + srow * HS_ + k0), x1 = *(const float4*)(KK + srow * HS_ + k0 + 4);
                const float4 y0 = *(const float4*)(A + srow * HS_ + k0), y1 = *(const float4*)(A + srow * HS_ + k0 + 4);
                const float kv[8] = {x0.x, x0.y, x0.z, x0.w, x1.x, x1.y, x1.z, x1.w}, as[8] = {y0.x, y0.y, y0.z, y0.w, y1.x, y1.y, y1.z, y1.w};
                float c_[8];
#pragma unroll
                for (int e = 0; e < 8; ++e) c_[e] = kv[e] * __builtin_amdgcn_exp2f(Rv[ks][e] - as[e]);
                const unsigned c0 = pack2(c_[0], c_[1]), c1 = pack2(c_[2], c_[3]), c2 = pack2(c_[4], c_[5]), c3 = pack2(c_[6], c_[7]);
                const bf16x8 kf = (bf16x8){(short)(c0 & 0xffff), (short)(c0 >> 16), (short)(c1 & 0xffff), (short)(c1 >> 16), (short)(c2 & 0xffff), (short)(c2 >> 16), (short)(c3 & 0xffff), (short)(c3 >> 16)};
                a = MFMA16(kf, qt[ks], a);
            }
            const bool diag = (S == T);
#pragma unroll
            for (int j = 0; j < 4; ++j) { const int sl = quad * 4 + j; const bool keep = !diag || (dir ? (sl >= li) : (sl <= li)); sc[i][j] = keep ? a[j] : 0.f; }
        } else {
#pragma unroll
            for (int j = 0; j < 4; ++j) sc[i][j] = 0.f;
        }
    }
    f32x4 O[4];
#pragma unroll
    for (int v = 0; v < 4; ++v) O[v] = (f32x4){0.f, 0.f, 0.f, 0.f};
#pragma unroll
    for (int pr = 0; pr < 2; ++pr) {
        if (2 * pr < nS) {
            const unsigned a0 = pack2(sc[2 * pr][0], sc[2 * pr][1]), a1 = pack2(sc[2 * pr][2], sc[2 * pr][3]), b0 = pack2(sc[2 * pr + 1][0], sc[2 * pr + 1][1]), b1 = pack2(sc[2 * pr + 1][2], sc[2 * pr + 1][3]);
            const bf16x8 pf = (bf16x8){(short)(a0 & 0xffff), (short)(a0 >> 16), (short)(a1 & 0xffff), (short)(a1 >> 16), (short)(b0 & 0xffff), (short)(b0 >> 16), (short)(b1 & 0xffff), (short)(b1 >> 16)};
            const int S0 = dir ? T + 2 * pr : 2 * pr; int S1 = S0 + 1; if (S1 > 3) S1 = 3;
            const u16* p0 = Ib + (16 * S0 + quad * 4 + (li >> 2)) * KVS + 4 * (li & 3);
            const u16* p1 = Ib + (16 * S1 + quad * 4 + (li >> 2)) * KVS + 4 * (li & 3);
#pragma unroll
            for (int v = 0; v < 4; ++v) O[v] = MFMA16(tr_read2(p0 + v * 16, p1 + v * 16), pf, O[v]);
        }
    }
#pragma unroll
    for (int ks = 0; ks < 2; ++ks) {
        const u16* p0 = Sb16 + (ks * 32 + quad * 8 + (li >> 2)) * KVS + 4 * (li & 3);
#pragma unroll
        for (int v = 0; v < 4; ++v) O[v] = MFMA16(tr_read2(p0 + v * 16, p0 + 4 * KVS + v * 16), qh[ks], O[v]);
    }
    if (dir == 1) {
#pragma unroll
        for (int v = 0; v < 4; ++v)
#pragma unroll
            for (int j = 0; j < 4; ++j) comb[(T * 16 + v * 4 + j) * 64 + lane] = O[v][j];
    }
    __syncthreads();
    if (dir == 0) {
        float ss = 0.f;
#pragma unroll
        for (int v = 0; v < 4; ++v)
#pragma unroll
            for (int j = 0; j < 4; ++j) { O[v][j] += comb[(T * 16 + v * 4 + j) * 64 + lane]; ss += O[v][j] * O[v][j]; }
        ss += shx(ss, 16); ss += shx(ss, 32);
        const float rstd = rsqrtf(ss * (1.f / 64.f) + EPSN);
        const size_t row = r0 + t;
#pragma unroll
        for (int v = 0; v < 4; ++v) {
            const int col = h * 64 + v * 16 + quad * 4;
            const float4 gn = *(const float4*)(p.hgrn_g + l * 512 + col);
            const uint2 g = *(const uint2*)(PJ(row, 14, col));
            uint2 wv; wv.x = pack2(O[v][0] * rstd * gn.x * siluf_(bflo(g.x)), O[v][1] * rstd * gn.y * siluf_(bfhi(g.x))); wv.y = pack2(O[v][2] * rstd * gn.z * siluf_(bflo(g.y)), O[v][3] * rstd * gn.w * siluf_(bfhi(g.y)));
            *(uint2*)(Y3 + row * 512 + col) = wv;
        }
    }
    __syncthreads();
}
#define XB_TMO      128
#define XB_XCNT(j)  (256  + 64 * (j))
#define XB_XSUB(j)  (1280 + 64 * (j))
#define XB_XGEN(j)  (2304 + 64 * (j))
#define XB_TOP      3328
#define XB_TOPGEN   3392
#define XCD_BAR_WORDS 3456
#define XB_SPIN_CAP (1u << 18)

__device__ __forceinline__ unsigned xb_ld(unsigned* p)              { return __hip_atomic_load(p, __ATOMIC_RELAXED, __HIP_MEMORY_SCOPE_AGENT); }
__device__ __forceinline__ unsigned xb_add(unsigned* p, unsigned v) { return __hip_atomic_fetch_add(p, v, __ATOMIC_RELAXED, __HIP_MEMORY_SCOPE_AGENT); }
__device__ __forceinline__ unsigned xb_xcc_id() { return (unsigned)__builtin_amdgcn_s_getreg((3 << 11) | 20) & 0xFu; }
#define XB_SPIN(cond, bar) do { unsigned _sp = 0; while (cond) { __builtin_amdgcn_s_sleep(1); \
    if ((++_sp & 255u) == 0u) { if (xb_ld(&(bar)[XB_TMO])) break; if (_sp > XB_SPIN_CAP) { atomicAdd(&(bar)[XB_TMO], 1u); break; } } } } while (0)

struct XcdBarrier {
    unsigned* bar; unsigned x;
    volatile LAS unsigned* st;
};

__device__ __forceinline__ XcdBarrier xcd_barrier_post(unsigned* bar, volatile LAS unsigned* st) {
    XcdBarrier b; b.bar = bar; b.x = xb_xcc_id(); b.st = st;
    if (tidx() == 0) (void)xb_add(&bar[XB_XCNT(b.x)], 1u);
    return b;
}
__device__ __forceinline__ void xcd_barrier_complete(unsigned* bar, unsigned x, unsigned& nloc, unsigned& nx) {
    const unsigned G = gridDim.x * gridDim.y * gridDim.z;
    unsigned sum, cnt, mine, sp = 0u;
    for (;;) {
        sum = 0u; cnt = 0u; mine = 0u;
#pragma unroll
        for (unsigned j = 0; j < 16; ++j) { const unsigned c = xb_ld(&bar[XB_XCNT(j)]); sum += c; cnt += (c > 0u) ? 1u : 0u; mine = (j == x) ? c : mine; }
        if (sum == G) break;
        __builtin_amdgcn_s_sleep(1);
        if ((++sp & 255u) == 0u) { if (xb_ld(&bar[XB_TMO])) break; if (sp > XB_SPIN_CAP) { atomicAdd(&bar[XB_TMO], 1u); break; } }
    }
    nloc = mine > 0u ? mine : 1u; nx = cnt > 0u ? cnt : 1u;
}

__device__ __forceinline__ void xcd_barrier(const XcdBarrier& b) {
    asm volatile("s_waitcnt vmcnt(0)" ::: "memory");
    __syncthreads();
    if (tidx() == 0) {
        unsigned* bar = b.bar;
        __builtin_amdgcn_s_waitcnt(0);
        unsigned nloc = b.st[0], nx = b.st[1];
        if (nloc == 0u) { xcd_barrier_complete(bar, b.x, nloc, nx); b.st[0] = nloc; b.st[1] = nx; }
        const unsigned old = xb_add(&bar[XB_XSUB(b.x)], 1u);
        const unsigned gen = old / nloc;
        if (old + 1u == (gen + 1u) * nloc) {
            __builtin_amdgcn_fence(__ATOMIC_RELEASE, "agent");
            asm volatile("s_waitcnt vmcnt(0)" ::: "memory");
            const unsigned og = xb_add(&bar[XB_TOP], 1u);
            const unsigned tg = og / nx;
            if (og + 1u == (tg + 1u) * nx) xb_add(&bar[XB_TOPGEN], 1u);
            else XB_SPIN(xb_ld(&bar[XB_TOPGEN]) == tg, bar);
            __builtin_amdgcn_fence(__ATOMIC_ACQUIRE, "agent");
            xb_add(&bar[XB_XGEN(b.x)], 1u);
            asm volatile("s_waitcnt vmcnt(0)" ::: "memory");
        } else {
            XB_SPIN(xb_ld(&bar[XB_XGEN(b.x)]) == gen, bar);
            __builtin_amdgcn_fence(__ATOMIC_ACQUIRE, "agent");
            asm volatile("s_waitcnt vmcnt(0)" ::: "memory");
        }
    }
    __syncthreads();
}

#ifndef STAG_B
#define STAG_B 240
#endif
#ifndef STAG_D
#define STAG_D 300
#endif
#ifndef REP_ATTN
#define REP_ATTN 1
#endif
#ifndef REP_B
#define REP_B 1
#endif
#ifndef REP_C1
#define REP_C1 1
#endif
#ifndef REP_C2
#define REP_C2 1
#endif
#ifndef REP_C3
#define REP_C3 1
#endif
#ifndef REP_DE
#define REP_DE 1
#endif
__device__ __forceinline__ void stagger(int ticks_per_slot) {
    const int slot = ((int)blockIdx.x >> 3) & 7;
    if (slot) { const unsigned long long t0 = __builtin_amdgcn_s_memrealtime(), dt = (unsigned long long)(slot * ticks_per_slot);
        while (__builtin_amdgcn_s_memrealtime() - t0 < dt) __builtin_amdgcn_s_sleep(4); }
}
template <class Epi> __device__ __forceinline__ void run_gemm(LAS unsigned char* lds, const u16* A, const u16* Bt, int M, int N, int K, const Epi& E) {
    pg8::Gemm g; g.A = A; g.Bt = Bt; g.M = M; g.N = N; g.K = K; g.rsA = 0; g.rsB = 0;
    pg8::StaticOrder S; S.init(M, N, (int)gridDim.x, (int)blockIdx.x);
    pg8::gemm_phase<Epi, pg8::StaticOrder, false>(lds, g, S, E, nullptr);
}


struct EpiNull {
    static constexpr bool PERM = true, AFTER_DRAIN = false;
    unsigned char* ws;
    __device__ __forceinline__ void operator()(const f32x4 (&acc)[2][2][4][2], const Unit& u, int wr, int wc, int fr, int fq) const {
        if (ws == nullptr) {
#pragma unroll
            for (int ai = 0; ai < 2; ++ai)
#pragma unroll
                for (int bj = 0; bj < 2; ++bj)
#pragma unroll
                    for (int m = 0; m < 4; ++m)
#pragma unroll
                        for (int n = 0; n < 2; ++n) *(f32x4*)(ws + (size_t)(((ai * 2 + bj) * 4 + m) * 2 + n) * 16 + fr * 1024 + fq * 65536 + wr * 4096 + wc * 16384 + u.pm) = acc[ai][bj][m][n];
        }
    }
};
struct MergeOrder : pg8::StaticOrder {
    __device__ bool next(int i, Unit& u) const { if (!pg8::StaticOrder::next(i >> 2, u)) return false; u.r = i & 3; return true; }
};
__device__ __forceinline__ Params KP() {
    auto q0 = __builtin_amdgcn_kernarg_segment_ptr();
    asm volatile("" : "+s"(q0));
    const __attribute__((address_space(4))) Params* q = (const __attribute__((address_space(4))) Params*)q0;
    Params r;
    r.x = q->x; r.c = q->c; r.ctx = q->ctx; r.c_ctx = q->c_ctx; r.w_ada = q->w_ada; r.b_ada = q->b_ada; r.g_pre = q->g_pre; r.g_post = q->g_post; r.w_in = q->w_in; r.rpb = q->rpb;
    r.fnet_w = q->fnet_w; r.gmlp_g = q->gmlp_g; r.gmlp_ws = q->gmlp_ws; r.gmlp_bs = q->gmlp_bs; r.lb_logits = q->lb_logits; r.hgrn_g = q->hgrn_g; r.w_branch = q->w_branch; r.w_out = q->w_out;
    r.out = q->out; r.ws = q->ws; return r;
}
constexpr size_t OFF_BAR = WS_END;
constexpr size_t WS_END2 = WS_END + (size_t)XCD_BAR_WORDS * 4;
__device__ __forceinline__ void gsync(LAS unsigned char* lds3) {
    XcdBarrier b; b.bar = (unsigned*)(opaque(KP().ws) + OFF_BAR); b.x = xb_xcc_id(); b.st = (volatile LAS unsigned*)(lds3 + LDS_BYTES);
    xcd_barrier(b);
}
__global__ void __launch_bounds__(512, 2) mega_fwd(Params p_unused) {
    extern __shared__ __attribute__((aligned(16))) unsigned char shm[];
    LAS unsigned char* lds3 = (LAS unsigned char*)shm;
    {
        if (tidx() < 4) ((volatile LAS unsigned*)(lds3 + LDS_BYTES))[tidx()] = 0u;
        if (blockIdx.x == 0) { unsigned* bar = (unsigned*)(opaque(KP().ws) + OFF_BAR); for (int i = tidx(); i < XCD_BAR_WORDS; i += 512) bar[i] = 0u; }
        __syncthreads();
    }
    prep1(KP(), shm);
    cg::this_grid().sync();
    { XcdBarrier b0 = xcd_barrier_post((unsigned*)(opaque(KP().ws) + OFF_BAR), (volatile LAS unsigned*)(lds3 + LDS_BYTES)); (void)b0; }
    prep2(KP(), shm);
    gsync(lds3);
#pragma nounroll
    for (int pass = 0; pass < 1 + NBATCH / GB; ++pass) {
        PassInfo ps;
        if (pass == 0) { ps.is_ctx = 1; ps.nb = NBATCH; ps.T = CTXL; ps.M = MCTX; ps.b0 = 0; }
        else { ps.is_ctx = 0; ps.nb = GB; ps.T = SEQ; ps.M = MLAT; ps.b0 = (pass - 1) * GB; }
        const int NC = ps.T >> 6;
#pragma nounroll
        for (int l = 0; l < DEPTH; ++l) {
            phase_norm(KP(), ps, l);
            gsync(lds3);
            _Pragma("nounroll") for (int rep = 0; rep < REP_B; ++rep) {
                unsigned char* ws = opaque(KP().ws);
                EpiProj E; E.ws = ws; E.l = l; E.is_ctx = ps.is_ctx;

                run_gemm(lds3, (const u16*)(ws + OFF_H), (const u16*)(ws + OFF_WTIN) + (size_t)l * NPROJ * DM, ps.M, NPROJ, DM, E);
                gsync(lds3);
#ifdef PROBE_NULL_B
                { EpiNull EN; EN.ws = ws; run_gemm(lds3, (const u16*)(ws + OFF_H), (const u16*)(ws + OFF_WTIN) + (size_t)l * NPROJ * DM, ps.M, NPROJ, DM, EN); gsync(lds3); }
#endif
            }
            const bool full = !(ps.is_ctx && l == DEPTH - 1);
            {
                const int nch = ps.nb * 16, n_at = full ? ps.nb * 8 * (ps.T >> 6) : 0, n_f1 = ps.is_ctx ? 0 : ps.nb * 64, n_g = 0;
                const int wg = (int)blockIdx.x, G = (int)gridDim.x;
                int first, stride;
                if (nch >= G || G != 4 * nch) {
                    for (int ci = wg; ci < nch; ci += G) hgrn_chain(KP(), ps, l, ci, shm);
                    first = wg; stride = G;
                } else {
                    const int g4 = wg >> 2, pos = wg & 3, cpos = (g4 >> 1) & 3;
                    if (pos == cpos) { hgrn_chain(KP(), ps, l, g4, shm); first = 0x7fffffff; stride = 1; }
                    else { first = g4 * 3 + pos - (pos > cpos ? 1 : 0); stride = (G >> 2) * 3; }
                }
                for (int it = first; it < n_at + n_f1 + n_g; it += stride) {
                    if (it < n_at) attn_item(KP(), ps, l, it, shm);
                    else if (it < n_at + n_f1) four1_item(KP(), it - n_at, shm);
                    else gmlp_item(KP(), l, it - n_at - n_f1, shm);
                }
                gsync(lds3);
            }
            if (!full) continue;
            {
                const int n_f2 = ps.is_ctx ? ps.nb * 4 : ps.nb * 64, n_h3 = ps.nb * 8 * NC, n_g3 = ps.M >> 7;
                for (int it = blockIdx.x; it < n_f2 + n_h3 + n_g3; it += gridDim.x) {
                    if (it < n_f2) { if (ps.is_ctx) fourc_item(KP(), it, shm); else four2_item(KP(), it, shm); }
                    else if (it < n_f2 + n_h3) hgrn3_item(KP(), ps, l, it - n_f2, shm);
                    else gmlp_item(KP(), l, it - n_f2 - n_h3, shm);
                }
                gsync(lds3);
            }
            _Pragma("nounroll") for (int rep = 0; rep < REP_DE; ++rep) {
            {
                unsigned char* ws = opaque(KP().ws);
                pg8::Gemm g; g.A = (const u16*)(ws + OFF_Y); g.Bt = (const u16*)(ws + OFF_WTBR) + (size_t)l * 4 * 1024 * 512; g.M = ps.M; g.N = 1024; g.K = 512;
                g.rsA = (size_t)MLAT * 512 * 2; g.rsB = (size_t)1024 * 512 * 2;
                MergeOrder S; S.init(ps.M, 1024, (int)gridDim.x, (int)blockIdx.x);
                EpiMerge E; E.ws = ws;

                pg8::gemm_phase<EpiMerge, MergeOrder, false>(lds3, g, S, E, nullptr);
            }
            gsync(lds3);
            if (REP_DE > 1 && rep + 1 < REP_DE) continue;
            {
                unsigned char* ws = opaque(KP().ws);
                EpiOut E; E.C = (u16*)(ws + OFF_OUT);
                run_gemm(lds3, (const u16*)(ws + OFF_MB), (const u16*)(ws + OFF_WTOUT) + (size_t)l * 1024 * 1024, ps.M, 1024, 1024, E);
            }
            gsync(lds3);
            }
        }
        if (!ps.is_ctx) phase_norm(KP(), ps, DEPTH);
    }
}

static_assert(WS_END2 <= (size_t)1073741824, "workspace map exceeds 1 GiB");

extern "C" void kernel_launch(void* const* d_in, const int* in_sizes, int n_in, void* d_out, int out_size, void* d_ws, size_t ws_size, hipStream_t stream) {
    static int grid_blocks = 0;
    if (grid_blocks == 0) {
        if (n_in != 18 || ws_size < WS_END2) { fprintf(stderr, "kernel_launch: unexpected n_in %d or ws_size %zu (need %zu)\n", n_in, ws_size, (size_t)WS_END2); grid_blocks = -1; return; }
        int dev = 0, cus = 0, per_cu = 0;
        hipGetDevice(&dev);
        hipDeviceGetAttribute(&cus, hipDeviceAttributeMultiprocessorCount, dev);
        if (hipFuncSetAttribute((const void*)mega_fwd, hipFuncAttributeMaxDynamicSharedMemorySize, LDS_BYTES + 16) != hipSuccess) { fprintf(stderr, "kernel_launch: hipFuncSetAttribute failed\n"); grid_blocks = -1; return; }
        hipOccupancyMaxActiveBlocksPerMultiprocessor(&per_cu, (const void*)mega_fwd, 512, LDS_BYTES + 16);
        if (per_cu < 1) { fprintf(stderr, "kernel_launch: occupancy query gave %d\n", per_cu); per_cu = 1; }
        (void)hipGetLastError();
        grid_blocks = cus * per_cu;
    }
    if (grid_blocks < 0) return;
    Params p{};
    const float** pp = (const float**)&p;
    for (int i = 0; i < 18; ++i) pp[i] = (const float*)d_in[i];
    p.out = (float*)d_out; p.ws = (unsigned char*)d_ws;
    void* args[] = {&p};
    hipError_t e = hipLaunchCooperativeKernel((const void*)mega_fwd, dim3(grid_blocks), dim3(512), args, LDS_BYTES + 16, stream);
    if (e != hipSuccess) fprintf(stderr, "cooperative launch failed: %s (grid %d)\n", hipGetErrorString(e), grid_blocks);
}
```

```cpp
#include <hip/hip_runtime.h>
#include <hip/hip_cooperative_groups.h>
#include <cstdio>
namespace cg = cooperative_groups;
__device__ __forceinline__ int tidx() { int t = threadIdx.x; asm volatile("" : "+v"(t)); return t; }
template <class T> __device__ __forceinline__ T* opaque(T* p) {
    unsigned long long v = (unsigned long long)p; const unsigned lo = __builtin_amdgcn_readfirstlane((unsigned)v), hi = __builtin_amdgcn_readfirstlane((unsigned)(v >> 32));
    v = ((unsigned long long)hi << 32) | lo; asm volatile("" : "+s"(v)); return (T*)((__attribute__((address_space(1))) T*)v); }
__device__ __forceinline__ float shx(float v, int m) { const int lane = tidx() & 63; return __int_as_float(__builtin_amdgcn_ds_bpermute((lane ^ m) << 2, __float_as_int(v))); }
namespace pg8 {
#define PG8_LAS __attribute__((address_space(3)))
typedef unsigned short bf16_t;
typedef short bf16x8 __attribute__((ext_vector_type(8)));
typedef float f32x4 __attribute__((ext_vector_type(4)));
typedef unsigned u32x4 __attribute__((ext_vector_type(4)));
constexpr int BM = 256, BK = 64, HALF = 128, HTB = HALF * BK * 2  , STAGE_BYTES = 8 * HTB, NXCD = 8, WGM = 8;

__host__ __device__ __forceinline__ int lds_byte(int r, int c) { const int st = (r >> 4) * 2 + (c >> 5), rr = r & 15, cc = c & 31, ob = rr * 64 + cc * 2; return st * 1024 + (ob ^ (((ob >> 9) & 1) << 5)); }
__host__ __device__ __forceinline__ void stage_rc(int b, int& R, int& C) { const int st = b / 1024, sb = b % 1024, swz = sb ^ (((sb >> 9) & 1) << 5); R = (st >> 1) * 16 + swz / 64; C = (st & 1) * 32 + (swz % 64) / 2; }
__host__ __device__ __forceinline__ int perm32(int rho) { const int n = rho >> 4, i = rho & 15; return 8 * (i >> 2) + 4 * n + (i & 3); }

struct Unit { int pm, pn, r; };
struct Gemm { const bf16_t* A; const bf16_t* Bt; int M, N, K; size_t rsA, rsB; };

struct StaticOrder {
    int nM, nN, nwg, G, c;
    __host__ __device__ void init(int M, int N, int G_, int c_) { nM = M / BM; nN = N / BM; nwg = nM * nN; G = G_; c = c_; }
    __host__ __device__ bool next(int i, Unit& u) const {
        const long L = (long)i * G + c; if (L >= nwg) return false;
        int wgid = (int)L; { const int q = nwg / NXCD, r = nwg % NXCD, xcd = wgid % NXCD, off = wgid / NXCD; wgid = (xcd < r ? xcd * (q + 1) : r * (q + 1) + (xcd - r) * q) + off; }
        const int nig = WGM * nN, gid = wgid / nig, fm = gid * WGM, gsz = (nM - fm) < WGM ? (nM - fm) : WGM;
        u.pm = fm + ((wgid % nig) % gsz); u.pn = (wgid % nig) / gsz; u.r = 0; return true;
    }
    __device__ __forceinline__ void a_ready(const Unit&) const {}
    __device__ __forceinline__ void done(const Unit&) const {}
};
__device__ __forceinline__ unsigned cvt_pk_bf16(float lo, float hi) { unsigned r; asm volatile("v_cvt_pk_bf16_f32 %0, %1, %2" : "=v"(r) : "v"(lo), "v"(hi)); return r; }

template <class Epi, class Sched, bool STAMP = false>
__device__ __forceinline__ void gemm_phase(PG8_LAS unsigned char* lds, const Gemm g, const Sched& S, const Epi& E, unsigned long long* stamps) {
    const int tid = tidx(), wid = __builtin_amdgcn_readfirstlane(tid >> 6), lane = tid & 63, wr = wid >> 2, wc = wid & 3, fr = lane & 15, fq = lane >> 4;
    const int K = g.K, nt = K / BK;
    int ts_lo = 0, ts_hi = 0, nts = 0; const unsigned long long rt_entry = STAMP ? (unsigned long long)wall_clock64() : 0ull;
#define PG8_STAMP() do { if (STAMP && wid == 0 && nts < 64) { const unsigned long long _c = (unsigned long long)clock64(); \
        ts_lo = (lane == nts) ? (int)(unsigned)_c : ts_lo; ts_hi = (lane == nts) ? (int)(unsigned)(_c >> 32) : ts_hi; ++nts; } } while (0)
    PG8_STAMP();
    unsigned voffA[2], voffB[2];
#pragma unroll
    for (int i = 0; i < 2; ++i) { int R, C; stage_rc(tid * 16 + i * 8192, R, C); const int Rb = Epi::PERM ? ((R & ~31) + perm32(R & 31)) : R;
        voffA[i] = (unsigned)(R * K + C) * 2u; voffB[i] = (unsigned)(Rb * K + C) * 2u; }
    const size_t kstep = (size_t)(BK * 2);
    const size_t hstep = (size_t)HALF * K * 2;
    const size_t tstep = 2 * hstep;
    const unsigned ldsw = (unsigned)wid * 1024u;
    const int aoff = lds_byte(wr * 64 + fr, fq * 8), boff = lds_byte(wc * 32 + fr, fq * 8);
#define PG8_SA(b, h) (((b) * 2 + (h)) * HTB)
#define PG8_SB(b, h) ((4 + (b) * 2 + (h)) * HTB)
#define PG8_STAGE(bufoff, gbase, voff) do { _Pragma("unroll") for (int _i = 0; _i < 2; ++_i) \
        __builtin_amdgcn_global_load_lds((const unsigned*)((const char*)(gbase) + (voff)[_i]), (PG8_LAS unsigned*)(lds + (bufoff) + ldsw + _i * 8192), 16, 0, 0); } while (0)
#define PG8_LDA(dst, b, h) do { _Pragma("unroll") for (int m = 0; m < 4; ++m) _Pragma("unroll") for (int k = 0; k < 2; ++k) dst[m][k] = *(const PG8_LAS bf16x8*)(lds + PG8_SA(b, h) + aoff + m * 2048 + k * 1024); } while (0)
#define PG8_LDB(dst, b, h) do { _Pragma("unroll") for (int n = 0; n < 2; ++n) _Pragma("unroll") for (int k = 0; k < 2; ++k) dst[n][k] = *(const PG8_LAS bf16x8*)(lds + PG8_SB(b, h) + boff + n * 2048 + k * 1024); } while (0)
#define PG8_MMA(ai, bj, At, Bt) do { __builtin_amdgcn_s_setprio(1); _Pragma("unroll") for (int m = 0; m < 4; ++m) _Pragma("unroll") for (int n = 0; n < 2; ++n) _Pragma("unroll") for (int k = 0; k < 2; ++k) \
        acc[ai][bj][m][n] = __builtin_amdgcn_mfma_f32_16x16x32_bf16(Bt[n][k], At[m][k], acc[ai][bj][m][n], 0, 0, 0); __builtin_amdgcn_s_setprio(0); } while (0)
#define PG8_WAIT_V(n) asm volatile("s_waitcnt vmcnt(" #n ")" ::: "memory")
#define PG8_WAIT_L(n) asm volatile("s_waitcnt lgkmcnt(" #n ")" ::: "memory")
#define PG8_BAR __builtin_amdgcn_s_barrier()
#define PG8_SCHED __builtin_amdgcn_sched_barrier(0)
    Unit cur, nxt; int ui = 0;
    if (!S.next(0, cur)) return;
    f32x4 acc[2][2][4][2];
#pragma unroll
    for (int a = 0; a < 2; ++a)
#pragma unroll
        for (int b = 0; b < 2; ++b)
#pragma unroll
            for (int m = 0; m < 4; ++m)
#pragma unroll
                for (int n = 0; n < 2; ++n) acc[a][b][m][n] = (f32x4){0.f, 0.f, 0.f, 0.f};
    bf16x8 At[4][2], B0[2][2], B1[2][2];
    const char* cA = (const char*)g.A + (size_t)cur.pm * tstep + (size_t)cur.r * g.rsA; const char* cB = (const char*)g.Bt + (size_t)cur.pn * tstep + (size_t)cur.r * g.rsB;
    S.a_ready(cur);
    PG8_STAGE(PG8_SB(0, 0), cB, voffB); PG8_STAGE(PG8_SA(0, 0), cA, voffA); PG8_STAGE(PG8_SB(0, 1), cB + hstep, voffB); PG8_STAGE(PG8_SA(0, 1), cA + hstep, voffA);
    if (wr == 1) PG8_BAR;
    PG8_WAIT_V(4); PG8_BAR;
    PG8_STAGE(PG8_SB(1, 0), cB + kstep, voffB); PG8_STAGE(PG8_SA(1, 0), cA + kstep, voffA); PG8_STAGE(PG8_SB(1, 1), cB + hstep + kstep, voffB);
    PG8_WAIT_V(6); PG8_BAR;
    PG8_STAMP();
    for (;;) {
        const bool has_next = S.next(ui + 1, nxt);
        const char* nA = has_next ? (const char*)g.A + (size_t)nxt.pm * tstep + (size_t)nxt.r * g.rsA : cA; const char* nB = has_next ? (const char*)g.Bt + (size_t)nxt.pn * tstep + (size_t)nxt.r * g.rsB : cB;
        for (int t = 0; t < nt; t += 2) {
            const bool last = (t == nt - 2);
            const char* a1 = cA + (size_t)(t + 1) * kstep;
            const char* a2 = last ? nA : cA + (size_t)(t + 2) * kstep; const char* b2 = last ? nB : cB + (size_t)(t + 2) * kstep;
            const char* a3 = a2 + kstep; const char* b3 = b2 + kstep;
            if (last && has_next) S.a_ready(nxt);
            PG8_LDB(B0, 0, 0); PG8_SCHED; PG8_LDA(At, 0, 0); PG8_STAGE(PG8_SA(1, 1), a1 + hstep, voffA);
            PG8_WAIT_L(8); PG8_BAR; PG8_WAIT_L(0); PG8_MMA(0, 0, At, B0); PG8_BAR; PG8_SCHED;
            PG8_LDB(B1, 0, 1); PG8_STAGE(PG8_SB(0, 0), b2, voffB);
            PG8_BAR; PG8_WAIT_L(0); PG8_MMA(0, 1, At, B1); PG8_BAR;
            PG8_LDA(At, 0, 1); PG8_STAGE(PG8_SA(0, 0), a2, voffA);
            PG8_BAR; PG8_WAIT_L(0); PG8_MMA(1, 0, At, B0); PG8_BAR; PG8_SCHED;
            PG8_STAGE(PG8_SB(0, 1), b2 + hstep, voffB);
            PG8_WAIT_V(6); PG8_BAR; PG8_MMA(1, 1, At, B1); PG8_BAR;
            PG8_LDB(B0, 1, 0); PG8_SCHED; PG8_LDA(At, 1, 0); PG8_STAGE(PG8_SA(0, 1), a2 + hstep, voffA);
            PG8_WAIT_L(8); PG8_BAR; PG8_WAIT_L(0); PG8_MMA(0, 0, At, B0); PG8_BAR; PG8_SCHED;
            PG8_LDB(B1, 1, 1); PG8_STAGE(PG8_SB(1, 0), b3, voffB);
            PG8_BAR; PG8_WAIT_L(0); PG8_MMA(0, 1, At, B1); PG8_BAR;
            PG8_LDA(At, 1, 1); PG8_STAGE(PG8_SA(1, 0), a3, voffA);
            PG8_BAR; PG8_WAIT_L(0); PG8_MMA(1, 0, At, B0); PG8_BAR; PG8_SCHED;
            PG8_STAGE(PG8_SB(1, 1), b3 + hstep, voffB);
            PG8_WAIT_V(6); PG8_BAR; PG8_MMA(1, 1, At, B1); PG8_BAR;
        }
        PG8_STAMP();
        if constexpr (!Epi::AFTER_DRAIN) { E(acc, cur, wr, wc, fr, fq); S.done(cur); }
        PG8_STAMP();
        if (!has_next) break;
#pragma unroll
        for (int a = 0; a < 2; ++a)
#pragma unroll
            for (int b = 0; b < 2; ++b)
#pragma unroll
                for (int m = 0; m < 4; ++m)
#pragma unroll
                    for (int n = 0; n < 2; ++n) acc[a][b][m][n] = (f32x4){0.f, 0.f, 0.f, 0.f};
        cur = nxt; cA = nA; cB = nB; ++ui;
    }
    PG8_WAIT_V(0);
    if (wr == 0) PG8_BAR;
    PG8_BAR;
    if constexpr (Epi::AFTER_DRAIN) { E.fused(acc, cur, wr, wc, fr, fq, lds, wid, lane); S.done(cur); }
    PG8_STAMP();
    if (STAMP && wid == 0) { stamps[lane] = lane < nts ? (((unsigned long long)(unsigned)ts_hi << 32) | (unsigned)ts_lo) : 0ull;
        if (lane == 62) stamps[62] = rt_entry; if (lane == 63) stamps[63] = (unsigned long long)wall_clock64(); }
#undef PG8_STAMP
#undef PG8_SA
#undef PG8_SB
#undef PG8_STAGE
#undef PG8_LDA
#undef PG8_LDB
#undef PG8_MMA
#undef PG8_WAIT_V
#undef PG8_WAIT_L
#undef PG8_BAR
#undef PG8_SCHED
}
}

typedef unsigned short u16;
typedef short s16x4 __attribute__((ext_vector_type(4)));
using pg8::bf16x8; using pg8::f32x4; using pg8::Unit;
#define LAS __attribute__((address_space(3)))
#define MFMA16(a, b, c) __builtin_amdgcn_mfma_f32_16x16x32_bf16(a, b, c, 0, 0, 0)

constexpr int DM = 1024, NBATCH = 16, SEQ = 4096, DEPTH = 4, CTXL = 256, NPROJ = 11776, NIN = 11264;
constexpr int GB = 4, MLAT = GB * SEQ, MCTX = NBATCH * CTXL;
constexpr int LDS_BYTES = 152 * 1024;
constexpr float LOG2E = 1.4426950408889634f;
constexpr float EPSN = 1e-6f;

constexpr size_t al256(size_t x) { return (x + 255) & ~(size_t)255; }
constexpr size_t OFF_WTIN = 0;
constexpr size_t OFF_WTBR = OFF_WTIN + (size_t)DEPTH * NPROJ * DM * 2;
constexpr size_t OFF_WTOUT = OFF_WTBR + (size_t)DEPTH * 4 * 1024 * 512 * 2;
constexpr size_t OFF_WS16 = OFF_WTOUT + (size_t)DEPTH * 1024 * 1024 * 2;
constexpr size_t OFF_MOD = OFF_WS16 + (size_t)DEPTH * 8 * 128 * 128 * 2;
constexpr size_t OFF_LB = OFF_MOD + al256((size_t)DEPTH * 17 * 3072 * 4);
constexpr size_t OFF_ROPE = OFF_LB + (size_t)DEPTH * 2 * 512 * 4;
constexpr size_t OFF_TW = OFF_ROPE + 2 * 64 * 16 * 4;
constexpr size_t OFF_M1 = OFF_TW + 4096 * 8;
constexpr size_t OFF_M2 = OFF_M1 + 128 * 128 * 2;
constexpr size_t OFF_M3 = OFF_M2 + 64 * 128 * 2;
constexpr size_t OFF_CSW = OFF_M3 + 256 * 512 * 2;
constexpr size_t OFF_CTXW = OFF_CSW + (size_t)DEPTH * 4 * 2 * 128 * 128 * 4;
constexpr size_t OFF_CTXKV = OFF_CTXW + (size_t)NBATCH * CTXL * DM * 4;
constexpr size_t OFF_CTXST = OFF_CTXKV + (size_t)DEPTH * MCTX * 1024 * 2;
constexpr size_t OFF_H = OFF_CTXST + (size_t)DEPTH * 256 * 4096 * 4;
constexpr size_t OFF_PROJ = OFF_H + (size_t)MLAT * DM * 2;
constexpr size_t OFF_QROT = OFF_PROJ + (size_t)MLAT * NPROJ * 2;
constexpr size_t OFF_LOGF = OFF_QROT + (size_t)MLAT * 512 * 2;
constexpr size_t OFF_Y = OFF_LOGF + (size_t)MLAT * 1024 * 4;
constexpr size_t OFF_FY = OFF_Y + (size_t)4 * MLAT * 512 * 2;
constexpr size_t OFF_HL = OFF_FY + (size_t)GB * 4096 * 1024 * 2;
constexpr size_t OFF_HD = OFF_HL + (size_t)4096 * 4096 * 4;
constexpr size_t OFF_HS = OFF_HD + (size_t)4096 * 64 * 4;
constexpr size_t OFF_MB = OFF_HS + (size_t)4096 * 4096 * 4;
constexpr size_t WS_END = OFF_MB + (size_t)MLAT * DM * 2;
constexpr size_t OFF_MERGED = OFF_LOGF;
constexpr size_t OFF_OUT = OFF_PROJ;

struct Params {
    const float *x, *c, *ctx, *c_ctx, *w_ada, *b_ada, *g_pre, *g_post, *w_in, *rpb, *fnet_w, *gmlp_g, *gmlp_ws, *gmlp_bs, *lb_logits, *hgrn_g, *w_branch, *w_out;
    float* out; unsigned char* ws;
};
struct PassInfo { int is_ctx, nb, T, M, b0; };

__device__ __forceinline__ u16 f2bf(float f) { unsigned u = __float_as_uint(f); u += 0x7FFFu + ((u >> 16) & 1u); return (u16)(u >> 16); }
__device__ __forceinline__ float bf2f(u16 b) { return __uint_as_float(((unsigned)b) << 16); }
typedef __bf16 bf16x2_t_ __attribute__((ext_vector_type(2)));
typedef float f32x2_t_ __attribute__((ext_vector_type(2)));
__device__ __forceinline__ unsigned pack2(float a, float b) { f32x2_t_ v = {a, b}; bf16x2_t_ r = __builtin_convertvector(v, bf16x2_t_); return __builtin_bit_cast(unsigned, r); }
__device__ __forceinline__ float bflo(unsigned w) { return __uint_as_float(w << 16); }
__device__ __forceinline__ float bfhi(unsigned w) { return __uint_as_float(w & 0xFFFF0000u); }
__device__ __forceinline__ float sigmoidf_(float v) { return __builtin_amdgcn_rcpf(1.f + __builtin_amdgcn_exp2f(-LOG2E * v)); }
__device__ __forceinline__ float siluf_(float v) { return v * __builtin_amdgcn_rcpf(1.f + __builtin_amdgcn_exp2f(-LOG2E * v)); }
__device__ __forceinline__ void unpack8(uint4 w, float* f) { f[0] = bflo(w.x); f[1] = bfhi(w.x); f[2] = bflo(w.y); f[3] = bfhi(w.y); f[4] = bflo(w.z); f[5] = bfhi(w.z); f[6] = bflo(w.w); f[7] = bfhi(w.w); }
__device__ __forceinline__ bf16x8 tr_read2(const u16* p0, const u16* p1) {
    s16x4 a = __builtin_amdgcn_ds_read_tr16_b64_v4i16((LAS s16x4*)p0);
    s16x4 b = __builtin_amdgcn_ds_read_tr16_b64_v4i16((LAS s16x4*)p1);
    return (bf16x8){a[0], a[1], a[2], a[3], b[0], b[1], b[2], b[3]};
}
__device__ __forceinline__ bf16x8 ld_frag_g(const u16* p) { return *(const bf16x8*)p; }

typedef unsigned u32x4_ __attribute__((ext_vector_type(4)));
__device__ __forceinline__ void nt_store16(uint4 w, void* p) { __builtin_nontemporal_store((u32x4_){w.x, w.y, w.z, w.w}, (u32x4_*)p); }
struct EpiProj {
    static constexpr bool PERM = true, AFTER_DRAIN = false;
    unsigned char* ws; int l; int is_ctx;
    __device__ __forceinline__ void operator()(const f32x4 (&acc)[2][2][4][2], const Unit& u, int wr, int wc, int fr, int fq) const {
        u16* proj = (u16*)(ws + OFF_PROJ);
        const int blk = u.pn >> 1;
        const int row0 = u.pm * 256 + wr * 64 + fr, col0 = u.pn * 256 + wc * 32 + 8 * fq;
        u16* pbase = proj + ((size_t)blk * MLAT + row0) * 512 + (col0 & 511);
        if ((blk == 0 || blk == 1) && !is_ctx) {
            u16* qrot = (u16*)(ws + OFF_QROT); const float* rope = (const float*)(ws + OFF_ROPE);
            const int f0 = 8 * (fq & 1); const float sgn = (fq >> 1) ? 1.f : -1.f;
#pragma unroll
            for (int ai = 0; ai < 2; ++ai)
#pragma unroll
                for (int m = 0; m < 4; ++m) {
                    const int row = row0 + ai * 128 + m * 16;
                    const int t = row & 4095, pos = (wc & 1) ? (t & 63) : (t >> 6);
                    const float4 c0 = *(const float4*)(rope + pos * 16 + f0), c1 = *(const float4*)(rope + pos * 16 + f0 + 4);
                    const float4 s0 = *(const float4*)(rope + 1024 + pos * 16 + f0), s1 = *(const float4*)(rope + 1024 + pos * 16 + f0 + 4);
                    const float cs[8] = {c0.x, c0.y, c0.z, c0.w, c1.x, c1.y, c1.z, c1.w}, sn[8] = {s0.x, s0.y, s0.z, s0.w, s1.x, s1.y, s1.z, s1.w};
#pragma unroll
                    for (int bj = 0; bj < 2; ++bj) {
                        const f32x4 v0 = acc[ai][bj][m][0], v1 = acc[ai][bj][m][1];
                        const float o[8] = {v0[0], v0[1], v0[2], v0[3], v1[0], v1[1], v1[2], v1[3]};
                        float r[8];
#pragma unroll
                        for (int e = 0; e < 8; ++e) { const float pr = shx(o[e], 32); r[e] = o[e] * cs[e] + sgn * pr * sn[e]; }
                        uint4 wr_; wr_.x = pack2(r[0], r[1]); wr_.y = pack2(r[2], r[3]); wr_.z = pack2(r[4], r[5]); wr_.w = pack2(r[6], r[7]);
                        u16* dst = pbase + (size_t)(ai * 128 + m * 16) * 512 + bj * 128;
                        if (blk == 0) {
                            uint4 wp; wp.x = pack2(o[0], o[1]); wp.y = pack2(o[2], o[3]); wp.z = pack2(o[4], o[5]); wp.w = pack2(o[6], o[7]);
                            nt_store16(wp, dst);
                            nt_store16(wr_, qrot + (size_t)row * 512 + (col0 & 511) + bj * 128);
                        } else nt_store16(wr_, dst);
                    }
                }
        } else if (blk == 11 || blk == 12) {
            float* logf = (float*)(ws + OFF_LOGF); const float* lb = (const float*)(ws + OFF_LB) + l * 1024;
            const int dir = blk - 11;
#pragma unroll
            for (int bj = 0; bj < 2; ++bj) {
                const int cc = (col0 & 511) + bj * 128;
                const float4 l0 = *(const float4*)(lb + dir * 512 + cc), l1 = *(const float4*)(lb + dir * 512 + cc + 4);
                const float lbv[8] = {l0.x, l0.y, l0.z, l0.w, l1.x, l1.y, l1.z, l1.w};
#pragma unroll
                for (int ai = 0; ai < 2; ++ai)
#pragma unroll
                    for (int m = 0; m < 4; ++m) {
                        const int row = row0 + ai * 128 + m * 16;
                        const f32x4 v0 = acc[ai][bj][m][0], v1 = acc[ai][bj][m][1];
                        const float z[8] = {v0[0], v0[1], v0[2], v0[3], v1[0], v1[1], v1[2], v1[3]};
                        float lf[8], o[8];
#pragma unroll
                        for (int e = 0; e < 8; ++e) {
                            const float ez = __expf(-z[e]);
                            const float inv = __builtin_amdgcn_rcpf(1.f + ez);
                            const float sg = inv, sgn_ = (ez > 1e30f) ? 1.f : ez * inv;
                            const float f = lbv[e] + (1.f - lbv[e]) * sg;
                            lf[e] = __logf(fmaxf(f, 1e-30f));
                            o[e] = (1.f - lbv[e]) * sgn_;
                        }
                        float* lp = logf + (size_t)row * 1024 + dir * 512 + cc;
                        __builtin_nontemporal_store((f32x4){lf[0], lf[1], lf[2], lf[3]}, (f32x4*)lp); __builtin_nontemporal_store((f32x4){lf[4], lf[5], lf[6], lf[7]}, (f32x4*)(lp + 4));
                        uint4 w; w.x = pack2(o[0], o[1]); w.y = pack2(o[2], o[3]); w.z = pack2(o[4], o[5]); w.w = pack2(o[6], o[7]);
                        nt_store16(w, pbase + (size_t)(ai * 128 + m * 16) * 512 + bj * 128);
                    }
            }
        } else {
            const bool copy = is_ctx && (blk == 1 || blk == 2);
            u16* cbase = (u16*)(ws + OFF_CTXKV) + (size_t)l * MCTX * 1024 + (size_t)row0 * 1024 + (blk - 1) * 512 + (col0 & 511);
            if (!copy) {
#pragma unroll
                for (int ai = 0; ai < 2; ++ai)
#pragma unroll
                    for (int m = 0; m < 4; ++m)
#pragma unroll
                        for (int bj = 0; bj < 2; ++bj) {
                            const f32x4 v0 = acc[ai][bj][m][0], v1 = acc[ai][bj][m][1];
                            uint4 w; w.x = pack2(v0[0], v0[1]); w.y = pack2(v0[2], v0[3]); w.z = pack2(v1[0], v1[1]); w.w = pack2(v1[2], v1[3]);
                            nt_store16(w, pbase + (size_t)(ai * 128 + m * 16) * 512 + bj * 128);
                        }
            } else {
#pragma unroll
                for (int ai = 0; ai < 2; ++ai)
#pragma unroll
                    for (int m = 0; m < 4; ++m)
#pragma unroll
                        for (int bj = 0; bj < 2; ++bj) {
                            const f32x4 v0 = acc[ai][bj][m][0], v1 = acc[ai][bj][m][1];
                            uint4 w; w.x = pack2(v0[0], v0[1]); w.y = pack2(v0[2], v0[3]); w.z = pack2(v1[0], v1[1]); w.w = pack2(v1[2], v1[3]);
                            nt_store16(w, pbase + (size_t)(ai * 128 + m * 16) * 512 + bj * 128);
                            *(uint4*)(cbase + (size_t)(ai * 128 + m * 16) * 1024 + bj * 128) = w;
                        }
            }
        }
    }
};
struct EpiMerge {
    static constexpr bool PERM = true, AFTER_DRAIN = false;
    unsigned char* ws;
    template <int MODE> __device__ __forceinline__ void run(const f32x4 (&acc)[2][2][4][2], const Unit& u, int wr, int wc, int fr, int fq) const {
        const u16* proj = (const u16*)(ws + OFF_PROJ); u16* mb = (u16*)(ws + OFF_MB);
        const int row0 = u.pm * 256 + wr * 64 + fr, col0 = u.pn * 256 + wc * 32 + 8 * fq, R = u.r;
        const int gcol0 = 7680 + R * 1024 + col0;
        const u16* gbase = proj + ((size_t)(gcol0 >> 9) * MLAT + row0) * 512 + (gcol0 & 511);
        u16* obase = mb + (size_t)row0 * 1024 + col0;
        uint4 g[2][4], old[2][4];
#define MG_LOAD(st, buf) do { _Pragma("unroll") for (int q = 0; q < 4; ++q) { const int ai_ = (st) >> 1, m_ = ((st) & 1) * 2 + (q >> 1), co_ = (q & 1) * 128; const size_t ro_ = (size_t)(ai_ * 128 + m_ * 16); \
            g[buf][q] = *(const uint4*)(gbase + ro_ * 512 + co_); if (MODE > 0) old[buf][q] = *(const uint4*)(obase + ro_ * 1024 + co_); } } while (0)
        MG_LOAD(0, 0);
#pragma unroll
        for (int st = 0; st < 4; ++st) {
            const int buf = st & 1;
            if (st + 1 < 4) MG_LOAD(st + 1, buf ^ 1);
            __builtin_amdgcn_sched_barrier(0);
#pragma unroll
            for (int q = 0; q < 4; ++q) { const int ai = st >> 1, m = (st & 1) * 2 + (q >> 1), bj = q & 1, co = bj * 128; const size_t ro = (size_t)(ai * 128 + m * 16);
                const f32x4 v0 = acc[ai][bj][m][0], v1 = acc[ai][bj][m][1];
                float gf[8]; unpack8(g[buf][q], gf);
                float o[8] = {v0[0] * sigmoidf_(gf[0]), v0[1] * sigmoidf_(gf[1]), v0[2] * sigmoidf_(gf[2]), v0[3] * sigmoidf_(gf[3]), v1[0] * sigmoidf_(gf[4]), v1[1] * sigmoidf_(gf[5]), v1[2] * sigmoidf_(gf[6]), v1[3] * sigmoidf_(gf[7])};
                if (MODE > 0) { float of[8]; unpack8(old[buf][q], of);
#pragma unroll
                    for (int e = 0; e < 8; ++e) o[e] += of[e]; }
                uint4 w; w.x = pack2(o[0], o[1]); w.y = pack2(o[2], o[3]); w.z = pack2(o[4], o[5]); w.w = pack2(o[6], o[7]);
                *(uint4*)(obase + ro * 1024 + co) = w; }
        }
#undef MG_LOAD
    }
    __device__ __forceinline__ void operator()(const f32x4 (&acc)[2][2][4][2], const Unit& u, int wr, int wc, int fr, int fq) const {
        if (u.r == 0) run<0>(acc, u, wr, wc, fr, fq);
        else run<1>(acc, u, wr, wc, fr, fq);
    }
};
struct EpiOut {
    static constexpr bool PERM = true, AFTER_DRAIN = false;
    u16* C;
    __device__ __forceinline__ void operator()(const f32x4 (&acc)[2][2][4][2], const Unit& u, int wr, int wc, int fr, int fq) const {
        const int row0 = u.pm * 256 + wr * 64 + fr, col0 = u.pn * 256 + wc * 32 + 8 * fq;
#pragma unroll
        for (int ai = 0; ai < 2; ++ai)
#pragma unroll
            for (int m = 0; m < 4; ++m) { u16* rowp = C + (size_t)(row0 + ai * 128 + m * 16) * 1024 + col0;
#pragma unroll
                for (int bj = 0; bj < 2; ++bj) { const f32x4 v0 = acc[ai][bj][m][0], v1 = acc[ai][bj][m][1];
                    uint4 w; w.x = pack2(v0[0], v0[1]); w.y = pack2(v0[2], v0[3]); w.z = pack2(v1[0], v1[1]); w.w = pack2(v1[2], v1[3]); *(uint4*)(rowp + bj * 128) = w; } }
    }
};

__device__ void transpose_tile(const float* src, int lds_, u16* dst, int ldd, int k0, int n0s, int n0d, u16* t) {
    const int tid = tidx();
#pragma unroll
    for (int it = 0; it < 2; ++it) {
        const int kk = (tid >> 4) + it * 32, nn = (tid & 15) * 4;
        const float4 v = *(const float4*)(src + (size_t)(k0 + kk) * lds_ + n0s + nn);
        t[(nn + 0) * 72 + kk] = f2bf(v.x); t[(nn + 1) * 72 + kk] = f2bf(v.y); t[(nn + 2) * 72 + kk] = f2bf(v.z); t[(nn + 3) * 72 + kk] = f2bf(v.w);
    }
    __syncthreads();
    { const int n = tid >> 3, k8 = (tid & 7) * 8;
      const uint4 v = *(const uint4*)(t + n * 72 + k8);
      *(uint4*)(dst + (size_t)(n0d + n) * ldd + k0 + k8) = v; }
    __syncthreads();
}

__device__ void prep1(const Params& p, unsigned char* lds) {
    unsigned char* ws = opaque(p.ws);
    const int tid = tidx();
    const size_t gt = (size_t)blockIdx.x * 512 + tid, gn = (size_t)gridDim.x * 512;
    { u16* ws16 = (u16*)(ws + OFF_WS16);
      for (size_t i = gt; i < (size_t)DEPTH * 8 * 128 * 128; i += gn) ws16[i] = f2bf(p.gmlp_ws[i]);
      float* lbp = (float*)(ws + OFF_LB);
      for (size_t i = gt; i < 1024; i += gn) {
          float e[DEPTH], mx = -1e30f, sum = 0.f;
#pragma unroll
          for (int l = 0; l < DEPTH; ++l) { e[l] = p.lb_logits[l * 1024 + i]; mx = fmaxf(mx, e[l]); }
#pragma unroll
          for (int l = 0; l < DEPTH; ++l) { e[l] = expf(e[l] - mx); sum += e[l]; }
          float run = 0.f;
#pragma unroll
          for (int l = 0; l < DEPTH; ++l) { if (l > 0) run += e[l] / sum; lbp[l * 1024 + i] = fmaxf(run, 0.f); }
      }
      float* rope = (float*)(ws + OFF_ROPE);
      for (size_t i = gt; i < 1024; i += gn) { const int pos = (int)(i >> 4), f = (int)(i & 15);
          const float inv = powf(10000.f, -(float)f * 2.0f / 32.0f), ang = (float)pos * inv;
          rope[i] = cosf(ang); rope[1024 + i] = sinf(ang); }
      float* tw = (float*)(ws + OFF_TW);
      for (size_t i = gt; i < 4096; i += gn) { float s, c; sincospif((float)i * (2.0f / 4096.0f), &s, &c); tw[2 * i] = c; tw[2 * i + 1] = s; }
      u16* m1 = (u16*)(ws + OFF_M1);
      for (size_t i = gt; i < 128 * 128; i += gn) { const int ii = (int)(i >> 7), kk = (int)(i & 127), k1 = ii >> 1, po = ii & 1, n1 = kk >> 1, pi = kk & 1;
          float s, c; sincospif((float)((k1 * n1) & 63) * (2.0f / 64.0f), &s, &c);
          const float v = (po == 0) ? (pi == 0 ? c : -s) : (pi == 0 ? -s : -c);
          m1[i] = f2bf(v); }
      u16* m2 = (u16*)(ws + OFF_M2);
      for (size_t i = gt; i < 64 * 128; i += gn) { const int k2 = (int)(i >> 7), kk = (int)(i & 127), n2 = kk >> 1, pi = kk & 1;
          float s, c; sincospif((float)((k2 * n2) & 63) * (2.0f / 64.0f), &s, &c);
          m2[i] = f2bf(pi == 0 ? c : s); }
      u16* m3 = (u16*)(ws + OFF_M3);
      for (size_t i = gt; i < 256 * 512; i += gn) { const int k = (int)(i >> 9), kk = (int)(i & 511), n = kk >> 1, pi = kk & 1;
          float s, c; sincospif((float)((k * n) & 255) * (2.0f / 256.0f), &s, &c);
          m3[i] = f2bf(pi == 0 ? c : -s); }
    }
    constexpr int N_WIN = DEPTH * 176 * 16, N_WBR = 16 * 16 * 8, N_WOUT = DEPTH * 16 * 16, N_MOD = DEPTH * 48, N_CSW = DEPTH * 4 * 2 * 2;
    constexpr int TOT = N_WIN + N_WBR + N_WOUT + N_MOD + N_CSW;
    for (int it = blockIdx.x; it < TOT; it += gridDim.x) {
        int idx = it;
        if (idx < N_WIN) {
            const int l = idx / 2816, rem = idx % 2816, cb = rem >> 4, kb = rem & 15, n0 = cb * 64;
            if (n0 >= 2048 && n0 < 2560) continue;
            const int n0d = n0 < 2048 ? n0 : n0 + 512;
            transpose_tile(p.w_in + (size_t)l * DM * NIN, NIN, (u16*)(ws + OFF_WTIN) + (size_t)l * NPROJ * DM, DM, kb * 64, n0, n0d, (u16*)lds);
            continue;
        }
        idx -= N_WIN;
        if (idx < N_WBR) {
            const int mat = idx >> 7, rem = idx & 127, cb = rem >> 3, kb = rem & 7;
            transpose_tile(p.w_branch + (size_t)mat * 512 * 1024, 1024, (u16*)(ws + OFF_WTBR) + (size_t)mat * 1024 * 512, 512, kb * 64, cb * 64, cb * 64, (u16*)lds);
            continue;
        }
        idx -= N_WBR;
        if (idx < N_WOUT) {
            const int l = idx >> 8, rem = idx & 255, cb = rem >> 4, kb = rem & 15;
            transpose_tile(p.w_out + (size_t)l * 1024 * 1024, 1024, (u16*)(ws + OFF_WTOUT) + (size_t)l * 1024 * 1024, 1024, kb * 64, cb * 64, cb * 64, (u16*)lds);
            continue;
        }
        idx -= N_WOUT;
        if (idx < N_MOD) {
            const int l = idx / 48, cb = idx % 48;
            float* s = (float*)lds; float* red = s + 17 * 1024;
            for (int i = tid; i < 17 * 1024; i += 512) { const int j = i >> 10, k = i & 1023; const float v = j < 16 ? p.c[j * 1024 + k] : p.c_ctx[k]; s[i] = v / (1.f + expf(-v)); }
            __syncthreads();
            const int col = tid & 63, ks = tid >> 6;
            float acc[17];
#pragma unroll
            for (int j = 0; j < 17; ++j) acc[j] = 0.f;
            for (int k = ks * 128; k < ks * 128 + 128; ++k) {
                const float w = p.w_ada[((size_t)l * 1024 + k) * 3072 + cb * 64 + col];
#pragma unroll
                for (int j = 0; j < 17; ++j) acc[j] += s[j * 1024 + k] * w;
            }
#pragma unroll
            for (int j = 0; j < 17; ++j) red[(ks * 17 + j) * 64 + col] = acc[j];
            __syncthreads();
            for (int o = tid; o < 17 * 64; o += 512) { const int j = o >> 6, cc = o & 63; float sum = 0.f;
                for (int q = 0; q < 8; ++q) sum += red[(q * 17 + j) * 64 + cc];
                ((float*)(ws + OFF_MOD))[((size_t)l * 17 + j) * 3072 + cb * 64 + cc] = sum + p.b_ada[l * 3072 + cb * 64 + cc]; }
            __syncthreads();
            continue;
        }
        idx -= N_MOD;
        {
            const int cblk = idx & 1, part = (idx >> 1) & 1, g = (idx >> 2) & 3, l = idx >> 4;
            float* tb = (float*)lds;
            if (tid < 128) { float s, c; sincospif((float)tid * (2.0f / 128.0f), &s, &c); tb[tid] = part ? s : c; }
            __syncthreads();
            const int d = tid & 127, cq = tid >> 7;
            float acc[16];
#pragma unroll
            for (int i = 0; i < 16; ++i) acc[i] = 0.f;
            const float* wf = p.fnet_w + ((size_t)(l * 4 + g) * 128) * 128;
            for (int c2 = 0; c2 < 128; ++c2) {
                const float w = wf[c2 * 128 + d];
#pragma unroll
                for (int i = 0; i < 16; ++i) { const int c = cblk * 64 + cq * 16 + i; acc[i] += tb[(c * c2) & 127] * w; }
            }
            float* dst = (float*)(ws + OFF_CSW) + ((size_t)((l * 4 + g) * 2 + part) * 128) * 128;
#pragma unroll
            for (int i = 0; i < 16; ++i) dst[(cblk * 64 + cq * 16 + i) * 128 + d] = acc[i];
            __syncthreads();
        }
    }
}

__device__ void prep2(const Params& p, unsigned char* lds) {
    unsigned char* ws = opaque(p.ws);
    const int tid = tidx();
    float* wb = (float*)lds;
    float* cw = wb + 64 * 129;
    for (int it = blockIdx.x; it < DEPTH * 4 * 2 * 16; it += gridDim.x) {
        const int kb = it & 15, part = (it >> 4) & 1, g = (it >> 5) & 3, l = it >> 7;
        for (int i = tid; i < 64 * 128; i += 512) { const int kk = i >> 7, c = i & 127; wb[kk * 129 + c] = p.w_in[((size_t)l * 1024 + kb * 64 + kk) * NIN + 2048 + g * 128 + c]; }
        const float* src = (const float*)(ws + OFF_CSW) + ((size_t)((l * 4 + g) * 2 + part) * 128) * 128;
        for (int i = tid; i < 128 * 128; i += 512) cw[i] = src[i];
        __syncthreads();
        const int d = tid & 127, kq = tid >> 7;
        float acc[16];
#pragma unroll
        for (int i = 0; i < 16; ++i) acc[i] = 0.f;
        for (int c = 0; c < 128; ++c) {
            const float w = cw[c * 128 + d];
#pragma unroll
            for (int i = 0; i < 16; ++i) acc[i] += wb[(kq * 16 + i) * 129 + c] * w;
        }
        u16* dst = (u16*)(ws + OFF_WTIN) + ((size_t)l * NPROJ + (4 + part) * 512 + g * 128 + d) * DM + kb * 64 + kq * 16;
        uint4 w0, w1;
        w0.x = pack2(acc[0], acc[1]); w0.y = pack2(acc[2], acc[3]); w0.z = pack2(acc[4], acc[5]); w0.w = pack2(acc[6], acc[7]);
        w1.x = pack2(acc[8], acc[9]); w1.y = pack2(acc[10], acc[11]); w1.z = pack2(acc[12], acc[13]); w1.w = pack2(acc[14], acc[15]);
        *(uint4*)dst = w0; *(uint4*)(dst + 8) = w1;
        __syncthreads();
    }
}

__device__ void phase_norm(const Params& p, const PassInfo ps, int l) {
    unsigned char* ws = opaque(p.ws);
    const int wave = tidx() >> 6, lane = tidx() & 63;
    const float* mod = (const float*)(ws + OFF_MOD);
    const u16* OUT = (const u16*)(ws + OFF_OUT);
    u16* H = (u16*)(ws + OFF_H);
    for (int rr = blockIdx.x * 8 + wave; rr < ps.M; rr += gridDim.x * 8) {
        const int tsh = ps.is_ctx ? 8 : 12; const int b = ps.b0 + (rr >> tsh), t = rr & (ps.T - 1), mrow = ps.is_ctx ? 16 : b;
        const size_t xoff = ((size_t)b * ps.T + t) * 1024;
        const float* xin = (l <= 1) ? ((ps.is_ctx ? p.ctx : p.x) + xoff) : ((ps.is_ctx ? (const float*)(ws + OFF_CTXW) : (const float*)p.out) + xoff);
        float* xout = (ps.is_ctx ? (float*)(ws + OFF_CTXW) : p.out) + xoff;
        float xv[16];
#pragma unroll
        for (int hlf = 0; hlf < 2; ++hlf) {
            const int c0 = hlf * 512 + lane * 8;
            const float4 a = *(const float4*)(xin + c0), bq = *(const float4*)(xin + c0 + 4);
            xv[hlf * 8 + 0] = a.x; xv[hlf * 8 + 1] = a.y; xv[hlf * 8 + 2] = a.z; xv[hlf * 8 + 3] = a.w;
            xv[hlf * 8 + 4] = bq.x; xv[hlf * 8 + 5] = bq.y; xv[hlf * 8 + 6] = bq.z; xv[hlf * 8 + 7] = bq.w;
        }
        if (l > 0) {
            float ov[16]; float ss = 0.f;
#pragma unroll
            for (int hlf = 0; hlf < 2; ++hlf) {
                const int c0 = hlf * 512 + lane * 8;
                unpack8(*(const uint4*)(OUT + (size_t)rr * 1024 + c0), ov + hlf * 8);
            }
#pragma unroll
            for (int e = 0; e < 16; ++e) ss += ov[e] * ov[e];
#pragma unroll
            for (int o = 32; o > 0; o >>= 1) ss += shx(ss, o);
            const float rstd = rsqrtf(ss * (1.f / 1024.f) + EPSN);
            const float* gt = mod + ((size_t)(l - 1) * 17 + mrow) * 3072 + 2048;
            const float* gp = p.g_post + (l - 1) * 1024;
#pragma unroll
            for (int hlf = 0; hlf < 2; ++hlf) {
                const int c0 = hlf * 512 + lane * 8;
#pragma unroll
                for (int e = 0; e < 8; ++e) xv[hlf * 8 + e] += gt[c0 + e] * (ov[hlf * 8 + e] * rstd * gp[c0 + e]);
                *(float4*)(xout + c0) = make_float4(xv[hlf * 8 + 0], xv[hlf * 8 + 1], xv[hlf * 8 + 2], xv[hlf * 8 + 3]);
                *(float4*)(xout + c0 + 4) = make_float4(xv[hlf * 8 + 4], xv[hlf * 8 + 5], xv[hlf * 8 + 6], xv[hlf * 8 + 7]);
            }
        }
        if (l < DEPTH) {
            float ss = 0.f;
#pragma unroll
            for (int e = 0; e < 16; ++e) ss += xv[e] * xv[e];
#pragma unroll
            for (int o = 32; o > 0; o >>= 1) ss += shx(ss, o);
            const float rstd = rsqrtf(ss * (1.f / 1024.f) + EPSN);
            const float* sh = mod + ((size_t)l * 17 + mrow) * 3072; const float* sc = sh + 1024;
            const float* gp = p.g_pre + l * 1024;
#pragma unroll
            for (int hlf = 0; hlf < 2; ++hlf) {
                const int c0 = hlf * 512 + lane * 8;
                float hv[8];
#pragma unroll
                for (int e = 0; e < 8; ++e) hv[e] = xv[hlf * 8 + e] * rstd * gp[c0 + e] * (1.f + sc[c0 + e]) + sh[c0 + e];
                uint4 w; w.x = pack2(hv[0], hv[1]); w.y = pack2(hv[2], hv[3]); w.z = pack2(hv[4], hv[5]); w.w = pack2(hv[6], hv[7]);
                *(uint4*)(H + (size_t)rr * 1024 + c0) = w;
            }
        }
    }
}

#define PJ(row, blk, c) (PROJ + ((size_t)(blk) * MLAT + (row)) * 512 + (c))
typedef unsigned u32x32_ __attribute__((ext_vector_type(32)));
struct Reg8 {
    u32x32_ v;
    __device__ __forceinline__ void ld(int i, const void* p) { const u32x4_ a = *(const u32x4_*)p; v[4 * i] = a[0]; v[4 * i + 1] = a[1]; v[4 * i + 2] = a[2]; v[4 * i + 3] = a[3]; }
    __device__ __forceinline__ u32x4_ get(int i) const { return (u32x4_){v[4 * i], v[4 * i + 1], v[4 * i + 2], v[4 * i + 3]}; }
    __device__ __forceinline__ uint4 getu(int i) const { uint4 r; r.x = v[4 * i]; r.y = v[4 * i + 1]; r.z = v[4 * i + 2]; r.w = v[4 * i + 3]; return r; }
};
#define MEMBAR() asm volatile("" ::: "memory")
constexpr int KVS = 72;
constexpr int TS = 528;
constexpr int T3S = 136;
constexpr int HS_ = 68;
constexpr float NORM_LAT = 0.0013810679320049757f;
constexpr float NORM_CTX = 0.005524271728019903f;

__device__ void attn_item(const Params& p, const PassInfo ps, int l, int item, unsigned char* lds) {
    unsigned char* ws = opaque(p.ws);
    const u16* PROJ = (const u16*)(ws + OFF_PROJ); const u16* QROT = (const u16*)(ws + OFF_QROT);
    const u16* CKV = (const u16*)(ws + OFF_CTXKV) + (size_t)l * MCTX * 1024;
    u16* Y0 = (u16*)(ws + OFF_Y);
    const int tid = tidx(), w = tid >> 6, lane = tid & 63, qtr = w & 3, kh = w >> 2, li = lane & 15, quad = lane >> 4;
    u16* Kl = (u16*)lds; u16* Vl = Kl + 512 * KVS; float* rp = (float*)(Vl + 512 * KVS);
    int bl, h, r = 0, qrow0, bglob;
    if (!ps.is_ctx) { r = item & 63; h = (item >> 6) & 7; bl = item >> 9; qrow0 = bl * 4096 + r * 64; bglob = ps.b0 + bl; }
    else { const int qb = item & 3; h = (item >> 2) & 7; bl = item >> 5; qrow0 = bl * 256 + qb * 64; bglob = bl; }
    const int qrow = qrow0 + qtr * 16 + li;
    float m_run = -1e30f, l_run = 0.f;
    const bf16x8 qp0 = ld_frag_g(PJ(qrow, 0, h * 64 + quad * 8)), qp1 = ld_frag_g(PJ(qrow, 0, h * 64 + 32 + quad * 8));
    uint2 gate4[4];
#pragma unroll
    for (int d = 0; d < 4; ++d) gate4[d] = *(const uint2*)(PJ(qrow, 3, h * 64 + d * 16 + quad * 4));
    Reg8 crg;
    { const size_t crow0 = (size_t)bglob * 256;
#pragma unroll
      for (int i = 0; i < 4; ++i) { const int idx = tid + 512 * i, key = idx >> 3, ch = idx & 7;
          crg.ld(2 * i, CKV + (crow0 + key) * 1024 + h * 64 + ch * 8); crg.ld(2 * i + 1, CKV + (crow0 + key) * 1024 + 512 + h * 64 + ch * 8); } }
    f32x4 O[4];
#pragma unroll
    for (int d = 0; d < 4; ++d) O[d] = (f32x4){0.f, 0.f, 0.f, 0.f};
    if (!ps.is_ctx) {
        const int rs = min(max(r - 4, 0), 56);
        const size_t krow0 = (size_t)bl * 4096 + rs * 64;
        const bf16x8 q0 = ld_frag_g(QROT + (size_t)qrow * 512 + h * 64 + quad * 8), q1 = ld_frag_g(QROT + (size_t)qrow * 512 + h * 64 + 32 + quad * 8);
        { u32x32_ kr, vr;
#pragma unroll
          for (int i = 0; i < 8; ++i) { const int idx = tid + 512 * i, key = idx >> 3, ch = idx & 7;
              const u32x4_ a = *(const u32x4_*)(PJ(krow0 + key, 1, h * 64 + ch * 8)), b = *(const u32x4_*)(PJ(krow0 + key, 2, h * 64 + ch * 8));
              kr[4 * i] = a[0]; kr[4 * i + 1] = a[1]; kr[4 * i + 2] = a[2]; kr[4 * i + 3] = a[3]; vr[4 * i] = b[0]; vr[4 * i + 1] = b[1]; vr[4 * i + 2] = b[2]; vr[4 * i + 3] = b[3]; }
          asm volatile("" ::: "memory");
#pragma unroll
          for (int i = 0; i < 8; ++i) { const int idx = tid + 512 * i, key = idx >> 3, ch = idx & 7;
              *(u32x4_*)(Kl + key * KVS + ch * 8) = (u32x4_){kr[4 * i], kr[4 * i + 1], kr[4 * i + 2], kr[4 * i + 3]}; *(u32x4_*)(Vl + key * KVS + ch * 8) = (u32x4_){vr[4 * i], vr[4 * i + 1], vr[4 * i + 2], vr[4 * i + 3]}; } }
        for (int i = tid; i < 465; i += 512) rp[i] = p.rpb[((size_t)l * 8 + h) * 465 + i];
        __syncthreads();
        const int cbase = (qtr == 0) ? 0 : (qtr == 1 ? 8 : (qtr == 2 ? 24 : 32));
        const int qc = qtr * 16 + li, cst = min(max(qc - 8, 0), 48);
        float s[8][4];
        float mx = -1e30f;
#pragma unroll
        for (int sb = 0; sb < 8; ++sb) {
            const int i = kh * 4 + (sb >> 1), cs = sb & 1;
            const u16* kp = Kl + (i * 64 + cbase + cs * 16 + li) * KVS + quad * 8;
            f32x4 a = (f32x4){0.f, 0.f, 0.f, 0.f};
            a = MFMA16(*(const bf16x8*)kp, q0, a); a = MFMA16(*(const bf16x8*)(kp + 32), q1, a);
            const int ridx = rs + i - r + 7;
#pragma unroll
            for (int j = 0; j < 4; ++j) { const int kc = cbase + cs * 16 + quad * 4 + j;
                const bool valid = (kc >= cst) && (kc < cst + 16);
                const int cidx = min(max(kc - qc + 15, 0), 30);
                const float v = valid ? (a[j] * 0.125f + rp[ridx * 31 + cidx]) : -1e30f;
                s[sb][j] = v; mx = fmaxf(mx, v); }
        }
        mx = fmaxf(mx, shx(mx, 16)); mx = fmaxf(mx, shx(mx, 32));
        m_run = mx;
        float ls = 0.f;
#pragma unroll
        for (int sb = 0; sb < 8; ++sb)
#pragma unroll
            for (int j = 0; j < 4; ++j) { const float e = __expf(s[sb][j] - mx); s[sb][j] = e; ls += e; }
        ls += shx(ls, 16); ls += shx(ls, 32);
        l_run = ls;
#pragma unroll
        for (int kp2 = 0; kp2 < 4; ++kp2) {
            bf16x8 pf; { const unsigned a0 = pack2(s[2 * kp2][0], s[2 * kp2][1]), a1 = pack2(s[2 * kp2][2], s[2 * kp2][3]), b0 = pack2(s[2 * kp2 + 1][0], s[2 * kp2 + 1][1]), b1 = pack2(s[2 * kp2 + 1][2], s[2 * kp2 + 1][3]);
                pf = (bf16x8){(short)(a0 & 0xffff), (short)(a0 >> 16), (short)(a1 & 0xffff), (short)(a1 >> 16), (short)(b0 & 0xffff), (short)(b0 >> 16), (short)(b1 & 0xffff), (short)(b1 >> 16)}; }
            const int vrow0 = (kh * 4 + kp2) * 64 + cbase + quad * 4 + (li >> 2);
#pragma unroll
            for (int d = 0; d < 4; ++d) {
                const u16* vp = Vl + vrow0 * KVS + d * 16 + 4 * (li & 3);
                const bf16x8 vf = tr_read2(vp, vp + 16 * KVS);
                O[d] = MFMA16(vf, pf, O[d]);
            }
        }
        __syncthreads();
    }
    {
#pragma unroll
        for (int i = 0; i < 4; ++i) { const int idx = tid + 512 * i, key = idx >> 3, ch = idx & 7;
            *(u32x4_*)(Kl + key * KVS + ch * 8) = crg.get(2 * i); *(u32x4_*)(Vl + key * KVS + ch * 8) = crg.get(2 * i + 1); }
        __syncthreads();
        const bf16x8 q0 = qp0, q1 = qp1;
        float s[8][4];
        float mx = -1e30f;
#pragma unroll
        for (int sb = 0; sb < 8; ++sb) {
            const u16* kp = Kl + (kh * 128 + sb * 16 + li) * KVS + quad * 8;
            f32x4 a = (f32x4){0.f, 0.f, 0.f, 0.f};
            a = MFMA16(*(const bf16x8*)kp, q0, a); a = MFMA16(*(const bf16x8*)(kp + 32), q1, a);
#pragma unroll
            for (int j = 0; j < 4; ++j) { const float v = a[j] * 0.125f; s[sb][j] = v; mx = fmaxf(mx, v); }
        }
        mx = fmaxf(mx, shx(mx, 16)); mx = fmaxf(mx, shx(mx, 32));
        const float m_new = fmaxf(m_run, mx), resc = __expf(m_run - m_new);
        float ls = 0.f;
#pragma unroll
        for (int sb = 0; sb < 8; ++sb)
#pragma unroll
            for (int j = 0; j < 4; ++j) { const float e = __expf(s[sb][j] - m_new); s[sb][j] = e; ls += e; }
        ls += shx(ls, 16); ls += shx(ls, 32);
        l_run = l_run * resc + ls; m_run = m_new;
#pragma unroll
        for (int d = 0; d < 4; ++d) O[d] *= resc;
#pragma unroll
        for (int kp2 = 0; kp2 < 4; ++kp2) {
            bf16x8 pf; { const unsigned a0 = pack2(s[2 * kp2][0], s[2 * kp2][1]), a1 = pack2(s[2 * kp2][2], s[2 * kp2][3]), b0 = pack2(s[2 * kp2 + 1][0], s[2 * kp2 + 1][1]), b1 = pack2(s[2 * kp2 + 1][2], s[2 * kp2 + 1][3]);
                pf = (bf16x8){(short)(a0 & 0xffff), (short)(a0 >> 16), (short)(a1 & 0xffff), (short)(a1 >> 16), (short)(b0 & 0xffff), (short)(b0 >> 16), (short)(b1 & 0xffff), (short)(b1 >> 16)}; }
            const int vrow0 = kh * 128 + kp2 * 32 + quad * 4 + (li >> 2);
#pragma unroll
            for (int d = 0; d < 4; ++d) {
                const u16* vp = Vl + vrow0 * KVS + d * 16 + 4 * (li & 3);
                const bf16x8 vf = tr_read2(vp, vp + 16 * KVS);
                O[d] = MFMA16(vf, pf, O[d]);
            }
        }
        __syncthreads();
    }
    float* cb = (float*)lds;
    if (kh == 1) {
#pragma unroll
        for (int d = 0; d < 4; ++d)
#pragma unroll
            for (int j = 0; j < 4; ++j) cb[(qtr * 18 + d * 4 + j) * 64 + lane] = O[d][j];
        cb[(qtr * 18 + 16) * 64 + lane] = m_run; cb[(qtr * 18 + 17) * 64 + lane] = l_run;
    }
    __syncthreads();
    if (kh == 0) {
        const float m2 = cb[(qtr * 18 + 16) * 64 + lane], l2 = cb[(qtr * 18 + 17) * 64 + lane];
        const float mm = fmaxf(m_run, m2), e1 = __expf(m_run - mm), e2 = __expf(m2 - mm);
        const float inv = 1.f / (l_run * e1 + l2 * e2);
#pragma unroll
        for (int d = 0; d < 4; ++d) {
            const int col = h * 64 + d * 16 + quad * 4;
            const uint2 g = gate4[d];
            float o[4];
#pragma unroll
            for (int j = 0; j < 4; ++j) o[j] = (O[d][j] * e1 + cb[(qtr * 18 + d * 4 + j) * 64 + lane] * e2) * inv;
            uint2 wv; wv.x = pack2(o[0] * siluf_(bflo(g.x)), o[1] * siluf_(bfhi(g.x))); wv.y = pack2(o[2] * siluf_(bflo(g.y)), o[3] * siluf_(bfhi(g.y)));
            *(uint2*)(Y0 + (size_t)qrow * 512 + col) = wv;
        }
    }
    __syncthreads();
}

template <int ROWS, int CPR> __device__ __forceinline__ void load_tile(u16* dstl, int lstride, const u16* src, size_t sstride) {
    constexpr int PER = ROWS * CPR / 512;
    static_assert(PER % 8 == 0, "tile size");
    const int tid_ = tidx();
#pragma unroll
    for (int b8 = 0; b8 < PER / 8; ++b8) { Reg8 rg;
#pragma unroll
        for (int j = 0; j < 8; ++j) { const int i = tid_ + 512 * (b8 * 8 + j), r = i / CPR, ch = i % CPR; rg.ld(j, src + (size_t)r * sstride + ch * 8); }
        MEMBAR();
#pragma unroll
        for (int j = 0; j < 8; ++j) { const int i = tid_ + 512 * (b8 * 8 + j), r = i / CPR, ch = i % CPR; *(u32x4_*)(dstl + r * lstride + ch * 8) = rg.get(j); }
        MEMBAR(); }
}

__device__ void four1_item(const Params& p, int item, unsigned char* lds) {
    unsigned char* ws = opaque(p.ws);
    const u16* PROJ = (const u16*)(ws + OFF_PROJ); const u16* M1 = (const u16*)(ws + OFF_M1); const float* TW = (const float*)(ws + OFF_TW);
    u16* FY = (u16*)(ws + OFF_FY);
    const int tid = tidx(), w = tid >> 6, lane = tid & 63, li = lane & 15, quad = lane >> 4;
    const int n2 = item & 63, bl = item >> 6;
    u16* T = (u16*)lds;
#pragma unroll
    for (int b8 = 0; b8 < 2; ++b8) { Reg8 rg;
#pragma unroll
        for (int j = 0; j < 8; ++j) { const int i = tid + 512 * (b8 * 8 + j), kk = i >> 6, ch = i & 63, n1 = kk >> 1, part = kk & 1;
            rg.ld(j, PJ((size_t)bl * 4096 + n1 * 64 + n2, 4 + part, ch * 8)); }
        MEMBAR();
#pragma unroll
        for (int j = 0; j < 8; ++j) { const int i = tid + 512 * (b8 * 8 + j), kk = i >> 6, ch = i & 63;
            *(u32x4_*)(T + kk * TS + ch * 8) = rg.get(j); }
        MEMBAR(); }
    float* twl = (float*)(T + 128 * TS);
    if (tid < 64) { const float2 tv = *(const float2*)(TW + 2 * (n2 * tid)); twl[2 * tid] = tv.x; twl[2 * tid + 1] = tv.y; }
    bf16x8 xf[4];
#pragma unroll
    for (int ks = 0; ks < 4; ++ks) xf[ks] = ld_frag_g(M1 + li * 128 + ks * 32 + quad * 8);
    __syncthreads();
    for (int isub = 0; isub < 8; ++isub) {
        bf16x8 xn[4];
        const int isn = isub < 7 ? isub + 1 : 7;
#pragma unroll
        for (int ks = 0; ks < 4; ++ks) xn[ks] = ld_frag_g(M1 + (isn * 16 + li) * 128 + ks * 32 + quad * 8);
        float tcs[2], tsn_[2];
#pragma unroll
        for (int hh = 0; hh < 2; ++hh) { const int k1 = isub * 8 + quad * 2 + hh; tcs[hh] = twl[2 * k1]; tsn_[hh] = twl[2 * k1 + 1]; }
#pragma unroll
        for (int cs = 0; cs < 4; ++cs) {
            const int c0 = w * 64 + cs * 16;
            f32x4 a = (f32x4){0.f, 0.f, 0.f, 0.f};
#pragma unroll
            for (int ks = 0; ks < 4; ++ks) {
                const u16* tp = T + (ks * 32 + quad * 8 + (li >> 2)) * TS + c0 + 4 * (li & 3);
                a = MFMA16(xf[ks], tr_read2(tp, tp + 4 * TS), a);
            }
            const int ch = c0 + li;
#pragma unroll
            for (int hh = 0; hh < 2; ++hh) {
                const int k1 = isub * 8 + quad * 2 + hh;
                const float yr = a[2 * hh], yi = a[2 * hh + 1];
                const float orr = yr * tcs[hh] + yi * tsn_[hh], oi = yi * tcs[hh] - yr * tsn_[hh];
                u16* dst = FY + (((size_t)bl * 64 + k1) * 64 + n2) * 1024 + ch;
                dst[0] = f2bf(orr); dst[512] = f2bf(oi);
            }
        }
#pragma unroll
        for (int ks = 0; ks < 4; ++ks) xf[ks] = xn[ks];
    }
    __syncthreads();
}

__device__ void four2_item(const Params& p, int item, unsigned char* lds) {
    unsigned char* ws = opaque(p.ws);
    const u16* PROJ = (const u16*)(ws + OFF_PROJ); const u16* M2 = (const u16*)(ws + OFF_M2); const u16* FY = (const u16*)(ws + OFF_FY);
    u16* Y1 = (u16*)(ws + OFF_Y) + (size_t)1 * MLAT * 512;
    const int tid = tidx(), w = tid >> 6, lane = tid & 63, li = lane & 15, quad = lane >> 4;
    const int k1 = item & 63, bl = item >> 6;
    u16* T = (u16*)lds;
    load_tile<128, 64>(T, TS, FY + ((size_t)bl * 64 + k1) * 64 * 1024, 512);
    __syncthreads();
    bf16x8 xf[4][4];
#pragma unroll
    for (int cs = 0; cs < 4; ++cs)
#pragma unroll
        for (int ks = 0; ks < 4; ++ks) { const u16* tp = T + (ks * 32 + quad * 8 + (li >> 2)) * TS + w * 64 + cs * 16 + 4 * (li & 3); xf[cs][ks] = tr_read2(tp, tp + 4 * TS); }
    bf16x8 yf[4]; uint2 gt[4];
#define F2_LOAD(k2s_, yf_, gt_) do { _Pragma("unroll") for (int ks = 0; ks < 4; ++ks) yf_[ks] = ld_frag_g(M2 + ((k2s_) * 16 + li) * 128 + ks * 32 + quad * 8); \
        const size_t row_ = (size_t)bl * 4096 + k1 + 64 * ((k2s_) * 16 + li); _Pragma("unroll") for (int cs = 0; cs < 4; ++cs) gt_[cs] = *(const uint2*)(PJ(row_, 6, w * 64 + cs * 16 + quad * 4)); } while (0)
    F2_LOAD(0, yf, gt);
    for (int k2s = 0; k2s < 4; ++k2s) {
        bf16x8 yn[4]; uint2 gn[4];
        const int kn = k2s < 3 ? k2s + 1 : 3;
        F2_LOAD(kn, yn, gn);
        const int k2 = k2s * 16 + li;
        const size_t row = (size_t)bl * 4096 + k1 + 64 * k2;
#pragma unroll
        for (int cs = 0; cs < 4; ++cs) {
            f32x4 a = (f32x4){0.f, 0.f, 0.f, 0.f};
#pragma unroll
            for (int ks = 0; ks < 4; ++ks) a = MFMA16(xf[cs][ks], yf[ks], a);
            const int ch = w * 64 + cs * 16 + quad * 4;
            const uint2 g = gt[cs];
            uint2 wv; wv.x = pack2(a[0] * NORM_LAT * siluf_(bflo(g.x)), a[1] * NORM_LAT * siluf_(bfhi(g.x))); wv.y = pack2(a[2] * NORM_LAT * siluf_(bflo(g.y)), a[3] * NORM_LAT * siluf_(bfhi(g.y)));
            *(uint2*)(Y1 + row * 512 + ch) = wv;
        }
#pragma unroll
        for (int q = 0; q < 4; ++q) { yf[q] = yn[q]; gt[q] = gn[q]; }
    }
#undef F2_LOAD
    __syncthreads();
}

__device__ void fourc_item(const Params& p, int item, unsigned char* lds) {
    unsigned char* ws = opaque(p.ws);
    const u16* PROJ = (const u16*)(ws + OFF_PROJ); const u16* M3 = (const u16*)(ws + OFF_M3);
    u16* Y1 = (u16*)(ws + OFF_Y) + (size_t)1 * MLAT * 512;
    const int tid = tidx(), w = tid >> 6, lane = tid & 63, li = lane & 15, quad = lane >> 4;
    const int chb = item & 3, b = item >> 2;
    u16* T = (u16*)lds;
#pragma unroll
    for (int b8 = 0; b8 < 2; ++b8) { Reg8 rg;
#pragma unroll
        for (int j = 0; j < 8; ++j) { const int i = tid + 512 * (b8 * 8 + j), kk = i >> 4, ch = i & 15, n = kk >> 1, part = kk & 1;
            rg.ld(j, PJ((size_t)b * 256 + n, 4 + part, chb * 128 + ch * 8)); }
        MEMBAR();
#pragma unroll
        for (int j = 0; j < 8; ++j) { const int i = tid + 512 * (b8 * 8 + j), kk = i >> 4, ch = i & 15;
            *(u32x4_*)(T + kk * T3S + ch * 8) = rg.get(j); }
        MEMBAR(); }
    __syncthreads();
    for (int kq = 0; kq < 2; ++kq) {
        const int ksub = w * 2 + kq;
        f32x4 a[8];
#pragma unroll
        for (int cs = 0; cs < 8; ++cs) a[cs] = (f32x4){0.f, 0.f, 0.f, 0.f};
        for (int ks = 0; ks < 16; ++ks) {
            const bf16x8 yf = ld_frag_g(M3 + (ksub * 16 + li) * 512 + ks * 32 + quad * 8);
#pragma unroll
            for (int cs = 0; cs < 8; ++cs) { const u16* tp = T + (ks * 32 + quad * 8 + (li >> 2)) * T3S + cs * 16 + 4 * (li & 3);
                a[cs] = MFMA16(tr_read2(tp, tp + 4 * T3S), yf, a[cs]); }
        }
        const size_t row = (size_t)b * 256 + ksub * 16 + li;
#pragma unroll
        for (int cs = 0; cs < 8; ++cs) {
            const int ch = chb * 128 + cs * 16 + quad * 4;
            const uint2 g = *(const uint2*)(PJ(row, 6, ch));
            uint2 wv; wv.x = pack2(a[cs][0] * NORM_CTX * siluf_(bflo(g.x)), a[cs][1] * NORM_CTX * siluf_(bfhi(g.x))); wv.y = pack2(a[cs][2] * NORM_CTX * siluf_(bflo(g.y)), a[cs][3] * NORM_CTX * siluf_(bfhi(g.y)));
            *(uint2*)(Y1 + row * 512 + ch) = wv;
        }
    }
    __syncthreads();
}

__device__ void gmlp_item(const Params& p, int l, int item, unsigned char* lds) {
    unsigned char* ws = opaque(p.ws);
    const u16* PROJ = (const u16*)(ws + OFF_PROJ); const u16* WS16 = (const u16*)(ws + OFF_WS16) + (size_t)l * 8 * 128 * 128;
    u16* Y2 = (u16*)(ws + OFF_Y) + (size_t)2 * MLAT * 512;
    const int tid = tidx(), w = tid >> 6, lane = tid & 63, li = lane & 15, quad = lane >> 4;
    const size_t r0 = (size_t)item * 128;
    u16* VN = (u16*)lds;
    {
        const int row = tid >> 2, qd = tid & 3;
        const u16* src = PJ(r0 + row, 8, 0);
        uint4 raw[16]; float ss = 0.f;
#pragma unroll
        for (int i = 0; i < 16; ++i) { raw[i] = *(const uint4*)(src + (qd + 4 * i) * 8); float f[8]; unpack8(raw[i], f);
#pragma unroll
            for (int e = 0; e < 8; ++e) ss += f[e] * f[e]; }
        ss += shx(ss, 1); ss += shx(ss, 2);
        const float rstd = rsqrtf(ss * (1.f / 512.f) + EPSN);
        const float* gn = p.gmlp_g + l * 512;
#pragma unroll
        for (int i = 0; i < 16; ++i) { float f[8]; unpack8(raw[i], f); const int c0 = (qd + 4 * i) * 8;
            const float4 g0 = *(const float4*)(gn + c0), g1 = *(const float4*)(gn + c0 + 4);
            uint4 o; o.x = pack2(f[0] * rstd * g0.x, f[1] * rstd * g0.y); o.y = pack2(f[2] * rstd * g0.z, f[3] * rstd * g0.w);
            o.z = pack2(f[4] * rstd * g1.x, f[5] * rstd * g1.y); o.w = pack2(f[6] * rstd * g1.z, f[7] * rstd * g1.w);
            *(uint4*)(VN + row * TS + c0) = o; }
    }
    __syncthreads();
    const int g = w;
    bf16x8 xf[4][4];
#pragma unroll
    for (int cs = 0; cs < 4; ++cs)
#pragma unroll
        for (int ks = 0; ks < 4; ++ks) { const u16* tp = VN + (ks * 32 + quad * 8 + (li >> 2)) * TS + g * 64 + cs * 16 + 4 * (li & 3); xf[cs][ks] = tr_read2(tp, tp + 4 * TS); }
    bf16x8 yf[4]; uint2 uu[4], gg[4]; float bs;
#define GM_LOAD(ts_, yf_, uu_, gg_, bs_) do { const int t_ = (ts_) * 16 + li; _Pragma("unroll") for (int ks = 0; ks < 4; ++ks) yf_[ks] = ld_frag_g(WS16 + ((size_t)g * 128 + t_) * 128 + ks * 32 + quad * 8); \
        bs_ = p.gmlp_bs[((size_t)l * 8 + g) * 128 + t_]; _Pragma("unroll") for (int cs = 0; cs < 4; ++cs) { const int c_ = g * 64 + cs * 16 + quad * 4; uu_[cs] = *(const uint2*)(PJ(r0 + t_, 7, c_)); gg_[cs] = *(const uint2*)(PJ(r0 + t_, 9, c_)); } } while (0)
    GM_LOAD(0, yf, uu, gg, bs);
    for (int ts = 0; ts < 8; ++ts) {
        bf16x8 yn[4]; uint2 un[4], gn[4]; float bn;
        const int tn = ts < 7 ? ts + 1 : 7;
        GM_LOAD(tn, yn, un, gn, bn);
        const int t = ts * 16 + li;
        const size_t row = r0 + t;
#pragma unroll
        for (int cs = 0; cs < 4; ++cs) {
            f32x4 a = (f32x4){0.f, 0.f, 0.f, 0.f};
#pragma unroll
            for (int ks = 0; ks < 4; ++ks) a = MFMA16(xf[cs][ks], yf[ks], a);
            const int c = g * 64 + cs * 16 + quad * 4;
            uint2 wv; wv.x = pack2(bflo(uu[cs].x) * (a[0] + bs) * siluf_(bflo(gg[cs].x)), bfhi(uu[cs].x) * (a[1] + bs) * siluf_(bfhi(gg[cs].x)));
            wv.y = pack2(bflo(uu[cs].y) * (a[2] + bs) * siluf_(bflo(gg[cs].y)), bfhi(uu[cs].y) * (a[3] + bs) * siluf_(bfhi(gg[cs].y)));
            *(uint2*)(Y2 + row * 512 + c) = wv;
        }
#pragma unroll
        for (int q = 0; q < 4; ++q) { yf[q] = yn[q]; uu[q] = un[q]; gg[q] = gn[q]; }
        bs = bn;
    }
#undef GM_LOAD
    __syncthreads();
}

__device__ __forceinline__ void chunk_cumsum(float* A, float* tmp, int dir) {
    const int k = tidx() & 63, seg = tidx() >> 6;
    float v[8]; float run = 0.f;
    if (dir == 0) {
#pragma unroll
        for (int e = 0; e < 8; ++e) { run += A[(seg * 8 + e) * HS_ + k]; v[e] = run; }
    } else {
#pragma unroll
        for (int e = 7; e >= 0; --e) { run += A[(seg * 8 + e) * HS_ + k]; v[e] = run; }
    }
    tmp[seg * 64 + k] = run;
    __syncthreads();
    float off = 0.f;
#pragma unroll
    for (int s2 = 0; s2 < 8; ++s2) { const float tv = tmp[s2 * 64 + k]; if (dir == 0 ? (s2 < seg) : (s2 > seg)) off += tv; }
#pragma unroll
    for (int e = 0; e < 8; ++e) A[(seg * 8 + e) * HS_ + k] = (v[e] + off) * LOG2E;
    __syncthreads();
}
__device__ __forceinline__ void chunk_cumsum2(float* Af, float* Ab, float* tmp) {
    const int k = tidx() & 63, seg = tidx() >> 6;
    float vf[8], vb[8]; float rf = 0.f, rb = 0.f;
#pragma unroll
    for (int e = 0; e < 8; ++e) { rf += Af[(seg * 8 + e) * HS_ + k]; vf[e] = rf; }
#pragma unroll
    for (int e = 7; e >= 0; --e) { rb += Ab[(seg * 8 + e) * HS_ + k]; vb[e] = rb; }
    tmp[seg * 64 + k] = rf; tmp[512 + seg * 64 + k] = rb;
    __syncthreads();
    float of = 0.f, ob = 0.f;
#pragma unroll
    for (int s2 = 0; s2 < 8; ++s2) { const float tf = tmp[s2 * 64 + k], tb = tmp[512 + s2 * 64 + k]; if (s2 < seg) of += tf; if (s2 > seg) ob += tb; }
#pragma unroll
    for (int e = 0; e < 8; ++e) { Af[(seg * 8 + e) * HS_ + k] = (vf[e] + of) * LOG2E; Ab[(seg * 8 + e) * HS_ + k] = (vb[e] + ob) * LOG2E; }
    __syncthreads();
}
__device__ __forceinline__ void load_bf_tile64(float* dst, const u16* src  , size_t sstride) {
    const int t = tidx() >> 3, k8 = (tidx() & 7) * 8;
    float f[8]; unpack8(*(const uint4*)(src + (size_t)t * sstride + k8), f);
    *(float4*)(dst + t * HS_ + k8) = make_float4(f[0], f[1], f[2], f[3]); *(float4*)(dst + t * HS_ + k8 + 4) = make_float4(f[4], f[5], f[6], f[7]);
}
__device__ __forceinline__ void load_f32_tile64(float* dst, const float* src, size_t sstride) {
    const int t = tidx() >> 3, k8 = (tidx() & 7) * 8;
    *(float4*)(dst + t * HS_ + k8) = *(const float4*)(src + (size_t)t * sstride + k8); *(float4*)(dst + t * HS_ + k8 + 4) = *(const float4*)(src + (size_t)t * sstride + k8 + 4);
}

__device__ __forceinline__ void hgrn1_issue(const u16* PROJ, const float* LOGF, const PassInfo ps, int item, Reg8& rg) {
    const int NC = ps.T >> 6, ncsh = ps.is_ctx ? 2 : 6, c = item & (NC - 1), ci = item >> ncsh, dir = ci & 1, h = (ci >> 1) & 7, bl = ci >> 4;
    const size_t r0 = (size_t)bl * ps.T + c * 64;
    const int t = tidx() >> 3, k8 = (tidx() & 7) * 8;
    const float* ap = LOGF + (r0 + t) * 1024 + dir * 512 + h * 64 + k8;
    rg.ld(0, ap); rg.ld(1, ap + 4); rg.ld(2, PJ(r0 + t, 11 + dir, h * 64 + k8)); rg.ld(3, PJ(r0 + t, 13, h * 64 + k8));
}
__device__ void hgrn1_loop(const Params& p, const PassInfo ps, int first, int end, int stride, unsigned char* lds) {
    if (first >= end) return;
    unsigned char* ws = opaque(p.ws);
    const u16* PROJ = (const u16*)(ws + OFF_PROJ); const float* LOGF = (const float*)(ws + OFF_LOGF);
    u16* HL = (u16*)(ws + OFF_HL); float* HD = (float*)(ws + OFF_HD);
    float* A = (float*)lds; float* tmp = A + 64 * HS_; u16* Wb = (u16*)(tmp + 512); u16* Ib = Wb + 64 * KVS;
    const int tid = tidx(), w = tid >> 6, lane = tid & 63, li = lane & 15, quad = lane >> 4;
    const int t = tid >> 3, k8 = (tid & 7) * 8;
    Reg8 rg;
    hgrn1_issue(PROJ, LOGF, ps, first, rg);
  for (int item = first; item < end; item += stride) {
    const int ncsh = ps.is_ctx ? 2 : 6, ci = item >> ncsh, dir = ci & 1;
    float kf[8];
    { MEMBAR();
      unpack8(rg.getu(2), kf);
      *(u32x4_*)(A + t * HS_ + k8) = rg.get(0); *(u32x4_*)(A + t * HS_ + k8 + 4) = rg.get(1);
      *(u32x4_*)(Ib + t * KVS + k8) = rg.get(3); }
    __syncthreads();
    if (item + stride < end) hgrn1_issue(PROJ, LOGF, ps, item + stride, rg);
    chunk_cumsum(A, tmp, dir);
    const int lastt = dir == 0 ? 63 : 0;
    { float wv[8];
#pragma unroll
      for (int e = 0; e < 8; ++e) wv[e] = kf[e] * __builtin_amdgcn_exp2f(A[lastt * HS_ + k8 + e] - A[t * HS_ + k8 + e]);
      uint4 wq; wq.x = pack2(wv[0], wv[1]); wq.y = pack2(wv[2], wv[3]); wq.z = pack2(wv[4], wv[5]); wq.w = pack2(wv[6], wv[7]);
      *(uint4*)(Wb + t * KVS + k8) = wq;
      if (tid < 64) HD[(size_t)item * 64 + tid] = __builtin_amdgcn_exp2f(A[lastt * HS_ + tid]); }
    __syncthreads();
    {
        const int ksub = w >> 1;
        bf16x8 yf[2];
#pragma unroll
        for (int ks = 0; ks < 2; ++ks) { const u16* tp = Wb + (ks * 32 + quad * 8 + (li >> 2)) * KVS + ksub * 16 + 4 * (li & 3); yf[ks] = tr_read2(tp, tp + 4 * KVS); }
#pragma unroll
        for (int vv = 0; vv < 2; ++vv) {
            const int vsub = (w & 1) * 2 + vv;
            f32x4 a = (f32x4){0.f, 0.f, 0.f, 0.f};
#pragma unroll
            for (int ks = 0; ks < 2; ++ks) { const u16* tp = Ib + (ks * 32 + quad * 8 + (li >> 2)) * KVS + vsub * 16 + 4 * (li & 3); a = MFMA16(tr_read2(tp, tp + 4 * KVS), yf[ks], a); }
            uint2 o; o.x = pack2(a[0], a[1]); o.y = pack2(a[2], a[3]);
            *(uint2*)(HL + ((size_t)item * 64 + ksub * 16 + li) * 64 + vsub * 16 + quad * 4) = o;
        }
    }
    __syncthreads();
  }
}

__device__ void hgrn_chain(const Params& p, const PassInfo ps, int l, int ci, unsigned char* lds) {
    unsigned char* ws = opaque(p.ws);
    const u16* PROJ = (const u16*)(ws + OFF_PROJ); const float* LOGF = (const float*)(ws + OFF_LOGF);
    u16* HS = (u16*)(ws + OFF_HS); float* CST = (float*)(ws + OFF_CTXST) + (size_t)l * 256 * 4096;
    const int tid = tidx(), w = tid >> 6, lane = tid & 63, li = lane & 15, quad = lane >> 4;
    const int t = tid >> 3, k8 = (tid & 7) * 8;
    const int NC = ps.T >> 6, dir = ci & 1, ksub = w >> 1, kk_ = ksub * 16 + li;
    float S[2][4];
#pragma unroll
    for (int vv = 0; vv < 2; ++vv) {
        const int v0 = ((w & 1) * 2 + vv) * 16 + quad * 4;
        if (!ps.is_ctx) { const float4 c4 = *(const float4*)(CST + ((size_t)ps.b0 * 16 + ci) * 4096 + kk_ * 64 + v0); S[vv][0] = c4.x; S[vv][1] = c4.y; S[vv][2] = c4.z; S[vv][3] = c4.w; }
        else { S[vv][0] = 0.f; S[vv][1] = 0.f; S[vv][2] = 0.f; S[vv][3] = 0.f; }
    }
    Reg8 rg;
    hgrn1_issue(PROJ, LOGF, ps, ci * NC + (dir ? NC - 1 : 0), rg);
  for (int cc = 0; cc < NC; ++cc) {
    const int c = dir ? NC - 1 - cc : cc, item = ci * NC + c;
    float* A = (float*)(lds + (cc & 1) * 38912); float* tmp = A + 64 * HS_; u16* Wb = (u16*)(tmp + 512); u16* Ib = Wb + 64 * KVS;
    float kf[8];
    { MEMBAR();
      unpack8(rg.getu(2), kf);
      *(u32x4_*)(A + t * HS_ + k8) = rg.get(0); *(u32x4_*)(A + t * HS_ + k8 + 4) = rg.get(1);
      *(u32x4_*)(Ib + t * KVS + k8) = rg.get(3); }
    __syncthreads();
    if (cc + 1 < NC) hgrn1_issue(PROJ, LOGF, ps, ci * NC + (dir ? NC - 2 - cc : cc + 1), rg);
    chunk_cumsum(A, tmp, dir);
    const int lastt = dir == 0 ? 63 : 0;
    { float wv[8];
#pragma unroll
      for (int e = 0; e < 8; ++e) wv[e] = kf[e] * __builtin_amdgcn_exp2f(A[lastt * HS_ + k8 + e] - A[t * HS_ + k8 + e]);
      uint4 wq; wq.x = pack2(wv[0], wv[1]); wq.y = pack2(wv[2], wv[3]); wq.z = pack2(wv[4], wv[5]); wq.w = pack2(wv[6], wv[7]);
      *(uint4*)(Wb + t * KVS + k8) = wq; }
    __syncthreads();
    {
        const float dk = __builtin_amdgcn_exp2f(A[lastt * HS_ + kk_]);
        bf16x8 yf[2];
#pragma unroll
        for (int ks = 0; ks < 2; ++ks) { const u16* tp = Wb + (ks * 32 + quad * 8 + (li >> 2)) * KVS + ksub * 16 + 4 * (li & 3); yf[ks] = tr_read2(tp, tp + 4 * KVS); }
#pragma unroll
        for (int vv = 0; vv < 2; ++vv) {
            const int vsub = (w & 1) * 2 + vv;
            f32x4 a = (f32x4){0.f, 0.f, 0.f, 0.f};
#pragma unroll
            for (int ks = 0; ks < 2; ++ks) { const u16* tp = Ib + (ks * 32 + quad * 8 + (li >> 2)) * KVS + vsub * 16 + 4 * (li & 3); a = MFMA16(tr_read2(tp, tp + 4 * KVS), yf[ks], a); }
            uint2 o; o.x = pack2(S[vv][0], S[vv][1]); o.y = pack2(S[vv][2], S[vv][3]);
            *(uint2*)(HS + ((size_t)item * 64 + kk_) * 64 + vsub * 16 + quad * 4) = o;
#pragma unroll
            for (int j = 0; j < 4; ++j) S[vv][j] = dk * S[vv][j] + a[j];
        }
    }
  }
    __syncthreads();
    if (ps.is_ctx) {
#pragma unroll
        for (int vv = 0; vv < 2; ++vv) { const int v0 = ((w & 1) * 2 + vv) * 16 + quad * 4;
            *(float4*)(CST + (size_t)ci * 4096 + kk_ * 64 + v0) = make_float4(S[vv][0], S[vv][1], S[vv][2], S[vv][3]); }
    }
}

__device__ void hgrn2_all(const Params& p, const PassInfo ps, int l) {
    unsigned char* ws = opaque(p.ws);
    const unsigned* HL = (const unsigned*)(ws + OFF_HL); const float* HD = (const float*)(ws + OFF_HD); unsigned* HS = (unsigned*)(ws + OFF_HS);
    float* CST = (float*)(ws + OFF_CTXST) + (size_t)l * 256 * 4096;
    const int NC = ps.T >> 6, chains = ps.nb * 16;
    const size_t total = (size_t)chains * 2048;
    for (size_t e = (size_t)blockIdx.x * 512 + tidx(); e < total; e += (size_t)gridDim.x * 512) {
        const int ci = (int)(e >> 11), kv2 = (int)(e & 2047), k = kv2 >> 5, dir = ci & 1;
        float s0 = 0.f, s1 = 0.f;
        if (!ps.is_ctx) { const float2 cs = *(const float2*)(CST + ((size_t)ps.b0 * 16 + ci) * 4096 + 2 * kv2); s0 = cs.x; s1 = cs.y; }
#define HG2_TRIP(BLK) for (int c4 = 0; c4 < NC; c4 += BLK) { float d[BLK]; unsigned lw[BLK]; \
            _Pragma("unroll") for (int j = 0; j < BLK; ++j) { const int c = dir ? NC - 1 - (c4 + j) : c4 + j; const size_t idx = (size_t)ci * NC + c; d[j] = HD[idx * 64 + k]; lw[j] = HL[idx * 2048 + kv2]; } \
            _Pragma("unroll") for (int j = 0; j < BLK; ++j) { const int c = dir ? NC - 1 - (c4 + j) : c4 + j; const size_t idx = (size_t)ci * NC + c; \
                HS[idx * 2048 + kv2] = pack2(s0, s1); s0 = d[j] * s0 + bflo(lw[j]); s1 = d[j] * s1 + bfhi(lw[j]); } }
        if (NC == 4) { HG2_TRIP(4) } else { HG2_TRIP(16) }
#undef HG2_TRIP
        if (ps.is_ctx) *(float2*)(CST + (size_t)ci * 4096 + 2 * kv2) = make_float2(s0, s1);
    }
}

__device__ void hgrn3_item(const Params& p, const PassInfo ps, int l, int item, unsigned char* lds) {
    unsigned char* ws = opaque(p.ws);
    const u16* PROJ = (const u16*)(ws + OFF_PROJ); const float* LOGF = (const float*)(ws + OFF_LOGF); const u16* HSt = (const u16*)(ws + OFF_HS);
    u16* Y3 = (u16*)(ws + OFF_Y) + (size_t)3 * MLAT * 512;
    const int NC = ps.T >> 6, ncsh = ps.is_ctx ? 2 : 6, c = item & (NC - 1), bh = item >> ncsh, h = bh & 7, bl = bh >> 3;
    const size_t r0 = (size_t)bl * ps.T + c * 64;
    const size_t idxf = (size_t)(bh * 2 + 0) * NC + c, idxb = (size_t)(bh * 2 + 1) * NC + c;
    float* Q = (float*)lds; float* KKf = Q + 64 * HS_; float* KKb = KKf + 64 * HS_; float* Af = KKb + 64 * HS_; float* Ab = Af + 64 * HS_; float* tmp = Ab + 64 * HS_;
    u16* Ib = (u16*)(tmp + 1024); u16* Sfb = Ib + 64 * KVS; u16* Sbb = Sfb + 64 * KVS; float* comb = (float*)(Sbb + 64 * KVS);
    const int tid = tidx(), w = tid >> 6, lane = tid & 63, li = lane & 15, quad = lane >> 4;
    { const int t = tid >> 3, k8 = (tid & 7) * 8;
      Reg8 ra, rb;
      const float* ap = LOGF + (r0 + t) * 1024 + h * 64 + k8;
      const u16* sf = HSt + idxf * 4096 + t * 64 + k8; const u16* sb = HSt + idxb * 4096 + t * 64 + k8;
      ra.ld(0, PJ(r0 + t, 10, h * 64 + k8)); ra.ld(1, PJ(r0 + t, 11, h * 64 + k8)); ra.ld(2, PJ(r0 + t, 12, h * 64 + k8)); ra.ld(3, PJ(r0 + t, 13, h * 64 + k8));
      ra.ld(4, ap); ra.ld(5, ap + 4); ra.ld(6, ap + 512); ra.ld(7, ap + 516);
      rb.ld(0, sf); rb.ld(1, sb);
      MEMBAR();
      float x[8];
      unpack8(ra.getu(0), x); *(float4*)(Q + t * HS_ + k8) = make_float4(x[0], x[1], x[2], x[3]); *(float4*)(Q + t * HS_ + k8 + 4) = make_float4(x[4], x[5], x[6], x[7]);
      unpack8(ra.getu(1), x); *(float4*)(KKf + t * HS_ + k8) = make_float4(x[0], x[1], x[2], x[3]); *(float4*)(KKf + t * HS_ + k8 + 4) = make_float4(x[4], x[5], x[6], x[7]);
      unpack8(ra.getu(2), x); *(float4*)(KKb + t * HS_ + k8) = make_float4(x[0], x[1], x[2], x[3]); *(float4*)(KKb + t * HS_ + k8 + 4) = make_float4(x[4], x[5], x[6], x[7]);
      *(u32x4_*)(Ib + t * KVS + k8) = ra.get(3);
      *(u32x4_*)(Af + t * HS_ + k8) = ra.get(4); *(u32x4_*)(Af + t * HS_ + k8 + 4) = ra.get(5); *(u32x4_*)(Ab + t * HS_ + k8) = ra.get(6); *(u32x4_*)(Ab + t * HS_ + k8 + 4) = ra.get(7);
      *(u32x4_*)(Sfb + t * KVS + k8) = rb.get(0); *(u32x4_*)(Sbb + t * KVS + k8) = rb.get(1); }
    __syncthreads();
    chunk_cumsum2(Af, Ab, tmp);
    const int dir = w >> 2, T = w & 3;
    const float* A = dir ? Ab : Af; const float* KK = dir ? KKb : KKf; const u16* Sb16 = dir ? Sbb : Sfb;
    const int t = 16 * T + li;
    const int rrow = dir ? 16 * T + 16 : 16 * T - 1; const bool rzero = dir ? (T == 3) : (T == 0);
    bf16x8 qt[2], qh[2];
    float Rv[2][8];
#pragma unroll
    for (int ks = 0; ks < 2; ++ks) {
        const int k0 = ks * 32 + quad * 8;
        float qv[8], av[8];
        { const float4 x0 = *(const float4*)(Q + t * HS_ + k0), x1 = *(const float4*)(Q + t * HS_ + k0 + 4); qv[0] = x0.x; qv[1] = x0.y; qv[2] = x0.z; qv[3] = x0.w; qv[4] = x1.x; qv[5] = x1.y; qv[6] = x1.z; qv[7] = x1.w; }
        { const float4 x0 = *(const float4*)(A + t * HS_ + k0), x1 = *(const float4*)(A + t * HS_ + k0 + 4); av[0] = x0.x; av[1] = x0.y; av[2] = x0.z; av[3] = x0.w; av[4] = x1.x; av[5] = x1.y; av[6] = x1.z; av[7] = x1.w; }
        if (rzero) {
#pragma unroll
            for (int e = 0; e < 8; ++e) Rv[ks][e] = 0.f;
        } else { const float4 x0 = *(const float4*)(A + rrow * HS_ + k0), x1 = *(const float4*)(A + rrow * HS_ + k0 + 4); Rv[ks][0] = x0.x; Rv[ks][1] = x0.y; Rv[ks][2] = x0.z; Rv[ks][3] = x0.w; Rv[ks][4] = x1.x; Rv[ks][5] = x1.y; Rv[ks][6] = x1.z; Rv[ks][7] = x1.w; }
        float a_[8], b_[8];
#pragma unroll
        for (int e = 0; e < 8; ++e) { a_[e] = qv[e] * __builtin_amdgcn_exp2f(av[e] - Rv[ks][e]); b_[e] = qv[e] * __builtin_amdgcn_exp2f(av[e]); }
        const unsigned a0 = pack2(a_[0], a_[1]), a1 = pack2(a_[2], a_[3]), a2 = pack2(a_[4], a_[5]), a3 = pack2(a_[6], a_[7]);
        const unsigned b0 = pack2(b_[0], b_[1]), b1 = pack2(b_[2], b_[3]), b2 = pack2(b_[4], b_[5]), b3 = pack2(b_[6], b_[7]);
        qt[ks] = (bf16x8){(short)(a0 & 0xffff), (short)(a0 >> 16), (short)(a1 & 0xffff), (short)(a1 >> 16), (short)(a2 & 0xffff), (short)(a2 >> 16), (short)(a3 & 0xffff), (short)(a3 >> 16)};
        qh[ks] = (bf16x8){(short)(b0 & 0xffff), (short)(b0 >> 16), (short)(b1 & 0xffff), (short)(b1 >> 16), (short)(b2 & 0xffff), (short)(b2 >> 16), (short)(b3 & 0xffff), (short)(b3 >> 16)};
    }
    const int nS = dir ? 4 - T : T + 1;
    float sc[4][4];
#pragma unroll
    for (int i = 0; i < 4; ++i) {
        if (i < nS) {
            const int S = dir ? T + i : i, srow = 16 * S + li;
            f32x4 a = (f32x4){0.f, 0.f, 0.f, 0.f};
#pragma unroll
            for (int ks = 0; ks < 2; ++ks) {
                const int k0 = ks * 32 + quad * 8;
                const float4 x0 = *(const float4*)(KK + srow * HS_ + k0), x1 = *(const float4*)(KK + srow * HS_ + k0 + 4);
                const float4 y0 = *(const float4*)(A + srow * HS_ + k0), y1 = *(const float4*)(A + srow * HS_ + k0 + 4);
                const float kv[8] = {x0.x, x0.y, x0.z, x0.w, x1.x, x1.y, x1.z, x1.w}, as[8] = {y0.x, y0.y, y0.z, y0.w, y1.x, y1.y, y1.z, y1.w};
                float c_[8];
#pragma unroll
                for (int e = 0; e < 8; ++e) c_[e] = kv[e] * __builtin_amdgcn_exp2f(Rv[ks][e] - as[e]);
                const unsigned c0 = pack2(c_[0], c_[1]), c1 = pack2(c_[2], c_[3]), c2 = pack2(c_[4], c_[5]), c3 = pack2(c_[6], c_[7]);
                const bf16x8 kf = (bf16x8){(short)(c0 & 0xffff), (short)(c0 >> 16), (short)(c1 & 0xffff), (short)(c1 >> 16), (short)(c2 & 0xffff), (short)(c2 >> 16), (short)(c3 & 0xffff), (short)(c3 >> 16)};
                a = MFMA16(kf, qt[ks], a);
            }
            const bool diag = (S == T);
#pragma unroll
            for (int j = 0; j < 4; ++j) { const int sl = quad * 4 + j; const bool keep = !diag || (dir ? (sl >= li) : (sl <= li)); sc[i][j] = keep ? a[j] : 0.f; }
        } else {
#pragma unroll
            for (int j = 0; j < 4; ++j) sc[i][j] = 0.f;
        }
    }
    f32x4 O[4];
#pragma unroll
    for (int v = 0; v < 4; ++v) O[v] = (f32x4){0.f, 0.f, 0.f, 0.f};
#pragma unroll
    for (int pr = 0; pr < 2; ++pr) {
        if (2 * pr < nS) {
            const unsigned a0 = pack2(sc[2 * pr][0], sc[2 * pr][1]), a1 = pack2(sc[2 * pr][2], sc[2 * pr][3]), b0 = pack2(sc[2 * pr + 1][0], sc[2 * pr + 1][1]), b1 = pack2(sc[2 * pr + 1][2], sc[2 * pr + 1][3]);
            const bf16x8 pf = (bf16x8){(short)(a0 & 0xffff), (short)(a0 >> 16), (short)(a1 & 0xffff), (short)(a1 >> 16), (short)(b0 & 0xffff), (short)(b0 >> 16), (short)(b1 & 0xffff), (short)(b1 >> 16)};
            const int S0 = dir ? T + 2 * pr : 2 * pr; int S1 = S0 + 1; if (S1 > 3) S1 = 3;
            const u16* p0 = Ib + (16 * S0 + quad * 4 + (li >> 2)) * KVS + 4 * (li & 3);
            const u16* p1 = Ib + (16 * S1 + quad * 4 + (li >> 2)) * KVS + 4 * (li & 3);
#pragma unroll
            for (int v = 0; v < 4; ++v) O[v] = MFMA16(tr_read2(p0 + v * 16, p1 + v * 16), pf, O[v]);
        }
    }
#pragma unroll
    for (int ks = 0; ks < 2; ++ks) {
        const u16* p0 = Sb16 + (ks * 32 + quad * 8 + (li >> 2)) * KVS + 4 * (li & 3);
#pragma unroll
        for (int v = 0; v < 4; ++v) O[v] = MFMA16(tr_read2(p0 + v * 16, p0 + 4 * KVS + v * 16), qh[ks], O[v]);
    }
    if (dir == 1) {
#pragma unroll
        for (int v = 0; v < 4; ++v)
#pragma unroll
            for (int j = 0; j < 4; ++j) comb[(T * 16 + v * 4 + j) * 64 + lane] = O[v][j];
    }
    __syncthreads();
    if (dir == 0) {
        float ss = 0.f;
#pragma unroll
        for (int v = 0; v < 4; ++v)
#pragma unroll
            for (int j = 0; j < 4; ++j) { O[v][j] += comb[(T * 16 + v * 4 + j) * 64 + lane]; ss += O[v][j] * O[v][j]; }
        ss += shx(ss, 16); ss += shx(ss, 32);
        const float rstd = rsqrtf(ss * (1.f / 64.f) + EPSN);
        const size_t row = r0 + t;
#pragma unroll
        for (int v = 0; v < 4; ++v) {
            const int col = h * 64 + v * 16 + quad * 4;
            const float4 gn = *(const float4*)(p.hgrn_g + l * 512 + col);
            const uint2 g = *(const uint2*)(PJ(row, 14, col));
            uint2 wv; wv.x = pack2(O[v][0] * rstd * gn.x * siluf_(bflo(g.x)), O[v][1] * rstd * gn.y * siluf_(bfhi(g.x))); wv.y = pack2(O[v][2] * rstd * gn.z * siluf_(bflo(g.y)), O[v][3] * rstd * gn.w * siluf_(bfhi(g.y)));
            *(uint2*)(Y3 + row * 512 + col) = wv;
        }
    }
    __syncthreads();
}
#define XB_TMO      128
#define XB_XCNT(j)  (256  + 64 * (j))
#define XB_XSUB(j)  (1280 + 64 * (j))
#define XB_XGEN(j)  (2304 + 64 * (j))
#define XB_TOP      3328
#define XB_TOPGEN   3392
#define XCD_BAR_WORDS 3456
#define XB_SPIN_CAP (1u << 18)

__device__ __forceinline__ unsigned xb_ld(unsigned* p)              { return __hip_atomic_load(p, __ATOMIC_RELAXED, __HIP_MEMORY_SCOPE_AGENT); }
__device__ __forceinline__ unsigned xb_add(unsigned* p, unsigned v) { return __hip_atomic_fetch_add(p, v, __ATOMIC_RELAXED, __HIP_MEMORY_SCOPE_AGENT); }
__device__ __forceinline__ unsigned xb_xcc_id() { return (unsigned)__builtin_amdgcn_s_getreg((3 << 11) | 20) & 0xFu; }
#define XB_SPIN(cond, bar) do { unsigned _sp = 0; while (cond) { __builtin_amdgcn_s_sleep(1); \
    if ((++_sp & 255u) == 0u) { if (xb_ld(&(bar)[XB_TMO])) break; if (_sp > XB_SPIN_CAP) { atomicAdd(&(bar)[XB_TMO], 1u); break; } } } } while (0)

struct XcdBarrier {
    unsigned* bar; unsigned x;
    volatile LAS unsigned* st;
};

__device__ __forceinline__ XcdBarrier xcd_barrier_post(unsigned* bar, volatile LAS unsigned* st) {
    XcdBarrier b; b.bar = bar; b.x = xb_xcc_id(); b.st = st;
    if (tidx() == 0) (void)xb_add(&bar[XB_XCNT(b.x)], 1u);
    return b;
}
__device__ __forceinline__ void xcd_barrier_complete(unsigned* bar, unsigned x, unsigned& nloc, unsigned& nx) {
    const unsigned G = gridDim.x * gridDim.y * gridDim.z;
    unsigned sum, cnt, mine, sp = 0u;
    for (;;) {
        sum = 0u; cnt = 0u; mine = 0u;
#pragma unroll
        for (unsigned j = 0; j < 16; ++j) { const unsigned c = xb_ld(&bar[XB_XCNT(j)]); sum += c; cnt += (c > 0u) ? 1u : 0u; mine = (j == x) ? c : mine; }
        if (sum == G) break;
        __builtin_amdgcn_s_sleep(1);
        if ((++sp & 255u) == 0u) { if (xb_ld(&bar[XB_TMO])) break; if (sp > XB_SPIN_CAP) { atomicAdd(&bar[XB_TMO], 1u); break; } }
    }
    nloc = mine > 0u ? mine : 1u; nx = cnt > 0u ? cnt : 1u;
}

__device__ __forceinline__ void xcd_barrier(const XcdBarrier& b) {
    asm volatile("s_waitcnt vmcnt(0)" ::: "memory");
    __syncthreads();
    if (tidx() == 0) {
        unsigned* bar = b.bar;
        __builtin_amdgcn_s_waitcnt(0);
        unsigned nloc = b.st[0], nx = b.st[1];
        if (nloc == 0u) { xcd_barrier_complete(bar, b.x, nloc, nx); b.st[0] = nloc; b.st[1] = nx; }
        const unsigned old = xb_add(&bar[XB_XSUB(b.x)], 1u);
        const unsigned gen = old / nloc;
        if (old + 1u == (gen + 1u) * nloc) {
            __builtin_amdgcn_fence(__ATOMIC_RELEASE, "agent");
            asm volatile("s_waitcnt vmcnt(0)" ::: "memory");
            const unsigned og = xb_add(&bar[XB_TOP], 1u);
            const unsigned tg = og / nx;
            if (og + 1u == (tg + 1u) * nx) xb_add(&bar[XB_TOPGEN], 1u);
            else XB_SPIN(xb_ld(&bar[XB_TOPGEN]) == tg, bar);
            __builtin_amdgcn_fence(__ATOMIC_ACQUIRE, "agent");
            xb_add(&bar[XB_XGEN(b.x)], 1u);
            asm volatile("s_waitcnt vmcnt(0)" ::: "memory");
        } else {
            XB_SPIN(xb_ld(&bar[XB_XGEN(b.x)]) == gen, bar);
            __builtin_amdgcn_fence(__ATOMIC_ACQUIRE, "agent");
            asm volatile("s_waitcnt vmcnt(0)" ::: "memory");
        }
    }
    __syncthreads();
}

#ifndef STAG_B
#define STAG_B 240
#endif
#ifndef STAG_D
#define STAG_D 300
#endif
#ifndef REP_ATTN
#define REP_ATTN 1
#endif
#ifndef REP_B
#define REP_B 1
#endif
#ifndef REP_C1
#define REP_C1 1
#endif
#ifndef REP_C2
#define REP_C2 1
#endif
#ifndef REP_C3
#define REP_C3 1
#endif
#ifndef REP_DE
#define REP_DE 1
#endif
__device__ __forceinline__ void stagger(int ticks_per_slot) {
    const int slot = ((int)blockIdx.x >> 3) & 7;
    if (slot) { const unsigned long long t0 = __builtin_amdgcn_s_memrealtime(), dt = (unsigned long long)(slot * ticks_per_slot);
        while (__builtin_amdgcn_s_memrealtime() - t0 < dt) __builtin_amdgcn_s_sleep(4); }
}
template <class Epi> __device__ __forceinline__ void run_gemm(LAS unsigned char* lds, const u16* A, const u16* Bt, int M, int N, int K, const Epi& E) {
    pg8::Gemm g; g.A = A; g.Bt = Bt; g.M = M; g.N = N; g.K = K; g.rsA = 0; g.rsB = 0;
    pg8::StaticOrder S; S.init(M, N, (int)gridDim.x, (int)blockIdx.x);
    pg8::gemm_phase<Epi, pg8::StaticOrder, false>(lds, g, S, E, nullptr);
}


struct EpiNull {
    static constexpr bool PERM = true, AFTER_DRAIN = false;
    unsigned char* ws;
    __device__ __forceinline__ void operator()(const f32x4 (&acc)[2][2][4][2], const Unit& u, int wr, int wc, int fr, int fq) const {
        if (ws == nullptr) {
#pragma unroll
            for (int ai = 0; ai < 2; ++ai)
#pragma unroll
                for (int bj = 0; bj < 2; ++bj)
#pragma unroll
                    for (int m = 0; m < 4; ++m)
#pragma unroll
                        for (int n = 0; n < 2; ++n) *(f32x4*)(ws + (size_t)(((ai * 2 + bj) * 4 + m) * 2 + n) * 16 + fr * 1024 + fq * 65536 + wr * 4096 + wc * 16384 + u.pm) = acc[ai][bj][m][n];
        }
    }
};
struct MergeOrder : pg8::StaticOrder {
    __device__ bool next(int i, Unit& u) const { if (!pg8::StaticOrder::next(i >> 2, u)) return false; u.r = i & 3; return true; }
};
__device__ __forceinline__ Params KP() {
    auto q0 = __builtin_amdgcn_kernarg_segment_ptr();
    asm volatile("" : "+s"(q0));
    const __attribute__((address_space(4))) Params* q = (const __attribute__((address_space(4))) Params*)q0;
    Params r;
    r.x = q->x; r.c = q->c; r.ctx = q->ctx; r.c_ctx = q->c_ctx; r.w_ada = q->w_ada; r.b_ada = q->b_ada; r.g_pre = q->g_pre; r.g_post = q->g_post; r.w_in = q->w_in; r.rpb = q->rpb;
    r.fnet_w = q->fnet_w; r.gmlp_g = q->gmlp_g; r.gmlp_ws = q->gmlp_ws; r.gmlp_bs = q->gmlp_bs; r.lb_logits = q->lb_logits; r.hgrn_g = q->hgrn_g; r.w_branch = q->w_branch; r.w_out = q->w_out;
    r.out = q->out; r.ws = q->ws; return r;
}
constexpr size_t OFF_BAR = WS_END;
constexpr size_t WS_END2 = WS_END + (size_t)XCD_BAR_WORDS * 4;
__device__ __forceinline__ void gsync(LAS unsigned char* lds3) {
    XcdBarrier b; b.bar = (unsigned*)(opaque(KP().ws) + OFF_BAR); b.x = xb_xcc_id(); b.st = (volatile LAS unsigned*)(lds3 + LDS_BYTES);
    xcd_barrier(b);
}
__global__ void __launch_bounds__(512, 2) mega_fwd(Params p_unused) {
    extern __shared__ __attribute__((aligned(16))) unsigned char shm[];
    LAS unsigned char* lds3 = (LAS unsigned char*)shm;
    {
        if (tidx() < 4) ((volatile LAS unsigned*)(lds3 + LDS_BYTES))[tidx()] = 0u;
        if (blockIdx.x == 0) { unsigned* bar = (unsigned*)(opaque(KP().ws) + OFF_BAR); for (int i = tidx(); i < XCD_BAR_WORDS; i += 512) bar[i] = 0u; }
        __syncthreads();
    }
    prep1(KP(), shm);
    cg::this_grid().sync();
    { XcdBarrier b0 = xcd_barrier_post((unsigned*)(opaque(KP().ws) + OFF_BAR), (volatile LAS unsigned*)(lds3 + LDS_BYTES)); (void)b0; }
    prep2(KP(), shm);
    gsync(lds3);
#pragma nounroll
    for (int pass = 0; pass < 1 + NBATCH / GB; ++pass) {
        PassInfo ps;
        if (pass == 0) { ps.is_ctx = 1; ps.nb = NBATCH; ps.T = CTXL; ps.M = MCTX; ps.b0 = 0; }
        else { ps.is_ctx = 0; ps.nb = GB; ps.T = SEQ; ps.M = MLAT; ps.b0 = (pass - 1) * GB; }
        const int NC = ps.T >> 6;
#pragma nounroll
        for (int l = 0; l < DEPTH; ++l) {
            phase_norm(KP(), ps, l);
            gsync(lds3);
            _Pragma("nounroll") for (int rep = 0; rep < REP_B; ++rep) {
                unsigned char* ws = opaque(KP().ws);
                EpiProj E; E.ws = ws; E.l = l; E.is_ctx = ps.is_ctx;

                run_gemm(lds3, (const u16*)(ws + OFF_H), (const u16*)(ws + OFF_WTIN) + (size_t)l * NPROJ * DM, ps.M, NPROJ, DM, E);
                gsync(lds3);
#ifdef PROBE_NULL_B
                { EpiNull EN; EN.ws = ws; run_gemm(lds3, (const u16*)(ws + OFF_H), (const u16*)(ws + OFF_WTIN) + (size_t)l * NPROJ * DM, ps.M, NPROJ, DM, EN); gsync(lds3); }
#endif
            }
            const bool full = !(ps.is_ctx && l == DEPTH - 1);
            {
                const int nch = ps.nb * 16, n_at = full ? ps.nb * 8 * (ps.T >> 6) : 0, n_f1 = ps.is_ctx ? 0 : ps.nb * 64, n_g = 0;
                const int wg = (int)blockIdx.x, G = (int)gridDim.x;
                int first, stride;
                bool xl = false; int xcd = 0, lr = 0, nloc = 1;
                if (nch >= G || G != 4 * nch || (G & 7) != 0 || !full) {
                    for (int ci = wg; ci < nch; ci += G) hgrn_chain(KP(), ps, l, ci, shm);
                    first = wg; stride = G;
                } else {
                    const int g4 = wg >> 2, pos = wg & 3, cpos = (g4 >> 1) & 3;
                    first = 0x7fffffff; stride = 1;
                    if (pos == cpos) hgrn_chain(KP(), ps, l, g4, shm);
                    else {
                        xl = true; xcd = wg & 7; nloc = 0;
                        for (int w2 = xcd; w2 < G; w2 += 8) { const int g2 = w2 >> 2, nonchain = ((w2 & 3) != ((g2 >> 1) & 3)) ? 1 : 0; nloc += nonchain; if (w2 < wg) lr += nonchain; }
                    }
                }
                const int A_x = n_at >> 3, F_x = n_f1 >> 3;
                const int na = xl ? (A_x - lr + nloc - 1) / nloc : 0;
                for (int k = 0;; ++k) {
                    int it;
                    if (xl) {
                        if (k < na) { const int a = lr + k * nloc; it = (((a >> 6) << 3) + xcd) * 64 + (a & 63); }
                        else { const int f = (nloc - 1 - lr) + (k - na) * nloc; if (f >= F_x) break; it = n_at + xcd * F_x + f; }
                    } else { it = first + k * stride; if (first == 0x7fffffff || it >= n_at + n_f1 + n_g) break; }
                    if (it < n_at) attn_item(KP(), ps, l, it, shm);
                    else if (it < n_at + n_f1) four1_item(KP(), it - n_at, shm);
                    else gmlp_item(KP(), l, it - n_at - n_f1, shm);
                }
                gsync(lds3);
            }
            if (!full) continue;
            {
                const int n_f2 = ps.is_ctx ? ps.nb * 4 : ps.nb * 64, n_h3 = ps.nb * 8 * NC, n_g3 = ps.M >> 7;
                for (int it = blockIdx.x; it < n_f2 + n_h3 + n_g3; it += gridDim.x) {
                    if (it < n_f2) { if (ps.is_ctx) fourc_item(KP(), it, shm); else four2_item(KP(), it, shm); }
                    else if (it < n_f2 + n_h3) hgrn3_item(KP(), ps, l, it - n_f2, shm);
                    else gmlp_item(KP(), l, it - n_f2 - n_h3, shm);
                }
                gsync(lds3);
            }
            _Pragma("nounroll") for (int rep = 0; rep < REP_DE; ++rep) {
            {
                unsigned char* ws = opaque(KP().ws);
                pg8::Gemm g; g.A = (const u16*)(ws + OFF_Y); g.Bt = (const u16*)(ws + OFF_WTBR) + (size_t)l * 4 * 1024 * 512; g.M = ps.M; g.N = 1024; g.K = 512;
                g.rsA = (size_t)MLAT * 512 * 2; g.rsB = (size_t)1024 * 512 * 2;
                MergeOrder S; S.init(ps.M, 1024, (int)gridDim.x, (int)blockIdx.x);
                EpiMerge E; E.ws = ws;

                pg8::gemm_phase<EpiMerge, MergeOrder, false>(lds3, g, S, E, nullptr);
            }
            gsync(lds3);
            if (REP_DE > 1 && rep + 1 < REP_DE) continue;
            {
                unsigned char* ws = opaque(KP().ws);
                EpiOut E; E.C = (u16*)(ws + OFF_OUT);
                run_gemm(lds3, (const u16*)(ws + OFF_MB), (const u16*)(ws + OFF_WTOUT) + (size_t)l * 1024 * 1024, ps.M, 1024, 1024, E);
            }
            gsync(lds3);
            }
        }
        if (!ps.is_ctx) phase_norm(KP(), ps, DEPTH);
    }
}

static_assert(WS_END2 <= (size_t)1073741824, "workspace map exceeds 1 GiB");

extern "C" void kernel_launch(void* const* d_in, const int* in_sizes, int n_in, void* d_out, int out_size, void* d_ws, size_t ws_size, hipStream_t stream) {
    static int grid_blocks = 0;
    if (grid_blocks == 0) {
        if (n_in != 18 || ws_size < WS_END2) { fprintf(stderr, "kernel_launch: unexpected n_in %d or ws_size %zu (need %zu)\n", n_in, ws_size, (size_t)WS_END2); grid_blocks = -1; return; }
        int dev = 0, cus = 0, per_cu = 0;
        hipGetDevice(&dev);
        hipDeviceGetAttribute(&cus, hipDeviceAttributeMultiprocessorCount, dev);
        if (hipFuncSetAttribute((const void*)mega_fwd, hipFuncAttributeMaxDynamicSharedMemorySize, LDS_BYTES + 16) != hipSuccess) { fprintf(stderr, "kernel_launch: hipFuncSetAttribute failed\n"); grid_blocks = -1; return; }
        hipOccupancyMaxActiveBlocksPerMultiprocessor(&per_cu, (const void*)mega_fwd, 512, LDS_BYTES + 16);
        if (per_cu < 1) { fprintf(stderr, "kernel_launch: occupancy query gave %d\n", per_cu); per_cu = 1; }
        (void)hipGetLastError();
        grid_blocks = cus * per_cu;
    }
    if (grid_blocks < 0) return;
    Params p{};
    const float** pp = (const float**)&p;
    for (int i = 0; i < 18; ++i) pp[i] = (const float*)d_in[i];
    p.out = (float*)d_out; p.ws = (unsigned char*)d_ws;
    void* args[] = {&p};
    hipError_t e = hipLaunchCooperativeKernel((const void*)mega_fwd, dim3(grid_blocks), dim3(512), args, LDS_BYTES + 16, stream);
    if (e != hipSuccess) fprintf(stderr, "cooperative launch failed: %s (grid %d)\n", hipGetErrorString(e), grid_blocks);
}
```

```cpp
#include <hip/hip_runtime.h>
#include <hip/hip_cooperative_groups.h>
#include <cstdio>
namespace cg = cooperative_groups;
__device__ __forceinline__ int tidx() { int t = threadIdx.x; asm volatile("" : "+v"(t)); return t; }
template <class T> __device__ __forceinline__ T* opaque(T* p) {
    unsigned long long v = (unsigned long long)p; const unsigned lo = __builtin_amdgcn_readfirstlane((unsigned)v), hi = __builtin_amdgcn_readfirstlane((unsigned)(v >> 32));
    v = ((unsigned long long)hi << 32) | lo; asm volatile("" : "+s"(v)); return (T*)((__attribute__((address_space(1))) T*)v); }
__device__ __forceinline__ float shx(float v, int m) { const int lane = tidx() & 63; return __int_as_float(__builtin_amdgcn_ds_bpermute((lane ^ m) << 2, __float_as_int(v))); }
namespace pg8 {
#define PG8_LAS __attribute__((address_space(3)))
typedef unsigned short bf16_t;
typedef short bf16x8 __attribute__((ext_vector_type(8)));
typedef float f32x4 __attribute__((ext_vector_type(4)));
typedef unsigned u32x4 __attribute__((ext_vector_type(4)));
constexpr int BM = 256, BK = 64, HALF = 128, HTB = HALF * BK * 2  , STAGE_BYTES = 8 * HTB, NXCD = 8, WGM = 8;

__host__ __device__ __forceinline__ int lds_byte(int r, int c) { const int st = (r >> 4) * 2 + (c >> 5), rr = r & 15, cc = c & 31, ob = rr * 64 + cc * 2; return st * 1024 + (ob ^ (((ob >> 9) & 1) << 5)); }
__host__ __device__ __forceinline__ void stage_rc(int b, int& R, int& C) { const int st = b / 1024, sb = b % 1024, swz = sb ^ (((sb >> 9) & 1) << 5); R = (st >> 1) * 16 + swz / 64; C = (st & 1) * 32 + (swz % 64) / 2; }
__host__ __device__ __forceinline__ int perm32(int rho) { const int n = rho >> 4, i = rho & 15; return 8 * (i >> 2) + 4 * n + (i & 3); }

struct Unit { int pm, pn, r; };
struct Gemm { const bf16_t* A; const bf16_t* Bt; int M, N, K; size_t rsA, rsB; };

struct StaticOrder {
    int nM, nN, nwg, G, c;
    __host__ __device__ void init(int M, int N, int G_, int c_) { nM = M / BM; nN = N / BM; nwg = nM * nN; G = G_; c = c_; }
    __host__ __device__ bool next(int i, Unit& u) const {
        const long L = (long)i * G + c; if (L >= nwg) return false;
        int wgid = (int)L; { const int q = nwg / NXCD, r = nwg % NXCD, xcd = wgid % NXCD, off = wgid / NXCD; wgid = (xcd < r ? xcd * (q + 1) : r * (q + 1) + (xcd - r) * q) + off; }
        const int nig = WGM * nN, gid = wgid / nig, fm = gid * WGM, gsz = (nM - fm) < WGM ? (nM - fm) : WGM;
        u.pm = fm + ((wgid % nig) % gsz); u.pn = (wgid % nig) / gsz; u.r = 0; return true;
    }
    __device__ __forceinline__ void a_ready(const Unit&) const {}
    __device__ __forceinline__ void done(const Unit&) const {}
};
__device__ __forceinline__ unsigned cvt_pk_bf16(float lo, float hi) { unsigned r; asm volatile("v_cvt_pk_bf16_f32 %0, %1, %2" : "=v"(r) : "v"(lo), "v"(hi)); return r; }

template <class Epi, class Sched, bool STAMP = false>
__device__ __forceinline__ void gemm_phase(PG8_LAS unsigned char* lds, const Gemm g, const Sched& S, const Epi& E, unsigned long long* stamps) {
    const int tid = tidx(), wid = __builtin_amdgcn_readfirstlane(tid >> 6), lane = tid & 63, wr = wid >> 2, wc = wid & 3, fr = lane & 15, fq = lane >> 4;
    const int K = g.K, nt = K / BK;
    int ts_lo = 0, ts_hi = 0, nts = 0; const unsigned long long rt_entry = STAMP ? (unsigned long long)wall_clock64() : 0ull;
#define PG8_STAMP() do { if (STAMP && wid == 0 && nts < 64) { const unsigned long long _c = (unsigned long long)clock64(); \
        ts_lo = (lane == nts) ? (int)(unsigned)_c : ts_lo; ts_hi = (lane == nts) ? (int)(unsigned)(_c >> 32) : ts_hi; ++nts; } } while (0)
    PG8_STAMP();
    unsigned voffA[2], voffB[2];
#pragma unroll
    for (int i = 0; i < 2; ++i) { int R, C; stage_rc(tid * 16 + i * 8192, R, C); const int Rb = Epi::PERM ? ((R & ~31) + perm32(R & 31)) : R;
        voffA[i] = (unsigned)(R * K + C) * 2u; voffB[i] = (unsigned)(Rb * K + C) * 2u; }
    const size_t kstep = (size_t)(BK * 2);
    const size_t hstep = (size_t)HALF * K * 2;
    const size_t tstep = 2 * hstep;
    const unsigned ldsw = (unsigned)wid * 1024u;
    const int aoff = lds_byte(wr * 64 + fr, fq * 8), boff = lds_byte(wc * 32 + fr, fq * 8);
#define PG8_SA(b, h) (((b) * 2 + (h)) * HTB)
#define PG8_SB(b, h) ((4 + (b) * 2 + (h)) * HTB)
#define PG8_STAGE(bufoff, gbase, voff) do { _Pragma("unroll") for (int _i = 0; _i < 2; ++_i) \
        __builtin_amdgcn_global_load_lds((const unsigned*)((const char*)(gbase) + (voff)[_i]), (PG8_LAS unsigned*)(lds + (bufoff) + ldsw + _i * 8192), 16, 0, 0); } while (0)
#define PG8_LDA(dst, b, h) do { _Pragma("unroll") for (int m = 0; m < 4; ++m) _Pragma("unroll") for (int k = 0; k < 2; ++k) dst[m][k] = *(const PG8_LAS bf16x8*)(lds + PG8_SA(b, h) + aoff + m * 2048 + k * 1024); } while (0)
#define PG8_LDB(dst, b, h) do { _Pragma("unroll") for (int n = 0; n < 2; ++n) _Pragma("unroll") for (int k = 0; k < 2; ++k) dst[n][k] = *(const PG8_LAS bf16x8*)(lds + PG8_SB(b, h) + boff + n * 2048 + k * 1024); } while (0)
#define PG8_MMA(ai, bj, At, Bt) do { __builtin_amdgcn_s_setprio(1); _Pragma("unroll") for (int m = 0; m < 4; ++m) _Pragma("unroll") for (int n = 0; n < 2; ++n) _Pragma("unroll") for (int k = 0; k < 2; ++k) \
        acc[ai][bj][m][n] = __builtin_amdgcn_mfma_f32_16x16x32_bf16(Bt[n][k], At[m][k], acc[ai][bj][m][n], 0, 0, 0); __builtin_amdgcn_s_setprio(0); } while (0)
#define PG8_WAIT_V(n) asm volatile("s_waitcnt vmcnt(" #n ")" ::: "memory")
#define PG8_WAIT_L(n) asm volatile("s_waitcnt lgkmcnt(" #n ")" ::: "memory")
#define PG8_BAR __builtin_amdgcn_s_barrier()
#define PG8_SCHED __builtin_amdgcn_sched_barrier(0)
    Unit cur, nxt; int ui = 0;
    if (!S.next(0, cur)) return;
    f32x4 acc[2][2][4][2];
#pragma unroll
    for (int a = 0; a < 2; ++a)
#pragma unroll
        for (int b = 0; b < 2; ++b)
#pragma unroll
            for (int m = 0; m < 4; ++m)
#pragma unroll
                for (int n = 0; n < 2; ++n) acc[a][b][m][n] = (f32x4){0.f, 0.f, 0.f, 0.f};
    bf16x8 At[4][2], B0[2][2], B1[2][2];
    const char* cA = (const char*)g.A + (size_t)cur.pm * tstep + (size_t)cur.r * g.rsA; const char* cB = (const char*)g.Bt + (size_t)cur.pn * tstep + (size_t)cur.r * g.rsB;
    S.a_ready(cur);
    PG8_STAGE(PG8_SB(0, 0), cB, voffB); PG8_STAGE(PG8_SA(0, 0), cA, voffA); PG8_STAGE(PG8_SB(0, 1), cB + hstep, voffB); PG8_STAGE(PG8_SA(0, 1), cA + hstep, voffA);
    if (wr == 1) PG8_BAR;
    PG8_WAIT_V(4); PG8_BAR;
    PG8_STAGE(PG8_SB(1, 0), cB + kstep, voffB); PG8_STAGE(PG8_SA(1, 0), cA + kstep, voffA); PG8_STAGE(PG8_SB(1, 1), cB + hstep + kstep, voffB);
    PG8_WAIT_V(6); PG8_BAR;
    PG8_STAMP();
    for (;;) {
        const bool has_next = S.next(ui + 1, nxt);
        const char* nA = has_next ? (const char*)g.A + (size_t)nxt.pm * tstep + (size_t)nxt.r * g.rsA : cA; const char* nB = has_next ? (const char*)g.Bt + (size_t)nxt.pn * tstep + (size_t)nxt.r * g.rsB : cB;
        for (int t = 0; t < nt; t += 2) {
            const bool last = (t == nt - 2);
            const char* a1 = cA + (size_t)(t + 1) * kstep;
            const char* a2 = last ? nA : cA + (size_t)(t + 2) * kstep; const char* b2 = last ? nB : cB + (size_t)(t + 2) * kstep;
            const char* a3 = a2 + kstep; const char* b3 = b2 + kstep;
            if (last && has_next) S.a_ready(nxt);
            PG8_LDB(B0, 0, 0); PG8_SCHED; PG8_LDA(At, 0, 0); PG8_STAGE(PG8_SA(1, 1), a1 + hstep, voffA);
            PG8_WAIT_L(8); PG8_BAR; PG8_WAIT_L(0); PG8_MMA(0, 0, At, B0); PG8_BAR; PG8_SCHED;
            PG8_LDB(B1, 0, 1); PG8_STAGE(PG8_SB(0, 0), b2, voffB);
            PG8_BAR; PG8_WAIT_L(0); PG8_MMA(0, 1, At, B1); PG8_BAR;
            PG8_LDA(At, 0, 1); PG8_STAGE(PG8_SA(0, 0), a2, voffA);
            PG8_BAR; PG8_WAIT_L(0); PG8_MMA(1, 0, At, B0); PG8_BAR; PG8_SCHED;
            PG8_STAGE(PG8_SB(0, 1), b2 + hstep, voffB);
            PG8_WAIT_V(6); PG8_BAR; PG8_MMA(1, 1, At, B1); PG8_BAR;
            PG8_LDB(B0, 1, 0); PG8_SCHED; PG8_LDA(At, 1, 0); PG8_STAGE(PG8_SA(0, 1), a2 + hstep, voffA);
            PG8_WAIT_L(8); PG8_BAR; PG8_WAIT_L(0); PG8_MMA(0, 0, At, B0); PG8_BAR; PG8_SCHED;
            PG8_LDB(B1, 1, 1); PG8_STAGE(PG8_SB(1, 0), b3, voffB);
            PG8_BAR; PG8_WAIT_L(0); PG8_MMA(0, 1, At, B1); PG8_BAR;
            PG8_LDA(At, 1, 1); PG8_STAGE(PG8_SA(1, 0), a3, voffA);
            PG8_BAR; PG8_WAIT_L(0); PG8_MMA(1, 0, At, B0); PG8_BAR; PG8_SCHED;
            PG8_STAGE(PG8_SB(1, 1), b3 + hstep, voffB);
            PG8_WAIT_V(6); PG8_BAR; PG8_MMA(1, 1, At, B1); PG8_BAR;
        }
        PG8_STAMP();
        if constexpr (!Epi::AFTER_DRAIN) { E(acc, cur, wr, wc, fr, fq); S.done(cur); }
        PG8_STAMP();
        if (!has_next) break;
#pragma unroll
        for (int a = 0; a < 2; ++a)
#pragma unroll
            for (int b = 0; b < 2; ++b)
#pragma unroll
                for (int m = 0; m < 4; ++m)
#pragma unroll
                    for (int n = 0; n < 2; ++n) acc[a][b][m][n] = (f32x4){0.f, 0.f, 0.f, 0.f};
        cur = nxt; cA = nA; cB = nB; ++ui;
    }
    PG8_WAIT_V(0);
    if (wr == 0) PG8_BAR;
    PG8_BAR;
    if constexpr (Epi::AFTER_DRAIN) { E.fused(acc, cur, wr, wc, fr, fq, lds, wid, lane); S.done(cur); }
    PG8_STAMP();
    if (STAMP && wid == 0) { stamps[lane] = lane < nts ? (((unsigned long long)(unsigned)ts_hi << 32) | (unsigned)ts_lo) : 0ull;
        if (lane == 62) stamps[62] = rt_entry; if (lane == 63) stamps[63] = (unsigned long long)wall_clock64(); }
#undef PG8_STAMP
#undef PG8_SA
#undef PG8_SB
#undef PG8_STAGE
#undef PG8_LDA
#undef PG8_LDB
#undef PG8_MMA
#undef PG8_WAIT_V
#undef PG8_WAIT_L
#undef PG8_BAR
#undef PG8_SCHED
}
}

typedef unsigned short u16;
typedef short s16x4 __attribute__((ext_vector_type(4)));
using pg8::bf16x8; using pg8::f32x4; using pg8::Unit;
#define LAS __attribute__((address_space(3)))
#define MFMA16(a, b, c) __builtin_amdgcn_mfma_f32_16x16x32_bf16(a, b, c, 0, 0, 0)

constexpr int DM = 1024, NBATCH = 16, SEQ = 4096, DEPTH = 4, CTXL = 256, NPROJ = 11776, NIN = 11264;
constexpr int GB = 4, MLAT = GB * SEQ, MCTX = NBATCH * CTXL;
constexpr int LDS_BYTES = 152 * 1024;
constexpr float LOG2E = 1.4426950408889634f;
constexpr float EPSN = 1e-6f;
constexpr float QSCALE = 0.125f * 1.4426950408889634f;

constexpr size_t al256(size_t x) { return (x + 255) & ~(size_t)255; }
constexpr size_t OFF_WTIN = 0;
constexpr size_t OFF_WTBR = OFF_WTIN + (size_t)DEPTH * NPROJ * DM * 2;
constexpr size_t OFF_WTOUT = OFF_WTBR + (size_t)DEPTH * 4 * 1024 * 512 * 2;
constexpr size_t OFF_WS16 = OFF_WTOUT + (size_t)DEPTH * 1024 * 1024 * 2;
constexpr size_t OFF_MOD = OFF_WS16 + (size_t)DEPTH * 8 * 128 * 128 * 2;
constexpr size_t OFF_LB = OFF_MOD + al256((size_t)DEPTH * 17 * 3072 * 4);
constexpr size_t OFF_ROPE = OFF_LB + (size_t)DEPTH * 2 * 512 * 4;
constexpr size_t OFF_TW = OFF_ROPE + 2 * 64 * 16 * 4;
constexpr size_t OFF_M1 = OFF_TW + 4096 * 8;
constexpr size_t OFF_M2 = OFF_M1 + 128 * 128 * 2;
constexpr size_t OFF_M3 = OFF_M2 + 64 * 128 * 2;
constexpr size_t OFF_CSW = OFF_M3 + 256 * 512 * 2;
constexpr size_t OFF_CTXW = OFF_CSW + (size_t)DEPTH * 4 * 2 * 128 * 128 * 4;
constexpr size_t OFF_CTXKV = OFF_CTXW + (size_t)NBATCH * CTXL * DM * 4;
constexpr size_t OFF_CTXST = OFF_CTXKV + (size_t)DEPTH * MCTX * 1024 * 2;
constexpr size_t OFF_H = OFF_CTXST + (size_t)DEPTH * 256 * 4096 * 4;
constexpr size_t OFF_PROJ = OFF_H + (size_t)MLAT * DM * 2;
constexpr size_t OFF_QROT = OFF_PROJ + (size_t)MLAT * NPROJ * 2;
constexpr size_t OFF_LOGF = OFF_QROT + (size_t)MLAT * 512 * 2;
constexpr size_t OFF_Y = OFF_LOGF + (size_t)MLAT * 1024 * 4;
constexpr size_t OFF_FY = OFF_Y + (size_t)4 * MLAT * 512 * 2;
constexpr size_t OFF_HL = OFF_FY + (size_t)GB * 4096 * 1024 * 2;
constexpr size_t OFF_HD = OFF_HL + (size_t)4096 * 4096 * 4;
constexpr size_t OFF_HS = OFF_HD + (size_t)4096 * 64 * 4;
constexpr size_t OFF_MB = OFF_HS + (size_t)4096 * 4096 * 4;
constexpr size_t WS_END = OFF_MB + (size_t)MLAT * DM * 2;
constexpr size_t OFF_MERGED = OFF_LOGF;
constexpr size_t OFF_OUT = OFF_PROJ;

struct Params {
    const float *x, *c, *ctx, *c_ctx, *w_ada, *b_ada, *g_pre, *g_post, *w_in, *rpb, *fnet_w, *gmlp_g, *gmlp_ws, *gmlp_bs, *lb_logits, *hgrn_g, *w_branch, *w_out;
    float* out; unsigned char* ws;
};
struct PassInfo { int is_ctx, nb, T, M, b0; };

__device__ __forceinline__ u16 f2bf(float f) { unsigned u = __float_as_uint(f); u += 0x7FFFu + ((u >> 16) & 1u); return (u16)(u >> 16); }
__device__ __forceinline__ float bf2f(u16 b) { return __uint_as_float(((unsigned)b) << 16); }
typedef __bf16 bf16x2_t_ __attribute__((ext_vector_type(2)));
typedef float f32x2_t_ __attribute__((ext_vector_type(2)));
__device__ __forceinline__ unsigned pack2(float a, float b) { f32x2_t_ v = {a, b}; bf16x2_t_ r = __builtin_convertvector(v, bf16x2_t_); return __builtin_bit_cast(unsigned, r); }
__device__ __forceinline__ float bflo(unsigned w) { return __uint_as_float(w << 16); }
__device__ __forceinline__ float bfhi(unsigned w) { return __uint_as_float(w & 0xFFFF0000u); }
__device__ __forceinline__ float sigmoidf_(float v) { return __builtin_amdgcn_rcpf(1.f + __builtin_amdgcn_exp2f(-LOG2E * v)); }
__device__ __forceinline__ float siluf_(float v) { return v * __builtin_amdgcn_rcpf(1.f + __builtin_amdgcn_exp2f(-LOG2E * v)); }
__device__ __forceinline__ void unpack8(uint4 w, float* f) { f[0] = bflo(w.x); f[1] = bfhi(w.x); f[2] = bflo(w.y); f[3] = bfhi(w.y); f[4] = bflo(w.z); f[5] = bfhi(w.z); f[6] = bflo(w.w); f[7] = bfhi(w.w); }
__device__ __forceinline__ bf16x8 tr_read2(const u16* p0, const u16* p1) {
    s16x4 a = __builtin_amdgcn_ds_read_tr16_b64_v4i16((LAS s16x4*)p0);
    s16x4 b = __builtin_amdgcn_ds_read_tr16_b64_v4i16((LAS s16x4*)p1);
    return (bf16x8){a[0], a[1], a[2], a[3], b[0], b[1], b[2], b[3]};
}
__device__ __forceinline__ bf16x8 ld_frag_g(const u16* p) { return *(const bf16x8*)p; }

typedef unsigned u32x4_ __attribute__((ext_vector_type(4)));
__device__ __forceinline__ void nt_store16(uint4 w, void* p) { __builtin_nontemporal_store((u32x4_){w.x, w.y, w.z, w.w}, (u32x4_*)p); }
struct EpiProj {
    static constexpr bool PERM = true, AFTER_DRAIN = false;
    unsigned char* ws; int l; int is_ctx;
    __device__ __forceinline__ void operator()(const f32x4 (&acc)[2][2][4][2], const Unit& u, int wr, int wc, int fr, int fq) const {
        u16* proj = (u16*)(ws + OFF_PROJ);
        const int blk = u.pn >> 1;
        const int row0 = u.pm * 256 + wr * 64 + fr, col0 = u.pn * 256 + wc * 32 + 8 * fq;
        u16* pbase = proj + ((size_t)blk * MLAT + row0) * 512 + (col0 & 511);
        if ((blk == 0 || blk == 1) && !is_ctx) {
            u16* qrot = (u16*)(ws + OFF_QROT); const float* rope = (const float*)(ws + OFF_ROPE);
            const int f0 = 8 * (fq & 1); const float sgn = (fq >> 1) ? 1.f : -1.f;
#pragma unroll
            for (int ai = 0; ai < 2; ++ai)
#pragma unroll
                for (int m = 0; m < 4; ++m) {
                    const int row = row0 + ai * 128 + m * 16;
                    const int t = row & 4095, pos = (wc & 1) ? (t & 63) : (t >> 6);
                    const float4 c0 = *(const float4*)(rope + pos * 16 + f0), c1 = *(const float4*)(rope + pos * 16 + f0 + 4);
                    const float4 s0 = *(const float4*)(rope + 1024 + pos * 16 + f0), s1 = *(const float4*)(rope + 1024 + pos * 16 + f0 + 4);
                    const float cs[8] = {c0.x, c0.y, c0.z, c0.w, c1.x, c1.y, c1.z, c1.w}, sn[8] = {s0.x, s0.y, s0.z, s0.w, s1.x, s1.y, s1.z, s1.w};
#pragma unroll
                    for (int bj = 0; bj < 2; ++bj) {
                        const f32x4 v0 = acc[ai][bj][m][0], v1 = acc[ai][bj][m][1];
                        const float qs_ = (blk == 0) ? QSCALE : 1.f;
                        const float o[8] = {v0[0] * qs_, v0[1] * qs_, v0[2] * qs_, v0[3] * qs_, v1[0] * qs_, v1[1] * qs_, v1[2] * qs_, v1[3] * qs_};
                        float r[8];
#pragma unroll
                        for (int e = 0; e < 8; ++e) { const float pr = shx(o[e], 32); r[e] = o[e] * cs[e] + sgn * pr * sn[e]; }
                        uint4 wr_; wr_.x = pack2(r[0], r[1]); wr_.y = pack2(r[2], r[3]); wr_.z = pack2(r[4], r[5]); wr_.w = pack2(r[6], r[7]);
                        u16* dst = pbase + (size_t)(ai * 128 + m * 16) * 512 + bj * 128;
                        if (blk == 0) {
                            uint4 wp; wp.x = pack2(o[0], o[1]); wp.y = pack2(o[2], o[3]); wp.z = pack2(o[4], o[5]); wp.w = pack2(o[6], o[7]);
                            nt_store16(wp, dst);
                            nt_store16(wr_, qrot + (size_t)row * 512 + (col0 & 511) + bj * 128);
                        } else nt_store16(wr_, dst);
                    }
                }
        } else if (blk == 11 || blk == 12) {
            float* logf = (float*)(ws + OFF_LOGF); const float* lb = (const float*)(ws + OFF_LB) + l * 1024;
            const int dir = blk - 11;
#pragma unroll
            for (int bj = 0; bj < 2; ++bj) {
                const int cc = (col0 & 511) + bj * 128;
                const float4 l0 = *(const float4*)(lb + dir * 512 + cc), l1 = *(const float4*)(lb + dir * 512 + cc + 4);
                const float lbv[8] = {l0.x, l0.y, l0.z, l0.w, l1.x, l1.y, l1.z, l1.w};
#pragma unroll
                for (int ai = 0; ai < 2; ++ai)
#pragma unroll
                    for (int m = 0; m < 4; ++m) {
                        const int row = row0 + ai * 128 + m * 16;
                        const f32x4 v0 = acc[ai][bj][m][0], v1 = acc[ai][bj][m][1];
                        const float z[8] = {v0[0], v0[1], v0[2], v0[3], v1[0], v1[1], v1[2], v1[3]};
                        float lf[8], o[8];
#pragma unroll
                        for (int e = 0; e < 8; ++e) {
                            const float ez = __expf(-z[e]);
                            const float inv = __builtin_amdgcn_rcpf(1.f + ez);
                            const float sg = inv, sgn_ = (ez > 1e30f) ? 1.f : ez * inv;
                            const float f = lbv[e] + (1.f - lbv[e]) * sg;
                            lf[e] = __logf(fmaxf(f, 1e-30f));
                            o[e] = (1.f - lbv[e]) * sgn_;
                        }
                        float* lp = logf + (size_t)row * 1024 + dir * 512 + cc;
                        __builtin_nontemporal_store((f32x4){lf[0], lf[1], lf[2], lf[3]}, (f32x4*)lp); __builtin_nontemporal_store((f32x4){lf[4], lf[5], lf[6], lf[7]}, (f32x4*)(lp + 4));
                        uint4 w; w.x = pack2(o[0], o[1]); w.y = pack2(o[2], o[3]); w.z = pack2(o[4], o[5]); w.w = pack2(o[6], o[7]);
                        nt_store16(w, pbase + (size_t)(ai * 128 + m * 16) * 512 + bj * 128);
                    }
            }
        } else {
            const bool copy = is_ctx && (blk == 1 || blk == 2);
            const float qs_ = (blk == 0) ? QSCALE : 1.f;
            u16* cbase = (u16*)(ws + OFF_CTXKV) + (size_t)l * MCTX * 1024 + (size_t)row0 * 1024 + (blk - 1) * 512 + (col0 & 511);
            if (!copy) {
#pragma unroll
                for (int ai = 0; ai < 2; ++ai)
#pragma unroll
                    for (int m = 0; m < 4; ++m)
#pragma unroll
                        for (int bj = 0; bj < 2; ++bj) {
                            const f32x4 v0 = acc[ai][bj][m][0], v1 = acc[ai][bj][m][1];
                            uint4 w; w.x = pack2(v0[0] * qs_, v0[1] * qs_); w.y = pack2(v0[2] * qs_, v0[3] * qs_); w.z = pack2(v1[0] * qs_, v1[1] * qs_); w.w = pack2(v1[2] * qs_, v1[3] * qs_);
                            nt_store16(w, pbase + (size_t)(ai * 128 + m * 16) * 512 + bj * 128);
                        }
            } else {
#pragma unroll
                for (int ai = 0; ai < 2; ++ai)
#pragma unroll
                    for (int m = 0; m < 4; ++m)
#pragma unroll
                        for (int bj = 0; bj < 2; ++bj) {
                            const f32x4 v0 = acc[ai][bj][m][0], v1 = acc[ai][bj][m][1];
                            uint4 w; w.x = pack2(v0[0], v0[1]); w.y = pack2(v0[2], v0[3]); w.z = pack2(v1[0], v1[1]); w.w = pack2(v1[2], v1[3]);
                            nt_store16(w, pbase + (size_t)(ai * 128 + m * 16) * 512 + bj * 128);
                            *(uint4*)(cbase + (size_t)(ai * 128 + m * 16) * 1024 + bj * 128) = w;
                        }
            }
        }
    }
};
struct EpiMerge {
    static constexpr bool PERM = true, AFTER_DRAIN = false;
    unsigned char* ws;
    template <int MODE> __device__ __forceinline__ void run(const f32x4 (&acc)[2][2][4][2], const Unit& u, int wr, int wc, int fr, int fq) const {
        const u16* proj = (const u16*)(ws + OFF_PROJ); u16* mb = (u16*)(ws + OFF_MB);
        const int row0 = u.pm * 256 + wr * 64 + fr, col0 = u.pn * 256 + wc * 32 + 8 * fq, R = u.r;
        const int gcol0 = 7680 + R * 1024 + col0;
        const u16* gbase = proj + ((size_t)(gcol0 >> 9) * MLAT + row0) * 512 + (gcol0 & 511);
        u16* obase = mb + (size_t)row0 * 1024 + col0;
        uint4 g[2][4], old[2][4];
#define MG_LOAD(st, buf) do { _Pragma("unroll") for (int q = 0; q < 4; ++q) { const int ai_ = (st) >> 1, m_ = ((st) & 1) * 2 + (q >> 1), co_ = (q & 1) * 128; const size_t ro_ = (size_t)(ai_ * 128 + m_ * 16); \
            g[buf][q] = *(const uint4*)(gbase + ro_ * 512 + co_); if (MODE > 0) old[buf][q] = *(const uint4*)(obase + ro_ * 1024 + co_); } } while (0)
        MG_LOAD(0, 0);
#pragma unroll
        for (int st = 0; st < 4; ++st) {
            const int buf = st & 1;
            if (st + 1 < 4) MG_LOAD(st + 1, buf ^ 1);
            __builtin_amdgcn_sched_barrier(0);
#pragma unroll
            for (int q = 0; q < 4; ++q) { const int ai = st >> 1, m = (st & 1) * 2 + (q >> 1), bj = q & 1, co = bj * 128; const size_t ro = (size_t)(ai * 128 + m * 16);
                const f32x4 v0 = acc[ai][bj][m][0], v1 = acc[ai][bj][m][1];
                float gf[8]; unpack8(g[buf][q], gf);
                float o[8] = {v0[0] * sigmoidf_(gf[0]), v0[1] * sigmoidf_(gf[1]), v0[2] * sigmoidf_(gf[2]), v0[3] * sigmoidf_(gf[3]), v1[0] * sigmoidf_(gf[4]), v1[1] * sigmoidf_(gf[5]), v1[2] * sigmoidf_(gf[6]), v1[3] * sigmoidf_(gf[7])};
                if (MODE > 0) { float of[8]; unpack8(old[buf][q], of);
#pragma unroll
                    for (int e = 0; e < 8; ++e) o[e] += of[e]; }
                uint4 w; w.x = pack2(o[0], o[1]); w.y = pack2(o[2], o[3]); w.z = pack2(o[4], o[5]); w.w = pack2(o[6], o[7]);
                *(uint4*)(obase + ro * 1024 + co) = w; }
        }
#undef MG_LOAD
    }
    __device__ __forceinline__ void operator()(const f32x4 (&acc)[2][2][4][2], const Unit& u, int wr, int wc, int fr, int fq) const {
        if (u.r == 0) run<0>(acc, u, wr, wc, fr, fq);
        else run<1>(acc, u, wr, wc, fr, fq);
    }
};
struct EpiOut {
    static constexpr bool PERM = true, AFTER_DRAIN = false;
    u16* C;
    __device__ __forceinline__ void operator()(const f32x4 (&acc)[2][2][4][2], const Unit& u, int wr, int wc, int fr, int fq) const {
        const int row0 = u.pm * 256 + wr * 64 + fr, col0 = u.pn * 256 + wc * 32 + 8 * fq;
#pragma unroll
        for (int ai = 0; ai < 2; ++ai)
#pragma unroll
            for (int m = 0; m < 4; ++m) { u16* rowp = C + (size_t)(row0 + ai * 128 + m * 16) * 1024 + col0;
#pragma unroll
                for (int bj = 0; bj < 2; ++bj) { const f32x4 v0 = acc[ai][bj][m][0], v1 = acc[ai][bj][m][1];
                    uint4 w; w.x = pack2(v0[0], v0[1]); w.y = pack2(v0[2], v0[3]); w.z = pack2(v1[0], v1[1]); w.w = pack2(v1[2], v1[3]); *(uint4*)(rowp + bj * 128) = w; } }
    }
};

__device__ void transpose_tile(const float* src, int lds_, u16* dst, int ldd, int k0, int n0s, int n0d, u16* t) {
    const int tid = tidx();
#pragma unroll
    for (int it = 0; it < 2; ++it) {
        const int kk = (tid >> 4) + it * 32, nn = (tid & 15) * 4;
        const float4 v = *(const float4*)(src + (size_t)(k0 + kk) * lds_ + n0s + nn);
        t[(nn + 0) * 72 + kk] = f2bf(v.x); t[(nn + 1) * 72 + kk] = f2bf(v.y); t[(nn + 2) * 72 + kk] = f2bf(v.z); t[(nn + 3) * 72 + kk] = f2bf(v.w);
    }
    __syncthreads();
    { const int n = tid >> 3, k8 = (tid & 7) * 8;
      const uint4 v = *(const uint4*)(t + n * 72 + k8);
      *(uint4*)(dst + (size_t)(n0d + n) * ldd + k0 + k8) = v; }
    __syncthreads();
}

__device__ void prep1(const Params& p, unsigned char* lds) {
    unsigned char* ws = opaque(p.ws);
    const int tid = tidx();
    const size_t gt = (size_t)blockIdx.x * 512 + tid, gn = (size_t)gridDim.x * 512;
    { u16* ws16 = (u16*)(ws + OFF_WS16);
      for (size_t i = gt; i < (size_t)DEPTH * 8 * 128 * 128; i += gn) ws16[i] = f2bf(p.gmlp_ws[i]);
      float* lbp = (float*)(ws + OFF_LB);
      for (size_t i = gt; i < 1024; i += gn) {
          float e[DEPTH], mx = -1e30f, sum = 0.f;
#pragma unroll
          for (int l = 0; l < DEPTH; ++l) { e[l] = p.lb_logits[l * 1024 + i]; mx = fmaxf(mx, e[l]); }
#pragma unroll
          for (int l = 0; l < DEPTH; ++l) { e[l] = expf(e[l] - mx); sum += e[l]; }
          float run = 0.f;
#pragma unroll
          for (int l = 0; l < DEPTH; ++l) { if (l > 0) run += e[l] / sum; lbp[l * 1024 + i] = fmaxf(run, 0.f); }
      }
      float* rope = (float*)(ws + OFF_ROPE);
      for (size_t i = gt; i < 1024; i += gn) { const int pos = (int)(i >> 4), f = (int)(i & 15);
          const float inv = powf(10000.f, -(float)f * 2.0f / 32.0f), ang = (float)pos * inv;
          rope[i] = cosf(ang); rope[1024 + i] = sinf(ang); }
      float* tw = (float*)(ws + OFF_TW);
      for (size_t i = gt; i < 4096; i += gn) { float s, c; sincospif((float)i * (2.0f / 4096.0f), &s, &c); tw[2 * i] = c; tw[2 * i + 1] = s; }
      u16* m1 = (u16*)(ws + OFF_M1);
      for (size_t i = gt; i < 128 * 128; i += gn) { const int ii = (int)(i >> 7), kk = (int)(i & 127), k1 = ii >> 1, po = ii & 1, n1 = kk >> 1, pi = kk & 1;
          float s, c; sincospif((float)((k1 * n1) & 63) * (2.0f / 64.0f), &s, &c);
          const float v = (po == 0) ? (pi == 0 ? c : -s) : (pi == 0 ? -s : -c);
          m1[i] = f2bf(v); }
      u16* m2 = (u16*)(ws + OFF_M2);
      for (size_t i = gt; i < 64 * 128; i += gn) { const int k2 = (int)(i >> 7), kk = (int)(i & 127), n2 = kk >> 1, pi = kk & 1;
          float s, c; sincospif((float)((k2 * n2) & 63) * (2.0f / 64.0f), &s, &c);
          m2[i] = f2bf(pi == 0 ? c : s); }
      u16* m3 = (u16*)(ws + OFF_M3);
      for (size_t i = gt; i < 256 * 512; i += gn) { const int k = (int)(i >> 9), kk = (int)(i & 511), n = kk >> 1, pi = kk & 1;
          float s, c; sincospif((float)((k * n) & 255) * (2.0f / 256.0f), &s, &c);
          m3[i] = f2bf(pi == 0 ? c : -s); }
    }
    constexpr int N_WIN = DEPTH * 176 * 16, N_WBR = 16 * 16 * 8, N_WOUT = DEPTH * 16 * 16, N_MOD = DEPTH * 48, N_CSW = DEPTH * 4 * 2 * 2;
    constexpr int TOT = N_WIN + N_WBR + N_WOUT + N_MOD + N_CSW;
    for (int it = blockIdx.x; it < TOT; it += gridDim.x) {
        int idx = it;
        if (idx < N_WIN) {
            const int l = idx / 2816, rem = idx % 2816, cb = rem >> 4, kb = rem & 15, n0 = cb * 64;
            if (n0 >= 2048 && n0 < 2560) continue;
            const int n0d = n0 < 2048 ? n0 : n0 + 512;
            transpose_tile(p.w_in + (size_t)l * DM * NIN, NIN, (u16*)(ws + OFF_WTIN) + (size_t)l * NPROJ * DM, DM, kb * 64, n0, n0d, (u16*)lds);
            continue;
        }
        idx -= N_WIN;
        if (idx < N_WBR) {
            const int mat = idx >> 7, rem = idx & 127, cb = rem >> 3, kb = rem & 7;
            transpose_tile(p.w_branch + (size_t)mat * 512 * 1024, 1024, (u16*)(ws + OFF_WTBR) + (size_t)mat * 1024 * 512, 512, kb * 64, cb * 64, cb * 64, (u16*)lds);
            continue;
        }
        idx -= N_WBR;
        if (idx < N_WOUT) {
            const int l = idx >> 8, rem = idx & 255, cb = rem >> 4, kb = rem & 15;
            transpose_tile(p.w_out + (size_t)l * 1024 * 1024, 1024, (u16*)(ws + OFF_WTOUT) + (size_t)l * 1024 * 1024, 1024, kb * 64, cb * 64, cb * 64, (u16*)lds);
            continue;
        }
        idx -= N_WOUT;
        if (idx < N_MOD) {
            const int l = idx / 48, cb = idx % 48;
            float* s = (float*)lds; float* red = s + 17 * 1024;
            for (int i = tid; i < 17 * 1024; i += 512) { const int j = i >> 10, k = i & 1023; const float v = j < 16 ? p.c[j * 1024 + k] : p.c_ctx[k]; s[i] = v / (1.f + expf(-v)); }
            __syncthreads();
            const int col = tid & 63, ks = tid >> 6;
            float acc[17];
#pragma unroll
            for (int j = 0; j < 17; ++j) acc[j] = 0.f;
            for (int k = ks * 128; k < ks * 128 + 128; ++k) {
                const float w = p.w_ada[((size_t)l * 1024 + k) * 3072 + cb * 64 + col];
#pragma unroll
                for (int j = 0; j < 17; ++j) acc[j] += s[j * 1024 + k] * w;
            }
#pragma unroll
            for (int j = 0; j < 17; ++j) red[(ks * 17 + j) * 64 + col] = acc[j];
            __syncthreads();
            for (int o = tid; o < 17 * 64; o += 512) { const int j = o >> 6, cc = o & 63; float sum = 0.f;
                for (int q = 0; q < 8; ++q) sum += red[(q * 17 + j) * 64 + cc];
                ((float*)(ws + OFF_MOD))[((size_t)l * 17 + j) * 3072 + cb * 64 + cc] = sum + p.b_ada[l * 3072 + cb * 64 + cc]; }
            __syncthreads();
            continue;
        }
        idx -= N_MOD;
        {
            const int cblk = idx & 1, part = (idx >> 1) & 1, g = (idx >> 2) & 3, l = idx >> 4;
            float* tb = (float*)lds;
            if (tid < 128) { float s, c; sincospif((float)tid * (2.0f / 128.0f), &s, &c); tb[tid] = part ? s : c; }
            __syncthreads();
            const int d = tid & 127, cq = tid >> 7;
            float acc[16];
#pragma unroll
            for (int i = 0; i < 16; ++i) acc[i] = 0.f;
            const float* wf = p.fnet_w + ((size_t)(l * 4 + g) * 128) * 128;
            for (int c2 = 0; c2 < 128; ++c2) {
                const float w = wf[c2 * 128 + d];
#pragma unroll
                for (int i = 0; i < 16; ++i) { const int c = cblk * 64 + cq * 16 + i; acc[i] += tb[(c * c2) & 127] * w; }
            }
            float* dst = (float*)(ws + OFF_CSW) + ((size_t)((l * 4 + g) * 2 + part) * 128) * 128;
#pragma unroll
            for (int i = 0; i < 16; ++i) dst[(cblk * 64 + cq * 16 + i) * 128 + d] = acc[i];
            __syncthreads();
        }
    }
}

__device__ void prep2(const Params& p, unsigned char* lds) {
    unsigned char* ws = opaque(p.ws);
    const int tid = tidx();
    float* wb = (float*)lds;
    float* cw = wb + 64 * 129;
    for (int it = blockIdx.x; it < DEPTH * 4 * 2 * 16; it += gridDim.x) {
        const int kb = it & 15, part = (it >> 4) & 1, g = (it >> 5) & 3, l = it >> 7;
        for (int i = tid; i < 64 * 128; i += 512) { const int kk = i >> 7, c = i & 127; wb[kk * 129 + c] = p.w_in[((size_t)l * 1024 + kb * 64 + kk) * NIN + 2048 + g * 128 + c]; }
        const float* src = (const float*)(ws + OFF_CSW) + ((size_t)((l * 4 + g) * 2 + part) * 128) * 128;
        for (int i = tid; i < 128 * 128; i += 512) cw[i] = src[i];
        __syncthreads();
        const int d = tid & 127, kq = tid >> 7;
        float acc[16];
#pragma unroll
        for (int i = 0; i < 16; ++i) acc[i] = 0.f;
        for (int c = 0; c < 128; ++c) {
            const float w = cw[c * 128 + d];
#pragma unroll
            for (int i = 0; i < 16; ++i) acc[i] += wb[(kq * 16 + i) * 129 + c] * w;
        }
        u16* dst = (u16*)(ws + OFF_WTIN) + ((size_t)l * NPROJ + (4 + part) * 512 + g * 128 + d) * DM + kb * 64 + kq * 16;
        uint4 w0, w1;
        w0.x = pack2(acc[0], acc[1]); w0.y = pack2(acc[2], acc[3]); w0.z = pack2(acc[4], acc[5]); w0.w = pack2(acc[6], acc[7]);
        w1.x = pack2(acc[8], acc[9]); w1.y = pack2(acc[10], acc[11]); w1.z = pack2(acc[12], acc[13]); w1.w = pack2(acc[14], acc[15]);
        *(uint4*)dst = w0; *(uint4*)(dst + 8) = w1;
        __syncthreads();
    }
}

__device__ void phase_norm(const Params& p, const PassInfo ps, int l) {
    unsigned char* ws = opaque(p.ws);
    const int wave = tidx() >> 6, lane = tidx() & 63;
    const float* mod = (const float*)(ws + OFF_MOD);
    const u16* OUT = (const u16*)(ws + OFF_OUT);
    u16* H = (u16*)(ws + OFF_H);
    for (int rr = blockIdx.x * 8 + wave; rr < ps.M; rr += gridDim.x * 8) {
        const int tsh = ps.is_ctx ? 8 : 12; const int b = ps.b0 + (rr >> tsh), t = rr & (ps.T - 1), mrow = ps.is_ctx ? 16 : b;
        const size_t xoff = ((size_t)b * ps.T + t) * 1024;
        const float* xin = (l <= 1) ? ((ps.is_ctx ? p.ctx : p.x) + xoff) : ((ps.is_ctx ? (const float*)(ws + OFF_CTXW) : (const float*)p.out) + xoff);
        float* xout = (ps.is_ctx ? (float*)(ws + OFF_CTXW) : p.out) + xoff;
        float xv[16];
#pragma unroll
        for (int hlf = 0; hlf < 2; ++hlf) {
            const int c0 = hlf * 512 + lane * 8;
            const float4 a = *(const float4*)(xin + c0), bq = *(const float4*)(xin + c0 + 4);
            xv[hlf * 8 + 0] = a.x; xv[hlf * 8 + 1] = a.y; xv[hlf * 8 + 2] = a.z; xv[hlf * 8 + 3] = a.w;
            xv[hlf * 8 + 4] = bq.x; xv[hlf * 8 + 5] = bq.y; xv[hlf * 8 + 6] = bq.z; xv[hlf * 8 + 7] = bq.w;
        }
        if (l > 0) {
            float ov[16]; float ss = 0.f;
#pragma unroll
            for (int hlf = 0; hlf < 2; ++hlf) {
                const int c0 = hlf * 512 + lane * 8;
                unpack8(*(const uint4*)(OUT + (size_t)rr * 1024 + c0), ov + hlf * 8);
            }
#pragma unroll
            for (int e = 0; e < 16; ++e) ss += ov[e] * ov[e];
#pragma unroll
            for (int o = 32; o > 0; o >>= 1) ss += shx(ss, o);
            const float rstd = rsqrtf(ss * (1.f / 1024.f) + EPSN);
            const float* gt = mod + ((size_t)(l - 1) * 17 + mrow) * 3072 + 2048;
            const float* gp = p.g_post + (l - 1) * 1024;
#pragma unroll
            for (int hlf = 0; hlf < 2; ++hlf) {
                const int c0 = hlf * 512 + lane * 8;
#pragma unroll
                for (int e = 0; e < 8; ++e) xv[hlf * 8 + e] += gt[c0 + e] * (ov[hlf * 8 + e] * rstd * gp[c0 + e]);
                *(float4*)(xout + c0) = make_float4(xv[hlf * 8 + 0], xv[hlf * 8 + 1], xv[hlf * 8 + 2], xv[hlf * 8 + 3]);
                *(float4*)(xout + c0 + 4) = make_float4(xv[hlf * 8 + 4], xv[hlf * 8 + 5], xv[hlf * 8 + 6], xv[hlf * 8 + 7]);
            }
        }
        if (l < DEPTH) {
            float ss = 0.f;
#pragma unroll
            for (int e = 0; e < 16; ++e) ss += xv[e] * xv[e];
#pragma unroll
            for (int o = 32; o > 0; o >>= 1) ss += shx(ss, o);
            const float rstd = rsqrtf(ss * (1.f / 1024.f) + EPSN);
            const float* sh = mod + ((size_t)l * 17 + mrow) * 3072; const float* sc = sh + 1024;
            const float* gp = p.g_pre + l * 1024;
#pragma unroll
            for (int hlf = 0; hlf < 2; ++hlf) {
                const int c0 = hlf * 512 + lane * 8;
                float hv[8];
#pragma unroll
                for (int e = 0; e < 8; ++e) hv[e] = xv[hlf * 8 + e] * rstd * gp[c0 + e] * (1.f + sc[c0 + e]) + sh[c0 + e];
                uint4 w; w.x = pack2(hv[0], hv[1]); w.y = pack2(hv[2], hv[3]); w.z = pack2(hv[4], hv[5]); w.w = pack2(hv[6], hv[7]);
                *(uint4*)(H + (size_t)rr * 1024 + c0) = w;
            }
        }
    }
}

#define PJ(row, blk, c) (PROJ + ((size_t)(blk) * MLAT + (row)) * 512 + (c))
typedef unsigned u32x32_ __attribute__((ext_vector_type(32)));
struct Reg8 {
    u32x32_ v;
    __device__ __forceinline__ void ld(int i, const void* p) { const u32x4_ a = *(const u32x4_*)p; v[4 * i] = a[0]; v[4 * i + 1] = a[1]; v[4 * i + 2] = a[2]; v[4 * i + 3] = a[3]; }
    __device__ __forceinline__ u32x4_ get(int i) const { return (u32x4_){v[4 * i], v[4 * i + 1], v[4 * i + 2], v[4 * i + 3]}; }
    __device__ __forceinline__ uint4 getu(int i) const { uint4 r; r.x = v[4 * i]; r.y = v[4 * i + 1]; r.z = v[4 * i + 2]; r.w = v[4 * i + 3]; return r; }
};
#define MEMBAR() asm volatile("" ::: "memory")
constexpr int KVS = 72;
constexpr int TS = 528;
constexpr int T3S = 136;
constexpr int HS_ = 68;
constexpr float NORM_LAT = 0.0013810679320049757f;
constexpr float NORM_CTX = 0.005524271728019903f;

__device__ void attn_item(const Params& p, const PassInfo ps, int l, int item, unsigned char* lds) {
    unsigned char* ws = opaque(p.ws);
    const u16* PROJ = (const u16*)(ws + OFF_PROJ); const u16* QROT = (const u16*)(ws + OFF_QROT);
    const u16* CKV = (const u16*)(ws + OFF_CTXKV) + (size_t)l * MCTX * 1024;
    u16* Y0 = (u16*)(ws + OFF_Y);
    const int tid = tidx(), w = tid >> 6, lane = tid & 63, qtr = w & 3, kh = w >> 2, li = lane & 15, quad = lane >> 4;
    u16* Kl = (u16*)lds; u16* Vl = Kl + 512 * KVS; float* rp = (float*)(Vl + 512 * KVS);
    int bl, h, r = 0, qrow0, bglob;
    if (!ps.is_ctx) { r = item & 63; h = (item >> 6) & 7; bl = item >> 9; qrow0 = bl * 4096 + r * 64; bglob = ps.b0 + bl; }
    else { const int qb = item & 3; h = (item >> 2) & 7; bl = item >> 5; qrow0 = bl * 256 + qb * 64; bglob = bl; }
    const int qrow = qrow0 + qtr * 16 + li;
    float m_run = -1e30f, l_run = 0.f;
    const bf16x8 qp0 = ld_frag_g(PJ(qrow, 0, h * 64 + quad * 8)), qp1 = ld_frag_g(PJ(qrow, 0, h * 64 + 32 + quad * 8));
    uint2 gate4[4];
#pragma unroll
    for (int d = 0; d < 4; ++d) gate4[d] = *(const uint2*)(PJ(qrow, 3, h * 64 + d * 16 + quad * 4));
    Reg8 crg;
    { const size_t crow0 = (size_t)bglob * 256;
#pragma unroll
      for (int i = 0; i < 4; ++i) { const int idx = tid + 512 * i, key = idx >> 3, ch = idx & 7;
          crg.ld(2 * i, CKV + (crow0 + key) * 1024 + h * 64 + ch * 8); crg.ld(2 * i + 1, CKV + (crow0 + key) * 1024 + 512 + h * 64 + ch * 8); } }
    f32x4 O[4];
#pragma unroll
    for (int d = 0; d < 4; ++d) O[d] = (f32x4){0.f, 0.f, 0.f, 0.f};
    if (!ps.is_ctx) {
        const int rs = min(max(r - 4, 0), 56);
        const size_t krow0 = (size_t)bl * 4096 + rs * 64;
        const bf16x8 q0 = ld_frag_g(QROT + (size_t)qrow * 512 + h * 64 + quad * 8), q1 = ld_frag_g(QROT + (size_t)qrow * 512 + h * 64 + 32 + quad * 8);
        { u32x32_ kr, vr;
#pragma unroll
          for (int i = 0; i < 8; ++i) { const int idx = tid + 512 * i, key = idx >> 3, ch = idx & 7;
              const u32x4_ a = *(const u32x4_*)(PJ(krow0 + key, 1, h * 64 + ch * 8)), b = *(const u32x4_*)(PJ(krow0 + key, 2, h * 64 + ch * 8));
              kr[4 * i] = a[0]; kr[4 * i + 1] = a[1]; kr[4 * i + 2] = a[2]; kr[4 * i + 3] = a[3]; vr[4 * i] = b[0]; vr[4 * i + 1] = b[1]; vr[4 * i + 2] = b[2]; vr[4 * i + 3] = b[3]; }
          asm volatile("" ::: "memory");
#pragma unroll
          for (int i = 0; i < 8; ++i) { const int idx = tid + 512 * i, key = idx >> 3, ch = idx & 7;
              *(u32x4_*)(Kl + key * KVS + ch * 8) = (u32x4_){kr[4 * i], kr[4 * i + 1], kr[4 * i + 2], kr[4 * i + 3]}; *(u32x4_*)(Vl + key * KVS + ch * 8) = (u32x4_){vr[4 * i], vr[4 * i + 1], vr[4 * i + 2], vr[4 * i + 3]}; } }
        for (int i = tid; i < 465; i += 512) rp[i] = p.rpb[((size_t)l * 8 + h) * 465 + i] * LOG2E;
        __syncthreads();
        const int cbase = (qtr == 0) ? 0 : (qtr == 1 ? 8 : (qtr == 2 ? 24 : 32));
        const int qc = qtr * 16 + li, cst = min(max(qc - 8, 0), 48);
        float s[8][4];
        float mx = -1e30f;
#pragma unroll
        for (int sb = 0; sb < 8; ++sb) {
            const int i = kh * 4 + (sb >> 1), cs = sb & 1;
            const u16* kp = Kl + (i * 64 + cbase + cs * 16 + li) * KVS + quad * 8;
            f32x4 a = (f32x4){0.f, 0.f, 0.f, 0.f};
            a = MFMA16(*(const bf16x8*)kp, q0, a); a = MFMA16(*(const bf16x8*)(kp + 32), q1, a);
            const int ridx = rs + i - r + 7;
#pragma unroll
            for (int j = 0; j < 4; ++j) { const int kc = cbase + cs * 16 + quad * 4 + j;
                const bool valid = (kc >= cst) && (kc < cst + 16);
                const int cidx = min(max(kc - qc + 15, 0), 30);
                const float v = valid ? (a[j] + rp[ridx * 31 + cidx]) : -1e30f;
                s[sb][j] = v; mx = fmaxf(mx, v); }
        }
        mx = fmaxf(mx, shx(mx, 16)); mx = fmaxf(mx, shx(mx, 32));
        m_run = mx;
        float ls = 0.f;
#pragma unroll
        for (int sb = 0; sb < 8; ++sb)
#pragma unroll
            for (int j = 0; j < 4; ++j) { const float e = __builtin_amdgcn_exp2f(s[sb][j] - mx); s[sb][j] = e; ls += e; }
        ls += shx(ls, 16); ls += shx(ls, 32);
        l_run = ls;
#pragma unroll
        for (int kp2 = 0; kp2 < 4; ++kp2) {
            bf16x8 pf; { const unsigned a0 = pack2(s[2 * kp2][0], s[2 * kp2][1]), a1 = pack2(s[2 * kp2][2], s[2 * kp2][3]), b0 = pack2(s[2 * kp2 + 1][0], s[2 * kp2 + 1][1]), b1 = pack2(s[2 * kp2 + 1][2], s[2 * kp2 + 1][3]);
                pf = (bf16x8){(short)(a0 & 0xffff), (short)(a0 >> 16), (short)(a1 & 0xffff), (short)(a1 >> 16), (short)(b0 & 0xffff), (short)(b0 >> 16), (short)(b1 & 0xffff), (short)(b1 >> 16)}; }
            const int vrow0 = (kh * 4 + kp2) * 64 + cbase + quad * 4 + (li >> 2);
#pragma unroll
            for (int d = 0; d < 4; ++d) {
                const u16* vp = Vl + vrow0 * KVS + d * 16 + 4 * (li & 3);
                const bf16x8 vf = tr_read2(vp, vp + 16 * KVS);
                O[d] = MFMA16(vf, pf, O[d]);
            }
        }
        __syncthreads();
    }
    {
#pragma unroll
        for (int i = 0; i < 4; ++i) { const int idx = tid + 512 * i, key = idx >> 3, ch = idx & 7;
            *(u32x4_*)(Kl + key * KVS + ch * 8) = crg.get(2 * i); *(u32x4_*)(Vl + key * KVS + ch * 8) = crg.get(2 * i + 1); }
        __syncthreads();
        const bf16x8 q0 = qp0, q1 = qp1;
        float s[8][4];
        float mx = -1e30f;
#pragma unroll
        for (int sb = 0; sb < 8; ++sb) {
            const u16* kp = Kl + (kh * 128 + sb * 16 + li) * KVS + quad * 8;
            f32x4 a = (f32x4){0.f, 0.f, 0.f, 0.f};
            a = MFMA16(*(const bf16x8*)kp, q0, a); a = MFMA16(*(const bf16x8*)(kp + 32), q1, a);
#pragma unroll
            for (int j = 0; j < 4; ++j) { const float v = a[j]; s[sb][j] = v; mx = fmaxf(mx, v); }
        }
        mx = fmaxf(mx, shx(mx, 16)); mx = fmaxf(mx, shx(mx, 32));
        const float m_new = fmaxf(m_run, mx), resc = __builtin_amdgcn_exp2f(m_run - m_new);
        float ls = 0.f;
#pragma unroll
        for (int sb = 0; sb < 8; ++sb)
#pragma unroll
            for (int j = 0; j < 4; ++j) { const float e = __builtin_amdgcn_exp2f(s[sb][j] - m_new); s[sb][j] = e; ls += e; }
        ls += shx(ls, 16); ls += shx(ls, 32);
        l_run = l_run * resc + ls; m_run = m_new;
#pragma unroll
        for (int d = 0; d < 4; ++d) O[d] *= resc;
#pragma unroll
        for (int kp2 = 0; kp2 < 4; ++kp2) {
            bf16x8 pf; { const unsigned a0 = pack2(s[2 * kp2][0], s[2 * kp2][1]), a1 = pack2(s[2 * kp2][2], s[2 * kp2][3]), b0 = pack2(s[2 * kp2 + 1][0], s[2 * kp2 + 1][1]), b1 = pack2(s[2 * kp2 + 1][2], s[2 * kp2 + 1][3]);
                pf = (bf16x8){(short)(a0 & 0xffff), (short)(a0 >> 16), (short)(a1 & 0xffff), (short)(a1 >> 16), (short)(b0 & 0xffff), (short)(b0 >> 16), (short)(b1 & 0xffff), (short)(b1 >> 16)}; }
            const int vrow0 = kh * 128 + kp2 * 32 + quad * 4 + (li >> 2);
#pragma unroll
            for (int d = 0; d < 4; ++d) {
                const u16* vp = Vl + vrow0 * KVS + d * 16 + 4 * (li & 3);
                const bf16x8 vf = tr_read2(vp, vp + 16 * KVS);
                O[d] = MFMA16(vf, pf, O[d]);
            }
        }
        __syncthreads();
    }
    float* cb = (float*)lds;
    if (kh == 1) {
#pragma unroll
        for (int d = 0; d < 4; ++d)
#pragma unroll
            for (int j = 0; j < 4; ++j) cb[(qtr * 18 + d * 4 + j) * 64 + lane] = O[d][j];
        cb[(qtr * 18 + 16) * 64 + lane] = m_run; cb[(qtr * 18 + 17) * 64 + lane] = l_run;
    }
    __syncthreads();
    if (kh == 0) {
        const float m2 = cb[(qtr * 18 + 16) * 64 + lane], l2 = cb[(qtr * 18 + 17) * 64 + lane];
        const float mm = fmaxf(m_run, m2), e1 = __builtin_amdgcn_exp2f(m_run - mm), e2 = __builtin_amdgcn_exp2f(m2 - mm);
        const float inv = 1.f / (l_run * e1 + l2 * e2);
#pragma unroll
        for (int d = 0; d < 4; ++d) {
            const int col = h * 64 + d * 16 + quad * 4;
            const uint2 g = gate4[d];
            float o[4];
#pragma unroll
            for (int j = 0; j < 4; ++j) o[j] = (O[d][j] * e1 + cb[(qtr * 18 + d * 4 + j) * 64 + lane] * e2) * inv;
            uint2 wv; wv.x = pack2(o[0] * siluf_(bflo(g.x)), o[1] * siluf_(bfhi(g.x))); wv.y = pack2(o[2] * siluf_(bflo(g.y)), o[3] * siluf_(bfhi(g.y)));
            *(uint2*)(Y0 + (size_t)qrow * 512 + col) = wv;
        }
    }
    __syncthreads();
}

template <int ROWS, int CPR> __device__ __forceinline__ void load_tile(u16* dstl, int lstride, const u16* src, size_t sstride) {
    constexpr int PER = ROWS * CPR / 512;
    static_assert(PER % 8 == 0, "tile size");
    const int tid_ = tidx();
#pragma unroll
    for (int b8 = 0; b8 < PER / 8; ++b8) { Reg8 rg;
#pragma unroll
        for (int j = 0; j < 8; ++j) { const int i = tid_ + 512 * (b8 * 8 + j), r = i / CPR, ch = i % CPR; rg.ld(j, src + (size_t)r * sstride + ch * 8); }
        MEMBAR();
#pragma unroll
        for (int j = 0; j < 8; ++j) { const int i = tid_ + 512 * (b8 * 8 + j), r = i / CPR, ch = i % CPR; *(u32x4_*)(dstl + r * lstride + ch * 8) = rg.get(j); }
        MEMBAR(); }
}

__device__ void four1_item(const Params& p, int item, unsigned char* lds) {
    unsigned char* ws = opaque(p.ws);
    const u16* PROJ = (const u16*)(ws + OFF_PROJ); const u16* M1 = (const u16*)(ws + OFF_M1); const float* TW = (const float*)(ws + OFF_TW);
    u16* FY = (u16*)(ws + OFF_FY);
    const int tid = tidx(), w = tid >> 6, lane = tid & 63, li = lane & 15, quad = lane >> 4;
    const int n2 = item & 63, bl = item >> 6;
    u16* T = (u16*)lds;
#pragma unroll
    for (int b8 = 0; b8 < 2; ++b8) { Reg8 rg;
#pragma unroll
        for (int j = 0; j < 8; ++j) { const int i = tid + 512 * (b8 * 8 + j), kk = i >> 6, ch = i & 63, n1 = kk >> 1, part = kk & 1;
            rg.ld(j, PJ((size_t)bl * 4096 + n1 * 64 + n2, 4 + part, ch * 8)); }
        MEMBAR();
#pragma unroll
        for (int j = 0; j < 8; ++j) { const int i = tid + 512 * (b8 * 8 + j), kk = i >> 6, ch = i & 63;
            *(u32x4_*)(T + kk * TS + ch * 8) = rg.get(j); }
        MEMBAR(); }
    float* twl = (float*)(T + 128 * TS);
    if (tid < 64) { const float2 tv = *(const float2*)(TW + 2 * (n2 * tid)); twl[2 * tid] = tv.x; twl[2 * tid + 1] = tv.y; }
    bf16x8 xf[4];
#pragma unroll
    for (int ks = 0; ks < 4; ++ks) xf[ks] = ld_frag_g(M1 + li * 128 + ks * 32 + quad * 8);
    __syncthreads();
    for (int isub = 0; isub < 8; ++isub) {
        bf16x8 xn[4];
        const int isn = isub < 7 ? isub + 1 : 7;
#pragma unroll
        for (int ks = 0; ks < 4; ++ks) xn[ks] = ld_frag_g(M1 + (isn * 16 + li) * 128 + ks * 32 + quad * 8);
        float tcs[2], tsn_[2];
#pragma unroll
        for (int hh = 0; hh < 2; ++hh) { const int k1 = isub * 8 + quad * 2 + hh; tcs[hh] = twl[2 * k1]; tsn_[hh] = twl[2 * k1 + 1]; }
#pragma unroll
        for (int cs = 0; cs < 4; ++cs) {
            const int c0 = w * 64 + cs * 16;
            f32x4 a = (f32x4){0.f, 0.f, 0.f, 0.f};
#pragma unroll
            for (int ks = 0; ks < 4; ++ks) {
                const u16* tp = T + (ks * 32 + quad * 8 + (li >> 2)) * TS + c0 + 4 * (li & 3);
                a = MFMA16(xf[ks], tr_read2(tp, tp + 4 * TS), a);
            }
            const int ch = c0 + li;
#pragma unroll
            for (int hh = 0; hh < 2; ++hh) {
                const int k1 = isub * 8 + quad * 2 + hh;
                const float yr = a[2 * hh], yi = a[2 * hh + 1];
                const float orr = yr * tcs[hh] + yi * tsn_[hh], oi = yi * tcs[hh] - yr * tsn_[hh];
                u16* dst = FY + (((size_t)bl * 64 + k1) * 64 + n2) * 1024 + ch;
                dst[0] = f2bf(orr); dst[512] = f2bf(oi);
            }
        }
#pragma unroll
        for (int ks = 0; ks < 4; ++ks) xf[ks] = xn[ks];
    }
    __syncthreads();
}

__device__ void four2_item(const Params& p, int item, unsigned char* lds) {
    unsigned char* ws = opaque(p.ws);
    const u16* PROJ = (const u16*)(ws + OFF_PROJ); const u16* M2 = (const u16*)(ws + OFF_M2); const u16* FY = (const u16*)(ws + OFF_FY);
    u16* Y1 = (u16*)(ws + OFF_Y) + (size_t)1 * MLAT * 512;
    const int tid = tidx(), w = tid >> 6, lane = tid & 63, li = lane & 15, quad = lane >> 4;
    const int k1 = item & 63, bl = item >> 6;
    u16* T = (u16*)lds;
    load_tile<128, 64>(T, TS, FY + ((size_t)bl * 64 + k1) * 64 * 1024, 512);
    __syncthreads();
    bf16x8 xf[4][4];
#pragma unroll
    for (int cs = 0; cs < 4; ++cs)
#pragma unroll
        for (int ks = 0; ks < 4; ++ks) { const u16* tp = T + (ks * 32 + quad * 8 + (li >> 2)) * TS + w * 64 + cs * 16 + 4 * (li & 3); xf[cs][ks] = tr_read2(tp, tp + 4 * TS); }
    bf16x8 yf[4]; uint2 gt[4];
#define F2_LOAD(k2s_, yf_, gt_) do { _Pragma("unroll") for (int ks = 0; ks < 4; ++ks) yf_[ks] = ld_frag_g(M2 + ((k2s_) * 16 + li) * 128 + ks * 32 + quad * 8); \
        const size_t row_ = (size_t)bl * 4096 + k1 + 64 * ((k2s_) * 16 + li); _Pragma("unroll") for (int cs = 0; cs < 4; ++cs) gt_[cs] = *(const uint2*)(PJ(row_, 6, w * 64 + cs * 16 + quad * 4)); } while (0)
    F2_LOAD(0, yf, gt);
    for (int k2s = 0; k2s < 4; ++k2s) {
        bf16x8 yn[4]; uint2 gn[4];
        const int kn = k2s < 3 ? k2s + 1 : 3;
        F2_LOAD(kn, yn, gn);
        const int k2 = k2s * 16 + li;
        const size_t row = (size_t)bl * 4096 + k1 + 64 * k2;
#pragma unroll
        for (int cs = 0; cs < 4; ++cs) {
            f32x4 a = (f32x4){0.f, 0.f, 0.f, 0.f};
#pragma unroll
            for (int ks = 0; ks < 4; ++ks) a = MFMA16(xf[cs][ks], yf[ks], a);
            const int ch = w * 64 + cs * 16 + quad * 4;
            const uint2 g = gt[cs];
            uint2 wv; wv.x = pack2(a[0] * NORM_LAT * siluf_(bflo(g.x)), a[1] * NORM_LAT * siluf_(bfhi(g.x))); wv.y = pack2(a[2] * NORM_LAT * siluf_(bflo(g.y)), a[3] * NORM_LAT * siluf_(bfhi(g.y)));
            *(uint2*)(Y1 + row * 512 + ch) = wv;
        }
#pragma unroll
        for (int q = 0; q < 4; ++q) { yf[q] = yn[q]; gt[q] = gn[q]; }
    }
#undef F2_LOAD
    __syncthreads();
}

__device__ void fourc_item(const Params& p, int item, unsigned char* lds) {
    unsigned char* ws = opaque(p.ws);
    const u16* PROJ = (const u16*)(ws + OFF_PROJ); const u16* M3 = (const u16*)(ws + OFF_M3);
    u16* Y1 = (u16*)(ws + OFF_Y) + (size_t)1 * MLAT * 512;
    const int tid = tidx(), w = tid >> 6, lane = tid & 63, li = lane & 15, quad = lane >> 4;
    const int chb = item & 3, b = item >> 2;
    u16* T = (u16*)lds;
#pragma unroll
    for (int b8 = 0; b8 < 2; ++b8) { Reg8 rg;
#pragma unroll
        for (int j = 0; j < 8; ++j) { const int i = tid + 512 * (b8 * 8 + j), kk = i >> 4, ch = i & 15, n = kk >> 1, part = kk & 1;
            rg.ld(j, PJ((size_t)b * 256 + n, 4 + part, chb * 128 + ch * 8)); }
        MEMBAR();
#pragma unroll
        for (int j = 0; j < 8; ++j) { const int i = tid + 512 * (b8 * 8 + j), kk = i >> 4, ch = i & 15;
            *(u32x4_*)(T + kk * T3S + ch * 8) = rg.get(j); }
        MEMBAR(); }
    __syncthreads();
    for (int kq = 0; kq < 2; ++kq) {
        const int ksub = w * 2 + kq;
        f32x4 a[8];
#pragma unroll
        for (int cs = 0; cs < 8; ++cs) a[cs] = (f32x4){0.f, 0.f, 0.f, 0.f};
        for (int ks = 0; ks < 16; ++ks) {
            const bf16x8 yf = ld_frag_g(M3 + (ksub * 16 + li) * 512 + ks * 32 + quad * 8);
#pragma unroll
            for (int cs = 0; cs < 8; ++cs) { const u16* tp = T + (ks * 32 + quad * 8 + (li >> 2)) * T3S + cs * 16 + 4 * (li & 3);
                a[cs] = MFMA16(tr_read2(tp, tp + 4 * T3S), yf, a[cs]); }
        }
        const size_t row = (size_t)b * 256 + ksub * 16 + li;
#pragma unroll
        for (int cs = 0; cs < 8; ++cs) {
            const int ch = chb * 128 + cs * 16 + quad * 4;
            const uint2 g = *(const uint2*)(PJ(row, 6, ch));
            uint2 wv; wv.x = pack2(a[cs][0] * NORM_CTX * siluf_(bflo(g.x)), a[cs][1] * NORM_CTX * siluf_(bfhi(g.x))); wv.y = pack2(a[cs][2] * NORM_CTX * siluf_(bflo(g.y)), a[cs][3] * NORM_CTX * siluf_(bfhi(g.y)));
            *(uint2*)(Y1 + row * 512 + ch) = wv;
        }
    }
    __syncthreads();
}

__device__ void gmlp_item(const Params& p, int l, int item, unsigned char* lds) {
    unsigned char* ws = opaque(p.ws);
    const u16* PROJ = (const u16*)(ws + OFF_PROJ); const u16* WS16 = (const u16*)(ws + OFF_WS16) + (size_t)l * 8 * 128 * 128;
    u16* Y2 = (u16*)(ws + OFF_Y) + (size_t)2 * MLAT * 512;
    const int tid = tidx(), w = tid >> 6, lane = tid & 63, li = lane & 15, quad = lane >> 4;
    const size_t r0 = (size_t)item * 128;
    u16* VN = (u16*)lds;
    {
        const int row = tid >> 2, qd = tid & 3;
        const u16* src = PJ(r0 + row, 8, 0);
        uint4 raw[16]; float ss = 0.f;
#pragma unroll
        for (int i = 0; i < 16; ++i) { raw[i] = *(const uint4*)(src + (qd + 4 * i) * 8); float f[8]; unpack8(raw[i], f);
#pragma unroll
            for (int e = 0; e < 8; ++e) ss += f[e] * f[e]; }
        ss += shx(ss, 1); ss += shx(ss, 2);
        const float rstd = rsqrtf(ss * (1.f / 512.f) + EPSN);
        const float* gn = p.gmlp_g + l * 512;
#pragma unroll
        for (int i = 0; i < 16; ++i) { float f[8]; unpack8(raw[i], f); const int c0 = (qd + 4 * i) * 8;
            const float4 g0 = *(const float4*)(gn + c0), g1 = *(const float4*)(gn + c0 + 4);
            uint4 o; o.x = pack2(f[0] * rstd * g0.x, f[1] * rstd * g0.y); o.y = pack2(f[2] * rstd * g0.z, f[3] * rstd * g0.w);
            o.z = pack2(f[4] * rstd * g1.x, f[5] * rstd * g1.y); o.w = pack2(f[6] * rstd * g1.z, f[7] * rstd * g1.w);
            *(uint4*)(VN + row * TS + c0) = o; }
    }
    __syncthreads();
    const int g = w;
    bf16x8 xf[4][4];
#pragma unroll
    for (int cs = 0; cs < 4; ++cs)
#pragma unroll
        for (int ks = 0; ks < 4; ++ks) { const u16* tp = VN + (ks * 32 + quad * 8 + (li >> 2)) * TS + g * 64 + cs * 16 + 4 * (li & 3); xf[cs][ks] = tr_read2(tp, tp + 4 * TS); }
    bf16x8 yf[4]; uint2 uu[4], gg[4]; float bs;
#define GM_LOAD(ts_, yf_, uu_, gg_, bs_) do { const int t_ = (ts_) * 16 + li; _Pragma("unroll") for (int ks = 0; ks < 4; ++ks) yf_[ks] = ld_frag_g(WS16 + ((size_t)g * 128 + t_) * 128 + ks * 32 + quad * 8); \
        bs_ = p.gmlp_bs[((size_t)l * 8 + g) * 128 + t_]; _Pragma("unroll") for (int cs = 0; cs < 4; ++cs) { const int c_ = g * 64 + cs * 16 + quad * 4; uu_[cs] = *(const uint2*)(PJ(r0 + t_, 7, c_)); gg_[cs] = *(const uint2*)(PJ(r0 + t_, 9, c_)); } } while (0)
    GM_LOAD(0, yf, uu, gg, bs);
    for (int ts = 0; ts < 8; ++ts) {
        bf16x8 yn[4]; uint2 un[4], gn[4]; float bn;
        const int tn = ts < 7 ? ts + 1 : 7;
        GM_LOAD(tn, yn, un, gn, bn);
        const int t = ts * 16 + li;
        const size_t row = r0 + t;
#pragma unroll
        for (int cs = 0; cs < 4; ++cs) {
            f32x4 a = (f32x4){0.f, 0.f, 0.f, 0.f};
#pragma unroll
            for (int ks = 0; ks < 4; ++ks) a = MFMA16(xf[cs][ks], yf[ks], a);
            const int c = g * 64 + cs * 16 + quad * 4;
            uint2 wv; wv.x = pack2(bflo(uu[cs].x) * (a[0] + bs) * siluf_(bflo(gg[cs].x)), bfhi(uu[cs].x) * (a[1] + bs) * siluf_(bfhi(gg[cs].x)));
            wv.y = pack2(bflo(uu[cs].y) * (a[2] + bs) * siluf_(bflo(gg[cs].y)), bfhi(uu[cs].y) * (a[3] + bs) * siluf_(bfhi(gg[cs].y)));
            *(uint2*)(Y2 + row * 512 + c) = wv;
        }
#pragma unroll
        for (int q = 0; q < 4; ++q) { yf[q] = yn[q]; uu[q] = un[q]; gg[q] = gn[q]; }
        bs = bn;
    }
#undef GM_LOAD
    __syncthreads();
}

__device__ __forceinline__ void chunk_cumsum(float* A, float* tmp, int dir) {
    const int k = tidx() & 63, seg = tidx() >> 6;
    float v[8]; float run = 0.f;
    if (dir == 0) {
#pragma unroll
        for (int e = 0; e < 8; ++e) { run += A[(seg * 8 + e) * HS_ + k]; v[e] = run; }
    } else {
#pragma unroll
        for (int e = 7; e >= 0; --e) { run += A[(seg * 8 + e) * HS_ + k]; v[e] = run; }
    }
    tmp[seg * 64 + k] = run;
    __syncthreads();
    float off = 0.f;
#pragma unroll
    for (int s2 = 0; s2 < 8; ++s2) { const float tv = tmp[s2 * 64 + k]; if (dir == 0 ? (s2 < seg) : (s2 > seg)) off += tv; }
#pragma unroll
    for (int e = 0; e < 8; ++e) A[(seg * 8 + e) * HS_ + k] = (v[e] + off) * LOG2E;
    __syncthreads();
}
__device__ __forceinline__ void chunk_cumsum2(float* Af, float* Ab, float* tmp) {
    const int k = tidx() & 63, seg = tidx() >> 6;
    float vf[8], vb[8]; float rf = 0.f, rb = 0.f;
#pragma unroll
    for (int e = 0; e < 8; ++e) { rf += Af[(seg * 8 + e) * HS_ + k]; vf[e] = rf; }
#pragma unroll
    for (int e = 7; e >= 0; --e) { rb += Ab[(seg * 8 + e) * HS_ + k]; vb[e] = rb; }
    tmp[seg * 64 + k] = rf; tmp[512 + seg * 64 + k] = rb;
    __syncthreads();
    float of = 0.f, ob = 0.f;
#pragma unroll
    for (int s2 = 0; s2 < 8; ++s2) { const float tf = tmp[s2 * 64 + k], tb = tmp[512 + s2 * 64 + k]; if (s2 < seg) of += tf; if (s2 > seg) ob += tb; }
#pragma unroll
    for (int e = 0; e < 8; ++e) { Af[(seg * 8 + e) * HS_ + k] = (vf[e] + of) * LOG2E; Ab[(seg * 8 + e) * HS_ + k] = (vb[e] + ob) * LOG2E; }
    __syncthreads();
}
__device__ __forceinline__ void load_bf_tile64(float* dst, const u16* src  , size_t sstride) {
    const int t = tidx() >> 3, k8 = (tidx() & 7) * 8;
    float f[8]; unpack8(*(const uint4*)(src + (size_t)t * sstride + k8), f);
    *(float4*)(dst + t * HS_ + k8) = make_float4(f[0], f[1], f[2], f[3]); *(float4*)(dst + t * HS_ + k8 + 4) = make_float4(f[4], f[5], f[6], f[7]);
}
__device__ __forceinline__ void load_f32_tile64(float* dst, const float* src, size_t sstride) {
    const int t = tidx() >> 3, k8 = (tidx() & 7) * 8;
    *(float4*)(dst + t * HS_ + k8) = *(const float4*)(src + (size_t)t * sstride + k8); *(float4*)(dst + t * HS_ + k8 + 4) = *(const float4*)(src + (size_t)t * sstride + k8 + 4);
}

__device__ __forceinline__ void hgrn1_issue(const u16* PROJ, const float* LOGF, const PassInfo ps, int item, Reg8& rg) {
    const int NC = ps.T >> 6, ncsh = ps.is_ctx ? 2 : 6, c = item & (NC - 1), ci = item >> ncsh, dir = ci & 1, h = (ci >> 1) & 7, bl = ci >> 4;
    const size_t r0 = (size_t)bl * ps.T + c * 64;
    const int t = tidx() >> 3, k8 = (tidx() & 7) * 8;
    const float* ap = LOGF + (r0 + t) * 1024 + dir * 512 + h * 64 + k8;
    rg.ld(0, ap); rg.ld(1, ap + 4); rg.ld(2, PJ(r0 + t, 11 + dir, h * 64 + k8)); rg.ld(3, PJ(r0 + t, 13, h * 64 + k8));
}
__device__ void hgrn1_loop(const Params& p, const PassInfo ps, int first, int end, int stride, unsigned char* lds) {
    if (first >= end) return;
    unsigned char* ws = opaque(p.ws);
    const u16* PROJ = (const u16*)(ws + OFF_PROJ); const float* LOGF = (const float*)(ws + OFF_LOGF);
    u16* HL = (u16*)(ws + OFF_HL); float* HD = (float*)(ws + OFF_HD);
    float* A = (float*)lds; float* tmp = A + 64 * HS_; u16* Wb = (u16*)(tmp + 512); u16* Ib = Wb + 64 * KVS;
    const int tid = tidx(), w = tid >> 6, lane = tid & 63, li = lane & 15, quad = lane >> 4;
    const int t = tid >> 3, k8 = (tid & 7) * 8;
    Reg8 rg;
    hgrn1_issue(PROJ, LOGF, ps, first, rg);
  for (int item = first; item < end; item += stride) {
    const int ncsh = ps.is_ctx ? 2 : 6, ci = item >> ncsh, dir = ci & 1;
    float kf[8];
    { MEMBAR();
      unpack8(rg.getu(2), kf);
      *(u32x4_*)(A + t * HS_ + k8) = rg.get(0); *(u32x4_*)(A + t * HS_ + k8 + 4) = rg.get(1);
      *(u32x4_*)(Ib + t * KVS + k8) = rg.get(3); }
    __syncthreads();
    if (item + stride < end) hgrn1_issue(PROJ, LOGF, ps, item + stride, rg);
    chunk_cumsum(A, tmp, dir);
    const int lastt = dir == 0 ? 63 : 0;
    { float wv[8];
#pragma unroll
      for (int e = 0; e < 8; ++e) wv[e] = kf[e] * __builtin_amdgcn_exp2f(A[lastt * HS_ + k8 + e] - A[t * HS_ + k8 + e]);
      uint4 wq; wq.x = pack2(wv[0], wv[1]); wq.y = pack2(wv[2], wv[3]); wq.z = pack2(wv[4], wv[5]); wq.w = pack2(wv[6], wv[7]);
      *(uint4*)(Wb + t * KVS + k8) = wq;
      if (tid < 64) HD[(size_t)item * 64 + tid] = __builtin_amdgcn_exp2f(A[lastt * HS_ + tid]); }
    __syncthreads();
    {
        const int ksub = w >> 1;
        bf16x8 yf[2];
#pragma unroll
        for (int ks = 0; ks < 2; ++ks) { const u16* tp = Wb + (ks * 32 + quad * 8 + (li >> 2)) * KVS + ksub * 16 + 4 * (li & 3); yf[ks] = tr_read2(tp, tp + 4 * KVS); }
#pragma unroll
        for (int vv = 0; vv < 2; ++vv) {
            const int vsub = (w & 1) * 2 + vv;
            f32x4 a = (f32x4){0.f, 0.f, 0.f, 0.f};
#pragma unroll
            for (int ks = 0; ks < 2; ++ks) { const u16* tp = Ib + (ks * 32 + quad * 8 + (li >> 2)) * KVS + vsub * 16 + 4 * (li & 3); a = MFMA16(tr_read2(tp, tp + 4 * KVS), yf[ks], a); }
            uint2 o; o.x = pack2(a[0], a[1]); o.y = pack2(a[2], a[3]);
            *(uint2*)(HL + ((size_t)item * 64 + ksub * 16 + li) * 64 + vsub * 16 + quad * 4) = o;
        }
    }
    __syncthreads();
  }
}

__device__ void hgrn_chain(const Params& p, const PassInfo ps, int l, int ci, unsigned char* lds) {
    unsigned char* ws = opaque(p.ws);
    const u16* PROJ = (const u16*)(ws + OFF_PROJ); const float* LOGF = (const float*)(ws + OFF_LOGF);
    u16* HS = (u16*)(ws + OFF_HS); float* CST = (float*)(ws + OFF_CTXST) + (size_t)l * 256 * 4096;
    const int tid = tidx(), w = tid >> 6, lane = tid & 63, li = lane & 15, quad = lane >> 4;
    const int t = tid >> 3, k8 = (tid & 7) * 8;
    const int NC = ps.T >> 6, dir = ci & 1, ksub = w >> 1, kk_ = ksub * 16 + li;
    float S[2][4];
#pragma unroll
    for (int vv = 0; vv < 2; ++vv) {
        const int v0 = ((w & 1) * 2 + vv) * 16 + quad * 4;
        if (!ps.is_ctx) { const float4 c4 = *(const float4*)(CST + ((size_t)ps.b0 * 16 + ci) * 4096 + kk_ * 64 + v0); S[vv][0] = c4.x; S[vv][1] = c4.y; S[vv][2] = c4.z; S[vv][3] = c4.w; }
        else { S[vv][0] = 0.f; S[vv][1] = 0.f; S[vv][2] = 0.f; S[vv][3] = 0.f; }
    }
    Reg8 rg;
    hgrn1_issue(PROJ, LOGF, ps, ci * NC + (dir ? NC - 1 : 0), rg);
  for (int cc = 0; cc < NC; ++cc) {
    const int c = dir ? NC - 1 - cc : cc, item = ci * NC + c;
    float* A = (float*)(lds + (cc & 1) * 38912); float* tmp = A + 64 * HS_; u16* Wb = (u16*)(tmp + 512); u16* Ib = Wb + 64 * KVS;
    float kf[8];
    { MEMBAR();
      unpack8(rg.getu(2), kf);
      *(u32x4_*)(A + t * HS_ + k8) = rg.get(0); *(u32x4_*)(A + t * HS_ + k8 + 4) = rg.get(1);
      *(u32x4_*)(Ib + t * KVS + k8) = rg.get(3); }
    __syncthreads();
    if (cc + 1 < NC) hgrn1_issue(PROJ, LOGF, ps, ci * NC + (dir ? NC - 2 - cc : cc + 1), rg);
    chunk_cumsum(A, tmp, dir);
    const int lastt = dir == 0 ? 63 : 0;
    { float wv[8];
#pragma unroll
      for (int e = 0; e < 8; ++e) wv[e] = kf[e] * __builtin_amdgcn_exp2f(A[lastt * HS_ + k8 + e] - A[t * HS_ + k8 + e]);
      uint4 wq; wq.x = pack2(wv[0], wv[1]); wq.y = pack2(wv[2], wv[3]); wq.z = pack2(wv[4], wv[5]); wq.w = pack2(wv[6], wv[7]);
      *(uint4*)(Wb + t * KVS + k8) = wq; }
    __syncthreads();
    {
        const float dk = __builtin_amdgcn_exp2f(A[lastt * HS_ + kk_]);
        bf16x8 yf[2];
#pragma unroll
        for (int ks = 0; ks < 2; ++ks) { const u16* tp = Wb + (ks * 32 + quad * 8 + (li >> 2)) * KVS + ksub * 16 + 4 * (li & 3); yf[ks] = tr_read2(tp, tp + 4 * KVS); }
#pragma unroll
        for (int vv = 0; vv < 2; ++vv) {
            const int vsub = (w & 1) * 2 + vv;
            f32x4 a = (f32x4){0.f, 0.f, 0.f, 0.f};
#pragma unroll
            for (int ks = 0; ks < 2; ++ks) { const u16* tp = Ib + (ks * 32 + quad * 8 + (li >> 2)) * KVS + vsub * 16 + 4 * (li & 3); a = MFMA16(tr_read2(tp, tp + 4 * KVS), yf[ks], a); }
            uint2 o; o.x = pack2(S[vv][0], S[vv][1]); o.y = pack2(S[vv][2], S[vv][3]);
            *(uint2*)(HS + ((size_t)item * 64 + kk_) * 64 + vsub * 16 + quad * 4) = o;
#pragma unroll
            for (int j = 0; j < 4; ++j) S[vv][j] = dk * S[vv][j] + a[j];
        }
    }
  }
    __syncthreads();
    if (ps.is_ctx) {
#pragma unroll
        for (int vv = 0; vv < 2; ++vv) { const int v0 = ((w & 1) * 2 + vv) * 16 + quad * 4;
            *(float4*)(CST + (size_t)ci * 4096 + kk_ * 64 + v0) = make_float4(S[vv][0], S[vv][1], S[vv][2], S[vv][3]); }
    }
}

__device__ void hgrn2_all(const Params& p, const PassInfo ps, int l) {
    unsigned char* ws = opaque(p.ws);
    const unsigned* HL = (const unsigned*)(ws + OFF_HL); const float* HD = (const float*)(ws + OFF_HD); unsigned* HS = (unsigned*)(ws + OFF_HS);
    float* CST = (float*)(ws + OFF_CTXST) + (size_t)l * 256 * 4096;
    const int NC = ps.T >> 6, chains = ps.nb * 16;
    const size_t total = (size_t)chains * 2048;
    for (size_t e = (size_t)blockIdx.x * 512 + tidx(); e < total; e += (size_t)gridDim.x * 512) {
        const int ci = (int)(e >> 11), kv2 = (int)(e & 2047), k = kv2 >> 5, dir = ci & 1;
        float s0 = 0.f, s1 = 0.f;
        if (!ps.is_ctx) { const float2 cs = *(const float2*)(CST + ((size_t)ps.b0 * 16 + ci) * 4096 + 2 * kv2); s0 = cs.x; s1 = cs.y; }
#define HG2_TRIP(BLK) for (int c4 = 0; c4 < NC; c4 += BLK) { float d[BLK]; unsigned lw[BLK]; \
            _Pragma("unroll") for (int j = 0; j < BLK; ++j) { const int c = dir ? NC - 1 - (c4 + j) : c4 + j; const size_t idx = (size_t)ci * NC + c; d[j] = HD[idx * 64 + k]; lw[j] = HL[idx * 2048 + kv2]; } \
            _Pragma("unroll") for (int j = 0; j < BLK; ++j) { const int c = dir ? NC - 1 - (c4 + j) : c4 + j; const size_t idx = (size_t)ci * NC + c; \
                HS[idx * 2048 + kv2] = pack2(s0, s1); s0 = d[j] * s0 + bflo(lw[j]); s1 = d[j] * s1 + bfhi(lw[j]); } }
        if (NC == 4) { HG2_TRIP(4) } else { HG2_TRIP(16) }
#undef HG2_TRIP
        if (ps.is_ctx) *(float2*)(CST + (size_t)ci * 4096 + 2 * kv2) = make_float2(s0, s1);
    }
}

__device__ void hgrn3_item(const Params& p, const PassInfo ps, int l, int item, unsigned char* lds) {
    unsigned char* ws = opaque(p.ws);
    const u16* PROJ = (const u16*)(ws + OFF_PROJ); const float* LOGF = (const float*)(ws + OFF_LOGF); const u16* HSt = (const u16*)(ws + OFF_HS);
    u16* Y3 = (u16*)(ws + OFF_Y) + (size_t)3 * MLAT * 512;
    const int NC = ps.T >> 6, ncsh = ps.is_ctx ? 2 : 6, c = item & (NC - 1), bh = item >> ncsh, h = bh & 7, bl = bh >> 3;
    const size_t r0 = (size_t)bl * ps.T + c * 64;
    const size_t idxf = (size_t)(bh * 2 + 0) * NC + c, idxb = (size_t)(bh * 2 + 1) * NC + c;
    float* Q = (float*)lds; float* KKf = Q + 64 * HS_; float* KKb = KKf + 64 * HS_; float* Af = KKb + 64 * HS_; float* Ab = Af + 64 * HS_; float* tmp = Ab + 64 * HS_;
    u16* Ib = (u16*)(tmp + 1024); u16* Sfb = Ib + 64 * KVS; u16* Sbb = Sfb + 64 * KVS; float* comb = (float*)(Sbb + 64 * KVS);
    const int tid = tidx(), w = tid >> 6, lane = tid & 63, li = lane & 15, quad = lane >> 4;
    { const int t = tid >> 3, k8 = (tid & 7) * 8;
      Reg8 ra, rb;
      const float* ap = LOGF + (r0 + t) * 1024 + h * 64 + k8;
      const u16* sf = HSt + idxf * 4096 + t * 64 + k8; const u16* sb = HSt + idxb * 4096 + t * 64 + k8;
      ra.ld(0, PJ(r0 + t, 10, h * 64 + k8)); ra.ld(1, PJ(r0 + t, 11, h * 64 + k8)); ra.ld(2, PJ(r0 + t, 12, h * 64 + k8)); ra.ld(3, PJ(r0 + t, 13, h * 64 + k8));
      ra.ld(4, ap); ra.ld(5, ap + 4); ra.ld(6, ap + 512); ra.ld(7, ap + 516);
      rb.ld(0, sf); rb.ld(1, sb);
      MEMBAR();
      float x[8];
      unpack8(ra.getu(0), x); *(float4*)(Q + t * HS_ + k8) = make_float4(x[0], x[1], x[2], x[3]); *(float4*)(Q + t * HS_ + k8 + 4) = make_float4(x[4], x[5], x[6], x[7]);
      unpack8(ra.getu(1), x); *(float4*)(KKf + t * HS_ + k8) = make_float4(x[0], x[1], x[2], x[3]); *(float4*)(KKf + t * HS_ + k8 + 4) = make_float4(x[4], x[5], x[6], x[7]);
      unpack8(ra.getu(2), x); *(float4*)(KKb + t * HS_ + k8) = make_float4(x[0], x[1], x[2], x[3]); *(float4*)(KKb + t * HS_ + k8 + 4) = make_float4(x[4], x[5], x[6], x[7]);
      *(u32x4_*)(Ib + t * KVS + k8) = ra.get(3);
      *(u32x4_*)(Af + t * HS_ + k8) = ra.get(4); *(u32x4_*)(Af + t * HS_ + k8 + 4) = ra.get(5); *(u32x4_*)(Ab + t * HS_ + k8) = ra.get(6); *(u32x4_*)(Ab + t * HS_ + k8 + 4) = ra.get(7);
      *(u32x4_*)(Sfb + t * KVS + k8) = rb.get(0); *(u32x4_*)(Sbb + t * KVS + k8) = rb.get(1); }
    __syncthreads();
    chunk_cumsum2(Af, Ab, tmp);
    const int dir = w >> 2, T = w & 3;
    const float* A = dir ? Ab : Af; const float* KK = dir ? KKb : KKf; const u16* Sb16 = dir ? Sbb : Sfb;
    const int t = 16 * T + li;
    const int rrow = dir ? 16 * T + 16 : 16 * T - 1; const bool rzero = dir ? (T == 3) : (T == 0);
    bf16x8 qt[2], qh[2];
    float Rv[2][8];
#pragma unroll
    for (int ks = 0; ks < 2; ++ks) {
        const int k0 = ks * 32 + quad * 8;
        float qv[8], av[8];
        { const float4 x0 = *(const float4*)(Q + t * HS_ + k0), x1 = *(const float4*)(Q + t * HS_ + k0 + 4); qv[0] = x0.x; qv[1] = x0.y; qv[2] = x0.z; qv[3] = x0.w; qv[4] = x1.x; qv[5] = x1.y; qv[6] = x1.z; qv[7] = x1.w; }
        { const float4 x0 = *(const float4*)(A + t * HS_ + k0), x1 = *(const float4*)(A + t * HS_ + k0 + 4); av[0] = x0.x; av[1] = x0.y; av[2] = x0.z; av[3] = x0.w; av[4] = x1.x; av[5] = x1.y; av[6] = x1.z; av[7] = x1.w; }
        if (rzero) {
#pragma unroll
            for (int e = 0; e < 8; ++e) Rv[ks][e] = 0.f;
        } else { const float4 x0 = *(const float4*)(A + rrow * HS_ + k0), x1 = *(const float4*)(A + rrow * HS_ + k0 + 4); Rv[ks][0] = x0.x; Rv[ks][1] = x0.y; Rv[ks][2] = x0.z; Rv[ks][3] = x0.w; Rv[ks][4] = x1.x; Rv[ks][5] = x1.y; Rv[ks][6] = x1.z; Rv[ks][7] = x1.w; }
        float a_[8], b_[8];
#pragma unroll
        for (int e = 0; e < 8; ++e) { a_[e] = qv[e] * __builtin_amdgcn_exp2f(av[e] - Rv[ks][e]); b_[e] = qv[e] * __builtin_amdgcn_exp2f(av[e]); }
        const unsigned a0 = pack2(a_[0], a_[1]), a1 = pack2(a_[2], a_[3]), a2 = pack2(a_[4], a_[5]), a3 = pack2(a_[6], a_[7]);
        const unsigned b0 = pack2(b_[0], b_[1]), b1 = pack2(b_[2], b_[3]), b2 = pack2(b_[4], b_[5]), b3 = pack2(b_[6], b_[7]);
        qt[ks] = (bf16x8){(short)(a0 & 0xffff), (short)(a0 >> 16), (short)(a1 & 0xffff), (short)(a1 >> 16), (short)(a2 & 0xffff), (short)(a2 >> 16), (short)(a3 & 0xffff), (short)(a3 >> 16)};
        qh[ks] = (bf16x8){(short)(b0 & 0xffff), (short)(b0 >> 16), (short)(b1 & 0xffff), (short)(b1 >> 16), (short)(b2 & 0xffff), (short)(b2 >> 16), (short)(b3 & 0xffff), (short)(b3 >> 16)};
    }
    const int nS = dir ? 4 - T : T + 1;
    float sc[4][4];
#pragma unroll
    for (int i = 0; i < 4; ++i) {
        if (i < nS) {
            const int S = dir ? T + i : i, srow = 16 * S + li;
            f32x4 a = (f32x4){0.f, 0.f, 0.f, 0.f};
#pragma unroll
            for (int ks = 0; ks < 2; ++ks) {
                const int k0 = ks * 32 + quad * 8;
                const float4 x0 = *(const float4*)(KK + srow * HS_ + k0), x1 = *(const float4*)(KK + srow * HS_ + k0 + 4);
                const float4 y0 = *(const float4*)(A + srow * HS_ + k0), y1 = *(const float4*)(A + srow * HS_ + k0 + 4);
                const float kv[8] = {x0.x, x0.y, x0.z, x0.w, x1.x, x1.y, x1.z, x1.w}, as[8] = {y0.x, y0.y, y0.z, y0.w, y1.x, y1.y, y1.z, y1.w};
                float c_[8];
#pragma unroll
                for (int e = 0; e < 8; ++e) c_[e] = kv[e] * __builtin_amdgcn_exp2f(Rv[ks][e] - as[e]);
                const unsigned c0 = pack2(c_[0], c_[1]), c1 = pack2(c_[2], c_[3]), c2 = pack2(c_[4], c_[5]), c3 = pack2(c_[6], c_[7]);
                const bf16x8 kf = (bf16x8){(short)(c0 & 0xffff), (short)(c0 >> 16), (short)(c1 & 0xffff), (short)(c1 >> 16), (short)(c2 & 0xffff), (short)(c2 >> 16), (short)(c3 & 0xffff), (short)(c3 >> 16)};
                a = MFMA16(kf, qt[ks], a);
            }
            const bool diag = (S == T);
#pragma unroll
            for (int j = 0; j < 4; ++j) { const int sl = quad * 4 + j; const bool keep = !diag || (dir ? (sl >= li) : (sl <= li)); sc[i][j] = keep ? a[j] : 0.f; }
        } else {
#pragma unroll
            for (int j = 0; j < 4; ++j) sc[i][j] = 0.f;
        }
    }
    f32x4 O[4];
#pragma unroll
    for (int v = 0; v < 4; ++v) O[v] = (f32x4){0.f, 0.f, 0.f, 0.f};
#pragma unroll
    for (int pr = 0; pr < 2; ++pr) {
        if (2 * pr < nS) {
            const unsigned a0 = pack2(sc[2 * pr][0], sc[2 * pr][1]), a1 = pack2(sc[2 * pr][2], sc[2 * pr][3]), b0 = pack2(sc[2 * pr + 1][0], sc[2 * pr + 1][1]), b1 = pack2(sc[2 * pr + 1][2], sc[2 * pr + 1][3]);
            const bf16x8 pf = (bf16x8){(short)(a0 & 0xffff), (short)(a0 >> 16), (short)(a1 & 0xffff), (short)(a1 >> 16), (short)(b0 & 0xffff), (short)(b0 >> 16), (short)(b1 & 0xffff), (short)(b1 >> 16)};
            const int S0 = dir ? T + 2 * pr : 2 * pr; int S1 = S0 + 1; if (S1 > 3) S1 = 3;
            const u16* p0 = Ib + (16 * S0 + quad * 4 + (li >> 2)) * KVS + 4 * (li & 3);
            const u16* p1 = Ib + (16 * S1 + quad * 4 + (li >> 2)) * KVS + 4 * (li & 3);
#pragma unroll
            for (int v = 0; v < 4; ++v) O[v] = MFMA16(tr_read2(p0 + v * 16, p1 + v * 16), pf, O[v]);
        }
    }
#pragma unroll
    for (int ks = 0; ks < 2; ++ks) {
        const u16* p0 = Sb16 + (ks * 32 + quad * 8 + (li >> 2)) * KVS + 4 * (li & 3);
#pragma unroll
        for (int v = 0; v < 4; ++v) O[v] = MFMA16(tr_read2(p0 + v * 16, p0 + 4 * KVS + v * 16), qh[ks], O[v]);
    }
    if (dir == 1) {
#pragma unroll
        for (int v = 0; v < 4; ++v)
#pragma unroll
            for (int j = 0; j < 4; ++j) comb[(T * 16 + v * 4 + j) * 64 + lane] = O[v][j];
    }
    __syncthreads();
    if (dir == 0) {
        float ss = 0.f;
#pragma unroll
        for (int v = 0; v < 4; ++v)
#pragma unroll
            for (int j = 0; j < 4; ++j) { O[v][j] += comb[(T * 16 + v * 4 + j) * 64 + lane]; ss += O[v][j] * O[v][j]; }
        ss += shx(ss, 16); ss += shx(ss, 32);
        const float rstd = rsqrtf(ss * (1.f / 64.f) + EPSN);
        const size_t row = r0 + t;
#pragma unroll
        for (int v = 0; v < 4; ++v) {
            const int col = h * 64 + v * 16 + quad * 4;
            const float4 gn = *(const float4*)(p.hgrn_g + l * 512 + col);
            const uint2 g = *(const uint2*)(PJ(row, 14, col));
            uint2 wv; wv.x = pack2(O[v][0] * rstd * gn.x * siluf_(bflo(g.x)), O[v][1] * rstd * gn.y * siluf_(bfhi(g.x))); wv.y = pack2(O[v][2] * rstd * gn.z * siluf_(bflo(g.y)), O[v][3] * rstd * gn.w * siluf_(bfhi(g.y)));
            *(uint2*)(Y3 + row * 512 + col) = wv;
        }
    }
    __syncthreads();
}
#define XB_TMO      128
#define XB_XCNT(j)  (256  + 64 * (j))
#define XB_XSUB(j)  (1280 + 64 * (j))
#define XB_XGEN(j)  (2304 + 64 * (j))
#define XB_TOP      3328
#define XB_TOPGEN   3392
#define XCD_BAR_WORDS 3456
#define XB_SPIN_CAP (1u << 18)

__device__ __forceinline__ unsigned xb_ld(unsigned* p)              { return __hip_atomic_load(p, __ATOMIC_RELAXED, __HIP_MEMORY_SCOPE_AGENT); }
__device__ __forceinline__ unsigned xb_add(unsigned* p, unsigned v) { return __hip_atomic_fetch_add(p, v, __ATOMIC_RELAXED, __HIP_MEMORY_SCOPE_AGENT); }
__device__ __forceinline__ unsigned xb_xcc_id() { return (unsigned)__builtin_amdgcn_s_getreg((3 << 11) | 20) & 0xFu; }
#define XB_SPIN(cond, bar) do { unsigned _sp = 0; while (cond) { __builtin_amdgcn_s_sleep(1); \
    if ((++_sp & 255u) == 0u) { if (xb_ld(&(bar)[XB_TMO])) break; if (_sp > XB_SPIN_CAP) { atomicAdd(&(bar)[XB_TMO], 1u); break; } } } } while (0)

struct XcdBarrier {
    unsigned* bar; unsigned x;
    volatile LAS unsigned* st;
};

__device__ __forceinline__ XcdBarrier xcd_barrier_post(unsigned* bar, volatile LAS unsigned* st) {
    XcdBarrier b; b.bar = bar; b.x = xb_xcc_id(); b.st = st;
    if (tidx() == 0) (void)xb_add(&bar[XB_XCNT(b.x)], 1u);
    return b;
}
__device__ __forceinline__ void xcd_barrier_complete(unsigned* bar, unsigned x, unsigned& nloc, unsigned& nx) {
    const unsigned G = gridDim.x * gridDim.y * gridDim.z;
    unsigned sum, cnt, mine, sp = 0u;
    for (;;) {
        sum = 0u; cnt = 0u; mine = 0u;
#pragma unroll
        for (unsigned j = 0; j < 16; ++j) { const unsigned c = xb_ld(&bar[XB_XCNT(j)]); sum += c; cnt += (c > 0u) ? 1u : 0u; mine = (j == x) ? c : mine; }
        if (sum == G) break;
        __builtin_amdgcn_s_sleep(1);
        if ((++sp & 255u) == 0u) { if (xb_ld(&bar[XB_TMO])) break; if (sp > XB_SPIN_CAP) { atomicAdd(&bar[XB_TMO], 1u); break; } }
    }
    nloc = mine > 0u ? mine : 1u; nx = cnt > 0u ? cnt : 1u;
}

__device__ __forceinline__ void xcd_barrier(const XcdBarrier& b) {
    asm volatile("s_waitcnt vmcnt(0)" ::: "memory");
    __syncthreads();
    if (tidx() == 0) {
        unsigned* bar = b.bar;
        __builtin_amdgcn_s_waitcnt(0);
        unsigned nloc = b.st[0], nx = b.st[1];
        if (nloc == 0u) { xcd_barrier_complete(bar, b.x, nloc, nx); b.st[0] = nloc; b.st[1] = nx; }
        const unsigned old = xb_add(&bar[XB_XSUB(b.x)], 1u);
        const unsigned gen = old / nloc;
        if (old + 1u == (gen + 1u) * nloc) {
            __builtin_amdgcn_fence(__ATOMIC_RELEASE, "agent");
            asm volatile("s_waitcnt vmcnt(0)" ::: "memory");
            const unsigned og = xb_add(&bar[XB_TOP], 1u);
            const unsigned tg = og / nx;
            if (og + 1u == (tg + 1u) * nx) xb_add(&bar[XB_TOPGEN], 1u);
            else XB_SPIN(xb_ld(&bar[XB_TOPGEN]) == tg, bar);
            __builtin_amdgcn_fence(__ATOMIC_ACQUIRE, "agent");
            xb_add(&bar[XB_XGEN(b.x)], 1u);
            asm volatile("s_waitcnt vmcnt(0)" ::: "memory");
        } else {
            XB_SPIN(xb_ld(&bar[XB_XGEN(b.x)]) == gen, bar);
            __builtin_amdgcn_fence(__ATOMIC_ACQUIRE, "agent");
            asm volatile("s_waitcnt vmcnt(0)" ::: "memory");
        }
    }
    __syncthreads();
}

#ifndef STAG_B
#define STAG_B 240
#endif
#ifndef STAG_D
#define STAG_D 300
#endif
#ifndef REP_ATTN
#define REP_ATTN 1
#endif
#ifndef REP_B
#define REP_B 1
#endif
#ifndef REP_C1
#define REP_C1 1
#endif
#ifndef REP_C2
#define REP_C2 1
#endif
#ifndef REP_C3
#define REP_C3 1
#endif
#ifndef REP_DE
#define REP_DE 1
#endif
__device__ __forceinline__ void stagger(int ticks_per_slot) {
    const int slot = ((int)blockIdx.x >> 3) & 7;
    if (slot) { const unsigned long long t0 = __builtin_amdgcn_s_memrealtime(), dt = (unsigned long long)(slot * ticks_per_slot);
        while (__builtin_amdgcn_s_memrealtime() - t0 < dt) __builtin_amdgcn_s_sleep(4); }
}
template <class Epi> __device__ __forceinline__ void run_gemm(LAS unsigned char* lds, const u16* A, const u16* Bt, int M, int N, int K, const Epi& E) {
    pg8::Gemm g; g.A = A; g.Bt = Bt; g.M = M; g.N = N; g.K = K; g.rsA = 0; g.rsB = 0;
    pg8::StaticOrder S; S.init(M, N, (int)gridDim.x, (int)blockIdx.x);
    pg8::gemm_phase<Epi, pg8::StaticOrder, false>(lds, g, S, E, nullptr);
}


struct EpiNull {
    static constexpr bool PERM = true, AFTER_DRAIN = false;
    unsigned char* ws;
    __device__ __forceinline__ void operator()(const f32x4 (&acc)[2][2][4][2], const Unit& u, int wr, int wc, int fr, int fq) const {
        if (ws == nullptr) {
#pragma unroll
            for (int ai = 0; ai < 2; ++ai)
#pragma unroll
                for (int bj = 0; bj < 2; ++bj)
#pragma unroll
                    for (int m = 0; m < 4; ++m)
#pragma unroll
                        for (int n = 0; n < 2; ++n) *(f32x4*)(ws + (size_t)(((ai * 2 + bj) * 4 + m) * 2 + n) * 16 + fr * 1024 + fq * 65536 + wr * 4096 + wc * 16384 + u.pm) = acc[ai][bj][m][n];
        }
    }
};
struct MergeOrder : pg8::StaticOrder {
    __device__ bool next(int i, Unit& u) const { if (!pg8::StaticOrder::next(i >> 2, u)) return false; u.r = i & 3; return true; }
};
__device__ __forceinline__ Params KP() {
    auto q0 = __builtin_amdgcn_kernarg_segment_ptr();
    asm volatile("" : "+s"(q0));
    const __attribute__((address_space(4))) Params* q = (const __attribute__((address_space(4))) Params*)q0;
    Params r;
    r.x = q->x; r.c = q->c; r.ctx = q->ctx; r.c_ctx = q->c_ctx; r.w_ada = q->w_ada; r.b_ada = q->b_ada; r.g_pre = q->g_pre; r.g_post = q->g_post; r.w_in = q->w_in; r.rpb = q->rpb;
    r.fnet_w = q->fnet_w; r.gmlp_g = q->gmlp_g; r.gmlp_ws = q->gmlp_ws; r.gmlp_bs = q->gmlp_bs; r.lb_logits = q->lb_logits; r.hgrn_g = q->hgrn_g; r.w_branch = q->w_branch; r.w_out = q->w_out;
    r.out = q->out; r.ws = q->ws; return r;
}
constexpr size_t OFF_BAR = WS_END;
constexpr size_t WS_END2 = WS_END + (size_t)XCD_BAR_WORDS * 4;
__device__ __forceinline__ void gsync(LAS unsigned char* lds3) {
    XcdBarrier b; b.bar = (unsigned*)(opaque(KP().ws) + OFF_BAR); b.x = xb_xcc_id(); b.st = (volatile LAS unsigned*)(lds3 + LDS_BYTES);
    xcd_barrier(b);
}
__global__ void __launch_bounds__(512, 2) mega_fwd(Params p_unused) {
    extern __shared__ __attribute__((aligned(16))) unsigned char shm[];
    LAS unsigned char* lds3 = (LAS unsigned char*)shm;
    {
        if (tidx() < 4) ((volatile LAS unsigned*)(lds3 + LDS_BYTES))[tidx()] = 0u;
        if (blockIdx.x == 0) { unsigned* bar = (unsigned*)(opaque(KP().ws) + OFF_BAR); for (int i = tidx(); i < XCD_BAR_WORDS; i += 512) bar[i] = 0u; }
        __syncthreads();
    }
    prep1(KP(), shm);
    cg::this_grid().sync();
    { XcdBarrier b0 = xcd_barrier_post((unsigned*)(opaque(KP().ws) + OFF_BAR), (volatile LAS unsigned*)(lds3 + LDS_BYTES)); (void)b0; }
    prep2(KP(), shm);
    gsync(lds3);
#pragma nounroll
    for (int pass = 0; pass < 1 + NBATCH / GB; ++pass) {
        PassInfo ps;
        if (pass == 0) { ps.is_ctx = 1; ps.nb = NBATCH; ps.T = CTXL; ps.M = MCTX; ps.b0 = 0; }
        else { ps.is_ctx = 0; ps.nb = GB; ps.T = SEQ; ps.M = MLAT; ps.b0 = (pass - 1) * GB; }
        const int NC = ps.T >> 6;
#pragma nounroll
        for (int l = 0; l < DEPTH; ++l) {
            phase_norm(KP(), ps, l);
            gsync(lds3);
            _Pragma("nounroll") for (int rep = 0; rep < REP_B; ++rep) {
                unsigned char* ws = opaque(KP().ws);
                EpiProj E; E.ws = ws; E.l = l; E.is_ctx = ps.is_ctx;

                run_gemm(lds3, (const u16*)(ws + OFF_H), (const u16*)(ws + OFF_WTIN) + (size_t)l * NPROJ * DM, ps.M, NPROJ, DM, E);
                gsync(lds3);
#ifdef PROBE_NULL_B
                { EpiNull EN; EN.ws = ws; run_gemm(lds3, (const u16*)(ws + OFF_H), (const u16*)(ws + OFF_WTIN) + (size_t)l * NPROJ * DM, ps.M, NPROJ, DM, EN); gsync(lds3); }
#endif
            }
            const bool full = !(ps.is_ctx && l == DEPTH - 1);
            {
                const int nch = ps.nb * 16, n_at = full ? ps.nb * 8 * (ps.T >> 6) : 0, n_f1 = ps.is_ctx ? 0 : ps.nb * 64, n_g = 0;
                const int wg = (int)blockIdx.x, G = (int)gridDim.x;
                int first, stride;
                bool xl = false; int xcd = 0, lr = 0, nloc = 1;
                if (nch >= G || G != 4 * nch || (G & 7) != 0 || !full) {
                    for (int ci = wg; ci < nch; ci += G) hgrn_chain(KP(), ps, l, ci, shm);
                    first = wg; stride = G;
                } else {
                    const int g4 = wg >> 2, pos = wg & 3, cpos = (g4 >> 1) & 3;
                    first = 0x7fffffff; stride = 1;
                    if (pos == cpos) hgrn_chain(KP(), ps, l, g4, shm);
                    else {
                        xl = true; xcd = wg & 7; nloc = 0;
                        for (int w2 = xcd; w2 < G; w2 += 8) { const int g2 = w2 >> 2, nonchain = ((w2 & 3) != ((g2 >> 1) & 3)) ? 1 : 0; nloc += nonchain; if (w2 < wg) lr += nonchain; }
                    }
                }
                const int A_x = n_at >> 3, F_x = n_f1 >> 3;
                const int na = xl ? (A_x - lr + nloc - 1) / nloc : 0;
                for (int k = 0;; ++k) {
                    int it;
                    if (xl) {
                        if (k < na) { const int a = lr + k * nloc; it = (((a >> 6) << 3) + xcd) * 64 + (a & 63); }
                        else { const int f = (nloc - 1 - lr) + (k - na) * nloc; if (f >= F_x) break; it = n_at + xcd * F_x + f; }
                    } else { it = first + k * stride; if (first == 0x7fffffff || it >= n_at + n_f1 + n_g) break; }
                    if (it < n_at) attn_item(KP(), ps, l, it, shm);
                    else if (it < n_at + n_f1) four1_item(KP(), it - n_at, shm);
                    else gmlp_item(KP(), l, it - n_at - n_f1, shm);
                }
                gsync(lds3);
            }
            if (!full) continue;
            {
                const int n_f2 = ps.is_ctx ? ps.nb * 4 : ps.nb * 64, n_h3 = ps.nb * 8 * NC, n_g3 = ps.M >> 7;
                for (int it = blockIdx.x; it < n_f2 + n_h3 + n_g3; it += gridDim.x) {
                    if (it < n_f2) { if (ps.is_ctx) fourc_item(KP(), it, shm); else four2_item(KP(), it, shm); }
                    else if (it < n_f2 + n_h3) hgrn3_item(KP(), ps, l, it - n_f2, shm);
                    else gmlp_item(KP(), l, it - n_f2 - n_h3, shm);
                }
                gsync(lds3);
            }
            _Pragma("nounroll") for (int rep = 0; rep < REP_DE; ++rep) {
            {
                unsigned char* ws = opaque(KP().ws);
                pg8::Gemm g; g.A = (const u16*)(ws + OFF_Y); g.Bt = (const u16*)(ws + OFF_WTBR) + (size_t)l * 4 * 1024 * 512; g.M = ps.M; g.N = 1024; g.K = 512;
                g.rsA = (size_t)MLAT * 512 * 2; g.rsB = (size_t)1024 * 512 * 2;
                MergeOrder S; S.init(ps.M, 1024, (int)gridDim.x, (int)blockIdx.x);
                EpiMerge E; E.ws = ws;

                pg8::gemm_phase<EpiMerge, MergeOrder, false>(lds3, g, S, E, nullptr);
            }
            gsync(lds3);
            if (REP_DE > 1 && rep + 1 < REP_DE) continue;
            {
                unsigned char* ws = opaque(KP().ws);
                EpiOut E; E.C = (u16*)(ws + OFF_OUT);
                run_gemm(lds3, (const u16*)(ws + OFF_MB), (const u16*)(ws + OFF_WTOUT) + (size_t)l * 1024 * 1024, ps.M, 1024, 1024, E);
            }
            gsync(lds3);
            }
        }
        if (!ps.is_ctx) phase_norm(KP(), ps, DEPTH);
    }
}

static_assert(WS_END2 <= (size_t)1073741824, "workspace map exceeds 1 GiB");

extern "C" void kernel_launch(void* const* d_in, const int* in_sizes, int n_in, void* d_out, int out_size, void* d_ws, size_t ws_size, hipStream_t stream) {
    static int grid_blocks = 0;
    if (grid_blocks == 0) {
        if (n_in != 18 || ws_size < WS_END2) { fprintf(stderr, "kernel_launch: unexpected n_in %d or ws_size %zu (need %zu)\n", n_in, ws_size, (size_t)WS_END2); grid_blocks = -1; return; }
        int dev = 0, cus = 0, per_cu = 0;
        hipGetDevice(&dev);
        hipDeviceGetAttribute(&cus, hipDeviceAttributeMultiprocessorCount, dev);
        if (hipFuncSetAttribute((const void*)mega_fwd, hipFuncAttributeMaxDynamicSharedMemorySize, LDS_BYTES + 16) != hipSuccess) { fprintf(stderr, "kernel_launch: hipFuncSetAttribute failed\n"); grid_blocks = -1; return; }
        hipOccupancyMaxActiveBlocksPerMultiprocessor(&per_cu, (const void*)mega_fwd, 512, LDS_BYTES + 16);
        if (per_cu < 1) { fprintf(stderr, "kernel_launch: occupancy query gave %d\n", per_cu); per_cu = 1; }
        (void)hipGetLastError();
        grid_blocks = cus * per_cu;
    }
    if (grid_blocks < 0) return;
    Params p{};
    const float** pp = (const float**)&p;
    for (int i = 0; i < 18; ++i) pp[i] = (const float*)d_in[i];
    p.out = (float*)d_out; p.ws = (unsigned char*)d_ws;
    void* args[] = {&p};
    hipError_t e = hipLaunchCooperativeKernel((const void*)mega_fwd, dim3(grid_blocks), dim3(512), args, LDS_BYTES + 16, stream);
    if (e != hipSuccess) fprintf(stderr, "cooperative launch failed: %s (grid %d)\n", hipGetErrorString(e), grid_blocks);
}
```

```cpp
#include <hip/hip_runtime.h>
#include <hip/hip_cooperative_groups.h>
#include <cstdio>
namespace cg = cooperative_groups;
__device__ __forceinline__ int tidx() { int t = threadIdx.x; asm volatile("" : "+v"(t)); return t; }
template <class T> __device__ __forceinline__ T* opaque(T* p) {
    unsigned long long v = (unsigned long long)p; const unsigned lo = __builtin_amdgcn_readfirstlane((unsigned)v), hi = __builtin_amdgcn_readfirstlane((unsigned)(v >> 32));
    v = ((unsigned long long)hi << 32) | lo; asm volatile("" : "+s"(v)); return (T*)((__attribute__((address_space(1))) T*)v); }
__device__ __forceinline__ float shx(float v, int m) { const int lane = tidx() & 63; return __int_as_float(__builtin_amdgcn_ds_bpermute((lane ^ m) << 2, __float_as_int(v))); }
namespace pg8 {
#define PG8_LAS __attribute__((address_space(3)))
typedef unsigned short bf16_t;
typedef short bf16x8 __attribute__((ext_vector_type(8)));
typedef float f32x4 __attribute__((ext_vector_type(4)));
typedef unsigned u32x4 __attribute__((ext_vector_type(4)));
constexpr int BM = 256, BK = 64, HALF = 128, HTB = HALF * BK * 2  , STAGE_BYTES = 8 * HTB, NXCD = 8, WGM = 8;

__host__ __device__ __forceinline__ int lds_byte(int r, int c) { const int st = (r >> 4) * 2 + (c >> 5), rr = r & 15, cc = c & 31, ob = rr * 64 + cc * 2; return st * 1024 + (ob ^ (((ob >> 9) & 1) << 5)); }
__host__ __device__ __forceinline__ void stage_rc(int b, int& R, int& C) { const int st = b / 1024, sb = b % 1024, swz = sb ^ (((sb >> 9) & 1) << 5); R = (st >> 1) * 16 + swz / 64; C = (st & 1) * 32 + (swz % 64) / 2; }
__host__ __device__ __forceinline__ int perm32(int rho) { const int n = rho >> 4, i = rho & 15; return 8 * (i >> 2) + 4 * n + (i & 3); }

struct Unit { int pm, pn, r; };
struct Gemm { const bf16_t* A; const bf16_t* Bt; int M, N, K; size_t rsA, rsB; };

struct StaticOrder {
    int nM, nN, nwg, G, c;
    __host__ __device__ void init(int M, int N, int G_, int c_) { nM = M / BM; nN = N / BM; nwg = nM * nN; G = G_; c = c_; }
    __host__ __device__ bool next(int i, Unit& u) const {
        const long L = (long)i * G + c; if (L >= nwg) return false;
        int wgid = (int)L; { const int q = nwg / NXCD, r = nwg % NXCD, xcd = wgid % NXCD, off = wgid / NXCD; wgid = (xcd < r ? xcd * (q + 1) : r * (q + 1) + (xcd - r) * q) + off; }
        const int nig = WGM * nN, gid = wgid / nig, fm = gid * WGM, gsz = (nM - fm) < WGM ? (nM - fm) : WGM;
        u.pm = fm + ((wgid % nig) % gsz); u.pn = (wgid % nig) / gsz; u.r = 0; return true;
    }
    __device__ __forceinline__ void a_ready(const Unit&) const {}
    __device__ __forceinline__ void done(const Unit&) const {}
};
__device__ __forceinline__ unsigned cvt_pk_bf16(float lo, float hi) { unsigned r; asm volatile("v_cvt_pk_bf16_f32 %0, %1, %2" : "=v"(r) : "v"(lo), "v"(hi)); return r; }

template <class Epi, class Sched, bool STAMP = false>
__device__ __forceinline__ void gemm_phase(PG8_LAS unsigned char* lds, const Gemm g, const Sched& S, const Epi& E, unsigned long long* stamps) {
    const int tid = tidx(), wid = __builtin_amdgcn_readfirstlane(tid >> 6), lane = tid & 63, wr = wid >> 2, wc = wid & 3, fr = lane & 15, fq = lane >> 4;
    const int K = g.K, nt = K / BK;
    int ts_lo = 0, ts_hi = 0, nts = 0; const unsigned long long rt_entry = STAMP ? (unsigned long long)wall_clock64() : 0ull;
#define PG8_STAMP() do { if (STAMP && wid == 0 && nts < 64) { const unsigned long long _c = (unsigned long long)clock64(); \
        ts_lo = (lane == nts) ? (int)(unsigned)_c : ts_lo; ts_hi = (lane == nts) ? (int)(unsigned)(_c >> 32) : ts_hi; ++nts; } } while (0)
    PG8_STAMP();
    unsigned voffA[2], voffB[2];
#pragma unroll
    for (int i = 0; i < 2; ++i) { int R, C; stage_rc(tid * 16 + i * 8192, R, C); const int Rb = Epi::PERM ? ((R & ~31) + perm32(R & 31)) : R;
        voffA[i] = (unsigned)(R * K + C) * 2u; voffB[i] = (unsigned)(Rb * K + C) * 2u; }
    const size_t kstep = (size_t)(BK * 2);
    const size_t hstep = (size_t)HALF * K * 2;
    const size_t tstep = 2 * hstep;
    const unsigned ldsw = (unsigned)wid * 1024u;
    const int aoff = lds_byte(wr * 64 + fr, fq * 8), boff = lds_byte(wc * 32 + fr, fq * 8);
#define PG8_SA(b, h) (((b) * 2 + (h)) * HTB)
#define PG8_SB(b, h) ((4 + (b) * 2 + (h)) * HTB)
#define PG8_STAGE(bufoff, gbase, voff) do { _Pragma("unroll") for (int _i = 0; _i < 2; ++_i) \
        __builtin_amdgcn_global_load_lds((const unsigned*)((const char*)(gbase) + (voff)[_i]), (PG8_LAS unsigned*)(lds + (bufoff) + ldsw + _i * 8192), 16, 0, 0); } while (0)
#define PG8_LDA(dst, b, h) do { _Pragma("unroll") for (int m = 0; m < 4; ++m) _Pragma("unroll") for (int k = 0; k < 2; ++k) dst[m][k] = *(const PG8_LAS bf16x8*)(lds + PG8_SA(b, h) + aoff + m * 2048 + k * 1024); } while (0)
#define PG8_LDB(dst, b, h) do { _Pragma("unroll") for (int n = 0; n < 2; ++n) _Pragma("unroll") for (int k = 0; k < 2; ++k) dst[n][k] = *(const PG8_LAS bf16x8*)(lds + PG8_SB(b, h) + boff + n * 2048 + k * 1024); } while (0)
#define PG8_MMA(ai, bj, At, Bt) do { __builtin_amdgcn_s_setprio(1); _Pragma("unroll") for (int m = 0; m < 4; ++m) _Pragma("unroll") for (int n = 0; n < 2; ++n) _Pragma("unroll") for (int k = 0; k < 2; ++k) \
        acc[ai][bj][m][n] = __builtin_amdgcn_mfma_f32_16x16x32_bf16(Bt[n][k], At[m][k], acc[ai][bj][m][n], 0, 0, 0); __builtin_amdgcn_s_setprio(0); } while (0)
#define PG8_WAIT_V(n) asm volatile("s_waitcnt vmcnt(" #n ")" ::: "memory")
#define PG8_WAIT_L(n) asm volatile("s_waitcnt lgkmcnt(" #n ")" ::: "memory")
#define PG8_BAR __builtin_amdgcn_s_barrier()
#define PG8_SCHED __builtin_amdgcn_sched_barrier(0)
    Unit cur, nxt; int ui = 0;
    if (!S.next(0, cur)) return;
    f32x4 acc[2][2][4][2];
#pragma unroll
    for (int a = 0; a < 2; ++a)
#pragma unroll
        for (int b = 0; b < 2; ++b)
#pragma unroll
            for (int m = 0; m < 4; ++m)
#pragma unroll
                for (int n = 0; n < 2; ++n) acc[a][b][m][n] = (f32x4){0.f, 0.f, 0.f, 0.f};
    bf16x8 At[4][2], B0[2][2], B1[2][2];
    const char* cA = (const char*)g.A + (size_t)cur.pm * tstep + (size_t)cur.r * g.rsA; const char* cB = (const char*)g.Bt + (size_t)cur.pn * tstep + (size_t)cur.r * g.rsB;
    S.a_ready(cur);
    PG8_STAGE(PG8_SB(0, 0), cB, voffB); PG8_STAGE(PG8_SA(0, 0), cA, voffA); PG8_STAGE(PG8_SB(0, 1), cB + hstep, voffB); PG8_STAGE(PG8_SA(0, 1), cA + hstep, voffA);
    if (wr == 1) PG8_BAR;
    PG8_WAIT_V(4); PG8_BAR;
    PG8_STAGE(PG8_SB(1, 0), cB + kstep, voffB); PG8_STAGE(PG8_SA(1, 0), cA + kstep, voffA); PG8_STAGE(PG8_SB(1, 1), cB + hstep + kstep, voffB);
    PG8_WAIT_V(6); PG8_BAR;
    PG8_STAMP();
    for (;;) {
        const bool has_next = S.next(ui + 1, nxt);
        const char* nA = has_next ? (const char*)g.A + (size_t)nxt.pm * tstep + (size_t)nxt.r * g.rsA : cA; const char* nB = has_next ? (const char*)g.Bt + (size_t)nxt.pn * tstep + (size_t)nxt.r * g.rsB : cB;
        for (int t = 0; t < nt; t += 2) {
            const bool last = (t == nt - 2);
            const char* a1 = cA + (size_t)(t + 1) * kstep;
            const char* a2 = last ? nA : cA + (size_t)(t + 2) * kstep; const char* b2 = last ? nB : cB + (size_t)(t + 2) * kstep;
            const char* a3 = a2 + kstep; const char* b3 = b2 + kstep;
            if (last && has_next) S.a_ready(nxt);
            PG8_LDB(B0, 0, 0); PG8_SCHED; PG8_LDA(At, 0, 0); PG8_STAGE(PG8_SA(1, 1), a1 + hstep, voffA);
            PG8_WAIT_L(8); PG8_BAR; PG8_WAIT_L(0); PG8_MMA(0, 0, At, B0); PG8_BAR; PG8_SCHED;
            PG8_LDB(B1, 0, 1); PG8_STAGE(PG8_SB(0, 0), b2, voffB);
            PG8_BAR; PG8_WAIT_L(0); PG8_MMA(0, 1, At, B1); PG8_BAR;
            PG8_LDA(At, 0, 1); PG8_STAGE(PG8_SA(0, 0), a2, voffA);
            PG8_BAR; PG8_WAIT_L(0); PG8_MMA(1, 0, At, B0); PG8_BAR; PG8_SCHED;
            PG8_STAGE(PG8_SB(0, 1), b2 + hstep, voffB);
            PG8_WAIT_V(6); PG8_BAR; PG8_MMA(1, 1, At, B1); PG8_BAR;
            PG8_LDB(B0, 1, 0); PG8_SCHED; PG8_LDA(At, 1, 0); PG8_STAGE(PG8_SA(0, 1), a2 + hstep, voffA);
            PG8_WAIT_L(8); PG8_BAR; PG8_WAIT_L(0); PG8_MMA(0, 0, At, B0); PG8_BAR; PG8_SCHED;
            PG8_LDB(B1, 1, 1); PG8_STAGE(PG8_SB(1, 0), b3, voffB);
            PG8_BAR; PG8_WAIT_L(0); PG8_MMA(0, 1, At, B1); PG8_BAR;
            PG8_LDA(At, 1, 1); PG8_STAGE(PG8_SA(1, 0), a3, voffA);
            PG8_BAR; PG8_WAIT_L(0); PG8_MMA(1, 0, At, B0); PG8_BAR; PG8_SCHED;
            PG8_STAGE(PG8_SB(1, 1), b3 + hstep, voffB);
            PG8_WAIT_V(6); PG8_BAR; PG8_MMA(1, 1, At, B1); PG8_BAR;
        }
        PG8_STAMP();
        if constexpr (!Epi::AFTER_DRAIN) { E(acc, cur, wr, wc, fr, fq); S.done(cur); }
        PG8_STAMP();
        if (!has_next) break;
#pragma unroll
        for (int a = 0; a < 2; ++a)
#pragma unroll
            for (int b = 0; b < 2; ++b)
#pragma unroll
                for (int m = 0; m < 4; ++m)
#pragma unroll
                    for (int n = 0; n < 2; ++n) acc[a][b][m][n] = (f32x4){0.f, 0.f, 0.f, 0.f};
        cur = nxt; cA = nA; cB = nB; ++ui;
    }
    PG8_WAIT_V(0);
    if (wr == 0) PG8_BAR;
    PG8_BAR;
    if constexpr (Epi::AFTER_DRAIN) { E.fused(acc, cur, wr, wc, fr, fq, lds, wid, lane); S.done(cur); }
    PG8_STAMP();
    if (STAMP && wid == 0) { stamps[lane] = lane < nts ? (((unsigned long long)(unsigned)ts_hi << 32) | (unsigned)ts_lo) : 0ull;
        if (lane == 62) stamps[62] = rt_entry; if (lane == 63) stamps[63] = (unsigned long long)wall_clock64(); }
#undef PG8_STAMP
#undef PG8_SA
#undef PG8_SB
#undef PG8_STAGE
#undef PG8_LDA
#undef PG8_LDB
#undef PG8_MMA
#undef PG8_WAIT_V
#undef PG8_WAIT_L
#undef PG8_BAR
#undef PG8_SCHED
}
}

typedef unsigned short u16;
typedef short s16x4 __attribute__((ext_vector_type(4)));
using pg8::bf16x8; using pg8::f32x4; using pg8::Unit;
#define LAS __attribute__((address_space(3)))
#define MFMA16(a, b, c) __builtin_amdgcn_mfma_f32_16x16x32_bf16(a, b, c, 0, 0, 0)

constexpr int DM = 1024, NBATCH = 16, SEQ = 4096, DEPTH = 4, CTXL = 256, NPROJ = 11776, NIN = 11264;
constexpr int GB = 4, MLAT = GB * SEQ, MCTX = NBATCH * CTXL;
constexpr int LDS_BYTES = 152 * 1024;
constexpr float LOG2E = 1.4426950408889634f;
constexpr float EPSN = 1e-6f;
constexpr float QSCALE = 0.125f * 1.4426950408889634f;

constexpr size_t al256(size_t x) { return (x + 255) & ~(size_t)255; }
constexpr size_t OFF_WTIN = 0;
constexpr size_t OFF_WTBR = OFF_WTIN + (size_t)DEPTH * NPROJ * DM * 2;
constexpr size_t OFF_WTOUT = OFF_WTBR + (size_t)DEPTH * 4 * 1024 * 512 * 2;
constexpr size_t OFF_WS16 = OFF_WTOUT + (size_t)DEPTH * 1024 * 1024 * 2;
constexpr size_t OFF_MOD = OFF_WS16 + (size_t)DEPTH * 8 * 128 * 128 * 2;
constexpr size_t OFF_LB = OFF_MOD + al256((size_t)DEPTH * 17 * 3072 * 4);
constexpr size_t OFF_ROPE = OFF_LB + (size_t)DEPTH * 2 * 512 * 4;
constexpr size_t OFF_TW = OFF_ROPE + 2 * 64 * 16 * 4;
constexpr size_t OFF_M1 = OFF_TW + 4096 * 8;
constexpr size_t OFF_M2 = OFF_M1 + 128 * 128 * 2;
constexpr size_t OFF_M3 = OFF_M2 + 64 * 128 * 2;
constexpr size_t OFF_CSW = OFF_M3 + 256 * 512 * 2;
constexpr size_t OFF_CTXW = OFF_CSW + (size_t)DEPTH * 4 * 2 * 128 * 128 * 4;
constexpr size_t OFF_CTXKV = OFF_CTXW + (size_t)NBATCH * CTXL * DM * 4;
constexpr size_t OFF_CTXST = OFF_CTXKV + (size_t)DEPTH * MCTX * 1024 * 2;
constexpr size_t OFF_H = OFF_CTXST + (size_t)DEPTH * 256 * 4096 * 4;
constexpr size_t OFF_PROJ = OFF_H + (size_t)MLAT * DM * 2;
constexpr size_t OFF_QROT = OFF_PROJ + (size_t)MLAT * NPROJ * 2;
constexpr size_t OFF_LOGF = OFF_QROT + (size_t)MLAT * 512 * 2;
constexpr size_t OFF_Y = OFF_LOGF + (size_t)MLAT * 1024 * 4;
constexpr size_t OFF_FY = OFF_Y + (size_t)4 * MLAT * 512 * 2;
constexpr size_t OFF_HL = OFF_FY + (size_t)GB * 4096 * 1024 * 2;
constexpr size_t OFF_HD = OFF_HL + (size_t)4096 * 4096 * 4;
constexpr size_t OFF_HS = OFF_HD + (size_t)4096 * 64 * 4;
constexpr size_t OFF_MB = OFF_HS + (size_t)4096 * 4096 * 4;
constexpr size_t WS_END = OFF_MB + (size_t)MLAT * DM * 2;
constexpr size_t OFF_MERGED = OFF_LOGF;
constexpr size_t OFF_OUT = OFF_PROJ;

struct Params {
    const float *x, *c, *ctx, *c_ctx, *w_ada, *b_ada, *g_pre, *g_post, *w_in, *rpb, *fnet_w, *gmlp_g, *gmlp_ws, *gmlp_bs, *lb_logits, *hgrn_g, *w_branch, *w_out;
    float* out; unsigned char* ws;
};
struct PassInfo { int is_ctx, nb, T, M, b0; };

__device__ __forceinline__ u16 f2bf(float f) { unsigned u = __float_as_uint(f); u += 0x7FFFu + ((u >> 16) & 1u); return (u16)(u >> 16); }
__device__ __forceinline__ float bf2f(u16 b) { return __uint_as_float(((unsigned)b) << 16); }
typedef __bf16 bf16x2_t_ __attribute__((ext_vector_type(2)));
typedef float f32x2_t_ __attribute__((ext_vector_type(2)));
__device__ __forceinline__ unsigned pack2(float a, float b) { f32x2_t_ v = {a, b}; bf16x2_t_ r = __builtin_convertvector(v, bf16x2_t_); return __builtin_bit_cast(unsigned, r); }
__device__ __forceinline__ float bflo(unsigned w) { return __uint_as_float(w << 16); }
__device__ __forceinline__ float bfhi(unsigned w) { return __uint_as_float(w & 0xFFFF0000u); }
__device__ __forceinline__ float sigmoidf_(float v) { return __builtin_amdgcn_rcpf(1.f + __builtin_amdgcn_exp2f(-LOG2E * v)); }
__device__ __forceinline__ float siluf_(float v) { return v * __builtin_amdgcn_rcpf(1.f + __builtin_amdgcn_exp2f(-LOG2E * v)); }
__device__ __forceinline__ void unpack8(uint4 w, float* f) { f[0] = bflo(w.x); f[1] = bfhi(w.x); f[2] = bflo(w.y); f[3] = bfhi(w.y); f[4] = bflo(w.z); f[5] = bfhi(w.z); f[6] = bflo(w.w); f[7] = bfhi(w.w); }
__device__ __forceinline__ bf16x8 tr_read2(const u16* p0, const u16* p1) {
    s16x4 a = __builtin_amdgcn_ds_read_tr16_b64_v4i16((LAS s16x4*)p0);
    s16x4 b = __builtin_amdgcn_ds_read_tr16_b64_v4i16((LAS s16x4*)p1);
    return (bf16x8){a[0], a[1], a[2], a[3], b[0], b[1], b[2], b[3]};
}
__device__ __forceinline__ bf16x8 ld_frag_g(const u16* p) { return *(const bf16x8*)p; }

typedef unsigned u32x4_ __attribute__((ext_vector_type(4)));
__device__ __forceinline__ void nt_store16(uint4 w, void* p) { __builtin_nontemporal_store((u32x4_){w.x, w.y, w.z, w.w}, (u32x4_*)p); }
struct EpiProj {
    static constexpr bool PERM = true, AFTER_DRAIN = false;
    unsigned char* ws; int l; int is_ctx;
    __device__ __forceinline__ void operator()(const f32x4 (&acc)[2][2][4][2], const Unit& u, int wr, int wc, int fr, int fq) const {
        u16* proj = (u16*)(ws + OFF_PROJ);
        const int blk = u.pn >> 1;
        const int row0 = u.pm * 256 + wr * 64 + fr, col0 = u.pn * 256 + wc * 32 + 8 * fq;
        u16* pbase = proj + ((size_t)blk * MLAT + row0) * 512 + (col0 & 511);
        if ((blk == 0 || blk == 1) && !is_ctx) {
            u16* qrot = (u16*)(ws + OFF_QROT); const float* rope = (const float*)(ws + OFF_ROPE);
            const int f0 = 8 * (fq & 1); const float sgn = (fq >> 1) ? 1.f : -1.f;
#pragma unroll
            for (int ai = 0; ai < 2; ++ai)
#pragma unroll
                for (int m = 0; m < 4; ++m) {
                    const int row = row0 + ai * 128 + m * 16;
                    const int t = row & 4095, pos = (wc & 1) ? (t & 63) : (t >> 6);
                    const float4 c0 = *(const float4*)(rope + pos * 16 + f0), c1 = *(const float4*)(rope + pos * 16 + f0 + 4);
                    const float4 s0 = *(const float4*)(rope + 1024 + pos * 16 + f0), s1 = *(const float4*)(rope + 1024 + pos * 16 + f0 + 4);
                    const float cs[8] = {c0.x, c0.y, c0.z, c0.w, c1.x, c1.y, c1.z, c1.w}, sn[8] = {s0.x, s0.y, s0.z, s0.w, s1.x, s1.y, s1.z, s1.w};
#pragma unroll
                    for (int bj = 0; bj < 2; ++bj) {
                        const f32x4 v0 = acc[ai][bj][m][0], v1 = acc[ai][bj][m][1];
                        const float qs_ = (blk == 0) ? QSCALE : 1.f;
                        const float o[8] = {v0[0] * qs_, v0[1] * qs_, v0[2] * qs_, v0[3] * qs_, v1[0] * qs_, v1[1] * qs_, v1[2] * qs_, v1[3] * qs_};
                        float r[8];
#pragma unroll
                        for (int e = 0; e < 8; ++e) { const float pr = shx(o[e], 32); r[e] = o[e] * cs[e] + sgn * pr * sn[e]; }
                        uint4 wr_; wr_.x = pack2(r[0], r[1]); wr_.y = pack2(r[2], r[3]); wr_.z = pack2(r[4], r[5]); wr_.w = pack2(r[6], r[7]);
                        u16* dst = pbase + (size_t)(ai * 128 + m * 16) * 512 + bj * 128;
                        if (blk == 0) {
                            uint4 wp; wp.x = pack2(o[0], o[1]); wp.y = pack2(o[2], o[3]); wp.z = pack2(o[4], o[5]); wp.w = pack2(o[6], o[7]);
                            nt_store16(wp, dst);
                            nt_store16(wr_, qrot + (size_t)row * 512 + (col0 & 511) + bj * 128);
                        } else nt_store16(wr_, dst);
                    }
                }
        } else if (blk == 11 || blk == 12) {
            float* logf = (float*)(ws + OFF_LOGF); const float* lb = (const float*)(ws + OFF_LB) + l * 1024;
            const int dir = blk - 11;
#pragma unroll
            for (int bj = 0; bj < 2; ++bj) {
                const int cc = (col0 & 511) + bj * 128;
                const float4 l0 = *(const float4*)(lb + dir * 512 + cc), l1 = *(const float4*)(lb + dir * 512 + cc + 4);
                const float lbv[8] = {l0.x, l0.y, l0.z, l0.w, l1.x, l1.y, l1.z, l1.w};
#pragma unroll
                for (int ai = 0; ai < 2; ++ai)
#pragma unroll
                    for (int m = 0; m < 4; ++m) {
                        const int row = row0 + ai * 128 + m * 16;
                        const f32x4 v0 = acc[ai][bj][m][0], v1 = acc[ai][bj][m][1];
                        const float z[8] = {v0[0], v0[1], v0[2], v0[3], v1[0], v1[1], v1[2], v1[3]};
                        float lf[8], o[8];
#pragma unroll
                        for (int e = 0; e < 8; ++e) {
                            const float ez = __expf(-z[e]);
                            const float inv = __builtin_amdgcn_rcpf(1.f + ez);
                            const float sg = inv, sgn_ = (ez > 1e30f) ? 1.f : ez * inv;
                            const float f = lbv[e] + (1.f - lbv[e]) * sg;
                            lf[e] = __logf(fmaxf(f, 1e-30f));
                            o[e] = (1.f - lbv[e]) * sgn_;
                        }
                        float* lp = logf + (size_t)row * 1024 + dir * 512 + cc;
                        __builtin_nontemporal_store((f32x4){lf[0], lf[1], lf[2], lf[3]}, (f32x4*)lp); __builtin_nontemporal_store((f32x4){lf[4], lf[5], lf[6], lf[7]}, (f32x4*)(lp + 4));
                        uint4 w; w.x = pack2(o[0], o[1]); w.y = pack2(o[2], o[3]); w.z = pack2(o[4], o[5]); w.w = pack2(o[6], o[7]);
                        nt_store16(w, pbase + (size_t)(ai * 128 + m * 16) * 512 + bj * 128);
                    }
            }
        } else {
            const bool copy = is_ctx && (blk == 1 || blk == 2);
            const float qs_ = (blk == 0) ? QSCALE : 1.f;
            u16* cbase = (u16*)(ws + OFF_CTXKV) + (size_t)l * MCTX * 1024 + (size_t)row0 * 1024 + (blk - 1) * 512 + (col0 & 511);
            if (!copy) {
#pragma unroll
                for (int ai = 0; ai < 2; ++ai)
#pragma unroll
                    for (int m = 0; m < 4; ++m)
#pragma unroll
                        for (int bj = 0; bj < 2; ++bj) {
                            const f32x4 v0 = acc[ai][bj][m][0], v1 = acc[ai][bj][m][1];
                            uint4 w; w.x = pack2(v0[0] * qs_, v0[1] * qs_); w.y = pack2(v0[2] * qs_, v0[3] * qs_); w.z = pack2(v1[0] * qs_, v1[1] * qs_); w.w = pack2(v1[2] * qs_, v1[3] * qs_);
                            nt_store16(w, pbase + (size_t)(ai * 128 + m * 16) * 512 + bj * 128);
                        }
            } else {
#pragma unroll
                for (int ai = 0; ai < 2; ++ai)
#pragma unroll
                    for (int m = 0; m < 4; ++m)
#pragma unroll
                        for (int bj = 0; bj < 2; ++bj) {
                            const f32x4 v0 = acc[ai][bj][m][0], v1 = acc[ai][bj][m][1];
                            uint4 w; w.x = pack2(v0[0], v0[1]); w.y = pack2(v0[2], v0[3]); w.z = pack2(v1[0], v1[1]); w.w = pack2(v1[2], v1[3]);
                            nt_store16(w, pbase + (size_t)(ai * 128 + m * 16) * 512 + bj * 128);
                            *(uint4*)(cbase + (size_t)(ai * 128 + m * 16) * 1024 + bj * 128) = w;
                        }
            }
        }
    }
};
struct EpiMerge {
    static constexpr bool PERM = true, AFTER_DRAIN = false;
    unsigned char* ws;
    template <int MODE> __device__ __forceinline__ void run(const f32x4 (&acc)[2][2][4][2], const Unit& u, int wr, int wc, int fr, int fq) const {
        const u16* proj = (const u16*)(ws + OFF_PROJ); u16* mb = (u16*)(ws + OFF_MB);
        const int row0 = u.pm * 256 + wr * 64 + fr, col0 = u.pn * 256 + wc * 32 + 8 * fq, R = u.r;
        const int gcol0 = 7680 + R * 1024 + col0;
        const u16* gbase = proj + ((size_t)(gcol0 >> 9) * MLAT + row0) * 512 + (gcol0 & 511);
        u16* obase = mb + (size_t)row0 * 1024 + col0;
        uint4 g[2][4], old[2][4];
#define MG_LOAD(st, buf) do { _Pragma("unroll") for (int q = 0; q < 4; ++q) { const int ai_ = (st) >> 1, m_ = ((st) & 1) * 2 + (q >> 1), co_ = (q & 1) * 128; const size_t ro_ = (size_t)(ai_ * 128 + m_ * 16); \
            g[buf][q] = *(const uint4*)(gbase + ro_ * 512 + co_); if (MODE > 0) old[buf][q] = *(const uint4*)(obase + ro_ * 1024 + co_); } } while (0)
        MG_LOAD(0, 0);
#pragma unroll
        for (int st = 0; st < 4; ++st) {
            const int buf = st & 1;
            if (st + 1 < 4) MG_LOAD(st + 1, buf ^ 1);
            __builtin_amdgcn_sched_barrier(0);
#pragma unroll
            for (int q = 0; q < 4; ++q) { const int ai = st >> 1, m = (st & 1) * 2 + (q >> 1), bj = q & 1, co = bj * 128; const size_t ro = (size_t)(ai * 128 + m * 16);
                const f32x4 v0 = acc[ai][bj][m][0], v1 = acc[ai][bj][m][1];
                float gf[8]; unpack8(g[buf][q], gf);
                float o[8] = {v0[0] * sigmoidf_(gf[0]), v0[1] * sigmoidf_(gf[1]), v0[2] * sigmoidf_(gf[2]), v0[3] * sigmoidf_(gf[3]), v1[0] * sigmoidf_(gf[4]), v1[1] * sigmoidf_(gf[5]), v1[2] * sigmoidf_(gf[6]), v1[3] * sigmoidf_(gf[7])};
                if (MODE > 0) { float of[8]; unpack8(old[buf][q], of);
#pragma unroll
                    for (int e = 0; e < 8; ++e) o[e] += of[e]; }
                uint4 w; w.x = pack2(o[0], o[1]); w.y = pack2(o[2], o[3]); w.z = pack2(o[4], o[5]); w.w = pack2(o[6], o[7]);
                *(uint4*)(obase + ro * 1024 + co) = w; }
        }
#undef MG_LOAD
    }
    __device__ __forceinline__ void operator()(const f32x4 (&acc)[2][2][4][2], const Unit& u, int wr, int wc, int fr, int fq) const {
        if (u.r == 0) run<0>(acc, u, wr, wc, fr, fq);
        else run<1>(acc, u, wr, wc, fr, fq);
    }
};
struct EpiOut {
    static constexpr bool PERM = true, AFTER_DRAIN = false;
    u16* C;
    __device__ __forceinline__ void operator()(const f32x4 (&acc)[2][2][4][2], const Unit& u, int wr, int wc, int fr, int fq) const {
        const int row0 = u.pm * 256 + wr * 64 + fr, col0 = u.pn * 256 + wc * 32 + 8 * fq;
#pragma unroll
        for (int ai = 0; ai < 2; ++ai)
#pragma unroll
            for (int m = 0; m < 4; ++m) { u16* rowp = C + (size_t)(row0 + ai * 128 + m * 16) * 1024 + col0;
#pragma unroll
                for (int bj = 0; bj < 2; ++bj) { const f32x4 v0 = acc[ai][bj][m][0], v1 = acc[ai][bj][m][1];
                    uint4 w; w.x = pack2(v0[0], v0[1]); w.y = pack2(v0[2], v0[3]); w.z = pack2(v1[0], v1[1]); w.w = pack2(v1[2], v1[3]); *(uint4*)(rowp + bj * 128) = w; } }
    }
};

__device__ void transpose_tile(const float* src, int lds_, u16* dst, int ldd, int k0, int n0s, int n0d, u16* t) {
    const int tid = tidx();
#pragma unroll
    for (int it = 0; it < 2; ++it) {
        const int kk = (tid >> 4) + it * 32, nn = (tid & 15) * 4;
        const float4 v = *(const float4*)(src + (size_t)(k0 + kk) * lds_ + n0s + nn);
        t[(nn + 0) * 72 + kk] = f2bf(v.x); t[(nn + 1) * 72 + kk] = f2bf(v.y); t[(nn + 2) * 72 + kk] = f2bf(v.z); t[(nn + 3) * 72 + kk] = f2bf(v.w);
    }
    __syncthreads();
    { const int n = tid >> 3, k8 = (tid & 7) * 8;
      const uint4 v = *(const uint4*)(t + n * 72 + k8);
      *(uint4*)(dst + (size_t)(n0d + n) * ldd + k0 + k8) = v; }
    __syncthreads();
}

__device__ void prep1(const Params& p, unsigned char* lds) {
    unsigned char* ws = opaque(p.ws);
    const int tid = tidx();
    const size_t gt = (size_t)blockIdx.x * 512 + tid, gn = (size_t)gridDim.x * 512;
    { u16* ws16 = (u16*)(ws + OFF_WS16);
      for (size_t i = gt; i < (size_t)DEPTH * 8 * 128 * 128; i += gn) ws16[i] = f2bf(p.gmlp_ws[i]);
      float* lbp = (float*)(ws + OFF_LB);
      for (size_t i = gt; i < 1024; i += gn) {
          float e[DEPTH], mx = -1e30f, sum = 0.f;
#pragma unroll
          for (int l = 0; l < DEPTH; ++l) { e[l] = p.lb_logits[l * 1024 + i]; mx = fmaxf(mx, e[l]); }
#pragma unroll
          for (int l = 0; l < DEPTH; ++l) { e[l] = expf(e[l] - mx); sum += e[l]; }
          float run = 0.f;
#pragma unroll
          for (int l = 0; l < DEPTH; ++l) { if (l > 0) run += e[l] / sum; lbp[l * 1024 + i] = fmaxf(run, 0.f); }
      }
      float* rope = (float*)(ws + OFF_ROPE);
      for (size_t i = gt; i < 1024; i += gn) { const int pos = (int)(i >> 4), f = (int)(i & 15);
          const float inv = powf(10000.f, -(float)f * 2.0f / 32.0f), ang = (float)pos * inv;
          rope[i] = cosf(ang); rope[1024 + i] = sinf(ang); }
      float* tw = (float*)(ws + OFF_TW);
      for (size_t i = gt; i < 4096; i += gn) { float s, c; sincospif((float)i * (2.0f / 4096.0f), &s, &c); tw[2 * i] = c; tw[2 * i + 1] = s; }
      u16* m1 = (u16*)(ws + OFF_M1);
      for (size_t i = gt; i < 128 * 128; i += gn) { const int ii = (int)(i >> 7), kk = (int)(i & 127), k1 = ii >> 1, po = ii & 1, n1 = kk >> 1, pi = kk & 1;
          float s, c; sincospif((float)((k1 * n1) & 63) * (2.0f / 64.0f), &s, &c);
          const float v = (po == 0) ? (pi == 0 ? c : -s) : (pi == 0 ? -s : -c);
          m1[i] = f2bf(v); }
      u16* m2 = (u16*)(ws + OFF_M2);
      for (size_t i = gt; i < 64 * 128; i += gn) { const int k2 = (int)(i >> 7), kk = (int)(i & 127), n2 = kk >> 1, pi = kk & 1;
          float s, c; sincospif((float)((k2 * n2) & 63) * (2.0f / 64.0f), &s, &c);
          m2[i] = f2bf(pi == 0 ? c : s); }
      u16* m3 = (u16*)(ws + OFF_M3);
      for (size_t i = gt; i < 256 * 512; i += gn) { const int k = (int)(i >> 9), kk = (int)(i & 511), n = kk >> 1, pi = kk & 1;
          float s, c; sincospif((float)((k * n) & 255) * (2.0f / 256.0f), &s, &c);
          m3[i] = f2bf(pi == 0 ? c : -s); }
    }
    constexpr int N_WIN = DEPTH * 176 * 16, N_WBR = 16 * 16 * 8, N_WOUT = DEPTH * 16 * 16, N_MOD = DEPTH * 48, N_CSW = DEPTH * 4 * 2 * 2;
    constexpr int TOT = N_WIN + N_WBR + N_WOUT + N_MOD + N_CSW;
    for (int it = blockIdx.x; it < TOT; it += gridDim.x) {
        int idx = it;
        if (idx < N_WIN) {
            const int l = idx / 2816, rem = idx % 2816, cb = rem >> 4, kb = rem & 15, n0 = cb * 64;
            if (n0 >= 2048 && n0 < 2560) continue;
            const int n0d = n0 < 2048 ? n0 : n0 + 512;
            transpose_tile(p.w_in + (size_t)l * DM * NIN, NIN, (u16*)(ws + OFF_WTIN) + (size_t)l * NPROJ * DM, DM, kb * 64, n0, n0d, (u16*)lds);
            continue;
        }
        idx -= N_WIN;
        if (idx < N_WBR) {
            const int mat = idx >> 7, rem = idx & 127, cb = rem >> 3, kb = rem & 7;
            transpose_tile(p.w_branch + (size_t)mat * 512 * 1024, 1024, (u16*)(ws + OFF_WTBR) + (size_t)mat * 1024 * 512, 512, kb * 64, cb * 64, cb * 64, (u16*)lds);
            continue;
        }
        idx -= N_WBR;
        if (idx < N_WOUT) {
            const int l = idx >> 8, rem = idx & 255, cb = rem >> 4, kb = rem & 15;
            transpose_tile(p.w_out + (size_t)l * 1024 * 1024, 1024, (u16*)(ws + OFF_WTOUT) + (size_t)l * 1024 * 1024, 1024, kb * 64, cb * 64, cb * 64, (u16*)lds);
            continue;
        }
        idx -= N_WOUT;
        if (idx < N_MOD) {
            const int l = idx / 48, cb = idx % 48;
            float* s = (float*)lds; float* red = s + 17 * 1024;
            for (int i = tid; i < 17 * 1024; i += 512) { const int j = i >> 10, k = i & 1023; const float v = j < 16 ? p.c[j * 1024 + k] : p.c_ctx[k]; s[i] = v / (1.f + expf(-v)); }
            __syncthreads();
            const int col = tid & 63, ks = tid >> 6;
            float acc[17];
#pragma unroll
            for (int j = 0; j < 17; ++j) acc[j] = 0.f;
            for (int k = ks * 128; k < ks * 128 + 128; ++k) {
                const float w = p.w_ada[((size_t)l * 1024 + k) * 3072 + cb * 64 + col];
#pragma unroll
                for (int j = 0; j < 17; ++j) acc[j] += s[j * 1024 + k] * w;
            }
#pragma unroll
            for (int j = 0; j < 17; ++j) red[(ks * 17 + j) * 64 + col] = acc[j];
            __syncthreads();
            for (int o = tid; o < 17 * 64; o += 512) { const int j = o >> 6, cc = o & 63; float sum = 0.f;
                for (int q = 0; q < 8; ++q) sum += red[(q * 17 + j) * 64 + cc];
                ((float*)(ws + OFF_MOD))[((size_t)l * 17 + j) * 3072 + cb * 64 + cc] = sum + p.b_ada[l * 3072 + cb * 64 + cc]; }
            __syncthreads();
            continue;
        }
        idx -= N_MOD;
        {
            const int cblk = idx & 1, part = (idx >> 1) & 1, g = (idx >> 2) & 3, l = idx >> 4;
            float* tb = (float*)lds;
            if (tid < 128) { float s, c; sincospif((float)tid * (2.0f / 128.0f), &s, &c); tb[tid] = part ? s : c; }
            __syncthreads();
            const int d = tid & 127, cq = tid >> 7;
            float acc[16];
#pragma unroll
            for (int i = 0; i < 16; ++i) acc[i] = 0.f;
            const float* wf = p.fnet_w + ((size_t)(l * 4 + g) * 128) * 128;
            for (int c2 = 0; c2 < 128; ++c2) {
                const float w = wf[c2 * 128 + d];
#pragma unroll
                for (int i = 0; i < 16; ++i) { const int c = cblk * 64 + cq * 16 + i; acc[i] += tb[(c * c2) & 127] * w; }
            }
            float* dst = (float*)(ws + OFF_CSW) + ((size_t)((l * 4 + g) * 2 + part) * 128) * 128;
#pragma unroll
            for (int i = 0; i < 16; ++i) dst[(cblk * 64 + cq * 16 + i) * 128 + d] = acc[i];
            __syncthreads();
        }
    }
}

__device__ void prep2(const Params& p, unsigned char* lds) {
    unsigned char* ws = opaque(p.ws);
    const int tid = tidx();
    float* wb = (float*)lds;
    float* cw = wb + 64 * 129;
    for (int it = blockIdx.x; it < DEPTH * 4 * 2 * 16; it += gridDim.x) {
        const int kb = it & 15, part = (it >> 4) & 1, g = (it >> 5) & 3, l = it >> 7;
        for (int i = tid; i < 64 * 128; i += 512) { const int kk = i >> 7, c = i & 127; wb[kk * 129 + c] = p.w_in[((size_t)l * 1024 + kb * 64 + kk) * NIN + 2048 + g * 128 + c]; }
        const float* src = (const float*)(ws + OFF_CSW) + ((size_t)((l * 4 + g) * 2 + part) * 128) * 128;
        for (int i = tid; i < 128 * 128; i += 512) cw[i] = src[i];
        __syncthreads();
        const int d = tid & 127, kq = tid >> 7;
        float acc[16];
#pragma unroll
        for (int i = 0; i < 16; ++i) acc[i] = 0.f;
        for (int c = 0; c < 128; ++c) {
            const float w = cw[c * 128 + d];
#pragma unroll
            for (int i = 0; i < 16; ++i) acc[i] += wb[(kq * 16 + i) * 129 + c] * w;
        }
        u16* dst = (u16*)(ws + OFF_WTIN) + ((size_t)l * NPROJ + (4 + part) * 512 + g * 128 + d) * DM + kb * 64 + kq * 16;
        uint4 w0, w1;
        w0.x = pack2(acc[0], acc[1]); w0.y = pack2(acc[2], acc[3]); w0.z = pack2(acc[4], acc[5]); w0.w = pack2(acc[6], acc[7]);
        w1.x = pack2(acc[8], acc[9]); w1.y = pack2(acc[10], acc[11]); w1.z = pack2(acc[12], acc[13]); w1.w = pack2(acc[14], acc[15]);
        *(uint4*)dst = w0; *(uint4*)(dst + 8) = w1;
        __syncthreads();
    }
}

__device__ void phase_norm(const Params& p, const PassInfo ps, int l) {
    unsigned char* ws = opaque(p.ws);
    const int wave = tidx() >> 6, lane = tidx() & 63;
    const float* mod = (const float*)(ws + OFF_MOD);
    const u16* OUT = (const u16*)(ws + OFF_OUT);
    u16* H = (u16*)(ws + OFF_H);
    for (int rr = blockIdx.x * 8 + wave; rr < ps.M; rr += gridDim.x * 8) {
        const int tsh = ps.is_ctx ? 8 : 12; const int b = ps.b0 + (rr >> tsh), t = rr & (ps.T - 1), mrow = ps.is_ctx ? 16 : b;
        const size_t xoff = ((size_t)b * ps.T + t) * 1024;
        const float* xin = (l <= 1) ? ((ps.is_ctx ? p.ctx : p.x) + xoff) : ((ps.is_ctx ? (const float*)(ws + OFF_CTXW) : (const float*)p.out) + xoff);
        float* xout = (ps.is_ctx ? (float*)(ws + OFF_CTXW) : p.out) + xoff;
        float xv[16];
#pragma unroll
        for (int hlf = 0; hlf < 2; ++hlf) {
            const int c0 = hlf * 512 + lane * 8;
            const float4 a = *(const float4*)(xin + c0), bq = *(const float4*)(xin + c0 + 4);
            xv[hlf * 8 + 0] = a.x; xv[hlf * 8 + 1] = a.y; xv[hlf * 8 + 2] = a.z; xv[hlf * 8 + 3] = a.w;
            xv[hlf * 8 + 4] = bq.x; xv[hlf * 8 + 5] = bq.y; xv[hlf * 8 + 6] = bq.z; xv[hlf * 8 + 7] = bq.w;
        }
        if (l > 0) {
            float ov[16]; float ss = 0.f;
#pragma unroll
            for (int hlf = 0; hlf < 2; ++hlf) {
                const int c0 = hlf * 512 + lane * 8;
                unpack8(*(const uint4*)(OUT + (size_t)rr * 1024 + c0), ov + hlf * 8);
            }
#pragma unroll
            for (int e = 0; e < 16; ++e) ss += ov[e] * ov[e];
#pragma unroll
            for (int o = 32; o > 0; o >>= 1) ss += shx(ss, o);
            const float rstd = rsqrtf(ss * (1.f / 1024.f) + EPSN);
            const float* gt = mod + ((size_t)(l - 1) * 17 + mrow) * 3072 + 2048;
            const float* gp = p.g_post + (l - 1) * 1024;
#pragma unroll
            for (int hlf = 0; hlf < 2; ++hlf) {
                const int c0 = hlf * 512 + lane * 8;
#pragma unroll
                for (int e = 0; e < 8; ++e) xv[hlf * 8 + e] += gt[c0 + e] * (ov[hlf * 8 + e] * rstd * gp[c0 + e]);
                *(float4*)(xout + c0) = make_float4(xv[hlf * 8 + 0], xv[hlf * 8 + 1], xv[hlf * 8 + 2], xv[hlf * 8 + 3]);
                *(float4*)(xout + c0 + 4) = make_float4(xv[hlf * 8 + 4], xv[hlf * 8 + 5], xv[hlf * 8 + 6], xv[hlf * 8 + 7]);
            }
        }
        if (l < DEPTH) {
            float ss = 0.f;
#pragma unroll
            for (int e = 0; e < 16; ++e) ss += xv[e] * xv[e];
#pragma unroll
            for (int o = 32; o > 0; o >>= 1) ss += shx(ss, o);
            const float rstd = rsqrtf(ss * (1.f / 1024.f) + EPSN);
            const float* sh = mod + ((size_t)l * 17 + mrow) * 3072; const float* sc = sh + 1024;
            const float* gp = p.g_pre + l * 1024;
#pragma unroll
            for (int hlf = 0; hlf < 2; ++hlf) {
                const int c0 = hlf * 512 + lane * 8;
                float hv[8];
#pragma unroll
                for (int e = 0; e < 8; ++e) hv[e] = xv[hlf * 8 + e] * rstd * gp[c0 + e] * (1.f + sc[c0 + e]) + sh[c0 + e];
                uint4 w; w.x = pack2(hv[0], hv[1]); w.y = pack2(hv[2], hv[3]); w.z = pack2(hv[4], hv[5]); w.w = pack2(hv[6], hv[7]);
                *(uint4*)(H + (size_t)rr * 1024 + c0) = w;
            }
        }
    }
}

#define PJ(row, blk, c) (PROJ + ((size_t)(blk) * MLAT + (row)) * 512 + (c))
typedef unsigned u32x32_ __attribute__((ext_vector_type(32)));
struct Reg8 {
    u32x32_ v;
    __device__ __forceinline__ void ld(int i, const void* p) { const u32x4_ a = *(const u32x4_*)p; v[4 * i] = a[0]; v[4 * i + 1] = a[1]; v[4 * i + 2] = a[2]; v[4 * i + 3] = a[3]; }
    __device__ __forceinline__ u32x4_ get(int i) const { return (u32x4_){v[4 * i], v[4 * i + 1], v[4 * i + 2], v[4 * i + 3]}; }
    __device__ __forceinline__ uint4 getu(int i) const { uint4 r; r.x = v[4 * i]; r.y = v[4 * i + 1]; r.z = v[4 * i + 2]; r.w = v[4 * i + 3]; return r; }
};
#define MEMBAR() asm volatile("" ::: "memory")
constexpr int KVS = 72;
constexpr int TS = 528;
constexpr int T3S = 136;
constexpr int HS_ = 68;
constexpr float NORM_LAT = 0.0013810679320049757f;
constexpr float NORM_CTX = 0.005524271728019903f;

__device__ void attn_item(const Params& p, const PassInfo ps, int l, int item, unsigned char* lds) {
    unsigned char* ws = opaque(p.ws);
    const u16* PROJ = (const u16*)(ws + OFF_PROJ); const u16* QROT = (const u16*)(ws + OFF_QROT);
    const u16* CKV = (const u16*)(ws + OFF_CTXKV) + (size_t)l * MCTX * 1024;
    u16* Y0 = (u16*)(ws + OFF_Y);
    const int tid = tidx(), w = tid >> 6, lane = tid & 63, qtr = w & 3, kh = w >> 2, li = lane & 15, quad = lane >> 4;
    u16* Kl = (u16*)lds; u16* Vl = Kl + 512 * KVS; float* rp = (float*)(Vl + 512 * KVS);
    int bl, h, r = 0, qrow0, bglob;
    if (!ps.is_ctx) { r = item & 63; h = (item >> 6) & 7; bl = item >> 9; qrow0 = bl * 4096 + r * 64; bglob = ps.b0 + bl; }
    else { const int qb = item & 3; h = (item >> 2) & 7; bl = item >> 5; qrow0 = bl * 256 + qb * 64; bglob = bl; }
    const int qrow = qrow0 + qtr * 16 + li;
    float m_run = -1e30f, l_run = 0.f;
    const bf16x8 qp0 = ld_frag_g(PJ(qrow, 0, h * 64 + quad * 8)), qp1 = ld_frag_g(PJ(qrow, 0, h * 64 + 32 + quad * 8));
    uint2 gate4[4];
#pragma unroll
    for (int d = 0; d < 4; ++d) gate4[d] = *(const uint2*)(PJ(qrow, 3, h * 64 + d * 16 + quad * 4));
    Reg8 crg;
    { const size_t crow0 = (size_t)bglob * 256;
#pragma unroll
      for (int i = 0; i < 4; ++i) { const int idx = tid + 512 * i, key = idx >> 3, ch = idx & 7;
          crg.ld(2 * i, CKV + (crow0 + key) * 1024 + h * 64 + ch * 8); crg.ld(2 * i + 1, CKV + (crow0 + key) * 1024 + 512 + h * 64 + ch * 8); } }
    f32x4 O[4];
#pragma unroll
    for (int d = 0; d < 4; ++d) O[d] = (f32x4){0.f, 0.f, 0.f, 0.f};
    if (!ps.is_ctx) {
        const int rs = min(max(r - 4, 0), 56);
        const size_t krow0 = (size_t)bl * 4096 + rs * 64;
        const bf16x8 q0 = ld_frag_g(QROT + (size_t)qrow * 512 + h * 64 + quad * 8), q1 = ld_frag_g(QROT + (size_t)qrow * 512 + h * 64 + 32 + quad * 8);
        { u32x32_ kr, vr;
#pragma unroll
          for (int i = 0; i < 8; ++i) { const int idx = tid + 512 * i, key = idx >> 3, ch = idx & 7;
              const u32x4_ a = *(const u32x4_*)(PJ(krow0 + key, 1, h * 64 + ch * 8)), b = *(const u32x4_*)(PJ(krow0 + key, 2, h * 64 + ch * 8));
              kr[4 * i] = a[0]; kr[4 * i + 1] = a[1]; kr[4 * i + 2] = a[2]; kr[4 * i + 3] = a[3]; vr[4 * i] = b[0]; vr[4 * i + 1] = b[1]; vr[4 * i + 2] = b[2]; vr[4 * i + 3] = b[3]; }
          asm volatile("" ::: "memory");
#pragma unroll
          for (int i = 0; i < 8; ++i) { const int idx = tid + 512 * i, key = idx >> 3, ch = idx & 7;
              *(u32x4_*)(Kl + key * KVS + ch * 8) = (u32x4_){kr[4 * i], kr[4 * i + 1], kr[4 * i + 2], kr[4 * i + 3]}; *(u32x4_*)(Vl + key * KVS + ch * 8) = (u32x4_){vr[4 * i], vr[4 * i + 1], vr[4 * i + 2], vr[4 * i + 3]}; } }
        for (int i = tid; i < 465; i += 512) rp[i] = p.rpb[((size_t)l * 8 + h) * 465 + i] * LOG2E;
        __syncthreads();
        const int cbase = (qtr == 0) ? 0 : (qtr == 1 ? 8 : (qtr == 2 ? 24 : 32));
        const int qc = qtr * 16 + li, cst = min(max(qc - 8, 0), 48);
        const int bnd = cst - cbase;
        float s[4][4];
        bool u0[4]; int bofs[4];
#pragma unroll
        for (int j = 0; j < 4; ++j) { const int c = quad * 4 + j; u0[j] = c >= bnd; const int kc = cbase + (u0[j] ? c : c + 16); bofs[j] = kc - qc + 15; }
        float mx = -1e30f;
#pragma unroll
        for (int i4 = 0; i4 < 4; ++i4) {
            const int i = kh * 4 + i4;
            const u16* kp = Kl + (i * 64 + cbase + li) * KVS + quad * 8;
            f32x4 a0 = (f32x4){0.f, 0.f, 0.f, 0.f}, a1 = (f32x4){0.f, 0.f, 0.f, 0.f};
            a0 = MFMA16(*(const bf16x8*)kp, q0, a0); a0 = MFMA16(*(const bf16x8*)(kp + 32), q1, a0);
            a1 = MFMA16(*(const bf16x8*)(kp + 16 * KVS), q0, a1); a1 = MFMA16(*(const bf16x8*)(kp + 16 * KVS + 32), q1, a1);
            const int ridx = rs + i - r + 7;
#pragma unroll
            for (int j = 0; j < 4; ++j) { const float v = (u0[j] ? a0[j] : a1[j]) + rp[ridx * 31 + bofs[j]]; s[i4][j] = v; mx = fmaxf(mx, v); }
        }
        mx = fmaxf(mx, shx(mx, 16)); mx = fmaxf(mx, shx(mx, 32));
        m_run = mx;
        float ls = 0.f;
#pragma unroll
        for (int i4 = 0; i4 < 4; ++i4)
#pragma unroll
            for (int j = 0; j < 4; ++j) { const float e = __builtin_amdgcn_exp2f(s[i4][j] - mx); s[i4][j] = e; ls += e; }
        ls += shx(ls, 16); ls += shx(ls, 32);
        l_run = ls;
#pragma unroll
        for (int kp2 = 0; kp2 < 4; ++kp2) {
            bf16x8 pf; { const unsigned a0 = pack2(u0[0] ? s[kp2][0] : 0.f, u0[1] ? s[kp2][1] : 0.f), a1 = pack2(u0[2] ? s[kp2][2] : 0.f, u0[3] ? s[kp2][3] : 0.f),
                                    b0 = pack2(u0[0] ? 0.f : s[kp2][0], u0[1] ? 0.f : s[kp2][1]), b1 = pack2(u0[2] ? 0.f : s[kp2][2], u0[3] ? 0.f : s[kp2][3]);
                pf = (bf16x8){(short)(a0 & 0xffff), (short)(a0 >> 16), (short)(a1 & 0xffff), (short)(a1 >> 16), (short)(b0 & 0xffff), (short)(b0 >> 16), (short)(b1 & 0xffff), (short)(b1 >> 16)}; }
            const int vrow0 = (kh * 4 + kp2) * 64 + cbase + quad * 4 + (li >> 2);
#pragma unroll
            for (int d = 0; d < 4; ++d) {
                const u16* vp = Vl + vrow0 * KVS + d * 16 + 4 * (li & 3);
                const bf16x8 vf = tr_read2(vp, vp + 16 * KVS);
                O[d] = MFMA16(vf, pf, O[d]);
            }
        }
        __syncthreads();
    }
    {
#pragma unroll
        for (int i = 0; i < 4; ++i) { const int idx = tid + 512 * i, key = idx >> 3, ch = idx & 7;
            *(u32x4_*)(Kl + key * KVS + ch * 8) = crg.get(2 * i); *(u32x4_*)(Vl + key * KVS + ch * 8) = crg.get(2 * i + 1); }
        __syncthreads();
        const bf16x8 q0 = qp0, q1 = qp1;
        float s[8][4];
        float mx = -1e30f;
#pragma unroll
        for (int sb = 0; sb < 8; ++sb) {
            const u16* kp = Kl + (kh * 128 + sb * 16 + li) * KVS + quad * 8;
            f32x4 a = (f32x4){0.f, 0.f, 0.f, 0.f};
            a = MFMA16(*(const bf16x8*)kp, q0, a); a = MFMA16(*(const bf16x8*)(kp + 32), q1, a);
#pragma unroll
            for (int j = 0; j < 4; ++j) { const float v = a[j]; s[sb][j] = v; mx = fmaxf(mx, v); }
        }
        mx = fmaxf(mx, shx(mx, 16)); mx = fmaxf(mx, shx(mx, 32));
        const float m_new = fmaxf(m_run, mx), resc = __builtin_amdgcn_exp2f(m_run - m_new);
        float ls = 0.f;
#pragma unroll
        for (int sb = 0; sb < 8; ++sb)
#pragma unroll
            for (int j = 0; j < 4; ++j) { const float e = __builtin_amdgcn_exp2f(s[sb][j] - m_new); s[sb][j] = e; ls += e; }
        ls += shx(ls, 16); ls += shx(ls, 32);
        l_run = l_run * resc + ls; m_run = m_new;
#pragma unroll
        for (int d = 0; d < 4; ++d) O[d] *= resc;
#pragma unroll
        for (int kp2 = 0; kp2 < 4; ++kp2) {
            bf16x8 pf; { const unsigned a0 = pack2(s[2 * kp2][0], s[2 * kp2][1]), a1 = pack2(s[2 * kp2][2], s[2 * kp2][3]), b0 = pack2(s[2 * kp2 + 1][0], s[2 * kp2 + 1][1]), b1 = pack2(s[2 * kp2 + 1][2], s[2 * kp2 + 1][3]);
                pf = (bf16x8){(short)(a0 & 0xffff), (short)(a0 >> 16), (short)(a1 & 0xffff), (short)(a1 >> 16), (short)(b0 & 0xffff), (short)(b0 >> 16), (short)(b1 & 0xffff), (short)(b1 >> 16)}; }
            const int vrow0 = kh * 128 + kp2 * 32 + quad * 4 + (li >> 2);
#pragma unroll
            for (int d = 0; d < 4; ++d) {
                const u16* vp = Vl + vrow0 * KVS + d * 16 + 4 * (li & 3);
                const bf16x8 vf = tr_read2(vp, vp + 16 * KVS);
                O[d] = MFMA16(vf, pf, O[d]);
            }
        }
        __syncthreads();
    }
    float* cb = (float*)lds;
    if (kh == 1) {
#pragma unroll
        for (int d = 0; d < 4; ++d)
#pragma unroll
            for (int j = 0; j < 4; ++j) cb[(qtr * 18 + d * 4 + j) * 64 + lane] = O[d][j];
        cb[(qtr * 18 + 16) * 64 + lane] = m_run; cb[(qtr * 18 + 17) * 64 + lane] = l_run;
    }
    __syncthreads();
    if (kh == 0) {
        const float m2 = cb[(qtr * 18 + 16) * 64 + lane], l2 = cb[(qtr * 18 + 17) * 64 + lane];
        const float mm = fmaxf(m_run, m2), e1 = __builtin_amdgcn_exp2f(m_run - mm), e2 = __builtin_amdgcn_exp2f(m2 - mm);
        const float inv = 1.f / (l_run * e1 + l2 * e2);
#pragma unroll
        for (int d = 0; d < 4; ++d) {
            const int col = h * 64 + d * 16 + quad * 4;
            const uint2 g = gate4[d];
            float o[4];
#pragma unroll
            for (int j = 0; j < 4; ++j) o[j] = (O[d][j] * e1 + cb[(qtr * 18 + d * 4 + j) * 64 + lane] * e2) * inv;
            uint2 wv; wv.x = pack2(o[0] * siluf_(bflo(g.x)), o[1] * siluf_(bfhi(g.x))); wv.y = pack2(o[2] * siluf_(bflo(g.y)), o[3] * siluf_(bfhi(g.y)));
            *(uint2*)(Y0 + (size_t)qrow * 512 + col) = wv;
        }
    }
    __syncthreads();
}

template <int ROWS, int CPR> __device__ __forceinline__ void load_tile(u16* dstl, int lstride, const u16* src, size_t sstride) {
    constexpr int PER = ROWS * CPR / 512;
    static_assert(PER % 8 == 0, "tile size");
    const int tid_ = tidx();
#pragma unroll
    for (int b8 = 0; b8 < PER / 8; ++b8) { Reg8 rg;
#pragma unroll
        for (int j = 0; j < 8; ++j) { const int i = tid_ + 512 * (b8 * 8 + j), r = i / CPR, ch = i % CPR; rg.ld(j, src + (size_t)r * sstride + ch * 8); }
        MEMBAR();
#pragma unroll
        for (int j = 0; j < 8; ++j) { const int i = tid_ + 512 * (b8 * 8 + j), r = i / CPR, ch = i % CPR; *(u32x4_*)(dstl + r * lstride + ch * 8) = rg.get(j); }
        MEMBAR(); }
}

__device__ void four1_item(const Params& p, int item, unsigned char* lds) {
    unsigned char* ws = opaque(p.ws);
    const u16* PROJ = (const u16*)(ws + OFF_PROJ); const u16* M1 = (const u16*)(ws + OFF_M1); const float* TW = (const float*)(ws + OFF_TW);
    u16* FY = (u16*)(ws + OFF_FY);
    const int tid = tidx(), w = tid >> 6, lane = tid & 63, li = lane & 15, quad = lane >> 4;
    const int n2 = item & 63, bl = item >> 6;
    u16* T = (u16*)lds;
#pragma unroll
    for (int b8 = 0; b8 < 2; ++b8) { Reg8 rg;
#pragma unroll
        for (int j = 0; j < 8; ++j) { const int i = tid + 512 * (b8 * 8 + j), kk = i >> 6, ch = i & 63, n1 = kk >> 1, part = kk & 1;
            rg.ld(j, PJ((size_t)bl * 4096 + n1 * 64 + n2, 4 + part, ch * 8)); }
        MEMBAR();
#pragma unroll
        for (int j = 0; j < 8; ++j) { const int i = tid + 512 * (b8 * 8 + j), kk = i >> 6, ch = i & 63;
            *(u32x4_*)(T + kk * TS + ch * 8) = rg.get(j); }
        MEMBAR(); }
    float* twl = (float*)(T + 128 * TS);
    if (tid < 64) { const float2 tv = *(const float2*)(TW + 2 * (n2 * tid)); twl[2 * tid] = tv.x; twl[2 * tid + 1] = tv.y; }
    bf16x8 xf[4];
#pragma unroll
    for (int ks = 0; ks < 4; ++ks) xf[ks] = ld_frag_g(M1 + li * 128 + ks * 32 + quad * 8);
    __syncthreads();
    for (int isub = 0; isub < 8; ++isub) {
        bf16x8 xn[4];
        const int isn = isub < 7 ? isub + 1 : 7;
#pragma unroll
        for (int ks = 0; ks < 4; ++ks) xn[ks] = ld_frag_g(M1 + (isn * 16 + li) * 128 + ks * 32 + quad * 8);
        float tcs[2], tsn_[2];
#pragma unroll
        for (int hh = 0; hh < 2; ++hh) { const int k1 = isub * 8 + quad * 2 + hh; tcs[hh] = twl[2 * k1]; tsn_[hh] = twl[2 * k1 + 1]; }
#pragma unroll
        for (int cs = 0; cs < 4; ++cs) {
            const int c0 = w * 64 + cs * 16;
            f32x4 a = (f32x4){0.f, 0.f, 0.f, 0.f};
#pragma unroll
            for (int ks = 0; ks < 4; ++ks) {
                const u16* tp = T + (ks * 32 + quad * 8 + (li >> 2)) * TS + c0 + 4 * (li & 3);
                a = MFMA16(xf[ks], tr_read2(tp, tp + 4 * TS), a);
            }
            const int ch = c0 + li;
#pragma unroll
            for (int hh = 0; hh < 2; ++hh) {
                const int k1 = isub * 8 + quad * 2 + hh;
                const float yr = a[2 * hh], yi = a[2 * hh + 1];
                const float orr = yr * tcs[hh] + yi * tsn_[hh], oi = yi * tcs[hh] - yr * tsn_[hh];
                u16* dst = FY + (((size_t)bl * 64 + k1) * 64 + n2) * 1024 + ch;
                dst[0] = f2bf(orr); dst[512] = f2bf(oi);
            }
        }
#pragma unroll
        for (int ks = 0; ks < 4; ++ks) xf[ks] = xn[ks];
    }
    __syncthreads();
}

__device__ void four2_item(const Params& p, int item, unsigned char* lds) {
    unsigned char* ws = opaque(p.ws);
    const u16* PROJ = (const u16*)(ws + OFF_PROJ); const u16* M2 = (const u16*)(ws + OFF_M2); const u16* FY = (const u16*)(ws + OFF_FY);
    u16* Y1 = (u16*)(ws + OFF_Y) + (size_t)1 * MLAT * 512;
    const int tid = tidx(), w = tid >> 6, lane = tid & 63, li = lane & 15, quad = lane >> 4;
    const int k1 = item & 63, bl = item >> 6;
    u16* T = (u16*)lds;
    load_tile<128, 64>(T, TS, FY + ((size_t)bl * 64 + k1) * 64 * 1024, 512);
    __syncthreads();
    bf16x8 xf[4][4];
#pragma unroll
    for (int cs = 0; cs < 4; ++cs)
#pragma unroll
        for (int ks = 0; ks < 4; ++ks) { const u16* tp = T + (ks * 32 + quad * 8 + (li >> 2)) * TS + w * 64 + cs * 16 + 4 * (li & 3); xf[cs][ks] = tr_read2(tp, tp + 4 * TS); }
    bf16x8 yf[4]; uint2 gt[4];
#define F2_LOAD(k2s_, yf_, gt_) do { _Pragma("unroll") for (int ks = 0; ks < 4; ++ks) yf_[ks] = ld_frag_g(M2 + ((k2s_) * 16 + li) * 128 + ks * 32 + quad * 8); \
        const size_t row_ = (size_t)bl * 4096 + k1 + 64 * ((k2s_) * 16 + li); _Pragma("unroll") for (int cs = 0; cs < 4; ++cs) gt_[cs] = *(const uint2*)(PJ(row_, 6, w * 64 + cs * 16 + quad * 4)); } while (0)
    F2_LOAD(0, yf, gt);
    for (int k2s = 0; k2s < 4; ++k2s) {
        bf16x8 yn[4]; uint2 gn[4];
        const int kn = k2s < 3 ? k2s + 1 : 3;
        F2_LOAD(kn, yn, gn);
        const int k2 = k2s * 16 + li;
        const size_t row = (size_t)bl * 4096 + k1 + 64 * k2;
#pragma unroll
        for (int cs = 0; cs < 4; ++cs) {
            f32x4 a = (f32x4){0.f, 0.f, 0.f, 0.f};
#pragma unroll
            for (int ks = 0; ks < 4; ++ks) a = MFMA16(xf[cs][ks], yf[ks], a);
            const int ch = w * 64 + cs * 16 + quad * 4;
            const uint2 g = gt[cs];
            uint2 wv; wv.x = pack2(a[0] * NORM_LAT * siluf_(bflo(g.x)), a[1] * NORM_LAT * siluf_(bfhi(g.x))); wv.y = pack2(a[2] * NORM_LAT * siluf_(bflo(g.y)), a[3] * NORM_LAT * siluf_(bfhi(g.y)));
            *(uint2*)(Y1 + row * 512 + ch) = wv;
        }
#pragma unroll
        for (int q = 0; q < 4; ++q) { yf[q] = yn[q]; gt[q] = gn[q]; }
    }
#undef F2_LOAD
    __syncthreads();
}

__device__ void fourc_item(const Params& p, int item, unsigned char* lds) {
    unsigned char* ws = opaque(p.ws);
    const u16* PROJ = (const u16*)(ws + OFF_PROJ); const u16* M3 = (const u16*)(ws + OFF_M3);
    u16* Y1 = (u16*)(ws + OFF_Y) + (size_t)1 * MLAT * 512;
    const int tid = tidx(), w = tid >> 6, lane = tid & 63, li = lane & 15, quad = lane >> 4;
    const int chb = item & 3, b = item >> 2;
    u16* T = (u16*)lds;
#pragma unroll
    for (int b8 = 0; b8 < 2; ++b8) { Reg8 rg;
#pragma unroll
        for (int j = 0; j < 8; ++j) { const int i = tid + 512 * (b8 * 8 + j), kk = i >> 4, ch = i & 15, n = kk >> 1, part = kk & 1;
            rg.ld(j, PJ((size_t)b * 256 + n, 4 + part, chb * 128 + ch * 8)); }
        MEMBAR();
#pragma unroll
        for (int j = 0; j < 8; ++j) { const int i = tid + 512 * (b8 * 8 + j), kk = i >> 4, ch = i & 15;
            *(u32x4_*)(T + kk * T3S + ch * 8) = rg.get(j); }
        MEMBAR(); }
    __syncthreads();
    for (int kq = 0; kq < 2; ++kq) {
        const int ksub = w * 2 + kq;
        f32x4 a[8];
#pragma unroll
        for (int cs = 0; cs < 8; ++cs) a[cs] = (f32x4){0.f, 0.f, 0.f, 0.f};
        for (int ks = 0; ks < 16; ++ks) {
            const bf16x8 yf = ld_frag_g(M3 + (ksub * 16 + li) * 512 + ks * 32 + quad * 8);
#pragma unroll
            for (int cs = 0; cs < 8; ++cs) { const u16* tp = T + (ks * 32 + quad * 8 + (li >> 2)) * T3S + cs * 16 + 4 * (li & 3);
                a[cs] = MFMA16(tr_read2(tp, tp + 4 * T3S), yf, a[cs]); }
        }
        const size_t row = (size_t)b * 256 + ksub * 16 + li;
#pragma unroll
        for (int cs = 0; cs < 8; ++cs) {
            const int ch = chb * 128 + cs * 16 + quad * 4;
            const uint2 g = *(const uint2*)(PJ(row, 6, ch));
            uint2 wv; wv.x = pack2(a[cs][0] * NORM_CTX * siluf_(bflo(g.x)), a[cs][1] * NORM_CTX * siluf_(bfhi(g.x))); wv.y = pack2(a[cs][2] * NORM_CTX * siluf_(bflo(g.y)), a[cs][3] * NORM_CTX * siluf_(bfhi(g.y)));
            *(uint2*)(Y1 + row * 512 + ch) = wv;
        }
    }
    __syncthreads();
}

__device__ void gmlp_item(const Params& p, int l, int item, unsigned char* lds) {
    unsigned char* ws = opaque(p.ws);
    const u16* PROJ = (const u16*)(ws + OFF_PROJ); const u16* WS16 = (const u16*)(ws + OFF_WS16) + (size_t)l * 8 * 128 * 128;
    u16* Y2 = (u16*)(ws + OFF_Y) + (size_t)2 * MLAT * 512;
    const int tid = tidx(), w = tid >> 6, lane = tid & 63, li = lane & 15, quad = lane >> 4;
    const size_t r0 = (size_t)item * 128;
    u16* VN = (u16*)lds;
    {
        const int row = tid >> 2, qd = tid & 3;
        const u16* src = PJ(r0 + row, 8, 0);
        uint4 raw[16]; float ss = 0.f;
#pragma unroll
        for (int i = 0; i < 16; ++i) { raw[i] = *(const uint4*)(src + (qd + 4 * i) * 8); float f[8]; unpack8(raw[i], f);
#pragma unroll
            for (int e = 0; e < 8; ++e) ss += f[e] * f[e]; }
        ss += shx(ss, 1); ss += shx(ss, 2);
        const float rstd = rsqrtf(ss * (1.f / 512.f) + EPSN);
        const float* gn = p.gmlp_g + l * 512;
#pragma unroll
        for (int i = 0; i < 16; ++i) { float f[8]; unpack8(raw[i], f); const int c0 = (qd + 4 * i) * 8;
            const float4 g0 = *(const float4*)(gn + c0), g1 = *(const float4*)(gn + c0 + 4);
            uint4 o; o.x = pack2(f[0] * rstd * g0.x, f[1] * rstd * g0.y); o.y = pack2(f[2] * rstd * g0.z, f[3] * rstd * g0.w);
            o.z = pack2(f[4] * rstd * g1.x, f[5] * rstd * g1.y); o.w = pack2(f[6] * rstd * g1.z, f[7] * rstd * g1.w);
            *(uint4*)(VN + row * TS + c0) = o; }
    }
    __syncthreads();
    const int g = w;
    bf16x8 xf[4][4];
#pragma unroll
    for (int cs = 0; cs < 4; ++cs)
#pragma unroll
        for (int ks = 0; ks < 4; ++ks) { const u16* tp = VN + (ks * 32 + quad * 8 + (li >> 2)) * TS + g * 64 + cs * 16 + 4 * (li & 3); xf[cs][ks] = tr_read2(tp, tp + 4 * TS); }
    bf16x8 yf[4]; uint2 uu[4], gg[4]; float bs;
#define GM_LOAD(ts_, yf_, uu_, gg_, bs_) do { const int t_ = (ts_) * 16 + li; _Pragma("unroll") for (int ks = 0; ks < 4; ++ks) yf_[ks] = ld_frag_g(WS16 + ((size_t)g * 128 + t_) * 128 + ks * 32 + quad * 8); \
        bs_ = p.gmlp_bs[((size_t)l * 8 + g) * 128 + t_]; _Pragma("unroll") for (int cs = 0; cs < 4; ++cs) { const int c_ = g * 64 + cs * 16 + quad * 4; uu_[cs] = *(const uint2*)(PJ(r0 + t_, 7, c_)); gg_[cs] = *(const uint2*)(PJ(r0 + t_, 9, c_)); } } while (0)
    GM_LOAD(0, yf, uu, gg, bs);
    for (int ts = 0; ts < 8; ++ts) {
        bf16x8 yn[4]; uint2 un[4], gn[4]; float bn;
        const int tn = ts < 7 ? ts + 1 : 7;
        GM_LOAD(tn, yn, un, gn, bn);
        const int t = ts * 16 + li;
        const size_t row = r0 + t;
#pragma unroll
        for (int cs = 0; cs < 4; ++cs) {
            f32x4 a = (f32x4){0.f, 0.f, 0.f, 0.f};
#pragma unroll
            for (int ks = 0; ks < 4; ++ks) a = MFMA16(xf[cs][ks], yf[ks], a);
            const int c = g * 64 + cs * 16 + quad * 4;
            uint2 wv; wv.x = pack2(bflo(uu[cs].x) * (a[0] + bs) * siluf_(bflo(gg[cs].x)), bfhi(uu[cs].x) * (a[1] + bs) * siluf_(bfhi(gg[cs].x)));
            wv.y = pack2(bflo(uu[cs].y) * (a[2] + bs) * siluf_(bflo(gg[cs].y)), bfhi(uu[cs].y) * (a[3] + bs) * siluf_(bfhi(gg[cs].y)));
            *(uint2*)(Y2 + row * 512 + c) = wv;
        }
#pragma unroll
        for (int q = 0; q < 4; ++q) { yf[q] = yn[q]; uu[q] = un[q]; gg[q] = gn[q]; }
        bs = bn;
    }
#undef GM_LOAD
    __syncthreads();
}

__device__ __forceinline__ void chunk_cumsum(float* A, float* tmp, int dir) {
    const int k = tidx() & 63, seg = tidx() >> 6;
    float v[8]; float run = 0.f;
    if (dir == 0) {
#pragma unroll
        for (int e = 0; e < 8; ++e) { run += A[(seg * 8 + e) * HS_ + k]; v[e] = run; }
    } else {
#pragma unroll
        for (int e = 7; e >= 0; --e) { run += A[(seg * 8 + e) * HS_ + k]; v[e] = run; }
    }
    tmp[seg * 64 + k] = run;
    __syncthreads();
    float off = 0.f;
#pragma unroll
    for (int s2 = 0; s2 < 8; ++s2) { const float tv = tmp[s2 * 64 + k]; if (dir == 0 ? (s2 < seg) : (s2 > seg)) off += tv; }
#pragma unroll
    for (int e = 0; e < 8; ++e) A[(seg * 8 + e) * HS_ + k] = (v[e] + off) * LOG2E;
    __syncthreads();
}
__device__ __forceinline__ void chunk_cumsum2(float* Af, float* Ab, float* tmp) {
    const int k = tidx() & 63, seg = tidx() >> 6;
    float vf[8], vb[8]; float rf = 0.f, rb = 0.f;
#pragma unroll
    for (int e = 0; e < 8; ++e) { rf += Af[(seg * 8 + e) * HS_ + k]; vf[e] = rf; }
#pragma unroll
    for (int e = 7; e >= 0; --e) { rb += Ab[(seg * 8 + e) * HS_ + k]; vb[e] = rb; }
    tmp[seg * 64 + k] = rf; tmp[512 + seg * 64 + k] = rb;
    __syncthreads();
    float of = 0.f, ob = 0.f;
#pragma unroll
    for (int s2 = 0; s2 < 8; ++s2) { const float tf = tmp[s2 * 64 + k], tb = tmp[512 + s2 * 64 + k]; if (s2 < seg) of += tf; if (s2 > seg) ob += tb; }
#pragma unroll
    for (int e = 0; e < 8; ++e) { Af[(seg * 8 + e) * HS_ + k] = (vf[e] + of) * LOG2E; Ab[(seg * 8 + e) * HS_ + k] = (vb[e] + ob) * LOG2E; }
    __syncthreads();
}
__device__ __forceinline__ void load_bf_tile64(float* dst, const u16* src  , size_t sstride) {
    const int t = tidx() >> 3, k8 = (tidx() & 7) * 8;
    float f[8]; unpack8(*(const uint4*)(src + (size_t)t * sstride + k8), f);
    *(float4*)(dst + t * HS_ + k8) = make_float4(f[0], f[1], f[2], f[3]); *(float4*)(dst + t * HS_ + k8 + 4) = make_float4(f[4], f[5], f[6], f[7]);
}
__device__ __forceinline__ void load_f32_tile64(float* dst, const float* src, size_t sstride) {
    const int t = tidx() >> 3, k8 = (tidx() & 7) * 8;
    *(float4*)(dst + t * HS_ + k8) = *(const float4*)(src + (size_t)t * sstride + k8); *(float4*)(dst + t * HS_ + k8 + 4) = *(const float4*)(src + (size_t)t * sstride + k8 + 4);
}

__device__ __forceinline__ void hgrn1_issue(const u16* PROJ, const float* LOGF, const PassInfo ps, int item, Reg8& rg) {
    const int NC = ps.T >> 6, ncsh = ps.is_ctx ? 2 : 6, c = item & (NC - 1), ci = item >> ncsh, dir = ci & 1, h = (ci >> 1) & 7, bl = ci >> 4;
    const size_t r0 = (size_t)bl * ps.T + c * 64;
    const int t = tidx() >> 3, k8 = (tidx() & 7) * 8;
    const float* ap = LOGF + (r0 + t) * 1024 + dir * 512 + h * 64 + k8;
    rg.ld(0, ap); rg.ld(1, ap + 4); rg.ld(2, PJ(r0 + t, 11 + dir, h * 64 + k8)); rg.ld(3, PJ(r0 + t, 13, h * 64 + k8));
}
__device__ void hgrn1_loop(const Params& p, const PassInfo ps, int first, int end, int stride, unsigned char* lds) {
    if (first >= end) return;
    unsigned char* ws = opaque(p.ws);
    const u16* PROJ = (const u16*)(ws + OFF_PROJ); const float* LOGF = (const float*)(ws + OFF_LOGF);
    u16* HL = (u16*)(ws + OFF_HL); float* HD = (float*)(ws + OFF_HD);
    float* A = (float*)lds; float* tmp = A + 64 * HS_; u16* Wb = (u16*)(tmp + 512); u16* Ib = Wb + 64 * KVS;
    const int tid = tidx(), w = tid >> 6, lane = tid & 63, li = lane & 15, quad = lane >> 4;
    const int t = tid >> 3, k8 = (tid & 7) * 8;
    Reg8 rg;
    hgrn1_issue(PROJ, LOGF, ps, first, rg);
  for (int item = first; item < end; item += stride) {
    const int ncsh = ps.is_ctx ? 2 : 6, ci = item >> ncsh, dir = ci & 1;
    float kf[8];
    { MEMBAR();
      unpack8(rg.getu(2), kf);
      *(u32x4_*)(A + t * HS_ + k8) = rg.get(0); *(u32x4_*)(A + t * HS_ + k8 + 4) = rg.get(1);
      *(u32x4_*)(Ib + t * KVS + k8) = rg.get(3); }
    __syncthreads();
    if (item + stride < end) hgrn1_issue(PROJ, LOGF, ps, item + stride, rg);
    chunk_cumsum(A, tmp, dir);
    const int lastt = dir == 0 ? 63 : 0;
    { float wv[8];
#pragma unroll
      for (int e = 0; e < 8; ++e) wv[e] = kf[e] * __builtin_amdgcn_exp2f(A[lastt * HS_ + k8 + e] - A[t * HS_ + k8 + e]);
      uint4 wq; wq.x = pack2(wv[0], wv[1]); wq.y = pack2(wv[2], wv[3]); wq.z = pack2(wv[4], wv[5]); wq.w = pack2(wv[6], wv[7]);
      *(uint4*)(Wb + t * KVS + k8) = wq;
      if (tid < 64) HD[(size_t)item * 64 + tid] = __builtin_amdgcn_exp2f(A[lastt * HS_ + tid]); }
    __syncthreads();
    {
        const int ksub = w >> 1;
        bf16x8 yf[2];
#pragma unroll
        for (int ks = 0; ks < 2; ++ks) { const u16* tp = Wb + (ks * 32 + quad * 8 + (li >> 2)) * KVS + ksub * 16 + 4 * (li & 3); yf[ks] = tr_read2(tp, tp + 4 * KVS); }
#pragma unroll
        for (int vv = 0; vv < 2; ++vv) {
            const int vsub = (w & 1) * 2 + vv;
            f32x4 a = (f32x4){0.f, 0.f, 0.f, 0.f};
#pragma unroll
            for (int ks = 0; ks < 2; ++ks) { const u16* tp = Ib + (ks * 32 + quad * 8 + (li >> 2)) * KVS + vsub * 16 + 4 * (li & 3); a = MFMA16(tr_read2(tp, tp + 4 * KVS), yf[ks], a); }
            uint2 o; o.x = pack2(a[0], a[1]); o.y = pack2(a[2], a[3]);
            *(uint2*)(HL + ((size_t)item * 64 + ksub * 16 + li) * 64 + vsub * 16 + quad * 4) = o;
        }
    }
    __syncthreads();
  }
}

__device__ void hgrn_chain(const Params& p, const PassInfo ps, int l, int ci, unsigned char* lds) {
    unsigned char* ws = opaque(p.ws);
    const u16* PROJ = (const u16*)(ws + OFF_PROJ); const float* LOGF = (const float*)(ws + OFF_LOGF);
    u16* HS = (u16*)(ws + OFF_HS); float* CST = (float*)(ws + OFF_CTXST) + (size_t)l * 256 * 4096;
    const int tid = tidx(), w = tid >> 6, lane = tid & 63, li = lane & 15, quad = lane >> 4;
    const int t = tid >> 3, k8 = (tid & 7) * 8;
    const int NC = ps.T >> 6, dir = ci & 1, ksub = w >> 1, kk_ = ksub * 16 + li;
    float S[2][4];
#pragma unroll
    for (int vv = 0; vv < 2; ++vv) {
        const int v0 = ((w & 1) * 2 + vv) * 16 + quad * 4;
        if (!ps.is_ctx) { const float4 c4 = *(const float4*)(CST + ((size_t)ps.b0 * 16 + ci) * 4096 + kk_ * 64 + v0); S[vv][0] = c4.x; S[vv][1] = c4.y; S[vv][2] = c4.z; S[vv][3] = c4.w; }
        else { S[vv][0] = 0.f; S[vv][1] = 0.f; S[vv][2] = 0.f; S[vv][3] = 0.f; }
    }
    Reg8 rg;
    hgrn1_issue(PROJ, LOGF, ps, ci * NC + (dir ? NC - 1 : 0), rg);
  for (int cc = 0; cc < NC; ++cc) {
    const int c = dir ? NC - 1 - cc : cc, item = ci * NC + c;
    float* A = (float*)(lds + (cc & 1) * 38912); float* tmp = A + 64 * HS_; u16* Wb = (u16*)(tmp + 512); u16* Ib = Wb + 64 * KVS;
    float kf[8];
    { MEMBAR();
      unpack8(rg.getu(2), kf);
      *(u32x4_*)(A + t * HS_ + k8) = rg.get(0); *(u32x4_*)(A + t * HS_ + k8 + 4) = rg.get(1);
      *(u32x4_*)(Ib + t * KVS + k8) = rg.get(3); }
    __syncthreads();
    if (cc + 1 < NC) hgrn1_issue(PROJ, LOGF, ps, ci * NC + (dir ? NC - 2 - cc : cc + 1), rg);
    chunk_cumsum(A, tmp, dir);
    const int lastt = dir == 0 ? 63 : 0;
    { float wv[8];
#pragma unroll
      for (int e = 0; e < 8; ++e) wv[e] = kf[e] * __builtin_amdgcn_exp2f(A[lastt * HS_ + k8 + e] - A[t * HS_ + k8 + e]);
      uint4 wq; wq.x = pack2(wv[0], wv[1]); wq.y = pack2(wv[2], wv[3]); wq.z = pack2(wv[4], wv[5]); wq.w = pack2(wv[6], wv[7]);
      *(uint4*)(Wb + t * KVS + k8) = wq; }
    __syncthreads();
    {
        const float dk = __builtin_amdgcn_exp2f(A[lastt * HS_ + kk_]);
        bf16x8 yf[2];
#pragma unroll
        for (int ks = 0; ks < 2; ++ks) { const u16* tp = Wb + (ks * 32 + quad * 8 + (li >> 2)) * KVS + ksub * 16 + 4 * (li & 3); yf[ks] = tr_read2(tp, tp + 4 * KVS); }
#pragma unroll
        for (int vv = 0; vv < 2; ++vv) {
            const int vsub = (w & 1) * 2 + vv;
            f32x4 a = (f32x4){0.f, 0.f, 0.f, 0.f};
#pragma unroll
            for (int ks = 0; ks < 2; ++ks) { const u16* tp = Ib + (ks * 32 + quad * 8 + (li >> 2)) * KVS + vsub * 16 + 4 * (li & 3); a = MFMA16(tr_read2(tp, tp + 4 * KVS), yf[ks], a); }
            uint2 o; o.x = pack2(S[vv][0], S[vv][1]); o.y = pack2(S[vv][2], S[vv][3]);
            *(uint2*)(HS + ((size_t)item * 64 + kk_) * 64 + vsub * 16 + quad * 4) = o;
#pragma unroll
            for (int j = 0; j < 4; ++j) S[vv][j] = dk * S[vv][j] + a[j];
        }
    }
  }
    __syncthreads();
    if (ps.is_ctx) {
#pragma unroll
        for (int vv = 0; vv < 2; ++vv) { const int v0 = ((w & 1) * 2 + vv) * 16 + quad * 4;
            *(float4*)(CST + (size_t)ci * 4096 + kk_ * 64 + v0) = make_float4(S[vv][0], S[vv][1], S[vv][2], S[vv][3]); }
    }
}

__device__ void hgrn2_all(const Params& p, const PassInfo ps, int l) {
    unsigned char* ws = opaque(p.ws);
    const unsigned* HL = (const unsigned*)(ws + OFF_HL); const float* HD = (const float*)(ws + OFF_HD); unsigned* HS = (unsigned*)(ws + OFF_HS);
    float* CST = (float*)(ws + OFF_CTXST) + (size_t)l * 256 * 4096;
    const int NC = ps.T >> 6, chains = ps.nb * 16;
    const size_t total = (size_t)chains * 2048;
    for (size_t e = (size_t)blockIdx.x * 512 + tidx(); e < total; e += (size_t)gridDim.x * 512) {
        const int ci = (int)(e >> 11), kv2 = (int)(e & 2047), k = kv2 >> 5, dir = ci & 1;
        float s0 = 0.f, s1 = 0.f;
        if (!ps.is_ctx) { const float2 cs = *(const float2*)(CST + ((size_t)ps.b0 * 16 + ci) * 4096 + 2 * kv2); s0 = cs.x; s1 = cs.y; }
#define HG2_TRIP(BLK) for (int c4 = 0; c4 < NC; c4 += BLK) { float d[BLK]; unsigned lw[BLK]; \
            _Pragma("unroll") for (int j = 0; j < BLK; ++j) { const int c = dir ? NC - 1 - (c4 + j) : c4 + j; const size_t idx = (size_t)ci * NC + c; d[j] = HD[idx * 64 + k]; lw[j] = HL[idx * 2048 + kv2]; } \
            _Pragma("unroll") for (int j = 0; j < BLK; ++j) { const int c = dir ? NC - 1 - (c4 + j) : c4 + j; const size_t idx = (size_t)ci * NC + c; \
                HS[idx * 2048 + kv2] = pack2(s0, s1); s0 = d[j] * s0 + bflo(lw[j]); s1 = d[j] * s1 + bfhi(lw[j]); } }
        if (NC == 4) { HG2_TRIP(4) } else { HG2_TRIP(16) }
#undef HG2_TRIP
        if (ps.is_ctx) *(float2*)(CST + (size_t)ci * 4096 + 2 * kv2) = make_float2(s0, s1);
    }
}

__device__ void hgrn3_item(const Params& p, const PassInfo ps, int l, int item, unsigned char* lds) {
    unsigned char* ws = opaque(p.ws);
    const u16* PROJ = (const u16*)(ws + OFF_PROJ); const float* LOGF = (const float*)(ws + OFF_LOGF); const u16* HSt = (const u16*)(ws + OFF_HS);
    u16* Y3 = (u16*)(ws + OFF_Y) + (size_t)3 * MLAT * 512;
    const int NC = ps.T >> 6, ncsh = ps.is_ctx ? 2 : 6, c = item & (NC - 1), bh = item >> ncsh, h = bh & 7, bl = bh >> 3;
    const size_t r0 = (size_t)bl * ps.T + c * 64;
    const size_t idxf = (size_t)(bh * 2 + 0) * NC + c, idxb = (size_t)(bh * 2 + 1) * NC + c;
    float* Q = (float*)lds; float* KKf = Q + 64 * HS_; float* KKb = KKf + 64 * HS_; float* Af = KKb + 64 * HS_; float* Ab = Af + 64 * HS_; float* tmp = Ab + 64 * HS_;
    u16* Ib = (u16*)(tmp + 1024); u16* Sfb = Ib + 64 * KVS; u16* Sbb = Sfb + 64 * KVS; float* comb = (float*)(Sbb + 64 * KVS);
    const int tid = tidx(), w = tid >> 6, lane = tid & 63, li = lane & 15, quad = lane >> 4;
    { const int t = tid >> 3, k8 = (tid & 7) * 8;
      Reg8 ra, rb;
      const float* ap = LOGF + (r0 + t) * 1024 + h * 64 + k8;
      const u16* sf = HSt + idxf * 4096 + t * 64 + k8; const u16* sb = HSt + idxb * 4096 + t * 64 + k8;
      ra.ld(0, PJ(r0 + t, 10, h * 64 + k8)); ra.ld(1, PJ(r0 + t, 11, h * 64 + k8)); ra.ld(2, PJ(r0 + t, 12, h * 64 + k8)); ra.ld(3, PJ(r0 + t, 13, h * 64 + k8));
      ra.ld(4, ap); ra.ld(5, ap + 4); ra.ld(6, ap + 512); ra.ld(7, ap + 516);
      rb.ld(0, sf); rb.ld(1, sb);
      MEMBAR();
      float x[8];
      unpack8(ra.getu(0), x); *(float4*)(Q + t * HS_ + k8) = make_float4(x[0], x[1], x[2], x[3]); *(float4*)(Q + t * HS_ + k8 + 4) = make_float4(x[4], x[5], x[6], x[7]);
      unpack8(ra.getu(1), x); *(float4*)(KKf + t * HS_ + k8) = make_float4(x[0], x[1], x[2], x[3]); *(float4*)(KKf + t * HS_ + k8 + 4) = make_float4(x[4], x[5], x[6], x[7]);
      unpack8(ra.getu(2), x); *(float4*)(KKb + t * HS_ + k8) = make_float4(x[0], x[1], x[2], x[3]); *(float4*)(KKb + t * HS_ + k8 + 4) = make_float4(x[4], x[5], x[6], x[7]);
      *(u32x4_*)(Ib + t * KVS + k8) = ra.get(3);
      *(u32x4_*)(Af + t * HS_ + k8) = ra.get(4); *(u32x4_*)(Af + t * HS_ + k8 + 4) = ra.get(5); *(u32x4_*)(Ab + t * HS_ + k8) = ra.get(6); *(u32x4_*)(Ab + t * HS_ + k8 + 4) = ra.get(7);
      *(u32x4_*)(Sfb + t * KVS + k8) = rb.get(0); *(u32x4_*)(Sbb + t * KVS + k8) = rb.get(1); }
    __syncthreads();
    chunk_cumsum2(Af, Ab, tmp);
    const int dir = w >> 2, T = w & 3;
    const float* A = dir ? Ab : Af; const float* KK = dir ? KKb : KKf; const u16* Sb16 = dir ? Sbb : Sfb;
    const int t = 16 * T + li;
    const int rrow = dir ? 16 * T + 16 : 16 * T - 1; const bool rzero = dir ? (T == 3) : (T == 0);
    bf16x8 qt[2], qh[2];
    float Rv[2][8];
#pragma unroll
    for (int ks = 0; ks < 2; ++ks) {
        const int k0 = ks * 32 + quad * 8;
        float qv[8], av[8];
        { const float4 x0 = *(const float4*)(Q + t * HS_ + k0), x1 = *(const float4*)(Q + t * HS_ + k0 + 4); qv[0] = x0.x; qv[1] = x0.y; qv[2] = x0.z; qv[3] = x0.w; qv[4] = x1.x; qv[5] = x1.y; qv[6] = x1.z; qv[7] = x1.w; }
        { const float4 x0 = *(const float4*)(A + t * HS_ + k0), x1 = *(const float4*)(A + t * HS_ + k0 + 4); av[0] = x0.x; av[1] = x0.y; av[2] = x0.z; av[3] = x0.w; av[4] = x1.x; av[5] = x1.y; av[6] = x1.z; av[7] = x1.w; }
        if (rzero) {
#pragma unroll
            for (int e = 0; e < 8; ++e) Rv[ks][e] = 0.f;
        } else { const float4 x0 = *(const float4*)(A + rrow * HS_ + k0), x1 = *(const float4*)(A + rrow * HS_ + k0 + 4); Rv[ks][0] = x0.x; Rv[ks][1] = x0.y; Rv[ks][2] = x0.z; Rv[ks][3] = x0.w; Rv[ks][4] = x1.x; Rv[ks][5] = x1.y; Rv[ks][6] = x1.z; Rv[ks][7] = x1.w; }
        float a_[8], b_[8];
#pragma unroll
        for (int e = 0; e < 8; ++e) { a_[e] = qv[e] * __builtin_amdgcn_exp2f(av[e] - Rv[ks][e]); b_[e] = qv[e] * __builtin_amdgcn_exp2f(av[e]); }
        const unsigned a0 = pack2(a_[0], a_[1]), a1 = pack2(a_[2], a_[3]), a2 = pack2(a_[4], a_[5]), a3 = pack2(a_[6], a_[7]);
        const unsigned b0 = pack2(b_[0], b_[1]), b1 = pack2(b_[2], b_[3]), b2 = pack2(b_[4], b_[5]), b3 = pack2(b_[6], b_[7]);
        qt[ks] = (bf16x8){(short)(a0 & 0xffff), (short)(a0 >> 16), (short)(a1 & 0xffff), (short)(a1 >> 16), (short)(a2 & 0xffff), (short)(a2 >> 16), (short)(a3 & 0xffff), (short)(a3 >> 16)};
        qh[ks] = (bf16x8){(short)(b0 & 0xffff), (short)(b0 >> 16), (short)(b1 & 0xffff), (short)(b1 >> 16), (short)(b2 & 0xffff), (short)(b2 >> 16), (short)(b3 & 0xffff), (short)(b3 >> 16)};
    }
    const int nS = dir ? 4 - T : T + 1;
    float sc[4][4];
#pragma unroll
    for (int i = 0; i < 4; ++i) {
        if (i < nS) {
            const int S = dir ? T + i : i, srow = 16 * S + li;
            f32x4 a = (f32x4){0.f, 0.f, 0.f, 0.f};
#pragma unroll
            for (int ks = 0; ks < 2; ++ks) {
                const int k0 = ks * 32 + quad * 8;
                const float4 x0 = *(const float4*)(KK + srow * HS_ + k0), x1 = *(const float4*)(KK + srow * HS_ + k0 + 4);
                const float4 y0 = *(const float4*)(A + srow * HS_ + k0), y1 = *(const float4*)(A + srow * HS_ + k0 + 4);
                const float kv[8] = {x0.x, x0.y, x0.z, x0.w, x1.x, x1.y, x1.z, x1.w}, as[8] = {y0.x, y0.y, y0.z, y0.w, y1.x, y1.y, y1.z, y1.w};
                float c_[8];
#pragma unroll
                for (int e = 0; e < 8; ++e) c_[e] = kv[e] * __builtin_amdgcn_exp2f(Rv[ks][e] - as[e]);
                const unsigned c0 = pack2(c_[0], c_[1]), c1 = pack2(c_[2], c_[3]), c2 = pack2(c_[4], c_[5]), c3 = pack2(c_[6], c_[7]);
                const bf16x8 kf = (bf16x8){(short)(c0 & 0xffff), (short)(c0 >> 16), (short)(c1 & 0xffff), (short)(c1 >> 16), (short)(c2 & 0xffff), (short)(c2 >> 16), (short)(c3 & 0xffff), (short)(c3 >> 16)};
                a = MFMA16(kf, qt[ks], a);
            }
            const bool diag = (S == T);
#pragma unroll
            for (int j = 0; j < 4; ++j) { const int sl = quad * 4 + j; const bool keep = !diag || (dir ? (sl >= li) : (sl <= li)); sc[i][j] = keep ? a[j] : 0.f; }
        } else {
#pragma unroll
            for (int j = 0; j < 4; ++j) sc[i][j] = 0.f;
        }
    }
    f32x4 O[4];
#pragma unroll
    for (int v = 0; v < 4; ++v) O[v] = (f32x4){0.f, 0.f, 0.f, 0.f};
#pragma unroll
    for (int pr = 0; pr < 2; ++pr) {
        if (2 * pr < nS) {
            const unsigned a0 = pack2(sc[2 * pr][0], sc[2 * pr][1]), a1 = pack2(sc[2 * pr][2], sc[2 * pr][3]), b0 = pack2(sc[2 * pr + 1][0], sc[2 * pr + 1][1]), b1 = pack2(sc[2 * pr + 1][2], sc[2 * pr + 1][3]);
            const bf16x8 pf = (bf16x8){(short)(a0 & 0xffff), (short)(a0 >> 16), (short)(a1 & 0xffff), (short)(a1 >> 16), (short)(b0 & 0xffff), (short)(b0 >> 16), (short)(b1 & 0xffff), (short)(b1 >> 16)};
            const int S0 = dir ? T + 2 * pr : 2 * pr; int S1 = S0 + 1; if (S1 > 3) S1 = 3;
            const u16* p0 = Ib + (16 * S0 + quad * 4 + (li >> 2)) * KVS + 4 * (li & 3);
            const u16* p1 = Ib + (16 * S1 + quad * 4 + (li >> 2)) * KVS + 4 * (li & 3);
#pragma unroll
            for (int v = 0; v < 4; ++v) O[v] = MFMA16(tr_read2(p0 + v * 16, p1 + v * 16), pf, O[v]);
        }
    }
#pragma unroll
    for (int ks = 0; ks < 2; ++ks) {
        const u16* p0 = Sb16 + (ks * 32 + quad * 8 + (li >> 2)) * KVS + 4 * (li & 3);
#pragma unroll
        for (int v = 0; v < 4; ++v) O[v] = MFMA16(tr_read2(p0 + v * 16, p0 + 4 * KVS + v * 16), qh[ks], O[v]);
    }
    if (dir == 1) {
#pragma unroll
        for (int v = 0; v < 4; ++v)
#pragma unroll
            for (int j = 0; j < 4; ++j) comb[(T * 16 + v * 4 + j) * 64 + lane] = O[v][j];
    }
    __syncthreads();
    if (dir == 0) {
        float ss = 0.f;
#pragma unroll
        for (int v = 0; v < 4; ++v)
#pragma unroll
            for (int j = 0; j < 4; ++j) { O[v][j] += comb[(T * 16 + v * 4 + j) * 64 + lane]; ss += O[v][j] * O[v][j]; }
        ss += shx(ss, 16); ss += shx(ss, 32);
        const float rstd = rsqrtf(ss * (1.f / 64.f) + EPSN);
        const size_t row = r0 + t;
#pragma unroll
        for (int v = 0; v < 4; ++v) {
            const int col = h * 64 + v * 16 + quad * 4;
            const float4 gn = *(const float4*)(p.hgrn_g + l * 512 + col);
            const uint2 g = *(const uint2*)(PJ(row, 14, col));
            uint2 wv; wv.x = pack2(O[v][0] * rstd * gn.x * siluf_(bflo(g.x)), O[v][1] * rstd * gn.y * siluf_(bfhi(g.x))); wv.y = pack2(O[v][2] * rstd * gn.z * siluf_(bflo(g.y)), O[v][3] * rstd * gn.w * siluf_(bfhi(g.y)));
            *(uint2*)(Y3 + row * 512 + col) = wv;
        }
    }
    __syncthreads();
}
#define XB_TMO      128
#define XB_XCNT(j)  (256  + 64 * (j))
#define XB_XSUB(j)  (1280 + 64 * (j))
#define XB_XGEN(j)  (2304 + 64 * (j))
#define XB_TOP      3328
#define XB_TOPGEN   3392
#define XCD_BAR_WORDS 3456
#define XB_SPIN_CAP (1u << 18)

__device__ __forceinline__ unsigned xb_ld(unsigned* p)              { return __hip_atomic_load(p, __ATOMIC_RELAXED, __HIP_MEMORY_SCOPE_AGENT); }
__device__ __forceinline__ unsigned xb_add(unsigned* p, unsigned v) { return __hip_atomic_fetch_add(p, v, __ATOMIC_RELAXED, __HIP_MEMORY_SCOPE_AGENT); }
__device__ __forceinline__ unsigned xb_xcc_id() { return (unsigned)__builtin_amdgcn_s_getreg((3 << 11) | 20) & 0xFu; }
#define XB_SPIN(cond, bar) do { unsigned _sp = 0; while (cond) { __builtin_amdgcn_s_sleep(1); \
    if ((++_sp & 255u) == 0u) { if (xb_ld(&(bar)[XB_TMO])) break; if (_sp > XB_SPIN_CAP) { atomicAdd(&(bar)[XB_TMO], 1u); break; } } } } while (0)

struct XcdBarrier {
    unsigned* bar; unsigned x;
    volatile LAS unsigned* st;
};

__device__ __forceinline__ XcdBarrier xcd_barrier_post(unsigned* bar, volatile LAS unsigned* st) {
    XcdBarrier b; b.bar = bar; b.x = xb_xcc_id(); b.st = st;
    if (tidx() == 0) (void)xb_add(&bar[XB_XCNT(b.x)], 1u);
    return b;
}
__device__ __forceinline__ void xcd_barrier_complete(unsigned* bar, unsigned x, unsigned& nloc, unsigned& nx) {
    const unsigned G = gridDim.x * gridDim.y * gridDim.z;
    unsigned sum, cnt, mine, sp = 0u;
    for (;;) {
        sum = 0u; cnt = 0u; mine = 0u;
#pragma unroll
        for (unsigned j = 0; j < 16; ++j) { const unsigned c = xb_ld(&bar[XB_XCNT(j)]); sum += c; cnt += (c > 0u) ? 1u : 0u; mine = (j == x) ? c : mine; }
        if (sum == G) break;
        __builtin_amdgcn_s_sleep(1);
        if ((++sp & 255u) == 0u) { if (xb_ld(&bar[XB_TMO])) break; if (sp > XB_SPIN_CAP) { atomicAdd(&bar[XB_TMO], 1u); break; } }
    }
    nloc = mine > 0u ? mine : 1u; nx = cnt > 0u ? cnt : 1u;
}

__device__ __forceinline__ void xcd_barrier(const XcdBarrier& b) {
    asm volatile("s_waitcnt vmcnt(0)" ::: "memory");
    __syncthreads();
    if (tidx() == 0) {
        unsigned* bar = b.bar;
        __builtin_amdgcn_s_waitcnt(0);
        unsigned nloc = b.st[0], nx = b.st[1];
        if (nloc == 0u) { xcd_barrier_complete(bar, b.x, nloc, nx); b.st[0] = nloc; b.st[1] = nx; }
        const unsigned old = xb_add(&bar[XB_XSUB(b.x)], 1u);
        const unsigned gen = old / nloc;
        if (old + 1u == (gen + 1u) * nloc) {
            __builtin_amdgcn_fence(__ATOMIC_RELEASE, "agent");
            asm volatile("s_waitcnt vmcnt(0)" ::: "memory");
            const unsigned og = xb_add(&bar[XB_TOP], 1u);
            const unsigned tg = og / nx;
            if (og + 1u == (tg + 1u) * nx) xb_add(&bar[XB_TOPGEN], 1u);
            else XB_SPIN(xb_ld(&bar[XB_TOPGEN]) == tg, bar);
            __builtin_amdgcn_fence(__ATOMIC_ACQUIRE, "agent");
            xb_add(&bar[XB_XGEN(b.x)], 1u);
            asm volatile("s_waitcnt vmcnt(0)" ::: "memory");
        } else {
            XB_SPIN(xb_ld(&bar[XB_XGEN(b.x)]) == gen, bar);
            __builtin_amdgcn_fence(__ATOMIC_ACQUIRE, "agent");
            asm volatile("s_waitcnt vmcnt(0)" ::: "memory");
        }
    }
    __syncthreads();
}

#ifndef STAG_B
#define STAG_B 240
#endif
#ifndef STAG_D
#define STAG_D 300
#endif
#ifndef REP_ATTN
#define REP_ATTN 1
#endif
#ifndef REP_B
#define REP_B 1
#endif
#ifndef REP_C1
#define REP_C1 1
#endif
#ifndef REP_C2
#define REP_C2 1
#endif
#ifndef REP_C3
#define REP_C3 1
#endif
#ifndef REP_DE
#define REP_DE 1
#endif
__device__ __forceinline__ void stagger(int ticks_per_slot) {
    const int slot = ((int)blockIdx.x >> 3) & 7;
    if (slot) { const unsigned long long t0 = __builtin_amdgcn_s_memrealtime(), dt = (unsigned long long)(slot * ticks_per_slot);
        while (__builtin_amdgcn_s_memrealtime() - t0 < dt) __builtin_amdgcn_s_sleep(4); }
}
template <class Epi> __device__ __forceinline__ void run_gemm(LAS unsigned char* lds, const u16* A, const u16* Bt, int M, int N, int K, const Epi& E) {
    pg8::Gemm g; g.A = A; g.Bt = Bt; g.M = M; g.N = N; g.K = K; g.rsA = 0; g.rsB = 0;
    pg8::StaticOrder S; S.init(M, N, (int)gridDim.x, (int)blockIdx.x);
    pg8::gemm_phase<Epi, pg8::StaticOrder, false>(lds, g, S, E, nullptr);
}


struct EpiNull {
    static constexpr bool PERM = true, AFTER_DRAIN = false;
    unsigned char* ws;
    __device__ __forceinline__ void operator()(const f32x4 (&acc)[2][2][4][2], const Unit& u, int wr, int wc, int fr, int fq) const {
        if (ws == nullptr) {
#pragma unroll
            for (int ai = 0; ai < 2; ++ai)
#pragma unroll
                for (int bj = 0; bj < 2; ++bj)
#pragma unroll
                    for (int m = 0; m < 4; ++m)
#pragma unroll
                        for (int n = 0; n < 2; ++n) *(f32x4*)(ws + (size_t)(((ai * 2 + bj) * 4 + m) * 2 + n) * 16 + fr * 1024 + fq * 65536 + wr * 4096 + wc * 16384 + u.pm) = acc[ai][bj][m][n];
        }
    }
};
struct MergeOrder : pg8::StaticOrder {
    __device__ bool next(int i, Unit& u) const { if (!pg8::StaticOrder::next(i >> 2, u)) return false; u.r = i & 3; return true; }
};
__device__ __forceinline__ Params KP() {
    auto q0 = __builtin_amdgcn_kernarg_segment_ptr();
    asm volatile("" : "+s"(q0));
    const __attribute__((address_space(4))) Params* q = (const __attribute__((address_space(4))) Params*)q0;
    Params r;
    r.x = q->x; r.c = q->c; r.ctx = q->ctx; r.c_ctx = q->c_ctx; r.w_ada = q->w_ada; r.b_ada = q->b_ada; r.g_pre = q->g_pre; r.g_post = q->g_post; r.w_in = q->w_in; r.rpb = q->rpb;
    r.fnet_w = q->fnet_w; r.gmlp_g = q->gmlp_g; r.gmlp_ws = q->gmlp_ws; r.gmlp_bs = q->gmlp_bs; r.lb_logits = q->lb_logits; r.hgrn_g = q->hgrn_g; r.w_branch = q->w_branch; r.w_out = q->w_out;
    r.out = q->out; r.ws = q->ws; return r;
}
constexpr size_t OFF_BAR = WS_END;
constexpr size_t WS_END2 = WS_END + (size_t)XCD_BAR_WORDS * 4;
__device__ __forceinline__ void gsync(LAS unsigned char* lds3) {
    XcdBarrier b; b.bar = (unsigned*)(opaque(KP().ws) + OFF_BAR); b.x = xb_xcc_id(); b.st = (volatile LAS unsigned*)(lds3 + LDS_BYTES);
    xcd_barrier(b);
}
__global__ void __launch_bounds__(512, 2) mega_fwd(Params p_unused) {
    extern __shared__ __attribute__((aligned(16))) unsigned char shm[];
    LAS unsigned char* lds3 = (LAS unsigned char*)shm;
    {
        if (tidx() < 4) ((volatile LAS unsigned*)(lds3 + LDS_BYTES))[tidx()] = 0u;
        if (blockIdx.x == 0) { unsigned* bar = (unsigned*)(opaque(KP().ws) + OFF_BAR); for (int i = tidx(); i < XCD_BAR_WORDS; i += 512) bar[i] = 0u; }
        __syncthreads();
    }
    prep1(KP(), shm);
    cg::this_grid().sync();
    { XcdBarrier b0 = xcd_barrier_post((unsigned*)(opaque(KP().ws) + OFF_BAR), (volatile LAS unsigned*)(lds3 + LDS_BYTES)); (void)b0; }
    prep2(KP(), shm);
    gsync(lds3);
#pragma nounroll
    for (int pass = 0; pass < 1 + NBATCH / GB; ++pass) {
        PassInfo ps;
        if (pass == 0) { ps.is_ctx = 1; ps.nb = NBATCH; ps.T = CTXL; ps.M = MCTX; ps.b0 = 0; }
        else { ps.is_ctx = 0; ps.nb = GB; ps.T = SEQ; ps.M = MLAT; ps.b0 = (pass - 1) * GB; }
        const int NC = ps.T >> 6;
#pragma nounroll
        for (int l = 0; l < DEPTH; ++l) {
            phase_norm(KP(), ps, l);
            gsync(lds3);
            _Pragma("nounroll") for (int rep = 0; rep < REP_B; ++rep) {
                unsigned char* ws = opaque(KP().ws);
                EpiProj E; E.ws = ws; E.l = l; E.is_ctx = ps.is_ctx;

                run_gemm(lds3, (const u16*)(ws + OFF_H), (const u16*)(ws + OFF_WTIN) + (size_t)l * NPROJ * DM, ps.M, NPROJ, DM, E);
                gsync(lds3);
#ifdef PROBE_NULL_B
                { EpiNull EN; EN.ws = ws; run_gemm(lds3, (const u16*)(ws + OFF_H), (const u16*)(ws + OFF_WTIN) + (size_t)l * NPROJ * DM, ps.M, NPROJ, DM, EN); gsync(lds3); }
#endif
            }
            const bool full = !(ps.is_ctx && l == DEPTH - 1);
            {
                const int nch = ps.nb * 16, n_at = full ? ps.nb * 8 * (ps.T >> 6) : 0, n_f1 = ps.is_ctx ? 0 : ps.nb * 64, n_g = 0;
                const int wg = (int)blockIdx.x, G = (int)gridDim.x;
                int first, stride;
                bool xl = false; int xcd = 0, lr = 0, nloc = 1;
                if (nch >= G || G != 4 * nch || (G & 7) != 0 || !full) {
                    for (int ci = wg; ci < nch; ci += G) hgrn_chain(KP(), ps, l, ci, shm);
                    first = wg; stride = G;
                } else {
                    const int g4 = wg >> 2, pos = wg & 3, cpos = (g4 >> 1) & 3;
                    first = 0x7fffffff; stride = 1;
                    if (pos == cpos) hgrn_chain(KP(), ps, l, g4, shm);
                    else {
                        xl = true; xcd = wg & 7; nloc = 0;
                        for (int w2 = xcd; w2 < G; w2 += 8) { const int g2 = w2 >> 2, nonchain = ((w2 & 3) != ((g2 >> 1) & 3)) ? 1 : 0; nloc += nonchain; if (w2 < wg) lr += nonchain; }
                    }
                }
                const int A_x = n_at >> 3, F_x = n_f1 >> 3;
                const int na = xl ? (A_x - lr + nloc - 1) / nloc : 0;
                for (int k = 0;; ++k) {
                    int it;
                    if (xl) {
                        if (k < na) { const int a = lr + k * nloc; it = (((a >> 6) << 3) + xcd) * 64 + (a & 63); }
                        else { const int f = (nloc - 1 - lr) + (k - na) * nloc; if (f >= F_x) break; it = n_at + xcd * F_x + f; }
                    } else { it = first + k * stride; if (first == 0x7fffffff || it >= n_at + n_f1 + n_g) break; }
                    if (it < n_at) attn_item(KP(), ps, l, it, shm);
                    else if (it < n_at + n_f1) four1_item(KP(), it - n_at, shm);
                    else gmlp_item(KP(), l, it - n_at - n_f1, shm);
                }
                gsync(lds3);
            }
            if (!full) continue;
            {
                const int n_f2 = ps.is_ctx ? ps.nb * 4 : ps.nb * 64, n_h3 = ps.nb * 8 * NC, n_g3 = ps.M >> 7;
                for (int it = blockIdx.x; it < n_f2 + n_h3 + n_g3; it += gridDim.x) {
                    if (it < n_f2) { if (ps.is_ctx) fourc_item(KP(), it, shm); else four2_item(KP(), it, shm); }
                    else if (it < n_f2 + n_h3) hgrn3_item(KP(), ps, l, it - n_f2, shm);
                    else gmlp_item(KP(), l, it - n_f2 - n_h3, shm);
                }
                gsync(lds3);
            }
            _Pragma("nounroll") for (int rep = 0; rep < REP_DE; ++rep) {
            {
                unsigned char* ws = opaque(KP().ws);
                pg8::Gemm g; g.A = (const u16*)(ws + OFF_Y); g.Bt = (const u16*)(ws + OFF_WTBR) + (size_t)l * 4 * 1024 * 512; g.M = ps.M; g.N = 1024; g.K = 512;
                g.rsA = (size_t)MLAT * 512 * 2; g.rsB = (size_t)1024 * 512 * 2;
                MergeOrder S; S.init(ps.M, 1024, (int)gridDim.x, (int)blockIdx.x);
                EpiMerge E; E.ws = ws;

                pg8::gemm_phase<EpiMerge, MergeOrder, false>(lds3, g, S, E, nullptr);
            }
            gsync(lds3);
            if (REP_DE > 1 && rep + 1 < REP_DE) continue;
            {
                unsigned char* ws = opaque(KP().ws);
                EpiOut E; E.C = (u16*)(ws + OFF_OUT);
                run_gemm(lds3, (const u16*)(ws + OFF_MB), (const u16*)(ws + OFF_WTOUT) + (size_t)l * 1024 * 1024, ps.M, 1024, 1024, E);
            }
            gsync(lds3);
            }
        }
        if (!ps.is_ctx) phase_norm(KP(), ps, DEPTH);
    }
}

static_assert(WS_END2 <= (size_t)1073741824, "workspace map exceeds 1 GiB");

extern "C" void kernel_launch(void* const* d_in, const int* in_sizes, int n_in, void* d_out, int out_size, void* d_ws, size_t ws_size, hipStream_t stream) {
    static int grid_blocks = 0;
    if (grid_blocks == 0) {
        if (n_in != 18 || ws_size < WS_END2) { fprintf(stderr, "kernel_launch: unexpected n_in %d or ws_size %zu (need %zu)\n", n_in, ws_size, (size_t)WS_END2); grid_blocks = -1; return; }
        int dev = 0, cus = 0, per_cu = 0;
        hipGetDevice(&dev);
        hipDeviceGetAttribute(&cus, hipDeviceAttributeMultiprocessorCount, dev);
        if (hipFuncSetAttribute((const void*)mega_fwd, hipFuncAttributeMaxDynamicSharedMemorySize, LDS_BYTES + 16) != hipSuccess) { fprintf(stderr, "kernel_launch: hipFuncSetAttribute failed\n"); grid_blocks = -1; return; }
        hipOccupancyMaxActiveBlocksPerMultiprocessor(&per_cu, (const void*)mega_fwd, 512, LDS_BYTES + 16);
        if (per_cu < 1) { fprintf(stderr, "kernel_launch: occupancy query gave %d\n", per_cu); per_cu = 1; }
        (void)hipGetLastError();
        grid_blocks = cus * per_cu;
    }
    if (grid_blocks < 0) return;
    Params p{};
    const float** pp = (const float**)&p;
    for (int i = 0; i < 18; ++i) pp[i] = (const float*)d_in[i];
    p.out = (float*)d_out; p.ws = (unsigned char*)d_ws;
    void* args[] = {&p};
    hipError_t e = hipLaunchCooperativeKernel((const void*)mega_fwd, dim3(grid_blocks), dim3(512), args, LDS_BYTES + 16, stream);
    if (e != hipSuccess) fprintf(stderr, "cooperative launch failed: %s (grid %d)\n", hipGetErrorString(e), grid_blocks);
}
```

```cpp
#include <hip/hip_runtime.h>
#include <hip/hip_cooperative_groups.h>
#include <cstdio>
namespace cg = cooperative_groups;
__device__ __forceinline__ int tidx() { int t = threadIdx.x; asm volatile("" : "+v"(t)); return t; }
template <class T> __device__ __forceinline__ T* opaque(T* p) {
    unsigned long long v = (unsigned long long)p; const unsigned lo = __builtin_amdgcn_readfirstlane((unsigned)v), hi = __builtin_amdgcn_readfirstlane((unsigned)(v >> 32));
    v = ((unsigned long long)hi << 32) | lo; asm volatile("" : "+s"(v)); return (T*)((__attribute__((address_space(1))) T*)v); }
__device__ __forceinline__ float shx(float v, int m) { const int lane = tidx() & 63; return __int_as_float(__builtin_amdgcn_ds_bpermute((lane ^ m) << 2, __float_as_int(v))); }
namespace pg8 {
#define PG8_LAS __attribute__((address_space(3)))
typedef unsigned short bf16_t;
typedef short bf16x8 __attribute__((ext_vector_type(8)));
typedef float f32x4 __attribute__((ext_vector_type(4)));
typedef unsigned u32x4 __attribute__((ext_vector_type(4)));
constexpr int BM = 256, BK = 64, HALF = 128, HTB = HALF * BK * 2  , STAGE_BYTES = 8 * HTB, NXCD = 8, WGM = 8;

__host__ __device__ __forceinline__ int lds_byte(int r, int c) { const int st = (r >> 4) * 2 + (c >> 5), rr = r & 15, cc = c & 31, ob = rr * 64 + cc * 2; return st * 1024 + (ob ^ (((ob >> 9) & 1) << 5)); }
__host__ __device__ __forceinline__ void stage_rc(int b, int& R, int& C) { const int st = b / 1024, sb = b % 1024, swz = sb ^ (((sb >> 9) & 1) << 5); R = (st >> 1) * 16 + swz / 64; C = (st & 1) * 32 + (swz % 64) / 2; }
__host__ __device__ __forceinline__ int perm32(int rho) { const int n = rho >> 4, i = rho & 15; return 8 * (i >> 2) + 4 * n + (i & 3); }

struct Unit { int pm, pn, r; };
struct Gemm { const bf16_t* A; const bf16_t* Bt; int M, N, K; size_t rsA, rsB; };

struct StaticOrder {
    int nM, nN, nwg, G, c;
    __host__ __device__ void init(int M, int N, int G_, int c_) { nM = M / BM; nN = N / BM; nwg = nM * nN; G = G_; c = c_; }
    __host__ __device__ bool next(int i, Unit& u) const {
        const long L = (long)i * G + c; if (L >= nwg) return false;
        int wgid = (int)L; { const int q = nwg / NXCD, r = nwg % NXCD, xcd = wgid % NXCD, off = wgid / NXCD; wgid = (xcd < r ? xcd * (q + 1) : r * (q + 1) + (xcd - r) * q) + off; }
        const int nig = WGM * nN, gid = wgid / nig, fm = gid * WGM, gsz = (nM - fm) < WGM ? (nM - fm) : WGM;
        u.pm = fm + ((wgid % nig) % gsz); u.pn = (wgid % nig) / gsz; u.r = 0; return true;
    }
    __device__ __forceinline__ void a_ready(const Unit&) const {}
    __device__ __forceinline__ void done(const Unit&) const {}
};
__device__ __forceinline__ unsigned cvt_pk_bf16(float lo, float hi) { unsigned r; asm volatile("v_cvt_pk_bf16_f32 %0, %1, %2" : "=v"(r) : "v"(lo), "v"(hi)); return r; }

template <class Epi, class Sched, bool STAMP = false>
__device__ __forceinline__ void gemm_phase(PG8_LAS unsigned char* lds, const Gemm g, const Sched& S, const Epi& E, unsigned long long* stamps) {
    const int tid = tidx(), wid = __builtin_amdgcn_readfirstlane(tid >> 6), lane = tid & 63, wr = wid >> 2, wc = wid & 3, fr = lane & 15, fq = lane >> 4;
    const int K = g.K, nt = K / BK;
    int ts_lo = 0, ts_hi = 0, nts = 0; const unsigned long long rt_entry = STAMP ? (unsigned long long)wall_clock64() : 0ull;
#define PG8_STAMP() do { if (STAMP && wid == 0 && nts < 64) { const unsigned long long _c = (unsigned long long)clock64(); \
        ts_lo = (lane == nts) ? (int)(unsigned)_c : ts_lo; ts_hi = (lane == nts) ? (int)(unsigned)(_c >> 32) : ts_hi; ++nts; } } while (0)
    PG8_STAMP();
    unsigned voffA[2], voffB[2];
#pragma unroll
    for (int i = 0; i < 2; ++i) { int R, C; stage_rc(tid * 16 + i * 8192, R, C); const int Rb = Epi::PERM ? ((R & ~31) + perm32(R & 31)) : R;
        voffA[i] = (unsigned)(R * K + C) * 2u; voffB[i] = (unsigned)(Rb * K + C) * 2u; }
    const size_t kstep = (size_t)(BK * 2);
    const size_t hstep = (size_t)HALF * K * 2;
    const size_t tstep = 2 * hstep;
    const unsigned ldsw = (unsigned)wid * 1024u;
    const int aoff = lds_byte(wr * 64 + fr, fq * 8), boff = lds_byte(wc * 32 + fr, fq * 8);
#define PG8_SA(b, h) (((b) * 2 + (h)) * HTB)
#define PG8_SB(b, h) ((4 + (b) * 2 + (h)) * HTB)
#define PG8_STAGE(bufoff, gbase, voff) do { _Pragma("unroll") for (int _i = 0; _i < 2; ++_i) \
        __builtin_amdgcn_global_load_lds((const unsigned*)((const char*)(gbase) + (voff)[_i]), (PG8_LAS unsigned*)(lds + (bufoff) + ldsw + _i * 8192), 16, 0, 0); } while (0)
#define PG8_LDA(dst, b, h) do { _Pragma("unroll") for (int m = 0; m < 4; ++m) _Pragma("unroll") for (int k = 0; k < 2; ++k) dst[m][k] = *(const PG8_LAS bf16x8*)(lds + PG8_SA(b, h) + aoff + m * 2048 + k * 1024); } while (0)
#define PG8_LDB(dst, b, h) do { _Pragma("unroll") for (int n = 0; n < 2; ++n) _Pragma("unroll") for (int k = 0; k < 2; ++k) dst[n][k] = *(const PG8_LAS bf16x8*)(lds + PG8_SB(b, h) + boff + n * 2048 + k * 1024); } while (0)
#define PG8_MMA(ai, bj, At, Bt) do { __builtin_amdgcn_s_setprio(1); _Pragma("unroll") for (int m = 0; m < 4; ++m) _Pragma("unroll") for (int n = 0; n < 2; ++n) _Pragma("unroll") for (int k = 0; k < 2; ++k) \
        acc[ai][bj][m][n] = __builtin_amdgcn_mfma_f32_16x16x32_bf16(Bt[n][k], At[m][k], acc[ai][bj][m][n], 0, 0, 0); __builtin_amdgcn_s_setprio(0); } while (0)
#define PG8_WAIT_V(n) asm volatile("s_waitcnt vmcnt(" #n ")" ::: "memory")
#define PG8_WAIT_L(n) asm volatile("s_waitcnt lgkmcnt(" #n ")" ::: "memory")
#define PG8_BAR __builtin_amdgcn_s_barrier()
#define PG8_SCHED __builtin_amdgcn_sched_barrier(0)
    Unit cur, nxt; int ui = 0;
    if (!S.next(0, cur)) return;
    f32x4 acc[2][2][4][2];
#pragma unroll
    for (int a = 0; a < 2; ++a)
#pragma unroll
        for (int b = 0; b < 2; ++b)
#pragma unroll
            for (int m = 0; m < 4; ++m)
#pragma unroll
                for (int n = 0; n < 2; ++n) acc[a][b][m][n] = (f32x4){0.f, 0.f, 0.f, 0.f};
    bf16x8 At[4][2], B0[2][2], B1[2][2];
    const char* cA = (const char*)g.A + (size_t)cur.pm * tstep + (size_t)cur.r * g.rsA; const char* cB = (const char*)g.Bt + (size_t)cur.pn * tstep + (size_t)cur.r * g.rsB;
    S.a_ready(cur);
    PG8_STAGE(PG8_SB(0, 0), cB, voffB); PG8_STAGE(PG8_SA(0, 0), cA, voffA); PG8_STAGE(PG8_SB(0, 1), cB + hstep, voffB); PG8_STAGE(PG8_SA(0, 1), cA + hstep, voffA);
    if (wr == 1) PG8_BAR;
    PG8_WAIT_V(4); PG8_BAR;
    PG8_STAGE(PG8_SB(1, 0), cB + kstep, voffB); PG8_STAGE(PG8_SA(1, 0), cA + kstep, voffA); PG8_STAGE(PG8_SB(1, 1), cB + hstep + kstep, voffB);
    PG8_WAIT_V(6); PG8_BAR;
    PG8_STAMP();
    for (;;) {
        const bool has_next = S.next(ui + 1, nxt);
        const char* nA = has_next ? (const char*)g.A + (size_t)nxt.pm * tstep + (size_t)nxt.r * g.rsA : cA; const char* nB = has_next ? (const char*)g.Bt + (size_t)nxt.pn * tstep + (size_t)nxt.r * g.rsB : cB;
        for (int t = 0; t < nt; t += 2) {
            const bool last = (t == nt - 2);
            const char* a1 = cA + (size_t)(t + 1) * kstep;
            const char* a2 = last ? nA : cA + (size_t)(t + 2) * kstep; const char* b2 = last ? nB : cB + (size_t)(t + 2) * kstep;
            const char* a3 = a2 + kstep; const char* b3 = b2 + kstep;
            if (last && has_next) S.a_ready(nxt);
            PG8_LDB(B0, 0, 0); PG8_SCHED; PG8_LDA(At, 0, 0); PG8_STAGE(PG8_SA(1, 1), a1 + hstep, voffA);
            PG8_WAIT_L(8); PG8_BAR; PG8_WAIT_L(0); PG8_MMA(0, 0, At, B0); PG8_BAR; PG8_SCHED;
            PG8_LDB(B1, 0, 1); PG8_STAGE(PG8_SB(0, 0), b2, voffB);
            PG8_BAR; PG8_WAIT_L(0); PG8_MMA(0, 1, At, B1); PG8_BAR;
            PG8_LDA(At, 0, 1); PG8_STAGE(PG8_SA(0, 0), a2, voffA);
            PG8_BAR; PG8_WAIT_L(0); PG8_MMA(1, 0, At, B0); PG8_BAR; PG8_SCHED;
            PG8_STAGE(PG8_SB(0, 1), b2 + hstep, voffB);
            PG8_WAIT_V(6); PG8_BAR; PG8_MMA(1, 1, At, B1); PG8_BAR;
            PG8_LDB(B0, 1, 0); PG8_SCHED; PG8_LDA(At, 1, 0); PG8_STAGE(PG8_SA(0, 1), a2 + hstep, voffA);
            PG8_WAIT_L(8); PG8_BAR; PG8_WAIT_L(0); PG8_MMA(0, 0, At, B0); PG8_BAR; PG8_SCHED;
            PG8_LDB(B1, 1, 1); PG8_STAGE(PG8_SB(1, 0), b3, voffB);
            PG8_BAR; PG8_WAIT_L(0); PG8_MMA(0, 1, At, B1); PG8_BAR;
            PG8_LDA(At, 1, 1); PG8_STAGE(PG8_SA(1, 0), a3, voffA);
            PG8_BAR; PG8_WAIT_L(0); PG8_MMA(1, 0, At, B0); PG8_BAR; PG8_SCHED;
            PG8_STAGE(PG8_SB(1, 1), b3 + hstep, voffB);
            PG8_WAIT_V(6); PG8_BAR; PG8_MMA(1, 1, At, B1); PG8_BAR;
        }
        PG8_STAMP();
        if constexpr (!Epi::AFTER_DRAIN) { E(acc, cur, wr, wc, fr, fq); S.done(cur); }
        PG8_STAMP();
        if (!has_next) break;
#pragma unroll
        for (int a = 0; a < 2; ++a)
#pragma unroll
            for (int b = 0; b < 2; ++b)
#pragma unroll
                for (int m = 0; m < 4; ++m)
#pragma unroll
                    for (int n = 0; n < 2; ++n) acc[a][b][m][n] = (f32x4){0.f, 0.f, 0.f, 0.f};
        cur = nxt; cA = nA; cB = nB; ++ui;
    }
    PG8_WAIT_V(0);
    if (wr == 0) PG8_BAR;
    PG8_BAR;
    if constexpr (Epi::AFTER_DRAIN) { E.fused(acc, cur, wr, wc, fr, fq, lds, wid, lane); S.done(cur); }
    PG8_STAMP();
    if (STAMP && wid == 0) { stamps[lane] = lane < nts ? (((unsigned long long)(unsigned)ts_hi << 32) | (unsigned)ts_lo) : 0ull;
        if (lane == 62) stamps[62] = rt_entry; if (lane == 63) stamps[63] = (unsigned long long)wall_clock64(); }
#undef PG8_STAMP
#undef PG8_SA
#undef PG8_SB
#undef PG8_STAGE
#undef PG8_LDA
#undef PG8_LDB
#undef PG8_MMA
#undef PG8_WAIT_V
#undef PG8_WAIT_L
#undef PG8_BAR
#undef PG8_SCHED
}
}

typedef unsigned short u16;
typedef short s16x4 __attribute__((ext_vector_type(4)));
using pg8::bf16x8; using pg8::f32x4; using pg8::Unit;
#define LAS __attribute__((address_space(3)))
#define MFMA16(a, b, c) __builtin_amdgcn_mfma_f32_16x16x32_bf16(a, b, c, 0, 0, 0)

constexpr int DM = 1024, NBATCH = 16, SEQ = 4096, DEPTH = 4, CTXL = 256, NPROJ = 11776, NIN = 11264;
constexpr int GB = 4, MLAT = GB * SEQ, MCTX = NBATCH * CTXL;
constexpr int LDS_BYTES = 152 * 1024;
constexpr float LOG2E = 1.4426950408889634f;
constexpr float EPSN = 1e-6f;
constexpr float QSCALE = 0.125f * 1.4426950408889634f;

constexpr size_t al256(size_t x) { return (x + 255) & ~(size_t)255; }
constexpr size_t OFF_WTIN = 0;
constexpr size_t OFF_WTBR = OFF_WTIN + (size_t)DEPTH * NPROJ * DM * 2;
constexpr size_t OFF_WTOUT = OFF_WTBR + (size_t)DEPTH * 4 * 1024 * 512 * 2;
constexpr size_t OFF_WS16 = OFF_WTOUT + (size_t)DEPTH * 1024 * 1024 * 2;
constexpr size_t OFF_MOD = OFF_WS16 + (size_t)DEPTH * 8 * 128 * 128 * 2;
constexpr size_t OFF_LB = OFF_MOD + al256((size_t)DEPTH * 17 * 3072 * 4);
constexpr size_t OFF_ROPE = OFF_LB + (size_t)DEPTH * 2 * 512 * 4;
constexpr size_t OFF_TW = OFF_ROPE + 2 * 64 * 16 * 4;
constexpr size_t OFF_M1 = OFF_TW + 4096 * 8;
constexpr size_t OFF_M2 = OFF_M1 + 128 * 128 * 2;
constexpr size_t OFF_M3 = OFF_M2 + 64 * 128 * 2;
constexpr size_t OFF_CSW = OFF_M3 + 256 * 512 * 2;
constexpr size_t OFF_CTXW = OFF_CSW + (size_t)DEPTH * 4 * 2 * 128 * 128 * 4;
constexpr size_t OFF_CTXKV = OFF_CTXW + (size_t)NBATCH * CTXL * DM * 4;
constexpr size_t OFF_CTXST = OFF_CTXKV + (size_t)DEPTH * MCTX * 1024 * 2;
constexpr size_t OFF_H = OFF_CTXST + (size_t)DEPTH * 256 * 4096 * 4;
constexpr size_t OFF_PROJ = OFF_H + (size_t)MLAT * DM * 2;
constexpr size_t OFF_QROT = OFF_PROJ + (size_t)MLAT * NPROJ * 2;
constexpr size_t OFF_LOGF = OFF_QROT + (size_t)MLAT * 512 * 2;
constexpr size_t OFF_Y = OFF_LOGF + (size_t)MLAT * 1024 * 4;
constexpr size_t OFF_FY = OFF_Y + (size_t)4 * MLAT * 512 * 2;
constexpr size_t OFF_HL = OFF_FY + (size_t)GB * 4096 * 1024 * 2;
constexpr size_t OFF_HD = OFF_HL + (size_t)4096 * 4096 * 4;
constexpr size_t OFF_HS = OFF_HD + (size_t)4096 * 64 * 4;
constexpr size_t OFF_MB = OFF_HS + (size_t)4096 * 4096 * 4;
constexpr size_t WS_END = OFF_MB + (size_t)MLAT * DM * 2;
constexpr size_t OFF_MERGED = OFF_LOGF;
constexpr size_t OFF_OUT = OFF_PROJ;

struct Params {
    const float *x, *c, *ctx, *c_ctx, *w_ada, *b_ada, *g_pre, *g_post, *w_in, *rpb, *fnet_w, *gmlp_g, *gmlp_ws, *gmlp_bs, *lb_logits, *hgrn_g, *w_branch, *w_out;
    float* out; unsigned char* ws;
};
struct PassInfo { int is_ctx, nb, T, M, b0; };

__device__ __forceinline__ u16 f2bf(float f) { unsigned u = __float_as_uint(f); u += 0x7FFFu + ((u >> 16) & 1u); return (u16)(u >> 16); }
__device__ __forceinline__ float bf2f(u16 b) { return __uint_as_float(((unsigned)b) << 16); }
typedef __bf16 bf16x2_t_ __attribute__((ext_vector_type(2)));
typedef float f32x2_t_ __attribute__((ext_vector_type(2)));
__device__ __forceinline__ unsigned pack2(float a, float b) { f32x2_t_ v = {a, b}; bf16x2_t_ r = __builtin_convertvector(v, bf16x2_t_); return __builtin_bit_cast(unsigned, r); }
__device__ __forceinline__ float bflo(unsigned w) { return __uint_as_float(w << 16); }
__device__ __forceinline__ float bfhi(unsigned w) { return __uint_as_float(w & 0xFFFF0000u); }
__device__ __forceinline__ float sigmoidf_(float v) { return __builtin_amdgcn_rcpf(1.f + __builtin_amdgcn_exp2f(-LOG2E * v)); }
__device__ __forceinline__ float siluf_(float v) { return v * __builtin_amdgcn_rcpf(1.f + __builtin_amdgcn_exp2f(-LOG2E * v)); }
__device__ __forceinline__ void unpack8(uint4 w, float* f) { f[0] = bflo(w.x); f[1] = bfhi(w.x); f[2] = bflo(w.y); f[3] = bfhi(w.y); f[4] = bflo(w.z); f[5] = bfhi(w.z); f[6] = bflo(w.w); f[7] = bfhi(w.w); }
__device__ __forceinline__ bf16x8 tr_read2(const u16* p0, const u16* p1) {
    s16x4 a = __builtin_amdgcn_ds_read_tr16_b64_v4i16((LAS s16x4*)p0);
    s16x4 b = __builtin_amdgcn_ds_read_tr16_b64_v4i16((LAS s16x4*)p1);
    return (bf16x8){a[0], a[1], a[2], a[3], b[0], b[1], b[2], b[3]};
}
__device__ __forceinline__ bf16x8 ld_frag_g(const u16* p) { return *(const bf16x8*)p; }

typedef unsigned u32x4_ __attribute__((ext_vector_type(4)));
__device__ __forceinline__ void nt_store16(uint4 w, void* p) { __builtin_nontemporal_store((u32x4_){w.x, w.y, w.z, w.w}, (u32x4_*)p); }
struct EpiProj {
    static constexpr bool PERM = true, AFTER_DRAIN = false;
    unsigned char* ws; int l; int is_ctx;
    __device__ __forceinline__ void operator()(const f32x4 (&acc)[2][2][4][2], const Unit& u, int wr, int wc, int fr, int fq) const {
        u16* proj = (u16*)(ws + OFF_PROJ);
        const int blk = u.pn >> 1;
        const int row0 = u.pm * 256 + wr * 64 + fr, col0 = u.pn * 256 + wc * 32 + 8 * fq;
        u16* pbase = proj + ((size_t)blk * MLAT + row0) * 512 + (col0 & 511);
        if ((blk == 0 || blk == 1) && !is_ctx) {
            u16* qrot = (u16*)(ws + OFF_QROT); const float* rope = (const float*)(ws + OFF_ROPE);
            const int f0 = 8 * (fq & 1); const float sgn = (fq >> 1) ? 1.f : -1.f;
#pragma unroll
            for (int ai = 0; ai < 2; ++ai)
#pragma unroll
                for (int m = 0; m < 4; ++m) {
                    const int row = row0 + ai * 128 + m * 16;
                    const int t = row & 4095, pos = (wc & 1) ? (t & 63) : (t >> 6);
                    const float4 c0 = *(const float4*)(rope + pos * 16 + f0), c1 = *(const float4*)(rope + pos * 16 + f0 + 4);
                    const float4 s0 = *(const float4*)(rope + 1024 + pos * 16 + f0), s1 = *(const float4*)(rope + 1024 + pos * 16 + f0 + 4);
                    const float cs[8] = {c0.x, c0.y, c0.z, c0.w, c1.x, c1.y, c1.z, c1.w}, sn[8] = {s0.x, s0.y, s0.z, s0.w, s1.x, s1.y, s1.z, s1.w};
#pragma unroll
                    for (int bj = 0; bj < 2; ++bj) {
                        const f32x4 v0 = acc[ai][bj][m][0], v1 = acc[ai][bj][m][1];
                        const float qs_ = (blk == 0) ? QSCALE : 1.f;
                        const float o[8] = {v0[0] * qs_, v0[1] * qs_, v0[2] * qs_, v0[3] * qs_, v1[0] * qs_, v1[1] * qs_, v1[2] * qs_, v1[3] * qs_};
                        float r[8];
#pragma unroll
                        for (int e = 0; e < 8; ++e) { const float pr = shx(o[e], 32); r[e] = o[e] * cs[e] + sgn * pr * sn[e]; }
                        uint4 wr_; wr_.x = pack2(r[0], r[1]); wr_.y = pack2(r[2], r[3]); wr_.z = pack2(r[4], r[5]); wr_.w = pack2(r[6], r[7]);
                        u16* dst = pbase + (size_t)(ai * 128 + m * 16) * 512 + bj * 128;
                        if (blk == 0) {
                            uint4 wp; wp.x = pack2(o[0], o[1]); wp.y = pack2(o[2], o[3]); wp.z = pack2(o[4], o[5]); wp.w = pack2(o[6], o[7]);
                            nt_store16(wp, dst);
                            nt_store16(wr_, qrot + (size_t)row * 512 + (col0 & 511) + bj * 128);
                        } else nt_store16(wr_, dst);
                    }
                }
        } else if (blk == 11 || blk == 12) {
            float* logf = (float*)(ws + OFF_LOGF); const float* lb = (const float*)(ws + OFF_LB) + l * 1024;
            const int dir = blk - 11;
#pragma unroll
            for (int bj = 0; bj < 2; ++bj) {
                const int cc = (col0 & 511) + bj * 128;
                const float4 l0 = *(const float4*)(lb + dir * 512 + cc), l1 = *(const float4*)(lb + dir * 512 + cc + 4);
                const float lbv[8] = {l0.x, l0.y, l0.z, l0.w, l1.x, l1.y, l1.z, l1.w};
#pragma unroll
                for (int ai = 0; ai < 2; ++ai)
#pragma unroll
                    for (int m = 0; m < 4; ++m) {
                        const int row = row0 + ai * 128 + m * 16;
                        const f32x4 v0 = acc[ai][bj][m][0], v1 = acc[ai][bj][m][1];
                        const float z[8] = {v0[0], v0[1], v0[2], v0[3], v1[0], v1[1], v1[2], v1[3]};
                        float lf[8], o[8];
#pragma unroll
                        for (int e = 0; e < 8; ++e) {
                            const float ez = __expf(-z[e]);
                            const float inv = __builtin_amdgcn_rcpf(1.f + ez);
                            const float sg = inv, sgn_ = (ez > 1e30f) ? 1.f : ez * inv;
                            const float f = lbv[e] + (1.f - lbv[e]) * sg;
                            lf[e] = __logf(fmaxf(f, 1e-30f));
                            o[e] = (1.f - lbv[e]) * sgn_;
                        }
                        float* lp = logf + (size_t)row * 1024 + dir * 512 + cc;
                        __builtin_nontemporal_store((f32x4){lf[0], lf[1], lf[2], lf[3]}, (f32x4*)lp); __builtin_nontemporal_store((f32x4){lf[4], lf[5], lf[6], lf[7]}, (f32x4*)(lp + 4));
                        uint4 w; w.x = pack2(o[0], o[1]); w.y = pack2(o[2], o[3]); w.z = pack2(o[4], o[5]); w.w = pack2(o[6], o[7]);
                        nt_store16(w, pbase + (size_t)(ai * 128 + m * 16) * 512 + bj * 128);
                    }
            }
        } else {
            const bool copy = is_ctx && (blk == 1 || blk == 2);
            const float qs_ = (blk == 0) ? QSCALE : 1.f;
            u16* cbase = (u16*)(ws + OFF_CTXKV) + (size_t)l * MCTX * 1024 + (size_t)row0 * 1024 + (blk - 1) * 512 + (col0 & 511);
            if (!copy) {
#pragma unroll
                for (int ai = 0; ai < 2; ++ai)
#pragma unroll
                    for (int m = 0; m < 4; ++m)
#pragma unroll
                        for (int bj = 0; bj < 2; ++bj) {
                            const f32x4 v0 = acc[ai][bj][m][0], v1 = acc[ai][bj][m][1];
                            uint4 w; w.x = pack2(v0[0] * qs_, v0[1] * qs_); w.y = pack2(v0[2] * qs_, v0[3] * qs_); w.z = pack2(v1[0] * qs_, v1[1] * qs_); w.w = pack2(v1[2] * qs_, v1[3] * qs_);
                            nt_store16(w, pbase + (size_t)(ai * 128 + m * 16) * 512 + bj * 128);
                        }
            } else {
#pragma unroll
                for (int ai = 0; ai < 2; ++ai)
#pragma unroll
                    for (int m = 0; m < 4; ++m)
#pragma unroll
                        for (int bj = 0; bj < 2; ++bj) {
                            const f32x4 v0 = acc[ai][bj][m][0], v1 = acc[ai][bj][m][1];
                            uint4 w; w.x = pack2(v0[0], v0[1]); w.y = pack2(v0[2], v0[3]); w.z = pack2(v1[0], v1[1]); w.w = pack2(v1[2], v1[3]);
                            nt_store16(w, pbase + (size_t)(ai * 128 + m * 16) * 512 + bj * 128);
                            *(uint4*)(cbase + (size_t)(ai * 128 + m * 16) * 1024 + bj * 128) = w;
                        }
            }
        }
    }
};
struct EpiMerge {
    static constexpr bool PERM = true, AFTER_DRAIN = false;
    unsigned char* ws;
    template <int MODE> __device__ __forceinline__ void run(const f32x4 (&acc)[2][2][4][2], const Unit& u, int wr, int wc, int fr, int fq) const {
        const u16* proj = (const u16*)(ws + OFF_PROJ); u16* mb = (u16*)(ws + OFF_MB);
        const int row0 = u.pm * 256 + wr * 64 + fr, col0 = u.pn * 256 + wc * 32 + 8 * fq, R = u.r;
        const int gcol0 = 7680 + R * 1024 + col0;
        const u16* gbase = proj + ((size_t)(gcol0 >> 9) * MLAT + row0) * 512 + (gcol0 & 511);
        u16* obase = mb + (size_t)row0 * 1024 + col0;
        uint4 g[2][4], old[2][4];
#define MG_LOAD(st, buf) do { _Pragma("unroll") for (int q = 0; q < 4; ++q) { const int ai_ = (st) >> 1, m_ = ((st) & 1) * 2 + (q >> 1), co_ = (q & 1) * 128; const size_t ro_ = (size_t)(ai_ * 128 + m_ * 16); \
            g[buf][q] = *(const uint4*)(gbase + ro_ * 512 + co_); if (MODE > 0) old[buf][q] = *(const uint4*)(obase + ro_ * 1024 + co_); } } while (0)
        MG_LOAD(0, 0);
#pragma unroll
        for (int st = 0; st < 4; ++st) {
            const int buf = st & 1;
            if (st + 1 < 4) MG_LOAD(st + 1, buf ^ 1);
            __builtin_amdgcn_sched_barrier(0);
#pragma unroll
            for (int q = 0; q < 4; ++q) { const int ai = st >> 1, m = (st & 1) * 2 + (q >> 1), bj = q & 1, co = bj * 128; const size_t ro = (size_t)(ai * 128 + m * 16);
                const f32x4 v0 = acc[ai][bj][m][0], v1 = acc[ai][bj][m][1];
                float gf[8]; unpack8(g[buf][q], gf);
                float o[8] = {v0[0] * sigmoidf_(gf[0]), v0[1] * sigmoidf_(gf[1]), v0[2] * sigmoidf_(gf[2]), v0[3] * sigmoidf_(gf[3]), v1[0] * sigmoidf_(gf[4]), v1[1] * sigmoidf_(gf[5]), v1[2] * sigmoidf_(gf[6]), v1[3] * sigmoidf_(gf[7])};
                if (MODE > 0) { float of[8]; unpack8(old[buf][q], of);
#pragma unroll
                    for (int e = 0; e < 8; ++e) o[e] += of[e]; }
                uint4 w; w.x = pack2(o[0], o[1]); w.y = pack2(o[2], o[3]); w.z = pack2(o[4], o[5]); w.w = pack2(o[6], o[7]);
                *(uint4*)(obase + ro * 1024 + co) = w; }
        }
#undef MG_LOAD
    }
    __device__ __forceinline__ void operator()(const f32x4 (&acc)[2][2][4][2], const Unit& u, int wr, int wc, int fr, int fq) const {
        if (u.r == 0) run<0>(acc, u, wr, wc, fr, fq);
        else run<1>(acc, u, wr, wc, fr, fq);
    }
};
struct EpiOut {
    static constexpr bool PERM = true, AFTER_DRAIN = false;
    u16* C;
    __device__ __forceinline__ void operator()(const f32x4 (&acc)[2][2][4][2], const Unit& u, int wr, int wc, int fr, int fq) const {
        const int row0 = u.pm * 256 + wr * 64 + fr, col0 = u.pn * 256 + wc * 32 + 8 * fq;
#pragma unroll
        for (int ai = 0; ai < 2; ++ai)
#pragma unroll
            for (int m = 0; m < 4; ++m) { u16* rowp = C + (size_t)(row0 + ai * 128 + m * 16) * 1024 + col0;
#pragma unroll
                for (int bj = 0; bj < 2; ++bj) { const f32x4 v0 = acc[ai][bj][m][0], v1 = acc[ai][bj][m][1];
                    uint4 w; w.x = pack2(v0[0], v0[1]); w.y = pack2(v0[2], v0[3]); w.z = pack2(v1[0], v1[1]); w.w = pack2(v1[2], v1[3]); *(uint4*)(rowp + bj * 128) = w; } }
    }
};

__device__ void transpose_tile(const float* src, int lds_, u16* dst, int ldd, int k0, int n0s, int n0d, u16* t) {
    const int tid = tidx();
#pragma unroll
    for (int it = 0; it < 2; ++it) {
        const int kk = (tid >> 4) + it * 32, nn = (tid & 15) * 4;
        const float4 v = *(const float4*)(src + (size_t)(k0 + kk) * lds_ + n0s + nn);
        t[(nn + 0) * 72 + kk] = f2bf(v.x); t[(nn + 1) * 72 + kk] = f2bf(v.y); t[(nn + 2) * 72 + kk] = f2bf(v.z); t[(nn + 3) * 72 + kk] = f2bf(v.w);
    }
    __syncthreads();
    { const int n = tid >> 3, k8 = (tid & 7) * 8;
      const uint4 v = *(const uint4*)(t + n * 72 + k8);
      *(uint4*)(dst + (size_t)(n0d + n) * ldd + k0 + k8) = v; }
    __syncthreads();
}

__device__ void prep1(const Params& p, unsigned char* lds) {
    unsigned char* ws = opaque(p.ws);
    const int tid = tidx();
    const size_t gt = (size_t)blockIdx.x * 512 + tid, gn = (size_t)gridDim.x * 512;
    { u16* ws16 = (u16*)(ws + OFF_WS16);
      for (size_t i = gt; i < (size_t)DEPTH * 8 * 128 * 128; i += gn) ws16[i] = f2bf(p.gmlp_ws[i]);
      float* lbp = (float*)(ws + OFF_LB);
      for (size_t i = gt; i < 1024; i += gn) {
          float e[DEPTH], mx = -1e30f, sum = 0.f;
#pragma unroll
          for (int l = 0; l < DEPTH; ++l) { e[l] = p.lb_logits[l * 1024 + i]; mx = fmaxf(mx, e[l]); }
#pragma unroll
          for (int l = 0; l < DEPTH; ++l) { e[l] = expf(e[l] - mx); sum += e[l]; }
          float run = 0.f;
#pragma unroll
          for (int l = 0; l < DEPTH; ++l) { if (l > 0) run += e[l] / sum; lbp[l * 1024 + i] = fmaxf(run, 0.f); }
      }
      float* rope = (float*)(ws + OFF_ROPE);
      for (size_t i = gt; i < 1024; i += gn) { const int pos = (int)(i >> 4), f = (int)(i & 15);
          const float inv = powf(10000.f, -(float)f * 2.0f / 32.0f), ang = (float)pos * inv;
          rope[i] = cosf(ang); rope[1024 + i] = sinf(ang); }
      float* tw = (float*)(ws + OFF_TW);
      for (size_t i = gt; i < 4096; i += gn) { float s, c; sincospif((float)i * (2.0f / 4096.0f), &s, &c); tw[2 * i] = c; tw[2 * i + 1] = s; }
      u16* m1 = (u16*)(ws + OFF_M1);
      for (size_t i = gt; i < 128 * 128; i += gn) { const int ii = (int)(i >> 7), kk = (int)(i & 127), k1 = ii >> 1, po = ii & 1, n1 = kk >> 1, pi = kk & 1;
          float s, c; sincospif((float)((k1 * n1) & 63) * (2.0f / 64.0f), &s, &c);
          const float v = (po == 0) ? (pi == 0 ? c : -s) : (pi == 0 ? -s : -c);
          m1[i] = f2bf(v); }
      u16* m2 = (u16*)(ws + OFF_M2);
      for (size_t i = gt; i < 64 * 128; i += gn) { const int k2 = (int)(i >> 7), kk = (int)(i & 127), n2 = kk >> 1, pi = kk & 1;
          float s, c; sincospif((float)((k2 * n2) & 63) * (2.0f / 64.0f), &s, &c);
          m2[i] = f2bf(pi == 0 ? c : s); }
      u16* m3 = (u16*)(ws + OFF_M3);
      for (size_t i = gt; i < 256 * 512; i += gn) { const int k = (int)(i >> 9), kk = (int)(i & 511), n = kk >> 1, pi = kk & 1;
          float s, c; sincospif((float)((k * n) & 255) * (2.0f / 256.0f), &s, &c);
          m3[i] = f2bf(pi == 0 ? c : -s); }
    }
    constexpr int N_WIN = DEPTH * 176 * 16, N_WBR = 16 * 16 * 8, N_WOUT = DEPTH * 16 * 16, N_MOD = DEPTH * 48, N_CSW = DEPTH * 4 * 2 * 2;
    constexpr int TOT = N_WIN + N_WBR + N_WOUT + N_MOD + N_CSW;
    for (int it = blockIdx.x; it < TOT; it += gridDim.x) {
        int idx = it;
        if (idx < N_WIN) {
            const int l = idx / 2816, rem = idx % 2816, cb = rem >> 4, kb = rem & 15, n0 = cb * 64;
            if (n0 >= 2048 && n0 < 2560) continue;
            const int n0d = n0 < 2048 ? n0 : n0 + 512;
            transpose_tile(p.w_in + (size_t)l * DM * NIN, NIN, (u16*)(ws + OFF_WTIN) + (size_t)l * NPROJ * DM, DM, kb * 64, n0, n0d, (u16*)lds);
            continue;
        }
        idx -= N_WIN;
        if (idx < N_WBR) {
            const int mat = idx >> 7, rem = idx & 127, cb = rem >> 3, kb = rem & 7;
            transpose_tile(p.w_branch + (size_t)mat * 512 * 1024, 1024, (u16*)(ws + OFF_WTBR) + (size_t)mat * 1024 * 512, 512, kb * 64, cb * 64, cb * 64, (u16*)lds);
            continue;
        }
        idx -= N_WBR;
        if (idx < N_WOUT) {
            const int l = idx >> 8, rem = idx & 255, cb = rem >> 4, kb = rem & 15;
            transpose_tile(p.w_out + (size_t)l * 1024 * 1024, 1024, (u16*)(ws + OFF_WTOUT) + (size_t)l * 1024 * 1024, 1024, kb * 64, cb * 64, cb * 64, (u16*)lds);
            continue;
        }
        idx -= N_WOUT;
        if (idx < N_MOD) {
            const int l = idx / 48, cb = idx % 48;
            float* s = (float*)lds; float* red = s + 17 * 1024;
            for (int i = tid; i < 17 * 1024; i += 512) { const int j = i >> 10, k = i & 1023; const float v = j < 16 ? p.c[j * 1024 + k] : p.c_ctx[k]; s[i] = v / (1.f + expf(-v)); }
            __syncthreads();
            const int col = tid & 63, ks = tid >> 6;
            float acc[17];
#pragma unroll
            for (int j = 0; j < 17; ++j) acc[j] = 0.f;
            for (int k = ks * 128; k < ks * 128 + 128; ++k) {
                const float w = p.w_ada[((size_t)l * 1024 + k) * 3072 + cb * 64 + col];
#pragma unroll
                for (int j = 0; j < 17; ++j) acc[j] += s[j * 1024 + k] * w;
            }
#pragma unroll
            for (int j = 0; j < 17; ++j) red[(ks * 17 + j) * 64 + col] = acc[j];
            __syncthreads();
            for (int o = tid; o < 17 * 64; o += 512) { const int j = o >> 6, cc = o & 63; float sum = 0.f;
                for (int q = 0; q < 8; ++q) sum += red[(q * 17 + j) * 64 + cc];
                ((float*)(ws + OFF_MOD))[((size_t)l * 17 + j) * 3072 + cb * 64 + cc] = sum + p.b_ada[l * 3072 + cb * 64 + cc]; }
            __syncthreads();
            continue;
        }
        idx -= N_MOD;
        {
            const int cblk = idx & 1, part = (idx >> 1) & 1, g = (idx >> 2) & 3, l = idx >> 4;
            float* tb = (float*)lds;
            if (tid < 128) { float s, c; sincospif((float)tid * (2.0f / 128.0f), &s, &c); tb[tid] = part ? s : c; }
            __syncthreads();
            const int d = tid & 127, cq = tid >> 7;
            float acc[16];
#pragma unroll
            for (int i = 0; i < 16; ++i) acc[i] = 0.f;
            const float* wf = p.fnet_w + ((size_t)(l * 4 + g) * 128) * 128;
            for (int c2 = 0; c2 < 128; ++c2) {
                const float w = wf[c2 * 128 + d];
#pragma unroll
                for (int i = 0; i < 16; ++i) { const int c = cblk * 64 + cq * 16 + i; acc[i] += tb[(c * c2) & 127] * w; }
            }
            float* dst = (float*)(ws + OFF_CSW) + ((size_t)((l * 4 + g) * 2 + part) * 128) * 128;
#pragma unroll
            for (int i = 0; i < 16; ++i) dst[(cblk * 64 + cq * 16 + i) * 128 + d] = acc[i];
            __syncthreads();
        }
    }
}

__device__ void prep2(const Params& p, unsigned char* lds) {
    unsigned char* ws = opaque(p.ws);
    const int tid = tidx();
    float* wb = (float*)lds;
    float* cw = wb + 64 * 129;
    for (int it = blockIdx.x; it < DEPTH * 4 * 2 * 16; it += gridDim.x) {
        const int kb = it & 15, part = (it >> 4) & 1, g = (it >> 5) & 3, l = it >> 7;
        for (int i = tid; i < 64 * 128; i += 512) { const int kk = i >> 7, c = i & 127; wb[kk * 129 + c] = p.w_in[((size_t)l * 1024 + kb * 64 + kk) * NIN + 2048 + g * 128 + c]; }
        const float* src = (const float*)(ws + OFF_CSW) + ((size_t)((l * 4 + g) * 2 + part) * 128) * 128;
        for (int i = tid; i < 128 * 128; i += 512) cw[i] = src[i];
        __syncthreads();
        const int d = tid & 127, kq = tid >> 7;
        float acc[16];
#pragma unroll
        for (int i = 0; i < 16; ++i) acc[i] = 0.f;
        for (int c = 0; c < 128; ++c) {
            const float w = cw[c * 128 + d];
#pragma unroll
            for (int i = 0; i < 16; ++i) acc[i] += wb[(kq * 16 + i) * 129 + c] * w;
        }
        u16* dst = (u16*)(ws + OFF_WTIN) + ((size_t)l * NPROJ + (4 + part) * 512 + g * 128 + d) * DM + kb * 64 + kq * 16;
        uint4 w0, w1;
        w0.x = pack2(acc[0], acc[1]); w0.y = pack2(acc[2], acc[3]); w0.z = pack2(acc[4], acc[5]); w0.w = pack2(acc[6], acc[7]);
        w1.x = pack2(acc[8], acc[9]); w1.y = pack2(acc[10], acc[11]); w1.z = pack2(acc[12], acc[13]); w1.w = pack2(acc[14], acc[15]);
        *(uint4*)dst = w0; *(uint4*)(dst + 8) = w1;
        __syncthreads();
    }
}

__device__ void phase_norm(const Params& p, const PassInfo ps, int l) {
    unsigned char* ws = opaque(p.ws);
    const int wave = tidx() >> 6, lane = tidx() & 63;
    const float* mod = (const float*)(ws + OFF_MOD);
    const u16* OUT = (const u16*)(ws + OFF_OUT);
    u16* H = (u16*)(ws + OFF_H);
    for (int rr = blockIdx.x * 8 + wave; rr < ps.M; rr += gridDim.x * 8) {
        const int tsh = ps.is_ctx ? 8 : 12; const int b = ps.b0 + (rr >> tsh), t = rr & (ps.T - 1), mrow = ps.is_ctx ? 16 : b;
        const size_t xoff = ((size_t)b * ps.T + t) * 1024;
        const float* xin = (l <= 1) ? ((ps.is_ctx ? p.ctx : p.x) + xoff) : ((ps.is_ctx ? (const float*)(ws + OFF_CTXW) : (const float*)p.out) + xoff);
        float* xout = (ps.is_ctx ? (float*)(ws + OFF_CTXW) : p.out) + xoff;
        float xv[16];
#pragma unroll
        for (int hlf = 0; hlf < 2; ++hlf) {
            const int c0 = hlf * 512 + lane * 8;
            const float4 a = *(const float4*)(xin + c0), bq = *(const float4*)(xin + c0 + 4);
            xv[hlf * 8 + 0] = a.x; xv[hlf * 8 + 1] = a.y; xv[hlf * 8 + 2] = a.z; xv[hlf * 8 + 3] = a.w;
            xv[hlf * 8 + 4] = bq.x; xv[hlf * 8 + 5] = bq.y; xv[hlf * 8 + 6] = bq.z; xv[hlf * 8 + 7] = bq.w;
        }
        if (l > 0) {
            float ov[16]; float ss = 0.f;
#pragma unroll
            for (int hlf = 0; hlf < 2; ++hlf) {
                const int c0 = hlf * 512 + lane * 8;
                unpack8(*(const uint4*)(OUT + (size_t)rr * 1024 + c0), ov + hlf * 8);
            }
#pragma unroll
            for (int e = 0; e < 16; ++e) ss += ov[e] * ov[e];
#pragma unroll
            for (int o = 32; o > 0; o >>= 1) ss += shx(ss, o);
            const float rstd = rsqrtf(ss * (1.f / 1024.f) + EPSN);
            const float* gt = mod + ((size_t)(l - 1) * 17 + mrow) * 3072 + 2048;
            const float* gp = p.g_post + (l - 1) * 1024;
#pragma unroll
            for (int hlf = 0; hlf < 2; ++hlf) {
                const int c0 = hlf * 512 + lane * 8;
#pragma unroll
                for (int e = 0; e < 8; ++e) xv[hlf * 8 + e] += gt[c0 + e] * (ov[hlf * 8 + e] * rstd * gp[c0 + e]);
                *(float4*)(xout + c0) = make_float4(xv[hlf * 8 + 0], xv[hlf * 8 + 1], xv[hlf * 8 + 2], xv[hlf * 8 + 3]);
                *(float4*)(xout + c0 + 4) = make_float4(xv[hlf * 8 + 4], xv[hlf * 8 + 5], xv[hlf * 8 + 6], xv[hlf * 8 + 7]);
            }
        }
        if (l < DEPTH) {
            float ss = 0.f;
#pragma unroll
            for (int e = 0; e < 16; ++e) ss += xv[e] * xv[e];
#pragma unroll
            for (int o = 32; o > 0; o >>= 1) ss += shx(ss, o);
            const float rstd = rsqrtf(ss * (1.f / 1024.f) + EPSN);
            const float* sh = mod + ((size_t)l * 17 + mrow) * 3072; const float* sc = sh + 1024;
            const float* gp = p.g_pre + l * 1024;
#pragma unroll
            for (int hlf = 0; hlf < 2; ++hlf) {
                const int c0 = hlf * 512 + lane * 8;
                float hv[8];
#pragma unroll
                for (int e = 0; e < 8; ++e) hv[e] = xv[hlf * 8 + e] * rstd * gp[c0 + e] * (1.f + sc[c0 + e]) + sh[c0 + e];
                uint4 w; w.x = pack2(hv[0], hv[1]); w.y = pack2(hv[2], hv[3]); w.z = pack2(hv[4], hv[5]); w.w = pack2(hv[6], hv[7]);
                *(uint4*)(H + (size_t)rr * 1024 + c0) = w;
            }
        }
    }
}

#define PJ(row, blk, c) (PROJ + ((size_t)(blk) * MLAT + (row)) * 512 + (c))
typedef unsigned u32x32_ __attribute__((ext_vector_type(32)));
struct Reg8 {
    u32x32_ v;
    __device__ __forceinline__ void ld(int i, const void* p) { const u32x4_ a = *(const u32x4_*)p; v[4 * i] = a[0]; v[4 * i + 1] = a[1]; v[4 * i + 2] = a[2]; v[4 * i + 3] = a[3]; }
    __device__ __forceinline__ u32x4_ get(int i) const { return (u32x4_){v[4 * i], v[4 * i + 1], v[4 * i + 2], v[4 * i + 3]}; }
    __device__ __forceinline__ uint4 getu(int i) const { uint4 r; r.x = v[4 * i]; r.y = v[4 * i + 1]; r.z = v[4 * i + 2]; r.w = v[4 * i + 3]; return r; }
};
#define MEMBAR() asm volatile("" ::: "memory")
constexpr int KVS = 72;
constexpr int TS = 528;
constexpr int T3S = 136;
constexpr int HS_ = 68;
constexpr float NORM_LAT = 0.0013810679320049757f;
constexpr float NORM_CTX = 0.005524271728019903f;

__device__ void attn_item(const Params& p, const PassInfo ps, int l, int item, unsigned char* lds) {
    unsigned char* ws = opaque(p.ws);
    const u16* PROJ = (const u16*)(ws + OFF_PROJ); const u16* QROT = (const u16*)(ws + OFF_QROT);
    const u16* CKV = (const u16*)(ws + OFF_CTXKV) + (size_t)l * MCTX * 1024;
    u16* Y0 = (u16*)(ws + OFF_Y);
    const int tid = tidx(), w = tid >> 6, lane = tid & 63, qtr = w & 3, kh = w >> 2, li = lane & 15, quad = lane >> 4;
    u16* Kl = (u16*)lds; u16* Vl = Kl + 512 * KVS; float* rp = (float*)(Vl + 512 * KVS);
    int bl, h, r = 0, qrow0, bglob;
    if (!ps.is_ctx) { r = item & 63; h = (item >> 6) & 7; bl = item >> 9; qrow0 = bl * 4096 + r * 64; bglob = ps.b0 + bl; }
    else { const int qb = item & 3; h = (item >> 2) & 7; bl = item >> 5; qrow0 = bl * 256 + qb * 64; bglob = bl; }
    const int qrow = qrow0 + qtr * 16 + li;
    float m_run = -1e30f, l_run = 0.f;
    const bf16x8 qp0 = ld_frag_g(PJ(qrow, 0, h * 64 + quad * 8)), qp1 = ld_frag_g(PJ(qrow, 0, h * 64 + 32 + quad * 8));
    uint2 gate4[4];
#pragma unroll
    for (int d = 0; d < 4; ++d) gate4[d] = *(const uint2*)(PJ(qrow, 3, h * 64 + d * 16 + quad * 4));
    Reg8 crg;
    { const size_t crow0 = (size_t)bglob * 256;
#pragma unroll
      for (int i = 0; i < 4; ++i) { const int idx = tid + 512 * i, key = idx >> 3, ch = idx & 7;
          crg.ld(2 * i, CKV + (crow0 + key) * 1024 + h * 64 + ch * 8); crg.ld(2 * i + 1, CKV + (crow0 + key) * 1024 + 512 + h * 64 + ch * 8); } }
    f32x4 O[4];
#pragma unroll
    for (int d = 0; d < 4; ++d) O[d] = (f32x4){0.f, 0.f, 0.f, 0.f};
    if (!ps.is_ctx) {
        const int rs = min(max(r - 4, 0), 56);
        const size_t krow0 = (size_t)bl * 4096 + rs * 64;
        const bf16x8 q0 = ld_frag_g(QROT + (size_t)qrow * 512 + h * 64 + quad * 8), q1 = ld_frag_g(QROT + (size_t)qrow * 512 + h * 64 + 32 + quad * 8);
        { u32x32_ kr, vr;
#pragma unroll
          for (int i = 0; i < 8; ++i) { const int idx = tid + 512 * i, key = idx >> 3, ch = idx & 7;
              const u32x4_ a = *(const u32x4_*)(PJ(krow0 + key, 1, h * 64 + ch * 8)), b = *(const u32x4_*)(PJ(krow0 + key, 2, h * 64 + ch * 8));
              kr[4 * i] = a[0]; kr[4 * i + 1] = a[1]; kr[4 * i + 2] = a[2]; kr[4 * i + 3] = a[3]; vr[4 * i] = b[0]; vr[4 * i + 1] = b[1]; vr[4 * i + 2] = b[2]; vr[4 * i + 3] = b[3]; }
          asm volatile("" ::: "memory");
#pragma unroll
          for (int i = 0; i < 8; ++i) { const int idx = tid + 512 * i, key = idx >> 3, ch = idx & 7;
              *(u32x4_*)(Kl + key * KVS + ch * 8) = (u32x4_){kr[4 * i], kr[4 * i + 1], kr[4 * i + 2], kr[4 * i + 3]}; *(u32x4_*)(Vl + key * KVS + ch * 8) = (u32x4_){vr[4 * i], vr[4 * i + 1], vr[4 * i + 2], vr[4 * i + 3]}; } }
        for (int i = tid; i < 465; i += 512) rp[i] = p.rpb[((size_t)l * 8 + h) * 465 + i] * LOG2E;
        __syncthreads();
        const int cbase = (qtr == 0) ? 0 : (qtr == 1 ? 8 : (qtr == 2 ? 24 : 32));
        const int qc = qtr * 16 + li, cst = min(max(qc - 8, 0), 48);
        const int bnd = cst - cbase;
        float s[4][4];
        bool u0[4]; int bofs[4];
#pragma unroll
        for (int j = 0; j < 4; ++j) { const int c = quad * 4 + j; u0[j] = c >= bnd; const int kc = cbase + (u0[j] ? c : c + 16); bofs[j] = kc - qc + 15; }
        float mx = -1e30f;
#pragma unroll
        for (int i4 = 0; i4 < 4; ++i4) {
            const int i = kh * 4 + i4;
            const u16* kp = Kl + (i * 64 + cbase + li) * KVS + quad * 8;
            f32x4 a0 = (f32x4){0.f, 0.f, 0.f, 0.f}, a1 = (f32x4){0.f, 0.f, 0.f, 0.f};
            a0 = MFMA16(*(const bf16x8*)kp, q0, a0); a0 = MFMA16(*(const bf16x8*)(kp + 32), q1, a0);
            a1 = MFMA16(*(const bf16x8*)(kp + 16 * KVS), q0, a1); a1 = MFMA16(*(const bf16x8*)(kp + 16 * KVS + 32), q1, a1);
            const int ridx = rs + i - r + 7;
#pragma unroll
            for (int j = 0; j < 4; ++j) { const float v = (u0[j] ? a0[j] : a1[j]) + rp[ridx * 31 + bofs[j]]; s[i4][j] = v; mx = fmaxf(mx, v); }
        }
        mx = fmaxf(mx, shx(mx, 16)); mx = fmaxf(mx, shx(mx, 32));
        m_run = mx;
        float ls = 0.f;
#pragma unroll
        for (int i4 = 0; i4 < 4; ++i4)
#pragma unroll
            for (int j = 0; j < 4; ++j) { const float e = __builtin_amdgcn_exp2f(s[i4][j] - mx); s[i4][j] = e; ls += e; }
        ls += shx(ls, 16); ls += shx(ls, 32);
        l_run = ls;
#pragma unroll
        for (int kp2 = 0; kp2 < 4; ++kp2) {
            bf16x8 pf; { const unsigned a0 = pack2(u0[0] ? s[kp2][0] : 0.f, u0[1] ? s[kp2][1] : 0.f), a1 = pack2(u0[2] ? s[kp2][2] : 0.f, u0[3] ? s[kp2][3] : 0.f),
                                    b0 = pack2(u0[0] ? 0.f : s[kp2][0], u0[1] ? 0.f : s[kp2][1]), b1 = pack2(u0[2] ? 0.f : s[kp2][2], u0[3] ? 0.f : s[kp2][3]);
                pf = (bf16x8){(short)(a0 & 0xffff), (short)(a0 >> 16), (short)(a1 & 0xffff), (short)(a1 >> 16), (short)(b0 & 0xffff), (short)(b0 >> 16), (short)(b1 & 0xffff), (short)(b1 >> 16)}; }
            const int vrow0 = (kh * 4 + kp2) * 64 + cbase + quad * 4 + (li >> 2);
#pragma unroll
            for (int d = 0; d < 4; ++d) {
                const u16* vp = Vl + vrow0 * KVS + d * 16 + 4 * (li & 3);
                const bf16x8 vf = tr_read2(vp, vp + 16 * KVS);
                O[d] = MFMA16(vf, pf, O[d]);
            }
        }
        __syncthreads();
    }
    {
#pragma unroll
        for (int i = 0; i < 4; ++i) { const int idx = tid + 512 * i, key = idx >> 3, ch = idx & 7;
            *(u32x4_*)(Kl + key * KVS + ch * 8) = crg.get(2 * i); *(u32x4_*)(Vl + key * KVS + ch * 8) = crg.get(2 * i + 1); }
        __syncthreads();
        const bf16x8 q0 = qp0, q1 = qp1;
        float s[8][4];
        float mx = -1e30f;
#pragma unroll
        for (int sb = 0; sb < 8; ++sb) {
            const u16* kp = Kl + (kh * 128 + sb * 16 + li) * KVS + quad * 8;
            f32x4 a = (f32x4){0.f, 0.f, 0.f, 0.f};
            a = MFMA16(*(const bf16x8*)kp, q0, a); a = MFMA16(*(const bf16x8*)(kp + 32), q1, a);
#pragma unroll
            for (int j = 0; j < 4; ++j) { const float v = a[j]; s[sb][j] = v; mx = fmaxf(mx, v); }
        }
        mx = fmaxf(mx, shx(mx, 16)); mx = fmaxf(mx, shx(mx, 32));
        const float m_new = fmaxf(m_run, mx), resc = __builtin_amdgcn_exp2f(m_run - m_new);
        float ls = 0.f;
#pragma unroll
        for (int sb = 0; sb < 8; ++sb)
#pragma unroll
            for (int j = 0; j < 4; ++j) { const float e = __builtin_amdgcn_exp2f(s[sb][j] - m_new); s[sb][j] = e; ls += e; }
        ls += shx(ls, 16); ls += shx(ls, 32);
        l_run = l_run * resc + ls; m_run = m_new;
#pragma unroll
        for (int d = 0; d < 4; ++d) O[d] *= resc;
#pragma unroll
        for (int kp2 = 0; kp2 < 4; ++kp2) {
            bf16x8 pf; { const unsigned a0 = pack2(s[2 * kp2][0], s[2 * kp2][1]), a1 = pack2(s[2 * kp2][2], s[2 * kp2][3]), b0 = pack2(s[2 * kp2 + 1][0], s[2 * kp2 + 1][1]), b1 = pack2(s[2 * kp2 + 1][2], s[2 * kp2 + 1][3]);
                pf = (bf16x8){(short)(a0 & 0xffff), (short)(a0 >> 16), (short)(a1 & 0xffff), (short)(a1 >> 16), (short)(b0 & 0xffff), (short)(b0 >> 16), (short)(b1 & 0xffff), (short)(b1 >> 16)}; }
            const int vrow0 = kh * 128 + kp2 * 32 + quad * 4 + (li >> 2);
#pragma unroll
            for (int d = 0; d < 4; ++d) {
                const u16* vp = Vl + vrow0 * KVS + d * 16 + 4 * (li & 3);
                const bf16x8 vf = tr_read2(vp, vp + 16 * KVS);
                O[d] = MFMA16(vf, pf, O[d]);
            }
        }
        __syncthreads();
    }
    float* cb = (float*)lds;
    if (kh == 1) {
#pragma unroll
        for (int d = 0; d < 4; ++d)
#pragma unroll
            for (int j = 0; j < 4; ++j) cb[(qtr * 18 + d * 4 + j) * 64 + lane] = O[d][j];
        cb[(qtr * 18 + 16) * 64 + lane] = m_run; cb[(qtr * 18 + 17) * 64 + lane] = l_run;
    }
    __syncthreads();
    if (kh == 0) {
        const float m2 = cb[(qtr * 18 + 16) * 64 + lane], l2 = cb[(qtr * 18 + 17) * 64 + lane];
        const float mm = fmaxf(m_run, m2), e1 = __builtin_amdgcn_exp2f(m_run - mm), e2 = __builtin_amdgcn_exp2f(m2 - mm);
        const float inv = 1.f / (l_run * e1 + l2 * e2);
#pragma unroll
        for (int d = 0; d < 4; ++d) {
            const int col = h * 64 + d * 16 + quad * 4;
            const uint2 g = gate4[d];
            float o[4];
#pragma unroll
            for (int j = 0; j < 4; ++j) o[j] = (O[d][j] * e1 + cb[(qtr * 18 + d * 4 + j) * 64 + lane] * e2) * inv;
            uint2 wv; wv.x = pack2(o[0] * siluf_(bflo(g.x)), o[1] * siluf_(bfhi(g.x))); wv.y = pack2(o[2] * siluf_(bflo(g.y)), o[3] * siluf_(bfhi(g.y)));
            *(uint2*)(Y0 + (size_t)qrow * 512 + col) = wv;
        }
    }
    __syncthreads();
}

template <int ROWS, int CPR> __device__ __forceinline__ void load_tile(u16* dstl, int lstride, const u16* src, size_t sstride) {
    constexpr int PER = ROWS * CPR / 512;
    static_assert(PER % 8 == 0, "tile size");
    const int tid_ = tidx();
#pragma unroll
    for (int b8 = 0; b8 < PER / 8; ++b8) { Reg8 rg;
#pragma unroll
        for (int j = 0; j < 8; ++j) { const int i = tid_ + 512 * (b8 * 8 + j), r = i / CPR, ch = i % CPR; rg.ld(j, src + (size_t)r * sstride + ch * 8); }
        MEMBAR();
#pragma unroll
        for (int j = 0; j < 8; ++j) { const int i = tid_ + 512 * (b8 * 8 + j), r = i / CPR, ch = i % CPR; *(u32x4_*)(dstl + r * lstride + ch * 8) = rg.get(j); }
        MEMBAR(); }
}

__device__ void four1_item(const Params& p, int item, unsigned char* lds) {
    unsigned char* ws = opaque(p.ws);
    const u16* PROJ = (const u16*)(ws + OFF_PROJ); const u16* M1 = (const u16*)(ws + OFF_M1); const float* TW = (const float*)(ws + OFF_TW);
    u16* FY = (u16*)(ws + OFF_FY);
    const int tid = tidx(), w = tid >> 6, lane = tid & 63, li = lane & 15, quad = lane >> 4;
    const int n2 = item & 63, bl = item >> 6;
    u16* T = (u16*)lds;
#pragma unroll
    for (int b8 = 0; b8 < 2; ++b8) { Reg8 rg;
#pragma unroll
        for (int j = 0; j < 8; ++j) { const int i = tid + 512 * (b8 * 8 + j), kk = i >> 6, ch = i & 63, n1 = kk >> 1, part = kk & 1;
            rg.ld(j, PJ((size_t)bl * 4096 + n1 * 64 + n2, 4 + part, ch * 8)); }
        MEMBAR();
#pragma unroll
        for (int j = 0; j < 8; ++j) { const int i = tid + 512 * (b8 * 8 + j), kk = i >> 6, ch = i & 63;
            *(u32x4_*)(T + kk * TS + ch * 8) = rg.get(j); }
        MEMBAR(); }
    float* twl = (float*)(T + 128 * TS);
    if (tid < 64) { const float2 tv = *(const float2*)(TW + 2 * (n2 * tid)); twl[2 * tid] = tv.x; twl[2 * tid + 1] = tv.y; }
    bf16x8 xf[4];
#pragma unroll
    for (int ks = 0; ks < 4; ++ks) xf[ks] = ld_frag_g(M1 + li * 128 + ks * 32 + quad * 8);
    __syncthreads();
    for (int isub = 0; isub < 8; ++isub) {
        bf16x8 xn[4];
        const int isn = isub < 7 ? isub + 1 : 7;
#pragma unroll
        for (int ks = 0; ks < 4; ++ks) xn[ks] = ld_frag_g(M1 + (isn * 16 + li) * 128 + ks * 32 + quad * 8);
        float tcs[2], tsn_[2];
#pragma unroll
        for (int hh = 0; hh < 2; ++hh) { const int k1 = isub * 8 + quad * 2 + hh; tcs[hh] = twl[2 * k1]; tsn_[hh] = twl[2 * k1 + 1]; }
#pragma unroll
        for (int cs = 0; cs < 4; ++cs) {
            const int c0 = w * 64 + cs * 16;
            f32x4 a = (f32x4){0.f, 0.f, 0.f, 0.f};
#pragma unroll
            for (int ks = 0; ks < 4; ++ks) {
                const u16* tp = T + (ks * 32 + quad * 8 + (li >> 2)) * TS + c0 + 4 * (li & 3);
                a = MFMA16(xf[ks], tr_read2(tp, tp + 4 * TS), a);
            }
            const int ch = c0 + li;
#pragma unroll
            for (int hh = 0; hh < 2; ++hh) {
                const int k1 = isub * 8 + quad * 2 + hh;
                const float yr = a[2 * hh], yi = a[2 * hh + 1];
                const float orr = yr * tcs[hh] + yi * tsn_[hh], oi = yi * tcs[hh] - yr * tsn_[hh];
                u16* dst = FY + (((size_t)bl * 64 + k1) * 64 + n2) * 1024 + ch;
                dst[0] = f2bf(orr); dst[512] = f2bf(oi);
            }
        }
#pragma unroll
        for (int ks = 0; ks < 4; ++ks) xf[ks] = xn[ks];
    }
    __syncthreads();
}

__device__ void four2_item(const Params& p, int item, unsigned char* lds) {
    unsigned char* ws = opaque(p.ws);
    const u16* PROJ = (const u16*)(ws + OFF_PROJ); const u16* M2 = (const u16*)(ws + OFF_M2); const u16* FY = (const u16*)(ws + OFF_FY);
    u16* Y1 = (u16*)(ws + OFF_Y) + (size_t)1 * MLAT * 512;
    const int tid = tidx(), w = tid >> 6, lane = tid & 63, li = lane & 15, quad = lane >> 4;
    const int k1 = item & 63, bl = item >> 6;
    u16* T = (u16*)lds;
    load_tile<128, 64>(T, TS, FY + ((size_t)bl * 64 + k1) * 64 * 1024, 512);
    __syncthreads();
    bf16x8 xf[4][4];
#pragma unroll
    for (int cs = 0; cs < 4; ++cs)
#pragma unroll
        for (int ks = 0; ks < 4; ++ks) { const u16* tp = T + (ks * 32 + quad * 8 + (li >> 2)) * TS + w * 64 + cs * 16 + 4 * (li & 3); xf[cs][ks] = tr_read2(tp, tp + 4 * TS); }
    bf16x8 yf[4]; uint2 gt[4];
#define F2_LOAD(k2s_, yf_, gt_) do { _Pragma("unroll") for (int ks = 0; ks < 4; ++ks) yf_[ks] = ld_frag_g(M2 + ((k2s_) * 16 + li) * 128 + ks * 32 + quad * 8); \
        const size_t row_ = (size_t)bl * 4096 + k1 + 64 * ((k2s_) * 16 + li); _Pragma("unroll") for (int cs = 0; cs < 4; ++cs) gt_[cs] = *(const uint2*)(PJ(row_, 6, w * 64 + cs * 16 + quad * 4)); } while (0)
    F2_LOAD(0, yf, gt);
    for (int k2s = 0; k2s < 4; ++k2s) {
        bf16x8 yn[4]; uint2 gn[4];
        const int kn = k2s < 3 ? k2s + 1 : 3;
        F2_LOAD(kn, yn, gn);
        const int k2 = k2s * 16 + li;
        const size_t row = (size_t)bl * 4096 + k1 + 64 * k2;
#pragma unroll
        for (int cs = 0; cs < 4; ++cs) {
            f32x4 a = (f32x4){0.f, 0.f, 0.f, 0.f};
#pragma unroll
            for (int ks = 0; ks < 4; ++ks) a = MFMA16(xf[cs][ks], yf[ks], a);
            const int ch = w * 64 + cs * 16 + quad * 4;
            const uint2 g = gt[cs];
            uint2 wv; wv.x = pack2(a[0] * NORM_LAT * siluf_(bflo(g.x)), a[1] * NORM_LAT * siluf_(bfhi(g.x))); wv.y = pack2(a[2] * NORM_LAT * siluf_(bflo(g.y)), a[3] * NORM_LAT * siluf_(bfhi(g.y)));
            *(uint2*)(Y1 + row * 512 + ch) = wv;
        }
#pragma unroll
        for (int q = 0; q < 4; ++q) { yf[q] = yn[q]; gt[q] = gn[q]; }
    }
#undef F2_LOAD
    __syncthreads();
}

__device__ void fourc_item(const Params& p, int item, unsigned char* lds) {
    unsigned char* ws = opaque(p.ws);
    const u16* PROJ = (const u16*)(ws + OFF_PROJ); const u16* M3 = (const u16*)(ws + OFF_M3);
    u16* Y1 = (u16*)(ws + OFF_Y) + (size_t)1 * MLAT * 512;
    const int tid = tidx(), w = tid >> 6, lane = tid & 63, li = lane & 15, quad = lane >> 4;
    const int chb = item & 3, b = item >> 2;
    u16* T = (u16*)lds;
#pragma unroll
    for (int b8 = 0; b8 < 2; ++b8) { Reg8 rg;
#pragma unroll
        for (int j = 0; j < 8; ++j) { const int i = tid + 512 * (b8 * 8 + j), kk = i >> 4, ch = i & 15, n = kk >> 1, part = kk & 1;
            rg.ld(j, PJ((size_t)b * 256 + n, 4 + part, chb * 128 + ch * 8)); }
        MEMBAR();
#pragma unroll
        for (int j = 0; j < 8; ++j) { const int i = tid + 512 * (b8 * 8 + j), kk = i >> 4, ch = i & 15;
            *(u32x4_*)(T + kk * T3S + ch * 8) = rg.get(j); }
        MEMBAR(); }
    __syncthreads();
    for (int kq = 0; kq < 2; ++kq) {
        const int ksub = w * 2 + kq;
        f32x4 a[8];
#pragma unroll
        for (int cs = 0; cs < 8; ++cs) a[cs] = (f32x4){0.f, 0.f, 0.f, 0.f};
        for (int ks = 0; ks < 16; ++ks) {
            const bf16x8 yf = ld_frag_g(M3 + (ksub * 16 + li) * 512 + ks * 32 + quad * 8);
#pragma unroll
            for (int cs = 0; cs < 8; ++cs) { const u16* tp = T + (ks * 32 + quad * 8 + (li >> 2)) * T3S + cs * 16 + 4 * (li & 3);
                a[cs] = MFMA16(tr_read2(tp, tp + 4 * T3S), yf, a[cs]); }
        }
        const size_t row = (size_t)b * 256 + ksub * 16 + li;
#pragma unroll
        for (int cs = 0; cs < 8; ++cs) {
            const int ch = chb * 128 + cs * 16 + quad * 4;
            const uint2 g = *(const uint2*)(PJ(row, 6, ch));
            uint2 wv; wv.x = pack2(a[cs][0] * NORM_CTX * siluf_(bflo(g.x)), a[cs][1] * NORM_CTX * siluf_(bfhi(g.x))); wv.y = pack2(a[cs][2] * NORM_CTX * siluf_(bflo(g.y)), a[cs][3] * NORM_CTX * siluf_(bfhi(g.y)));
            *(uint2*)(Y1 + row * 512 + ch) = wv;
        }
    }
    __syncthreads();
}

__device__ void gmlp_item(const Params& p, int l, int item, unsigned char* lds) {
    unsigned char* ws = opaque(p.ws);
    const u16* PROJ = (const u16*)(ws + OFF_PROJ); const u16* WS16 = (const u16*)(ws + OFF_WS16) + (size_t)l * 8 * 128 * 128;
    u16* Y2 = (u16*)(ws + OFF_Y) + (size_t)2 * MLAT * 512;
    const int tid = tidx(), w = tid >> 6, lane = tid & 63, li = lane & 15, quad = lane >> 4;
    const size_t r0 = (size_t)item * 128;
    u16* VN = (u16*)lds;
    {
        const int row = tid >> 2, qd = tid & 3;
        const u16* src = PJ(r0 + row, 8, 0);
        uint4 raw[16]; float ss = 0.f;
#pragma unroll
        for (int i = 0; i < 16; ++i) { raw[i] = *(const uint4*)(src + (qd + 4 * i) * 8); float f[8]; unpack8(raw[i], f);
#pragma unroll
            for (int e = 0; e < 8; ++e) ss += f[e] * f[e]; }
        ss += shx(ss, 1); ss += shx(ss, 2);
        const float rstd = rsqrtf(ss * (1.f / 512.f) + EPSN);
        const float* gn = p.gmlp_g + l * 512;
#pragma unroll
        for (int i = 0; i < 16; ++i) { float f[8]; unpack8(raw[i], f); const int c0 = (qd + 4 * i) * 8;
            const float4 g0 = *(const float4*)(gn + c0), g1 = *(const float4*)(gn + c0 + 4);
            uint4 o; o.x = pack2(f[0] * rstd * g0.x, f[1] * rstd * g0.y); o.y = pack2(f[2] * rstd * g0.z, f[3] * rstd * g0.w);
            o.z = pack2(f[4] * rstd * g1.x, f[5] * rstd * g1.y); o.w = pack2(f[6] * rstd * g1.z, f[7] * rstd * g1.w);
            *(uint4*)(VN + row * TS + c0) = o; }
    }
    __syncthreads();
    const int g = w;
    bf16x8 xf[4][4];
#pragma unroll
    for (int cs = 0; cs < 4; ++cs)
#pragma unroll
        for (int ks = 0; ks < 4; ++ks) { const u16* tp = VN + (ks * 32 + quad * 8 + (li >> 2)) * TS + g * 64 + cs * 16 + 4 * (li & 3); xf[cs][ks] = tr_read2(tp, tp + 4 * TS); }
    bf16x8 yf[4]; uint2 uu[4], gg[4]; float bs;
#define GM_LOAD(ts_, yf_, uu_, gg_, bs_) do { const int t_ = (ts_) * 16 + li; _Pragma("unroll") for (int ks = 0; ks < 4; ++ks) yf_[ks] = ld_frag_g(WS16 + ((size_t)g * 128 + t_) * 128 + ks * 32 + quad * 8); \
        bs_ = p.gmlp_bs[((size_t)l * 8 + g) * 128 + t_]; _Pragma("unroll") for (int cs = 0; cs < 4; ++cs) { const int c_ = g * 64 + cs * 16 + quad * 4; uu_[cs] = *(const uint2*)(PJ(r0 + t_, 7, c_)); gg_[cs] = *(const uint2*)(PJ(r0 + t_, 9, c_)); } } while (0)
    GM_LOAD(0, yf, uu, gg, bs);
    for (int ts = 0; ts < 8; ++ts) {
        bf16x8 yn[4]; uint2 un[4], gn[4]; float bn;
        const int tn = ts < 7 ? ts + 1 : 7;
        GM_LOAD(tn, yn, un, gn, bn);
        const int t = ts * 16 + li;
        const size_t row = r0 + t;
#pragma unroll
        for (int cs = 0; cs < 4; ++cs) {
            f32x4 a = (f32x4){0.f, 0.f, 0.f, 0.f};
#pragma unroll
            for (int ks = 0; ks < 4; ++ks) a = MFMA16(xf[cs][ks], yf[ks], a);
            const int c = g * 64 + cs * 16 + quad * 4;
            uint2 wv; wv.x = pack2(bflo(uu[cs].x) * (a[0] + bs) * siluf_(bflo(gg[cs].x)), bfhi(uu[cs].x) * (a[1] + bs) * siluf_(bfhi(gg[cs].x)));
            wv.y = pack2(bflo(uu[cs].y) * (a[2] + bs) * siluf_(bflo(gg[cs].y)), bfhi(uu[cs].y) * (a[3] + bs) * siluf_(bfhi(gg[cs].y)));
            *(uint2*)(Y2 + row * 512 + c) = wv;
        }
#pragma unroll
        for (int q = 0; q < 4; ++q) { yf[q] = yn[q]; uu[q] = un[q]; gg[q] = gn[q]; }
        bs = bn;
    }
#undef GM_LOAD
    __syncthreads();
}

__device__ __forceinline__ void chunk_cumsum(float* A, float* tmp, int dir) {
    const int k = tidx() & 63, seg = tidx() >> 6;
    float v[8]; float run = 0.f;
    if (dir == 0) {
#pragma unroll
        for (int e = 0; e < 8; ++e) { run += A[(seg * 8 + e) * HS_ + k]; v[e] = run; }
    } else {
#pragma unroll
        for (int e = 7; e >= 0; --e) { run += A[(seg * 8 + e) * HS_ + k]; v[e] = run; }
    }
    tmp[seg * 64 + k] = run;
    __syncthreads();
    float off = 0.f;
#pragma unroll
    for (int s2 = 0; s2 < 8; ++s2) { const float tv = tmp[s2 * 64 + k]; if (dir == 0 ? (s2 < seg) : (s2 > seg)) off += tv; }
#pragma unroll
    for (int e = 0; e < 8; ++e) A[(seg * 8 + e) * HS_ + k] = (v[e] + off) * LOG2E;
    __syncthreads();
}
__device__ __forceinline__ void chunk_cumsum2(float* Af, float* Ab, float* tmp) {
    const int k = tidx() & 63, seg = tidx() >> 6;
    float vf[8], vb[8]; float rf = 0.f, rb = 0.f;
#pragma unroll
    for (int e = 0; e < 8; ++e) { rf += Af[(seg * 8 + e) * HS_ + k]; vf[e] = rf; }
#pragma unroll
    for (int e = 7; e >= 0; --e) { rb += Ab[(seg * 8 + e) * HS_ + k]; vb[e] = rb; }
    tmp[seg * 64 + k] = rf; tmp[512 + seg * 64 + k] = rb;
    __syncthreads();
    float of = 0.f, ob = 0.f;
#pragma unroll
    for (int s2 = 0; s2 < 8; ++s2) { const float tf = tmp[s2 * 64 + k], tb = tmp[512 + s2 * 64 + k]; if (s2 < seg) of += tf; if (s2 > seg) ob += tb; }
#pragma unroll
    for (int e = 0; e < 8; ++e) { Af[(seg * 8 + e) * HS_ + k] = (vf[e] + of) * LOG2E; Ab[(seg * 8 + e) * HS_ + k] = (vb[e] + ob) * LOG2E; }
    __syncthreads();
}
__device__ __forceinline__ void load_bf_tile64(float* dst, const u16* src  , size_t sstride) {
    const int t = tidx() >> 3, k8 = (tidx() & 7) * 8;
    float f[8]; unpack8(*(const uint4*)(src + (size_t)t * sstride + k8), f);
    *(float4*)(dst + t * HS_ + k8) = make_float4(f[0], f[1], f[2], f[3]); *(float4*)(dst + t * HS_ + k8 + 4) = make_float4(f[4], f[5], f[6], f[7]);
}
__device__ __forceinline__ void load_f32_tile64(float* dst, const float* src, size_t sstride) {
    const int t = tidx() >> 3, k8 = (tidx() & 7) * 8;
    *(float4*)(dst + t * HS_ + k8) = *(const float4*)(src + (size_t)t * sstride + k8); *(float4*)(dst + t * HS_ + k8 + 4) = *(const float4*)(src + (size_t)t * sstride + k8 + 4);
}

__device__ __forceinline__ void hgrn1_issue(const u16* PROJ, const float* LOGF, const PassInfo ps, int item, Reg8& rg) {
    const int NC = ps.T >> 6, ncsh = ps.is_ctx ? 2 : 6, c = item & (NC - 1), ci = item >> ncsh, dir = ci & 1, h = (ci >> 1) & 7, bl = ci >> 4;
    const size_t r0 = (size_t)bl * ps.T + c * 64;
    const int t = tidx() >> 3, k8 = (tidx() & 7) * 8;
    const float* ap = LOGF + (r0 + t) * 1024 + dir * 512 + h * 64 + k8;
    rg.ld(0, ap); rg.ld(1, ap + 4); rg.ld(2, PJ(r0 + t, 11 + dir, h * 64 + k8)); rg.ld(3, PJ(r0 + t, 13, h * 64 + k8));
}
__device__ void hgrn1_loop(const Params& p, const PassInfo ps, int first, int end, int stride, unsigned char* lds) {
    if (first >= end) return;
    unsigned char* ws = opaque(p.ws);
    const u16* PROJ = (const u16*)(ws + OFF_PROJ); const float* LOGF = (const float*)(ws + OFF_LOGF);
    u16* HL = (u16*)(ws + OFF_HL); float* HD = (float*)(ws + OFF_HD);
    float* A = (float*)lds; float* tmp = A + 64 * HS_; u16* Wb = (u16*)(tmp + 512); u16* Ib = Wb + 64 * KVS;
    const int tid = tidx(), w = tid >> 6, lane = tid & 63, li = lane & 15, quad = lane >> 4;
    const int t = tid >> 3, k8 = (tid & 7) * 8;
    Reg8 rg;
    hgrn1_issue(PROJ, LOGF, ps, first, rg);
  for (int item = first; item < end; item += stride) {
    const int ncsh = ps.is_ctx ? 2 : 6, ci = item >> ncsh, dir = ci & 1;
    float kf[8];
    { MEMBAR();
      unpack8(rg.getu(2), kf);
      *(u32x4_*)(A + t * HS_ + k8) = rg.get(0); *(u32x4_*)(A + t * HS_ + k8 + 4) = rg.get(1);
      *(u32x4_*)(Ib + t * KVS + k8) = rg.get(3); }
    __syncthreads();
    if (item + stride < end) hgrn1_issue(PROJ, LOGF, ps, item + stride, rg);
    chunk_cumsum(A, tmp, dir);
    const int lastt = dir == 0 ? 63 : 0;
    { float wv[8];
#pragma unroll
      for (int e = 0; e < 8; ++e) wv[e] = kf[e] * __builtin_amdgcn_exp2f(A[lastt * HS_ + k8 + e] - A[t * HS_ + k8 + e]);
      uint4 wq; wq.x = pack2(wv[0], wv[1]); wq.y = pack2(wv[2], wv[3]); wq.z = pack2(wv[4], wv[5]); wq.w = pack2(wv[6], wv[7]);
      *(uint4*)(Wb + t * KVS + k8) = wq;
      if (tid < 64) HD[(size_t)item * 64 + tid] = __builtin_amdgcn_exp2f(A[lastt * HS_ + tid]); }
    __syncthreads();
    {
        const int ksub = w >> 1;
        bf16x8 yf[2];
#pragma unroll
        for (int ks = 0; ks < 2; ++ks) { const u16* tp = Wb + (ks * 32 + quad * 8 + (li >> 2)) * KVS + ksub * 16 + 4 * (li & 3); yf[ks] = tr_read2(tp, tp + 4 * KVS); }
#pragma unroll
        for (int vv = 0; vv < 2; ++vv) {
            const int vsub = (w & 1) * 2 + vv;
            f32x4 a = (f32x4){0.f, 0.f, 0.f, 0.f};
#pragma unroll
            for (int ks = 0; ks < 2; ++ks) { const u16* tp = Ib + (ks * 32 + quad * 8 + (li >> 2)) * KVS + vsub * 16 + 4 * (li & 3); a = MFMA16(tr_read2(tp, tp + 4 * KVS), yf[ks], a); }
            uint2 o; o.x = pack2(a[0], a[1]); o.y = pack2(a[2], a[3]);
            *(uint2*)(HL + ((size_t)item * 64 + ksub * 16 + li) * 64 + vsub * 16 + quad * 4) = o;
        }
    }
    __syncthreads();
  }
}

__device__ void hgrn_chain(const Params& p, const PassInfo ps, int l, int ci, unsigned char* lds) {
    unsigned char* ws = opaque(p.ws);
    const u16* PROJ = (const u16*)(ws + OFF_PROJ); const float* LOGF = (const float*)(ws + OFF_LOGF);
    u16* HS = (u16*)(ws + OFF_HS); float* CST = (float*)(ws + OFF_CTXST) + (size_t)l * 256 * 4096;
    const int tid = tidx(), w = tid >> 6, lane = tid & 63, li = lane & 15, quad = lane >> 4;
    const int t = tid >> 3, k8 = (tid & 7) * 8;
    const int NC = ps.T >> 6, dir = ci & 1, ksub = w >> 1, kk_ = ksub * 16 + li;
    float S[2][4];
#pragma unroll
    for (int vv = 0; vv < 2; ++vv) {
        const int v0 = ((w & 1) * 2 + vv) * 16 + quad * 4;
        if (!ps.is_ctx) { const float4 c4 = *(const float4*)(CST + ((size_t)ps.b0 * 16 + ci) * 4096 + kk_ * 64 + v0); S[vv][0] = c4.x; S[vv][1] = c4.y; S[vv][2] = c4.z; S[vv][3] = c4.w; }
        else { S[vv][0] = 0.f; S[vv][1] = 0.f; S[vv][2] = 0.f; S[vv][3] = 0.f; }
    }
    Reg8 rg;
    hgrn1_issue(PROJ, LOGF, ps, ci * NC + (dir ? NC - 1 : 0), rg);
  for (int cc = 0; cc < NC; ++cc) {
    const int c = dir ? NC - 1 - cc : cc, item = ci * NC + c;
    float* A = (float*)(lds + (cc & 1) * 38912); float* tmp = A + 64 * HS_; u16* Wb = (u16*)(tmp + 512); u16* Ib = Wb + 64 * KVS;
    float kf[8];
    { MEMBAR();
      unpack8(rg.getu(2), kf);
      *(u32x4_*)(A + t * HS_ + k8) = rg.get(0); *(u32x4_*)(A + t * HS_ + k8 + 4) = rg.get(1);
      *(u32x4_*)(Ib + t * KVS + k8) = rg.get(3); }
    __syncthreads();
    if (cc + 1 < NC) hgrn1_issue(PROJ, LOGF, ps, ci * NC + (dir ? NC - 2 - cc : cc + 1), rg);
    chunk_cumsum(A, tmp, dir);
    const int lastt = dir == 0 ? 63 : 0;
    { float wv[8];
#pragma unroll
      for (int e = 0; e < 8; ++e) wv[e] = kf[e] * __builtin_amdgcn_exp2f(A[lastt * HS_ + k8 + e] - A[t * HS_ + k8 + e]);
      uint4 wq; wq.x = pack2(wv[0], wv[1]); wq.y = pack2(wv[2], wv[3]); wq.z = pack2(wv[4], wv[5]); wq.w = pack2(wv[6], wv[7]);
      *(uint4*)(Wb + t * KVS + k8) = wq; }
    __syncthreads();
    {
        const float dk = __builtin_amdgcn_exp2f(A[lastt * HS_ + kk_]);
        bf16x8 yf[2];
#pragma unroll
        for (int ks = 0; ks < 2; ++ks) { const u16* tp = Wb + (ks * 32 + quad * 8 + (li >> 2)) * KVS + ksub * 16 + 4 * (li & 3); yf[ks] = tr_read2(tp, tp + 4 * KVS); }
#pragma unroll
        for (int vv = 0; vv < 2; ++vv) {
            const int vsub = (w & 1) * 2 + vv;
            f32x4 a = (f32x4){0.f, 0.f, 0.f, 0.f};
#pragma unroll
            for (int ks = 0; ks < 2; ++ks) { const u16* tp = Ib + (ks * 32 + quad * 8 + (li >> 2)) * KVS + vsub * 16 + 4 * (li & 3); a = MFMA16(tr_read2(tp, tp + 4 * KVS), yf[ks], a); }
            uint2 o; o.x = pack2(S[vv][0], S[vv][1]); o.y = pack2(S[vv][2], S[vv][3]);
            *(uint2*)(HS + ((size_t)item * 64 + kk_) * 64 + vsub * 16 + quad * 4) = o;
#pragma unroll
            for (int j = 0; j < 4; ++j) S[vv][j] = dk * S[vv][j] + a[j];
        }
    }
  }
    __syncthreads();
    if (ps.is_ctx) {
#pragma unroll
        for (int vv = 0; vv < 2; ++vv) { const int v0 = ((w & 1) * 2 + vv) * 16 + quad * 4;
            *(float4*)(CST + (size_t)ci * 4096 + kk_ * 64 + v0) = make_float4(S[vv][0], S[vv][1], S[vv][2], S[vv][3]); }
    }
}

__device__ void hgrn2_all(const Params& p, const PassInfo ps, int l) {
    unsigned char* ws = opaque(p.ws);
    const unsigned* HL = (const unsigned*)(ws + OFF_HL); const float* HD = (const float*)(ws + OFF_HD); unsigned* HS = (unsigned*)(ws + OFF_HS);
    float* CST = (float*)(ws + OFF_CTXST) + (size_t)l * 256 * 4096;
    const int NC = ps.T >> 6, chains = ps.nb * 16;
    const size_t total = (size_t)chains * 2048;
    for (size_t e = (size_t)blockIdx.x * 512 + tidx(); e < total; e += (size_t)gridDim.x * 512) {
        const int ci = (int)(e >> 11), kv2 = (int)(e & 2047), k = kv2 >> 5, dir = ci & 1;
        float s0 = 0.f, s1 = 0.f;
        if (!ps.is_ctx) { const float2 cs = *(const float2*)(CST + ((size_t)ps.b0 * 16 + ci) * 4096 + 2 * kv2); s0 = cs.x; s1 = cs.y; }
#define HG2_TRIP(BLK) for (int c4 = 0; c4 < NC; c4 += BLK) { float d[BLK]; unsigned lw[BLK]; \
            _Pragma("unroll") for (int j = 0; j < BLK; ++j) { const int c = dir ? NC - 1 - (c4 + j) : c4 + j; const size_t idx = (size_t)ci * NC + c; d[j] = HD[idx * 64 + k]; lw[j] = HL[idx * 2048 + kv2]; } \
            _Pragma("unroll") for (int j = 0; j < BLK; ++j) { const int c = dir ? NC - 1 - (c4 + j) : c4 + j; const size_t idx = (size_t)ci * NC + c; \
                HS[idx * 2048 + kv2] = pack2(s0, s1); s0 = d[j] * s0 + bflo(lw[j]); s1 = d[j] * s1 + bfhi(lw[j]); } }
        if (NC == 4) { HG2_TRIP(4) } else { HG2_TRIP(16) }
#undef HG2_TRIP
        if (ps.is_ctx) *(float2*)(CST + (size_t)ci * 4096 + 2 * kv2) = make_float2(s0, s1);
    }
}

__device__ void hgrn3_item(const Params& p, const PassInfo ps, int l, int item, unsigned char* lds) {
    unsigned char* ws = opaque(p.ws);
    const u16* PROJ = (const u16*)(ws + OFF_PROJ); const float* LOGF = (const float*)(ws + OFF_LOGF); const u16* HSt = (const u16*)(ws + OFF_HS);
    u16* Y3 = (u16*)(ws + OFF_Y) + (size_t)3 * MLAT * 512;
    const int NC = ps.T >> 6, ncsh = ps.is_ctx ? 2 : 6, c = item & (NC - 1), bh = item >> ncsh, h = bh & 7, bl = bh >> 3;
    const size_t r0 = (size_t)bl * ps.T + c * 64;
    const size_t idxf = (size_t)(bh * 2 + 0) * NC + c, idxb = (size_t)(bh * 2 + 1) * NC + c;
    float* Q = (float*)lds; float* KKf = Q + 64 * HS_; float* KKb = KKf + 64 * HS_; float* Af = KKb + 64 * HS_; float* Ab = Af + 64 * HS_; float* tmp = Ab + 64 * HS_;
    u16* Ib = (u16*)(tmp + 1024); u16* Sfb = Ib + 64 * KVS; u16* Sbb = Sfb + 64 * KVS; float* comb = (float*)(Sbb + 64 * KVS);
    const int tid = tidx(), w = tid >> 6, lane = tid & 63, li = lane & 15, quad = lane >> 4;
    { const int t = tid >> 3, k8 = (tid & 7) * 8;
      Reg8 ra, rb;
      const float* ap = LOGF + (r0 + t) * 1024 + h * 64 + k8;
      const u16* sf = HSt + idxf * 4096 + t * 64 + k8; const u16* sb = HSt + idxb * 4096 + t * 64 + k8;
      ra.ld(0, PJ(r0 + t, 10, h * 64 + k8)); ra.ld(1, PJ(r0 + t, 11, h * 64 + k8)); ra.ld(2, PJ(r0 + t, 12, h * 64 + k8)); ra.ld(3, PJ(r0 + t, 13, h * 64 + k8));
      ra.ld(4, ap); ra.ld(5, ap + 4); ra.ld(6, ap + 512); ra.ld(7, ap + 516);
      rb.ld(0, sf); rb.ld(1, sb);
      MEMBAR();
      float x[8];
      unpack8(ra.getu(0), x); *(float4*)(Q + t * HS_ + k8) = make_float4(x[0], x[1], x[2], x[3]); *(float4*)(Q + t * HS_ + k8 + 4) = make_float4(x[4], x[5], x[6], x[7]);
      unpack8(ra.getu(1), x); *(float4*)(KKf + t * HS_ + k8) = make_float4(x[0], x[1], x[2], x[3]); *(float4*)(KKf + t * HS_ + k8 + 4) = make_float4(x[4], x[5], x[6], x[7]);
      unpack8(ra.getu(2), x); *(float4*)(KKb + t * HS_ + k8) = make_float4(x[0], x[1], x[2], x[3]); *(float4*)(KKb + t * HS_ + k8 + 4) = make_float4(x[4], x[5], x[6], x[7]);
      *(u32x4_*)(Ib + t * KVS + k8) = ra.get(3);
      *(u32x4_*)(Af + t * HS_ + k8) = ra.get(4); *(u32x4_*)(Af + t * HS_ + k8 + 4) = ra.get(5); *(u32x4_*)(Ab + t * HS_ + k8) = ra.get(6); *(u32x4_*)(Ab + t * HS_ + k8 + 4) = ra.get(7);
      *(u32x4_*)(Sfb + t * KVS + k8) = rb.get(0); *(u32x4_*)(Sbb + t * KVS + k8) = rb.get(1); }
    __syncthreads();
    chunk_cumsum2(Af, Ab, tmp);
    const int dir = w >> 2, T = w & 3;
    const float* A = dir ? Ab : Af; const float* KK = dir ? KKb : KKf; const u16* Sb16 = dir ? Sbb : Sfb;
    const int t = 16 * T + li;
    const int rrow = dir ? 16 * T + 16 : 16 * T - 1; const bool rzero = dir ? (T == 3) : (T == 0);
    bf16x8 qt[2], qh[2];
    float Rv[2][8];
#pragma unroll
    for (int ks = 0; ks < 2; ++ks) {
        const int k0 = ks * 32 + quad * 8;
        float qv[8], av[8];
        { const float4 x0 = *(const float4*)(Q + t * HS_ + k0), x1 = *(const float4*)(Q + t * HS_ + k0 + 4); qv[0] = x0.x; qv[1] = x0.y; qv[2] = x0.z; qv[3] = x0.w; qv[4] = x1.x; qv[5] = x1.y; qv[6] = x1.z; qv[7] = x1.w; }
        { const float4 x0 = *(const float4*)(A + t * HS_ + k0), x1 = *(const float4*)(A + t * HS_ + k0 + 4); av[0] = x0.x; av[1] = x0.y; av[2] = x0.z; av[3] = x0.w; av[4] = x1.x; av[5] = x1.y; av[6] = x1.z; av[7] = x1.w; }
        if (rzero) {
#pragma unroll
            for (int e = 0; e < 8; ++e) Rv[ks][e] = 0.f;
        } else { const float4 x0 = *(const float4*)(A + rrow * HS_ + k0), x1 = *(const float4*)(A + rrow * HS_ + k0 + 4); Rv[ks][0] = x0.x; Rv[ks][1] = x0.y; Rv[ks][2] = x0.z; Rv[ks][3] = x0.w; Rv[ks][4] = x1.x; Rv[ks][5] = x1.y; Rv[ks][6] = x1.z; Rv[ks][7] = x1.w; }
        float a_[8], b_[8];
#pragma unroll
        for (int e = 0; e < 8; ++e) { a_[e] = qv[e] * __builtin_amdgcn_exp2f(av[e] - Rv[ks][e]); b_[e] = qv[e] * __builtin_amdgcn_exp2f(av[e]); }
        const unsigned a0 = pack2(a_[0], a_[1]), a1 = pack2(a_[2], a_[3]), a2 = pack2(a_[4], a_[5]), a3 = pack2(a_[6], a_[7]);
        const unsigned b0 = pack2(b_[0], b_[1]), b1 = pack2(b_[2], b_[3]), b2 = pack2(b_[4], b_[5]), b3 = pack2(b_[6], b_[7]);
        qt[ks] = (bf16x8){(short)(a0 & 0xffff), (short)(a0 >> 16), (short)(a1 & 0xffff), (short)(a1 >> 16), (short)(a2 & 0xffff), (short)(a2 >> 16), (short)(a3 & 0xffff), (short)(a3 >> 16)};
        qh[ks] = (bf16x8){(short)(b0 & 0xffff), (short)(b0 >> 16), (short)(b1 & 0xffff), (short)(b1 >> 16), (short)(b2 & 0xffff), (short)(b2 >> 16), (short)(b3 & 0xffff), (short)(b3 >> 16)};
    }
    const int nS = dir ? 4 - T : T + 1;
    float sc[4][4];
#pragma unroll
    for (int i = 0; i < 4; ++i) {
        if (i < nS) {
            const int S = dir ? T + i : i, srow = 16 * S + li;
            f32x4 a = (f32x4){0.f, 0.f, 0.f, 0.f};
#pragma unroll
            for (int ks = 0; ks < 2; ++ks) {
                const int k0 = ks * 32 + quad * 8;
                const float4 x0 = *(const float4*)(KK + srow * HS_ + k0), x1 = *(const float4*)(KK + srow * HS_ + k0 + 4);
                const float4 y0 = *(const float4*)(A + srow * HS_ + k0), y1 = *(const float4*)(A + srow * HS_ + k0 + 4);
                const float kv[8] = {x0.x, x0.y, x0.z, x0.w, x1.x, x1.y, x1.z, x1.w}, as[8] = {y0.x, y0.y, y0.z, y0.w, y1.x, y1.y, y1.z, y1.w};
                float c_[8];
#pragma unroll
                for (int e = 0; e < 8; ++e) c_[e] = kv[e] * __builtin_amdgcn_exp2f(Rv[ks][e] - as[e]);
                const unsigned c0 = pack2(c_[0], c_[1]), c1 = pack2(c_[2], c_[3]), c2 = pack2(c_[4], c_[5]), c3 = pack2(c_[6], c_[7]);
                const bf16x8 kf = (bf16x8){(short)(c0 & 0xffff), (short)(c0 >> 16), (short)(c1 & 0xffff), (short)(c1 >> 16), (short)(c2 & 0xffff), (short)(c2 >> 16), (short)(c3 & 0xffff), (short)(c3 >> 16)};
                a = MFMA16(kf, qt[ks], a);
            }
            const bool diag = (S == T);
#pragma unroll
            for (int j = 0; j < 4; ++j) { const int sl = quad * 4 + j; const bool keep = !diag || (dir ? (sl >= li) : (sl <= li)); sc[i][j] = keep ? a[j] : 0.f; }
        } else {
#pragma unroll
            for (int j = 0; j < 4; ++j) sc[i][j] = 0.f;
        }
    }
    f32x4 O[4];
#pragma unroll
    for (int v = 0; v < 4; ++v) O[v] = (f32x4){0.f, 0.f, 0.f, 0.f};
#pragma unroll
    for (int pr = 0; pr < 2; ++pr) {
        if (2 * pr < nS) {
            const unsigned a0 = pack2(sc[2 * pr][0], sc[2 * pr][1]), a1 = pack2(sc[2 * pr][2], sc[2 * pr][3]), b0 = pack2(sc[2 * pr + 1][0], sc[2 * pr + 1][1]), b1 = pack2(sc[2 * pr + 1][2], sc[2 * pr + 1][3]);
            const bf16x8 pf = (bf16x8){(short)(a0 & 0xffff), (short)(a0 >> 16), (short)(a1 & 0xffff), (short)(a1 >> 16), (short)(b0 & 0xffff), (short)(b0 >> 16), (short)(b1 & 0xffff), (short)(b1 >> 16)};
            const int S0 = dir ? T + 2 * pr : 2 * pr; int S1 = S0 + 1; if (S1 > 3) S1 = 3;
            const u16* p0 = Ib + (16 * S0 + quad * 4 + (li >> 2)) * KVS + 4 * (li & 3);
            const u16* p1 = Ib + (16 * S1 + quad * 4 + (li >> 2)) * KVS + 4 * (li & 3);
#pragma unroll
            for (int v = 0; v < 4; ++v) O[v] = MFMA16(tr_read2(p0 + v * 16, p1 + v * 16), pf, O[v]);
        }
    }
#pragma unroll
    for (int ks = 0; ks < 2; ++ks) {
        const u16* p0 = Sb16 + (ks * 32 + quad * 8 + (li >> 2)) * KVS + 4 * (li & 3);
#pragma unroll
        for (int v = 0; v < 4; ++v) O[v] = MFMA16(tr_read2(p0 + v * 16, p0 + 4 * KVS + v * 16), qh[ks], O[v]);
    }
    if (dir == 1) {
#pragma unroll
        for (int v = 0; v < 4; ++v)
#pragma unroll
            for (int j = 0; j < 4; ++j) comb[(T * 16 + v * 4 + j) * 64 + lane] = O[v][j];
    }
    __syncthreads();
    if (dir == 0) {
        float ss = 0.f;
#pragma unroll
        for (int v = 0; v < 4; ++v)
#pragma unroll
            for (int j = 0; j < 4; ++j) { O[v][j] += comb[(T * 16 + v * 4 + j) * 64 + lane]; ss += O[v][j] * O[v][j]; }
        ss += shx(ss, 16); ss += shx(ss, 32);
        const float rstd = rsqrtf(ss * (1.f / 64.f) + EPSN);
        const size_t row = r0 + t;
#pragma unroll
        for (int v = 0; v < 4; ++v) {
            const int col = h * 64 + v * 16 + quad * 4;
            const float4 gn = *(const float4*)(p.hgrn_g + l * 512 + col);
            const uint2 g = *(const uint2*)(PJ(row, 14, col));
            uint2 wv; wv.x = pack2(O[v][0] * rstd * gn.x * siluf_(bflo(g.x)), O[v][1] * rstd * gn.y * siluf_(bfhi(g.x))); wv.y = pack2(O[v][2] * rstd * gn.z * siluf_(bflo(g.y)), O[v][3] * rstd * gn.w * siluf_(bfhi(g.y)));
            *(uint2*)(Y3 + row * 512 + col) = wv;
        }
    }
    __syncthreads();
}
#define XB_TMO      128
#define XB_XCNT(j)  (256  + 64 * (j))
#define XB_XSUB(j)  (1280 + 64 * (j))
#define XB_XGEN(j)  (2304 + 64 * (j))
#define XB_TOP      3328
#define XB_TOPGEN   3392
#define XCD_BAR_WORDS 3456
#define XB_SPIN_CAP (1u << 18)

__device__ __forceinline__ unsigned xb_ld(unsigned* p)              { return __hip_atomic_load(p, __ATOMIC_RELAXED, __HIP_MEMORY_SCOPE_AGENT); }
__device__ __forceinline__ unsigned xb_add(unsigned* p, unsigned v) { return __hip_atomic_fetch_add(p, v, __ATOMIC_RELAXED, __HIP_MEMORY_SCOPE_AGENT); }
__device__ __forceinline__ unsigned xb_xcc_id() { return (unsigned)__builtin_amdgcn_s_getreg((3 << 11) | 20) & 0xFu; }
#define XB_SPIN(cond, bar) do { unsigned _sp = 0; while (cond) { __builtin_amdgcn_s_sleep(1); \
    if ((++_sp & 255u) == 0u) { if (xb_ld(&(bar)[XB_TMO])) break; if (_sp > XB_SPIN_CAP) { atomicAdd(&(bar)[XB_TMO], 1u); break; } } } } while (0)

struct XcdBarrier {
    unsigned* bar; unsigned x;
    volatile LAS unsigned* st;
};

__device__ __forceinline__ XcdBarrier xcd_barrier_post(unsigned* bar, volatile LAS unsigned* st) {
    XcdBarrier b; b.bar = bar; b.x = xb_xcc_id(); b.st = st;
    if (tidx() == 0) (void)xb_add(&bar[XB_XCNT(b.x)], 1u);
    return b;
}
__device__ __forceinline__ void xcd_barrier_complete(unsigned* bar, unsigned x, unsigned& nloc, unsigned& nx) {
    const unsigned G = gridDim.x * gridDim.y * gridDim.z;
    unsigned sum, cnt, mine, sp = 0u;
    for (;;) {
        sum = 0u; cnt = 0u; mine = 0u;
#pragma unroll
        for (unsigned j = 0; j < 16; ++j) { const unsigned c = xb_ld(&bar[XB_XCNT(j)]); sum += c; cnt += (c > 0u) ? 1u : 0u; mine = (j == x) ? c : mine; }
        if (sum == G) break;
        __builtin_amdgcn_s_sleep(1);
        if ((++sp & 255u) == 0u) { if (xb_ld(&bar[XB_TMO])) break; if (sp > XB_SPIN_CAP) { atomicAdd(&bar[XB_TMO], 1u); break; } }
    }
    nloc = mine > 0u ? mine : 1u; nx = cnt > 0u ? cnt : 1u;
}

__device__ __forceinline__ void xcd_barrier(const XcdBarrier& b) {
    asm volatile("s_waitcnt vmcnt(0)" ::: "memory");
    __syncthreads();
    if (tidx() == 0) {
        unsigned* bar = b.bar;
        __builtin_amdgcn_s_waitcnt(0);
        unsigned nloc = b.st[0], nx = b.st[1];
        if (nloc == 0u) { xcd_barrier_complete(bar, b.x, nloc, nx); b.st[0] = nloc; b.st[1] = nx; }
        const unsigned old = xb_add(&bar[XB_XSUB(b.x)], 1u);
        const unsigned gen = old / nloc;
        if (old + 1u == (gen + 1u) * nloc) {
            __builtin_amdgcn_fence(__ATOMIC_RELEASE, "agent");
            asm volatile("s_waitcnt vmcnt(0)" ::: "memory");
            const unsigned og = xb_add(&bar[XB_TOP], 1u);
            const unsigned tg = og / nx;
            if (og + 1u == (tg + 1u) * nx) xb_add(&bar[XB_TOPGEN], 1u);
            else XB_SPIN(xb_ld(&bar[XB_TOPGEN]) == tg, bar);
            __builtin_amdgcn_fence(__ATOMIC_ACQUIRE, "agent");
            xb_add(&bar[XB_XGEN(b.x)], 1u);
            asm volatile("s_waitcnt vmcnt(0)" ::: "memory");
        } else {
            XB_SPIN(xb_ld(&bar[XB_XGEN(b.x)]) == gen, bar);
            __builtin_amdgcn_fence(__ATOMIC_ACQUIRE, "agent");
            asm volatile("s_waitcnt vmcnt(0)" ::: "memory");
        }
    }
    __syncthreads();
}

#ifndef STAG_B
#define STAG_B 240
#endif
#ifndef STAG_D
#define STAG_D 300
#endif
#ifndef REP_ATTN
#define REP_ATTN 1
#endif
#ifndef REP_B
#define REP_B 1
#endif
#ifndef REP_C1
#define REP_C1 1
#endif
#ifndef REP_C2
#define REP_C2 1
#endif
#ifndef REP_C3
#define REP_C3 1
#endif
#ifndef REP_DE
#define REP_DE 1
#endif
__device__ __forceinline__ void stagger(int ticks_per_slot) {
    const int slot = ((int)blockIdx.x >> 3) & 7;
    if (slot) { const unsigned long long t0 = __builtin_amdgcn_s_memrealtime(), dt = (unsigned long long)(slot * ticks_per_slot);
        while (__builtin_amdgcn_s_memrealtime() - t0 < dt) __builtin_amdgcn_s_sleep(4); }
}
template <class Epi> __device__ __forceinline__ void run_gemm(LAS unsigned char* lds, const u16* A, const u16* Bt, int M, int N, int K, const Epi& E) {
    pg8::Gemm g; g.A = A; g.Bt = Bt; g.M = M; g.N = N; g.K = K; g.rsA = 0; g.rsB = 0;
    pg8::StaticOrder S; S.init(M, N, (int)gridDim.x, (int)blockIdx.x);
    pg8::gemm_phase<Epi, pg8::StaticOrder, false>(lds, g, S, E, nullptr);
}


struct EpiNull {
    static constexpr bool PERM = true, AFTER_DRAIN = false;
    unsigned char* ws;
    __device__ __forceinline__ void operator()(const f32x4 (&acc)[2][2][4][2], const Unit& u, int wr, int wc, int fr, int fq) const {
        if (ws == nullptr) {
#pragma unroll
            for (int ai = 0; ai < 2; ++ai)
#pragma unroll
                for (int bj = 0; bj < 2; ++bj)
#pragma unroll
                    for (int m = 0; m < 4; ++m)
#pragma unroll
                        for (int n = 0; n < 2; ++n) *(f32x4*)(ws + (size_t)(((ai * 2 + bj) * 4 + m) * 2 + n) * 16 + fr * 1024 + fq * 65536 + wr * 4096 + wc * 16384 + u.pm) = acc[ai][bj][m][n];
        }
    }
};
struct MergeOrder : pg8::StaticOrder {
    __device__ bool next(int i, Unit& u) const { if (!pg8::StaticOrder::next(i >> 2, u)) return false; u.r = i & 3; return true; }
};
__device__ __forceinline__ Params KP() {
    auto q0 = __builtin_amdgcn_kernarg_segment_ptr();
    asm volatile("" : "+s"(q0));
    const __attribute__((address_space(4))) Params* q = (const __attribute__((address_space(4))) Params*)q0;
    Params r;
    r.x = q->x; r.c = q->c; r.ctx = q->ctx; r.c_ctx = q->c_ctx; r.w_ada = q->w_ada; r.b_ada = q->b_ada; r.g_pre = q->g_pre; r.g_post = q->g_post; r.w_in = q->w_in; r.rpb = q->rpb;
    r.fnet_w = q->fnet_w; r.gmlp_g = q->gmlp_g; r.gmlp_ws = q->gmlp_ws; r.gmlp_bs = q->gmlp_bs; r.lb_logits = q->lb_logits; r.hgrn_g = q->hgrn_g; r.w_branch = q->w_branch; r.w_out = q->w_out;
    r.out = q->out; r.ws = q->ws; return r;
}
constexpr size_t OFF_BAR = WS_END;
constexpr size_t WS_END2 = WS_END + (size_t)XCD_BAR_WORDS * 4;
__device__ __forceinline__ void gsync(LAS unsigned char* lds3) {
    XcdBarrier b; b.bar = (unsigned*)(opaque(KP().ws) + OFF_BAR); b.x = xb_xcc_id(); b.st = (volatile LAS unsigned*)(lds3 + LDS_BYTES);
    xcd_barrier(b);
}
__global__ void __launch_bounds__(512, 2) mega_fwd(Params p_unused) {
    extern __shared__ __attribute__((aligned(16))) unsigned char shm[];
    LAS unsigned char* lds3 = (LAS unsigned char*)shm;
    {
        if (tidx() < 4) ((volatile LAS unsigned*)(lds3 + LDS_BYTES))[tidx()] = 0u;
        if (blockIdx.x == 0) { unsigned* bar = (unsigned*)(opaque(KP().ws) + OFF_BAR); for (int i = tidx(); i < XCD_BAR_WORDS; i += 512) bar[i] = 0u; }
        __syncthreads();
    }
    prep1(KP(), shm);
    cg::this_grid().sync();
    { XcdBarrier b0 = xcd_barrier_post((unsigned*)(opaque(KP().ws) + OFF_BAR), (volatile LAS unsigned*)(lds3 + LDS_BYTES)); (void)b0; }
    prep2(KP(), shm);
    gsync(lds3);
#pragma nounroll
    for (int pass = 0; pass < 1 + NBATCH / GB; ++pass) {
        PassInfo ps;
        if (pass == 0) { ps.is_ctx = 1; ps.nb = NBATCH; ps.T = CTXL; ps.M = MCTX; ps.b0 = 0; }
        else { ps.is_ctx = 0; ps.nb = GB; ps.T = SEQ; ps.M = MLAT; ps.b0 = (pass - 1) * GB; }
        const int NC = ps.T >> 6;
#pragma nounroll
        for (int l = 0; l < DEPTH; ++l) {
            phase_norm(KP(), ps, l);
            gsync(lds3);
            _Pragma("nounroll") for (int rep = 0; rep < REP_B; ++rep) {
                unsigned char* ws = opaque(KP().ws);
                EpiProj E; E.ws = ws; E.l = l; E.is_ctx = ps.is_ctx;

                run_gemm(lds3, (const u16*)(ws + OFF_H), (const u16*)(ws + OFF_WTIN) + (size_t)l * NPROJ * DM, ps.M, NPROJ, DM, E);
                gsync(lds3);
#ifdef PROBE_NULL_B
                { EpiNull EN; EN.ws = ws; run_gemm(lds3, (const u16*)(ws + OFF_H), (const u16*)(ws + OFF_WTIN) + (size_t)l * NPROJ * DM, ps.M, NPROJ, DM, EN); gsync(lds3); }
#endif
            }
            const bool full = !(ps.is_ctx && l == DEPTH - 1);
            {
                const int nch = ps.nb * 16, n_at = full ? ps.nb * 8 * (ps.T >> 6) : 0, n_f1 = ps.is_ctx ? 0 : ps.nb * 64;
                const bool latx = !(nch >= (int)gridDim.x || (int)gridDim.x != 4 * nch || ((int)gridDim.x & 7) != 0 || !full);
                const int n_g = latx ? (ps.M >> 7) : 0;
                const int wg = (int)blockIdx.x, G = (int)gridDim.x;
                int first, stride;
                bool xl = false; int xcd = 0, lr = 0, nloc = 1, grank = 0;
                if (!latx) {
                    for (int ci = wg; ci < nch; ci += G) hgrn_chain(KP(), ps, l, ci, shm);
                    first = wg; stride = G;
                } else {
                    const int g4 = wg >> 2, pos = wg & 3, cpos = (g4 >> 1) & 3;
                    first = 0x7fffffff; stride = 1;
                    if (pos == cpos) hgrn_chain(KP(), ps, l, g4, shm);
                    else {
                        xl = true; xcd = wg & 7; nloc = 0; grank = g4 * 3 + pos - (pos > cpos ? 1 : 0);
                        for (int w2 = xcd; w2 < G; w2 += 8) { const int g2 = w2 >> 2, nonchain = ((w2 & 3) != ((g2 >> 1) & 3)) ? 1 : 0; nloc += nonchain; if (w2 < wg) lr += nonchain; }
                    }
                }
                const int A_x = n_at >> 3, F_x = n_f1 >> 3;
                const int na = xl ? (A_x - lr + nloc - 1) / nloc : 0;
                for (int k = 0;; ++k) {
                    int it;
                    if (xl) {
                        if (k < na) { const int a = lr + k * nloc; it = (((a >> 6) << 3) + xcd) * 64 + (a & 63); }
                        else { const int f = (nloc - 1 - lr) + (k - na) * nloc;
                            if (f < F_x) it = n_at + xcd * F_x + f;
                            else { const int nf = (F_x - (nloc - 1 - lr) + nloc - 1) / nloc, gi = grank + (k - na - nf) * ((G >> 2) * 3); if (gi >= n_g) break; it = n_at + n_f1 + gi; } }
                    } else { it = first + k * stride; if (first == 0x7fffffff || it >= n_at + n_f1 + n_g) break; }
                    if (it < n_at) attn_item(KP(), ps, l, it, shm);
                    else if (it < n_at + n_f1) four1_item(KP(), it - n_at, shm);
                    else gmlp_item(KP(), l, it - n_at - n_f1, shm);
                }
                gsync(lds3);
            }
            if (!full) continue;
            {
                const int n_f2 = ps.is_ctx ? ps.nb * 4 : ps.nb * 64, n_h3 = ps.nb * 8 * NC, n_g3 = (ps.is_ctx || (int)gridDim.x != 64 * ps.nb || ((int)gridDim.x & 7) != 0) ? (ps.M >> 7) : 0;
                for (int it = blockIdx.x; it < n_f2 + n_h3 + n_g3; it += gridDim.x) {
                    if (it < n_f2) { if (ps.is_ctx) fourc_item(KP(), it, shm); else four2_item(KP(), it, shm); }
                    else if (it < n_f2 + n_h3) hgrn3_item(KP(), ps, l, it - n_f2, shm);
                    else gmlp_item(KP(), l, it - n_f2 - n_h3, shm);
                }
                gsync(lds3);
            }
            _Pragma("nounroll") for (int rep = 0; rep < REP_DE; ++rep) {
            {
                unsigned char* ws = opaque(KP().ws);
                pg8::Gemm g; g.A = (const u16*)(ws + OFF_Y); g.Bt = (const u16*)(ws + OFF_WTBR) + (size_t)l * 4 * 1024 * 512; g.M = ps.M; g.N = 1024; g.K = 512;
                g.rsA = (size_t)MLAT * 512 * 2; g.rsB = (size_t)1024 * 512 * 2;
                MergeOrder S; S.init(ps.M, 1024, (int)gridDim.x, (int)blockIdx.x);
                EpiMerge E; E.ws = ws;

                pg8::gemm_phase<EpiMerge, MergeOrder, false>(lds3, g, S, E, nullptr);
            }
            gsync(lds3);
            if (REP_DE > 1 && rep + 1 < REP_DE) continue;
            {
                unsigned char* ws = opaque(KP().ws);
                EpiOut E; E.C = (u16*)(ws + OFF_OUT);
                run_gemm(lds3, (const u16*)(ws + OFF_MB), (const u16*)(ws + OFF_WTOUT) + (size_t)l * 1024 * 1024, ps.M, 1024, 1024, E);
            }
            gsync(lds3);
            }
        }
        if (!ps.is_ctx) phase_norm(KP(), ps, DEPTH);
    }
}

static_assert(WS_END2 <= (size_t)1073741824, "workspace map exceeds 1 GiB");

extern "C" void kernel_launch(void* const* d_in, const int* in_sizes, int n_in, void* d_out, int out_size, void* d_ws, size_t ws_size, hipStream_t stream) {
    static int grid_blocks = 0;
    if (grid_blocks == 0) {
        if (n_in != 18 || ws_size < WS_END2) { fprintf(stderr, "kernel_launch: unexpected n_in %d or ws_size %zu (need %zu)\n", n_in, ws_size, (size_t)WS_END2); grid_blocks = -1; return; }
        int dev = 0, cus = 0, per_cu = 0;
        hipGetDevice(&dev);
        hipDeviceGetAttribute(&cus, hipDeviceAttributeMultiprocessorCount, dev);
        if (hipFuncSetAttribute((const void*)mega_fwd, hipFuncAttributeMaxDynamicSharedMemorySize, LDS_BYTES + 16) != hipSuccess) { fprintf(stderr, "kernel_launch: hipFuncSetAttribute failed\n"); grid_blocks = -1; return; }
        hipOccupancyMaxActiveBlocksPerMultiprocessor(&per_cu, (const void*)mega_fwd, 512, LDS_BYTES + 16);
        if (per_cu < 1) { fprintf(stderr, "kernel_launch: occupancy query gave %d\n", per_cu); per_cu = 1; }
        (void)hipGetLastError();
        grid_blocks = cus * per_cu;
    }
    if (grid_blocks < 0) return;
    Params p{};
    const float** pp = (const float**)&p;
    for (int i = 0; i < 18; ++i) pp[i] = (const float*)d_in[i];
    p.out = (float*)d_out; p.ws = (unsigned char*)d_ws;
    void* args[] = {&p};
    hipError_t e = hipLaunchCooperativeKernel((const void*)mega_fwd, dim3(grid_blocks), dim3(512), args, LDS_BYTES + 16, stream);
    if (e != hipSuccess) fprintf(stderr, "cooperative launch failed: %s (grid %d)\n", hipGetErrorString(e), grid_blocks);
}
```
